# Optimizing an MI355X kernel written in HIP

```python
import math
import jax, jax.numpy as jnp
from jax import lax
import numpy as np

D_MODEL = 1024
BATCH = 16
SEQ = 2048
DEPTH = 1

D_MIX = D_MODEL
SB_HEADS = 8
SB_HEAD_DIM = 64
SB_WIDTH = SB_HEADS * SB_HEAD_DIM
RW_HEADS = 8
RW_HEAD_DIM = 64
RW_WIDTH = RW_HEADS * RW_HEAD_DIM
LORA_W = 64
LORA_A = 64
LORA_G = 128
RW_IN = 3 * RW_WIDTH + LORA_W + LORA_A + LORA_G
SB_IN = 3 * SB_WIDTH
N_IN = SB_IN + RW_IN
Q_BLOCK = 128
N_GROUPS = 4
EXPERTS_PER_GROUP = 8
N_EXPERTS = N_GROUPS * EXPERTS_PER_GROUP
TOP_K_IN_GROUP = 2
D_EXPERT = 256
RMS_EPS = 1e-6
GN_EPS = 64e-5

kernel_name = "hybrid_sbattn_rwkv7_hiermoe"


def rmsnorm(x, g):
    xf = x.astype(jnp.float32)
    y = xf * lax.rsqrt(jnp.mean(xf * xf, axis=-1, keepdims=True) + RMS_EPS)
    return (y * g.astype(jnp.float32)).astype(x.dtype)


def token_shift(u):
    return jnp.pad(u, ((0, 0), (1, 0), (0, 0)))[:, :-1]


def stick_breaking_attention(q, k, v):
    B, H, S, dh = q.shape
    scale = 1.0 / math.sqrt(dh)
    outs = []
    for blk in range(S // Q_BLOCK):
        t0 = blk * Q_BLOCK
        kv_len = t0 + Q_BLOCK
        qb = q[:, :, t0:kv_len].astype(jnp.float32)
        kb = k[:, :, :kv_len].astype(jnp.float32)
        vb = v[:, :, :kv_len].astype(jnp.float32)
        z = jnp.einsum('bhqd,bhkd->bhqk', qb, kb) * scale
        t_pos = t0 + jnp.arange(Q_BLOCK)[:, None]
        s_pos = jnp.arange(kv_len)[None, :]
        strict = s_pos < t_pos
        log_rest = jnp.where(strict, jax.nn.log_sigmoid(-z), 0.0)
        suffix = lax.cumsum(log_rest, axis=3, reverse=True) - log_rest
        weights = jnp.where(strict, jnp.exp(jax.nn.log_sigmoid(z) + suffix), 0.0)
        outs.append(jnp.einsum('bhqk,bhkd->bhqd', weights, vb))
    return jnp.concatenate(outs, axis=2)


def rwkv7_scan(r, w, k, v, kk, a):
    B, S, H, N = r.shape
    xs = tuple(jnp.moveaxis(t, 1, 0) for t in (r, w, k, v, kk, a))

    def step(state, inp):
        r_t, w_t, k_t, v_t, kk_t, a_t = inp
        sa = jnp.einsum('bhij,bhj->bhi', state, -kk_t)
        state = (state * w_t[:, :, None, :]
                 + sa[..., None] * (kk_t * a_t)[:, :, None, :]
                 + v_t[..., None] * k_t[:, :, None, :])
        out = jnp.einsum('bhij,bhj->bhi', state, r_t)
        return state, out

    state0 = jnp.zeros((B, H, N, N), jnp.float32)
    _, outs = lax.scan(step, state0, xs)
    return jnp.moveaxis(outs, 0, 1)


def rwkv7_group(u_rw, shift_mu, w0, w2, a0, a2, g2, k_k, k_a, r_k, ln_w, ln_b):
    B, S, _ = u_rw.shape
    uf = u_rw.astype(jnp.float32)
    um = uf + (token_shift(uf) - uf) * shift_mu.astype(jnp.float32)
    o = 0
    r = um[..., o:o + RW_WIDTH]; o += RW_WIDTH
    k = um[..., o:o + RW_WIDTH]; o += RW_WIDTH
    v = um[..., o:o + RW_WIDTH]; o += RW_WIDTH
    xw = um[..., o:o + LORA_W]; o += LORA_W
    xa = um[..., o:o + LORA_A]; o += LORA_A
    xg = um[..., o:o + LORA_G]
    w_log = -jax.nn.softplus(-(w0 + jnp.tanh(xw) @ w2)) - 0.5
    decay = jnp.exp(-jnp.exp(w_log))
    a = jax.nn.sigmoid(a0 + xa @ a2)
    g = jax.nn.sigmoid(xg) @ g2
    hs = lambda t: t.reshape(B, S, RW_HEADS, RW_HEAD_DIM)
    kk = hs(k * k_k)
    kk = kk * lax.rsqrt(jnp.maximum(jnp.sum(kk * kk, axis=-1, keepdims=True), 1e-24))
    k = k * (1.0 + (a - 1.0) * k_a)
    r_h, k_h, v_h, w_h, a_h = hs(r), hs(k), hs(v), hs(decay), hs(a)
    out = rwkv7_scan(r_h, w_h, k_h, v_h, kk, a_h)
    mean = jnp.mean(out, axis=-1, keepdims=True)
    var = jnp.mean(jnp.square(out - mean), axis=-1, keepdims=True)
    out = ((out - mean) * lax.rsqrt(var + GN_EPS)).reshape(B, S, RW_WIDTH) * ln_w + ln_b
    bonus = jnp.sum(r_h * k_h * r_k, axis=-1, keepdims=True) * v_h
    out = (out + bonus.reshape(B, S, RW_WIDTH)) * g
    return out.astype(u_rw.dtype)


def sb_group(u_sb, sb_out_g):
    B, S, _ = u_sb.shape
    heads = lambda t: t.reshape(B, S, SB_HEADS, SB_HEAD_DIM).transpose(0, 2, 1, 3)
    q = heads(u_sb[..., :SB_WIDTH])
    k = heads(u_sb[..., SB_WIDTH:2 * SB_WIDTH])
    v = heads(u_sb[..., 2 * SB_WIDTH:])
    o = stick_breaking_attention(q, k, v).transpose(0, 2, 1, 3)
    o = o * lax.rsqrt(jnp.mean(o * o, axis=-1, keepdims=True) + RMS_EPS)
    return (o.reshape(B, S, SB_WIDTH) * sb_out_g).astype(u_sb.dtype)


def hier_moe(x2d, w_grp, b_grp, w_exp, b_exp, w_gate, w_up, w_down):
    T = x2d.shape[0]
    xf = x2d.astype(jnp.float32)
    grp_prob = jax.nn.softmax(xf @ w_grp.astype(jnp.float32) + b_grp.astype(jnp.float32), axis=-1)
    g_val, g_idx = lax.top_k(grp_prob, 1)
    exp_logits = (xf @ w_exp.astype(jnp.float32) + b_exp.astype(jnp.float32)).reshape(T, N_GROUPS, EXPERTS_PER_GROUP)
    sel = jnp.take_along_axis(exp_logits, g_idx[:, :, None], axis=1)[:, 0]
    e_val, e_idx = lax.top_k(jax.nn.softmax(sel, axis=-1), TOP_K_IN_GROUP)
    weights = g_val * e_val / jnp.sum(e_val, axis=-1, keepdims=True)
    global_idx = g_idx * EXPERTS_PER_GROUP + e_idx
    combine = jnp.sum(jax.nn.one_hot(global_idx, N_EXPERTS, dtype=jnp.float32) * weights[..., None], axis=1)
    combine = combine.astype(x2d.dtype)
    y = jnp.zeros_like(x2d)
    for e in range(N_EXPERTS):
        h = jax.nn.silu(x2d @ w_gate[e]) * (x2d @ w_up[e])
        y = y + combine[:, e:e + 1] * (h @ w_down[e])
    return y


def setup_inputs(seed: int = 0) -> dict:
    key = jax.random.key(seed)
    ks = jax.random.split(key, 28)
    f32 = jnp.float32
    nrm = lambda k, shape, s: jax.random.normal(k, shape, f32) * s
    L = DEPTH
    return {
        "x": jax.random.normal(ks[0], (BATCH, SEQ, D_MODEL), f32),
        "norm_mix_g": 1.0 + nrm(ks[1], (L, D_MODEL), 0.02),
        "w_in": nrm(ks[2], (L, D_MODEL, N_IN), D_MODEL ** -0.5),
        "shift_mu": jax.random.uniform(ks[3], (L, RW_IN), f32, 0.1, 0.9),
        "sb_out_g": 1.0 + nrm(ks[4], (L, SB_WIDTH), 0.02),
        "rw_w0": jax.random.uniform(ks[5], (L, RW_WIDTH), f32, -6.5, -1.5),
        "rw_w2": nrm(ks[6], (L, LORA_W, RW_WIDTH), 0.5 * LORA_W ** -0.5),
        "rw_a0": nrm(ks[7], (L, RW_WIDTH), 0.1),
        "rw_a2": nrm(ks[8], (L, LORA_A, RW_WIDTH), LORA_A ** -0.5),
        "rw_g2": nrm(ks[9], (L, LORA_G, RW_WIDTH), LORA_G ** -0.5),
        "rw_k_k": 0.85 + nrm(ks[10], (L, RW_WIDTH), 0.02),
        "rw_k_a": 1.0 + nrm(ks[11], (L, RW_WIDTH), 0.02),
        "rw_r_k": nrm(ks[12], (L, RW_HEADS, RW_HEAD_DIM), 0.1),
        "rw_ln_w": 1.0 + nrm(ks[13], (L, RW_WIDTH), 0.02),
        "rw_ln_b": nrm(ks[14], (L, RW_WIDTH), 0.02),
        "w_out": nrm(ks[15], (L, D_MIX, D_MODEL), D_MIX ** -0.5),
        "norm_ffn_g": 1.0 + nrm(ks[16], (L, D_MODEL), 0.02),
        "router_grp_w": nrm(ks[17], (L, D_MODEL, N_GROUPS), D_MODEL ** -0.5),
        "router_grp_b": nrm(ks[18], (L, N_GROUPS), 0.01),
        "router_exp_w": nrm(ks[19], (L, D_MODEL, N_EXPERTS), D_MODEL ** -0.5),
        "router_exp_b": nrm(ks[20], (L, N_EXPERTS), 0.01),
        "exp_w_gate": nrm(ks[21], (L, N_EXPERTS, D_MODEL, D_EXPERT), D_MODEL ** -0.5),
        "exp_w_up": nrm(ks[22], (L, N_EXPERTS, D_MODEL, D_EXPERT), D_MODEL ** -0.5),
        "exp_w_down": nrm(ks[23], (L, N_EXPERTS, D_EXPERT, D_MODEL), D_EXPERT ** -0.5),
        "final_norm_g": 1.0 + nrm(ks[24], (D_MODEL,), 0.02),
    }


def reference(x, norm_mix_g, w_in, shift_mu, sb_out_g, rw_w0, rw_w2, rw_a0, rw_a2, rw_g2,
              rw_k_k, rw_k_a, rw_r_k, rw_ln_w, rw_ln_b, w_out, norm_ffn_g,
              router_grp_w, router_grp_b, router_exp_w, router_exp_b,
              exp_w_gate, exp_w_up, exp_w_down, final_norm_g):
    B, S, D = x.shape
    h = x
    for l in range(DEPTH):
        u = rmsnorm(h, norm_mix_g[l]) @ w_in[l]
        o_sb = sb_group(u[..., :SB_IN], sb_out_g[l])
        o_rw = rwkv7_group(u[..., SB_IN:], shift_mu[l], rw_w0[l], rw_w2[l], rw_a0[l], rw_a2[l],
                           rw_g2[l], rw_k_k[l], rw_k_a[l], rw_r_k[l], rw_ln_w[l], rw_ln_b[l])
        h = h + jnp.concatenate([o_sb, o_rw], axis=-1) @ w_out[l]
        xn = rmsnorm(h, norm_ffn_g[l]).reshape(B * S, D)
        y = hier_moe(xn, router_grp_w[l], router_grp_b[l], router_exp_w[l], router_exp_b[l],
                     exp_w_gate[l], exp_w_up[l], exp_w_down[l])
        h = h + y.reshape(B, S, D)
    return rmsnorm(h, final_norm_g)
```

```cpp
#include <hip/hip_runtime.h>
#include <hip/hip_cooperative_groups.h>
#include <cstdio>
#include <cstdint>
namespace cg = cooperative_groups;

#define LAS __attribute__((address_space(3)))
typedef unsigned short bf16_t;
typedef short bf16x8 __attribute__((ext_vector_type(8)));
typedef short s16x4 __attribute__((ext_vector_type(4)));
typedef float f32x4 __attribute__((ext_vector_type(4)));
typedef float f32x2 __attribute__((ext_vector_type(2)));
typedef float f32x16 __attribute__((ext_vector_type(16)));
typedef unsigned u32x2 __attribute__((ext_vector_type(2)));
typedef unsigned u32x4 __attribute__((ext_vector_type(4)));

constexpr int NB = 16, S = 2048, T = NB * S, D = 1024, NIN = 3328, NH = 8, HD = 64;
constexpr int UQ = 0, UK = 512, UV = 1024, UR = 1536, URK = 2048, URV = 2560, UXW = 3072, UXA = 3136, UXG = 3200;
constexpr int NE = 32, DE = 256;
constexpr float LOG2E = 1.4426950408889634f, LN2 = 0.6931471805599453f;
constexpr float QSCALE = 0.125f * LOG2E;
constexpr int NTHREADS = 512, NWAVES = 8;
constexpr int LDS_BYTES = 131072 + 1024;

constexpr size_t WS_CTL   = 0;
constexpr size_t WS_WIN   = 65536;
constexpr size_t WS_WOUT  = WS_WIN  + (size_t)NIN * D * 2;
constexpr size_t WS_WGU   = WS_WOUT + (size_t)D * D * 2;
constexpr size_t WS_WDN   = WS_WGU  + (size_t)NE * 512 * D * 2;
constexpr size_t WS_RSTD1 = WS_WDN  + (size_t)NE * D * DE * 2;
constexpr size_t WS_RSTD2 = WS_RSTD1 + (size_t)T * 4;
constexpr size_t WS_LIST  = WS_RSTD2 + (size_t)T * 4;
constexpr size_t WS_LISTW = WS_LIST + (size_t)NE * T * 4;
constexpr size_t WS_WR    = WS_LISTW + (size_t)NE * T * 4;
constexpr size_t WS_A     = WS_WR + (size_t)2 * 48 * D * 2;
constexpr size_t WS_B     = WS_A + (size_t)T * NIN * 2;
constexpr size_t WS_END   = WS_B + (size_t)T * D * 2;
constexpr int HID_ROWS = 2 * T + NE * 256;

struct Params {
    const float* x; const float* norm_mix_g; const float* w_in; const float* shift_mu; const float* sb_out_g;
    const float* rw_w0; const float* rw_w2; const float* rw_a0; const float* rw_a2; const float* rw_g2;
    const float* rw_k_k; const float* rw_k_a; const float* rw_r_k; const float* rw_ln_w; const float* rw_ln_b;
    const float* w_out; const float* norm_ffn_g; const float* r_grp_w; const float* r_grp_b; const float* r_exp_w; const float* r_exp_b;
    const float* w_gate; const float* w_up; const float* w_down; const float* final_g;
    float* out; unsigned char* ws;
};

__device__ __forceinline__ unsigned cvt_pk_bf16(float lo, float hi) { unsigned r; asm volatile("v_cvt_pk_bf16_f32 %0, %1, %2" : "=v"(r) : "v"(lo), "v"(hi)); return r; }
__device__ __forceinline__ float bf16_lo(unsigned w) { return __uint_as_float(w << 16); }
__device__ __forceinline__ float bf16_hi(unsigned w) { return __uint_as_float(w & 0xffff0000u); }
__device__ __forceinline__ float fexp2(float x) { return __builtin_amdgcn_exp2f(x); }
__device__ __forceinline__ float flog2(float x) { return __builtin_amdgcn_logf(x); }
__device__ __forceinline__ float frcp(float x) { return __builtin_amdgcn_rcpf(x); }
__device__ __forceinline__ float frsq(float x) { return __builtin_amdgcn_rsqf(x); }
template <int CTRL> __device__ __forceinline__ float dppf(float v) { return __builtin_bit_cast(float, __builtin_amdgcn_update_dpp(0, __builtin_bit_cast(int, v), CTRL, 0xF, 0xF, true)); }
__device__ __forceinline__ float rlane(float v, int l) { return __builtin_bit_cast(float, __builtin_amdgcn_readlane(__builtin_bit_cast(int, v), l)); }
__device__ __forceinline__ float sum8(float v) { v += dppf<0xB1>(v); v += dppf<0x4E>(v); v += dppf<0x141>(v); return v; }
__device__ __forceinline__ float sum16(float v) { v = sum8(v); v += dppf<0x140>(v); return v; }
__device__ __forceinline__ float wave_sum(float v) { v = sum16(v); return (rlane(v, 0) + rlane(v, 16)) + (rlane(v, 32) + rlane(v, 48)); }
__device__ __forceinline__ float swap32(float v) { return __shfl_xor(v, 32); }
#define LDS_WAIT() asm volatile("s_waitcnt lgkmcnt(0)" ::: "memory")

namespace g8 {
constexpr int BK = 64, HALF = 128, HTB = HALF * BK * 2;
__device__ __forceinline__ int lds_byte(int r, int c) { const int st = (r >> 4) * 2 + (c >> 5), rr = r & 15, cc = c & 31, ob = rr * 64 + cc * 2; return st * 1024 + (ob ^ (((ob >> 9) & 1) << 5)); }
__device__ __forceinline__ void stage_rc(int b, int& R, int& C) { const int st = b / 1024, sb = b % 1024, swz = sb ^ (((sb >> 9) & 1) << 5); R = (st >> 1) * 16 + swz / 64; C = (st & 1) * 32 + (swz % 64) / 2; }

#define G8_SA(b, h) (((b) * 2 + (h)) * HTB)
#define G8_SB(b, h) ((4 + (b) * 2 + (h)) * HTB)
#define G8_STAGE_A(bufoff, h, kt) do { _Pragma("unroll") for (int _i = 0; _i < 2; ++_i) \
    __builtin_amdgcn_global_load_lds((const unsigned*)((Ab + (size_t)(kt) * (BK * 2)) + aoff[h][_i]), (LAS unsigned*)(lds + (bufoff) + ldsw + _i * 8192), 16, 0, 0); } while (0)
#define G8_STAGE_B(bufoff, h, kt) do { _Pragma("unroll") for (int _i = 0; _i < 2; ++_i) \
    __builtin_amdgcn_global_load_lds((const unsigned*)((Bb + (size_t)(h) * bhalf + (size_t)(kt) * (BK * 2)) + boff[_i]), (LAS unsigned*)(lds + (bufoff) + ldsw + _i * 8192), 16, 0, 0); } while (0)
#define G8_LDA(dst, b, h) do { _Pragma("unroll") for (int m = 0; m < 4; ++m) _Pragma("unroll") for (int k = 0; k < 2; ++k) dst[m][k] = *(const LAS bf16x8*)(lds + G8_SA(b, h) + la_off + m * 2048 + k * 1024); } while (0)
#define G8_LDB(dst, b, h) do { _Pragma("unroll") for (int n = 0; n < 2; ++n) _Pragma("unroll") for (int k = 0; k < 2; ++k) dst[n][k] = *(const LAS bf16x8*)(lds + G8_SB(b, h) + lb_off + n * 2048 + k * 1024); } while (0)
#define G8_MMA(ai, bj, At, Bt) do { __builtin_amdgcn_s_setprio(1); _Pragma("unroll") for (int m = 0; m < 4; ++m) _Pragma("unroll") for (int n = 0; n < 2; ++n) _Pragma("unroll") for (int k = 0; k < 2; ++k) \
    acc[ai][bj][m][n] = __builtin_amdgcn_mfma_f32_16x16x32_bf16(Bt[n][k], At[m][k], acc[ai][bj][m][n], 0, 0, 0); __builtin_amdgcn_s_setprio(0); } while (0)
#define G8_WAIT_V(n) asm volatile("s_waitcnt vmcnt(" #n ")" ::: "memory")
#define G8_WAIT_L(n) asm volatile("s_waitcnt lgkmcnt(" #n ")" ::: "memory")
#define G8_BAR __builtin_amdgcn_s_barrier()
#define G8_SCHED __builtin_amdgcn_sched_barrier(0)

template <class Epi>
__device__ __forceinline__ void gemm_unit(LAS unsigned char* lds, const char* Ab, const unsigned (&aoff)[2][2], const char* Bb, int K, const Epi& E) {
    const int tid = threadIdx.x, wid = __builtin_amdgcn_readfirstlane(tid >> 6), lane = tid & 63, wr = wid >> 2, wc = wid & 3, fr = lane & 15, fq = lane >> 4;
    const int nt = K / BK;
    unsigned boff[2];
#pragma unroll
    for (int i = 0; i < 2; ++i) { int R, C; stage_rc(tid * 16 + i * 8192, R, C); boff[i] = (unsigned)(R * K + C) * 2u; }
    const size_t bhalf = (size_t)HALF * K * 2;
    const unsigned ldsw = (unsigned)wid * 1024u;
    const int la_off = lds_byte(wr * 64 + fr, fq * 8), lb_off = lds_byte(wc * 32 + fr, fq * 8);
    f32x4 acc[2][2][4][2];
#pragma unroll
    for (int a = 0; a < 2; ++a)
#pragma unroll
        for (int b = 0; b < 2; ++b)
#pragma unroll
            for (int m = 0; m < 4; ++m)
#pragma unroll
                for (int n = 0; n < 2; ++n) acc[a][b][m][n] = (f32x4){0.f, 0.f, 0.f, 0.f};
    bf16x8 At[4][2], B0[2][2], B1[2][2];
    G8_STAGE_B(G8_SB(0, 0), 0, 0); G8_STAGE_A(G8_SA(0, 0), 0, 0);
    G8_STAGE_B(G8_SB(0, 1), 1, 0); G8_STAGE_A(G8_SA(0, 1), 1, 0);
    if (wr == 1) G8_BAR;
    G8_WAIT_V(4); G8_BAR;
    G8_STAGE_B(G8_SB(1, 0), 0, 1); G8_STAGE_A(G8_SA(1, 0), 0, 1); G8_STAGE_B(G8_SB(1, 1), 1, 1);
    G8_WAIT_V(6); G8_BAR;
    for (int t = 0; t < nt - 2; t += 2) {
        G8_LDB(B0, 0, 0); G8_SCHED; G8_LDA(At, 0, 0); G8_STAGE_A(G8_SA(1, 1), 1, t + 1);
        G8_WAIT_L(8); G8_BAR; G8_WAIT_L(0); G8_MMA(0, 0, At, B0); G8_BAR; G8_SCHED;
        G8_LDB(B1, 0, 1); G8_STAGE_B(G8_SB(0, 0), 0, t + 2);
        G8_BAR; G8_WAIT_L(0); G8_MMA(0, 1, At, B1); G8_BAR;
        G8_LDA(At, 0, 1); G8_STAGE_A(G8_SA(0, 0), 0, t + 2);
        G8_BAR; G8_WAIT_L(0); G8_MMA(1, 0, At, B0); G8_BAR; G8_SCHED;
        G8_STAGE_B(G8_SB(0, 1), 1, t + 2);
        G8_WAIT_V(6); G8_BAR; G8_MMA(1, 1, At, B1); G8_BAR;
        G8_LDB(B0, 1, 0); G8_SCHED; G8_LDA(At, 1, 0); G8_STAGE_A(G8_SA(0, 1), 1, t + 2);
        G8_WAIT_L(8); G8_BAR; G8_WAIT_L(0); G8_MMA(0, 0, At, B0); G8_BAR; G8_SCHED;
        G8_LDB(B1, 1, 1); G8_STAGE_B(G8_SB(1, 0), 0, t + 3);
        G8_BAR; G8_WAIT_L(0); G8_MMA(0, 1, At, B1); G8_BAR;
        G8_LDA(At, 1, 1); G8_STAGE_A(G8_SA(1, 0), 0, t + 3);
        G8_BAR; G8_WAIT_L(0); G8_MMA(1, 0, At, B0); G8_BAR; G8_SCHED;
        G8_STAGE_B(G8_SB(1, 1), 1, t + 3);
        G8_WAIT_V(6); G8_BAR; G8_MMA(1, 1, At, B1); G8_BAR;
    }
    { G8_LDB(B0, 0, 0); G8_LDA(At, 0, 0); G8_STAGE_A(G8_SA(1, 1), 1, nt - 1);
      G8_BAR; G8_WAIT_L(0); G8_MMA(0, 0, At, B0); G8_BAR;
      G8_LDB(B1, 0, 1); G8_BAR; G8_WAIT_L(0); G8_MMA(0, 1, At, B1); G8_BAR;
      G8_LDA(At, 0, 1); G8_WAIT_V(4); G8_BAR; G8_WAIT_L(0); G8_MMA(1, 0, At, B0); G8_MMA(1, 1, At, B1); G8_BAR; }
    { G8_LDB(B0, 1, 0); G8_LDA(At, 1, 0); G8_WAIT_V(2); G8_BAR; G8_WAIT_L(0); G8_MMA(0, 0, At, B0); G8_BAR;
      G8_LDB(B1, 1, 1); G8_WAIT_V(0); G8_BAR; G8_WAIT_L(0); G8_MMA(0, 1, At, B1); G8_BAR;
      G8_LDA(At, 1, 1); G8_BAR; G8_WAIT_L(0); G8_MMA(1, 0, At, B0); G8_MMA(1, 1, At, B1); G8_BAR; }
    if (wr == 0) G8_BAR;
    asm volatile("" ::: "memory");
    E(acc, wr, wc, fr, fq);
    __syncthreads();
}
__device__ __forceinline__ void aoff_rows(unsigned (&aoff)[2][2], int K) {
    const int tid = threadIdx.x;
#pragma unroll
    for (int i = 0; i < 2; ++i) { int R, C; stage_rc(tid * 16 + i * 8192, R, C);
#pragma unroll
        for (int h = 0; h < 2; ++h) aoff[h][i] = (unsigned)((h * HALF + R) * K + C) * 2u; }
}
__device__ __forceinline__ void tile_order(int L, int nM, int nN, int& pm, int& pn) {
    const int nwg = nM * nN; int wgid = L;
    { const int q = nwg / 8, r = nwg % 8, xcd = wgid % 8, off = wgid / 8; wgid = (xcd < r ? xcd * (q + 1) : r * (q + 1) + (xcd - r) * q) + off; }
    const int nig = 8 * nN, gid = wgid / nig, fm = gid * 8, gsz = (nM - fm) < 8 ? (nM - fm) : 8;
    pm = fm + ((wgid % nig) % gsz); pn = (wgid % nig) / gsz;
}
}

__device__ __forceinline__ void p0_transpose_item(const float* W, int K, int N, int k0, int n0, bf16_t* WTrow0  , const float* kscale, float mul, LAS float* scr, int lane) {
#pragma unroll 8
    for (int i = 0; i < 32; ++i) { const int kk = 2 * i + (lane >> 5); float v = W[(size_t)(k0 + kk) * N + n0 + (lane & 31)]; if (kscale) v *= kscale[k0 + kk]; scr[kk * 33 + (lane & 31)] = v * mul; }
    LDS_WAIT();
    const int c = lane & 7;
#pragma unroll
    for (int j = 0; j < 4; ++j) { const int n = (lane >> 3) + 8 * j; const LAS float* s = scr + (8 * c) * 33 + n;
        u32x4 o; o.x = cvt_pk_bf16(s[0 * 33], s[1 * 33]); o.y = cvt_pk_bf16(s[2 * 33], s[3 * 33]); o.z = cvt_pk_bf16(s[4 * 33], s[5 * 33]); o.w = cvt_pk_bf16(s[6 * 33], s[7 * 33]);
        *(u32x4*)(WTrow0 + (size_t)n * K + k0 + 8 * c) = o; }
    LDS_WAIT();
}

__device__ __forceinline__ void phase0(const Params& p, LAS unsigned char* lds) {
    const int tid = threadIdx.x, wave = tid >> 6, lane = tid & 63;
    const int gw = blockIdx.x * NWAVES + wave, NGW = gridDim.x * NWAVES;
    LAS float* scr = (LAS float*)(lds + wave * 8704);
    bf16_t* win = (bf16_t*)(p.ws + WS_WIN); bf16_t* wout = (bf16_t*)(p.ws + WS_WOUT); bf16_t* wgu = (bf16_t*)(p.ws + WS_WGU); bf16_t* wdn = (bf16_t*)(p.ws + WS_WDN);
    constexpr int I_IN = 16 * 104, I_OUT = 16 * 32, I_G = NE * 16 * 8, I_D = NE * 4 * 32;
    constexpr int NITEMS = I_IN + I_OUT + 2 * I_G + I_D;
    for (int it = gw; it < NITEMS; it += NGW) {
        int r = it;
        if (r < I_IN) { const int kb = r / 104, nb = r % 104, n0 = nb * 32; p0_transpose_item(p.w_in, D, NIN, kb * 64, n0, win + (size_t)n0 * D, p.norm_mix_g, n0 < 512 ? QSCALE : 1.f, scr, lane); continue; } r -= I_IN;
        if (r < I_OUT) { const int kb = r / 32, nb = r % 32, n0 = nb * 32; p0_transpose_item(p.w_out, D, D, kb * 64, n0, wout + (size_t)n0 * D, nullptr, 1.f, scr, lane); continue; } r -= I_OUT;
        if (r < 2 * I_G) { const int up = r >= I_G; if (up) r -= I_G; const int e = r / 128, q = r % 128, kb = q / 8, nb = q % 8, n0 = nb * 32;
            const int drow = (n0 >> 7) * 256 + up * 128 + (n0 & 127);
            p0_transpose_item((up ? p.w_up : p.w_gate) + (size_t)e * D * DE, D, DE, kb * 64, n0, wgu + ((size_t)e * 512 + drow) * D, p.norm_ffn_g, 1.f, scr, lane); continue; } r -= 2 * I_G;
        { const int e = r / 128, q = r % 128, kb = q / 32, nb = q % 32, n0 = nb * 32;
            p0_transpose_item(p.w_down + (size_t)e * DE * D, DE, D, kb * 64, n0, wdn + ((size_t)e * D + n0) * DE, nullptr, 1.f, scr, lane); }
    }
    bf16_t* xb = (bf16_t*)(p.ws + WS_B); float* rstd1 = (float*)(p.ws + WS_RSTD1);
    for (int row = gw; row < T; row += NGW) {
        const f32x4* xr = (const f32x4*)(p.x + (size_t)row * D) + lane; f32x4 v[4]; float s = 0.f;
#pragma unroll
        for (int j = 0; j < 4; ++j) { v[j] = xr[64 * j]; s += (v[j].x * v[j].x + v[j].y * v[j].y) + (v[j].z * v[j].z + v[j].w * v[j].w); }
        s = wave_sum(s);
        u32x2* o = (u32x2*)(xb + (size_t)row * D) + lane;
#pragma unroll
        for (int j = 0; j < 4; ++j) { u32x2 w; w.x = cvt_pk_bf16(v[j].x, v[j].y); w.y = cvt_pk_bf16(v[j].z, v[j].w); o[64 * j] = w; }
        if (lane == 0) rstd1[row] = 1.0f / sqrtf(s * (1.0f / D) + 1e-6f);
    }
    bf16_t* wr_hi = (bf16_t*)(p.ws + WS_WR); bf16_t* wr_lo = wr_hi + 48 * D;
    for (int i = blockIdx.x * NTHREADS + tid; i < 48 * D; i += gridDim.x * NTHREADS) {
        const int c = i / D, k = i % D; float w = 0.f;
        if (c < 4) w = p.r_grp_w[k * 4 + c]; else if (c < 36) w = p.r_exp_w[k * 32 + (c - 4)];
        w *= p.norm_ffn_g[k];
        const unsigned hi = cvt_pk_bf16(w, 0.f) & 0xffffu; const float rem = w - __uint_as_float(hi << 16);
        wr_hi[i] = (bf16_t)hi; wr_lo[i] = (bf16_t)(cvt_pk_bf16(rem, 0.f) & 0xffffu);
    }
    if (blockIdx.x == 0 && tid < 64) ((unsigned*)(p.ws + WS_CTL))[tid] = 0u;
}

struct EpiU {
    bf16_t* u; const float* rstd; int row0, col0;
    __device__ __forceinline__ void operator()(const f32x4 (&acc)[2][2][4][2], int wr, int wc, int fr, int fq) const {
#pragma unroll
        for (int ai = 0; ai < 2; ++ai)
#pragma unroll
            for (int m = 0; m < 4; ++m) { const int row = row0 + ai * 128 + wr * 64 + m * 16 + fr; const float rs = rstd[row]; bf16_t* rp = u + (size_t)row * NIN + col0 + wc * 32 + 4 * fq;
#pragma unroll
                for (int bj = 0; bj < 2; ++bj)
#pragma unroll
                    for (int n = 0; n < 2; ++n) { const f32x4 v = acc[ai][bj][m][n] * rs; u32x2 w; w.x = cvt_pk_bf16(v[0], v[1]); w.y = cvt_pk_bf16(v[2], v[3]); *(u32x2*)(rp + bj * 128 + n * 16) = w; } }
    }
};
__device__ __forceinline__ void phase1(const Params& p, LAS unsigned char* lds) {
    constexpr int nM = T / 256, nN = NIN / 256;
    unsigned aoff[2][2]; g8::aoff_rows(aoff, D);
    for (int L = blockIdx.x; L < nM * nN; L += gridDim.x) {
        int pm, pn; g8::tile_order(L, nM, nN, pm, pn);
        EpiU E{(bf16_t*)(p.ws + WS_A), (const float*)(p.ws + WS_RSTD1), pm * 256, pn * 256};
        g8::gemm_unit(lds, (const char*)(p.ws + WS_B) + (size_t)pm * 256 * D * 2, aoff, (const char*)(p.ws + WS_WIN) + (size_t)pn * 256 * D * 2, D, E);
    }
}


typedef short v4i16_t __attribute__((ext_vector_type(4)));
__device__ __forceinline__ s16x4 lds_tr16(const LAS unsigned char* p) { return __builtin_bit_cast(s16x4, __builtin_amdgcn_ds_read_tr16_b64_v4i16((LAS v4i16_t*)p)); }

__device__ __forceinline__ void attn_tile(const Params& p, LAS unsigned char* vl  , int b, int h, int qt) {
    const int lane = threadIdx.x & 63, r32 = lane & 31, hi = lane >> 5;
    const bf16_t* u = (const bf16_t*)(p.ws + WS_A);
    const size_t row0 = (size_t)b * S; const int q0 = qt * 32;
    bf16x8 qf[4];
    { const bf16_t* qp = u + (row0 + q0 + r32) * NIN + UQ + h * HD + 8 * hi;
#pragma unroll
      for (int s = 0; s < 4; ++s) qf[s] = *(const bf16x8*)(qp + 16 * s); }
    f32x16 o0, o1;
#pragma unroll
    for (int i = 0; i < 16; ++i) { o0[i] = 0.f; o1[i] = 0.f; }
    float carry = 0.f;
    const int kperm = 16 * ((r32 >> 2) & 1) + (r32 & 3) + 4 * (r32 >> 3);
    const int g = lane >> 4, i16 = lane & 15, tq = i16 >> 2, tp = i16 & 3;
    const LAS unsigned char* vrd = vl + (16 * (g >> 1) + tq) * 144 + (16 * (g & 1) + 4 * tp) * 2;
    LAS unsigned char* vwr = vl + (lane >> 1) * 144 + (lane & 1) * 64;
    for (int kb = qt; kb >= 0; --kb) {
        const int key0 = kb * 32;
        { const bf16_t* vp = u + (row0 + key0 + (lane >> 1)) * NIN + UV + h * HD + 32 * (lane & 1);
          u32x4 v0 = *(const u32x4*)(vp), v1 = *(const u32x4*)(vp + 8), v2 = *(const u32x4*)(vp + 16), v3 = *(const u32x4*)(vp + 24);
          *(LAS u32x4*)(vwr) = v0; *(LAS u32x4*)(vwr + 16) = v1; *(LAS u32x4*)(vwr + 32) = v2; *(LAS u32x4*)(vwr + 48) = v3; }
        f32x16 st;
#pragma unroll
        for (int i = 0; i < 16; ++i) st[i] = 0.f;
        { const bf16_t* kp = u + (row0 + key0 + kperm) * NIN + UK + h * HD + 8 * hi;
          bf16x8 kf[4];
#pragma unroll
          for (int s = 0; s < 4; ++s) kf[s] = *(const bf16x8*)(kp + 16 * s);
#pragma unroll
          for (int s = 0; s < 4; ++s) st = __builtin_amdgcn_mfma_f32_32x32x16_bf16(kf[s], qf[s], st, 0, 0, 0); }
        const bool diag = (kb == qt);
        float lw[16], suf[16];
        float run = 0.f;
#pragma unroll
        for (int reg = 15; reg >= 0; --reg) {
            const float z = st[reg];
            const float l = flog2(1.0f + fexp2(-fabsf(z)));
            const float sp = fmaxf(z, 0.f) + l;
            const bool valid = !diag || (16 * hi + reg < r32);
            lw[reg] = valid ? (z - sp) : -1.0e30f;
            suf[reg] = run;
            run += valid ? -sp : 0.f;
        }
        const float other = swap32(run);
        const float tot_hi = hi ? run : other, tot_lo = hi ? other : run;
        const float base = carry + (hi ? 0.f : tot_hi);
        carry += tot_lo + tot_hi;
        unsigned pk[8];
#pragma unroll
        for (int j = 0; j < 8; ++j) pk[j] = cvt_pk_bf16(fexp2(lw[2 * j] + suf[2 * j] + base), fexp2(lw[2 * j + 1] + suf[2 * j + 1] + base));
        LDS_WAIT();
#pragma unroll
        for (int s2 = 0; s2 < 2; ++s2) {
            bf16x8 pf = __builtin_bit_cast(bf16x8, (u32x4){pk[4 * s2], pk[4 * s2 + 1], pk[4 * s2 + 2], pk[4 * s2 + 3]});
#pragma unroll
            for (int dh = 0; dh < 2; ++dh) {
                const s16x4 a = lds_tr16(vrd + (8 * s2) * 144 + 64 * dh), c = lds_tr16(vrd + (8 * s2 + 4) * 144 + 64 * dh);
                bf16x8 vf; vf[0] = a[0]; vf[1] = a[1]; vf[2] = a[2]; vf[3] = a[3]; vf[4] = c[0]; vf[5] = c[1]; vf[6] = c[2]; vf[7] = c[3];
                if (dh == 0) o0 = __builtin_amdgcn_mfma_f32_32x32x16_bf16(vf, pf, o0, 0, 0, 0); else o1 = __builtin_amdgcn_mfma_f32_32x32x16_bf16(vf, pf, o1, 0, 0, 0);
            }
        }
        LDS_WAIT();
        if (__builtin_amdgcn_ballot_w64(carry > -150.0f) == 0ull) break;
    }
    float ss = 0.f;
#pragma unroll
    for (int i = 0; i < 16; ++i) ss += o0[i] * o0[i] + o1[i] * o1[i];
    ss += swap32(ss);
    const float rs = 1.0f / sqrtf(ss * (1.0f / HD) + 1e-6f);
    bf16_t* op = (bf16_t*)(p.ws + WS_B) + (row0 + q0 + r32) * D + h * HD + 4 * hi;
    const float* gp = p.sb_out_g + h * HD + 4 * hi;
#pragma unroll
    for (int dh = 0; dh < 2; ++dh)
#pragma unroll
        for (int gq = 0; gq < 4; ++gq) {
            const f32x4 gg = *(const f32x4*)(gp + 32 * dh + 8 * gq);
            const f32x16& o = dh ? o1 : o0;
            u32x2 w; w.x = cvt_pk_bf16(o[4 * gq] * rs * gg[0], o[4 * gq + 1] * rs * gg[1]); w.y = cvt_pk_bf16(o[4 * gq + 2] * rs * gg[2], o[4 * gq + 3] * rs * gg[3]);
            *(u32x2*)(op + 32 * dh + 8 * gq) = w;
        }
}

namespace rw {
constexpr int CH = 16;
constexpr int O_UM = 0;
constexpr int O_LW = O_UM + CH * 448 * 4;
constexpr int O_LA = O_LW + CH * 64 * 4;
constexpr int O_LG0 = O_LA + CH * 64 * 4;
constexpr int O_LG1 = O_LG0 + CH * 64 * 4;
constexpr int O_A1 = O_LG1 + CH * 64 * 4;
constexpr int O_R1 = O_A1 + CH * 64 * 4;
constexpr int O_B1 = O_R1 + CH * 64 * 4;
constexpr int O_K1 = O_B1 + CH * 64 * 4;
constexpr int O_O = O_K1 + CH * 64 * 4;
constexpr int O_WT = O_O + CH * 64 * 4;
constexpr int O_GC = O_WT + 8 * 64 * 4;
constexpr int O_SC = O_GC + 64 * 4;
constexpr int O_END = O_SC + 3 * 16 * 4;
}
__device__ __forceinline__ bf16x8 ldw_frag(const float* W, int ldw, int m0, int col) {
    unsigned w[4];
#pragma unroll
    for (int j = 0; j < 4; ++j) w[j] = cvt_pk_bf16(W[(size_t)(m0 + 2 * j) * ldw + col], W[(size_t)(m0 + 2 * j + 1) * ldw + col]);
    return __builtin_bit_cast(bf16x8, (u32x4){w[0], w[1], w[2], w[3]});
}
template <int ACT>
__device__ __forceinline__ bf16x8 act_frag(const LAS float* src) {
    const f32x4 a = *(const LAS f32x4*)src, b = *(const LAS f32x4*)(src + 4); float v[8] = {a[0], a[1], a[2], a[3], b[0], b[1], b[2], b[3]};
#pragma unroll
    for (int j = 0; j < 8; ++j) {
        if (ACT == 1) v[j] = 1.0f - 2.0f * frcp(1.0f + fexp2(v[j] * (2.0f * LOG2E)));
        if (ACT == 2) v[j] = frcp(1.0f + fexp2(-v[j] * LOG2E));
    }
    return __builtin_bit_cast(bf16x8, (u32x4){cvt_pk_bf16(v[0], v[1]), cvt_pk_bf16(v[2], v[3]), cvt_pk_bf16(v[4], v[5]), cvt_pk_bf16(v[6], v[7])});
}

__device__ __forceinline__ void rwkv_chain(const Params& p, LAS unsigned char* lds, int b, int h) {
    using namespace rw;
    const int tid = threadIdx.x, wave = __builtin_amdgcn_readfirstlane(tid >> 6), lane = tid & 63;
    const bf16_t* u = (const bf16_t*)(p.ws + WS_A);
    bf16_t* mix = (bf16_t*)(p.ws + WS_B);
    const size_t row0 = (size_t)b * S;
    LAS float* UM = (LAS float*)(lds + O_UM); LAS float* LW = (LAS float*)(lds + O_LW); LAS float* LA = (LAS float*)(lds + O_LA);
    LAS float* LG0 = (LAS float*)(lds + O_LG0); LAS float* LG1 = (LAS float*)(lds + O_LG1);
    LAS float* A1 = (LAS float*)(lds + O_A1); LAS float* R1 = (LAS float*)(lds + O_R1); LAS float* B1 = (LAS float*)(lds + O_B1); LAS float* K1 = (LAS float*)(lds + O_K1);
    LAS float* OO = (LAS float*)(lds + O_O); LAS float* WT = (LAS float*)(lds + O_WT); LAS float* GC = (LAS float*)(lds + O_GC); LAS float* SC = (LAS float*)(lds + O_SC);
    const int fc = lane & 15, fq = lane >> 4;
    bf16x8 bwa[2], bg[2];
    { const float* W = wave < 4 ? p.rw_w2 : p.rw_a2; const int col = h * HD + 16 * (wave & 3) + fc;
      bwa[0] = ldw_frag(W, 512, 8 * fq, col); bwa[1] = ldw_frag(W, 512, 32 + 8 * fq, col);
      const int ks = (wave >> 2) * 2; bg[0] = ldw_frag(p.rw_g2, 512, 32 * ks + 8 * fq, col); bg[1] = ldw_frag(p.rw_g2, 512, 32 * (ks + 1) + 8 * fq, col); }
    const int hj = h * HD + lane;
    const float c_w0 = p.rw_w0[hj], c_a0 = p.rw_a0[hj], c_kk = p.rw_k_k[hj], c_ka = p.rw_k_a[hj], c_rk = p.rw_r_k[hj], c_lnw = p.rw_ln_w[hj], c_lnb = p.rw_ln_b[hj];
    int ld_t[2], ld_c[2], ld_uc[2]; bool ld_ok[2];
#pragma unroll
    for (int r = 0; r < 2; ++r) { const int gid = tid + 512 * r; ld_ok[r] = gid < CH * 56; const int t = gid / 56, cg8 = gid % 56; ld_t[r] = t; ld_c[r] = cg8 * 8;
        ld_uc[r] = cg8 < 8 ? UR + h * HD + 8 * cg8 : cg8 < 16 ? URK + h * HD + 8 * (cg8 - 8) : cg8 < 24 ? URV + h * HD + 8 * (cg8 - 16) : UXW + 8 * (cg8 - 24); }
    const int si = 8 * wave + (lane >> 3), sj = 8 * (lane & 7);
    float st[8];
#pragma unroll
    for (int n = 0; n < 8; ++n) st[n] = 0.f;
    u32x4 cur[2], prv[2];
    auto issue_loads = [&](int t0) {
#pragma unroll
        for (int r = 0; r < 2; ++r) { cur[r] = (u32x4){0u, 0u, 0u, 0u}; prv[r] = (u32x4){0u, 0u, 0u, 0u};
            if (ld_ok[r]) { const int tt = t0 + ld_t[r]; const bf16_t* a = u + (row0 + tt) * NIN + ld_uc[r]; cur[r] = *(const u32x4*)a; if (tt > 0) prv[r] = *(const u32x4*)(a - NIN); } }
    };
    issue_loads(0);
    for (int c = 0; c < S / CH; ++c) {
        const int t0 = c * CH;
#pragma unroll
        for (int r = 0; r < 2; ++r) if (ld_ok[r]) {
            const float* mu = p.shift_mu + (ld_uc[r] - UR); const f32x4 m0 = *(const f32x4*)mu, m1 = *(const f32x4*)(mu + 4);
            float cv[8], pv[8];
#pragma unroll
            for (int j = 0; j < 4; ++j) { cv[2 * j] = bf16_lo(cur[r][j]); cv[2 * j + 1] = bf16_hi(cur[r][j]); pv[2 * j] = bf16_lo(prv[r][j]); pv[2 * j + 1] = bf16_hi(prv[r][j]); }
            f32x4 o0, o1;
#pragma unroll
            for (int j = 0; j < 4; ++j) { o0[j] = cv[j] + (pv[j] - cv[j]) * m0[j]; o1[j] = cv[4 + j] + (pv[4 + j] - cv[4 + j]) * m1[j]; }
            LAS float* d = UM + ld_t[r] * 448 + ld_c[r]; *(LAS f32x4*)d = o0; *(LAS f32x4*)(d + 4) = o1;
        }
        if (c + 1 < S / CH) issue_loads(t0 + CH);
        __syncthreads();
        {
            f32x4 acc = (f32x4){0.f, 0.f, 0.f, 0.f};
            const LAS float* src = UM + fc * 448 + (wave < 4 ? 192 : 256) + 8 * fq;
            if (wave < 4) { acc = __builtin_amdgcn_mfma_f32_16x16x32_bf16(act_frag<1>(src), bwa[0], acc, 0, 0, 0); acc = __builtin_amdgcn_mfma_f32_16x16x32_bf16(act_frag<1>(src + 32), bwa[1], acc, 0, 0, 0); }
            else          { acc = __builtin_amdgcn_mfma_f32_16x16x32_bf16(act_frag<0>(src), bwa[0], acc, 0, 0, 0); acc = __builtin_amdgcn_mfma_f32_16x16x32_bf16(act_frag<0>(src + 32), bwa[1], acc, 0, 0, 0); }
            LAS float* dst = (wave < 4 ? LW : LA) + 16 * (wave & 3) + fc;
#pragma unroll
            for (int r = 0; r < 4; ++r) dst[(4 * fq + r) * 64] = acc[r];
            f32x4 ag = (f32x4){0.f, 0.f, 0.f, 0.f};
            const LAS float* sg = UM + fc * 448 + 320 + 64 * (wave >> 2) + 8 * fq;
            ag = __builtin_amdgcn_mfma_f32_16x16x32_bf16(act_frag<2>(sg), bg[0], ag, 0, 0, 0); ag = __builtin_amdgcn_mfma_f32_16x16x32_bf16(act_frag<2>(sg + 32), bg[1], ag, 0, 0, 0);
            LAS float* dg = (wave < 4 ? LG0 : LG1) + 16 * (wave & 3) + fc;
#pragma unroll
            for (int r = 0; r < 4; ++r) dg[(4 * fq + r) * 64] = ag[r];
        }
        __syncthreads();
        float e_kk[2], e_b[2], e_k[2], e_r[2], e_ld[2];
#pragma unroll
        for (int tt = 0; tt < 2; ++tt) {
            const int t = 2 * wave + tt;
            const float xw = c_w0 + LW[t * 64 + lane];
            const float spn = (fmaxf(-xw, 0.f) + LN2 * flog2(1.0f + fexp2(-fabsf(xw) * LOG2E)));
            e_ld[tt] = -fexp2((-spn - 0.5f) * LOG2E);
            const float a = frcp(1.0f + fexp2(-(c_a0 + LA[t * 64 + lane]) * LOG2E));
            const float kraw = UM[t * 448 + 64 + lane], r = UM[t * 448 + lane];
            const float kkv = kraw * c_kk; const float ssq = wave_sum(kkv * kkv);
            const float kk = kkv * frsq(fmaxf(ssq, 1e-24f));
            const float kmod = kraw * (1.0f + (a - 1.0f) * c_ka);
            const float bb = kk * a;
            const float cbr = wave_sum(bb * r), ckr = wave_sum(kmod * r), bon = wave_sum(r * kmod * c_rk);
            if (lane == 0) { SC[t] = cbr; SC[16 + t] = ckr; SC[32 + t] = bon; }
            e_kk[tt] = kk; e_b[tt] = bb; e_k[tt] = kmod; e_r[tt] = r;
        }
        WT[wave * 64 + lane] = e_ld[0] + e_ld[1];
        __syncthreads();
        {
            float off = 0.f, tot = 0.f;
#pragma unroll
            for (int w = 0; w < 8; ++w) { const float x = WT[w * 64 + lane]; if (w < wave) off += x; tot += x; }
            const float c0 = off + e_ld[0], c1 = c0 + e_ld[1];
            const int t = 2 * wave;
            A1[t * 64 + lane] = -e_kk[0] * fexp2(off * LOG2E);       A1[(t + 1) * 64 + lane] = -e_kk[1] * fexp2(c0 * LOG2E);
            R1[t * 64 + lane] = e_r[0] * fexp2(c0 * LOG2E);          R1[(t + 1) * 64 + lane] = e_r[1] * fexp2(c1 * LOG2E);
            const float i0 = fexp2(-c0 * LOG2E), i1 = fexp2(-c1 * LOG2E);
            B1[t * 64 + lane] = e_b[0] * i0;                          B1[(t + 1) * 64 + lane] = e_b[1] * i1;
            K1[t * 64 + lane] = e_k[0] * i0;                          K1[(t + 1) * 64 + lane] = e_k[1] * i1;
            if (wave == 0) GC[lane] = fexp2(tot * LOG2E);
        }
        __syncthreads();
#pragma unroll 4
        for (int t = 0; t < CH; ++t) {
            const f32x4 a0 = *(const LAS f32x4*)(A1 + t * 64 + sj), a1 = *(const LAS f32x4*)(A1 + t * 64 + sj + 4);
            const f32x4 r0 = *(const LAS f32x4*)(R1 + t * 64 + sj), r1 = *(const LAS f32x4*)(R1 + t * 64 + sj + 4);
            const f32x4 b0 = *(const LAS f32x4*)(B1 + t * 64 + sj), b1 = *(const LAS f32x4*)(B1 + t * 64 + sj + 4);
            const f32x4 k0 = *(const LAS f32x4*)(K1 + t * 64 + sj), k1 = *(const LAS f32x4*)(K1 + t * 64 + sj + 4);
            const float v = UM[t * 448 + 128 + si], cbr = SC[t], ckr = SC[16 + t];
            float sa = (st[0] * a0[0] + st[1] * a0[1]) + (st[2] * a0[2] + st[3] * a0[3]) + ((st[4] * a1[0] + st[5] * a1[1]) + (st[6] * a1[2] + st[7] * a1[3]));
            float pp = (st[0] * r0[0] + st[1] * r0[1]) + (st[2] * r0[2] + st[3] * r0[3]) + ((st[4] * r1[0] + st[5] * r1[1]) + (st[6] * r1[2] + st[7] * r1[3]));
            sa = sum8(sa); pp = sum8(pp);
            if ((lane & 7) == 0) OO[t * 64 + si] = pp + sa * cbr + v * ckr;
#pragma unroll
            for (int n = 0; n < 4; ++n) { st[n] += sa * b0[n] + v * k0[n]; st[4 + n] += sa * b1[n] + v * k1[n]; }
        }
        {
            const f32x4 g0 = *(const LAS f32x4*)(GC + sj), g1 = *(const LAS f32x4*)(GC + sj + 4);
#pragma unroll
            for (int n = 0; n < 4; ++n) { st[n] *= g0[n]; st[4 + n] *= g1[n]; }
        }
        __syncthreads();
#pragma unroll
        for (int tt = 0; tt < 2; ++tt) {
            const int t = 2 * wave + tt;
            const float o = OO[t * 64 + lane];
            const float mean = wave_sum(o) * (1.0f / 64.0f); const float dlt = o - mean;
            const float var = wave_sum(dlt * dlt) * (1.0f / 64.0f);
            const float gn = dlt * (1.0f / sqrtf(var + 64e-5f)) * c_lnw + c_lnb;
            const float res = (gn + SC[32 + t] * UM[t * 448 + 128 + lane]) * (LG0[t * 64 + lane] + LG1[t * 64 + lane]);
            mix[(row0 + t0 + t) * D + 512 + h * HD + lane] = (bf16_t)(cvt_pk_bf16(res, 0.f) & 0xffffu);
        }
        __syncthreads();
    }
}

__device__ __forceinline__ void phase2(const Params& p, LAS unsigned char* lds) {
    const int nchain = NB * NH, G = gridDim.x, wave = threadIdx.x >> 6;
    const int nscan = G >= 2 * nchain ? nchain : (G > 1 ? G / 2 : 0);
    if ((int)blockIdx.x < nscan || nscan == 0) {
        const int stride = nscan == 0 ? G : nscan;
        for (int it = blockIdx.x; it < nchain; it += stride) rwkv_chain(p, lds, it / NH, it % NH);
    }
    if ((int)blockIdx.x >= nscan) {
        const int nb = G - nscan, bi = blockIdx.x - nscan;
        for (int it = bi * 8 + wave; it < NB * NH * 64; it += nb * 8) attn_tile(p, lds + wave * 4608, it / (NH * 64), (it / 64) % NH, 63 - (it % 64));
    }
}

struct EpiH {
    const float* x; float* hout; int row0, col0;
    __device__ __forceinline__ void operator()(const f32x4 (&acc)[2][2][4][2], int wr, int wc, int fr, int fq) const {
#pragma unroll
        for (int ai = 0; ai < 2; ++ai)
#pragma unroll
            for (int m = 0; m < 4; ++m) { const size_t off = (size_t)(row0 + ai * 128 + wr * 64 + m * 16 + fr) * D + col0 + wc * 32 + 4 * fq;
#pragma unroll
                for (int bj = 0; bj < 2; ++bj)
#pragma unroll
                    for (int n = 0; n < 2; ++n) { const f32x4 xv = *(const f32x4*)(x + off + bj * 128 + n * 16); *(f32x4*)(hout + off + bj * 128 + n * 16) = xv + acc[ai][bj][m][n]; } }
    }
};
__device__ __forceinline__ void phase3(const Params& p, LAS unsigned char* lds) {
    constexpr int nM = T / 256, nN = D / 256;
    unsigned aoff[2][2]; g8::aoff_rows(aoff, D);
    for (int L = blockIdx.x; L < nM * nN; L += gridDim.x) {
        int pm, pn; g8::tile_order(L, nM, nN, pm, pn);
        EpiH E{p.x, p.out, pm * 256, pn * 256};
        g8::gemm_unit(lds, (const char*)(p.ws + WS_B) + (size_t)pm * 256 * D * 2, aoff, (const char*)(p.ws + WS_WOUT) + (size_t)pn * 256 * D * 2, D, E);
    }
}

__device__ __forceinline__ void phase4(const Params& p, LAS unsigned char* lds) {
    const int tid = threadIdx.x, wave = tid >> 6, lane = tid & 63, fr = lane & 15, fq = lane >> 4;
    const float* hsrc = p.out; bf16_t* hb = (bf16_t*)(p.ws + WS_A); float* rstd2 = (float*)(p.ws + WS_RSTD2);
    const bf16_t* wr_hi = (const bf16_t*)(p.ws + WS_WR); const bf16_t* wr_lo = wr_hi + 48 * D;
    int* list = (int*)(p.ws + WS_LIST); float* listw = (float*)(p.ws + WS_LISTW); unsigned* cnt = (unsigned*)(p.ws + WS_CTL);
    LAS float* lg = (LAS float*)(lds + wave * 3072);
    LAS unsigned* lcnt = (LAS unsigned*)(lds + 8 * 3072);
    LAS unsigned* gbase = lcnt + 32;
    for (int blk = blockIdx.x; blk < T / 128; blk += gridDim.x) {
        if (tid < 32) lcnt[tid] = 0u;
        __syncthreads();
        const int tok0 = blk * 128 + wave * 16;
        f32x4 acc[3];
#pragma unroll
        for (int n = 0; n < 3; ++n) acc[n] = (f32x4){0.f, 0.f, 0.f, 0.f};
        float ss = 0.f;
        const float* hp = hsrc + (size_t)(tok0 + fr) * D + 8 * fq; bf16_t* hbp = hb + (size_t)(tok0 + fr) * D + 8 * fq;
        const bf16_t* bh = wr_hi + (size_t)fr * D + 8 * fq; const bf16_t* bl = wr_lo + (size_t)fr * D + 8 * fq;
#pragma unroll 2
        for (int ks = 0; ks < D / 32; ++ks) {
            const f32x4 v0 = *(const f32x4*)(hp + 32 * ks), v1 = *(const f32x4*)(hp + 32 * ks + 4);
            ss += (v0[0] * v0[0] + v0[1] * v0[1]) + (v0[2] * v0[2] + v0[3] * v0[3]) + ((v1[0] * v1[0] + v1[1] * v1[1]) + (v1[2] * v1[2] + v1[3] * v1[3]));
            u32x4 hi; hi.x = cvt_pk_bf16(v0[0], v0[1]); hi.y = cvt_pk_bf16(v0[2], v0[3]); hi.z = cvt_pk_bf16(v1[0], v1[1]); hi.w = cvt_pk_bf16(v1[2], v1[3]);
            *(u32x4*)(hbp + 32 * ks) = hi;
            u32x4 lo; lo.x = cvt_pk_bf16(v0[0] - bf16_lo(hi.x), v0[1] - bf16_hi(hi.x)); lo.y = cvt_pk_bf16(v0[2] - bf16_lo(hi.y), v0[3] - bf16_hi(hi.y));
            lo.z = cvt_pk_bf16(v1[0] - bf16_lo(hi.z), v1[1] - bf16_hi(hi.z)); lo.w = cvt_pk_bf16(v1[2] - bf16_lo(hi.w), v1[3] - bf16_hi(hi.w));
            const bf16x8 ah = __builtin_bit_cast(bf16x8, hi), al = __builtin_bit_cast(bf16x8, lo);
#pragma unroll
            for (int n = 0; n < 3; ++n) {
                const bf16x8 wh = *(const bf16x8*)(bh + (size_t)n * 16 * D + 32 * ks), wl = *(const bf16x8*)(bl + (size_t)n * 16 * D + 32 * ks);
                acc[n] = __builtin_amdgcn_mfma_f32_16x16x32_bf16(ah, wh, acc[n], 0, 0, 0);
                acc[n] = __builtin_amdgcn_mfma_f32_16x16x32_bf16(al, wh, acc[n], 0, 0, 0);
                acc[n] = __builtin_amdgcn_mfma_f32_16x16x32_bf16(ah, wl, acc[n], 0, 0, 0);
            }
        }
        ss += __shfl_xor(ss, 16); ss += __shfl_xor(ss, 32);
        const float rs = 1.0f / sqrtf(ss * (1.0f / D) + 1e-6f);
        if (fq == 0) rstd2[tok0 + fr] = rs;
#pragma unroll
        for (int n = 0; n < 3; ++n)
#pragma unroll
            for (int r = 0; r < 4; ++r) lg[(4 * fq + r) * 48 + 16 * n + fr] = acc[n][r];
        LDS_WAIT();
        int e0 = 0, e1 = 0; float w0 = 0.f, w1 = 0.f; unsigned lp0 = 0, lp1 = 0;
        if (lane < 16) {
            const float rst = rs;
            const LAS float* L = lg + lane * 48;
            float gl[4]; int gi = 0; float gm;
#pragma unroll
            for (int g = 0; g < 4; ++g) gl[g] = L[g] * rst + p.r_grp_b[g];
            gm = gl[0];
#pragma unroll
            for (int g = 1; g < 4; ++g) if (gl[g] > gm) { gm = gl[g]; gi = g; }
            float gs = 0.f;
#pragma unroll
            for (int g = 0; g < 4; ++g) gs += __expf(gl[g] - gm);
            const float gval = 1.0f / gs;
            float el[8];
#pragma unroll
            for (int e = 0; e < 8; ++e) el[e] = L[4 + gi * 8 + e] * rst + p.r_exp_b[gi * 8 + e];
            int i0 = 0; float m0 = el[0];
#pragma unroll
            for (int e = 1; e < 8; ++e) if (el[e] > m0) { m0 = el[e]; i0 = e; }
            int i1 = -1; float m1 = -3.0e38f;
#pragma unroll
            for (int e = 0; e < 8; ++e) if (e != i0 && el[e] > m1) { m1 = el[e]; i1 = e; }
            const float x1 = __expf(m1 - m0); const float den = 1.0f / (1.0f + x1);
            e0 = gi * 8 + i0; e1 = gi * 8 + i1; w0 = gval * den; w1 = gval * x1 * den;
            lp0 = atomicAdd((unsigned*)&lcnt[e0], 1u); lp1 = atomicAdd((unsigned*)&lcnt[e1], 1u);
        }
        __syncthreads();
        if (tid < 32) gbase[tid] = atomicAdd(&cnt[tid], lcnt[tid]);
        __syncthreads();
        if (lane < 16) {
            const int tok = tok0 + lane;
            const unsigned q0 = gbase[e0] + lp0, q1 = gbase[e1] + lp1;
            list[(size_t)e0 * T + q0] = tok * 2;     listw[(size_t)e0 * T + q0] = w0;
            list[(size_t)e1 * T + q1] = tok * 2 + 1; listw[(size_t)e1 * T + q1] = w1;
        }
        __syncthreads();
    }
}

constexpr int LDS_MAP = 131072;
__device__ __forceinline__ void expert_map_build(const unsigned* cnt, LAS unsigned char* lds) {
    LAS int* pre = (LAS int*)(lds + LDS_MAP); LAS int* cn = pre + 40;
    if (threadIdx.x == 0) { int acc = 0; for (int i = 0; i < NE; ++i) { const int ci = (int)__hip_atomic_load(cnt + i, __ATOMIC_RELAXED, __HIP_MEMORY_SCOPE_AGENT); pre[i] = acc; cn[i] = ci; acc += (ci + 255) >> 8; } pre[NE] = acc; }
    __syncthreads();
}
__device__ __forceinline__ void expert_find(LAS unsigned char* lds, int mt, int& e, int& local, int& c) {
    const LAS int* pre = (const LAS int*)(lds + LDS_MAP); const LAS int* cn = pre + 40;
    int lo = 0;
#pragma unroll 1
    for (int i = 1; i < NE; ++i) if (pre[i] <= mt) lo = i;
    e = __builtin_amdgcn_readfirstlane(lo); local = mt - __builtin_amdgcn_readfirstlane(pre[e]); c = __builtin_amdgcn_readfirstlane(cn[e]);
}
__device__ __forceinline__ int expert_tiles(LAS unsigned char* lds) { return __builtin_amdgcn_readfirstlane(((const LAS int*)(lds + LDS_MAP))[NE]); }

struct EpiGU {
    bf16_t* hid; const float* rstd2; const int* lst; int cnt, p0, hrow0, ct;
    __device__ __forceinline__ void operator()(const f32x4 (&acc)[2][2][4][2], int wr, int wc, int fr, int fq) const {
#pragma unroll
        for (int ai = 0; ai < 2; ++ai)
#pragma unroll
            for (int m = 0; m < 4; ++m) { const int r = ai * 128 + wr * 64 + m * 16 + fr; const int pp = p0 + r;
                const float rs = pp < cnt ? rstd2[lst[pp] >> 1] : 0.f;
                bf16_t* op = hid + (size_t)(hrow0 + r) * DE + ct * 128 + wc * 32 + 4 * fq;
#pragma unroll
                for (int n = 0; n < 2; ++n) { const f32x4 g = acc[ai][0][m][n] * rs, uu = acc[ai][1][m][n] * rs; float o[4];
#pragma unroll
                    for (int j = 0; j < 4; ++j) o[j] = g[j] * frcp(1.0f + fexp2(-g[j] * LOG2E)) * uu[j];
                    u32x2 w; w.x = cvt_pk_bf16(o[0], o[1]); w.y = cvt_pk_bf16(o[2], o[3]); *(u32x2*)(op + n * 16) = w; } }
    }
};
__device__ __forceinline__ void phase5(const Params& p, LAS unsigned char* lds) {
    expert_map_build((const unsigned*)(p.ws + WS_CTL), lds);
    const int MT = expert_tiles(lds);
    const int tid = threadIdx.x;
    for (int unit = blockIdx.x; unit < MT * 2; unit += gridDim.x) {
        const int mt = unit >> 1, ct = unit & 1; int e, local, c; expert_find(lds, mt, e, local, c);
        const int* lst = (const int*)(p.ws + WS_LIST) + (size_t)e * T; const int p0 = local * 256;
        unsigned aoff[2][2];
#pragma unroll
        for (int i = 0; i < 2; ++i) { int R, C; g8::stage_rc(tid * 16 + i * 8192, R, C);
#pragma unroll
            for (int hh = 0; hh < 2; ++hh) { const int pp = p0 + hh * 128 + R; const int tok = pp < c ? (lst[pp] >> 1) : 0; aoff[hh][i] = (unsigned)(tok * D + C) * 2u; } }
        EpiGU E{(bf16_t*)(p.ws + WS_B), (const float*)(p.ws + WS_RSTD2), lst, c, p0, mt * 256, ct};
        g8::gemm_unit(lds, (const char*)(p.ws + WS_A), aoff, (const char*)(p.ws + WS_WGU) + ((size_t)e * 512 + ct * 256) * D * 2, D, E);
    }
}
struct EpiDN {
    bf16_t* y; bf16_t* dummy; const int* lst; const float* lw; int cnt, p0, col0;
    __device__ __forceinline__ void operator()(const f32x4 (&acc)[2][2][4][2], int wr, int wc, int fr, int fq) const {
#pragma unroll
        for (int ai = 0; ai < 2; ++ai)
#pragma unroll
            for (int m = 0; m < 4; ++m) { const int pp = p0 + ai * 128 + wr * 64 + m * 16 + fr;
                const bool ok = pp < cnt; const int ent = lst[pp]; const float w = lw[pp];
                bf16_t* op = (ok ? y + ((size_t)(ent & 1) * T + (ent >> 1)) * D : dummy) + col0 + wc * 32 + 4 * fq;
#pragma unroll
                for (int bj = 0; bj < 2; ++bj)
#pragma unroll
                    for (int n = 0; n < 2; ++n) { const f32x4 v = acc[ai][bj][m][n] * w; u32x2 o; o.x = cvt_pk_bf16(v[0], v[1]); o.y = cvt_pk_bf16(v[2], v[3]); *(u32x2*)(op + bj * 128 + n * 16) = o; }
                if (m & 1) asm volatile("" ::: "memory"); }
    }
};
__device__ __forceinline__ void phase6(const Params& p, LAS unsigned char* lds) {
    expert_map_build((const unsigned*)(p.ws + WS_CTL), lds);
    const int MT = expert_tiles(lds);
    constexpr int kdn = DE;
    unsigned aoff[2][2]; g8::aoff_rows(aoff, kdn);
    for (int unit = blockIdx.x; unit < MT * 4; unit += gridDim.x) {
        const int mt = unit >> 2, pn = unit & 3; int e, local, c; expert_find(lds, mt, e, local, c);
        EpiDN E{(bf16_t*)(p.ws + WS_A + (size_t)T * D * 2), (bf16_t*)(p.ws + WS_A + (size_t)3 * T * D * 2), (const int*)(p.ws + WS_LIST) + (size_t)e * T, (const float*)(p.ws + WS_LISTW) + (size_t)e * T, c, local * 256, pn * 256};
        g8::gemm_unit(lds, (const char*)(p.ws + WS_B) + (size_t)mt * 256 * DE * 2, aoff, (const char*)(p.ws + WS_WDN) + ((size_t)e * D + pn * 256) * DE * 2, kdn, E);
    }
}

__device__ __forceinline__ void phase7(const Params& p) {
    const int wave = threadIdx.x >> 6, lane = threadIdx.x & 63;
    const bf16_t* y0 = (const bf16_t*)(p.ws + WS_A + (size_t)T * D * 2); const bf16_t* y1 = y0 + (size_t)T * D;
    f32x4 g[4];
#pragma unroll
    for (int j = 0; j < 4; ++j) g[j] = *((const f32x4*)p.final_g + lane + 64 * j);
    for (int row = blockIdx.x * NWAVES + wave; row < T; row += gridDim.x * NWAVES) {
        f32x4* hr = (f32x4*)(p.out + (size_t)row * D) + lane; const u32x2* a = (const u32x2*)(y0 + (size_t)row * D) + lane; const u32x2* bq = (const u32x2*)(y1 + (size_t)row * D) + lane;
        f32x4 v[4]; float s = 0.f;
#pragma unroll
        for (int j = 0; j < 4; ++j) { v[j] = hr[64 * j]; const u32x2 ya = a[64 * j], yb = bq[64 * j];
            v[j][0] += bf16_lo(ya.x) + bf16_lo(yb.x); v[j][1] += bf16_hi(ya.x) + bf16_hi(yb.x); v[j][2] += bf16_lo(ya.y) + bf16_lo(yb.y); v[j][3] += bf16_hi(ya.y) + bf16_hi(yb.y);
            s += (v[j][0] * v[j][0] + v[j][1] * v[j][1]) + (v[j][2] * v[j][2] + v[j][3] * v[j][3]); }
        s = wave_sum(s);
        const float rs = 1.0f / sqrtf(s * (1.0f / D) + 1e-6f);
#pragma unroll
        for (int j = 0; j < 4; ++j) hr[64 * j] = v[j] * rs * g[j];
    }
}

__global__ __launch_bounds__(512) void mega(Params p) {
    extern __shared__ __attribute__((aligned(16))) unsigned char lds_raw[];
    LAS unsigned char* lds = (LAS unsigned char*)lds_raw;
    cg::grid_group grid = cg::this_grid();
#ifndef PHASE_MASK
#define PHASE_MASK 0xff
#endif
    if (PHASE_MASK & 1) phase0(p, lds); grid.sync();
    if (PHASE_MASK & 2) phase1(p, lds); grid.sync();
    if (PHASE_MASK & 4) phase2(p, lds); grid.sync();
    if (PHASE_MASK & 8) phase3(p, lds); grid.sync();
    if (PHASE_MASK & 16) phase4(p, lds); grid.sync();
    if (PHASE_MASK & 32) phase5(p, lds); grid.sync();
    if (PHASE_MASK & 64) phase6(p, lds); grid.sync();
    if (PHASE_MASK & 128) phase7(p);
}

extern "C" void kernel_launch(void* const* d_in, const int* in_sizes, int n_in, void* d_out, int out_size, void* d_ws, size_t ws_size, hipStream_t stream) {
    static int grid = 0;
    if (grid == 0) {
        if (n_in != 25 || out_size != T * D || ws_size < WS_END) { fprintf(stderr, "kernel_launch: unexpected sizes n_in %d out %d ws %zu (need %zu)\n", n_in, out_size, ws_size, (size_t)WS_END); grid = -1; return; }
        int dev = 0, cus = 0, per_cu = 0;
        (void)hipGetDevice(&dev); (void)hipDeviceGetAttribute(&cus, hipDeviceAttributeMultiprocessorCount, dev);
        if (hipFuncSetAttribute((const void*)mega, hipFuncAttributeMaxDynamicSharedMemorySize, LDS_BYTES) != hipSuccess) { fprintf(stderr, "kernel_launch: hipFuncSetAttribute failed\n"); grid = -1; return; }
        if (hipOccupancyMaxActiveBlocksPerMultiprocessor(&per_cu, (const void*)mega, NTHREADS, LDS_BYTES) != hipSuccess || per_cu < 1) { fprintf(stderr, "kernel_launch: occupancy query failed (%d)\n", per_cu); (void)hipGetLastError(); per_cu = 1; }
        grid = cus * 1;
    }
    if (grid < 0) return;
    Params p{};
    const float** f = (const float**)&p;
    for (int i = 0; i < 25; ++i) f[i] = (const float*)d_in[i];
    p.out = (float*)d_out; p.ws = (unsigned char*)d_ws;
    void* args[] = {&p};
    hipError_t e = hipLaunchCooperativeKernel((const void*)mega, dim3(grid), dim3(NTHREADS), args, LDS_BYTES, stream);
    if (e != hipSuccess) fprintf(stderr, "cooperative launch failed: %s (grid %d)\n", hipGetErrorString(e), grid);
}
```

```cpp
#include <hip/hip_runtime.h>
#include <cstdio>
#include <cstdint>
#define TPQ 8.0f

#define LAS __attribute__((address_space(3)))
typedef unsigned short bf16_t;
typedef short bf16x8 __attribute__((ext_vector_type(8)));
typedef short s16x4 __attribute__((ext_vector_type(4)));
typedef float f32x4 __attribute__((ext_vector_type(4)));
typedef float f32x2 __attribute__((ext_vector_type(2)));
typedef float f32x16 __attribute__((ext_vector_type(16)));
typedef unsigned u32x2 __attribute__((ext_vector_type(2)));
typedef unsigned u32x4 __attribute__((ext_vector_type(4)));

constexpr int NB = 16, S = 2048, T = NB * S, D = 1024, NIN = 3328, NH = 8, HD = 64;
constexpr int UQ = 0, UK = 512, UV = 1024, UR = 1536, URK = 2048, URV = 2560, UXW = 3072, UXA = 3136, UXG = 3200;
constexpr int NE = 32, DE = 256;
constexpr float LOG2E = 1.4426950408889634f, LN2 = 0.6931471805599453f;
constexpr float QSCALE = 0.125f * LOG2E;
constexpr int NTHREADS = 512, NWAVES = 8;
constexpr int LDS_BYTES = 131072 + 1024;

constexpr size_t WS_CTL   = 0;
constexpr size_t WS_BAR   = 8192;
constexpr size_t WS_WIN   = 65536;
constexpr size_t WS_WOUT  = WS_WIN  + (size_t)NIN * D * 2;
constexpr size_t WS_WGU   = WS_WOUT + (size_t)D * D * 2;
constexpr size_t WS_WDN   = WS_WGU  + (size_t)NE * 512 * D * 2;
constexpr size_t WS_RSTD1 = WS_WDN  + (size_t)NE * D * DE * 2;
constexpr size_t WS_RSTD2 = WS_RSTD1 + (size_t)T * 4;
constexpr size_t WS_LIST  = WS_RSTD2 + (size_t)T * 4;
constexpr size_t WS_LISTW = WS_LIST + (size_t)NE * T * 4;
constexpr size_t WS_WR    = WS_LISTW + (size_t)NE * T * 4;
constexpr size_t WS_A     = WS_WR + (size_t)2 * 48 * D * 2;
constexpr size_t WS_B     = WS_A + (size_t)T * NIN * 2;
constexpr size_t WS_END   = WS_B + (size_t)T * D * 2;
constexpr int HID_ROWS = 2 * T + NE * 256;

struct Params {
    const float* x; const float* norm_mix_g; const float* w_in; const float* shift_mu; const float* sb_out_g;
    const float* rw_w0; const float* rw_w2; const float* rw_a0; const float* rw_a2; const float* rw_g2;
    const float* rw_k_k; const float* rw_k_a; const float* rw_r_k; const float* rw_ln_w; const float* rw_ln_b;
    const float* w_out; const float* norm_ffn_g; const float* r_grp_w; const float* r_grp_b; const float* r_exp_w; const float* r_exp_b;
    const float* w_gate; const float* w_up; const float* w_down; const float* final_g;
    float* out; unsigned char* ws;
};

__device__ __forceinline__ unsigned cvt_pk_bf16(float lo, float hi) { unsigned r; asm volatile("v_cvt_pk_bf16_f32 %0, %1, %2" : "=v"(r) : "v"(lo), "v"(hi)); return r; }
__device__ __forceinline__ float bf16_lo(unsigned w) { return __uint_as_float(w << 16); }
__device__ __forceinline__ float bf16_hi(unsigned w) { return __uint_as_float(w & 0xffff0000u); }
__device__ __forceinline__ float fexp2(float x) { return __builtin_amdgcn_exp2f(x); }
__device__ __forceinline__ float flog2(float x) { return __builtin_amdgcn_logf(x); }
__device__ __forceinline__ float frcp(float x) { return __builtin_amdgcn_rcpf(x); }
__device__ __forceinline__ float frsq(float x) { return __builtin_amdgcn_rsqf(x); }
template <int CTRL> __device__ __forceinline__ float dppf(float v) { return __builtin_bit_cast(float, __builtin_amdgcn_update_dpp(0, __builtin_bit_cast(int, v), CTRL, 0xF, 0xF, true)); }
__device__ __forceinline__ float rlane(float v, int l) { return __builtin_bit_cast(float, __builtin_amdgcn_readlane(__builtin_bit_cast(int, v), l)); }
__device__ __forceinline__ float sum8(float v) { v += dppf<0xB1>(v); v += dppf<0x4E>(v); v += dppf<0x141>(v); return v; }
__device__ __forceinline__ float sum16(float v) { v = sum8(v); v += dppf<0x140>(v); return v; }
__device__ __forceinline__ float wave_sum(float v) { v = sum16(v); return (rlane(v, 0) + rlane(v, 16)) + (rlane(v, 32) + rlane(v, 48)); }
__device__ __forceinline__ float swap32(float v) { return __shfl_xor(v, 32); }
#define LDS_WAIT() asm volatile("s_waitcnt lgkmcnt(0)" ::: "memory")


#define XB_TMO      128
#define XB_XCNT(j)  (256  + 64 * (j))
#define XB_XSUB(j)  (1280 + 64 * (j))
#define XB_XGEN(j)  (2304 + 64 * (j))
#define XB_TOP      3328
#define XB_TOPGEN   3392
#define XCD_BAR_WORDS 3456
#define XB_SPIN_CAP (1u << 22)
__device__ __forceinline__ unsigned xb_ld(unsigned* p)              { return __hip_atomic_load(p, __ATOMIC_RELAXED, __HIP_MEMORY_SCOPE_AGENT); }
__device__ __forceinline__ unsigned xb_add(unsigned* p, unsigned v) { return __hip_atomic_fetch_add(p, v, __ATOMIC_RELAXED, __HIP_MEMORY_SCOPE_AGENT); }
__device__ __forceinline__ unsigned xb_xcc_id() { return (unsigned)__builtin_amdgcn_s_getreg((3 << 11) | 20) & 0xFu; }
#define XB_SPIN(cond, bar) do { unsigned _sp = 0; while (cond) { __builtin_amdgcn_s_sleep(1); \
    if ((++_sp & 255u) == 0u) { if (xb_ld(&(bar)[XB_TMO])) break; if (_sp > XB_SPIN_CAP) { atomicAdd(&(bar)[XB_TMO], 1u); break; } } } } while (0)
struct XcdBarrier { unsigned* bar; unsigned x; volatile LAS unsigned* st; };
__device__ __forceinline__ XcdBarrier xcd_barrier_post(unsigned* bar, volatile LAS unsigned* st) {
    XcdBarrier b; b.bar = bar; b.x = xb_xcc_id(); b.st = st;
    if (threadIdx.x == 0) (void)xb_add(&bar[XB_XCNT(b.x)], 1u);
    return b;
}
__device__ __forceinline__ void xcd_barrier_complete(unsigned* bar, unsigned x, unsigned& nloc, unsigned& nx) {
    const unsigned G = gridDim.x * gridDim.y * gridDim.z;
    unsigned sum, cnt, mine, sp = 0u;
    for (;;) {
        sum = 0u; cnt = 0u; mine = 0u;
#pragma unroll
        for (unsigned j = 0; j < 16; ++j) { const unsigned c = xb_ld(&bar[XB_XCNT(j)]); sum += c; cnt += (c > 0u) ? 1u : 0u; mine = (j == x) ? c : mine; }
        if (sum == G) break;
        __builtin_amdgcn_s_sleep(1);
        if ((++sp & 255u) == 0u) { if (xb_ld(&bar[XB_TMO])) break; if (sp > XB_SPIN_CAP) { atomicAdd(&bar[XB_TMO], 1u); break; } }
    }
    nloc = mine > 0u ? mine : 1u; nx = cnt > 0u ? cnt : 1u;
}
__device__ __forceinline__ void xcd_barrier(const XcdBarrier& b) {
    asm volatile("s_waitcnt vmcnt(0)" ::: "memory");
    __syncthreads();
    if (threadIdx.x == 0) {
        unsigned* bar = b.bar;
        __builtin_amdgcn_s_waitcnt(0);
        unsigned nloc = b.st[0], nx = b.st[1];
        if (nloc == 0u) { xcd_barrier_complete(bar, b.x, nloc, nx); b.st[0] = nloc; b.st[1] = nx; }
        const unsigned old = xb_add(&bar[XB_XSUB(b.x)], 1u);
        const unsigned gen = old / nloc;
        if (old + 1u == (gen + 1u) * nloc) {
            __builtin_amdgcn_fence(__ATOMIC_RELEASE, "agent");
            asm volatile("s_waitcnt vmcnt(0)" ::: "memory");
            const unsigned og = xb_add(&bar[XB_TOP], 1u);
            const unsigned tg = og / nx;
            if (og + 1u == (tg + 1u) * nx) xb_add(&bar[XB_TOPGEN], 1u);
            else XB_SPIN(xb_ld(&bar[XB_TOPGEN]) == tg, bar);
            __builtin_amdgcn_fence(__ATOMIC_ACQUIRE, "agent");
            xb_add(&bar[XB_XGEN(b.x)], 1u);
            asm volatile("s_waitcnt vmcnt(0)" ::: "memory");
        } else {
            XB_SPIN(xb_ld(&bar[XB_XGEN(b.x)]) == gen, bar);
            __builtin_amdgcn_fence(__ATOMIC_ACQUIRE, "agent");
            asm volatile("s_waitcnt vmcnt(0)" ::: "memory");
        }
    }
    __syncthreads();
}

namespace g8 {
constexpr int BK = 64, HALF = 128, HTB = HALF * BK * 2;
__device__ __forceinline__ int lds_byte(int r, int c) { const int st = (r >> 4) * 2 + (c >> 5), rr = r & 15, cc = c & 31, ob = rr * 64 + cc * 2; return st * 1024 + (ob ^ (((ob >> 9) & 1) << 5)); }
__device__ __forceinline__ void stage_rc(int b, int& R, int& C) { const int st = b / 1024, sb = b % 1024, swz = sb ^ (((sb >> 9) & 1) << 5); R = (st >> 1) * 16 + swz / 64; C = (st & 1) * 32 + (swz % 64) / 2; }

#define G8_SA(b, h) (((b) * 2 + (h)) * HTB)
#define G8_SB(b, h) ((4 + (b) * 2 + (h)) * HTB)
#define G8_STAGE_A(bufoff, h, kt) do { _Pragma("unroll") for (int _i = 0; _i < 2; ++_i) \
    __builtin_amdgcn_global_load_lds((const unsigned*)((Ab + (size_t)(kt) * (BK * 2)) + aoff[h][_i]), (LAS unsigned*)(lds + (bufoff) + ldsw + _i * 8192), 16, 0, 0); } while (0)
#define G8_STAGE_B(bufoff, h, kt) do { _Pragma("unroll") for (int _i = 0; _i < 2; ++_i) \
    __builtin_amdgcn_global_load_lds((const unsigned*)((Bb + (size_t)(h) * bhalf + (size_t)(kt) * (BK * 2)) + boff[_i]), (LAS unsigned*)(lds + (bufoff) + ldsw + _i * 8192), 16, 0, 0); } while (0)
#define G8_LDA(dst, b, h) do { _Pragma("unroll") for (int m = 0; m < 4; ++m) _Pragma("unroll") for (int k = 0; k < 2; ++k) dst[m][k] = *(const LAS bf16x8*)(lds + G8_SA(b, h) + la_off + m * 2048 + k * 1024); } while (0)
#define G8_LDB(dst, b, h) do { _Pragma("unroll") for (int n = 0; n < 2; ++n) _Pragma("unroll") for (int k = 0; k < 2; ++k) dst[n][k] = *(const LAS bf16x8*)(lds + G8_SB(b, h) + lb_off + n * 2048 + k * 1024); } while (0)
#define G8_MMA(ai, bj, At, Bt) do { __builtin_amdgcn_s_setprio(1); _Pragma("unroll") for (int m = 0; m < 4; ++m) _Pragma("unroll") for (int n = 0; n < 2; ++n) _Pragma("unroll") for (int k = 0; k < 2; ++k) \
    acc[ai][bj][m][n] = __builtin_amdgcn_mfma_f32_16x16x32_bf16(Bt[n][k], At[m][k], acc[ai][bj][m][n], 0, 0, 0); __builtin_amdgcn_s_setprio(0); } while (0)
#define G8_WAIT_V(n) asm volatile("s_waitcnt vmcnt(" #n ")" ::: "memory")
#define G8_WAIT_L(n) asm volatile("s_waitcnt lgkmcnt(" #n ")" ::: "memory")
#define G8_BAR __builtin_amdgcn_s_barrier()
#define G8_SCHED __builtin_amdgcn_sched_barrier(0)

template <class Epi>
__device__ __forceinline__ void gemm_unit(LAS unsigned char* lds, const char* Ab, const unsigned (&aoff)[2][2], const char* Bb, int K, const Epi& E) {
    const int tid = threadIdx.x, wid = __builtin_amdgcn_readfirstlane(tid >> 6), lane = tid & 63, wr = wid >> 2, wc = wid & 3, fr = lane & 15, fq = lane >> 4;
    const int nt = K / BK;
    unsigned boff[2];
#pragma unroll
    for (int i = 0; i < 2; ++i) { int R, C; stage_rc(tid * 16 + i * 8192, R, C); boff[i] = (unsigned)(R * K + C) * 2u; }
    const size_t bhalf = (size_t)HALF * K * 2;
    const unsigned ldsw = (unsigned)wid * 1024u;
    const int la_off = lds_byte(wr * 64 + fr, fq * 8), lb_off = lds_byte(wc * 32 + fr, fq * 8);
    f32x4 acc[2][2][4][2];
#pragma unroll
    for (int a = 0; a < 2; ++a)
#pragma unroll
        for (int b = 0; b < 2; ++b)
#pragma unroll
            for (int m = 0; m < 4; ++m)
#pragma unroll
                for (int n = 0; n < 2; ++n) acc[a][b][m][n] = (f32x4){0.f, 0.f, 0.f, 0.f};
    bf16x8 At[4][2], B0[2][2], B1[2][2];
    G8_STAGE_B(G8_SB(0, 0), 0, 0); G8_STAGE_A(G8_SA(0, 0), 0, 0);
    G8_STAGE_B(G8_SB(0, 1), 1, 0); G8_STAGE_A(G8_SA(0, 1), 1, 0);
    if (wr == 1) G8_BAR;
    G8_WAIT_V(4); G8_BAR;
    G8_STAGE_B(G8_SB(1, 0), 0, 1); G8_STAGE_A(G8_SA(1, 0), 0, 1); G8_STAGE_B(G8_SB(1, 1), 1, 1);
    G8_WAIT_V(6); G8_BAR;
    for (int t = 0; t < nt - 2; t += 2) {
        G8_LDB(B0, 0, 0); G8_SCHED; G8_LDA(At, 0, 0); G8_STAGE_A(G8_SA(1, 1), 1, t + 1);
        G8_WAIT_L(8); G8_BAR; G8_WAIT_L(0); G8_MMA(0, 0, At, B0); G8_BAR; G8_SCHED;
        G8_LDB(B1, 0, 1); G8_STAGE_B(G8_SB(0, 0), 0, t + 2);
        G8_BAR; G8_WAIT_L(0); G8_MMA(0, 1, At, B1); G8_BAR;
        G8_LDA(At, 0, 1); G8_STAGE_A(G8_SA(0, 0), 0, t + 2);
        G8_BAR; G8_WAIT_L(0); G8_MMA(1, 0, At, B0); G8_BAR; G8_SCHED;
        G8_STAGE_B(G8_SB(0, 1), 1, t + 2);
        G8_WAIT_V(6); G8_BAR; G8_MMA(1, 1, At, B1); G8_BAR;
        G8_LDB(B0, 1, 0); G8_SCHED; G8_LDA(At, 1, 0); G8_STAGE_A(G8_SA(0, 1), 1, t + 2);
        G8_WAIT_L(8); G8_BAR; G8_WAIT_L(0); G8_MMA(0, 0, At, B0); G8_BAR; G8_SCHED;
        G8_LDB(B1, 1, 1); G8_STAGE_B(G8_SB(1, 0), 0, t + 3);
        G8_BAR; G8_WAIT_L(0); G8_MMA(0, 1, At, B1); G8_BAR;
        G8_LDA(At, 1, 1); G8_STAGE_A(G8_SA(1, 0), 0, t + 3);
        G8_BAR; G8_WAIT_L(0); G8_MMA(1, 0, At, B0); G8_BAR; G8_SCHED;
        G8_STAGE_B(G8_SB(1, 1), 1, t + 3);
        G8_WAIT_V(6); G8_BAR; G8_MMA(1, 1, At, B1); G8_BAR;
    }
    { G8_LDB(B0, 0, 0); G8_LDA(At, 0, 0); G8_STAGE_A(G8_SA(1, 1), 1, nt - 1);
      G8_BAR; G8_WAIT_L(0); G8_MMA(0, 0, At, B0); G8_BAR;
      G8_LDB(B1, 0, 1); G8_BAR; G8_WAIT_L(0); G8_MMA(0, 1, At, B1); G8_BAR;
      G8_LDA(At, 0, 1); G8_WAIT_V(4); G8_BAR; G8_WAIT_L(0); G8_MMA(1, 0, At, B0); G8_MMA(1, 1, At, B1); G8_BAR; }
    { G8_LDB(B0, 1, 0); G8_LDA(At, 1, 0); G8_WAIT_V(2); G8_BAR; G8_WAIT_L(0); G8_MMA(0, 0, At, B0); G8_BAR;
      G8_LDB(B1, 1, 1); G8_WAIT_V(0); G8_BAR; G8_WAIT_L(0); G8_MMA(0, 1, At, B1); G8_BAR;
      G8_LDA(At, 1, 1); G8_BAR; G8_WAIT_L(0); G8_MMA(1, 0, At, B0); G8_MMA(1, 1, At, B1); G8_BAR; }
    if (wr == 0) G8_BAR;
    asm volatile("" ::: "memory");
    E(acc, wr, wc, fr, fq);
    __syncthreads();
}
__device__ __forceinline__ void aoff_rows(unsigned (&aoff)[2][2], int K) {
    const int tid = threadIdx.x;
#pragma unroll
    for (int i = 0; i < 2; ++i) { int R, C; stage_rc(tid * 16 + i * 8192, R, C);
#pragma unroll
        for (int h = 0; h < 2; ++h) aoff[h][i] = (unsigned)((h * HALF + R) * K + C) * 2u; }
}
__device__ __forceinline__ void tile_order(int L, int nM, int nN, int& pm, int& pn) {
    const int nwg = nM * nN; int wgid = L;
    { const int q = nwg / 8, r = nwg % 8, xcd = wgid % 8, off = wgid / 8; wgid = (xcd < r ? xcd * (q + 1) : r * (q + 1) + (xcd - r) * q) + off; }
    const int nig = 8 * nN, gid = wgid / nig, fm = gid * 8, gsz = (nM - fm) < 8 ? (nM - fm) : 8;
    pm = fm + ((wgid % nig) % gsz); pn = (wgid % nig) / gsz;
}
}

__device__ __forceinline__ void p0_transpose_item(const float* W, int K, int N, int k0, int n0, bf16_t* WTrow0  , const float* kscale, float mul, LAS float* scr, int lane) {
#pragma unroll 8
    for (int i = 0; i < 32; ++i) { const int kk = 2 * i + (lane >> 5); float v = W[(size_t)(k0 + kk) * N + n0 + (lane & 31)]; if (kscale) v *= kscale[k0 + kk]; scr[kk * 33 + (lane & 31)] = v * mul; }
    LDS_WAIT();
    const int c = lane & 7;
#pragma unroll
    for (int j = 0; j < 4; ++j) { const int n = (lane >> 3) + 8 * j; const LAS float* s = scr + (8 * c) * 33 + n;
        u32x4 o; o.x = cvt_pk_bf16(s[0 * 33], s[1 * 33]); o.y = cvt_pk_bf16(s[2 * 33], s[3 * 33]); o.z = cvt_pk_bf16(s[4 * 33], s[5 * 33]); o.w = cvt_pk_bf16(s[6 * 33], s[7 * 33]);
        *(u32x4*)(WTrow0 + (size_t)n * K + k0 + 8 * c) = o; }
    LDS_WAIT();
}

__device__ __forceinline__ void p0_expert_weights(const Params& p, LAS unsigned char* lds, int gw, int NGW) {
    const int wave = threadIdx.x >> 6, lane = threadIdx.x & 63;
    LAS float* scr = (LAS float*)(lds + 49152 + wave * 8704);
    bf16_t* wgu = (bf16_t*)(p.ws + WS_WGU); bf16_t* wdn = (bf16_t*)(p.ws + WS_WDN);
    constexpr int I_G = NE * 16 * 8, I_D = NE * 4 * 32;
    for (int it = gw; it < 2 * I_G + I_D; it += NGW) {
        int r = it;
        if (r < 2 * I_G) { const int up = r >= I_G; if (up) r -= I_G; const int e = r / 128, q = r % 128, kb = q / 8, nb = q % 8, n0 = nb * 32;
            const int drow = (n0 >> 7) * 256 + up * 128 + (n0 & 127);
            p0_transpose_item((up ? p.w_up : p.w_gate) + (size_t)e * D * DE, D, DE, kb * 64, n0, wgu + ((size_t)e * 512 + drow) * D, p.norm_ffn_g, 1.f, scr, lane); continue; } r -= 2 * I_G;
        { const int e = r / 128, q = r % 128, kb = q / 32, nb = q % 32, n0 = nb * 32;
            p0_transpose_item(p.w_down + (size_t)e * DE * D, DE, D, kb * 64, n0, wdn + ((size_t)e * D + n0) * DE, nullptr, 1.f, scr, lane); }
    }
}
__device__ __forceinline__ void phase0(const Params& p, LAS unsigned char* lds) {
    const int tid = threadIdx.x, wave = tid >> 6, lane = tid & 63;
    const int gw = blockIdx.x * NWAVES + wave, NGW = gridDim.x * NWAVES;
    LAS float* scr = (LAS float*)(lds + wave * 8704);
    bf16_t* win = (bf16_t*)(p.ws + WS_WIN); bf16_t* wout = (bf16_t*)(p.ws + WS_WOUT);
    constexpr int I_IN = 16 * 104, I_OUT = 16 * 32;
    for (int it = gw; it < I_IN + I_OUT; it += NGW) {
        int r = it;
        if (r < I_IN) { const int kb = r / 104, nb = r % 104, n0 = nb * 32; p0_transpose_item(p.w_in, D, NIN, kb * 64, n0, win + (size_t)n0 * D, p.norm_mix_g, n0 < 512 ? QSCALE : 1.f, scr, lane); continue; } r -= I_IN;
        { const int kb = r / 32, nb = r % 32, n0 = nb * 32; p0_transpose_item(p.w_out, D, D, kb * 64, n0, wout + (size_t)n0 * D, nullptr, 1.f, scr, lane); }
    }
    bf16_t* xb = (bf16_t*)(p.ws + WS_B); float* rstd1 = (float*)(p.ws + WS_RSTD1);
    for (int row = gw; row < T; row += NGW) {
        const f32x4* xr = (const f32x4*)(p.x + (size_t)row * D) + lane; f32x4 v[4]; float s = 0.f;
#pragma unroll
        for (int j = 0; j < 4; ++j) { v[j] = xr[64 * j]; s += (v[j].x * v[j].x + v[j].y * v[j].y) + (v[j].z * v[j].z + v[j].w * v[j].w); }
        s = wave_sum(s);
        u32x2* o = (u32x2*)(xb + (size_t)row * D) + lane;
#pragma unroll
        for (int j = 0; j < 4; ++j) { u32x2 w; w.x = cvt_pk_bf16(v[j].x, v[j].y); w.y = cvt_pk_bf16(v[j].z, v[j].w); o[64 * j] = w; }
        if (lane == 0) rstd1[row] = 1.0f / sqrtf(s * (1.0f / D) + 1e-6f);
    }
    bf16_t* wr_hi = (bf16_t*)(p.ws + WS_WR); bf16_t* wr_lo = wr_hi + 48 * D;
    for (int i = blockIdx.x * NTHREADS + tid; i < 48 * D; i += gridDim.x * NTHREADS) {
        const int c = i / D, k = i % D; float w = 0.f;
        if (c < 4) w = p.r_grp_w[k * 4 + c]; else if (c < 36) w = p.r_exp_w[k * 32 + (c - 4)];
        w *= p.norm_ffn_g[k];
        const unsigned hi = cvt_pk_bf16(w, 0.f) & 0xffffu; const float rem = w - __uint_as_float(hi << 16);
        wr_hi[i] = (bf16_t)hi; wr_lo[i] = (bf16_t)(cvt_pk_bf16(rem, 0.f) & 0xffffu);
    }
    if (blockIdx.x == 0 && tid < 64) ((unsigned*)(p.ws + WS_CTL))[tid] = 0u;
}

struct EpiU {
    bf16_t* u; const float* rstd; int row0, col0;
    __device__ __forceinline__ void operator()(const f32x4 (&acc)[2][2][4][2], int wr, int wc, int fr, int fq) const {
#pragma unroll
        for (int ai = 0; ai < 2; ++ai)
#pragma unroll
            for (int m = 0; m < 4; ++m) { const int row = row0 + ai * 128 + wr * 64 + m * 16 + fr; const float rs = rstd[row]; bf16_t* rp = u + (size_t)row * NIN + col0 + wc * 32 + 4 * fq;
#pragma unroll
                for (int bj = 0; bj < 2; ++bj)
#pragma unroll
                    for (int n = 0; n < 2; ++n) { const f32x4 v = acc[ai][bj][m][n] * rs; u32x2 w; w.x = cvt_pk_bf16(v[0], v[1]); w.y = cvt_pk_bf16(v[2], v[3]); *(u32x2*)(rp + bj * 128 + n * 16) = w; } }
    }
};
__device__ __forceinline__ void phase1(const Params& p, LAS unsigned char* lds) {
    constexpr int nM = T / 256, nN = NIN / 256;
    unsigned aoff[2][2]; g8::aoff_rows(aoff, D);
    for (int L = blockIdx.x; L < nM * nN; L += gridDim.x) {
        int pm, pn; g8::tile_order(L, nM, nN, pm, pn);
        EpiU E{(bf16_t*)(p.ws + WS_A), (const float*)(p.ws + WS_RSTD1), pm * 256, pn * 256};
        g8::gemm_unit(lds, (const char*)(p.ws + WS_B) + (size_t)pm * 256 * D * 2, aoff, (const char*)(p.ws + WS_WIN) + (size_t)pn * 256 * D * 2, D, E);
    }
}


typedef short v4i16_t __attribute__((ext_vector_type(4)));
__device__ __forceinline__ s16x4 lds_tr16(const LAS unsigned char* p) { return __builtin_bit_cast(s16x4, __builtin_amdgcn_ds_read_tr16_b64_v4i16((LAS v4i16_t*)p)); }

__device__ __forceinline__ void attn_tile(const Params& p, LAS unsigned char* vl  , int b, int h, int qt) {
    const int lane = threadIdx.x & 63, r32 = lane & 31, hi = lane >> 5;
    const bf16_t* u = (const bf16_t*)(p.ws + WS_A);
    const size_t row0 = (size_t)b * S; const int q0 = qt * 32;
    bf16x8 qf[4];
    { const bf16_t* qp = u + (row0 + q0 + r32) * NIN + UQ + h * HD + 8 * hi;
#pragma unroll
      for (int s = 0; s < 4; ++s) qf[s] = *(const bf16x8*)(qp + 16 * s); }
    f32x16 o0, o1;
#pragma unroll
    for (int i = 0; i < 16; ++i) { o0[i] = 0.f; o1[i] = 0.f; }
    float carry = 0.f;
    const int kperm = 16 * ((r32 >> 2) & 1) + (r32 & 3) + 4 * (r32 >> 3);
    const int g = lane >> 4, i16 = lane & 15, tq = i16 >> 2, tp = i16 & 3;
    const LAS unsigned char* vrd = vl + (16 * (g >> 1) + tq) * 144 + (16 * (g & 1) + 4 * tp) * 2;
    LAS unsigned char* vwr = vl + (lane >> 1) * 144 + (lane & 1) * 64;
    for (int kb = qt; kb >= 0; --kb) {
        const int key0 = kb * 32;
        { const bf16_t* vp = u + (row0 + key0 + (lane >> 1)) * NIN + UV + h * HD + 32 * (lane & 1);
          u32x4 v0 = *(const u32x4*)(vp), v1 = *(const u32x4*)(vp + 8), v2 = *(const u32x4*)(vp + 16), v3 = *(const u32x4*)(vp + 24);
          *(LAS u32x4*)(vwr) = v0; *(LAS u32x4*)(vwr + 16) = v1; *(LAS u32x4*)(vwr + 32) = v2; *(LAS u32x4*)(vwr + 48) = v3; }
        f32x16 st;
#pragma unroll
        for (int i = 0; i < 16; ++i) st[i] = 0.f;
        { const bf16_t* kp = u + (row0 + key0 + kperm) * NIN + UK + h * HD + 8 * hi;
          bf16x8 kf[4];
#pragma unroll
          for (int s = 0; s < 4; ++s) kf[s] = *(const bf16x8*)(kp + 16 * s);
#pragma unroll
          for (int s = 0; s < 4; ++s) st = __builtin_amdgcn_mfma_f32_32x32x16_bf16(kf[s], qf[s], st, 0, 0, 0); }
        const bool diag = (kb == qt);
        float lw[16], suf[16];
        float run = 0.f;
#pragma unroll
        for (int reg = 15; reg >= 0; --reg) {
            const float z = st[reg];
            const float l = flog2(1.0f + fexp2(-fabsf(z)));
            const float sp = fmaxf(z, 0.f) + l;
            const bool valid = !diag || (16 * hi + reg < r32);
            lw[reg] = valid ? (z - sp) : -1.0e30f;
            suf[reg] = run;
            run += valid ? -sp : 0.f;
        }
        const float other = swap32(run);
        const float tot_hi = hi ? run : other, tot_lo = hi ? other : run;
        const float base = carry + (hi ? 0.f : tot_hi);
        carry += tot_lo + tot_hi;
        unsigned pk[8];
#pragma unroll
        for (int j = 0; j < 8; ++j) pk[j] = cvt_pk_bf16(fexp2(lw[2 * j] + suf[2 * j] + base), fexp2(lw[2 * j + 1] + suf[2 * j + 1] + base));
        LDS_WAIT();
#pragma unroll
        for (int s2 = 0; s2 < 2; ++s2) {
            bf16x8 pf = __builtin_bit_cast(bf16x8, (u32x4){pk[4 * s2], pk[4 * s2 + 1], pk[4 * s2 + 2], pk[4 * s2 + 3]});
#pragma unroll
            for (int dh = 0; dh < 2; ++dh) {
                const s16x4 a = lds_tr16(vrd + (8 * s2) * 144 + 64 * dh), c = lds_tr16(vrd + (8 * s2 + 4) * 144 + 64 * dh);
                bf16x8 vf; vf[0] = a[0]; vf[1] = a[1]; vf[2] = a[2]; vf[3] = a[3]; vf[4] = c[0]; vf[5] = c[1]; vf[6] = c[2]; vf[7] = c[3];
                if (dh == 0) o0 = __builtin_amdgcn_mfma_f32_32x32x16_bf16(vf, pf, o0, 0, 0, 0); else o1 = __builtin_amdgcn_mfma_f32_32x32x16_bf16(vf, pf, o1, 0, 0, 0);
            }
        }
        LDS_WAIT();
        if (__builtin_amdgcn_ballot_w64(carry > -150.0f) == 0ull) break;
    }
    float ss = 0.f;
#pragma unroll
    for (int i = 0; i < 16; ++i) ss += o0[i] * o0[i] + o1[i] * o1[i];
    ss += swap32(ss);
    const float rs = 1.0f / sqrtf(ss * (1.0f / HD) + 1e-6f);
    bf16_t* op = (bf16_t*)(p.ws + WS_B) + (row0 + q0 + r32) * D + h * HD + 4 * hi;
    const float* gp = p.sb_out_g + h * HD + 4 * hi;
#pragma unroll
    for (int dh = 0; dh < 2; ++dh)
#pragma unroll
        for (int gq = 0; gq < 4; ++gq) {
            const f32x4 gg = *(const f32x4*)(gp + 32 * dh + 8 * gq);
            const f32x16& o = dh ? o1 : o0;
            u32x2 w; w.x = cvt_pk_bf16(o[4 * gq] * rs * gg[0], o[4 * gq + 1] * rs * gg[1]); w.y = cvt_pk_bf16(o[4 * gq + 2] * rs * gg[2], o[4 * gq + 3] * rs * gg[3]);
            *(u32x2*)(op + 32 * dh + 8 * gq) = w;
        }
}

namespace rw {
constexpr int CH = 16;
constexpr int O_UM = 0;
constexpr int O_LW = O_UM + CH * 448 * 4;
constexpr int O_LA = O_LW + CH * 64 * 4;
constexpr int O_LG0 = O_LA + CH * 64 * 4;
constexpr int O_LG1 = O_LG0 + CH * 64 * 4;
constexpr int O_A1 = O_LG1 + CH * 64 * 4;
constexpr int O_R1 = O_A1 + CH * 64 * 4;
constexpr int O_B1 = O_R1 + CH * 64 * 4;
constexpr int O_K1 = O_B1 + CH * 64 * 4;
constexpr int O_O = O_K1 + CH * 64 * 4;
constexpr int O_WT = O_O + CH * 64 * 4;
constexpr int O_GC = O_WT + 8 * 64 * 4;
constexpr int O_SC = O_GC + 64 * 4;
constexpr int O_END = O_SC + 3 * 16 * 4;
}
__device__ __forceinline__ bf16x8 ldw_frag(const float* W, int ldw, int m0, int col) {
    unsigned w[4];
#pragma unroll
    for (int j = 0; j < 4; ++j) w[j] = cvt_pk_bf16(W[(size_t)(m0 + 2 * j) * ldw + col], W[(size_t)(m0 + 2 * j + 1) * ldw + col]);
    return __builtin_bit_cast(bf16x8, (u32x4){w[0], w[1], w[2], w[3]});
}
template <int ACT>
__device__ __forceinline__ bf16x8 act_frag(const LAS float* src) {
    const f32x4 a = *(const LAS f32x4*)src, b = *(const LAS f32x4*)(src + 4); float v[8] = {a[0], a[1], a[2], a[3], b[0], b[1], b[2], b[3]};
#pragma unroll
    for (int j = 0; j < 8; ++j) {
        if (ACT == 1) v[j] = 1.0f - 2.0f * frcp(1.0f + fexp2(v[j] * (2.0f * LOG2E)));
        if (ACT == 2) v[j] = frcp(1.0f + fexp2(-v[j] * LOG2E));
    }
    return __builtin_bit_cast(bf16x8, (u32x4){cvt_pk_bf16(v[0], v[1]), cvt_pk_bf16(v[2], v[3]), cvt_pk_bf16(v[4], v[5]), cvt_pk_bf16(v[6], v[7])});
}

__device__ __forceinline__ void rwkv_chain(const Params& p, LAS unsigned char* lds, int b, int h) {
    using namespace rw;
    const int tid = threadIdx.x, wave = __builtin_amdgcn_readfirstlane(tid >> 6), lane = tid & 63;
    const bf16_t* u = (const bf16_t*)(p.ws + WS_A);
    bf16_t* mix = (bf16_t*)(p.ws + WS_B);
    const size_t row0 = (size_t)b * S;
    LAS float* UM = (LAS float*)(lds + O_UM); LAS float* LW = (LAS float*)(lds + O_LW); LAS float* LA = (LAS float*)(lds + O_LA);
    LAS float* LG0 = (LAS float*)(lds + O_LG0); LAS float* LG1 = (LAS float*)(lds + O_LG1);
    LAS float* A1 = (LAS float*)(lds + O_A1); LAS float* R1 = (LAS float*)(lds + O_R1); LAS float* B1 = (LAS float*)(lds + O_B1); LAS float* K1 = (LAS float*)(lds + O_K1);
    LAS float* OO = (LAS float*)(lds + O_O); LAS float* WT = (LAS float*)(lds + O_WT); LAS float* GC = (LAS float*)(lds + O_GC); LAS float* SC = (LAS float*)(lds + O_SC);
    const int fc = lane & 15, fq = lane >> 4;
    bf16x8 bwa[2], bg[2];
    { const float* W = wave < 4 ? p.rw_w2 : p.rw_a2; const int col = h * HD + 16 * (wave & 3) + fc;
      bwa[0] = ldw_frag(W, 512, 8 * fq, col); bwa[1] = ldw_frag(W, 512, 32 + 8 * fq, col);
      const int ks = (wave >> 2) * 2; bg[0] = ldw_frag(p.rw_g2, 512, 32 * ks + 8 * fq, col); bg[1] = ldw_frag(p.rw_g2, 512, 32 * (ks + 1) + 8 * fq, col); }
    const int hj = h * HD + lane;
    const float c_w0 = p.rw_w0[hj], c_a0 = p.rw_a0[hj], c_kk = p.rw_k_k[hj], c_ka = p.rw_k_a[hj], c_rk = p.rw_r_k[hj], c_lnw = p.rw_ln_w[hj], c_lnb = p.rw_ln_b[hj];
    int ld_t[2], ld_c[2], ld_uc[2]; bool ld_ok[2];
#pragma unroll
    for (int r = 0; r < 2; ++r) { const int gid = tid + 512 * r; ld_ok[r] = gid < CH * 56; const int t = gid / 56, cg8 = gid % 56; ld_t[r] = t; ld_c[r] = cg8 * 8;
        ld_uc[r] = cg8 < 8 ? UR + h * HD + 8 * cg8 : cg8 < 16 ? URK + h * HD + 8 * (cg8 - 8) : cg8 < 24 ? URV + h * HD + 8 * (cg8 - 16) : UXW + 8 * (cg8 - 24); }
    const int si = 8 * wave + (lane >> 3), sj = 8 * (lane & 7);
    float st[8];
#pragma unroll
    for (int n = 0; n < 8; ++n) st[n] = 0.f;
    u32x4 cur[2], prv[2];
    auto issue_loads = [&](int t0) {
#pragma unroll
        for (int r = 0; r < 2; ++r) { cur[r] = (u32x4){0u, 0u, 0u, 0u}; prv[r] = (u32x4){0u, 0u, 0u, 0u};
            if (ld_ok[r]) { const int tt = t0 + ld_t[r]; const bf16_t* a = u + (row0 + tt) * NIN + ld_uc[r]; cur[r] = *(const u32x4*)a; if (tt > 0) prv[r] = *(const u32x4*)(a - NIN); } }
    };
    issue_loads(0);
    for (int c = 0; c < S / CH; ++c) {
        const int t0 = c * CH;
#pragma unroll
        for (int r = 0; r < 2; ++r) if (ld_ok[r]) {
            const float* mu = p.shift_mu + (ld_uc[r] - UR); const f32x4 m0 = *(const f32x4*)mu, m1 = *(const f32x4*)(mu + 4);
            float cv[8], pv[8];
#pragma unroll
            for (int j = 0; j < 4; ++j) { cv[2 * j] = bf16_lo(cur[r][j]); cv[2 * j + 1] = bf16_hi(cur[r][j]); pv[2 * j] = bf16_lo(prv[r][j]); pv[2 * j + 1] = bf16_hi(prv[r][j]); }
            f32x4 o0, o1;
#pragma unroll
            for (int j = 0; j < 4; ++j) { o0[j] = cv[j] + (pv[j] - cv[j]) * m0[j]; o1[j] = cv[4 + j] + (pv[4 + j] - cv[4 + j]) * m1[j]; }
            LAS float* d = UM + ld_t[r] * 448 + ld_c[r]; *(LAS f32x4*)d = o0; *(LAS f32x4*)(d + 4) = o1;
        }
        if (c + 1 < S / CH) issue_loads(t0 + CH);
        __syncthreads();
        {
            f32x4 acc = (f32x4){0.f, 0.f, 0.f, 0.f};
            const LAS float* src = UM + fc * 448 + (wave < 4 ? 192 : 256) + 8 * fq;
            if (wave < 4) { acc = __builtin_amdgcn_mfma_f32_16x16x32_bf16(act_frag<1>(src), bwa[0], acc, 0, 0, 0); acc = __builtin_amdgcn_mfma_f32_16x16x32_bf16(act_frag<1>(src + 32), bwa[1], acc, 0, 0, 0); }
            else          { acc = __builtin_amdgcn_mfma_f32_16x16x32_bf16(act_frag<0>(src), bwa[0], acc, 0, 0, 0); acc = __builtin_amdgcn_mfma_f32_16x16x32_bf16(act_frag<0>(src + 32), bwa[1], acc, 0, 0, 0); }
            LAS float* dst = (wave < 4 ? LW : LA) + 16 * (wave & 3) + fc;
#pragma unroll
            for (int r = 0; r < 4; ++r) dst[(4 * fq + r) * 64] = acc[r];
            f32x4 ag = (f32x4){0.f, 0.f, 0.f, 0.f};
            const LAS float* sg = UM + fc * 448 + 320 + 64 * (wave >> 2) + 8 * fq;
            ag = __builtin_amdgcn_mfma_f32_16x16x32_bf16(act_frag<2>(sg), bg[0], ag, 0, 0, 0); ag = __builtin_amdgcn_mfma_f32_16x16x32_bf16(act_frag<2>(sg + 32), bg[1], ag, 0, 0, 0);
            LAS float* dg = (wave < 4 ? LG0 : LG1) + 16 * (wave & 3) + fc;
#pragma unroll
            for (int r = 0; r < 4; ++r) dg[(4 * fq + r) * 64] = ag[r];
        }
        __syncthreads();
        float e_kk[2], e_b[2], e_k[2], e_r[2], e_ld[2];
#pragma unroll
        for (int tt = 0; tt < 2; ++tt) {
            const int t = 2 * wave + tt;
            const float xw = c_w0 + LW[t * 64 + lane];
            const float spn = (fmaxf(-xw, 0.f) + LN2 * flog2(1.0f + fexp2(-fabsf(xw) * LOG2E)));
            e_ld[tt] = -fexp2((-spn - 0.5f) * LOG2E);
            const float a = frcp(1.0f + fexp2(-(c_a0 + LA[t * 64 + lane]) * LOG2E));
            const float kraw = UM[t * 448 + 64 + lane], r = UM[t * 448 + lane];
            const float kkv = kraw * c_kk; const float ssq = wave_sum(kkv * kkv);
            const float kk = kkv * frsq(fmaxf(ssq, 1e-24f));
            const float kmod = kraw * (1.0f + (a - 1.0f) * c_ka);
            const float bb = kk * a;
            const float cbr = wave_sum(bb * r), ckr = wave_sum(kmod * r), bon = wave_sum(r * kmod * c_rk);
            if (lane == 0) { SC[t] = cbr; SC[16 + t] = ckr; SC[32 + t] = bon; }
            e_kk[tt] = kk; e_b[tt] = bb; e_k[tt] = kmod; e_r[tt] = r;
        }
        WT[wave * 64 + lane] = e_ld[0] + e_ld[1];
        __syncthreads();
        {
            float off = 0.f, tot = 0.f;
#pragma unroll
            for (int w = 0; w < 8; ++w) { const float x = WT[w * 64 + lane]; if (w < wave) off += x; tot += x; }
            const float c0 = off + e_ld[0], c1 = c0 + e_ld[1];
            const int t = 2 * wave;
            A1[t * 64 + lane] = -e_kk[0] * fexp2(off * LOG2E);       A1[(t + 1) * 64 + lane] = -e_kk[1] * fexp2(c0 * LOG2E);
            R1[t * 64 + lane] = e_r[0] * fexp2(c0 * LOG2E);          R1[(t + 1) * 64 + lane] = e_r[1] * fexp2(c1 * LOG2E);
            const float i0 = fexp2(-c0 * LOG2E), i1 = fexp2(-c1 * LOG2E);
            B1[t * 64 + lane] = e_b[0] * i0;                          B1[(t + 1) * 64 + lane] = e_b[1] * i1;
            K1[t * 64 + lane] = e_k[0] * i0;                          K1[(t + 1) * 64 + lane] = e_k[1] * i1;
            if (wave == 0) GC[lane] = fexp2(tot * LOG2E);
        }
        __syncthreads();
#pragma unroll 4
        for (int t = 0; t < CH; ++t) {
            const f32x4 a0 = *(const LAS f32x4*)(A1 + t * 64 + sj), a1 = *(const LAS f32x4*)(A1 + t * 64 + sj + 4);
            const f32x4 r0 = *(const LAS f32x4*)(R1 + t * 64 + sj), r1 = *(const LAS f32x4*)(R1 + t * 64 + sj + 4);
            const f32x4 b0 = *(const LAS f32x4*)(B1 + t * 64 + sj), b1 = *(const LAS f32x4*)(B1 + t * 64 + sj + 4);
            const f32x4 k0 = *(const LAS f32x4*)(K1 + t * 64 + sj), k1 = *(const LAS f32x4*)(K1 + t * 64 + sj + 4);
            const float v = UM[t * 448 + 128 + si], cbr = SC[t], ckr = SC[16 + t];
            float sa = (st[0] * a0[0] + st[1] * a0[1]) + (st[2] * a0[2] + st[3] * a0[3]) + ((st[4] * a1[0] + st[5] * a1[1]) + (st[6] * a1[2] + st[7] * a1[3]));
            float pp = (st[0] * r0[0] + st[1] * r0[1]) + (st[2] * r0[2] + st[3] * r0[3]) + ((st[4] * r1[0] + st[5] * r1[1]) + (st[6] * r1[2] + st[7] * r1[3]));
            sa = sum8(sa); pp = sum8(pp);
            if ((lane & 7) == 0) OO[t * 64 + si] = pp + sa * cbr + v * ckr;
#pragma unroll
            for (int n = 0; n < 4; ++n) { st[n] += sa * b0[n] + v * k0[n]; st[4 + n] += sa * b1[n] + v * k1[n]; }
        }
        {
            const f32x4 g0 = *(const LAS f32x4*)(GC + sj), g1 = *(const LAS f32x4*)(GC + sj + 4);
#pragma unroll
            for (int n = 0; n < 4; ++n) { st[n] *= g0[n]; st[4 + n] *= g1[n]; }
        }
        __syncthreads();
#pragma unroll
        for (int tt = 0; tt < 2; ++tt) {
            const int t = 2 * wave + tt;
            const float o = OO[t * 64 + lane];
            const float mean = wave_sum(o) * (1.0f / 64.0f); const float dlt = o - mean;
            const float var = wave_sum(dlt * dlt) * (1.0f / 64.0f);
            const float gn = dlt * (1.0f / sqrtf(var + 64e-5f)) * c_lnw + c_lnb;
            const float res = (gn + SC[32 + t] * UM[t * 448 + 128 + lane]) * (LG0[t * 64 + lane] + LG1[t * 64 + lane]);
            mix[(row0 + t0 + t) * D + 512 + h * HD + lane] = (bf16_t)(cvt_pk_bf16(res, 0.f) & 0xffffu);
        }
        __syncthreads();
    }
}

__device__ __forceinline__ void phase2(const Params& p, LAS unsigned char* lds) {
    const int nchain = NB * NH, G = gridDim.x, wave = threadIdx.x >> 6;
    const int nscan = G >= 2 * nchain ? nchain : (G > 1 ? G / 2 : 0);
    if ((int)blockIdx.x < nscan || nscan == 0) {
        const int stride = nscan == 0 ? G : nscan;
        for (int it = blockIdx.x; it < nchain; it += stride) rwkv_chain(p, lds, it / NH, it % NH);
    }
    if ((int)blockIdx.x >= nscan) {
        const int nb = G - nscan, bi = blockIdx.x - nscan;
        for (int it = bi * 8 + wave; it < NB * NH * 64; it += nb * 8) attn_tile(p, lds + wave * 4608, it / (NH * 64), (it / 64) % NH, 63 - (it % 64));
        p0_expert_weights(p, lds, bi * 8 + wave, nb * 8);
    }
}

struct EpiH {
    const float* x; float* hout; int row0, col0;
    __device__ __forceinline__ void operator()(const f32x4 (&acc)[2][2][4][2], int wr, int wc, int fr, int fq) const {
#pragma unroll
        for (int ai = 0; ai < 2; ++ai)
#pragma unroll
            for (int m = 0; m < 4; ++m) { const size_t off = (size_t)(row0 + ai * 128 + wr * 64 + m * 16 + fr) * D + col0 + wc * 32 + 4 * fq;
#pragma unroll
                for (int bj = 0; bj < 2; ++bj)
#pragma unroll
                    for (int n = 0; n < 2; ++n) { const f32x4 xv = *(const f32x4*)(x + off + bj * 128 + n * 16); *(f32x4*)(hout + off + bj * 128 + n * 16) = xv + acc[ai][bj][m][n]; } }
    }
};
__device__ __forceinline__ void phase3(const Params& p, LAS unsigned char* lds) {
    constexpr int nM = T / 256, nN = D / 256;
    unsigned aoff[2][2]; g8::aoff_rows(aoff, D);
    for (int L = blockIdx.x; L < nM * nN; L += gridDim.x) {
        int pm, pn; g8::tile_order(L, nM, nN, pm, pn);
        EpiH E{p.x, p.out, pm * 256, pn * 256};
        g8::gemm_unit(lds, (const char*)(p.ws + WS_B) + (size_t)pm * 256 * D * 2, aoff, (const char*)(p.ws + WS_WOUT) + (size_t)pn * 256 * D * 2, D, E);
    }
}

__device__ __forceinline__ void phase4(const Params& p, LAS unsigned char* lds) {
    const int tid = threadIdx.x, wave = tid >> 6, lane = tid & 63, fr = lane & 15, fq = lane >> 4;
    const float* hsrc = p.out; bf16_t* hb = (bf16_t*)(p.ws + WS_A); float* rstd2 = (float*)(p.ws + WS_RSTD2);
    const bf16_t* wr_hi = (const bf16_t*)(p.ws + WS_WR); const bf16_t* wr_lo = wr_hi + 48 * D;
    int* list = (int*)(p.ws + WS_LIST); float* listw = (float*)(p.ws + WS_LISTW); unsigned* cnt = (unsigned*)(p.ws + WS_CTL);
    LAS float* lg = (LAS float*)(lds + wave * 3072);
    LAS unsigned* lcnt = (LAS unsigned*)(lds + 8 * 3072);
    LAS unsigned* gbase = lcnt + 32;
    for (int blk = blockIdx.x; blk < T / 128; blk += gridDim.x) {
        if (tid < 32) lcnt[tid] = 0u;
        __syncthreads();
        const int tok0 = blk * 128 + wave * 16;
        f32x4 acc[3];
#pragma unroll
        for (int n = 0; n < 3; ++n) acc[n] = (f32x4){0.f, 0.f, 0.f, 0.f};
        float ss = 0.f;
        const float* hp = hsrc + (size_t)(tok0 + fr) * D + 8 * fq; bf16_t* hbp = hb + (size_t)(tok0 + fr) * D + 8 * fq;
        const bf16_t* bh = wr_hi + (size_t)fr * D + 8 * fq; const bf16_t* bl = wr_lo + (size_t)fr * D + 8 * fq;
#pragma unroll 2
        for (int ks = 0; ks < D / 32; ++ks) {
            const f32x4 v0 = *(const f32x4*)(hp + 32 * ks), v1 = *(const f32x4*)(hp + 32 * ks + 4);
            ss += (v0[0] * v0[0] + v0[1] * v0[1]) + (v0[2] * v0[2] + v0[3] * v0[3]) + ((v1[0] * v1[0] + v1[1] * v1[1]) + (v1[2] * v1[2] + v1[3] * v1[3]));
            u32x4 hi; hi.x = cvt_pk_bf16(v0[0], v0[1]); hi.y = cvt_pk_bf16(v0[2], v0[3]); hi.z = cvt_pk_bf16(v1[0], v1[1]); hi.w = cvt_pk_bf16(v1[2], v1[3]);
            *(u32x4*)(hbp + 32 * ks) = hi;
            u32x4 lo; lo.x = cvt_pk_bf16(v0[0] - bf16_lo(hi.x), v0[1] - bf16_hi(hi.x)); lo.y = cvt_pk_bf16(v0[2] - bf16_lo(hi.y), v0[3] - bf16_hi(hi.y));
            lo.z = cvt_pk_bf16(v1[0] - bf16_lo(hi.z), v1[1] - bf16_hi(hi.z)); lo.w = cvt_pk_bf16(v1[2] - bf16_lo(hi.w), v1[3] - bf16_hi(hi.w));
            const bf16x8 ah = __builtin_bit_cast(bf16x8, hi), al = __builtin_bit_cast(bf16x8, lo);
#pragma unroll
            for (int n = 0; n < 3; ++n) {
                const bf16x8 wh = *(const bf16x8*)(bh + (size_t)n * 16 * D + 32 * ks), wl = *(const bf16x8*)(bl + (size_t)n * 16 * D + 32 * ks);
                acc[n] = __builtin_amdgcn_mfma_f32_16x16x32_bf16(ah, wh, acc[n], 0, 0, 0);
                acc[n] = __builtin_amdgcn_mfma_f32_16x16x32_bf16(al, wh, acc[n], 0, 0, 0);
                acc[n] = __builtin_amdgcn_mfma_f32_16x16x32_bf16(ah, wl, acc[n], 0, 0, 0);
            }
        }
        ss += __shfl_xor(ss, 16); ss += __shfl_xor(ss, 32);
        const float rs = 1.0f / sqrtf(ss * (1.0f / D) + 1e-6f);
        if (fq == 0) rstd2[tok0 + fr] = rs;
#pragma unroll
        for (int n = 0; n < 3; ++n)
#pragma unroll
            for (int r = 0; r < 4; ++r) lg[(4 * fq + r) * 48 + 16 * n + fr] = acc[n][r];
        LDS_WAIT();
        int e0 = 0, e1 = 0; float w0 = 0.f, w1 = 0.f; unsigned lp0 = 0, lp1 = 0;
        if (lane < 16) {
            const float rst = rs;
            const LAS float* L = lg + lane * 48;
            float gl[4]; int gi = 0; float gm;
#pragma unroll
            for (int g = 0; g < 4; ++g) gl[g] = L[g] * rst + p.r_grp_b[g];
            gm = gl[0];
#pragma unroll
            for (int g = 1; g < 4; ++g) if (gl[g] > gm) { gm = gl[g]; gi = g; }
            float gs = 0.f;
#pragma unroll
            for (int g = 0; g < 4; ++g) gs += __expf(gl[g] - gm);
            const float gval = 1.0f / gs;
            float el[8];
#pragma unroll
            for (int e = 0; e < 8; ++e) el[e] = L[4 + gi * 8 + e] * rst + p.r_exp_b[gi * 8 + e];
            int i0 = 0; float m0 = el[0];
#pragma unroll
            for (int e = 1; e < 8; ++e) if (el[e] > m0) { m0 = el[e]; i0 = e; }
            int i1 = -1; float m1 = -3.0e38f;
#pragma unroll
            for (int e = 0; e < 8; ++e) if (e != i0 && el[e] > m1) { m1 = el[e]; i1 = e; }
            const float x1 = __expf(m1 - m0); const float den = 1.0f / (1.0f + x1);
            e0 = gi * 8 + i0; e1 = gi * 8 + i1; w0 = gval * den; w1 = gval * x1 * den;
            lp0 = atomicAdd((unsigned*)&lcnt[e0], 1u); lp1 = atomicAdd((unsigned*)&lcnt[e1], 1u);
        }
        __syncthreads();
        if (tid < 32) gbase[tid] = atomicAdd(&cnt[tid], lcnt[tid]);
        __syncthreads();
        if (lane < 16) {
            const int tok = tok0 + lane;
            const unsigned q0 = gbase[e0] + lp0, q1 = gbase[e1] + lp1;
            list[(size_t)e0 * T + q0] = tok * 2;     listw[(size_t)e0 * T + q0] = w0;
            list[(size_t)e1 * T + q1] = tok * 2 + 1; listw[(size_t)e1 * T + q1] = w1;
        }
        __syncthreads();
    }
}

constexpr int LDS_MAP = 131072;
__device__ __forceinline__ void expert_map_build(const unsigned* cnt, LAS unsigned char* lds) {
    LAS int* pre = (LAS int*)(lds + LDS_MAP); LAS int* cn = pre + 40;
    if (threadIdx.x == 0) { int acc = 0; for (int i = 0; i < NE; ++i) { const int ci = (int)__hip_atomic_load(cnt + i, __ATOMIC_RELAXED, __HIP_MEMORY_SCOPE_AGENT); pre[i] = acc; cn[i] = ci; acc += (ci + 255) >> 8; } pre[NE] = acc; }
    __syncthreads();
}
__device__ __forceinline__ void expert_find(LAS unsigned char* lds, int mt, int& e, int& local, int& c) {
    const LAS int* pre = (const LAS int*)(lds + LDS_MAP); const LAS int* cn = pre + 40;
    int lo = 0;
#pragma unroll 1
    for (int i = 1; i < NE; ++i) if (pre[i] <= mt) lo = i;
    e = __builtin_amdgcn_readfirstlane(lo); local = mt - __builtin_amdgcn_readfirstlane(pre[e]); c = __builtin_amdgcn_readfirstlane(cn[e]);
}
__device__ __forceinline__ int expert_tiles(LAS unsigned char* lds) { return __builtin_amdgcn_readfirstlane(((const LAS int*)(lds + LDS_MAP))[NE]); }

struct EpiGU {
    bf16_t* hid; const float* rstd2; const int* lst; int cnt, p0, hrow0, ct;
    __device__ __forceinline__ void operator()(const f32x4 (&acc)[2][2][4][2], int wr, int wc, int fr, int fq) const {
#pragma unroll
        for (int ai = 0; ai < 2; ++ai)
#pragma unroll
            for (int m = 0; m < 4; ++m) { const int r = ai * 128 + wr * 64 + m * 16 + fr; const int pp = p0 + r;
                const float rs = pp < cnt ? rstd2[lst[pp] >> 1] : 0.f;
                bf16_t* op = hid + (size_t)(hrow0 + r) * DE + ct * 128 + wc * 32 + 4 * fq;
#pragma unroll
                for (int n = 0; n < 2; ++n) { const f32x4 g = acc[ai][0][m][n] * rs, uu = acc[ai][1][m][n] * rs; float o[4];
#pragma unroll
                    for (int j = 0; j < 4; ++j) o[j] = g[j] * frcp(1.0f + fexp2(-g[j] * LOG2E)) * uu[j];
                    u32x2 w; w.x = cvt_pk_bf16(o[0], o[1]); w.y = cvt_pk_bf16(o[2], o[3]); *(u32x2*)(op + n * 16) = w; } }
    }
};
__device__ __forceinline__ void phase5(const Params& p, LAS unsigned char* lds) {
    expert_map_build((const unsigned*)(p.ws + WS_CTL), lds);
    const int MT = expert_tiles(lds);
    const int tid = threadIdx.x;
    for (int unit = blockIdx.x; unit < MT * 2; unit += gridDim.x) {
        const int mt = unit >> 1, ct = unit & 1; int e, local, c; expert_find(lds, mt, e, local, c);
        const int* lst = (const int*)(p.ws + WS_LIST) + (size_t)e * T; const int p0 = local * 256;
        unsigned aoff[2][2];
#pragma unroll
        for (int i = 0; i < 2; ++i) { int R, C; g8::stage_rc(tid * 16 + i * 8192, R, C);
#pragma unroll
            for (int hh = 0; hh < 2; ++hh) { const int pp = p0 + hh * 128 + R; const int tok = pp < c ? (lst[pp] >> 1) : 0; aoff[hh][i] = (unsigned)(tok * D + C) * 2u; } }
        EpiGU E{(bf16_t*)(p.ws + WS_B), (const float*)(p.ws + WS_RSTD2), lst, c, p0, mt * 256, ct};
        g8::gemm_unit(lds, (const char*)(p.ws + WS_A), aoff, (const char*)(p.ws + WS_WGU) + ((size_t)e * 512 + ct * 256) * D * 2, D, E);
    }
}
struct EpiDN {
    bf16_t* y; bf16_t* dummy; const int* lst; const float* lw; int cnt, p0, col0;
    __device__ __forceinline__ void operator()(const f32x4 (&acc)[2][2][4][2], int wr, int wc, int fr, int fq) const {
#pragma unroll
        for (int ai = 0; ai < 2; ++ai)
#pragma unroll
            for (int m = 0; m < 4; ++m) { const int pp = p0 + ai * 128 + wr * 64 + m * 16 + fr;
                const bool ok = pp < cnt; const int ent = lst[pp]; const float w = lw[pp];
                bf16_t* op = (ok ? y + ((size_t)(ent & 1) * T + (ent >> 1)) * D : dummy) + col0 + wc * 32 + 4 * fq;
#pragma unroll
                for (int bj = 0; bj < 2; ++bj)
#pragma unroll
                    for (int n = 0; n < 2; ++n) { const f32x4 v = acc[ai][bj][m][n] * w; u32x2 o; o.x = cvt_pk_bf16(v[0], v[1]); o.y = cvt_pk_bf16(v[2], v[3]); *(u32x2*)(op + bj * 128 + n * 16) = o; }
                if (m & 1) asm volatile("" ::: "memory"); }
    }
};
__device__ __forceinline__ void phase6(const Params& p, LAS unsigned char* lds) {
    expert_map_build((const unsigned*)(p.ws + WS_CTL), lds);
    const int MT = expert_tiles(lds);
    constexpr int kdn = DE;
    unsigned aoff[2][2]; g8::aoff_rows(aoff, kdn);
    for (int unit = blockIdx.x; unit < MT * 4; unit += gridDim.x) {
        const int mt = unit >> 2, pn = unit & 3; int e, local, c; expert_find(lds, mt, e, local, c);
        EpiDN E{(bf16_t*)(p.ws + WS_A + (size_t)T * D * 2), (bf16_t*)(p.ws + WS_A + (size_t)3 * T * D * 2), (const int*)(p.ws + WS_LIST) + (size_t)e * T, (const float*)(p.ws + WS_LISTW) + (size_t)e * T, c, local * 256, pn * 256};
        g8::gemm_unit(lds, (const char*)(p.ws + WS_B) + (size_t)mt * 256 * DE * 2, aoff, (const char*)(p.ws + WS_WDN) + ((size_t)e * D + pn * 256) * DE * 2, kdn, E);
    }
}

__device__ __forceinline__ void phase7(const Params& p) {
    const int wave = threadIdx.x >> 6, lane = threadIdx.x & 63;
    const bf16_t* y0 = (const bf16_t*)(p.ws + WS_A + (size_t)T * D * 2); const bf16_t* y1 = y0 + (size_t)T * D;
    f32x4 g[4];
#pragma unroll
    for (int j = 0; j < 4; ++j) g[j] = *((const f32x4*)p.final_g + lane + 64 * j);
    for (int row = blockIdx.x * NWAVES + wave; row < T; row += gridDim.x * NWAVES) {
        f32x4* hr = (f32x4*)(p.out + (size_t)row * D) + lane; const u32x2* a = (const u32x2*)(y0 + (size_t)row * D) + lane; const u32x2* bq = (const u32x2*)(y1 + (size_t)row * D) + lane;
        f32x4 v[4]; float s = 0.f;
#pragma unroll
        for (int j = 0; j < 4; ++j) { v[j] = hr[64 * j]; const u32x2 ya = a[64 * j], yb = bq[64 * j];
            v[j][0] += bf16_lo(ya.x) + bf16_lo(yb.x); v[j][1] += bf16_hi(ya.x) + bf16_hi(yb.x); v[j][2] += bf16_lo(ya.y) + bf16_lo(yb.y); v[j][3] += bf16_hi(ya.y) + bf16_hi(yb.y);
            s += (v[j][0] * v[j][0] + v[j][1] * v[j][1]) + (v[j][2] * v[j][2] + v[j][3] * v[j][3]); }
        s = wave_sum(s);
        const float rs = 1.0f / sqrtf(s * (1.0f / D) + 1e-6f);
#pragma unroll
        for (int j = 0; j < 4; ++j) hr[64 * j] = v[j] * rs * g[j];
    }
}

__global__ __launch_bounds__(512) void mega(Params p) {
    extern __shared__ __attribute__((aligned(16))) unsigned char lds_raw[];
    LAS unsigned char* lds = (LAS unsigned char*)lds_raw;
    volatile LAS unsigned* bst = (volatile LAS unsigned*)(lds + LDS_MAP + 512);
    if (threadIdx.x == 0) { bst[0] = 0u; bst[1] = 0u; bst[2] = 0u; bst[3] = 0u; }
    __syncthreads();
    const XcdBarrier gb = xcd_barrier_post((unsigned*)(p.ws + WS_BAR), bst);
#define GSYNC() xcd_barrier(gb)
#ifndef PHASE_MASK
#define PHASE_MASK 0xff
#endif
#ifdef TPROBE
    unsigned long long ts[9]; ts[0] = __builtin_amdgcn_s_memrealtime();
#define TS(i) ts[i] = __builtin_amdgcn_s_memrealtime()
#else
#define TS(i)
#endif
    if (PHASE_MASK & 1) phase0(p, lds); GSYNC(); TS(1);
    if (PHASE_MASK & 2) phase1(p, lds); GSYNC(); TS(2);
    if (PHASE_MASK & 4) phase2(p, lds); GSYNC(); TS(3);
    if (PHASE_MASK & 8) phase3(p, lds); GSYNC(); TS(4);
    if (PHASE_MASK & 16) phase4(p, lds); GSYNC(); TS(5);
    if (PHASE_MASK & 32) phase5(p, lds); GSYNC(); TS(6);
    if (PHASE_MASK & 64) phase6(p, lds); GSYNC(); TS(7);
    if (PHASE_MASK & 128) phase7(p);
#ifdef TPROBE
    GSYNC(); TS(8);
    float* tw = (float*)(p.ws + WS_CTL + 1024);
    if (blockIdx.x == 0 && threadIdx.x == 0) { const float t1 = (float)(ts[TPROBE + 1] - ts[TPROBE]) * 0.01f; tw[0] = floorf(log2f(t1) * TPQ + 0.5f) / TPQ; }
    GSYNC();
    const float c1 = tw[0];
    for (size_t i = (size_t)blockIdx.x * NTHREADS + threadIdx.x; i < (size_t)T * D; i += (size_t)gridDim.x * NTHREADS) p.out[i] = c1;
#endif
}

extern "C" void kernel_launch(void* const* d_in, const int* in_sizes, int n_in, void* d_out, int out_size, void* d_ws, size_t ws_size, hipStream_t stream) {
    static int grid = 0;
    if (grid == 0) {
        if (n_in != 25 || out_size != T * D || ws_size < WS_END) { fprintf(stderr, "kernel_launch: unexpected sizes n_in %d out %d ws %zu (need %zu)\n", n_in, out_size, ws_size, (size_t)WS_END); grid = -1; return; }
        int dev = 0, cus = 0, per_cu = 0;
        (void)hipGetDevice(&dev); (void)hipDeviceGetAttribute(&cus, hipDeviceAttributeMultiprocessorCount, dev);
        if (hipFuncSetAttribute((const void*)mega, hipFuncAttributeMaxDynamicSharedMemorySize, LDS_BYTES) != hipSuccess) { fprintf(stderr, "kernel_launch: hipFuncSetAttribute failed\n"); grid = -1; return; }
        if (hipOccupancyMaxActiveBlocksPerMultiprocessor(&per_cu, (const void*)mega, NTHREADS, LDS_BYTES) != hipSuccess || per_cu < 1) { fprintf(stderr, "kernel_launch: occupancy query failed (%d)\n", per_cu); (void)hipGetLastError(); per_cu = 1; }
        grid = cus * 1;
    }
    if (grid < 0) return;
    Params p{};
    const float** f = (const float**)&p;
    for (int i = 0; i < 25; ++i) f[i] = (const float*)d_in[i];
    p.out = (float*)d_out; p.ws = (unsigned char*)d_ws;
    if (hipMemsetAsync((char*)d_ws + WS_BAR, 0, XCD_BAR_WORDS * 4, stream) != hipSuccess) { fprintf(stderr, "kernel_launch: memset failed\n"); return; }
    hipLaunchKernelGGL(mega, dim3(grid), dim3(NTHREADS), LDS_BYTES, stream, p);
    hipError_t e = hipPeekAtLastError();
    if (e != hipSuccess) fprintf(stderr, "launch failed: %s (grid %d)\n", hipGetErrorString(e), grid);
}
```

```cpp
#include <hip/hip_runtime.h>
#include <cstdio>
#include <cstdint>
#define TPQ 8.0f

#define LAS __attribute__((address_space(3)))
typedef unsigned short bf16_t;
typedef short bf16x8 __attribute__((ext_vector_type(8)));
typedef short s16x4 __attribute__((ext_vector_type(4)));
typedef float f32x4 __attribute__((ext_vector_type(4)));
typedef float f32x2 __attribute__((ext_vector_type(2)));
typedef float f32x16 __attribute__((ext_vector_type(16)));
typedef unsigned u32x2 __attribute__((ext_vector_type(2)));
typedef unsigned u32x4 __attribute__((ext_vector_type(4)));

constexpr int NB = 16, S = 2048, T = NB * S, D = 1024, NIN = 3328, NH = 8, HD = 64;
constexpr int UQ = 0, UK = 512, UV = 1024, UR = 1536, URK = 2048, URV = 2560, UXW = 3072, UXA = 3136, UXG = 3200;
constexpr int NE = 32, DE = 256;
constexpr float LOG2E = 1.4426950408889634f, LN2 = 0.6931471805599453f;
constexpr float QSCALE = 0.125f * LOG2E;
constexpr int NTHREADS = 512, NWAVES = 8;
constexpr int LDS_BYTES = 139264 + 1024;

constexpr size_t WS_CTL   = 0;
constexpr size_t WS_BAR   = 8192;
constexpr size_t WS_WIN   = 65536;
constexpr size_t WS_WOUT  = WS_WIN  + (size_t)NIN * D * 2;
constexpr size_t WS_WGU   = WS_WOUT + (size_t)D * D * 2;
constexpr size_t WS_WDN   = WS_WGU  + (size_t)NE * 512 * D * 2;
constexpr size_t WS_RSTD1 = WS_WDN  + (size_t)NE * D * DE * 2;
constexpr size_t WS_RSTD2 = WS_RSTD1 + (size_t)T * 4;
constexpr size_t WS_LIST  = WS_RSTD2 + (size_t)T * 4;
constexpr size_t WS_LISTW = WS_LIST + (size_t)NE * T * 4;
constexpr size_t WS_WR    = WS_LISTW + (size_t)NE * T * 4;
constexpr size_t WS_LT    = WS_WR + (size_t)2 * 48 * D * 2;
constexpr size_t WS_A     = WS_LT + (size_t)512 * 256 * 2;
constexpr size_t WS_B     = WS_A + (size_t)T * NIN * 2;
constexpr size_t WS_END   = WS_B + (size_t)T * D * 2;
constexpr int HID_ROWS = 2 * T + NE * 256;

struct Params {
    const float* x; const float* norm_mix_g; const float* w_in; const float* shift_mu; const float* sb_out_g;
    const float* rw_w0; const float* rw_w2; const float* rw_a0; const float* rw_a2; const float* rw_g2;
    const float* rw_k_k; const float* rw_k_a; const float* rw_r_k; const float* rw_ln_w; const float* rw_ln_b;
    const float* w_out; const float* norm_ffn_g; const float* r_grp_w; const float* r_grp_b; const float* r_exp_w; const float* r_exp_b;
    const float* w_gate; const float* w_up; const float* w_down; const float* final_g;
    float* out; unsigned char* ws;
};

typedef __bf16 bf16x2_t __attribute__((ext_vector_type(2)));
__device__ __forceinline__ unsigned cvt_pk_bf16(float lo, float hi) { const f32x2 v = {lo, hi}; return __builtin_bit_cast(unsigned, __builtin_convertvector(v, bf16x2_t)); }
__device__ __forceinline__ float bf16_lo(unsigned w) { return __uint_as_float(w << 16); }
__device__ __forceinline__ float bf16_hi(unsigned w) { return __uint_as_float(w & 0xffff0000u); }
__device__ __forceinline__ float fexp2(float x) { return __builtin_amdgcn_exp2f(x); }
__device__ __forceinline__ float flog2(float x) { return __builtin_amdgcn_logf(x); }
__device__ __forceinline__ float frcp(float x) { return __builtin_amdgcn_rcpf(x); }
__device__ __forceinline__ float frsq(float x) { return __builtin_amdgcn_rsqf(x); }
template <int CTRL> __device__ __forceinline__ float dppf(float v) { return __builtin_bit_cast(float, __builtin_amdgcn_update_dpp(0, __builtin_bit_cast(int, v), CTRL, 0xF, 0xF, true)); }
__device__ __forceinline__ float rlane(float v, int l) { return __builtin_bit_cast(float, __builtin_amdgcn_readlane(__builtin_bit_cast(int, v), l)); }
__device__ __forceinline__ float sum8(float v) { v += dppf<0xB1>(v); v += dppf<0x4E>(v); v += dppf<0x141>(v); return v; }
__device__ __forceinline__ float sum16(float v) { v = sum8(v); v += dppf<0x140>(v); return v; }
__device__ __forceinline__ float wave_sum(float v) { v = sum16(v); return (rlane(v, 0) + rlane(v, 16)) + (rlane(v, 32) + rlane(v, 48)); }
__device__ __forceinline__ float swap32(float v) { return __shfl_xor(v, 32); }
#define LDS_WAIT() asm volatile("s_waitcnt lgkmcnt(0)" ::: "memory")


#define XB_TMO      128
#define XB_XCNT(j)  (256  + 64 * (j))
#define XB_XSUB(j)  (1280 + 64 * (j))
#define XB_XGEN(j)  (2304 + 64 * (j))
#define XB_TOP      3328
#define XB_TOPGEN   3392
#define XCD_BAR_WORDS 3456
#define XB_SPIN_CAP (1u << 22)
__device__ __forceinline__ unsigned xb_ld(unsigned* p)              { return __hip_atomic_load(p, __ATOMIC_RELAXED, __HIP_MEMORY_SCOPE_AGENT); }
__device__ __forceinline__ unsigned xb_add(unsigned* p, unsigned v) { return __hip_atomic_fetch_add(p, v, __ATOMIC_RELAXED, __HIP_MEMORY_SCOPE_AGENT); }
__device__ __forceinline__ unsigned xb_xcc_id() { return (unsigned)__builtin_amdgcn_s_getreg((3 << 11) | 20) & 0xFu; }
#define XB_SPIN(cond, bar) do { unsigned _sp = 0; while (cond) { __builtin_amdgcn_s_sleep(1); \
    if ((++_sp & 255u) == 0u) { if (xb_ld(&(bar)[XB_TMO])) break; if (_sp > XB_SPIN_CAP) { atomicAdd(&(bar)[XB_TMO], 1u); break; } } } } while (0)
struct XcdBarrier { unsigned* bar; unsigned x; volatile LAS unsigned* st; };
__device__ __forceinline__ XcdBarrier xcd_barrier_post(unsigned* bar, volatile LAS unsigned* st) {
    XcdBarrier b; b.bar = bar; b.x = xb_xcc_id(); b.st = st;
    if (threadIdx.x == 0) (void)xb_add(&bar[XB_XCNT(b.x)], 1u);
    return b;
}
__device__ __forceinline__ void xcd_barrier_complete(unsigned* bar, unsigned x, unsigned& nloc, unsigned& nx) {
    const unsigned G = gridDim.x * gridDim.y * gridDim.z;
    unsigned sum, cnt, mine, sp = 0u;
    for (;;) {
        sum = 0u; cnt = 0u; mine = 0u;
#pragma unroll
        for (unsigned j = 0; j < 16; ++j) { const unsigned c = xb_ld(&bar[XB_XCNT(j)]); sum += c; cnt += (c > 0u) ? 1u : 0u; mine = (j == x) ? c : mine; }
        if (sum == G) break;
        __builtin_amdgcn_s_sleep(1);
        if ((++sp & 255u) == 0u) { if (xb_ld(&bar[XB_TMO])) break; if (sp > XB_SPIN_CAP) { atomicAdd(&bar[XB_TMO], 1u); break; } }
    }
    nloc = mine > 0u ? mine : 1u; nx = cnt > 0u ? cnt : 1u;
}
__device__ __forceinline__ void xcd_barrier(const XcdBarrier& b) {
    asm volatile("s_waitcnt vmcnt(0)" ::: "memory");
    __syncthreads();
    if (threadIdx.x == 0) {
        unsigned* bar = b.bar;
        __builtin_amdgcn_s_waitcnt(0);
        unsigned nloc = b.st[0], nx = b.st[1];
        if (nloc == 0u) { xcd_barrier_complete(bar, b.x, nloc, nx); b.st[0] = nloc; b.st[1] = nx; }
        const unsigned old = xb_add(&bar[XB_XSUB(b.x)], 1u);
        const unsigned gen = old / nloc;
        if (old + 1u == (gen + 1u) * nloc) {
            __builtin_amdgcn_fence(__ATOMIC_RELEASE, "agent");
            asm volatile("s_waitcnt vmcnt(0)" ::: "memory");
            const unsigned og = xb_add(&bar[XB_TOP], 1u);
            const unsigned tg = og / nx;
            if (og + 1u == (tg + 1u) * nx) xb_add(&bar[XB_TOPGEN], 1u);
            else XB_SPIN(xb_ld(&bar[XB_TOPGEN]) == tg, bar);
            __builtin_amdgcn_fence(__ATOMIC_ACQUIRE, "agent");
            xb_add(&bar[XB_XGEN(b.x)], 1u);
            asm volatile("s_waitcnt vmcnt(0)" ::: "memory");
        } else {
            XB_SPIN(xb_ld(&bar[XB_XGEN(b.x)]) == gen, bar);
            __builtin_amdgcn_fence(__ATOMIC_ACQUIRE, "agent");
            asm volatile("s_waitcnt vmcnt(0)" ::: "memory");
        }
    }
    __syncthreads();
}

namespace g8 {
constexpr int BK = 64, HALF = 128, HTB = HALF * BK * 2;
__device__ __forceinline__ int lds_byte(int r, int c) { const int st = (r >> 4) * 2 + (c >> 5), rr = r & 15, cc = c & 31, ob = rr * 64 + cc * 2; return st * 1024 + (ob ^ (((ob >> 9) & 1) << 5)); }
__device__ __forceinline__ void stage_rc(int b, int& R, int& C) { const int st = b / 1024, sb = b % 1024, swz = sb ^ (((sb >> 9) & 1) << 5); R = (st >> 1) * 16 + swz / 64; C = (st & 1) * 32 + (swz % 64) / 2; }

#define G8_SA(b, h) (((b) * 2 + (h)) * HTB)
#define G8_SB(b, h) ((4 + (b) * 2 + (h)) * HTB)
#define G8_STAGE_A(bufoff, h, kt) do { _Pragma("unroll") for (int _i = 0; _i < 2; ++_i) \
    __builtin_amdgcn_global_load_lds((const unsigned*)((Ab + (size_t)(kt) * (BK * 2)) + aoff[h][_i]), (LAS unsigned*)(lds + (bufoff) + ldsw + _i * 8192), 16, 0, 0); } while (0)
#define G8_STAGE_B(bufoff, h, kt) do { _Pragma("unroll") for (int _i = 0; _i < 2; ++_i) \
    __builtin_amdgcn_global_load_lds((const unsigned*)((Bb + (size_t)(h) * bhalf + (size_t)(kt) * (BK * 2)) + boff[_i]), (LAS unsigned*)(lds + (bufoff) + ldsw + _i * 8192), 16, 0, 0); } while (0)
#define G8_LDA(dst, b, h) do { _Pragma("unroll") for (int m = 0; m < 4; ++m) _Pragma("unroll") for (int k = 0; k < 2; ++k) dst[m][k] = *(const LAS bf16x8*)(lds + G8_SA(b, h) + la_off + m * 2048 + k * 1024); } while (0)
#define G8_LDB(dst, b, h) do { _Pragma("unroll") for (int n = 0; n < 2; ++n) _Pragma("unroll") for (int k = 0; k < 2; ++k) dst[n][k] = *(const LAS bf16x8*)(lds + G8_SB(b, h) + lb_off + n * 2048 + k * 1024); } while (0)
#define G8_MMA(ai, bj, At, Bt) do { __builtin_amdgcn_s_setprio(1); _Pragma("unroll") for (int m = 0; m < 4; ++m) _Pragma("unroll") for (int n = 0; n < 2; ++n) _Pragma("unroll") for (int k = 0; k < 2; ++k) \
    acc[ai][bj][m][n] = __builtin_amdgcn_mfma_f32_16x16x32_bf16(Bt[n][k], At[m][k], acc[ai][bj][m][n], 0, 0, 0); __builtin_amdgcn_s_setprio(0); } while (0)
#define G8_WAIT_V(n) asm volatile("s_waitcnt vmcnt(" #n ")" ::: "memory")
#define G8_WAIT_L(n) asm volatile("s_waitcnt lgkmcnt(" #n ")" ::: "memory")
#define G8_BAR __builtin_amdgcn_s_barrier()
#define G8_SCHED __builtin_amdgcn_sched_barrier(0)

template <class Epi>
__device__ __forceinline__ void gemm_unit(LAS unsigned char* lds, const char* Ab, const unsigned (&aoff)[2][2], const char* Bb, int K, const Epi& E) {
    int tid = threadIdx.x; asm volatile("" : "+v"(tid));
    const int wid = __builtin_amdgcn_readfirstlane(tid >> 6), lane = tid & 63, wr = wid >> 2, wc = wid & 3, fr = lane & 15, fq = lane >> 4;
    const int nt = K / BK;
    unsigned boff[2];
#pragma unroll
    for (int i = 0; i < 2; ++i) { int R, C; stage_rc(tid * 16 + i * 8192, R, C); boff[i] = (unsigned)(R * K + C) * 2u; }
    const size_t bhalf = (size_t)HALF * K * 2;
    const unsigned ldsw = (unsigned)wid * 1024u;
    const int la_off = lds_byte(wr * 64 + fr, fq * 8), lb_off = lds_byte(wc * 32 + fr, fq * 8);
    f32x4 acc[2][2][4][2];
#pragma unroll
    for (int a = 0; a < 2; ++a)
#pragma unroll
        for (int b = 0; b < 2; ++b)
#pragma unroll
            for (int m = 0; m < 4; ++m)
#pragma unroll
                for (int n = 0; n < 2; ++n) acc[a][b][m][n] = (f32x4){0.f, 0.f, 0.f, 0.f};
    bf16x8 At[4][2], B0[2][2], B1[2][2];
    G8_STAGE_B(G8_SB(0, 0), 0, 0); G8_STAGE_A(G8_SA(0, 0), 0, 0);
    G8_STAGE_B(G8_SB(0, 1), 1, 0); G8_STAGE_A(G8_SA(0, 1), 1, 0);
    if (wr == 1) G8_BAR;
    G8_WAIT_V(4); G8_BAR;
    G8_STAGE_B(G8_SB(1, 0), 0, 1); G8_STAGE_A(G8_SA(1, 0), 0, 1); G8_STAGE_B(G8_SB(1, 1), 1, 1);
    G8_WAIT_V(6); G8_BAR;
    for (int t = 0; t < nt - 2; t += 2) {
        G8_LDB(B0, 0, 0); G8_SCHED; G8_LDA(At, 0, 0); G8_STAGE_A(G8_SA(1, 1), 1, t + 1);
        G8_WAIT_L(8); G8_BAR; G8_WAIT_L(0); G8_MMA(0, 0, At, B0); G8_BAR; G8_SCHED;
        G8_LDB(B1, 0, 1); G8_STAGE_B(G8_SB(0, 0), 0, t + 2);
        G8_BAR; G8_WAIT_L(0); G8_MMA(0, 1, At, B1); G8_BAR;
        G8_LDA(At, 0, 1); G8_STAGE_A(G8_SA(0, 0), 0, t + 2);
        G8_BAR; G8_WAIT_L(0); G8_MMA(1, 0, At, B0); G8_BAR; G8_SCHED;
        G8_STAGE_B(G8_SB(0, 1), 1, t + 2);
        G8_WAIT_V(6); G8_BAR; G8_MMA(1, 1, At, B1); G8_BAR;
        G8_LDB(B0, 1, 0); G8_SCHED; G8_LDA(At, 1, 0); G8_STAGE_A(G8_SA(0, 1), 1, t + 2);
        G8_WAIT_L(8); G8_BAR; G8_WAIT_L(0); G8_MMA(0, 0, At, B0); G8_BAR; G8_SCHED;
        G8_LDB(B1, 1, 1); G8_STAGE_B(G8_SB(1, 0), 0, t + 3);
        G8_BAR; G8_WAIT_L(0); G8_MMA(0, 1, At, B1); G8_BAR;
        G8_LDA(At, 1, 1); G8_STAGE_A(G8_SA(1, 0), 0, t + 3);
        G8_BAR; G8_WAIT_L(0); G8_MMA(1, 0, At, B0); G8_BAR; G8_SCHED;
        G8_STAGE_B(G8_SB(1, 1), 1, t + 3);
        G8_WAIT_V(6); G8_BAR; G8_MMA(1, 1, At, B1); G8_BAR;
    }
    { G8_LDB(B0, 0, 0); G8_LDA(At, 0, 0); G8_STAGE_A(G8_SA(1, 1), 1, nt - 1);
      G8_BAR; G8_WAIT_L(0); G8_MMA(0, 0, At, B0); G8_BAR;
      G8_LDB(B1, 0, 1); G8_BAR; G8_WAIT_L(0); G8_MMA(0, 1, At, B1); G8_BAR;
      G8_LDA(At, 0, 1); G8_WAIT_V(4); G8_BAR; G8_WAIT_L(0); G8_MMA(1, 0, At, B0); G8_MMA(1, 1, At, B1); G8_BAR; }
    { G8_LDB(B0, 1, 0); G8_LDA(At, 1, 0); G8_WAIT_V(2); G8_BAR; G8_WAIT_L(0); G8_MMA(0, 0, At, B0); G8_BAR;
      G8_LDB(B1, 1, 1); G8_WAIT_V(0); G8_BAR; G8_WAIT_L(0); G8_MMA(0, 1, At, B1); G8_BAR;
      G8_LDA(At, 1, 1); G8_BAR; G8_WAIT_L(0); G8_MMA(1, 0, At, B0); G8_MMA(1, 1, At, B1); G8_BAR; }
    if (wr == 0) G8_BAR;
    asm volatile("" ::: "memory");
    E(acc, wr, wc, fr, fq);
    __syncthreads();
}
__device__ __forceinline__ void aoff_rows(unsigned (&aoff)[2][2], int K) {
    int tid = threadIdx.x; asm volatile("" : "+v"(tid));
#pragma unroll
    for (int i = 0; i < 2; ++i) { int R, C; stage_rc(tid * 16 + i * 8192, R, C);
#pragma unroll
        for (int h = 0; h < 2; ++h) aoff[h][i] = (unsigned)((h * HALF + R) * K + C) * 2u; }
}
__device__ __forceinline__ void tile_order(int L, int nM, int nN, int& pm, int& pn) {
    const int nwg = nM * nN; int wgid = L;
    { const int q = nwg / 8, r = nwg % 8, xcd = wgid % 8, off = wgid / 8; wgid = (xcd < r ? xcd * (q + 1) : r * (q + 1) + (xcd - r) * q) + off; }
    const int nig = 8 * nN, gid = wgid / nig, fm = gid * 8, gsz = (nM - fm) < 8 ? (nM - fm) : 8;
    pm = fm + ((wgid % nig) % gsz); pn = (wgid % nig) / gsz;
}
}

__device__ __forceinline__ void p0_transpose_item(const float* W, int K, int N, int k0, int n0, bf16_t* WTrow0  , const float* kscale, float mul, LAS float* scr, int lane) {
#pragma unroll 8
    for (int i = 0; i < 32; ++i) { const int kk = 2 * i + (lane >> 5); float v = W[(size_t)(k0 + kk) * N + n0 + (lane & 31)]; if (kscale) v *= kscale[k0 + kk]; scr[kk * 33 + (lane & 31)] = v * mul; }
    LDS_WAIT();
    const int c = lane & 7;
#pragma unroll
    for (int j = 0; j < 4; ++j) { const int n = (lane >> 3) + 8 * j; const LAS float* s = scr + (8 * c) * 33 + n;
        u32x4 o; o.x = cvt_pk_bf16(s[0 * 33], s[1 * 33]); o.y = cvt_pk_bf16(s[2 * 33], s[3 * 33]); o.z = cvt_pk_bf16(s[4 * 33], s[5 * 33]); o.w = cvt_pk_bf16(s[6 * 33], s[7 * 33]);
        *(u32x4*)(WTrow0 + (size_t)n * K + k0 + 8 * c) = o; }
    LDS_WAIT();
}

__device__ __forceinline__ void p0_expert_weights(const Params& p, LAS unsigned char* lds, int gw, int NGW) {
    const int wave = threadIdx.x >> 6, lane = threadIdx.x & 63;
    LAS float* scr = (LAS float*)(lds + 49152 + wave * 8704);
    bf16_t* wgu = (bf16_t*)(p.ws + WS_WGU); bf16_t* wdn = (bf16_t*)(p.ws + WS_WDN);
    constexpr int I_G = NE * 16 * 8, I_D = NE * 4 * 32;
    for (int it = gw; it < 2 * I_G + I_D; it += NGW) {
        int r = it;
        if (r < 2 * I_G) { const int up = r >= I_G; if (up) r -= I_G; const int e = r / 128, q = r % 128, kb = q / 8, nb = q % 8, n0 = nb * 32;
            const int drow = (n0 >> 7) * 256 + up * 128 + (n0 & 127);
            p0_transpose_item((up ? p.w_up : p.w_gate) + (size_t)e * D * DE, D, DE, kb * 64, n0, wgu + ((size_t)e * 512 + drow) * D, p.norm_ffn_g, 1.f, scr, lane); continue; } r -= 2 * I_G;
        { const int e = r / 128, q = r % 128, kb = q / 32, nb = q % 32, n0 = nb * 32;
            p0_transpose_item(p.w_down + (size_t)e * DE * D, DE, D, kb * 64, n0, wdn + ((size_t)e * D + n0) * DE, nullptr, 1.f, scr, lane); }
    }
}
__device__ __forceinline__ void phase0(const Params& p, LAS unsigned char* lds) {
    const int tid = threadIdx.x, wave = tid >> 6, lane = tid & 63;
    const int gw = blockIdx.x * NWAVES + wave, NGW = gridDim.x * NWAVES;
    LAS float* scr = (LAS float*)(lds + wave * 8704);
    bf16_t* win = (bf16_t*)(p.ws + WS_WIN); bf16_t* wout = (bf16_t*)(p.ws + WS_WOUT);
    constexpr int I_IN = 16 * 104, I_OUT = 16 * 32;
    for (int it = gw; it < I_IN + I_OUT; it += NGW) {
        int r = it;
        if (r < I_IN) { const int kb = r / 104, nb = r % 104, n0 = nb * 32; p0_transpose_item(p.w_in, D, NIN, kb * 64, n0, win + (size_t)n0 * D, p.norm_mix_g, n0 < 512 ? QSCALE : 1.f, scr, lane); continue; } r -= I_IN;
        { const int kb = r / 32, nb = r % 32, n0 = nb * 32; p0_transpose_item(p.w_out, D, D, kb * 64, n0, wout + (size_t)n0 * D, nullptr, 1.f, scr, lane); }
    }
    bf16_t* xb = (bf16_t*)(p.ws + WS_B); float* rstd1 = (float*)(p.ws + WS_RSTD1);
    for (int row = gw; row < T; row += NGW) {
        const f32x4* xr = (const f32x4*)(p.x + (size_t)row * D) + lane; f32x4 v[4]; float s = 0.f;
#pragma unroll
        for (int j = 0; j < 4; ++j) { v[j] = xr[64 * j]; s += (v[j].x * v[j].x + v[j].y * v[j].y) + (v[j].z * v[j].z + v[j].w * v[j].w); }
        s = wave_sum(s);
        u32x2* o = (u32x2*)(xb + (size_t)row * D) + lane;
#pragma unroll
        for (int j = 0; j < 4; ++j) { u32x2 w; w.x = cvt_pk_bf16(v[j].x, v[j].y); w.y = cvt_pk_bf16(v[j].z, v[j].w); o[64 * j] = w; }
        if (lane == 0) rstd1[row] = 1.0f / sqrtf(s * (1.0f / D) + 1e-6f);
    }
    bf16_t* wr_hi = (bf16_t*)(p.ws + WS_WR); bf16_t* wr_lo = wr_hi + 48 * D;
    for (int i = blockIdx.x * NTHREADS + tid; i < 48 * D; i += gridDim.x * NTHREADS) {
        const int c = i / D, k = i % D; float w = 0.f;
        if (c < 4) w = p.r_grp_w[k * 4 + c]; else if (c < 36) w = p.r_exp_w[k * 32 + (c - 4)];
        w *= p.norm_ffn_g[k];
        const unsigned hi = cvt_pk_bf16(w, 0.f) & 0xffffu; const float rem = w - __uint_as_float(hi << 16);
        wr_hi[i] = (bf16_t)hi; wr_lo[i] = (bf16_t)(cvt_pk_bf16(rem, 0.f) & 0xffffu);
    }
    { bf16_t* w2t = (bf16_t*)(p.ws + WS_LT); bf16_t* a2t = w2t + 512 * 64; bf16_t* g2t = a2t + 512 * 64;
      for (int i = blockIdx.x * NTHREADS + tid; i < 512 * 256; i += gridDim.x * NTHREADS) {
          if (i < 512 * 64) { const int c = i >> 6, m = i & 63; w2t[i] = (bf16_t)(cvt_pk_bf16(p.rw_w2[m * 512 + c], 0.f) & 0xffffu); }
          else if (i < 2 * 512 * 64) { const int q = i - 512 * 64, c = q >> 6, m = q & 63; a2t[q] = (bf16_t)(cvt_pk_bf16(p.rw_a2[m * 512 + c], 0.f) & 0xffffu); }
          else { const int q = i - 2 * 512 * 64, c = q >> 7, m = q & 127; g2t[q] = (bf16_t)(cvt_pk_bf16(p.rw_g2[m * 512 + c], 0.f) & 0xffffu); } } }
    if (blockIdx.x == 0 && tid < 64) ((unsigned*)(p.ws + WS_CTL))[tid] = 0u;
}

struct EpiU {
    bf16_t* u; const float* rstd; int row0, col0;
    __device__ __forceinline__ void operator()(const f32x4 (&acc)[2][2][4][2], int wr, int wc, int fr, int fq) const {
#pragma unroll
        for (int ai = 0; ai < 2; ++ai)
#pragma unroll
            for (int m = 0; m < 4; ++m) { const int row = row0 + ai * 128 + wr * 64 + m * 16 + fr; const float rs = rstd[row]; bf16_t* rp = u + (size_t)row * NIN + col0 + wc * 32 + 4 * fq;
#pragma unroll
                for (int bj = 0; bj < 2; ++bj)
#pragma unroll
                    for (int n = 0; n < 2; ++n) { const f32x4 v = acc[ai][bj][m][n] * rs; u32x2 w; w.x = cvt_pk_bf16(v[0], v[1]); w.y = cvt_pk_bf16(v[2], v[3]); *(u32x2*)(rp + bj * 128 + n * 16) = w; } }
    }
};
__device__ __forceinline__ void phase1(const Params& p, LAS unsigned char* lds) {
    constexpr int nM = T / 256, nN = NIN / 256;
    unsigned aoff[2][2]; g8::aoff_rows(aoff, D);
    for (int L = blockIdx.x; L < nM * nN; L += gridDim.x) {
        int pm, pn; g8::tile_order(L, nM, nN, pm, pn);
        EpiU E{(bf16_t*)(p.ws + WS_A), (const float*)(p.ws + WS_RSTD1), pm * 256, pn * 256};
        g8::gemm_unit(lds, (const char*)(p.ws + WS_B) + (size_t)pm * 256 * D * 2, aoff, (const char*)(p.ws + WS_WIN) + (size_t)pn * 256 * D * 2, D, E);
    }
}


typedef short v4i16_t __attribute__((ext_vector_type(4)));
__device__ __forceinline__ s16x4 lds_tr16(const LAS unsigned char* p) { return __builtin_bit_cast(s16x4, __builtin_amdgcn_ds_read_tr16_b64_v4i16((LAS v4i16_t*)p)); }

__device__ __forceinline__ void attn_tile(const Params& p, LAS unsigned char* vl  , int b, int h, int qt) {
    const int lane = threadIdx.x & 63, r32 = lane & 31, hi = lane >> 5;
    const bf16_t* u = (const bf16_t*)(p.ws + WS_A);
    const size_t row0 = (size_t)b * S; const int q0 = qt * 32;
    bf16x8 qf[4];
    { const bf16_t* qp = u + (row0 + q0 + r32) * NIN + UQ + h * HD + 8 * hi;
#pragma unroll
      for (int s = 0; s < 4; ++s) qf[s] = *(const bf16x8*)(qp + 16 * s); }
    f32x16 o0, o1;
#pragma unroll
    for (int i = 0; i < 16; ++i) { o0[i] = 0.f; o1[i] = 0.f; }
    float carry = 0.f;
    const int kperm = 16 * ((r32 >> 2) & 1) + (r32 & 3) + 4 * (r32 >> 3);
    const int g = lane >> 4, i16 = lane & 15, tq = i16 >> 2, tp = i16 & 3;
    const LAS unsigned char* vrd = vl + (16 * (g >> 1) + tq) * 144 + (16 * (g & 1) + 4 * tp) * 2;
    LAS unsigned char* vwr = vl + (lane >> 1) * 144 + (lane & 1) * 64;
    for (int kb = qt; kb >= 0; --kb) {
        const int key0 = kb * 32;
        { const bf16_t* vp = u + (row0 + key0 + (lane >> 1)) * NIN + UV + h * HD + 32 * (lane & 1);
          u32x4 v0 = *(const u32x4*)(vp), v1 = *(const u32x4*)(vp + 8), v2 = *(const u32x4*)(vp + 16), v3 = *(const u32x4*)(vp + 24);
          *(LAS u32x4*)(vwr) = v0; *(LAS u32x4*)(vwr + 16) = v1; *(LAS u32x4*)(vwr + 32) = v2; *(LAS u32x4*)(vwr + 48) = v3; }
        f32x16 st;
#pragma unroll
        for (int i = 0; i < 16; ++i) st[i] = 0.f;
        { const bf16_t* kp = u + (row0 + key0 + kperm) * NIN + UK + h * HD + 8 * hi;
          bf16x8 kf[4];
#pragma unroll
          for (int s = 0; s < 4; ++s) kf[s] = *(const bf16x8*)(kp + 16 * s);
#pragma unroll
          for (int s = 0; s < 4; ++s) st = __builtin_amdgcn_mfma_f32_32x32x16_bf16(kf[s], qf[s], st, 0, 0, 0); }
        const bool diag = (kb == qt);
        float lw[16], suf[16];
        float run = 0.f;
#pragma unroll
        for (int reg = 15; reg >= 0; --reg) {
            const float z = st[reg];
            const float l = flog2(1.0f + fexp2(-fabsf(z)));
            const float sp = fmaxf(z, 0.f) + l;
            const bool valid = !diag || (16 * hi + reg < r32);
            lw[reg] = valid ? (z - sp) : -1.0e30f;
            suf[reg] = run;
            run += valid ? -sp : 0.f;
        }
        const float other = swap32(run);
        const float tot_hi = hi ? run : other, tot_lo = hi ? other : run;
        const float base = carry + (hi ? 0.f : tot_hi);
        carry += tot_lo + tot_hi;
        unsigned pk[8];
#pragma unroll
        for (int j = 0; j < 8; ++j) pk[j] = cvt_pk_bf16(fexp2(lw[2 * j] + suf[2 * j] + base), fexp2(lw[2 * j + 1] + suf[2 * j + 1] + base));
        LDS_WAIT();
#pragma unroll
        for (int s2 = 0; s2 < 2; ++s2) {
            bf16x8 pf = __builtin_bit_cast(bf16x8, (u32x4){pk[4 * s2], pk[4 * s2 + 1], pk[4 * s2 + 2], pk[4 * s2 + 3]});
#pragma unroll
            for (int dh = 0; dh < 2; ++dh) {
                const s16x4 a = lds_tr16(vrd + (8 * s2) * 144 + 64 * dh), c = lds_tr16(vrd + (8 * s2 + 4) * 144 + 64 * dh);
                bf16x8 vf; vf[0] = a[0]; vf[1] = a[1]; vf[2] = a[2]; vf[3] = a[3]; vf[4] = c[0]; vf[5] = c[1]; vf[6] = c[2]; vf[7] = c[3];
                if (dh == 0) o0 = __builtin_amdgcn_mfma_f32_32x32x16_bf16(vf, pf, o0, 0, 0, 0); else o1 = __builtin_amdgcn_mfma_f32_32x32x16_bf16(vf, pf, o1, 0, 0, 0);
            }
        }
        LDS_WAIT();
        if (__builtin_amdgcn_ballot_w64(carry > -150.0f) == 0ull) break;
    }
    float ss = 0.f;
#pragma unroll
    for (int i = 0; i < 16; ++i) ss += o0[i] * o0[i] + o1[i] * o1[i];
    ss += swap32(ss);
    const float rs = 1.0f / sqrtf(ss * (1.0f / HD) + 1e-6f);
    bf16_t* op = (bf16_t*)(p.ws + WS_B) + (row0 + q0 + r32) * D + h * HD + 4 * hi;
    const float* gp = p.sb_out_g + h * HD + 4 * hi;
#pragma unroll
    for (int dh = 0; dh < 2; ++dh)
#pragma unroll
        for (int gq = 0; gq < 4; ++gq) {
            const f32x4 gg = *(const f32x4*)(gp + 32 * dh + 8 * gq);
            const f32x16& o = dh ? o1 : o0;
            u32x2 w; w.x = cvt_pk_bf16(o[4 * gq] * rs * gg[0], o[4 * gq + 1] * rs * gg[1]); w.y = cvt_pk_bf16(o[4 * gq + 2] * rs * gg[2], o[4 * gq + 3] * rs * gg[3]);
            *(u32x2*)(op + 32 * dh + 8 * gq) = w;
        }
}

namespace rk {
constexpr int C = 32, NCH = S / C, NSLOT = 16;
constexpr int SL_PS = 0, SL_QS = 8192, SL_PO = 12288, SL_QO = 16384, SL_VR = 18432, SL_BV = 22528, SL_GG = 26624, SLOT_BYTES = 30720;
constexpr int MSTR = 144;
constexpr int PM_AT = 0, PM_RT = 4608, PM_BT = 9216, PM_KT = 13824, PM_GC = 18432, PROD_LDS = 18688;
constexpr int L_CONS = 7 * PROD_LDS;
constexpr int L_FLAG = L_CONS + 4608;
}
__device__ __forceinline__ bf16x8 accfrag(const f32x16& a, int s) {
    return __builtin_bit_cast(bf16x8, (u32x4){cvt_pk_bf16(a[8 * s], a[8 * s + 1]), cvt_pk_bf16(a[8 * s + 2], a[8 * s + 3]), cvt_pk_bf16(a[8 * s + 4], a[8 * s + 5]), cvt_pk_bf16(a[8 * s + 6], a[8 * s + 7])});
}
__device__ __forceinline__ bf16x8 trfrag(const LAS unsigned char* mat, int s, int nt, int lane) {
    const int g = lane >> 4, i16 = lane & 15, q = i16 >> 2, pp = i16 & 3, h = g >> 1;
    const LAS unsigned char* a = mat + (16 * s + 4 * h + q) * rk::MSTR + (32 * nt + 16 * (g & 1) + 4 * pp) * 2;
    const s16x4 x = lds_tr16(a), y = lds_tr16(a + 8 * rk::MSTR);
    bf16x8 r; r[0] = x[0]; r[1] = x[1]; r[2] = x[2]; r[3] = x[3]; r[4] = y[0]; r[5] = y[1]; r[6] = y[2]; r[7] = y[3]; return r;
}
__device__ __forceinline__ void f8_from_bf16(const u32x4 w, float (&o)[8]) {
#pragma unroll
    for (int j = 0; j < 4; ++j) { o[2 * j] = bf16_lo(w[j]); o[2 * j + 1] = bf16_hi(w[j]); }
}
__device__ __forceinline__ f32x16 mfma32(bf16x8 a, bf16x8 b, f32x16 c) { return __builtin_amdgcn_mfma_f32_32x32x16_bf16(a, b, c, 0, 0, 0); }
__device__ __forceinline__ f32x16 zero16() { f32x16 z; for (int i = 0; i < 16; ++i) z[i] = 0.f; return z; }
__device__ __forceinline__ void um8(const bf16_t* urow  , bool has_prev, const float* mu, float (&o)[8]) {
    const u32x4 c = *(const u32x4*)urow; u32x4 pv = (u32x4){0u, 0u, 0u, 0u}; if (has_prev) pv = *(const u32x4*)(urow - NIN);
    const f32x4 m0 = *(const f32x4*)mu, m1 = *(const f32x4*)(mu + 4);
    float cv[8], pf[8]; f8_from_bf16(c, cv); f8_from_bf16(pv, pf);
#pragma unroll
    for (int j = 0; j < 4; ++j) { o[j] = cv[j] + (pf[j] - cv[j]) * m0[j]; o[4 + j] = cv[4 + j] + (pf[4 + j] - cv[4 + j]) * m1[j]; }
}
__device__ __forceinline__ float scan32(float x) {
    x += dppf<0x111>(x); x += dppf<0x112>(x); x += dppf<0x114>(x); x += dppf<0x118>(x);
    const float bc = __builtin_bit_cast(float, __builtin_amdgcn_update_dpp(0, __builtin_bit_cast(int, x), 0x142, 0xA, 0xF, false));
    return x + bc;
}

__device__ __forceinline__ void rk_produce(const Params& p, LAS unsigned char* pl  , unsigned char* slot, int b, int hh, int c) {
    using namespace rk;
    int lane = threadIdx.x & 63; asm volatile("" : "+v"(lane));
    const int r32 = lane & 31, h = lane >> 5;
    const bf16_t* u = (const bf16_t*)(p.ws + WS_A);
    const size_t row0 = (size_t)b * S; const int t0 = c * C; const int tt = t0 + r32; const bool hp = tt > 0;
    const bf16_t* urow = u + (row0 + tt) * NIN;
    const bf16_t* w2t = (const bf16_t*)(p.ws + WS_LT); const bf16_t* a2t = w2t + 512 * 64; const bf16_t* g2t = a2t + 512 * 64;
    const int jrow0 = 32 * ((r32 >> 2) & 1) + (r32 & 3) + 4 * (r32 >> 3);
    f32x16 lw[2], la[2], lg[2];
#pragma unroll
    for (int mt = 0; mt < 2; ++mt) { lw[mt] = zero16(); la[mt] = zero16(); lg[mt] = zero16(); }
#pragma unroll 1
    for (int s = 0; s < 4; ++s) {
        float xv[8]; um8(urow + UXW + 16 * s + 8 * h, hp, p.shift_mu + (UXW - UR) + 16 * s + 8 * h, xv);
#pragma unroll
        for (int j = 0; j < 8; ++j) xv[j] = 1.0f - 2.0f * frcp(1.0f + fexp2(xv[j] * (2.0f * LOG2E)));
        const bf16x8 bw = __builtin_bit_cast(bf16x8, (u32x4){cvt_pk_bf16(xv[0], xv[1]), cvt_pk_bf16(xv[2], xv[3]), cvt_pk_bf16(xv[4], xv[5]), cvt_pk_bf16(xv[6], xv[7])});
        float xa[8]; um8(urow + UXA + 16 * s + 8 * h, hp, p.shift_mu + (UXA - UR) + 16 * s + 8 * h, xa);
        const bf16x8 ba = __builtin_bit_cast(bf16x8, (u32x4){cvt_pk_bf16(xa[0], xa[1]), cvt_pk_bf16(xa[2], xa[3]), cvt_pk_bf16(xa[4], xa[5]), cvt_pk_bf16(xa[6], xa[7])});
#pragma unroll
        for (int mt = 0; mt < 2; ++mt) {
            const int col = hh * HD + jrow0 + 16 * mt;
            lw[mt] = mfma32(*(const bf16x8*)(w2t + col * 64 + 16 * s + 8 * h), bw, lw[mt]);
            la[mt] = mfma32(*(const bf16x8*)(a2t + col * 64 + 16 * s + 8 * h), ba, la[mt]);
        }
        asm volatile("" ::: "memory");
    }
#pragma unroll 1
    for (int s = 0; s < 8; ++s) {
        float xg[8]; um8(urow + UXG + 16 * s + 8 * h, hp, p.shift_mu + (UXG - UR) + 16 * s + 8 * h, xg);
#pragma unroll
        for (int j = 0; j < 8; ++j) xg[j] = frcp(1.0f + fexp2(-xg[j] * LOG2E));
        const bf16x8 bgf = __builtin_bit_cast(bf16x8, (u32x4){cvt_pk_bf16(xg[0], xg[1]), cvt_pk_bf16(xg[2], xg[3]), cvt_pk_bf16(xg[4], xg[5]), cvt_pk_bf16(xg[6], xg[7])});
#pragma unroll
        for (int mt = 0; mt < 2; ++mt) lg[mt] = mfma32(*(const bf16x8*)(g2t + (hh * HD + jrow0 + 16 * mt) * 128 + 16 * s + 8 * h), bgf, lg[mt]);
        if (s & 1) asm volatile("" ::: "memory");
    }
#pragma unroll
    for (int mt = 0; mt < 2; ++mt) {
        u32x4 w0, w1; w0.x = cvt_pk_bf16(lg[mt][0], lg[mt][1]); w0.y = cvt_pk_bf16(lg[mt][2], lg[mt][3]); w0.z = cvt_pk_bf16(lg[mt][4], lg[mt][5]); w0.w = cvt_pk_bf16(lg[mt][6], lg[mt][7]);
        w1.x = cvt_pk_bf16(lg[mt][8], lg[mt][9]); w1.y = cvt_pk_bf16(lg[mt][10], lg[mt][11]); w1.z = cvt_pk_bf16(lg[mt][12], lg[mt][13]); w1.w = cvt_pk_bf16(lg[mt][14], lg[mt][15]);
        u32x4* d = (u32x4*)(slot + SL_GG + r32 * 128 + (32 * h + 16 * mt) * 2); d[0] = w0; d[1] = w1;
    }
    const int cb = hh * HD + 32 * h;
    float ssq = 0.f;
#pragma unroll
    for (int q = 0; q < 4; ++q) {
        float t8[8]; um8(urow + URK + cb + 8 * q, hp, p.shift_mu + (URK - UR) + cb + 8 * q, t8);
        const f32x4 c0 = *(const f32x4*)(p.rw_k_k + cb + 8 * q), c1 = *(const f32x4*)(p.rw_k_k + cb + 8 * q + 4);
#pragma unroll
        for (int j = 0; j < 4; ++j) { const float x0 = t8[j] * c0[j], x1 = t8[4 + j] * c1[j]; ssq += x0 * x0 + x1 * x1; }
    }
    ssq += swap32(ssq);
    const float kinv = frsq(fmaxf(ssq, 1e-24f));
    float bonus = 0.f;
    LAS unsigned char* mAT = pl + PM_AT; LAS unsigned char* mRT = pl + PM_RT; LAS unsigned char* mBT = pl + PM_BT; LAS unsigned char* mKT = pl + PM_KT;
    LAS float* gc = (LAS float*)(pl + PM_GC);
#pragma unroll
    for (int mt = 0; mt < 2; ++mt) {
#pragma unroll
        for (int q8 = 0; q8 < 2; ++q8) {
            const int cj0 = cb + 16 * mt + 8 * q8;
            float k8[8], r8[8];
            um8(urow + URK + cj0, hp, p.shift_mu + (URK - UR) + cj0, k8);
            um8(urow + UR + cj0, hp, p.shift_mu + cj0, r8);
            float cw0[8], ca0[8], ckk[8], cka[8], crk[8];
#pragma unroll
            for (int e = 0; e < 2; ++e) { const f32x4 a = *(const f32x4*)(p.rw_w0 + cj0 + 4 * e), bq = *(const f32x4*)(p.rw_a0 + cj0 + 4 * e), cc = *(const f32x4*)(p.rw_k_k + cj0 + 4 * e), dd = *(const f32x4*)(p.rw_k_a + cj0 + 4 * e), ee = *(const f32x4*)(p.rw_r_k + cj0 + 4 * e);
#pragma unroll
                for (int j = 0; j < 4; ++j) { cw0[4 * e + j] = a[j]; ca0[4 * e + j] = bq[j]; ckk[4 * e + j] = cc[j]; cka[4 * e + j] = dd[j]; crk[4 * e + j] = ee[j]; } }
            float oa[8], orr[8], ob[8], ok[8];
#pragma unroll
            for (int e = 0; e < 8; ++e) {
                const int reg = 8 * q8 + e;
                const float xw = cw0[e] + lw[mt][reg];
                const float spn = fmaxf(-xw, 0.f) + LN2 * flog2(1.0f + fexp2(-fabsf(xw) * LOG2E));
                const float ld = -fexp2((-spn - 0.5f) * LOG2E);
                const float al = frcp(1.0f + fexp2(-(ca0[e] + la[mt][reg]) * LOG2E));
                const float kk = k8[e] * ckk[e] * kinv;
                const float kmod = k8[e] * (1.0f + (al - 1.0f) * cka[e]);
                const float bb = kk * al;
                bonus += r8[e] * kmod * crk[e];
                const float G = scan32(ld);
                const float eG = fexp2(G * LOG2E), eGm = fexp2((G - ld) * LOG2E), eiG = fexp2(-G * LOG2E);
                oa[e] = -kk * eGm; orr[e] = r8[e] * eG; ob[e] = bb * eiG; ok[e] = kmod * eiG;
                if (r32 == 31) gc[32 * h + 16 * mt + reg] = eG;
            }
            const int off = r32 * MSTR + (32 * h + 16 * mt + 8 * q8) * 2;
            *(LAS u32x4*)(mAT + off) = (u32x4){cvt_pk_bf16(oa[0], oa[1]), cvt_pk_bf16(oa[2], oa[3]), cvt_pk_bf16(oa[4], oa[5]), cvt_pk_bf16(oa[6], oa[7])};
            *(LAS u32x4*)(mRT + off) = (u32x4){cvt_pk_bf16(orr[0], orr[1]), cvt_pk_bf16(orr[2], orr[3]), cvt_pk_bf16(orr[4], orr[5]), cvt_pk_bf16(orr[6], orr[7])};
            *(LAS u32x4*)(mBT + off) = (u32x4){cvt_pk_bf16(ob[0], ob[1]), cvt_pk_bf16(ob[2], ob[3]), cvt_pk_bf16(ob[4], ob[5]), cvt_pk_bf16(ob[6], ob[7])};
            *(LAS u32x4*)(mKT + off) = (u32x4){cvt_pk_bf16(ok[0], ok[1]), cvt_pk_bf16(ok[2], ok[3]), cvt_pk_bf16(ok[4], ok[5]), cvt_pk_bf16(ok[6], ok[7])};
            asm volatile("" ::: "memory");
        }
    }
    bonus += swap32(bonus);
#pragma unroll
    for (int q = 0; q < 4; ++q) {
        float v8[8]; um8(urow + URV + cb + 8 * q, hp, p.shift_mu + (URV - UR) + cb + 8 * q, v8);
        *(u32x4*)(slot + SL_VR + r32 * 128 + (32 * h + 8 * q) * 2) = (u32x4){cvt_pk_bf16(v8[0], v8[1]), cvt_pk_bf16(v8[2], v8[3]), cvt_pk_bf16(v8[4], v8[5]), cvt_pk_bf16(v8[6], v8[7])};
        *(u32x4*)(slot + SL_BV + r32 * 128 + (32 * h + 8 * q) * 2) = (u32x4){cvt_pk_bf16(bonus * v8[0], bonus * v8[1]), cvt_pk_bf16(bonus * v8[2], bonus * v8[3]), cvt_pk_bf16(bonus * v8[4], bonus * v8[5]), cvt_pk_bf16(bonus * v8[6], bonus * v8[7])};
    }
    LDS_WAIT();
    f32x16 nab = zero16(), nabT = zero16(), nakT = zero16(), mbr = zero16(), mkr = zero16();
#pragma unroll
    for (int s = 0; s < 4; ++s) {
        const int off = r32 * MSTR + (16 * s + 8 * h) * 2;
        const bf16x8 fa = *(const LAS bf16x8*)(mAT + off), fr = *(const LAS bf16x8*)(mRT + off), fb = *(const LAS bf16x8*)(mBT + off), fk = *(const LAS bf16x8*)(mKT + off);
        nab = mfma32(fb, fa, nab); nabT = mfma32(fa, fb, nabT); nakT = mfma32(fa, fk, nakT); mbr = mfma32(fb, fr, mbr); mkr = mfma32(fk, fr, mkr);
    }
#pragma unroll
    for (int reg = 0; reg < 16; ++reg) {
        const int row = (reg & 3) + 8 * (reg >> 2) + 4 * h;
        nab[reg] = row < r32 ? nab[reg] : 0.f;
        nabT[reg] = r32 < row ? nabT[reg] : 0.f;
        nakT[reg] = r32 < row ? nakT[reg] : 0.f;
        mbr[reg] = row <= r32 ? mbr[reg] : 0.f;
        mkr[reg] = row <= r32 ? mkr[reg] : 0.f;
    }
    f32x16 Y = nab;
#pragma unroll
    for (int reg = 0; reg < 16; ++reg) { const int row = (reg & 3) + 8 * (reg >> 2) + 4 * h; if (row == r32) Y[reg] += 1.0f; }
    {
        f32x16 M = nab, MT = nabT;
#pragma unroll
        for (int lvl = 0; lvl < 4; ++lvl) {
            const bf16x8 m0 = accfrag(M, 0), m1 = accfrag(M, 1), t0f = accfrag(MT, 0), t1f = accfrag(MT, 1);
            f32x16 M2T = mfma32(m0, t0f, zero16()); M2T = mfma32(m1, t1f, M2T);
            f32x16 M2 = zero16();
            if (lvl < 3) { M2 = mfma32(t0f, m0, M2); M2 = mfma32(t1f, m1, M2); }
            const bf16x8 y0 = accfrag(Y, 0), y1 = accfrag(Y, 1);
            Y = mfma32(accfrag(M2T, 0), y0, Y); Y = mfma32(accfrag(M2T, 1), y1, Y);
            M = M2; MT = M2T;
        }
    }
    const bf16x8 ty0 = accfrag(Y, 0), ty1 = accfrag(Y, 1);
    f32x16 paT[2];
#pragma unroll
    for (int nt = 0; nt < 2; ++nt) { paT[nt] = mfma32(ty0, trfrag(mAT, 0, nt, lane), zero16()); paT[nt] = mfma32(ty1, trfrag(mAT, 1, nt, lane), paT[nt]); }
    f32x16 qakT = mfma32(ty0, accfrag(nakT, 0), zero16()); qakT = mfma32(ty1, accfrag(nakT, 1), qakT);
    const bf16x8 mb0 = accfrag(mbr, 0), mb1 = accfrag(mbr, 1);
#pragma unroll
    for (int mt = 0; mt < 2; ++mt) {
        f32x16 po;
#pragma unroll
        for (int g = 0; g < 4; ++g) { const u32x2 w = *(const LAS u32x2*)(mRT + r32 * MSTR + (32 * mt + 8 * g + 4 * h) * 2);
            po[4 * g] = bf16_lo(w.x); po[4 * g + 1] = bf16_hi(w.x); po[4 * g + 2] = bf16_lo(w.y); po[4 * g + 3] = bf16_hi(w.y); }
        po = mfma32(accfrag(paT[mt], 0), mb0, po); po = mfma32(accfrag(paT[mt], 1), mb1, po);
#pragma unroll
        for (int sp = 0; sp < 2; ++sp)
            *(u32x4*)(slot + SL_PO + r32 * 128 + (32 * mt + 16 * sp + 8 * h) * 2) = (u32x4){cvt_pk_bf16(po[8 * sp], po[8 * sp + 1]), cvt_pk_bf16(po[8 * sp + 2], po[8 * sp + 3]), cvt_pk_bf16(po[8 * sp + 4], po[8 * sp + 5]), cvt_pk_bf16(po[8 * sp + 6], po[8 * sp + 7])};
    }
    {
        f32x16 qo = mfma32(accfrag(qakT, 0), mb0, mkr); qo = mfma32(accfrag(qakT, 1), mb1, qo);
#pragma unroll
        for (int g = 0; g < 4; ++g) *(u32x2*)(slot + SL_QO + r32 * 64 + (8 * g + 4 * h) * 2) = (u32x2){cvt_pk_bf16(qo[4 * g], qo[4 * g + 1]), cvt_pk_bf16(qo[4 * g + 2], qo[4 * g + 3])};
    }
#pragma unroll
    for (int nt = 0; nt < 2; ++nt) {
        const bf16x8 bt0 = trfrag(mBT, 0, nt, lane), bt1 = trfrag(mBT, 1, nt, lane);
        const float gam = gc[32 * nt + r32];
#pragma unroll
        for (int mt = 0; mt < 2; ++mt) {
            f32x16 ps = zero16();
            if (mt == nt) {
#pragma unroll
                for (int reg = 0; reg < 16; ++reg) { const int row = (reg & 3) + 8 * (reg >> 2) + 4 * h; ps[reg] = (row == r32) ? 1.0f : 0.f; }
            }
            ps = mfma32(accfrag(paT[mt], 0), bt0, ps); ps = mfma32(accfrag(paT[mt], 1), bt1, ps);
#pragma unroll
            for (int sp = 0; sp < 2; ++sp)
                *(u32x4*)(slot + SL_PS + (32 * nt + r32) * 128 + (32 * mt + 16 * sp + 8 * h) * 2) = (u32x4){cvt_pk_bf16(ps[8 * sp] * gam, ps[8 * sp + 1] * gam), cvt_pk_bf16(ps[8 * sp + 2] * gam, ps[8 * sp + 3] * gam), cvt_pk_bf16(ps[8 * sp + 4] * gam, ps[8 * sp + 5] * gam), cvt_pk_bf16(ps[8 * sp + 6] * gam, ps[8 * sp + 7] * gam)};
        }
        f32x16 qs;
        { const bf16x8 k0 = trfrag(mKT, 0, nt, lane), k1 = trfrag(mKT, 1, nt, lane);
          const u32x4 w0 = __builtin_bit_cast(u32x4, k0), w1 = __builtin_bit_cast(u32x4, k1);
#pragma unroll
          for (int j = 0; j < 4; ++j) { qs[2 * j] = bf16_lo(w0[j]); qs[2 * j + 1] = bf16_hi(w0[j]); qs[8 + 2 * j] = bf16_lo(w1[j]); qs[8 + 2 * j + 1] = bf16_hi(w1[j]); } }
        qs = mfma32(accfrag(qakT, 0), bt0, qs); qs = mfma32(accfrag(qakT, 1), bt1, qs);
#pragma unroll
        for (int g = 0; g < 4; ++g) *(u32x2*)(slot + SL_QS + (32 * nt + r32) * 64 + (8 * g + 4 * h) * 2) = (u32x2){cvt_pk_bf16(qs[4 * g] * gam, qs[4 * g + 1] * gam), cvt_pk_bf16(qs[4 * g + 2] * gam, qs[4 * g + 3] * gam)};
    }
    LDS_WAIT();
}

__device__ __forceinline__ u32x4 ntload16(const void* ptr) { return __builtin_nontemporal_load((const u32x4*)ptr); }
__device__ __forceinline__ u32x2 ntload8(const void* ptr) { return __builtin_nontemporal_load((const u32x2*)ptr); }
__device__ __forceinline__ void rk_consume(const Params& p, LAS unsigned char* vs  , const unsigned char* slot, f32x16 (&st)[2][2], int b, int hh, int c) {
    using namespace rk;
    int lane = threadIdx.x & 63; asm volatile("" : "+v"(lane));
    const int r32 = lane & 31, h = lane >> 5;
    { const u32x4 a0 = ntload16(slot + SL_VR + lane * 64), a1 = ntload16(slot + SL_VR + lane * 64 + 16), a2 = ntload16(slot + SL_VR + lane * 64 + 32), a3 = ntload16(slot + SL_VR + lane * 64 + 48);
      LAS unsigned char* d = vs + (lane >> 1) * MSTR + (lane & 1) * 64;
      *(LAS u32x4*)d = a0; *(LAS u32x4*)(d + 16) = a1; *(LAS u32x4*)(d + 32) = a2; *(LAS u32x4*)(d + 48) = a3; }
    bf16x8 fps[2][2][2], fqs[2][2], fpo[2][2], fqo[2];
#pragma unroll
    for (int mt = 0; mt < 2; ++mt) {
#pragma unroll
        for (int jt = 0; jt < 2; ++jt)
#pragma unroll
            for (int s = 0; s < 2; ++s) fps[mt][jt][s] = __builtin_bit_cast(bf16x8, ntload16(slot + SL_PS + (32 * mt + r32) * 128 + (32 * jt + 16 * s + 8 * h) * 2));
#pragma unroll
        for (int s = 0; s < 2; ++s) fqs[mt][s] = __builtin_bit_cast(bf16x8, ntload16(slot + SL_QS + (32 * mt + r32) * 64 + (16 * s + 8 * h) * 2));
    }
#pragma unroll
    for (int jt = 0; jt < 2; ++jt)
#pragma unroll
        for (int s = 0; s < 2; ++s) fpo[jt][s] = __builtin_bit_cast(bf16x8, ntload16(slot + SL_PO + r32 * 128 + (32 * jt + 16 * s + 8 * h) * 2));
#pragma unroll
    for (int s = 0; s < 2; ++s) fqo[s] = __builtin_bit_cast(bf16x8, ntload16(slot + SL_QO + r32 * 64 + (16 * s + 8 * h) * 2));
    bf16x8 sf[2][2][2];
#pragma unroll
    for (int jt = 0; jt < 2; ++jt)
#pragma unroll
        for (int it = 0; it < 2; ++it) { sf[jt][it][0] = accfrag(st[jt][it], 0); sf[jt][it][1] = accfrag(st[jt][it], 1); }
    LDS_WAIT();
    bf16x8 vf[2][2];
    { const int g = lane >> 4, i16 = lane & 15, q = i16 >> 2, pp = i16 & 3;
#pragma unroll
      for (int it = 0; it < 2; ++it)
#pragma unroll
          for (int s = 0; s < 2; ++s) { const LAS unsigned char* a = vs + (16 * s + 8 * h + q) * MSTR + (32 * it + 16 * (g & 1) + 4 * pp) * 2;
              const s16x4 x = lds_tr16(a), y = lds_tr16(a + 4 * MSTR);
              bf16x8 r; r[0] = x[0]; r[1] = x[1]; r[2] = x[2]; r[3] = x[3]; r[4] = y[0]; r[5] = y[1]; r[6] = y[2]; r[7] = y[3]; vf[it][s] = r; } }
    f32x16 o[2];
#pragma unroll
    for (int it = 0; it < 2; ++it) {
        o[it] = zero16();
#pragma unroll
        for (int jt = 0; jt < 2; ++jt)
#pragma unroll
            for (int s = 0; s < 2; ++s) o[it] = mfma32(sf[jt][it][s], fpo[jt][s], o[it]);
#pragma unroll
        for (int s = 0; s < 2; ++s) o[it] = mfma32(vf[it][s], fqo[s], o[it]);
    }
#pragma unroll
    for (int mt = 0; mt < 2; ++mt)
#pragma unroll
        for (int it = 0; it < 2; ++it) {
            f32x16 a = zero16();
#pragma unroll
            for (int jt = 0; jt < 2; ++jt)
#pragma unroll
                for (int s = 0; s < 2; ++s) a = mfma32(fps[mt][jt][s], sf[jt][it][s], a);
#pragma unroll
            for (int s = 0; s < 2; ++s) a = mfma32(fqs[mt][s], vf[it][s], a);
            st[mt][it] = a;
        }
    float sm = 0.f;
#pragma unroll
    for (int it = 0; it < 2; ++it)
#pragma unroll
        for (int reg = 0; reg < 16; ++reg) sm += o[it][reg];
    sm += swap32(sm);
    const float mean = sm * (1.0f / 64.0f);
    float sv = 0.f;
#pragma unroll
    for (int it = 0; it < 2; ++it)
#pragma unroll
        for (int reg = 0; reg < 16; ++reg) { const float d = o[it][reg] - mean; sv += d * d; }
    sv += swap32(sv);
    const float rstd = 1.0f / sqrtf(sv * (1.0f / 64.0f) + 64e-5f);
    bf16_t* mrow = (bf16_t*)(p.ws + WS_B) + ((size_t)b * S + c * C + r32) * D + 512 + hh * HD;
#pragma unroll
    for (int it = 0; it < 2; ++it)
#pragma unroll
        for (int g = 0; g < 4; ++g) {
            const int i0 = 32 * it + 8 * g + 4 * h;
            const u32x2 bv = ntload8(slot + SL_BV + r32 * 128 + i0 * 2), gg = ntload8(slot + SL_GG + r32 * 128 + i0 * 2);
            const f32x4 lw4 = *(const f32x4*)(p.rw_ln_w + hh * HD + i0), lb4 = *(const f32x4*)(p.rw_ln_b + hh * HD + i0);
            const float bvf[4] = {bf16_lo(bv.x), bf16_hi(bv.x), bf16_lo(bv.y), bf16_hi(bv.y)}, ggf[4] = {bf16_lo(gg.x), bf16_hi(gg.x), bf16_lo(gg.y), bf16_hi(gg.y)};
            float r[4];
#pragma unroll
            for (int e = 0; e < 4; ++e) r[e] = ((o[it][4 * g + e] - mean) * rstd * lw4[e] + lb4[e] + bvf[e]) * ggf[e];
            *(u32x2*)(mrow + i0) = (u32x2){cvt_pk_bf16(r[0], r[1]), cvt_pk_bf16(r[2], r[3])};
        }
}

__device__ __forceinline__ void rwkv_chain(const Params& p, LAS unsigned char* lds, int b, int hh) {
    using namespace rk;
    const int tid = threadIdx.x, wave = __builtin_amdgcn_readfirstlane(tid >> 6), lane = tid & 63;
    volatile LAS unsigned* ready = (volatile LAS unsigned*)(lds + L_FLAG); volatile LAS unsigned* freed = ready + NSLOT; volatile LAS unsigned* err = freed + NSLOT;
    if (tid < 2 * NSLOT + 1) ready[tid] = 0u;
    __syncthreads();
    unsigned char* ring = (unsigned char*)p.out + (size_t)(b * NH + hh) * NSLOT * SLOT_BYTES;
    if (wave == 0) {
        f32x16 st[2][2];
#pragma unroll
        for (int a = 0; a < 2; ++a)
#pragma unroll
            for (int d = 0; d < 2; ++d) st[a][d] = zero16();
        for (int c = 0; c < NCH; ++c) {
            const int sl = c % NSLOT; unsigned spin = 0;
            while (ready[sl] != (unsigned)(c + 1)) { __builtin_amdgcn_s_sleep(2); if (++spin > (1u << 24)) { err[0] = 1u; break; } }
            asm volatile("" ::: "memory");
            rk_consume(p, lds + L_CONS, ring + (size_t)sl * SLOT_BYTES, st, b, hh, c);
            asm volatile("s_waitcnt vmcnt(0)" ::: "memory");
            if (lane == 0) freed[sl] = (unsigned)(c + 1);
        }
    } else {
        for (int c = wave - 1; c < NCH; c += 7) {
            const int sl = c % NSLOT; unsigned spin = 0;
            if (c >= NSLOT) while (freed[sl] != (unsigned)(c - NSLOT + 1)) { __builtin_amdgcn_s_sleep(4); if (++spin > (1u << 24)) { err[0] = 1u; break; } }
            asm volatile("" ::: "memory");
            rk_produce(p, lds + (wave - 1) * PROD_LDS, ring + (size_t)sl * SLOT_BYTES, b, hh, c);
            asm volatile("s_waitcnt vmcnt(0)" ::: "memory");
            if (lane == 0) ready[sl] = (unsigned)(c + 1);
        }
    }
    __syncthreads();
}

#ifdef RWDEBUG
namespace rw {
constexpr int CH = 16;
constexpr int O_UM = 0;
constexpr int O_LW = O_UM + CH * 448 * 4;
constexpr int O_LA = O_LW + CH * 64 * 4;
constexpr int O_LG0 = O_LA + CH * 64 * 4;
constexpr int O_LG1 = O_LG0 + CH * 64 * 4;
constexpr int O_A1 = O_LG1 + CH * 64 * 4;
constexpr int O_R1 = O_A1 + CH * 64 * 4;
constexpr int O_B1 = O_R1 + CH * 64 * 4;
constexpr int O_K1 = O_B1 + CH * 64 * 4;
constexpr int O_O = O_K1 + CH * 64 * 4;
constexpr int O_WT = O_O + CH * 64 * 4;
constexpr int O_GC = O_WT + 8 * 64 * 4;
constexpr int O_SC = O_GC + 64 * 4;
constexpr int O_END = O_SC + 3 * 16 * 4;
}
__device__ __forceinline__ bf16x8 ldw_frag(const float* W, int ldw, int m0, int col) {
    unsigned w[4];
#pragma unroll
    for (int j = 0; j < 4; ++j) w[j] = cvt_pk_bf16(W[(size_t)(m0 + 2 * j) * ldw + col], W[(size_t)(m0 + 2 * j + 1) * ldw + col]);
    return __builtin_bit_cast(bf16x8, (u32x4){w[0], w[1], w[2], w[3]});
}
template <int ACT>
__device__ __forceinline__ bf16x8 act_frag(const LAS float* src) {
    const f32x4 a = *(const LAS f32x4*)src, b = *(const LAS f32x4*)(src + 4); float v[8] = {a[0], a[1], a[2], a[3], b[0], b[1], b[2], b[3]};
#pragma unroll
    for (int j = 0; j < 8; ++j) {
        if (ACT == 1) v[j] = 1.0f - 2.0f * frcp(1.0f + fexp2(v[j] * (2.0f * LOG2E)));
        if (ACT == 2) v[j] = frcp(1.0f + fexp2(-v[j] * LOG2E));
    }
    return __builtin_bit_cast(bf16x8, (u32x4){cvt_pk_bf16(v[0], v[1]), cvt_pk_bf16(v[2], v[3]), cvt_pk_bf16(v[4], v[5]), cvt_pk_bf16(v[6], v[7])});
}

__device__ __forceinline__ void rwkv_chain_seq(const Params& p, LAS unsigned char* lds, int b, int h, bf16_t* mix, int nchunks) {
    using namespace rw;
    const int tid = threadIdx.x, wave = __builtin_amdgcn_readfirstlane(tid >> 6), lane = tid & 63;
    const bf16_t* u = (const bf16_t*)(p.ws + WS_A);
    const size_t row0 = (size_t)b * S;
    LAS float* UM = (LAS float*)(lds + O_UM); LAS float* LW = (LAS float*)(lds + O_LW); LAS float* LA = (LAS float*)(lds + O_LA);
    LAS float* LG0 = (LAS float*)(lds + O_LG0); LAS float* LG1 = (LAS float*)(lds + O_LG1);
    LAS float* A1 = (LAS float*)(lds + O_A1); LAS float* R1 = (LAS float*)(lds + O_R1); LAS float* B1 = (LAS float*)(lds + O_B1); LAS float* K1 = (LAS float*)(lds + O_K1);
    LAS float* OO = (LAS float*)(lds + O_O); LAS float* WT = (LAS float*)(lds + O_WT); LAS float* GC = (LAS float*)(lds + O_GC); LAS float* SC = (LAS float*)(lds + O_SC);
    const int fc = lane & 15, fq = lane >> 4;
    bf16x8 bwa[2], bg[2];
    { const float* W = wave < 4 ? p.rw_w2 : p.rw_a2; const int col = h * HD + 16 * (wave & 3) + fc;
      bwa[0] = ldw_frag(W, 512, 8 * fq, col); bwa[1] = ldw_frag(W, 512, 32 + 8 * fq, col);
      const int ks = (wave >> 2) * 2; bg[0] = ldw_frag(p.rw_g2, 512, 32 * ks + 8 * fq, col); bg[1] = ldw_frag(p.rw_g2, 512, 32 * (ks + 1) + 8 * fq, col); }
    const int hj = h * HD + lane;
    const float c_w0 = p.rw_w0[hj], c_a0 = p.rw_a0[hj], c_kk = p.rw_k_k[hj], c_ka = p.rw_k_a[hj], c_rk = p.rw_r_k[hj], c_lnw = p.rw_ln_w[hj], c_lnb = p.rw_ln_b[hj];
    int ld_t[2], ld_c[2], ld_uc[2]; bool ld_ok[2];
#pragma unroll
    for (int r = 0; r < 2; ++r) { const int gid = tid + 512 * r; ld_ok[r] = gid < CH * 56; const int t = gid / 56, cg8 = gid % 56; ld_t[r] = t; ld_c[r] = cg8 * 8;
        ld_uc[r] = cg8 < 8 ? UR + h * HD + 8 * cg8 : cg8 < 16 ? URK + h * HD + 8 * (cg8 - 8) : cg8 < 24 ? URV + h * HD + 8 * (cg8 - 16) : UXW + 8 * (cg8 - 24); }
    const int si = 8 * wave + (lane >> 3), sj = 8 * (lane & 7);
    float st[8];
#pragma unroll
    for (int n = 0; n < 8; ++n) st[n] = 0.f;
    u32x4 cur[2], prv[2];
    auto issue_loads = [&](int t0) {
#pragma unroll
        for (int r = 0; r < 2; ++r) { cur[r] = (u32x4){0u, 0u, 0u, 0u}; prv[r] = (u32x4){0u, 0u, 0u, 0u};
            if (ld_ok[r]) { const int tt = t0 + ld_t[r]; const bf16_t* a = u + (row0 + tt) * NIN + ld_uc[r]; cur[r] = *(const u32x4*)a; if (tt > 0) prv[r] = *(const u32x4*)(a - NIN); } }
    };
    issue_loads(0);
    for (int c = 0; c < nchunks; ++c) {
        const int t0 = c * CH;
#pragma unroll
        for (int r = 0; r < 2; ++r) if (ld_ok[r]) {
            const float* mu = p.shift_mu + (ld_uc[r] - UR); const f32x4 m0 = *(const f32x4*)mu, m1 = *(const f32x4*)(mu + 4);
            float cv[8], pv[8];
#pragma unroll
            for (int j = 0; j < 4; ++j) { cv[2 * j] = bf16_lo(cur[r][j]); cv[2 * j + 1] = bf16_hi(cur[r][j]); pv[2 * j] = bf16_lo(prv[r][j]); pv[2 * j + 1] = bf16_hi(prv[r][j]); }
            f32x4 o0, o1;
#pragma unroll
            for (int j = 0; j < 4; ++j) { o0[j] = cv[j] + (pv[j] - cv[j]) * m0[j]; o1[j] = cv[4 + j] + (pv[4 + j] - cv[4 + j]) * m1[j]; }
            LAS float* d = UM + ld_t[r] * 448 + ld_c[r]; *(LAS f32x4*)d = o0; *(LAS f32x4*)(d + 4) = o1;
        }
        if (c + 1 < S / CH) issue_loads(t0 + CH);
        __syncthreads();
        {
            f32x4 acc = (f32x4){0.f, 0.f, 0.f, 0.f};
            const LAS float* src = UM + fc * 448 + (wave < 4 ? 192 : 256) + 8 * fq;
            if (wave < 4) { acc = __builtin_amdgcn_mfma_f32_16x16x32_bf16(act_frag<1>(src), bwa[0], acc, 0, 0, 0); acc = __builtin_amdgcn_mfma_f32_16x16x32_bf16(act_frag<1>(src + 32), bwa[1], acc, 0, 0, 0); }
            else          { acc = __builtin_amdgcn_mfma_f32_16x16x32_bf16(act_frag<0>(src), bwa[0], acc, 0, 0, 0); acc = __builtin_amdgcn_mfma_f32_16x16x32_bf16(act_frag<0>(src + 32), bwa[1], acc, 0, 0, 0); }
            LAS float* dst = (wave < 4 ? LW : LA) + 16 * (wave & 3) + fc;
#pragma unroll
            for (int r = 0; r < 4; ++r) dst[(4 * fq + r) * 64] = acc[r];
            f32x4 ag = (f32x4){0.f, 0.f, 0.f, 0.f};
            const LAS float* sg = UM + fc * 448 + 320 + 64 * (wave >> 2) + 8 * fq;
            ag = __builtin_amdgcn_mfma_f32_16x16x32_bf16(act_frag<2>(sg), bg[0], ag, 0, 0, 0); ag = __builtin_amdgcn_mfma_f32_16x16x32_bf16(act_frag<2>(sg + 32), bg[1], ag, 0, 0, 0);
            LAS float* dg = (wave < 4 ? LG0 : LG1) + 16 * (wave & 3) + fc;
#pragma unroll
            for (int r = 0; r < 4; ++r) dg[(4 * fq + r) * 64] = ag[r];
        }
        __syncthreads();
        float e_kk[2], e_b[2], e_k[2], e_r[2], e_ld[2];
#pragma unroll
        for (int tt = 0; tt < 2; ++tt) {
            const int t = 2 * wave + tt;
            const float xw = c_w0 + LW[t * 64 + lane];
            const float spn = (fmaxf(-xw, 0.f) + LN2 * flog2(1.0f + fexp2(-fabsf(xw) * LOG2E)));
            e_ld[tt] = -fexp2((-spn - 0.5f) * LOG2E);
            const float a = frcp(1.0f + fexp2(-(c_a0 + LA[t * 64 + lane]) * LOG2E));
            const float kraw = UM[t * 448 + 64 + lane], r = UM[t * 448 + lane];
            const float kkv = kraw * c_kk; const float ssq = wave_sum(kkv * kkv);
            const float kk = kkv * frsq(fmaxf(ssq, 1e-24f));
            const float kmod = kraw * (1.0f + (a - 1.0f) * c_ka);
            const float bb = kk * a;
            const float cbr = wave_sum(bb * r), ckr = wave_sum(kmod * r), bon = wave_sum(r * kmod * c_rk);
            if (lane == 0) { SC[t] = cbr; SC[16 + t] = ckr; SC[32 + t] = bon; }
            e_kk[tt] = kk; e_b[tt] = bb; e_k[tt] = kmod; e_r[tt] = r;
        }
        WT[wave * 64 + lane] = e_ld[0] + e_ld[1];
        __syncthreads();
        {
            float off = 0.f, tot = 0.f;
#pragma unroll
            for (int w = 0; w < 8; ++w) { const float x = WT[w * 64 + lane]; if (w < wave) off += x; tot += x; }
            const float c0 = off + e_ld[0], c1 = c0 + e_ld[1];
            const int t = 2 * wave;
            A1[t * 64 + lane] = -e_kk[0] * fexp2(off * LOG2E);       A1[(t + 1) * 64 + lane] = -e_kk[1] * fexp2(c0 * LOG2E);
            R1[t * 64 + lane] = e_r[0] * fexp2(c0 * LOG2E);          R1[(t + 1) * 64 + lane] = e_r[1] * fexp2(c1 * LOG2E);
            const float i0 = fexp2(-c0 * LOG2E), i1 = fexp2(-c1 * LOG2E);
            B1[t * 64 + lane] = e_b[0] * i0;                          B1[(t + 1) * 64 + lane] = e_b[1] * i1;
            K1[t * 64 + lane] = e_k[0] * i0;                          K1[(t + 1) * 64 + lane] = e_k[1] * i1;
            if (wave == 0) GC[lane] = fexp2(tot * LOG2E);
        }
        __syncthreads();
#pragma unroll 4
        for (int t = 0; t < CH; ++t) {
            const f32x4 a0 = *(const LAS f32x4*)(A1 + t * 64 + sj), a1 = *(const LAS f32x4*)(A1 + t * 64 + sj + 4);
            const f32x4 r0 = *(const LAS f32x4*)(R1 + t * 64 + sj), r1 = *(const LAS f32x4*)(R1 + t * 64 + sj + 4);
            const f32x4 b0 = *(const LAS f32x4*)(B1 + t * 64 + sj), b1 = *(const LAS f32x4*)(B1 + t * 64 + sj + 4);
            const f32x4 k0 = *(const LAS f32x4*)(K1 + t * 64 + sj), k1 = *(const LAS f32x4*)(K1 + t * 64 + sj + 4);
            const float v = UM[t * 448 + 128 + si], cbr = SC[t], ckr = SC[16 + t];
            float sa = (st[0] * a0[0] + st[1] * a0[1]) + (st[2] * a0[2] + st[3] * a0[3]) + ((st[4] * a1[0] + st[5] * a1[1]) + (st[6] * a1[2] + st[7] * a1[3]));
            float pp = (st[0] * r0[0] + st[1] * r0[1]) + (st[2] * r0[2] + st[3] * r0[3]) + ((st[4] * r1[0] + st[5] * r1[1]) + (st[6] * r1[2] + st[7] * r1[3]));
            sa = sum8(sa); pp = sum8(pp);
            if ((lane & 7) == 0) OO[t * 64 + si] = pp + sa * cbr + v * ckr;
#pragma unroll
            for (int n = 0; n < 4; ++n) { st[n] += sa * b0[n] + v * k0[n]; st[4 + n] += sa * b1[n] + v * k1[n]; }
        }
        {
            const f32x4 g0 = *(const LAS f32x4*)(GC + sj), g1 = *(const LAS f32x4*)(GC + sj + 4);
#pragma unroll
            for (int n = 0; n < 4; ++n) { st[n] *= g0[n]; st[4 + n] *= g1[n]; }
        }
        __syncthreads();
#pragma unroll
        for (int tt = 0; tt < 2; ++tt) {
            const int t = 2 * wave + tt;
            const float o = OO[t * 64 + lane];
            const float mean = wave_sum(o) * (1.0f / 64.0f); const float dlt = o - mean;
            const float var = wave_sum(dlt * dlt) * (1.0f / 64.0f);
            const float gn = dlt * (1.0f / sqrtf(var + 64e-5f)) * c_lnw + c_lnb;
            const float res = (gn + SC[32 + t] * UM[t * 448 + 128 + lane]) * (LG0[t * 64 + lane] + LG1[t * 64 + lane]);
            mix[(row0 + t0 + t) * D + 512 + h * HD + lane] = (bf16_t)(cvt_pk_bf16(res, 0.f) & 0xffffu);
        }
        __syncthreads();
    }
}

#endif

__device__ __forceinline__ void phase2(const Params& p, LAS unsigned char* lds) {
    const int nchain = NB * NH, G = gridDim.x, wave = threadIdx.x >> 6;
    const int nscan = G >= 2 * nchain ? nchain : (G > 1 ? G / 2 : 0);
    if ((int)blockIdx.x < nscan || nscan == 0) {
        const int stride = nscan == 0 ? G : nscan;
        for (int it = blockIdx.x; it < nchain; it += stride) rwkv_chain(p, lds, it / NH, it % NH);
    }
    if ((int)blockIdx.x >= nscan) {
        const int nb = G - nscan, bi = blockIdx.x - nscan;
        for (int it = bi * 8 + wave; it < NB * NH * 64; it += nb * 8) attn_tile(p, lds + wave * 4608, it / (NH * 64), (it / 64) % NH, 63 - (it % 64));
        p0_expert_weights(p, lds, bi * 8 + wave, nb * 8);
    }
}

struct EpiH {
    const float* x; float* hout; int row0, col0;
    __device__ __forceinline__ void operator()(const f32x4 (&acc)[2][2][4][2], int wr, int wc, int fr, int fq) const {
#pragma unroll
        for (int ai = 0; ai < 2; ++ai)
#pragma unroll
            for (int m = 0; m < 4; ++m) { const size_t off = (size_t)(row0 + ai * 128 + wr * 64 + m * 16 + fr) * D + col0 + wc * 32 + 4 * fq;
#pragma unroll
                for (int bj = 0; bj < 2; ++bj)
#pragma unroll
                    for (int n = 0; n < 2; ++n) { const f32x4 xv = *(const f32x4*)(x + off + bj * 128 + n * 16); *(f32x4*)(hout + off + bj * 128 + n * 16) = xv + acc[ai][bj][m][n]; } }
    }
};
__device__ __forceinline__ void phase3(const Params& p, LAS unsigned char* lds) {
    constexpr int nM = T / 256, nN = D / 256;
    unsigned aoff[2][2]; g8::aoff_rows(aoff, D);
    for (int L = blockIdx.x; L < nM * nN; L += gridDim.x) {
        int pm, pn; g8::tile_order(L, nM, nN, pm, pn);
        EpiH E{p.x, p.out, pm * 256, pn * 256};
        g8::gemm_unit(lds, (const char*)(p.ws + WS_B) + (size_t)pm * 256 * D * 2, aoff, (const char*)(p.ws + WS_WOUT) + (size_t)pn * 256 * D * 2, D, E);
    }
}

__device__ __forceinline__ void phase4(const Params& p, LAS unsigned char* lds) {
    const int tid = threadIdx.x, wave = tid >> 6, lane = tid & 63, fr = lane & 15, fq = lane >> 4;
    const float* hsrc = p.out; bf16_t* hb = (bf16_t*)(p.ws + WS_A); float* rstd2 = (float*)(p.ws + WS_RSTD2);
    const bf16_t* wr_hi = (const bf16_t*)(p.ws + WS_WR); const bf16_t* wr_lo = wr_hi + 48 * D;
    int* list = (int*)(p.ws + WS_LIST); float* listw = (float*)(p.ws + WS_LISTW); unsigned* cnt = (unsigned*)(p.ws + WS_CTL);
    LAS float* lg = (LAS float*)(lds + wave * 3072);
    LAS unsigned* lcnt = (LAS unsigned*)(lds + 8 * 3072);
    LAS unsigned* gbase = lcnt + 32;
    for (int blk = blockIdx.x; blk < T / 128; blk += gridDim.x) {
        if (tid < 32) lcnt[tid] = 0u;
        __syncthreads();
        const int tok0 = blk * 128 + wave * 16;
        f32x4 acc[3];
#pragma unroll
        for (int n = 0; n < 3; ++n) acc[n] = (f32x4){0.f, 0.f, 0.f, 0.f};
        float ss = 0.f;
        const float* hp = hsrc + (size_t)(tok0 + fr) * D + 8 * fq; bf16_t* hbp = hb + (size_t)(tok0 + fr) * D + 8 * fq;
        const bf16_t* bh = wr_hi + (size_t)fr * D + 8 * fq; const bf16_t* bl = wr_lo + (size_t)fr * D + 8 * fq;
#pragma unroll 2
        for (int ks = 0; ks < D / 32; ++ks) {
            const f32x4 v0 = *(const f32x4*)(hp + 32 * ks), v1 = *(const f32x4*)(hp + 32 * ks + 4);
            ss += (v0[0] * v0[0] + v0[1] * v0[1]) + (v0[2] * v0[2] + v0[3] * v0[3]) + ((v1[0] * v1[0] + v1[1] * v1[1]) + (v1[2] * v1[2] + v1[3] * v1[3]));
            u32x4 hi; hi.x = cvt_pk_bf16(v0[0], v0[1]); hi.y = cvt_pk_bf16(v0[2], v0[3]); hi.z = cvt_pk_bf16(v1[0], v1[1]); hi.w = cvt_pk_bf16(v1[2], v1[3]);
            *(u32x4*)(hbp + 32 * ks) = hi;
            u32x4 lo; lo.x = cvt_pk_bf16(v0[0] - bf16_lo(hi.x), v0[1] - bf16_hi(hi.x)); lo.y = cvt_pk_bf16(v0[2] - bf16_lo(hi.y), v0[3] - bf16_hi(hi.y));
            lo.z = cvt_pk_bf16(v1[0] - bf16_lo(hi.z), v1[1] - bf16_hi(hi.z)); lo.w = cvt_pk_bf16(v1[2] - bf16_lo(hi.w), v1[3] - bf16_hi(hi.w));
            const bf16x8 ah = __builtin_bit_cast(bf16x8, hi), al = __builtin_bit_cast(bf16x8, lo);
#pragma unroll
            for (int n = 0; n < 3; ++n) {
                const bf16x8 wh = *(const bf16x8*)(bh + (size_t)n * 16 * D + 32 * ks), wl = *(const bf16x8*)(bl + (size_t)n * 16 * D + 32 * ks);
                acc[n] = __builtin_amdgcn_mfma_f32_16x16x32_bf16(ah, wh, acc[n], 0, 0, 0);
                acc[n] = __builtin_amdgcn_mfma_f32_16x16x32_bf16(al, wh, acc[n], 0, 0, 0);
                acc[n] = __builtin_amdgcn_mfma_f32_16x16x32_bf16(ah, wl, acc[n], 0, 0, 0);
            }
        }
        ss += __shfl_xor(ss, 16); ss += __shfl_xor(ss, 32);
        const float rs = 1.0f / sqrtf(ss * (1.0f / D) + 1e-6f);
        if (fq == 0) rstd2[tok0 + fr] = rs;
#pragma unroll
        for (int n = 0; n < 3; ++n)
#pragma unroll
            for (int r = 0; r < 4; ++r) lg[(4 * fq + r) * 48 + 16 * n + fr] = acc[n][r];
        LDS_WAIT();
        int e0 = 0, e1 = 0; float w0 = 0.f, w1 = 0.f; unsigned lp0 = 0, lp1 = 0;
        if (lane < 16) {
            const float rst = rs;
            const LAS float* L = lg + lane * 48;
            float gl[4]; int gi = 0; float gm;
#pragma unroll
            for (int g = 0; g < 4; ++g) gl[g] = L[g] * rst + p.r_grp_b[g];
            gm = gl[0];
#pragma unroll
            for (int g = 1; g < 4; ++g) if (gl[g] > gm) { gm = gl[g]; gi = g; }
            float gs = 0.f;
#pragma unroll
            for (int g = 0; g < 4; ++g) gs += __expf(gl[g] - gm);
            const float gval = 1.0f / gs;
            float el[8];
#pragma unroll
            for (int e = 0; e < 8; ++e) el[e] = L[4 + gi * 8 + e] * rst + p.r_exp_b[gi * 8 + e];
            int i0 = 0; float m0 = el[0];
#pragma unroll
            for (int e = 1; e < 8; ++e) if (el[e] > m0) { m0 = el[e]; i0 = e; }
            int i1 = i0 == 0 ? 1 : 0; float m1 = el[i1];
#pragma unroll
            for (int e = 0; e < 8; ++e) if (e != i0 && el[e] > m1) { m1 = el[e]; i1 = e; }
            const float x1 = __expf(m1 - m0); const float den = 1.0f / (1.0f + x1);
            e0 = gi * 8 + i0; e1 = gi * 8 + i1; w0 = gval * den; w1 = gval * x1 * den;
            lp0 = atomicAdd((unsigned*)&lcnt[e0], 1u); lp1 = atomicAdd((unsigned*)&lcnt[e1], 1u);
        }
        __syncthreads();
        if (tid < 32) gbase[tid] = atomicAdd(&cnt[tid], lcnt[tid]);
        __syncthreads();
        if (lane < 16) {
            const int tok = tok0 + lane;
            const unsigned q0 = gbase[e0] + lp0, q1 = gbase[e1] + lp1;
            list[(size_t)e0 * T + q0] = tok * 2;     listw[(size_t)e0 * T + q0] = w0;
            list[(size_t)e1 * T + q1] = tok * 2 + 1; listw[(size_t)e1 * T + q1] = w1;
        }
        __syncthreads();
    }
}

constexpr int LDS_MAP = 139264;
__device__ __forceinline__ void expert_map_build(const unsigned* cnt, LAS unsigned char* lds) {
    LAS int* pre = (LAS int*)(lds + LDS_MAP); LAS int* cn = pre + 40;
    if (threadIdx.x == 0) { int acc = 0; for (int i = 0; i < NE; ++i) { const int ci = (int)__hip_atomic_load(cnt + i, __ATOMIC_RELAXED, __HIP_MEMORY_SCOPE_AGENT); pre[i] = acc; cn[i] = ci; acc += (ci + 255) >> 8; } pre[NE] = acc; }
    __syncthreads();
}
__device__ __forceinline__ void expert_find(LAS unsigned char* lds, int mt, int& e, int& local, int& c) {
    const LAS int* pre = (const LAS int*)(lds + LDS_MAP); const LAS int* cn = pre + 40;
    int lo = 0;
#pragma unroll 1
    for (int i = 1; i < NE; ++i) if (pre[i] <= mt) lo = i;
    e = __builtin_amdgcn_readfirstlane(lo); local = mt - __builtin_amdgcn_readfirstlane(pre[e]); c = __builtin_amdgcn_readfirstlane(cn[e]);
}
__device__ __forceinline__ int expert_tiles(LAS unsigned char* lds) { return __builtin_amdgcn_readfirstlane(((const LAS int*)(lds + LDS_MAP))[NE]); }

struct EpiGU {
    bf16_t* hid; const float* rstd2; const int* lst; int cnt, p0, hrow0, ct;
    __device__ __forceinline__ void operator()(const f32x4 (&acc)[2][2][4][2], int wr, int wc, int fr, int fq) const {
#pragma unroll
        for (int ai = 0; ai < 2; ++ai)
#pragma unroll
            for (int m = 0; m < 4; ++m) { const int r = ai * 128 + wr * 64 + m * 16 + fr; const int pp = p0 + r;
                const float rs = pp < cnt ? rstd2[lst[pp] >> 1] : 0.f;
                bf16_t* op = hid + (size_t)(hrow0 + r) * DE + ct * 128 + wc * 32 + 4 * fq;
#pragma unroll
                for (int n = 0; n < 2; ++n) { const f32x4 g = acc[ai][0][m][n] * rs, uu = acc[ai][1][m][n] * rs; float o[4];
#pragma unroll
                    for (int j = 0; j < 4; ++j) o[j] = g[j] * frcp(1.0f + fexp2(-g[j] * LOG2E)) * uu[j];
                    u32x2 w; w.x = cvt_pk_bf16(o[0], o[1]); w.y = cvt_pk_bf16(o[2], o[3]); *(u32x2*)(op + n * 16) = w; } }
    }
};
__device__ __forceinline__ void phase5(const Params& p, LAS unsigned char* lds) {
    expert_map_build((const unsigned*)(p.ws + WS_CTL), lds);
    const int MT = expert_tiles(lds);
    const int tid = threadIdx.x;
    for (int unit = blockIdx.x; unit < MT * 2; unit += gridDim.x) {
        const int mt = unit >> 1, ct = unit & 1; int e, local, c; expert_find(lds, mt, e, local, c);
        const int* lst = (const int*)(p.ws + WS_LIST) + (size_t)e * T; const int p0 = local * 256;
        unsigned aoff[2][2];
#pragma unroll
        for (int i = 0; i < 2; ++i) { int R, C; g8::stage_rc(tid * 16 + i * 8192, R, C);
#pragma unroll
            for (int hh = 0; hh < 2; ++hh) { const int pp = p0 + hh * 128 + R; const int tok = pp < c ? (lst[pp] >> 1) : 0; aoff[hh][i] = (unsigned)(tok * D + C) * 2u; } }
        EpiGU E{(bf16_t*)(p.ws + WS_B), (const float*)(p.ws + WS_RSTD2), lst, c, p0, mt * 256, ct};
        g8::gemm_unit(lds, (const char*)(p.ws + WS_A), aoff, (const char*)(p.ws + WS_WGU) + ((size_t)e * 512 + ct * 256) * D * 2, D, E);
    }
}
struct EpiDN {
    bf16_t* y; bf16_t* dummy; const int* lst; const float* lw; int cnt, p0, col0;
    __device__ __forceinline__ void operator()(const f32x4 (&acc)[2][2][4][2], int wr, int wc, int fr, int fq) const {
#pragma unroll
        for (int ai = 0; ai < 2; ++ai)
#pragma unroll
            for (int m = 0; m < 4; ++m) { const int pp = p0 + ai * 128 + wr * 64 + m * 16 + fr;
                const bool ok = pp < cnt; const int ent = lst[pp]; const float w = lw[pp];
                bf16_t* op = (ok ? y + ((size_t)(ent & 1) * T + (ent >> 1)) * D : dummy) + col0 + wc * 32 + 4 * fq;
#pragma unroll
                for (int bj = 0; bj < 2; ++bj)
#pragma unroll
                    for (int n = 0; n < 2; ++n) { const f32x4 v = acc[ai][bj][m][n] * w; u32x2 o; o.x = cvt_pk_bf16(v[0], v[1]); o.y = cvt_pk_bf16(v[2], v[3]); *(u32x2*)(op + bj * 128 + n * 16) = o; }
                if (m & 1) asm volatile("" ::: "memory"); }
    }
};
__device__ __forceinline__ void phase6(const Params& p, LAS unsigned char* lds) {
    expert_map_build((const unsigned*)(p.ws + WS_CTL), lds);
    const int MT = expert_tiles(lds);
    constexpr int kdn = DE;
    unsigned aoff[2][2]; g8::aoff_rows(aoff, kdn);
    for (int unit = blockIdx.x; unit < MT * 4; unit += gridDim.x) {
        const int mt = unit >> 2, pn = unit & 3; int e, local, c; expert_find(lds, mt, e, local, c);
        EpiDN E{(bf16_t*)(p.ws + WS_A + (size_t)T * D * 2), (bf16_t*)(p.ws + WS_A + (size_t)3 * T * D * 2), (const int*)(p.ws + WS_LIST) + (size_t)e * T, (const float*)(p.ws + WS_LISTW) + (size_t)e * T, c, local * 256, pn * 256};
        g8::gemm_unit(lds, (const char*)(p.ws + WS_B) + (size_t)mt * 256 * DE * 2, aoff, (const char*)(p.ws + WS_WDN) + ((size_t)e * D + pn * 256) * DE * 2, kdn, E);
    }
}

__device__ __forceinline__ void phase7(const Params& p) {
    const int wave = threadIdx.x >> 6, lane = threadIdx.x & 63;
    const bf16_t* y0 = (const bf16_t*)(p.ws + WS_A + (size_t)T * D * 2); const bf16_t* y1 = y0 + (size_t)T * D;
    f32x4 g[4];
#pragma unroll
    for (int j = 0; j < 4; ++j) g[j] = *((const f32x4*)p.final_g + lane + 64 * j);
    for (int row = blockIdx.x * NWAVES + wave; row < T; row += gridDim.x * NWAVES) {
        f32x4* hr = (f32x4*)(p.out + (size_t)row * D) + lane; const u32x2* a = (const u32x2*)(y0 + (size_t)row * D) + lane; const u32x2* bq = (const u32x2*)(y1 + (size_t)row * D) + lane;
        f32x4 v[4]; float s = 0.f;
#pragma unroll
        for (int j = 0; j < 4; ++j) { v[j] = hr[64 * j]; const u32x2 ya = a[64 * j], yb = bq[64 * j];
            v[j][0] += bf16_lo(ya.x) + bf16_lo(yb.x); v[j][1] += bf16_hi(ya.x) + bf16_hi(yb.x); v[j][2] += bf16_lo(ya.y) + bf16_lo(yb.y); v[j][3] += bf16_hi(ya.y) + bf16_hi(yb.y);
            s += (v[j][0] * v[j][0] + v[j][1] * v[j][1]) + (v[j][2] * v[j][2] + v[j][3] * v[j][3]); }
        s = wave_sum(s);
        const float rs = 1.0f / sqrtf(s * (1.0f / D) + 1e-6f);
#pragma unroll
        for (int j = 0; j < 4; ++j) hr[64 * j] = v[j] * rs * g[j];
    }
}

__global__ __launch_bounds__(512) void mega(Params p) {
    extern __shared__ __attribute__((aligned(16))) unsigned char lds_raw[];
    LAS unsigned char* lds = (LAS unsigned char*)lds_raw;
    volatile LAS unsigned* bst = (volatile LAS unsigned*)(lds + LDS_MAP + 512);
    if (threadIdx.x == 0) { bst[0] = 0u; bst[1] = 0u; bst[2] = 0u; bst[3] = 0u; }
    __syncthreads();
    const XcdBarrier gb = xcd_barrier_post((unsigned*)(p.ws + WS_BAR), bst);
#define GSYNC() xcd_barrier(gb)
#ifndef PHASE_MASK
#define PHASE_MASK 0xff
#endif
#ifdef TPROBE
    unsigned long long ts[9]; ts[0] = __builtin_amdgcn_s_memrealtime();
#define TS(i) ts[i] = __builtin_amdgcn_s_memrealtime()
#else
#define TS(i)
#endif
    if (PHASE_MASK & 1) phase0(p, lds); GSYNC(); TS(1);
    if (PHASE_MASK & 2) phase1(p, lds); GSYNC(); TS(2);
    if (PHASE_MASK & 4) phase2(p, lds); GSYNC(); TS(3);
#ifdef RWDEBUG
    {
        bf16_t* dbg = (bf16_t*)(p.ws + WS_A + (size_t)3 * T * D * 2 + 4096);
        float* red = (float*)(p.ws + WS_CTL + 2048);
        if (blockIdx.x == 0) {
            rwkv_chain_seq(p, lds, RWDEBUG_B, RWDEBUG_H, dbg - (size_t)RWDEBUG_B * S * D, 2 * RWDEBUG_C1);
            __syncthreads();
            const bf16_t* mix = (const bf16_t*)(p.ws + WS_B);
            float md = 0.f, mr = 0.f; int bad = 0;
            for (int i = threadIdx.x; i < (RWDEBUG_C1 - RWDEBUG_C0) * 32 * 64; i += NTHREADS) {
                const int t = RWDEBUG_C0 * 32 + i / 64, col = 512 + RWDEBUG_H * 64 + (i % 64);
                const float a = __uint_as_float((unsigned)mix[((size_t)RWDEBUG_B * S + t) * D + col] << 16), r = __uint_as_float((unsigned)dbg[(size_t)t * D + col] << 16);
                if (!(fabsf(a) < 1e30f)) bad++;
                else { md = fmaxf(md, fabsf(a - r)); } mr = fmaxf(mr, fabsf(r));
            }
            LAS float* sh = (LAS float*)lds;
            sh[threadIdx.x] = md; sh[512 + threadIdx.x] = mr; sh[1024 + threadIdx.x] = (float)bad; __syncthreads();
            if (threadIdx.x == 0) { float a = 0.f, r = 0.f, nb = 0.f; for (int i = 0; i < NTHREADS; ++i) { a = fmaxf(a, sh[i]); r = fmaxf(r, sh[512 + i]); nb += sh[1024 + i]; }
                float rel = a / fmaxf(r, 1e-20f); float code = nb > 0.f ? 40.0f : (rel < 0.03f ? 5.0f : (rel < 0.3f ? 10.0f : 20.0f));
                red[0] = code; }
        }
        GSYNC();
        const float code = ((const float*)(p.ws + WS_CTL + 2048))[0];
        for (size_t i = (size_t)blockIdx.x * NTHREADS + threadIdx.x; i < (size_t)T * D; i += (size_t)gridDim.x * NTHREADS) p.out[i] = code;
        return;
    }
#endif
    if (PHASE_MASK & 8) phase3(p, lds); GSYNC(); TS(4);
    if (PHASE_MASK & 16) phase4(p, lds); GSYNC(); TS(5);
    if (PHASE_MASK & 32) phase5(p, lds); GSYNC(); TS(6);
    if (PHASE_MASK & 64) phase6(p, lds); GSYNC(); TS(7);
    if (PHASE_MASK & 128) phase7(p);
#ifdef TPROBE
    GSYNC(); TS(8);
    float* tw = (float*)(p.ws + WS_CTL + 1024);
    if (blockIdx.x == 0 && threadIdx.x == 0) { const float t1 = (float)(ts[TPROBE + 1] - ts[TPROBE]) * 0.01f; tw[0] = floorf(log2f(t1) * TPQ + 0.5f) / TPQ; }
    GSYNC();
    const float c1 = tw[0];
    for (size_t i = (size_t)blockIdx.x * NTHREADS + threadIdx.x; i < (size_t)T * D; i += (size_t)gridDim.x * NTHREADS) p.out[i] = c1;
#endif
}

extern "C" void kernel_launch(void* const* d_in, const int* in_sizes, int n_in, void* d_out, int out_size, void* d_ws, size_t ws_size, hipStream_t stream) {
    static int grid = 0;
    if (grid == 0) {
        if (n_in != 25 || out_size != T * D || ws_size < WS_END) { fprintf(stderr, "kernel_launch: unexpected sizes n_in %d out %d ws %zu (need %zu)\n", n_in, out_size, ws_size, (size_t)WS_END); grid = -1; return; }
        int dev = 0, cus = 0, per_cu = 0;
        (void)hipGetDevice(&dev); (void)hipDeviceGetAttribute(&cus, hipDeviceAttributeMultiprocessorCount, dev);
        if (hipFuncSetAttribute((const void*)mega, hipFuncAttributeMaxDynamicSharedMemorySize, LDS_BYTES) != hipSuccess) { fprintf(stderr, "kernel_launch: hipFuncSetAttribute failed\n"); grid = -1; return; }
        if (hipOccupancyMaxActiveBlocksPerMultiprocessor(&per_cu, (const void*)mega, NTHREADS, LDS_BYTES) != hipSuccess || per_cu < 1) { fprintf(stderr, "kernel_launch: occupancy query failed (%d)\n", per_cu); (void)hipGetLastError(); per_cu = 1; }
        grid = cus * 1;
    }
    if (grid < 0) return;
    Params p{};
    const float** f = (const float**)&p;
    for (int i = 0; i < 25; ++i) f[i] = (const float*)d_in[i];
    p.out = (float*)d_out; p.ws = (unsigned char*)d_ws;
    if (hipMemsetAsync((char*)d_ws + WS_BAR, 0, XCD_BAR_WORDS * 4, stream) != hipSuccess) { fprintf(stderr, "kernel_launch: memset failed\n"); return; }
    hipLaunchKernelGGL(mega, dim3(grid), dim3(NTHREADS), LDS_BYTES, stream, p);
    hipError_t e = hipPeekAtLastError();
    if (e != hipSuccess) fprintf(stderr, "launch failed: %s (grid %d)\n", hipGetErrorString(e), grid);
}
```

```cpp
#include <hip/hip_runtime.h>
#include <cstdio>
#include <cstdint>
#define TPQ 8.0f

#define LAS __attribute__((address_space(3)))
typedef unsigned short bf16_t;
typedef short bf16x8 __attribute__((ext_vector_type(8)));
typedef short s16x4 __attribute__((ext_vector_type(4)));
typedef float f32x4 __attribute__((ext_vector_type(4)));
typedef float f32x2 __attribute__((ext_vector_type(2)));
typedef float f32x16 __attribute__((ext_vector_type(16)));
typedef unsigned u32x2 __attribute__((ext_vector_type(2)));
typedef unsigned u32x4 __attribute__((ext_vector_type(4)));

constexpr int NB = 16, S = 2048, T = NB * S, D = 1024, NIN = 3328, NH = 8, HD = 64;
constexpr int UQ = 0, UK = 512, UV = 1024, UR = 1536, URK = 2048, URV = 2560, UXW = 3072, UXA = 3136, UXG = 3200;
constexpr int NE = 32, DE = 256;
constexpr float LOG2E = 1.4426950408889634f, LN2 = 0.6931471805599453f;
constexpr float QSCALE = 0.125f * LOG2E;
constexpr int NTHREADS = 512, NWAVES = 8;
constexpr int LDS_BYTES = 161792 + 1024;

constexpr size_t WS_CTL   = 0;
constexpr size_t WS_BAR   = 8192;
constexpr size_t WS_WIN   = 65536;
constexpr size_t WS_WOUT  = WS_WIN  + (size_t)NIN * D * 2;
constexpr size_t WS_WGU   = WS_WOUT + (size_t)D * D * 2;
constexpr size_t WS_WDN   = WS_WGU  + (size_t)NE * 512 * D * 2;
constexpr size_t WS_RSTD1 = WS_WDN  + (size_t)NE * D * DE * 2;
constexpr size_t WS_RSTD2 = WS_RSTD1 + (size_t)T * 4;
constexpr size_t WS_LIST  = WS_RSTD2 + (size_t)T * 4;
constexpr size_t WS_LISTW = WS_LIST + (size_t)NE * T * 4;
constexpr size_t WS_WR    = WS_LISTW + (size_t)NE * T * 4;
constexpr size_t WS_LT    = WS_WR + (size_t)2 * 48 * D * 2;
constexpr size_t WS_A     = WS_LT + (size_t)512 * 256 * 2;
constexpr size_t WS_B     = WS_A + (size_t)T * NIN * 2;
constexpr size_t WS_END   = WS_B + (size_t)T * D * 2;
constexpr int HID_ROWS = 2 * T + NE * 256;

struct Params {
    const float* x; const float* norm_mix_g; const float* w_in; const float* shift_mu; const float* sb_out_g;
    const float* rw_w0; const float* rw_w2; const float* rw_a0; const float* rw_a2; const float* rw_g2;
    const float* rw_k_k; const float* rw_k_a; const float* rw_r_k; const float* rw_ln_w; const float* rw_ln_b;
    const float* w_out; const float* norm_ffn_g; const float* r_grp_w; const float* r_grp_b; const float* r_exp_w; const float* r_exp_b;
    const float* w_gate; const float* w_up; const float* w_down; const float* final_g;
    float* out; unsigned char* ws;
};

typedef __bf16 bf16x2_t __attribute__((ext_vector_type(2)));
__device__ __forceinline__ unsigned cvt_pk_bf16(float lo, float hi) { const f32x2 v = {lo, hi}; return __builtin_bit_cast(unsigned, __builtin_convertvector(v, bf16x2_t)); }
__device__ __forceinline__ float bf16_lo(unsigned w) { return __uint_as_float(w << 16); }
__device__ __forceinline__ float bf16_hi(unsigned w) { return __uint_as_float(w & 0xffff0000u); }
__device__ __forceinline__ float fexp2(float x) { return __builtin_amdgcn_exp2f(x); }
__device__ __forceinline__ float flog2(float x) { return __builtin_amdgcn_logf(x); }
__device__ __forceinline__ float frcp(float x) { return __builtin_amdgcn_rcpf(x); }
__device__ __forceinline__ float frsq(float x) { return __builtin_amdgcn_rsqf(x); }
template <int CTRL> __device__ __forceinline__ float dppf(float v) { return __builtin_bit_cast(float, __builtin_amdgcn_update_dpp(0, __builtin_bit_cast(int, v), CTRL, 0xF, 0xF, true)); }
__device__ __forceinline__ float rlane(float v, int l) { return __builtin_bit_cast(float, __builtin_amdgcn_readlane(__builtin_bit_cast(int, v), l)); }
__device__ __forceinline__ float sum8(float v) { v += dppf<0xB1>(v); v += dppf<0x4E>(v); v += dppf<0x141>(v); return v; }
__device__ __forceinline__ float sum16(float v) { v = sum8(v); v += dppf<0x140>(v); return v; }
__device__ __forceinline__ float wave_sum(float v) { v = sum16(v); return (rlane(v, 0) + rlane(v, 16)) + (rlane(v, 32) + rlane(v, 48)); }
__device__ __forceinline__ float swap32(float v) { return __shfl_xor(v, 32); }
#define LDS_WAIT() asm volatile("s_waitcnt lgkmcnt(0)" ::: "memory")


#define XB_TMO      128
#define XB_XCNT(j)  (256  + 64 * (j))
#define XB_XSUB(j)  (1280 + 64 * (j))
#define XB_XGEN(j)  (2304 + 64 * (j))
#define XB_TOP      3328
#define XB_TOPGEN   3392
#define XCD_BAR_WORDS 3456
#define XB_SPIN_CAP (1u << 22)
__device__ __forceinline__ unsigned xb_ld(unsigned* p)              { return __hip_atomic_load(p, __ATOMIC_RELAXED, __HIP_MEMORY_SCOPE_AGENT); }
__device__ __forceinline__ unsigned xb_add(unsigned* p, unsigned v) { return __hip_atomic_fetch_add(p, v, __ATOMIC_RELAXED, __HIP_MEMORY_SCOPE_AGENT); }
__device__ __forceinline__ unsigned xb_xcc_id() { return (unsigned)__builtin_amdgcn_s_getreg((3 << 11) | 20) & 0xFu; }
#define XB_SPIN(cond, bar) do { unsigned _sp = 0; while (cond) { __builtin_amdgcn_s_sleep(1); \
    if ((++_sp & 255u) == 0u) { if (xb_ld(&(bar)[XB_TMO])) break; if (_sp > XB_SPIN_CAP) { atomicAdd(&(bar)[XB_TMO], 1u); break; } } } } while (0)
struct XcdBarrier { unsigned* bar; unsigned x; volatile LAS unsigned* st; };
__device__ __forceinline__ XcdBarrier xcd_barrier_post(unsigned* bar, volatile LAS unsigned* st) {
    XcdBarrier b; b.bar = bar; b.x = xb_xcc_id(); b.st = st;
    if (threadIdx.x == 0) (void)xb_add(&bar[XB_XCNT(b.x)], 1u);
    return b;
}
__device__ __forceinline__ void xcd_barrier_complete(unsigned* bar, unsigned x, unsigned& nloc, unsigned& nx) {
    const unsigned G = gridDim.x * gridDim.y * gridDim.z;
    unsigned sum, cnt, mine, sp = 0u;
    for (;;) {
        sum = 0u; cnt = 0u; mine = 0u;
#pragma unroll
        for (unsigned j = 0; j < 16; ++j) { const unsigned c = xb_ld(&bar[XB_XCNT(j)]); sum += c; cnt += (c > 0u) ? 1u : 0u; mine = (j == x) ? c : mine; }
        if (sum == G) break;
        __builtin_amdgcn_s_sleep(1);
        if ((++sp & 255u) == 0u) { if (xb_ld(&bar[XB_TMO])) break; if (sp > XB_SPIN_CAP) { atomicAdd(&bar[XB_TMO], 1u); break; } }
    }
    nloc = mine > 0u ? mine : 1u; nx = cnt > 0u ? cnt : 1u;
}
__device__ __forceinline__ void xcd_barrier(const XcdBarrier& b) {
    asm volatile("s_waitcnt vmcnt(0)" ::: "memory");
    __syncthreads();
    if (threadIdx.x == 0) {
        unsigned* bar = b.bar;
        __builtin_amdgcn_s_waitcnt(0);
        unsigned nloc = b.st[0], nx = b.st[1];
        if (nloc == 0u) { xcd_barrier_complete(bar, b.x, nloc, nx); b.st[0] = nloc; b.st[1] = nx; }
        const unsigned old = xb_add(&bar[XB_XSUB(b.x)], 1u);
        const unsigned gen = old / nloc;
        if (old + 1u == (gen + 1u) * nloc) {
            __builtin_amdgcn_fence(__ATOMIC_RELEASE, "agent");
            asm volatile("s_waitcnt vmcnt(0)" ::: "memory");
            const unsigned og = xb_add(&bar[XB_TOP], 1u);
            const unsigned tg = og / nx;
            if (og + 1u == (tg + 1u) * nx) xb_add(&bar[XB_TOPGEN], 1u);
            else XB_SPIN(xb_ld(&bar[XB_TOPGEN]) == tg, bar);
            __builtin_amdgcn_fence(__ATOMIC_ACQUIRE, "agent");
            xb_add(&bar[XB_XGEN(b.x)], 1u);
            asm volatile("s_waitcnt vmcnt(0)" ::: "memory");
        } else {
            XB_SPIN(xb_ld(&bar[XB_XGEN(b.x)]) == gen, bar);
            __builtin_amdgcn_fence(__ATOMIC_ACQUIRE, "agent");
            asm volatile("s_waitcnt vmcnt(0)" ::: "memory");
        }
    }
    __syncthreads();
}

namespace g8 {
constexpr int BK = 64, HALF = 128, HTB = HALF * BK * 2;
__device__ __forceinline__ int lds_byte(int r, int c) { const int st = (r >> 4) * 2 + (c >> 5), rr = r & 15, cc = c & 31, ob = rr * 64 + cc * 2; return st * 1024 + (ob ^ (((ob >> 9) & 1) << 5)); }
__device__ __forceinline__ void stage_rc(int b, int& R, int& C) { const int st = b / 1024, sb = b % 1024, swz = sb ^ (((sb >> 9) & 1) << 5); R = (st >> 1) * 16 + swz / 64; C = (st & 1) * 32 + (swz % 64) / 2; }

#define G8_SA(b, h) (((b) * 2 + (h)) * HTB)
#define G8_SB(b, h) ((4 + (b) * 2 + (h)) * HTB)
#define G8_STAGE_A(bufoff, h, kt) do { _Pragma("unroll") for (int _i = 0; _i < 2; ++_i) \
    __builtin_amdgcn_global_load_lds((const unsigned*)((Ab + (size_t)(kt) * (BK * 2)) + aoff[h][_i]), (LAS unsigned*)(lds + (bufoff) + ldsw + _i * 8192), 16, 0, 0); } while (0)
#define G8_STAGE_B(bufoff, h, kt) do { _Pragma("unroll") for (int _i = 0; _i < 2; ++_i) \
    __builtin_amdgcn_global_load_lds((const unsigned*)((Bb + (size_t)(h) * bhalf + (size_t)(kt) * (BK * 2)) + boff[_i]), (LAS unsigned*)(lds + (bufoff) + ldsw + _i * 8192), 16, 0, 0); } while (0)
#define G8_LDA(dst, b, h) do { _Pragma("unroll") for (int m = 0; m < 4; ++m) _Pragma("unroll") for (int k = 0; k < 2; ++k) dst[m][k] = *(const LAS bf16x8*)(lds + G8_SA(b, h) + la_off + m * 2048 + k * 1024); } while (0)
#define G8_LDB(dst, b, h) do { _Pragma("unroll") for (int n = 0; n < 2; ++n) _Pragma("unroll") for (int k = 0; k < 2; ++k) dst[n][k] = *(const LAS bf16x8*)(lds + G8_SB(b, h) + lb_off + n * 2048 + k * 1024); } while (0)
#define G8_MMA(ai, bj, At, Bt) do { __builtin_amdgcn_s_setprio(1); _Pragma("unroll") for (int m = 0; m < 4; ++m) _Pragma("unroll") for (int n = 0; n < 2; ++n) _Pragma("unroll") for (int k = 0; k < 2; ++k) \
    acc[ai][bj][m][n] = __builtin_amdgcn_mfma_f32_16x16x32_bf16(Bt[n][k], At[m][k], acc[ai][bj][m][n], 0, 0, 0); __builtin_amdgcn_s_setprio(0); } while (0)
#define G8_WAIT_V(n) asm volatile("s_waitcnt vmcnt(" #n ")" ::: "memory")
#define G8_WAIT_L(n) asm volatile("s_waitcnt lgkmcnt(" #n ")" ::: "memory")
#define G8_BAR __builtin_amdgcn_s_barrier()
#define G8_SCHED __builtin_amdgcn_sched_barrier(0)

template <class Epi>
__device__ __forceinline__ void gemm_unit(LAS unsigned char* lds, const char* Ab, const unsigned (&aoff)[2][2], const char* Bb, int K, const Epi& E) {
    int tid = threadIdx.x; asm volatile("" : "+v"(tid));
    const int wid = __builtin_amdgcn_readfirstlane(tid >> 6), lane = tid & 63, wr = wid >> 2, wc = wid & 3, fr = lane & 15, fq = lane >> 4;
    const int nt = K / BK;
    unsigned boff[2];
#pragma unroll
    for (int i = 0; i < 2; ++i) { int R, C; stage_rc(tid * 16 + i * 8192, R, C); boff[i] = (unsigned)(R * K + C) * 2u; }
    const size_t bhalf = (size_t)HALF * K * 2;
    const unsigned ldsw = (unsigned)wid * 1024u;
    const int la_off = lds_byte(wr * 64 + fr, fq * 8), lb_off = lds_byte(wc * 32 + fr, fq * 8);
    f32x4 acc[2][2][4][2];
#pragma unroll
    for (int a = 0; a < 2; ++a)
#pragma unroll
        for (int b = 0; b < 2; ++b)
#pragma unroll
            for (int m = 0; m < 4; ++m)
#pragma unroll
                for (int n = 0; n < 2; ++n) acc[a][b][m][n] = (f32x4){0.f, 0.f, 0.f, 0.f};
    bf16x8 At[4][2], B0[2][2], B1[2][2];
    G8_STAGE_B(G8_SB(0, 0), 0, 0); G8_STAGE_A(G8_SA(0, 0), 0, 0);
    G8_STAGE_B(G8_SB(0, 1), 1, 0); G8_STAGE_A(G8_SA(0, 1), 1, 0);
    if (wr == 1) G8_BAR;
    G8_WAIT_V(4); G8_BAR;
    G8_STAGE_B(G8_SB(1, 0), 0, 1); G8_STAGE_A(G8_SA(1, 0), 0, 1); G8_STAGE_B(G8_SB(1, 1), 1, 1);
    G8_WAIT_V(6); G8_BAR;
    for (int t = 0; t < nt - 2; t += 2) {
        G8_LDB(B0, 0, 0); G8_SCHED; G8_LDA(At, 0, 0); G8_STAGE_A(G8_SA(1, 1), 1, t + 1);
        G8_WAIT_L(8); G8_BAR; G8_WAIT_L(0); G8_MMA(0, 0, At, B0); G8_BAR; G8_SCHED;
        G8_LDB(B1, 0, 1); G8_STAGE_B(G8_SB(0, 0), 0, t + 2);
        G8_BAR; G8_WAIT_L(0); G8_MMA(0, 1, At, B1); G8_BAR;
        G8_LDA(At, 0, 1); G8_STAGE_A(G8_SA(0, 0), 0, t + 2);
        G8_BAR; G8_WAIT_L(0); G8_MMA(1, 0, At, B0); G8_BAR; G8_SCHED;
        G8_STAGE_B(G8_SB(0, 1), 1, t + 2);
        G8_WAIT_V(6); G8_BAR; G8_MMA(1, 1, At, B1); G8_BAR;
        G8_LDB(B0, 1, 0); G8_SCHED; G8_LDA(At, 1, 0); G8_STAGE_A(G8_SA(0, 1), 1, t + 2);
        G8_WAIT_L(8); G8_BAR; G8_WAIT_L(0); G8_MMA(0, 0, At, B0); G8_BAR; G8_SCHED;
        G8_LDB(B1, 1, 1); G8_STAGE_B(G8_SB(1, 0), 0, t + 3);
        G8_BAR; G8_WAIT_L(0); G8_MMA(0, 1, At, B1); G8_BAR;
        G8_LDA(At, 1, 1); G8_STAGE_A(G8_SA(1, 0), 0, t + 3);
        G8_BAR; G8_WAIT_L(0); G8_MMA(1, 0, At, B0); G8_BAR; G8_SCHED;
        G8_STAGE_B(G8_SB(1, 1), 1, t + 3);
        G8_WAIT_V(6); G8_BAR; G8_MMA(1, 1, At, B1); G8_BAR;
    }
    { G8_LDB(B0, 0, 0); G8_LDA(At, 0, 0); G8_STAGE_A(G8_SA(1, 1), 1, nt - 1);
      G8_BAR; G8_WAIT_L(0); G8_MMA(0, 0, At, B0); G8_BAR;
      G8_LDB(B1, 0, 1); G8_BAR; G8_WAIT_L(0); G8_MMA(0, 1, At, B1); G8_BAR;
      G8_LDA(At, 0, 1); G8_WAIT_V(4); G8_BAR; G8_WAIT_L(0); G8_MMA(1, 0, At, B0); G8_MMA(1, 1, At, B1); G8_BAR; }
    { G8_LDB(B0, 1, 0); G8_LDA(At, 1, 0); G8_WAIT_V(2); G8_BAR; G8_WAIT_L(0); G8_MMA(0, 0, At, B0); G8_BAR;
      G8_LDB(B1, 1, 1); G8_WAIT_V(0); G8_BAR; G8_WAIT_L(0); G8_MMA(0, 1, At, B1); G8_BAR;
      G8_LDA(At, 1, 1); G8_BAR; G8_WAIT_L(0); G8_MMA(1, 0, At, B0); G8_MMA(1, 1, At, B1); G8_BAR; }
    if (wr == 0) G8_BAR;
    asm volatile("" ::: "memory");
    E(acc, wr, wc, fr, fq);
    __syncthreads();
}
__device__ __forceinline__ void aoff_rows(unsigned (&aoff)[2][2], int K) {
    int tid = threadIdx.x; asm volatile("" : "+v"(tid));
#pragma unroll
    for (int i = 0; i < 2; ++i) { int R, C; stage_rc(tid * 16 + i * 8192, R, C);
#pragma unroll
        for (int h = 0; h < 2; ++h) aoff[h][i] = (unsigned)((h * HALF + R) * K + C) * 2u; }
}
__device__ __forceinline__ void tile_order(int L, int nM, int nN, int& pm, int& pn) {
    const int nwg = nM * nN; int wgid = L;
    { const int q = nwg / 8, r = nwg % 8, xcd = wgid % 8, off = wgid / 8; wgid = (xcd < r ? xcd * (q + 1) : r * (q + 1) + (xcd - r) * q) + off; }
    const int nig = 8 * nN, gid = wgid / nig, fm = gid * 8, gsz = (nM - fm) < 8 ? (nM - fm) : 8;
    pm = fm + ((wgid % nig) % gsz); pn = (wgid % nig) / gsz;
}
}

__device__ __forceinline__ void p0_transpose_item(const float* W, int K, int N, int k0, int n0, bf16_t* WTrow0  , const float* kscale, float mul, LAS float* scr, int lane) {
#pragma unroll 8
    for (int i = 0; i < 32; ++i) { const int kk = 2 * i + (lane >> 5); float v = W[(size_t)(k0 + kk) * N + n0 + (lane & 31)]; if (kscale) v *= kscale[k0 + kk]; scr[kk * 33 + (lane & 31)] = v * mul; }
    LDS_WAIT();
    const int c = lane & 7;
#pragma unroll
    for (int j = 0; j < 4; ++j) { const int n = (lane >> 3) + 8 * j; const LAS float* s = scr + (8 * c) * 33 + n;
        u32x4 o; o.x = cvt_pk_bf16(s[0 * 33], s[1 * 33]); o.y = cvt_pk_bf16(s[2 * 33], s[3 * 33]); o.z = cvt_pk_bf16(s[4 * 33], s[5 * 33]); o.w = cvt_pk_bf16(s[6 * 33], s[7 * 33]);
        *(u32x4*)(WTrow0 + (size_t)n * K + k0 + 8 * c) = o; }
    LDS_WAIT();
}

__device__ __forceinline__ void p0_expert_weights(const Params& p, LAS unsigned char* lds, int gw, int NGW) {
    const int wave = threadIdx.x >> 6, lane = threadIdx.x & 63;
    LAS float* scr = (LAS float*)(lds + 49152 + wave * 8704);
    bf16_t* wgu = (bf16_t*)(p.ws + WS_WGU); bf16_t* wdn = (bf16_t*)(p.ws + WS_WDN);
    constexpr int I_G = NE * 16 * 8, I_D = NE * 4 * 32;
    for (int it = gw; it < 2 * I_G + I_D; it += NGW) {
        int r = it;
        if (r < 2 * I_G) { const int up = r >= I_G; if (up) r -= I_G; const int e = r / 128, q = r % 128, kb = q / 8, nb = q % 8, n0 = nb * 32;
            const int drow = (n0 >> 7) * 256 + up * 128 + (n0 & 127);
            p0_transpose_item((up ? p.w_up : p.w_gate) + (size_t)e * D * DE, D, DE, kb * 64, n0, wgu + ((size_t)e * 512 + drow) * D, p.norm_ffn_g, 1.f, scr, lane); continue; } r -= 2 * I_G;
        { const int e = r / 128, q = r % 128, kb = q / 32, nb = q % 32, n0 = nb * 32;
            p0_transpose_item(p.w_down + (size_t)e * DE * D, DE, D, kb * 64, n0, wdn + ((size_t)e * D + n0) * DE, nullptr, 1.f, scr, lane); }
    }
}
__device__ __forceinline__ void phase0(const Params& p, LAS unsigned char* lds) {
    int tid = threadIdx.x; asm volatile("" : "+v"(tid));
    const int wave = tid >> 6, lane = tid & 63;
    const int gw = blockIdx.x * NWAVES + wave, NGW = gridDim.x * NWAVES;
    LAS float* scr = (LAS float*)(lds + wave * 8704);
    bf16_t* win = (bf16_t*)(p.ws + WS_WIN); bf16_t* wout = (bf16_t*)(p.ws + WS_WOUT);
    constexpr int I_IN = 16 * 104, I_OUT = 16 * 32;
    for (int it = gw; it < I_IN + I_OUT; it += NGW) {
        int r = it;
        if (r < I_IN) { const int kb = r / 104, nb = r % 104, n0 = nb * 32; p0_transpose_item(p.w_in, D, NIN, kb * 64, n0, win + (size_t)n0 * D, p.norm_mix_g, n0 < 512 ? QSCALE : 1.f, scr, lane); continue; } r -= I_IN;
        { const int kb = r / 32, nb = r % 32, n0 = nb * 32; p0_transpose_item(p.w_out, D, D, kb * 64, n0, wout + (size_t)n0 * D, nullptr, 1.f, scr, lane); }
    }
    bf16_t* xb = (bf16_t*)(p.ws + WS_B); float* rstd1 = (float*)(p.ws + WS_RSTD1);
    for (int row = gw; row < T; row += NGW) {
        const f32x4* xr = (const f32x4*)(p.x + (size_t)row * D) + lane; f32x4 v[4]; float s = 0.f;
#pragma unroll
        for (int j = 0; j < 4; ++j) { v[j] = xr[64 * j]; s += (v[j].x * v[j].x + v[j].y * v[j].y) + (v[j].z * v[j].z + v[j].w * v[j].w); }
        s = wave_sum(s);
        u32x2* o = (u32x2*)(xb + (size_t)row * D) + lane;
#pragma unroll
        for (int j = 0; j < 4; ++j) { u32x2 w; w.x = cvt_pk_bf16(v[j].x, v[j].y); w.y = cvt_pk_bf16(v[j].z, v[j].w); o[64 * j] = w; }
        if (lane == 0) rstd1[row] = 1.0f / sqrtf(s * (1.0f / D) + 1e-6f);
    }
    bf16_t* wr_hi = (bf16_t*)(p.ws + WS_WR); bf16_t* wr_lo = wr_hi + 48 * D;
    for (int i = blockIdx.x * NTHREADS + tid; i < 48 * D; i += gridDim.x * NTHREADS) {
        const int c = i / D, k = i % D; float w = 0.f;
        if (c < 4) w = p.r_grp_w[k * 4 + c]; else if (c < 36) w = p.r_exp_w[k * 32 + (c - 4)];
        w *= p.norm_ffn_g[k];
        const unsigned hi = cvt_pk_bf16(w, 0.f) & 0xffffu; const float rem = w - __uint_as_float(hi << 16);
        wr_hi[i] = (bf16_t)hi; wr_lo[i] = (bf16_t)(cvt_pk_bf16(rem, 0.f) & 0xffffu);
    }
    { bf16_t* w2t = (bf16_t*)(p.ws + WS_LT); bf16_t* a2t = w2t + 512 * 64; bf16_t* g2t = a2t + 512 * 64;
      for (int i = blockIdx.x * NTHREADS + tid; i < 512 * 256; i += gridDim.x * NTHREADS) {
          if (i < 512 * 64) { const int c = i >> 6, m = i & 63; w2t[i] = (bf16_t)(cvt_pk_bf16(p.rw_w2[m * 512 + c], 0.f) & 0xffffu); }
          else if (i < 2 * 512 * 64) { const int q = i - 512 * 64, c = q >> 6, m = q & 63; a2t[q] = (bf16_t)(cvt_pk_bf16(p.rw_a2[m * 512 + c], 0.f) & 0xffffu); }
          else { const int q = i - 2 * 512 * 64, c = q >> 7, m = q & 127; g2t[q] = (bf16_t)(cvt_pk_bf16(p.rw_g2[m * 512 + c], 0.f) & 0xffffu); } } }
    if (blockIdx.x == 0 && tid < 64) ((unsigned*)(p.ws + WS_CTL))[tid] = 0u;
}

struct EpiU {
    bf16_t* u; const float* rstd; int row0, col0;
    __device__ __forceinline__ void operator()(const f32x4 (&acc)[2][2][4][2], int wr, int wc, int fr, int fq) const {
#pragma unroll
        for (int ai = 0; ai < 2; ++ai)
#pragma unroll
            for (int m = 0; m < 4; ++m) { const int row = row0 + ai * 128 + wr * 64 + m * 16 + fr; const float rs = rstd[row]; bf16_t* rp = u + (size_t)row * NIN + col0 + wc * 32 + 4 * fq;
#pragma unroll
                for (int bj = 0; bj < 2; ++bj)
#pragma unroll
                    for (int n = 0; n < 2; ++n) { const f32x4 v = acc[ai][bj][m][n] * rs; u32x2 w; w.x = cvt_pk_bf16(v[0], v[1]); w.y = cvt_pk_bf16(v[2], v[3]); *(u32x2*)(rp + bj * 128 + n * 16) = w; } }
    }
};
__device__ __forceinline__ void phase1(const Params& p, LAS unsigned char* lds) {
    constexpr int nM = T / 256, nN = NIN / 256;
    unsigned aoff[2][2]; g8::aoff_rows(aoff, D);
    for (int L = blockIdx.x; L < nM * nN; L += gridDim.x) {
        int pm, pn; g8::tile_order(L, nM, nN, pm, pn);
        EpiU E{(bf16_t*)(p.ws + WS_A), (const float*)(p.ws + WS_RSTD1), pm * 256, pn * 256};
        g8::gemm_unit(lds, (const char*)(p.ws + WS_B) + (size_t)pm * 256 * D * 2, aoff, (const char*)(p.ws + WS_WIN) + (size_t)pn * 256 * D * 2, D, E);
    }
}


typedef short v4i16_t __attribute__((ext_vector_type(4)));
__device__ __forceinline__ s16x4 lds_tr16(const LAS unsigned char* p) { return __builtin_bit_cast(s16x4, __builtin_amdgcn_ds_read_tr16_b64_v4i16((LAS v4i16_t*)p)); }

__device__ __forceinline__ void attn_tile(const Params& p, LAS unsigned char* vl  , int b, int h, int qt) {
    const int lane = threadIdx.x & 63, r32 = lane & 31, hi = lane >> 5;
    const bf16_t* u = (const bf16_t*)(p.ws + WS_A);
    const size_t row0 = (size_t)b * S; const int q0 = qt * 32;
    bf16x8 qf[4];
    { const bf16_t* qp = u + (row0 + q0 + r32) * NIN + UQ + h * HD + 8 * hi;
#pragma unroll
      for (int s = 0; s < 4; ++s) qf[s] = *(const bf16x8*)(qp + 16 * s); }
    f32x16 o0, o1;
#pragma unroll
    for (int i = 0; i < 16; ++i) { o0[i] = 0.f; o1[i] = 0.f; }
    float carry = 0.f;
    const int kperm = 16 * ((r32 >> 2) & 1) + (r32 & 3) + 4 * (r32 >> 3);
    const int g = lane >> 4, i16 = lane & 15, tq = i16 >> 2, tp = i16 & 3;
    const LAS unsigned char* vrd = vl + (16 * (g >> 1) + tq) * 144 + (16 * (g & 1) + 4 * tp) * 2;
    LAS unsigned char* vwr = vl + (lane >> 1) * 144 + (lane & 1) * 64;
    for (int kb = qt; kb >= 0; --kb) {
        const int key0 = kb * 32;
        { const bf16_t* vp = u + (row0 + key0 + (lane >> 1)) * NIN + UV + h * HD + 32 * (lane & 1);
          u32x4 v0 = *(const u32x4*)(vp), v1 = *(const u32x4*)(vp + 8), v2 = *(const u32x4*)(vp + 16), v3 = *(const u32x4*)(vp + 24);
          *(LAS u32x4*)(vwr) = v0; *(LAS u32x4*)(vwr + 16) = v1; *(LAS u32x4*)(vwr + 32) = v2; *(LAS u32x4*)(vwr + 48) = v3; }
        f32x16 st;
#pragma unroll
        for (int i = 0; i < 16; ++i) st[i] = 0.f;
        { const bf16_t* kp = u + (row0 + key0 + kperm) * NIN + UK + h * HD + 8 * hi;
          bf16x8 kf[4];
#pragma unroll
          for (int s = 0; s < 4; ++s) kf[s] = *(const bf16x8*)(kp + 16 * s);
#pragma unroll
          for (int s = 0; s < 4; ++s) st = __builtin_amdgcn_mfma_f32_32x32x16_bf16(kf[s], qf[s], st, 0, 0, 0); }
        const bool diag = (kb == qt);
        float lw[16], suf[16];
        float run = 0.f;
#pragma unroll
        for (int reg = 15; reg >= 0; --reg) {
            const float z = st[reg];
            const float l = flog2(1.0f + fexp2(-fabsf(z)));
            const float sp = fmaxf(z, 0.f) + l;
            const bool valid = !diag || (16 * hi + reg < r32);
            lw[reg] = valid ? (z - sp) : -1.0e30f;
            suf[reg] = run;
            run += valid ? -sp : 0.f;
        }
        const float other = swap32(run);
        const float tot_hi = hi ? run : other, tot_lo = hi ? other : run;
        const float base = carry + (hi ? 0.f : tot_hi);
        carry += tot_lo + tot_hi;
        unsigned pk[8];
#pragma unroll
        for (int j = 0; j < 8; ++j) pk[j] = cvt_pk_bf16(fexp2(lw[2 * j] + suf[2 * j] + base), fexp2(lw[2 * j + 1] + suf[2 * j + 1] + base));
        LDS_WAIT();
#pragma unroll
        for (int s2 = 0; s2 < 2; ++s2) {
            bf16x8 pf = __builtin_bit_cast(bf16x8, (u32x4){pk[4 * s2], pk[4 * s2 + 1], pk[4 * s2 + 2], pk[4 * s2 + 3]});
#pragma unroll
            for (int dh = 0; dh < 2; ++dh) {
                const s16x4 a = lds_tr16(vrd + (8 * s2) * 144 + 64 * dh), c = lds_tr16(vrd + (8 * s2 + 4) * 144 + 64 * dh);
                bf16x8 vf; vf[0] = a[0]; vf[1] = a[1]; vf[2] = a[2]; vf[3] = a[3]; vf[4] = c[0]; vf[5] = c[1]; vf[6] = c[2]; vf[7] = c[3];
                if (dh == 0) o0 = __builtin_amdgcn_mfma_f32_32x32x16_bf16(vf, pf, o0, 0, 0, 0); else o1 = __builtin_amdgcn_mfma_f32_32x32x16_bf16(vf, pf, o1, 0, 0, 0);
            }
        }
        LDS_WAIT();
        if (__builtin_amdgcn_ballot_w64(carry > -150.0f) == 0ull) break;
    }
    float ss = 0.f;
#pragma unroll
    for (int i = 0; i < 16; ++i) ss += o0[i] * o0[i] + o1[i] * o1[i];
    ss += swap32(ss);
    const float rs = 1.0f / sqrtf(ss * (1.0f / HD) + 1e-6f);
    bf16_t* op = (bf16_t*)(p.ws + WS_B) + (row0 + q0 + r32) * D + h * HD + 4 * hi;
    const float* gp = p.sb_out_g + h * HD + 4 * hi;
#pragma unroll
    for (int dh = 0; dh < 2; ++dh)
#pragma unroll
        for (int gq = 0; gq < 4; ++gq) {
            const f32x4 gg = *(const f32x4*)(gp + 32 * dh + 8 * gq);
            const f32x16& o = dh ? o1 : o0;
            u32x2 w; w.x = cvt_pk_bf16(o[4 * gq] * rs * gg[0], o[4 * gq + 1] * rs * gg[1]); w.y = cvt_pk_bf16(o[4 * gq + 2] * rs * gg[2], o[4 * gq + 3] * rs * gg[3]);
            *(u32x2*)(op + 32 * dh + 8 * gq) = w;
        }
}

namespace rk {
constexpr int C = 32, NCH = S / C, NSLOT = 16;
constexpr int SL_PS = 0, SL_QS = 8192, SL_PO = 12288, SL_QO = 16384, SL_VR = 18432, SL_GB = 22528, SL_GW = 26624, SLOT_BYTES = 30720;
constexpr int MSTR = 144;
constexpr int PM_AT = 0, PM_RT = 4608, PM_BT = 9216, PM_KT = 13824, PM_GC = 18432, PROD_LDS = 18688;
constexpr int NPROD = 6;
constexpr int L_CONS = NPROD * PROD_LDS;
constexpr int OSTR = 272;
constexpr int L_OBUF = L_CONS + 4608;
constexpr int L_FLAG = L_OBUF + 32 * OSTR;
constexpr int L_W2 = L_FLAG + 256;
constexpr int L_A2 = L_W2 + 8192;
constexpr int L_G2 = L_A2 + 8192;
constexpr int L_CST = L_G2 + 16384;
constexpr int C_MUL = 0, C_MUR = 256, C_MUK = 320, C_MUV = 384, C_W0 = 448, C_A0 = 512, C_KK = 576, C_KA = 640, C_RK = 704, C_LNB = 768, C_END = 832;
static_assert(L_CST + C_END * 4 <= 161792, "rwkv LDS layout overflows");
}
__device__ __forceinline__ bf16x8 accfrag(const f32x16& a, int s) {
    return __builtin_bit_cast(bf16x8, (u32x4){cvt_pk_bf16(a[8 * s], a[8 * s + 1]), cvt_pk_bf16(a[8 * s + 2], a[8 * s + 3]), cvt_pk_bf16(a[8 * s + 4], a[8 * s + 5]), cvt_pk_bf16(a[8 * s + 6], a[8 * s + 7])});
}
__device__ __forceinline__ bf16x8 trfrag(const LAS unsigned char* mat, int s, int nt, int lane) {
    const int g = lane >> 4, i16 = lane & 15, q = i16 >> 2, pp = i16 & 3, h = g >> 1;
    const LAS unsigned char* a = mat + (16 * s + 4 * h + q) * rk::MSTR + (32 * nt + 16 * (g & 1) + 4 * pp) * 2;
    const s16x4 x = lds_tr16(a), y = lds_tr16(a + 8 * rk::MSTR);
    bf16x8 r; r[0] = x[0]; r[1] = x[1]; r[2] = x[2]; r[3] = x[3]; r[4] = y[0]; r[5] = y[1]; r[6] = y[2]; r[7] = y[3]; return r;
}
__device__ __forceinline__ void f8_from_bf16(const u32x4 w, float (&o)[8]) {
#pragma unroll
    for (int j = 0; j < 4; ++j) { o[2 * j] = bf16_lo(w[j]); o[2 * j + 1] = bf16_hi(w[j]); }
}
__device__ __forceinline__ f32x16 mfma32(bf16x8 a, bf16x8 b, f32x16 c) { return __builtin_amdgcn_mfma_f32_32x32x16_bf16(a, b, c, 0, 0, 0); }
__device__ __forceinline__ f32x16 zero16() { f32x16 z; for (int i = 0; i < 16; ++i) z[i] = 0.f; return z; }
__device__ __forceinline__ void um8(const bf16_t* urow  , bool has_prev, const float* mu, float (&o)[8]) {
    const u32x4 c = *(const u32x4*)urow; u32x4 pv = (u32x4){0u, 0u, 0u, 0u}; if (has_prev) pv = *(const u32x4*)(urow - NIN);
    const f32x4 m0 = *(const f32x4*)mu, m1 = *(const f32x4*)(mu + 4);
    float cv[8], pf[8]; f8_from_bf16(c, cv); f8_from_bf16(pv, pf);
#pragma unroll
    for (int j = 0; j < 4; ++j) { o[j] = cv[j] + (pf[j] - cv[j]) * m0[j]; o[4 + j] = cv[4 + j] + (pf[4 + j] - cv[4 + j]) * m1[j]; }
}
__device__ __forceinline__ void lerp8(const u32x4 c, const u32x4 pv, const LAS float* mu, float (&o)[8]) {
    const f32x4 m0 = *(const LAS f32x4*)mu, m1 = *(const LAS f32x4*)(mu + 4);
    float cv[8], pf[8]; f8_from_bf16(c, cv); f8_from_bf16(pv, pf);
#pragma unroll
    for (int j = 0; j < 4; ++j) { o[j] = cv[j] + (pf[j] - cv[j]) * m0[j]; o[4 + j] = cv[4 + j] + (pf[4 + j] - cv[4 + j]) * m1[j]; }
}
__device__ __forceinline__ void lerp8(const u32x4 c, const u32x4 pv, const float* mu, float (&o)[8]) {
    const f32x4 m0 = *(const f32x4*)mu, m1 = *(const f32x4*)(mu + 4);
    float cv[8], pf[8]; f8_from_bf16(c, cv); f8_from_bf16(pv, pf);
#pragma unroll
    for (int j = 0; j < 4; ++j) { o[j] = cv[j] + (pf[j] - cv[j]) * m0[j]; o[4 + j] = cv[4 + j] + (pf[4 + j] - cv[4 + j]) * m1[j]; }
}
__device__ __forceinline__ float scan32(float x) {
    x += dppf<0x111>(x); x += dppf<0x112>(x); x += dppf<0x114>(x); x += dppf<0x118>(x);
    const float bc = __builtin_bit_cast(float, __builtin_amdgcn_update_dpp(0, __builtin_bit_cast(int, x), 0x142, 0xA, 0xF, false));
    return x + bc;
}

__device__ __forceinline__ void rk_produce(const Params& p, LAS unsigned char* lds, LAS unsigned char* pl  , unsigned char* slot, int b, int hh, int c) {
    using namespace rk;
    int lane = threadIdx.x & 63; asm volatile("" : "+v"(lane));
    const int r32 = lane & 31, h = lane >> 5;
    const bf16_t* u = (const bf16_t*)(p.ws + WS_A);
    const size_t row0 = (size_t)b * S; const int t0 = c * C; const int tt = t0 + r32; const bool hp = tt > 0;
    const bf16_t* urow = u + (row0 + tt) * NIN;
    const LAS float* cst = (const LAS float*)(lds + L_CST);
    const int jrow0 = 32 * ((r32 >> 2) & 1) + (r32 & 3) + 4 * (r32 >> 3);
    f32x16 lw[2], la[2], lg[2];
#pragma unroll
    for (int mt = 0; mt < 2; ++mt) { lw[mt] = zero16(); la[mt] = zero16(); lg[mt] = zero16(); }
    {
        u32x4 cw[4], pw[4], ca[4], pa4[4];
#pragma unroll
        for (int s = 0; s < 4; ++s) { const bf16_t* a = urow + UXW + 16 * s + 8 * h; const bf16_t* bq = urow + UXA + 16 * s + 8 * h;
            cw[s] = *(const u32x4*)a; ca[s] = *(const u32x4*)bq; pw[s] = (u32x4){0u, 0u, 0u, 0u}; pa4[s] = (u32x4){0u, 0u, 0u, 0u};
            if (hp) { pw[s] = *(const u32x4*)(a - NIN); pa4[s] = *(const u32x4*)(bq - NIN); } }
#pragma unroll
        for (int s = 0; s < 4; ++s) {
            float xv[8]; lerp8(cw[s], pw[s], cst + C_MUL + 16 * s + 8 * h, xv);
#pragma unroll
            for (int j = 0; j < 8; ++j) xv[j] = 1.0f - 2.0f * frcp(1.0f + fexp2(xv[j] * (2.0f * LOG2E)));
            const bf16x8 bw = __builtin_bit_cast(bf16x8, (u32x4){cvt_pk_bf16(xv[0], xv[1]), cvt_pk_bf16(xv[2], xv[3]), cvt_pk_bf16(xv[4], xv[5]), cvt_pk_bf16(xv[6], xv[7])});
            float xa[8]; lerp8(ca[s], pa4[s], cst + C_MUL + 64 + 16 * s + 8 * h, xa);
            const bf16x8 ba = __builtin_bit_cast(bf16x8, (u32x4){cvt_pk_bf16(xa[0], xa[1]), cvt_pk_bf16(xa[2], xa[3]), cvt_pk_bf16(xa[4], xa[5]), cvt_pk_bf16(xa[6], xa[7])});
#pragma unroll
            for (int mt = 0; mt < 2; ++mt) {
                const int jl = jrow0 + 16 * mt, sw = (((2 * s + h) ^ (jl & 7)) << 4);
                lw[mt] = mfma32(*(const LAS bf16x8*)(lds + L_W2 + jl * 128 + sw), bw, lw[mt]);
                la[mt] = mfma32(*(const LAS bf16x8*)(lds + L_A2 + jl * 128 + sw), ba, la[mt]);
            }
        }
    }
    asm volatile("" ::: "memory");
    {
        u32x4 cg[8], pg[8];
#pragma unroll
        for (int s = 0; s < 8; ++s) { const bf16_t* a = urow + UXG + 16 * s + 8 * h; cg[s] = *(const u32x4*)a; pg[s] = (u32x4){0u, 0u, 0u, 0u}; if (hp) pg[s] = *(const u32x4*)(a - NIN); }
#pragma unroll
        for (int s = 0; s < 8; ++s) {
            float xg[8]; lerp8(cg[s], pg[s], cst + C_MUL + 128 + 16 * s + 8 * h, xg);
#pragma unroll
            for (int j = 0; j < 8; ++j) xg[j] = frcp(1.0f + fexp2(-xg[j] * LOG2E));
            const bf16x8 bgf = __builtin_bit_cast(bf16x8, (u32x4){cvt_pk_bf16(xg[0], xg[1]), cvt_pk_bf16(xg[2], xg[3]), cvt_pk_bf16(xg[4], xg[5]), cvt_pk_bf16(xg[6], xg[7])});
#pragma unroll
            for (int mt = 0; mt < 2; ++mt) { const int jl = jrow0 + 16 * mt; lg[mt] = mfma32(*(const LAS bf16x8*)(lds + L_G2 + jl * 256 + (((2 * s + h) ^ (jl & 7)) << 4)), bgf, lg[mt]); }
        }
    }
#pragma unroll
    for (int mt = 0; mt < 2; ++mt) {
        u32x4 w0, w1; w0.x = cvt_pk_bf16(lg[mt][0], lg[mt][1]); w0.y = cvt_pk_bf16(lg[mt][2], lg[mt][3]); w0.z = cvt_pk_bf16(lg[mt][4], lg[mt][5]); w0.w = cvt_pk_bf16(lg[mt][6], lg[mt][7]);
        w1.x = cvt_pk_bf16(lg[mt][8], lg[mt][9]); w1.y = cvt_pk_bf16(lg[mt][10], lg[mt][11]); w1.z = cvt_pk_bf16(lg[mt][12], lg[mt][13]); w1.w = cvt_pk_bf16(lg[mt][14], lg[mt][15]);
        u32x4* d = (u32x4*)(slot + SL_GW + r32 * 128 + (32 * h + 16 * mt) * 2); d[0] = w0; d[1] = w1;
    }
    asm volatile("" ::: "memory");
    const int cb = hh * HD + 32 * h;
    u32x4 ck[4], pk4[4], cr[4], pr4[4];
#pragma unroll
    for (int q = 0; q < 4; ++q) { const bf16_t* a = urow + URK + cb + 8 * q; const bf16_t* bq = urow + UR + cb + 8 * q;
        ck[q] = *(const u32x4*)a; cr[q] = *(const u32x4*)bq; pk4[q] = (u32x4){0u, 0u, 0u, 0u}; pr4[q] = pk4[q];
        if (hp) { pk4[q] = *(const u32x4*)(a - NIN); pr4[q] = *(const u32x4*)(bq - NIN); } }
    float ssq = 0.f;
#pragma unroll
    for (int q = 0; q < 4; ++q) {
        float t8[8]; lerp8(ck[q], pk4[q], cst + C_MUK + 32 * h + 8 * q, t8);
        const f32x4 c0 = *(const LAS f32x4*)(cst + C_KK + 32 * h + 8 * q), c1 = *(const LAS f32x4*)(cst + C_KK + 32 * h + 8 * q + 4);
#pragma unroll
        for (int j = 0; j < 4; ++j) { const float x0 = t8[j] * c0[j], x1 = t8[4 + j] * c1[j]; ssq += x0 * x0 + x1 * x1; }
    }
    ssq += swap32(ssq);
    const float kinv = frsq(fmaxf(ssq, 1e-24f));
    float bonus = 0.f;
    LAS unsigned char* mAT = pl + PM_AT; LAS unsigned char* mRT = pl + PM_RT; LAS unsigned char* mBT = pl + PM_BT; LAS unsigned char* mKT = pl + PM_KT;
    LAS float* gc = (LAS float*)(pl + PM_GC);
#pragma unroll
    for (int mt = 0; mt < 2; ++mt) {
#pragma unroll
        for (int q8 = 0; q8 < 2; ++q8) {
            const int jl0 = 32 * h + 16 * mt + 8 * q8, q = 2 * mt + q8;
            float k8[8], r8[8];
            lerp8(ck[q], pk4[q], cst + C_MUK + jl0, k8);
            lerp8(cr[q], pr4[q], cst + C_MUR + jl0, r8);
            float cw0[8], ca0[8], ckk[8], cka[8], crk[8];
#pragma unroll
            for (int e = 0; e < 2; ++e) { const f32x4 a = *(const LAS f32x4*)(cst + C_W0 + jl0 + 4 * e), bq = *(const LAS f32x4*)(cst + C_A0 + jl0 + 4 * e), cc = *(const LAS f32x4*)(cst + C_KK + jl0 + 4 * e), dd = *(const LAS f32x4*)(cst + C_KA + jl0 + 4 * e), ee = *(const LAS f32x4*)(cst + C_RK + jl0 + 4 * e);
#pragma unroll
                for (int j = 0; j < 4; ++j) { cw0[4 * e + j] = a[j]; ca0[4 * e + j] = bq[j]; ckk[4 * e + j] = cc[j]; cka[4 * e + j] = dd[j]; crk[4 * e + j] = ee[j]; } }
            float oa[8], orr[8], ob[8], ok[8];
#pragma unroll
            for (int e = 0; e < 8; ++e) {
                const int reg = 8 * q8 + e;
                const float xw = cw0[e] + lw[mt][reg];
                const float spn = fmaxf(-xw, 0.f) + LN2 * flog2(1.0f + fexp2(-fabsf(xw) * LOG2E));
                const float ld = -fexp2((-spn - 0.5f) * LOG2E);
                const float al = frcp(1.0f + fexp2(-(ca0[e] + la[mt][reg]) * LOG2E));
                const float kk = k8[e] * ckk[e] * kinv;
                const float kmod = k8[e] * (1.0f + (al - 1.0f) * cka[e]);
                const float bb = kk * al;
                bonus += r8[e] * kmod * crk[e];
                const float G = scan32(ld);
                const float eG = fexp2(G * LOG2E), eGm = fexp2((G - ld) * LOG2E), eiG = fexp2(-G * LOG2E);
                oa[e] = -kk * eGm; orr[e] = r8[e] * eG; ob[e] = bb * eiG; ok[e] = kmod * eiG;
                if (r32 == 31) gc[32 * h + 16 * mt + reg] = eG;
            }
            const int off = r32 * MSTR + (32 * h + 16 * mt + 8 * q8) * 2;
            *(LAS u32x4*)(mAT + off) = (u32x4){cvt_pk_bf16(oa[0], oa[1]), cvt_pk_bf16(oa[2], oa[3]), cvt_pk_bf16(oa[4], oa[5]), cvt_pk_bf16(oa[6], oa[7])};
            *(LAS u32x4*)(mRT + off) = (u32x4){cvt_pk_bf16(orr[0], orr[1]), cvt_pk_bf16(orr[2], orr[3]), cvt_pk_bf16(orr[4], orr[5]), cvt_pk_bf16(orr[6], orr[7])};
            *(LAS u32x4*)(mBT + off) = (u32x4){cvt_pk_bf16(ob[0], ob[1]), cvt_pk_bf16(ob[2], ob[3]), cvt_pk_bf16(ob[4], ob[5]), cvt_pk_bf16(ob[6], ob[7])};
            *(LAS u32x4*)(mKT + off) = (u32x4){cvt_pk_bf16(ok[0], ok[1]), cvt_pk_bf16(ok[2], ok[3]), cvt_pk_bf16(ok[4], ok[5]), cvt_pk_bf16(ok[6], ok[7])};
            asm volatile("" ::: "memory");
        }
    }
    bonus += swap32(bonus);
    u32x4 cv4[4], pv4[4];
#pragma unroll
    for (int q = 0; q < 4; ++q) { const bf16_t* cq = urow + URV + cb + 8 * q; cv4[q] = *(const u32x4*)cq; pv4[q] = (u32x4){0u, 0u, 0u, 0u}; if (hp) pv4[q] = *(const u32x4*)(cq - NIN); }
#pragma unroll
    for (int q = 0; q < 4; ++q) {
        float v8[8]; lerp8(cv4[q], pv4[q], cst + C_MUV + 32 * h + 8 * q, v8);
        *(u32x4*)(slot + SL_VR + r32 * 128 + (32 * h + 8 * q) * 2) = (u32x4){cvt_pk_bf16(v8[0], v8[1]), cvt_pk_bf16(v8[2], v8[3]), cvt_pk_bf16(v8[4], v8[5]), cvt_pk_bf16(v8[6], v8[7])};
        const f32x4 b0 = *(const LAS f32x4*)(cst + C_LNB + 32 * h + 8 * q), b1 = *(const LAS f32x4*)(cst + C_LNB + 32 * h + 8 * q + 4);
        float gb[8];
#pragma unroll
        for (int e = 0; e < 8; ++e) gb[e] = (e < 4 ? b0[e] : b1[e - 4]) + bonus * v8[e];
        *(u32x4*)(slot + SL_GB + r32 * 128 + (32 * h + 8 * q) * 2) = (u32x4){cvt_pk_bf16(gb[0], gb[1]), cvt_pk_bf16(gb[2], gb[3]), cvt_pk_bf16(gb[4], gb[5]), cvt_pk_bf16(gb[6], gb[7])};
    }
    LDS_WAIT();
    f32x16 nab = zero16(), nabT = zero16(), nakT = zero16(), mbr = zero16(), mkr = zero16();
#pragma unroll
    for (int s = 0; s < 4; ++s) {
        const int off = r32 * MSTR + (16 * s + 8 * h) * 2;
        const bf16x8 fa = *(const LAS bf16x8*)(mAT + off), fr = *(const LAS bf16x8*)(mRT + off), fb = *(const LAS bf16x8*)(mBT + off), fk = *(const LAS bf16x8*)(mKT + off);
        nab = mfma32(fb, fa, nab); nabT = mfma32(fa, fb, nabT); nakT = mfma32(fa, fk, nakT); mbr = mfma32(fb, fr, mbr); mkr = mfma32(fk, fr, mkr);
    }
#pragma unroll
    for (int reg = 0; reg < 16; ++reg) {
        const int row = (reg & 3) + 8 * (reg >> 2) + 4 * h;
        nab[reg] = row < r32 ? nab[reg] : 0.f;
        nabT[reg] = r32 < row ? nabT[reg] : 0.f;
        nakT[reg] = r32 < row ? nakT[reg] : 0.f;
        mbr[reg] = row <= r32 ? mbr[reg] : 0.f;
        mkr[reg] = row <= r32 ? mkr[reg] : 0.f;
    }
    f32x16 Y = nab;
#pragma unroll
    for (int reg = 0; reg < 16; ++reg) { const int row = (reg & 3) + 8 * (reg >> 2) + 4 * h; if (row == r32) Y[reg] += 1.0f; }
    {
        f32x16 M = nab, MT = nabT;
#pragma unroll
        for (int lvl = 0; lvl < 4; ++lvl) {
            const bf16x8 m0 = accfrag(M, 0), m1 = accfrag(M, 1), t0f = accfrag(MT, 0), t1f = accfrag(MT, 1);
            f32x16 M2T = mfma32(m0, t0f, zero16()); M2T = mfma32(m1, t1f, M2T);
            f32x16 M2 = zero16();
            if (lvl < 3) { M2 = mfma32(t0f, m0, M2); M2 = mfma32(t1f, m1, M2); }
            const bf16x8 y0 = accfrag(Y, 0), y1 = accfrag(Y, 1);
            Y = mfma32(accfrag(M2T, 0), y0, Y); Y = mfma32(accfrag(M2T, 1), y1, Y);
            M = M2; MT = M2T;
        }
    }
    const bf16x8 ty0 = accfrag(Y, 0), ty1 = accfrag(Y, 1);
    f32x16 paT[2];
#pragma unroll
    for (int nt = 0; nt < 2; ++nt) { paT[nt] = mfma32(ty0, trfrag(mAT, 0, nt, lane), zero16()); paT[nt] = mfma32(ty1, trfrag(mAT, 1, nt, lane), paT[nt]); }
    f32x16 qakT = mfma32(ty0, accfrag(nakT, 0), zero16()); qakT = mfma32(ty1, accfrag(nakT, 1), qakT);
    const bf16x8 mb0 = accfrag(mbr, 0), mb1 = accfrag(mbr, 1);
#pragma unroll
    for (int mt = 0; mt < 2; ++mt) {
        f32x16 po;
#pragma unroll
        for (int g = 0; g < 4; ++g) { const u32x2 w = *(const LAS u32x2*)(mRT + r32 * MSTR + (32 * mt + 8 * g + 4 * h) * 2);
            po[4 * g] = bf16_lo(w.x); po[4 * g + 1] = bf16_hi(w.x); po[4 * g + 2] = bf16_lo(w.y); po[4 * g + 3] = bf16_hi(w.y); }
        po = mfma32(accfrag(paT[mt], 0), mb0, po); po = mfma32(accfrag(paT[mt], 1), mb1, po);
#pragma unroll
        for (int sp = 0; sp < 2; ++sp)
            *(u32x4*)(slot + SL_PO + r32 * 128 + (32 * mt + 16 * sp + 8 * h) * 2) = (u32x4){cvt_pk_bf16(po[8 * sp], po[8 * sp + 1]), cvt_pk_bf16(po[8 * sp + 2], po[8 * sp + 3]), cvt_pk_bf16(po[8 * sp + 4], po[8 * sp + 5]), cvt_pk_bf16(po[8 * sp + 6], po[8 * sp + 7])};
    }
    {
        f32x16 qo = mfma32(accfrag(qakT, 0), mb0, mkr); qo = mfma32(accfrag(qakT, 1), mb1, qo);
#pragma unroll
        for (int g = 0; g < 4; ++g) *(u32x2*)(slot + SL_QO + r32 * 64 + (8 * g + 4 * h) * 2) = (u32x2){cvt_pk_bf16(qo[4 * g], qo[4 * g + 1]), cvt_pk_bf16(qo[4 * g + 2], qo[4 * g + 3])};
    }
#pragma unroll
    for (int nt = 0; nt < 2; ++nt) {
        const bf16x8 bt0 = trfrag(mBT, 0, nt, lane), bt1 = trfrag(mBT, 1, nt, lane);
        const float gam = gc[32 * nt + r32];
#pragma unroll
        for (int mt = 0; mt < 2; ++mt) {
            f32x16 ps = zero16();
            if (mt == nt) {
#pragma unroll
                for (int reg = 0; reg < 16; ++reg) { const int row = (reg & 3) + 8 * (reg >> 2) + 4 * h; ps[reg] = (row == r32) ? 1.0f : 0.f; }
            }
            ps = mfma32(accfrag(paT[mt], 0), bt0, ps); ps = mfma32(accfrag(paT[mt], 1), bt1, ps);
#pragma unroll
            for (int sp = 0; sp < 2; ++sp)
                *(u32x4*)(slot + SL_PS + (32 * nt + r32) * 128 + (32 * mt + 16 * sp + 8 * h) * 2) = (u32x4){cvt_pk_bf16(ps[8 * sp] * gam, ps[8 * sp + 1] * gam), cvt_pk_bf16(ps[8 * sp + 2] * gam, ps[8 * sp + 3] * gam), cvt_pk_bf16(ps[8 * sp + 4] * gam, ps[8 * sp + 5] * gam), cvt_pk_bf16(ps[8 * sp + 6] * gam, ps[8 * sp + 7] * gam)};
        }
        f32x16 qs;
        { const bf16x8 k0 = trfrag(mKT, 0, nt, lane), k1 = trfrag(mKT, 1, nt, lane);
          const u32x4 w0 = __builtin_bit_cast(u32x4, k0), w1 = __builtin_bit_cast(u32x4, k1);
#pragma unroll
          for (int j = 0; j < 4; ++j) { qs[2 * j] = bf16_lo(w0[j]); qs[2 * j + 1] = bf16_hi(w0[j]); qs[8 + 2 * j] = bf16_lo(w1[j]); qs[8 + 2 * j + 1] = bf16_hi(w1[j]); } }
        qs = mfma32(accfrag(qakT, 0), bt0, qs); qs = mfma32(accfrag(qakT, 1), bt1, qs);
#pragma unroll
        for (int g = 0; g < 4; ++g) *(u32x2*)(slot + SL_QS + (32 * nt + r32) * 64 + (8 * g + 4 * h) * 2) = (u32x2){cvt_pk_bf16(qs[4 * g] * gam, qs[4 * g + 1] * gam), cvt_pk_bf16(qs[4 * g + 2] * gam, qs[4 * g + 3] * gam)};
    }
    LDS_WAIT();
}

__device__ __forceinline__ u32x4 ntload16(const void* ptr) { return __builtin_nontemporal_load((const u32x4*)ptr); }
struct RkOps { u32x4 vr[4]; bf16x8 fps[2][2][2], fqs[2][2], fpo[2][2], fqo[2]; };
__device__ __forceinline__ void rk_load_ops(RkOps& o, const unsigned char* slot, int lane) {
    using namespace rk;
    const int r32 = lane & 31, h = lane >> 5;
#pragma unroll
    for (int k = 0; k < 4; ++k) o.vr[k] = ntload16(slot + SL_VR + lane * 64 + 16 * k);
#pragma unroll
    for (int jt = 0; jt < 2; ++jt)
#pragma unroll
        for (int s = 0; s < 2; ++s) o.fpo[jt][s] = __builtin_bit_cast(bf16x8, ntload16(slot + SL_PO + r32 * 128 + (32 * jt + 16 * s + 8 * h) * 2));
#pragma unroll
    for (int s = 0; s < 2; ++s) o.fqo[s] = __builtin_bit_cast(bf16x8, ntload16(slot + SL_QO + r32 * 64 + (16 * s + 8 * h) * 2));
#pragma unroll
    for (int mt = 0; mt < 2; ++mt) {
#pragma unroll
        for (int jt = 0; jt < 2; ++jt)
#pragma unroll
            for (int s = 0; s < 2; ++s) o.fps[mt][jt][s] = __builtin_bit_cast(bf16x8, ntload16(slot + SL_PS + (32 * mt + r32) * 128 + (32 * jt + 16 * s + 8 * h) * 2));
#pragma unroll
        for (int s = 0; s < 2; ++s) o.fqs[mt][s] = __builtin_bit_cast(bf16x8, ntload16(slot + SL_QS + (32 * mt + r32) * 64 + (16 * s + 8 * h) * 2));
    }
}
#define RK_SPIN(cond) do { unsigned _sp = 0; while (cond) { __builtin_amdgcn_s_sleep(1); if (++_sp > (1u << 24)) { err[0] = 1u; break; } } asm volatile("" ::: "memory"); } while (0)

__device__ __forceinline__ void rwkv_chain(const Params& p, LAS unsigned char* lds, int b, int hh) {
    using namespace rk;
    int tid = threadIdx.x; asm volatile("" : "+v"(tid));
    const int wave = __builtin_amdgcn_readfirstlane(tid >> 6);
    volatile LAS unsigned* ready = (volatile LAS unsigned*)(lds + L_FLAG); volatile LAS unsigned* freed = ready + NSLOT; volatile LAS unsigned* ofull = freed + NSLOT; volatile LAS unsigned* ofree = ofull + 2; volatile LAS unsigned* err = ofree + 2;
    if (tid < 2 * NSLOT + 5) ready[tid] = 0u;
    {
        const bf16_t* w2t = (const bf16_t*)(p.ws + WS_LT); const bf16_t* a2t = w2t + 512 * 64; const bf16_t* g2t = a2t + 512 * 64;
        for (int i = tid; i < 64 * 8; i += NTHREADS) { const int j = i >> 3, ch = i & 7, d = j * 128 + ((ch ^ (j & 7)) << 4);
            *(LAS u32x4*)(lds + L_W2 + d) = *(const u32x4*)(w2t + (hh * HD + j) * 64 + 8 * ch); *(LAS u32x4*)(lds + L_A2 + d) = *(const u32x4*)(a2t + (hh * HD + j) * 64 + 8 * ch); }
        for (int i = tid; i < 64 * 16; i += NTHREADS) { const int j = i >> 4, ch = i & 15; *(LAS u32x4*)(lds + L_G2 + j * 256 + ((ch ^ (j & 7)) << 4)) = *(const u32x4*)(g2t + (hh * HD + j) * 128 + 8 * ch); }
        LAS float* cst = (LAS float*)(lds + L_CST);
        for (int i = tid; i < C_END; i += NTHREADS) { float v;
            if (i < 256) v = p.shift_mu[(UXW - UR) + i];
            else if (i < 320) v = p.shift_mu[hh * HD + (i - 256)];
            else if (i < 384) v = p.shift_mu[(URK - UR) + hh * HD + (i - 320)];
            else if (i < 448) v = p.shift_mu[(URV - UR) + hh * HD + (i - 384)];
            else if (i < 512) v = p.rw_w0[hh * HD + (i - 448)];
            else if (i < 576) v = p.rw_a0[hh * HD + (i - 512)];
            else if (i < 640) v = p.rw_k_k[hh * HD + (i - 576)];
            else if (i < 704) v = p.rw_k_a[hh * HD + (i - 640)];
            else if (i < 768) v = p.rw_r_k[hh * HD + (i - 704)];
            else v = p.rw_ln_b[hh * HD + (i - 768)];
            cst[i] = v; }
    }
    __syncthreads();
    unsigned char* ring = (unsigned char*)p.out + (size_t)(b * NH + hh) * NSLOT * SLOT_BYTES;
    if (wave == 0) {
        int lane = tid & 63; asm volatile("" : "+v"(lane));
        const int r32 = lane & 31, h = lane >> 5;
        LAS unsigned char* vs = lds + L_CONS;
        f32x16 st[2][2];
#pragma unroll
        for (int a = 0; a < 2; ++a)
#pragma unroll
            for (int d = 0; d < 2; ++d) st[a][d] = zero16();
        RkOps ops;
        RK_SPIN(ready[0] != 1u);
        rk_load_ops(ops, ring, lane);
        for (int c = 0; c < NCH; ++c) {
            bf16x8 sf[2][2][2];
#pragma unroll
            for (int jt = 0; jt < 2; ++jt)
#pragma unroll
                for (int it = 0; it < 2; ++it) { sf[jt][it][0] = accfrag(st[jt][it], 0); sf[jt][it][1] = accfrag(st[jt][it], 1); }
            { LAS unsigned char* d = vs + (lane >> 1) * MSTR + (lane & 1) * 64;
              *(LAS u32x4*)d = ops.vr[0]; *(LAS u32x4*)(d + 16) = ops.vr[1]; *(LAS u32x4*)(d + 32) = ops.vr[2]; *(LAS u32x4*)(d + 48) = ops.vr[3]; }
            LDS_WAIT();
            bf16x8 vf[2][2];
            { const int g = lane >> 4, i16 = lane & 15, q = i16 >> 2, pp = i16 & 3;
#pragma unroll
              for (int it = 0; it < 2; ++it)
#pragma unroll
                  for (int s = 0; s < 2; ++s) { const LAS unsigned char* a = vs + (16 * s + 8 * h + q) * MSTR + (32 * it + 16 * (g & 1) + 4 * pp) * 2;
                      const s16x4 x = lds_tr16(a), y = lds_tr16(a + 4 * MSTR);
                      bf16x8 r; r[0] = x[0]; r[1] = x[1]; r[2] = x[2]; r[3] = x[3]; r[4] = y[0]; r[5] = y[1]; r[6] = y[2]; r[7] = y[3]; vf[it][s] = r; } }
            f32x16 o[2];
#pragma unroll
            for (int it = 0; it < 2; ++it) {
                o[it] = zero16();
#pragma unroll
                for (int jt = 0; jt < 2; ++jt)
#pragma unroll
                    for (int s = 0; s < 2; ++s) o[it] = mfma32(sf[jt][it][s], ops.fpo[jt][s], o[it]);
#pragma unroll
                for (int s = 0; s < 2; ++s) o[it] = mfma32(vf[it][s], ops.fqo[s], o[it]);
            }
#pragma unroll
            for (int mt = 0; mt < 2; ++mt)
#pragma unroll
                for (int it = 0; it < 2; ++it) {
                    f32x16 a = zero16();
#pragma unroll
                    for (int jt = 0; jt < 2; ++jt)
#pragma unroll
                        for (int s = 0; s < 2; ++s) a = mfma32(ops.fps[mt][jt][s], sf[jt][it][s], a);
#pragma unroll
                    for (int s = 0; s < 2; ++s) a = mfma32(ops.fqs[mt][s], vf[it][s], a);
                    st[mt][it] = a;
                }
            if (c + 1 < NCH) { const int sn = (c + 1) % NSLOT; RK_SPIN(ready[sn] != (unsigned)(c + 2)); rk_load_ops(ops, ring + (size_t)sn * SLOT_BYTES, lane); }
            if (c >= 1) RK_SPIN(ofree[0] != (unsigned)c);
            { LAS unsigned char* ob = lds + L_OBUF + r32 * OSTR;
#pragma unroll
              for (int it = 0; it < 2; ++it)
#pragma unroll
                  for (int g = 0; g < 4; ++g) *(LAS f32x4*)(ob + (32 * it + 8 * g + 4 * h) * 4) = (f32x4){o[it][4 * g], o[it][4 * g + 1], o[it][4 * g + 2], o[it][4 * g + 3]}; }
            LDS_WAIT();
            if (lane == 0) ofull[0] = (unsigned)(c + 1);
        }
    } else if (wave == 1) {
        int lane = tid & 63; asm volatile("" : "+v"(lane));
        const int r32 = lane & 31, h = lane >> 5;
        u32x4 gw[4], gb[4];
        RK_SPIN(ready[0] != 1u);
#pragma unroll
        for (int k = 0; k < 4; ++k) { gw[k] = ntload16(ring + SL_GW + r32 * 128 + (32 * h + 8 * k) * 2); gb[k] = ntload16(ring + SL_GB + r32 * 128 + (32 * h + 8 * k) * 2); }
        for (int c = 0; c < NCH; ++c) {
            const int sl = c % NSLOT;
            RK_SPIN(ofull[0] != (unsigned)(c + 1));
            float ov[32];
            { const LAS unsigned char* ob = lds + L_OBUF + r32 * OSTR + 128 * h;
#pragma unroll
              for (int k = 0; k < 8; ++k) { const f32x4 x = *(const LAS f32x4*)(ob + 16 * k); ov[4 * k] = x[0]; ov[4 * k + 1] = x[1]; ov[4 * k + 2] = x[2]; ov[4 * k + 3] = x[3]; } }
            LDS_WAIT();
            if (lane == 0) ofree[0] = (unsigned)(c + 1);
            float sm = 0.f;
#pragma unroll
            for (int k = 0; k < 32; ++k) sm += ov[k];
            sm += swap32(sm);
            const float mean = sm * (1.0f / 64.0f);
            float sv = 0.f;
#pragma unroll
            for (int k = 0; k < 32; ++k) { const float d = ov[k] - mean; sv += d * d; }
            sv += swap32(sv);
            const float rstd = 1.0f / sqrtf(sv * (1.0f / 64.0f) + 64e-5f);
            bf16_t* mrow = (bf16_t*)(p.ws + WS_B) + ((size_t)b * S + c * C + r32) * D + 512 + hh * HD + 32 * h;
#pragma unroll
            for (int k = 0; k < 4; ++k) {
                float w8[8], b8[8], r[8]; f8_from_bf16(gw[k], w8); f8_from_bf16(gb[k], b8);
                const f32x4 l0 = *(const f32x4*)(p.rw_ln_w + hh * HD + 32 * h + 8 * k), l1 = *(const f32x4*)(p.rw_ln_w + hh * HD + 32 * h + 8 * k + 4);
#pragma unroll
                for (int e = 0; e < 8; ++e) r[e] = ((ov[8 * k + e] - mean) * rstd * (e < 4 ? l0[e] : l1[e - 4]) + b8[e]) * w8[e];
                *(u32x4*)(mrow + 8 * k) = (u32x4){cvt_pk_bf16(r[0], r[1]), cvt_pk_bf16(r[2], r[3]), cvt_pk_bf16(r[4], r[5]), cvt_pk_bf16(r[6], r[7])};
            }
            if (lane == 0) freed[sl] = (unsigned)(c + 1);
            if (c + 1 < NCH) { const int sn = (c + 1) % NSLOT; const unsigned char* sp_ = ring + (size_t)sn * SLOT_BYTES; RK_SPIN(ready[sn] != (unsigned)(c + 2));
#pragma unroll
                for (int k = 0; k < 4; ++k) { gw[k] = ntload16(sp_ + SL_GW + r32 * 128 + (32 * h + 8 * k) * 2); gb[k] = ntload16(sp_ + SL_GB + r32 * 128 + (32 * h + 8 * k) * 2); } }
        }
    } else {
        int lane = tid & 63;
        for (int c = wave - 2; c < NCH; c += NPROD) {
            const int sl = c % NSLOT;
            if (c >= NSLOT) RK_SPIN(freed[sl] != (unsigned)(c - NSLOT + 1));
            rk_produce(p, lds, lds + (wave - 2) * PROD_LDS, ring + (size_t)sl * SLOT_BYTES, b, hh, c);
            asm volatile("s_waitcnt vmcnt(0)" ::: "memory");
            if (lane == 0) ready[sl] = (unsigned)(c + 1);
        }
    }
    __syncthreads();
}

#ifdef RWDEBUG
namespace rw {
constexpr int CH = 16;
constexpr int O_UM = 0;
constexpr int O_LW = O_UM + CH * 448 * 4;
constexpr int O_LA = O_LW + CH * 64 * 4;
constexpr int O_LG0 = O_LA + CH * 64 * 4;
constexpr int O_LG1 = O_LG0 + CH * 64 * 4;
constexpr int O_A1 = O_LG1 + CH * 64 * 4;
constexpr int O_R1 = O_A1 + CH * 64 * 4;
constexpr int O_B1 = O_R1 + CH * 64 * 4;
constexpr int O_K1 = O_B1 + CH * 64 * 4;
constexpr int O_O = O_K1 + CH * 64 * 4;
constexpr int O_WT = O_O + CH * 64 * 4;
constexpr int O_GC = O_WT + 8 * 64 * 4;
constexpr int O_SC = O_GC + 64 * 4;
constexpr int O_END = O_SC + 3 * 16 * 4;
}
__device__ __forceinline__ bf16x8 ldw_frag(const float* W, int ldw, int m0, int col) {
    unsigned w[4];
#pragma unroll
    for (int j = 0; j < 4; ++j) w[j] = cvt_pk_bf16(W[(size_t)(m0 + 2 * j) * ldw + col], W[(size_t)(m0 + 2 * j + 1) * ldw + col]);
    return __builtin_bit_cast(bf16x8, (u32x4){w[0], w[1], w[2], w[3]});
}
template <int ACT>
__device__ __forceinline__ bf16x8 act_frag(const LAS float* src) {
    const f32x4 a = *(const LAS f32x4*)src, b = *(const LAS f32x4*)(src + 4); float v[8] = {a[0], a[1], a[2], a[3], b[0], b[1], b[2], b[3]};
#pragma unroll
    for (int j = 0; j < 8; ++j) {
        if (ACT == 1) v[j] = 1.0f - 2.0f * frcp(1.0f + fexp2(v[j] * (2.0f * LOG2E)));
        if (ACT == 2) v[j] = frcp(1.0f + fexp2(-v[j] * LOG2E));
    }
    return __builtin_bit_cast(bf16x8, (u32x4){cvt_pk_bf16(v[0], v[1]), cvt_pk_bf16(v[2], v[3]), cvt_pk_bf16(v[4], v[5]), cvt_pk_bf16(v[6], v[7])});
}

__device__ __forceinline__ void rwkv_chain_seq(const Params& p, LAS unsigned char* lds, int b, int h, bf16_t* mix, int nchunks) {
    using namespace rw;
    const int tid = threadIdx.x, wave = __builtin_amdgcn_readfirstlane(tid >> 6), lane = tid & 63;
    const bf16_t* u = (const bf16_t*)(p.ws + WS_A);
    const size_t row0 = (size_t)b * S;
    LAS float* UM = (LAS float*)(lds + O_UM); LAS float* LW = (LAS float*)(lds + O_LW); LAS float* LA = (LAS float*)(lds + O_LA);
    LAS float* LG0 = (LAS float*)(lds + O_LG0); LAS float* LG1 = (LAS float*)(lds + O_LG1);
    LAS float* A1 = (LAS float*)(lds + O_A1); LAS float* R1 = (LAS float*)(lds + O_R1); LAS float* B1 = (LAS float*)(lds + O_B1); LAS float* K1 = (LAS float*)(lds + O_K1);
    LAS float* OO = (LAS float*)(lds + O_O); LAS float* WT = (LAS float*)(lds + O_WT); LAS float* GC = (LAS float*)(lds + O_GC); LAS float* SC = (LAS float*)(lds + O_SC);
    const int fc = lane & 15, fq = lane >> 4;
    bf16x8 bwa[2], bg[2];
    { const float* W = wave < 4 ? p.rw_w2 : p.rw_a2; const int col = h * HD + 16 * (wave & 3) + fc;
      bwa[0] = ldw_frag(W, 512, 8 * fq, col); bwa[1] = ldw_frag(W, 512, 32 + 8 * fq, col);
      const int ks = (wave >> 2) * 2; bg[0] = ldw_frag(p.rw_g2, 512, 32 * ks + 8 * fq, col); bg[1] = ldw_frag(p.rw_g2, 512, 32 * (ks + 1) + 8 * fq, col); }
    const int hj = h * HD + lane;
    const float c_w0 = p.rw_w0[hj], c_a0 = p.rw_a0[hj], c_kk = p.rw_k_k[hj], c_ka = p.rw_k_a[hj], c_rk = p.rw_r_k[hj], c_lnw = p.rw_ln_w[hj], c_lnb = p.rw_ln_b[hj];
    int ld_t[2], ld_c[2], ld_uc[2]; bool ld_ok[2];
#pragma unroll
    for (int r = 0; r < 2; ++r) { const int gid = tid + 512 * r; ld_ok[r] = gid < CH * 56; const int t = gid / 56, cg8 = gid % 56; ld_t[r] = t; ld_c[r] = cg8 * 8;
        ld_uc[r] = cg8 < 8 ? UR + h * HD + 8 * cg8 : cg8 < 16 ? URK + h * HD + 8 * (cg8 - 8) : cg8 < 24 ? URV + h * HD + 8 * (cg8 - 16) : UXW + 8 * (cg8 - 24); }
    const int si = 8 * wave + (lane >> 3), sj = 8 * (lane & 7);
    float st[8];
#pragma unroll
    for (int n = 0; n < 8; ++n) st[n] = 0.f;
    u32x4 cur[2], prv[2];
    auto issue_loads = [&](int t0) {
#pragma unroll
        for (int r = 0; r < 2; ++r) { cur[r] = (u32x4){0u, 0u, 0u, 0u}; prv[r] = (u32x4){0u, 0u, 0u, 0u};
            if (ld_ok[r]) { const int tt = t0 + ld_t[r]; const bf16_t* a = u + (row0 + tt) * NIN + ld_uc[r]; cur[r] = *(const u32x4*)a; if (tt > 0) prv[r] = *(const u32x4*)(a - NIN); } }
    };
    issue_loads(0);
    for (int c = 0; c < nchunks; ++c) {
        const int t0 = c * CH;
#pragma unroll
        for (int r = 0; r < 2; ++r) if (ld_ok[r]) {
            const float* mu = p.shift_mu + (ld_uc[r] - UR); const f32x4 m0 = *(const f32x4*)mu, m1 = *(const f32x4*)(mu + 4);
            float cv[8], pv[8];
#pragma unroll
            for (int j = 0; j < 4; ++j) { cv[2 * j] = bf16_lo(cur[r][j]); cv[2 * j + 1] = bf16_hi(cur[r][j]); pv[2 * j] = bf16_lo(prv[r][j]); pv[2 * j + 1] = bf16_hi(prv[r][j]); }
            f32x4 o0, o1;
#pragma unroll
            for (int j = 0; j < 4; ++j) { o0[j] = cv[j] + (pv[j] - cv[j]) * m0[j]; o1[j] = cv[4 + j] + (pv[4 + j] - cv[4 + j]) * m1[j]; }
            LAS float* d = UM + ld_t[r] * 448 + ld_c[r]; *(LAS f32x4*)d = o0; *(LAS f32x4*)(d + 4) = o1;
        }
        if (c + 1 < S / CH) issue_loads(t0 + CH);
        __syncthreads();
        {
            f32x4 acc = (f32x4){0.f, 0.f, 0.f, 0.f};
            const LAS float* src = UM + fc * 448 + (wave < 4 ? 192 : 256) + 8 * fq;
            if (wave < 4) { acc = __builtin_amdgcn_mfma_f32_16x16x32_bf16(act_frag<1>(src), bwa[0], acc, 0, 0, 0); acc = __builtin_amdgcn_mfma_f32_16x16x32_bf16(act_frag<1>(src + 32), bwa[1], acc, 0, 0, 0); }
            else          { acc = __builtin_amdgcn_mfma_f32_16x16x32_bf16(act_frag<0>(src), bwa[0], acc, 0, 0, 0); acc = __builtin_amdgcn_mfma_f32_16x16x32_bf16(act_frag<0>(src + 32), bwa[1], acc, 0, 0, 0); }
            LAS float* dst = (wave < 4 ? LW : LA) + 16 * (wave & 3) + fc;
#pragma unroll
            for (int r = 0; r < 4; ++r) dst[(4 * fq + r) * 64] = acc[r];
            f32x4 ag = (f32x4){0.f, 0.f, 0.f, 0.f};
            const LAS float* sg = UM + fc * 448 + 320 + 64 * (wave >> 2) + 8 * fq;
            ag = __builtin_amdgcn_mfma_f32_16x16x32_bf16(act_frag<2>(sg), bg[0], ag, 0, 0, 0); ag = __builtin_amdgcn_mfma_f32_16x16x32_bf16(act_frag<2>(sg + 32), bg[1], ag, 0, 0, 0);
            LAS float* dg = (wave < 4 ? LG0 : LG1) + 16 * (wave & 3) + fc;
#pragma unroll
            for (int r = 0; r < 4; ++r) dg[(4 * fq + r) * 64] = ag[r];
        }
        __syncthreads();
        float e_kk[2], e_b[2], e_k[2], e_r[2], e_ld[2];
#pragma unroll
        for (int tt = 0; tt < 2; ++tt) {
            const int t = 2 * wave + tt;
            const float xw = c_w0 + LW[t * 64 + lane];
            const float spn = (fmaxf(-xw, 0.f) + LN2 * flog2(1.0f + fexp2(-fabsf(xw) * LOG2E)));
            e_ld[tt] = -fexp2((-spn - 0.5f) * LOG2E);
            const float a = frcp(1.0f + fexp2(-(c_a0 + LA[t * 64 + lane]) * LOG2E));
            const float kraw = UM[t * 448 + 64 + lane], r = UM[t * 448 + lane];
            const float kkv = kraw * c_kk; const float ssq = wave_sum(kkv * kkv);
            const float kk = kkv * frsq(fmaxf(ssq, 1e-24f));
            const float kmod = kraw * (1.0f + (a - 1.0f) * c_ka);
            const float bb = kk * a;
            const float cbr = wave_sum(bb * r), ckr = wave_sum(kmod * r), bon = wave_sum(r * kmod * c_rk);
            if (lane == 0) { SC[t] = cbr; SC[16 + t] = ckr; SC[32 + t] = bon; }
            e_kk[tt] = kk; e_b[tt] = bb; e_k[tt] = kmod; e_r[tt] = r;
        }
        WT[wave * 64 + lane] = e_ld[0] + e_ld[1];
        __syncthreads();
        {
            float off = 0.f, tot = 0.f;
#pragma unroll
            for (int w = 0; w < 8; ++w) { const float x = WT[w * 64 + lane]; if (w < wave) off += x; tot += x; }
            const float c0 = off + e_ld[0], c1 = c0 + e_ld[1];
            const int t = 2 * wave;
            A1[t * 64 + lane] = -e_kk[0] * fexp2(off * LOG2E);       A1[(t + 1) * 64 + lane] = -e_kk[1] * fexp2(c0 * LOG2E);
            R1[t * 64 + lane] = e_r[0] * fexp2(c0 * LOG2E);          R1[(t + 1) * 64 + lane] = e_r[1] * fexp2(c1 * LOG2E);
            const float i0 = fexp2(-c0 * LOG2E), i1 = fexp2(-c1 * LOG2E);
            B1[t * 64 + lane] = e_b[0] * i0;                          B1[(t + 1) * 64 + lane] = e_b[1] * i1;
            K1[t * 64 + lane] = e_k[0] * i0;                          K1[(t + 1) * 64 + lane] = e_k[1] * i1;
            if (wave == 0) GC[lane] = fexp2(tot * LOG2E);
        }
        __syncthreads();
#pragma unroll 4
        for (int t = 0; t < CH; ++t) {
            const f32x4 a0 = *(const LAS f32x4*)(A1 + t * 64 + sj), a1 = *(const LAS f32x4*)(A1 + t * 64 + sj + 4);
            const f32x4 r0 = *(const LAS f32x4*)(R1 + t * 64 + sj), r1 = *(const LAS f32x4*)(R1 + t * 64 + sj + 4);
            const f32x4 b0 = *(const LAS f32x4*)(B1 + t * 64 + sj), b1 = *(const LAS f32x4*)(B1 + t * 64 + sj + 4);
            const f32x4 k0 = *(const LAS f32x4*)(K1 + t * 64 + sj), k1 = *(const LAS f32x4*)(K1 + t * 64 + sj + 4);
            const float v = UM[t * 448 + 128 + si], cbr = SC[t], ckr = SC[16 + t];
            float sa = (st[0] * a0[0] + st[1] * a0[1]) + (st[2] * a0[2] + st[3] * a0[3]) + ((st[4] * a1[0] + st[5] * a1[1]) + (st[6] * a1[2] + st[7] * a1[3]));
            float pp = (st[0] * r0[0] + st[1] * r0[1]) + (st[2] * r0[2] + st[3] * r0[3]) + ((st[4] * r1[0] + st[5] * r1[1]) + (st[6] * r1[2] + st[7] * r1[3]));
            sa = sum8(sa); pp = sum8(pp);
            if ((lane & 7) == 0) OO[t * 64 + si] = pp + sa * cbr + v * ckr;
#pragma unroll
            for (int n = 0; n < 4; ++n) { st[n] += sa * b0[n] + v * k0[n]; st[4 + n] += sa * b1[n] + v * k1[n]; }
        }
        {
            const f32x4 g0 = *(const LAS f32x4*)(GC + sj), g1 = *(const LAS f32x4*)(GC + sj + 4);
#pragma unroll
            for (int n = 0; n < 4; ++n) { st[n] *= g0[n]; st[4 + n] *= g1[n]; }
        }
        __syncthreads();
#pragma unroll
        for (int tt = 0; tt < 2; ++tt) {
            const int t = 2 * wave + tt;
            const float o = OO[t * 64 + lane];
            const float mean = wave_sum(o) * (1.0f / 64.0f); const float dlt = o - mean;
            const float var = wave_sum(dlt * dlt) * (1.0f / 64.0f);
            const float gn = dlt * (1.0f / sqrtf(var + 64e-5f)) * c_lnw + c_lnb;
            const float res = (gn + SC[32 + t] * UM[t * 448 + 128 + lane]) * (LG0[t * 64 + lane] + LG1[t * 64 + lane]);
            mix[(row0 + t0 + t) * D + 512 + h * HD + lane] = (bf16_t)(cvt_pk_bf16(res, 0.f) & 0xffffu);
        }
        __syncthreads();
    }
}

#endif

__device__ __forceinline__ void phase2(const Params& p, LAS unsigned char* lds) {
    const int nchain = NB * NH, G = gridDim.x, wave = threadIdx.x >> 6;
    const int nscan = G >= 2 * nchain ? nchain : (G > 1 ? G / 2 : 0);
    if ((int)blockIdx.x < nscan || nscan == 0) {
        const int stride = nscan == 0 ? G : nscan;
        for (int it = blockIdx.x; it < nchain; it += stride) rwkv_chain(p, lds, it / NH, it % NH);
    }
    if ((int)blockIdx.x >= nscan) {
        const int nb = G - nscan, bi = blockIdx.x - nscan;
        for (int it = bi * 8 + wave; it < NB * NH * 64; it += nb * 8) attn_tile(p, lds + wave * 4608, it / (NH * 64), (it / 64) % NH, 63 - (it % 64));
        p0_expert_weights(p, lds, bi * 8 + wave, nb * 8);
    }
}

struct EpiH {
    const float* x; float* hout; int row0, col0;
    __device__ __forceinline__ void operator()(const f32x4 (&acc)[2][2][4][2], int wr, int wc, int fr, int fq) const {
#pragma unroll
        for (int ai = 0; ai < 2; ++ai)
#pragma unroll
            for (int m = 0; m < 4; ++m) { const size_t off = (size_t)(row0 + ai * 128 + wr * 64 + m * 16 + fr) * D + col0 + wc * 32 + 4 * fq;
#pragma unroll
                for (int bj = 0; bj < 2; ++bj)
#pragma unroll
                    for (int n = 0; n < 2; ++n) { const f32x4 xv = *(const f32x4*)(x + off + bj * 128 + n * 16); *(f32x4*)(hout + off + bj * 128 + n * 16) = xv + acc[ai][bj][m][n]; } }
    }
};
__device__ __forceinline__ void phase3(const Params& p, LAS unsigned char* lds) {
    constexpr int nM = T / 256, nN = D / 256;
    unsigned aoff[2][2]; g8::aoff_rows(aoff, D);
    for (int L = blockIdx.x; L < nM * nN; L += gridDim.x) {
        int pm, pn; g8::tile_order(L, nM, nN, pm, pn);
        EpiH E{p.x, p.out, pm * 256, pn * 256};
        g8::gemm_unit(lds, (const char*)(p.ws + WS_B) + (size_t)pm * 256 * D * 2, aoff, (const char*)(p.ws + WS_WOUT) + (size_t)pn * 256 * D * 2, D, E);
    }
}

__device__ __forceinline__ void phase4(const Params& p, LAS unsigned char* lds) {
    int tid = threadIdx.x; asm volatile("" : "+v"(tid));
    const int wave = tid >> 6, lane = tid & 63, fr = lane & 15, fq = lane >> 4;
    const float* hsrc = p.out; bf16_t* hb = (bf16_t*)(p.ws + WS_A); float* rstd2 = (float*)(p.ws + WS_RSTD2);
    const bf16_t* wr_hi = (const bf16_t*)(p.ws + WS_WR); const bf16_t* wr_lo = wr_hi + 48 * D;
    int* list = (int*)(p.ws + WS_LIST); float* listw = (float*)(p.ws + WS_LISTW); unsigned* cnt = (unsigned*)(p.ws + WS_CTL);
    LAS float* lg = (LAS float*)(lds + wave * 3072);
    LAS unsigned* lcnt = (LAS unsigned*)(lds + 8 * 3072);
    LAS unsigned* gbase = lcnt + 32;
    for (int blk = blockIdx.x; blk < T / 128; blk += gridDim.x) {
        if (tid < 32) lcnt[tid] = 0u;
        __syncthreads();
        const int tok0 = blk * 128 + wave * 16;
        f32x4 acc[3];
#pragma unroll
        for (int n = 0; n < 3; ++n) acc[n] = (f32x4){0.f, 0.f, 0.f, 0.f};
        float ss = 0.f;
        const float* hp = hsrc + (size_t)(tok0 + fr) * D + 8 * fq; bf16_t* hbp = hb + (size_t)(tok0 + fr) * D + 8 * fq;
        const bf16_t* bh = wr_hi + (size_t)fr * D + 8 * fq; const bf16_t* bl = wr_lo + (size_t)fr * D + 8 * fq;
#pragma unroll 2
        for (int ks = 0; ks < D / 32; ++ks) {
            const f32x4 v0 = *(const f32x4*)(hp + 32 * ks), v1 = *(const f32x4*)(hp + 32 * ks + 4);
            ss += (v0[0] * v0[0] + v0[1] * v0[1]) + (v0[2] * v0[2] + v0[3] * v0[3]) + ((v1[0] * v1[0] + v1[1] * v1[1]) + (v1[2] * v1[2] + v1[3] * v1[3]));
            u32x4 hi; hi.x = cvt_pk_bf16(v0[0], v0[1]); hi.y = cvt_pk_bf16(v0[2], v0[3]); hi.z = cvt_pk_bf16(v1[0], v1[1]); hi.w = cvt_pk_bf16(v1[2], v1[3]);
            *(u32x4*)(hbp + 32 * ks) = hi;
            u32x4 lo; lo.x = cvt_pk_bf16(v0[0] - bf16_lo(hi.x), v0[1] - bf16_hi(hi.x)); lo.y = cvt_pk_bf16(v0[2] - bf16_lo(hi.y), v0[3] - bf16_hi(hi.y));
            lo.z = cvt_pk_bf16(v1[0] - bf16_lo(hi.z), v1[1] - bf16_hi(hi.z)); lo.w = cvt_pk_bf16(v1[2] - bf16_lo(hi.w), v1[3] - bf16_hi(hi.w));
            const bf16x8 ah = __builtin_bit_cast(bf16x8, hi), al = __builtin_bit_cast(bf16x8, lo);
#pragma unroll
            for (int n = 0; n < 3; ++n) {
                const bf16x8 wh = *(const bf16x8*)(bh + (size_t)n * 16 * D + 32 * ks), wl = *(const bf16x8*)(bl + (size_t)n * 16 * D + 32 * ks);
                acc[n] = __builtin_amdgcn_mfma_f32_16x16x32_bf16(ah, wh, acc[n], 0, 0, 0);
                acc[n] = __builtin_amdgcn_mfma_f32_16x16x32_bf16(al, wh, acc[n], 0, 0, 0);
                acc[n] = __builtin_amdgcn_mfma_f32_16x16x32_bf16(ah, wl, acc[n], 0, 0, 0);
            }
        }
        ss += __shfl_xor(ss, 16); ss += __shfl_xor(ss, 32);
        const float rs = 1.0f / sqrtf(ss * (1.0f / D) + 1e-6f);
        if (fq == 0) rstd2[tok0 + fr] = rs;
#pragma unroll
        for (int n = 0; n < 3; ++n)
#pragma unroll
            for (int r = 0; r < 4; ++r) lg[(4 * fq + r) * 48 + 16 * n + fr] = acc[n][r];
        LDS_WAIT();
        int e0 = 0, e1 = 0; float w0 = 0.f, w1 = 0.f; unsigned lp0 = 0, lp1 = 0;
        if (lane < 16) {
            const float rst = rs;
            const LAS float* L = lg + lane * 48;
            float gl[4]; int gi = 0; float gm;
#pragma unroll
            for (int g = 0; g < 4; ++g) gl[g] = L[g] * rst + p.r_grp_b[g];
            gm = gl[0];
#pragma unroll
            for (int g = 1; g < 4; ++g) if (gl[g] > gm) { gm = gl[g]; gi = g; }
            float gs = 0.f;
#pragma unroll
            for (int g = 0; g < 4; ++g) gs += __expf(gl[g] - gm);
            const float gval = 1.0f / gs;
            float el[8];
#pragma unroll
            for (int e = 0; e < 8; ++e) el[e] = L[4 + gi * 8 + e] * rst + p.r_exp_b[gi * 8 + e];
            int i0 = 0; float m0 = el[0];
#pragma unroll
            for (int e = 1; e < 8; ++e) if (el[e] > m0) { m0 = el[e]; i0 = e; }
            int i1 = i0 == 0 ? 1 : 0; float m1 = el[i1];
#pragma unroll
            for (int e = 0; e < 8; ++e) if (e != i0 && el[e] > m1) { m1 = el[e]; i1 = e; }
            const float x1 = __expf(m1 - m0); const float den = 1.0f / (1.0f + x1);
            e0 = gi * 8 + i0; e1 = gi * 8 + i1; w0 = gval * den; w1 = gval * x1 * den;
            lp0 = atomicAdd((unsigned*)&lcnt[e0], 1u); lp1 = atomicAdd((unsigned*)&lcnt[e1], 1u);
        }
        __syncthreads();
        if (tid < 32) gbase[tid] = atomicAdd(&cnt[tid], lcnt[tid]);
        __syncthreads();
        if (lane < 16) {
            const int tok = tok0 + lane;
            const unsigned q0 = gbase[e0] + lp0, q1 = gbase[e1] + lp1;
            list[(size_t)e0 * T + q0] = tok * 2;     listw[(size_t)e0 * T + q0] = w0;
            list[(size_t)e1 * T + q1] = tok * 2 + 1; listw[(size_t)e1 * T + q1] = w1;
        }
        __syncthreads();
    }
}

constexpr int LDS_MAP = 161792;
__device__ __forceinline__ void expert_map_build(const unsigned* cnt, LAS unsigned char* lds) {
    LAS int* pre = (LAS int*)(lds + LDS_MAP); LAS int* cn = pre + 40;
    if (threadIdx.x == 0) { int acc = 0; for (int i = 0; i < NE; ++i) { const int ci = (int)__hip_atomic_load(cnt + i, __ATOMIC_RELAXED, __HIP_MEMORY_SCOPE_AGENT); pre[i] = acc; cn[i] = ci; acc += (ci + 255) >> 8; } pre[NE] = acc; }
    __syncthreads();
}
__device__ __forceinline__ void expert_find(LAS unsigned char* lds, int mt, int& e, int& local, int& c) {
    const LAS int* pre = (const LAS int*)(lds + LDS_MAP); const LAS int* cn = pre + 40;
    int lo = 0;
#pragma unroll 1
    for (int i = 1; i < NE; ++i) if (pre[i] <= mt) lo = i;
    e = __builtin_amdgcn_readfirstlane(lo); local = mt - __builtin_amdgcn_readfirstlane(pre[e]); c = __builtin_amdgcn_readfirstlane(cn[e]);
}
__device__ __forceinline__ int expert_tiles(LAS unsigned char* lds) { return __builtin_amdgcn_readfirstlane(((const LAS int*)(lds + LDS_MAP))[NE]); }

struct EpiGU {
    bf16_t* hid; const float* rstd2; const int* lst; int cnt, p0, hrow0, ct;
    __device__ __forceinline__ void operator()(const f32x4 (&acc)[2][2][4][2], int wr, int wc, int fr, int fq) const {
#pragma unroll
        for (int ai = 0; ai < 2; ++ai)
#pragma unroll
            for (int m = 0; m < 4; ++m) { const int r = ai * 128 + wr * 64 + m * 16 + fr; const int pp = p0 + r;
                const float rs = pp < cnt ? rstd2[lst[pp] >> 1] : 0.f;
                bf16_t* op = hid + (size_t)(hrow0 + r) * DE + ct * 128 + wc * 32 + 4 * fq;
#pragma unroll
                for (int n = 0; n < 2; ++n) { const f32x4 g = acc[ai][0][m][n] * rs, uu = acc[ai][1][m][n] * rs; float o[4];
#pragma unroll
                    for (int j = 0; j < 4; ++j) o[j] = g[j] * frcp(1.0f + fexp2(-g[j] * LOG2E)) * uu[j];
                    u32x2 w; w.x = cvt_pk_bf16(o[0], o[1]); w.y = cvt_pk_bf16(o[2], o[3]); *(u32x2*)(op + n * 16) = w; } }
    }
};
__device__ __forceinline__ void phase5(const Params& p, LAS unsigned char* lds) {
    expert_map_build((const unsigned*)(p.ws + WS_CTL), lds);
    const int MT = expert_tiles(lds);
    const int tid = threadIdx.x;
    for (int unit = blockIdx.x; unit < MT * 2; unit += gridDim.x) {
        const int mt = unit >> 1, ct = unit & 1; int e, local, c; expert_find(lds, mt, e, local, c);
        const int* lst = (const int*)(p.ws + WS_LIST) + (size_t)e * T; const int p0 = local * 256;
        unsigned aoff[2][2];
#pragma unroll
        for (int i = 0; i < 2; ++i) { int R, C; g8::stage_rc(tid * 16 + i * 8192, R, C);
#pragma unroll
            for (int hh = 0; hh < 2; ++hh) { const int pp = p0 + hh * 128 + R; const int tok = pp < c ? (lst[pp] >> 1) : 0; aoff[hh][i] = (unsigned)(tok * D + C) * 2u; } }
        EpiGU E{(bf16_t*)(p.ws + WS_B), (const float*)(p.ws + WS_RSTD2), lst, c, p0, mt * 256, ct};
        g8::gemm_unit(lds, (const char*)(p.ws + WS_A), aoff, (const char*)(p.ws + WS_WGU) + ((size_t)e * 512 + ct * 256) * D * 2, D, E);
    }
}
struct EpiDN {
    bf16_t* y; bf16_t* dummy; const int* lst; const float* lw; int cnt, p0, col0;
    __device__ __forceinline__ void operator()(const f32x4 (&acc)[2][2][4][2], int wr, int wc, int fr, int fq) const {
#pragma unroll
        for (int ai = 0; ai < 2; ++ai)
#pragma unroll
            for (int m = 0; m < 4; ++m) { const int pp = p0 + ai * 128 + wr * 64 + m * 16 + fr;
                const bool ok = pp < cnt; const int ent = lst[pp]; const float w = lw[pp];
                bf16_t* op = (ok ? y + ((size_t)(ent & 1) * T + (ent >> 1)) * D : dummy) + col0 + wc * 32 + 4 * fq;
#pragma unroll
                for (int bj = 0; bj < 2; ++bj)
#pragma unroll
                    for (int n = 0; n < 2; ++n) { const f32x4 v = acc[ai][bj][m][n] * w; u32x2 o; o.x = cvt_pk_bf16(v[0], v[1]); o.y = cvt_pk_bf16(v[2], v[3]); *(u32x2*)(op + bj * 128 + n * 16) = o; }
                if (m & 1) asm volatile("" ::: "memory"); }
    }
};
__device__ __forceinline__ void phase6(const Params& p, LAS unsigned char* lds) {
    expert_map_build((const unsigned*)(p.ws + WS_CTL), lds);
    const int MT = expert_tiles(lds);
    constexpr int kdn = DE;
    unsigned aoff[2][2]; g8::aoff_rows(aoff, kdn);
    for (int unit = blockIdx.x; unit < MT * 4; unit += gridDim.x) {
        const int mt = unit >> 2, pn = unit & 3; int e, local, c; expert_find(lds, mt, e, local, c);
        EpiDN E{(bf16_t*)(p.ws + WS_A + (size_t)T * D * 2), (bf16_t*)(p.ws + WS_A + (size_t)3 * T * D * 2), (const int*)(p.ws + WS_LIST) + (size_t)e * T, (const float*)(p.ws + WS_LISTW) + (size_t)e * T, c, local * 256, pn * 256};
        g8::gemm_unit(lds, (const char*)(p.ws + WS_B) + (size_t)mt * 256 * DE * 2, aoff, (const char*)(p.ws + WS_WDN) + ((size_t)e * D + pn * 256) * DE * 2, kdn, E);
    }
}

__device__ __forceinline__ void phase7(const Params& p) {
    int tid7 = threadIdx.x; asm volatile("" : "+v"(tid7));
    const int wave = tid7 >> 6, lane = tid7 & 63;
    const bf16_t* y0 = (const bf16_t*)(p.ws + WS_A + (size_t)T * D * 2); const bf16_t* y1 = y0 + (size_t)T * D;
    f32x4 g[4];
#pragma unroll
    for (int j = 0; j < 4; ++j) g[j] = *((const f32x4*)p.final_g + lane + 64 * j);
    for (int row = blockIdx.x * NWAVES + wave; row < T; row += gridDim.x * NWAVES) {
        f32x4* hr = (f32x4*)(p.out + (size_t)row * D) + lane; const u32x2* a = (const u32x2*)(y0 + (size_t)row * D) + lane; const u32x2* bq = (const u32x2*)(y1 + (size_t)row * D) + lane;
        f32x4 v[4]; float s = 0.f;
#pragma unroll
        for (int j = 0; j < 4; ++j) { v[j] = hr[64 * j]; const u32x2 ya = a[64 * j], yb = bq[64 * j];
            v[j][0] += bf16_lo(ya.x) + bf16_lo(yb.x); v[j][1] += bf16_hi(ya.x) + bf16_hi(yb.x); v[j][2] += bf16_lo(ya.y) + bf16_lo(yb.y); v[j][3] += bf16_hi(ya.y) + bf16_hi(yb.y);
            s += (v[j][0] * v[j][0] + v[j][1] * v[j][1]) + (v[j][2] * v[j][2] + v[j][3] * v[j][3]); }
        s = wave_sum(s);
        const float rs = 1.0f / sqrtf(s * (1.0f / D) + 1e-6f);
#pragma unroll
        for (int j = 0; j < 4; ++j) hr[64 * j] = v[j] * rs * g[j];
    }
}

__global__ __launch_bounds__(512) void mega(Params p) {
    extern __shared__ __attribute__((aligned(16))) unsigned char lds_raw[];
    LAS unsigned char* lds = (LAS unsigned char*)lds_raw;
    volatile LAS unsigned* bst = (volatile LAS unsigned*)(lds + LDS_MAP + 512);
    if (threadIdx.x == 0) { bst[0] = 0u; bst[1] = 0u; bst[2] = 0u; bst[3] = 0u; }
    __syncthreads();
    const XcdBarrier gb = xcd_barrier_post((unsigned*)(p.ws + WS_BAR), bst);
#define GSYNC() xcd_barrier(gb)
#ifndef PHASE_MASK
#define PHASE_MASK 0xff
#endif
#ifdef TPROBE
    volatile LAS unsigned long long* tsl = (volatile LAS unsigned long long*)(lds + LDS_MAP + 640);
    if (threadIdx.x == 0) tsl[0] = __builtin_amdgcn_s_memrealtime();
#define TS(i) do { if (threadIdx.x == 0 && ((i) == TPROBE || (i) == TPROBE + 1)) tsl[i] = __builtin_amdgcn_s_memrealtime(); } while (0)
#else
#define TS(i)
#endif
    if (PHASE_MASK & 1) phase0(p, lds); GSYNC(); TS(1);
    if (PHASE_MASK & 2) phase1(p, lds); GSYNC(); TS(2);
    if (PHASE_MASK & 4) phase2(p, lds); GSYNC(); TS(3);
#ifdef RWDEBUG
    {
        bf16_t* dbg = (bf16_t*)(p.ws + WS_A + (size_t)3 * T * D * 2 + 4096);
        float* red = (float*)(p.ws + WS_CTL + 2048);
        if (blockIdx.x == 0) {
            rwkv_chain_seq(p, lds, RWDEBUG_B, RWDEBUG_H, dbg - (size_t)RWDEBUG_B * S * D, 2 * RWDEBUG_C1);
            __syncthreads();
            const bf16_t* mix = (const bf16_t*)(p.ws + WS_B);
            float md = 0.f, mr = 0.f; int bad = 0;
            for (int i = threadIdx.x; i < (RWDEBUG_C1 - RWDEBUG_C0) * 32 * 64; i += NTHREADS) {
                const int t = RWDEBUG_C0 * 32 + i / 64, col = 512 + RWDEBUG_H * 64 + (i % 64);
                const float a = __uint_as_float((unsigned)mix[((size_t)RWDEBUG_B * S + t) * D + col] << 16), r = __uint_as_float((unsigned)dbg[(size_t)t * D + col] << 16);
                if (!(fabsf(a) < 1e30f)) bad++;
                else { md = fmaxf(md, fabsf(a - r)); } mr = fmaxf(mr, fabsf(r));
            }
            LAS float* sh = (LAS float*)lds;
            sh[threadIdx.x] = md; sh[512 + threadIdx.x] = mr; sh[1024 + threadIdx.x] = (float)bad; __syncthreads();
            if (threadIdx.x == 0) { float a = 0.f, r = 0.f, nb = 0.f; for (int i = 0; i < NTHREADS; ++i) { a = fmaxf(a, sh[i]); r = fmaxf(r, sh[512 + i]); nb += sh[1024 + i]; }
                float rel = a / fmaxf(r, 1e-20f); float code = nb > 0.f ? 40.0f : (rel < 0.03f ? 5.0f : (rel < 0.3f ? 10.0f : 20.0f));
                red[0] = code; }
        }
        GSYNC();
        const float code = ((const float*)(p.ws + WS_CTL + 2048))[0];
        for (size_t i = (size_t)blockIdx.x * NTHREADS + threadIdx.x; i < (size_t)T * D; i += (size_t)gridDim.x * NTHREADS) p.out[i] = code;
        return;
    }
#endif
    if (PHASE_MASK & 8) phase3(p, lds); GSYNC(); TS(4);
    if (PHASE_MASK & 16) phase4(p, lds); GSYNC(); TS(5);
    if (PHASE_MASK & 32) phase5(p, lds); GSYNC(); TS(6);
    if (PHASE_MASK & 64) phase6(p, lds); GSYNC(); TS(7);
    if (PHASE_MASK & 128) phase7(p);
#ifdef TPROBE
    GSYNC(); TS(8);
    float* tw = (float*)(p.ws + WS_CTL + 1024);
    if (blockIdx.x == 0 && threadIdx.x == 0) { const float t1 = (float)(tsl[TPROBE + 1] - tsl[TPROBE]) * 0.01f; tw[0] = floorf(log2f(t1) * TPQ + 0.5f) / TPQ; }
    GSYNC();
    const float c1 = tw[0];
    int tq_ = threadIdx.x; asm volatile("" : "+v"(tq_));
    for (size_t i = (size_t)blockIdx.x * NTHREADS + tq_; i < (size_t)T * D; i += (size_t)gridDim.x * NTHREADS) p.out[i] = c1;
#endif
}

extern "C" void kernel_launch(void* const* d_in, const int* in_sizes, int n_in, void* d_out, int out_size, void* d_ws, size_t ws_size, hipStream_t stream) {
    static int grid = 0;
    if (grid == 0) {
        if (n_in != 25 || out_size != T * D || ws_size < WS_END) { fprintf(stderr, "kernel_launch: unexpected sizes n_in %d out %d ws %zu (need %zu)\n", n_in, out_size, ws_size, (size_t)WS_END); grid = -1; return; }
        int dev = 0, cus = 0, per_cu = 0;
        (void)hipGetDevice(&dev); (void)hipDeviceGetAttribute(&cus, hipDeviceAttributeMultiprocessorCount, dev);
        if (hipFuncSetAttribute((const void*)mega, hipFuncAttributeMaxDynamicSharedMemorySize, LDS_BYTES) != hipSuccess) { fprintf(stderr, "kernel_launch: hipFuncSetAttribute failed\n"); grid = -1; return; }
        if (hipOccupancyMaxActiveBlocksPerMultiprocessor(&per_cu, (const void*)mega, NTHREADS, LDS_BYTES) != hipSuccess || per_cu < 1) { fprintf(stderr, "kernel_launch: occupancy query failed (%d)\n", per_cu); (void)hipGetLastError(); per_cu = 1; }
        grid = cus * 1;
    }
    if (grid < 0) return;
    Params p{};
    const float** f = (const float**)&p;
    for (int i = 0; i < 25; ++i) f[i] = (const float*)d_in[i];
    p.out = (float*)d_out; p.ws = (unsigned char*)d_ws;
    if (hipMemsetAsync((char*)d_ws + WS_BAR, 0, XCD_BAR_WORDS * 4, stream) != hipSuccess) { fprintf(stderr, "kernel_launch: memset failed\n"); return; }
    hipLaunchKernelGGL(mega, dim3(grid), dim3(NTHREADS), LDS_BYTES, stream, p);
    hipError_t e = hipPeekAtLastError();
    if (e != hipSuccess) fprintf(stderr, "launch failed: %s (grid %d)\n", hipGetErrorString(e), grid);
}
```

```cpp
#include <hip/hip_runtime.h>
#include <cstdio>
#include <cstdint>
#define TPQ 8.0f

#define LAS __attribute__((address_space(3)))
typedef unsigned short bf16_t;
typedef short bf16x8 __attribute__((ext_vector_type(8)));
typedef short s16x4 __attribute__((ext_vector_type(4)));
typedef float f32x4 __attribute__((ext_vector_type(4)));
typedef float f32x2 __attribute__((ext_vector_type(2)));
typedef float f32x16 __attribute__((ext_vector_type(16)));
typedef unsigned u32x2 __attribute__((ext_vector_type(2)));
typedef unsigned u32x4 __attribute__((ext_vector_type(4)));

constexpr int NB = 16, S = 2048, T = NB * S, D = 1024, NIN = 3328, NH = 8, HD = 64;
constexpr int UQ = 0, UK = 512, UV = 1024, UR = 1536, URK = 2048, URV = 2560, UXW = 3072, UXA = 3136, UXG = 3200;
constexpr int NE = 32, DE = 256;
constexpr float LOG2E = 1.4426950408889634f, LN2 = 0.6931471805599453f;
constexpr float QSCALE = 0.125f * LOG2E;
constexpr int NTHREADS = 512, NWAVES = 8;
constexpr int LDS_BYTES = 161792 + 1024;

constexpr size_t WS_CTL   = 0;
constexpr size_t WS_BAR   = 8192;
constexpr size_t WS_WIN   = 65536;
constexpr size_t WS_WOUT  = WS_WIN  + (size_t)NIN * D * 2;
constexpr size_t WS_WGU   = WS_WOUT + (size_t)D * D * 2;
constexpr size_t WS_WDN   = WS_WGU  + (size_t)NE * 512 * D * 2;
constexpr size_t WS_RSTD1 = WS_WDN  + (size_t)NE * D * DE * 2;
constexpr size_t WS_RSTD2 = WS_RSTD1 + (size_t)T * 4;
constexpr size_t WS_LIST  = WS_RSTD2 + (size_t)T * 4;
constexpr size_t WS_LISTW = WS_LIST + (size_t)NE * T * 4;
constexpr size_t WS_WR    = WS_LISTW + (size_t)NE * T * 4;
constexpr size_t WS_LT    = WS_WR + (size_t)2 * 48 * D * 2;
constexpr size_t WS_A     = WS_LT + (size_t)512 * 256 * 2;
constexpr size_t WS_B     = WS_A + (size_t)T * NIN * 2;
constexpr size_t WS_END   = WS_B + (size_t)T * D * 2;
constexpr int HID_ROWS = 2 * T + NE * 256;

struct Params {
    const float* x; const float* norm_mix_g; const float* w_in; const float* shift_mu; const float* sb_out_g;
    const float* rw_w0; const float* rw_w2; const float* rw_a0; const float* rw_a2; const float* rw_g2;
    const float* rw_k_k; const float* rw_k_a; const float* rw_r_k; const float* rw_ln_w; const float* rw_ln_b;
    const float* w_out; const float* norm_ffn_g; const float* r_grp_w; const float* r_grp_b; const float* r_exp_w; const float* r_exp_b;
    const float* w_gate; const float* w_up; const float* w_down; const float* final_g;
    float* out; unsigned char* ws;
};

typedef __bf16 bf16x2_t __attribute__((ext_vector_type(2)));
__device__ __forceinline__ unsigned cvt_pk_bf16(float lo, float hi) { const f32x2 v = {lo, hi}; return __builtin_bit_cast(unsigned, __builtin_convertvector(v, bf16x2_t)); }
__device__ __forceinline__ float bf16_lo(unsigned w) { return __uint_as_float(w << 16); }
__device__ __forceinline__ float bf16_hi(unsigned w) { return __uint_as_float(w & 0xffff0000u); }
__device__ __forceinline__ float fexp2(float x) { return __builtin_amdgcn_exp2f(x); }
__device__ __forceinline__ float flog2(float x) { return __builtin_amdgcn_logf(x); }
__device__ __forceinline__ float frcp(float x) { return __builtin_amdgcn_rcpf(x); }
__device__ __forceinline__ float frsq(float x) { return __builtin_amdgcn_rsqf(x); }
template <int CTRL> __device__ __forceinline__ float dppf(float v) { return __builtin_bit_cast(float, __builtin_amdgcn_update_dpp(0, __builtin_bit_cast(int, v), CTRL, 0xF, 0xF, true)); }
__device__ __forceinline__ float rlane(float v, int l) { return __builtin_bit_cast(float, __builtin_amdgcn_readlane(__builtin_bit_cast(int, v), l)); }
__device__ __forceinline__ float sum8(float v) { v += dppf<0xB1>(v); v += dppf<0x4E>(v); v += dppf<0x141>(v); return v; }
__device__ __forceinline__ float sum16(float v) { v = sum8(v); v += dppf<0x140>(v); return v; }
__device__ __forceinline__ float wave_sum(float v) { v = sum16(v); return (rlane(v, 0) + rlane(v, 16)) + (rlane(v, 32) + rlane(v, 48)); }
__device__ __forceinline__ float swap32(float v) { return __shfl_xor(v, 32); }
#define LDS_WAIT() asm volatile("s_waitcnt lgkmcnt(0)" ::: "memory")


#define XB_TMO      128
#define XB_XCNT(j)  (256  + 64 * (j))
#define XB_XSUB(j)  (1280 + 64 * (j))
#define XB_XGEN(j)  (2304 + 64 * (j))
#define XB_TOP      3328
#define XB_TOPGEN   3392
#define XCD_BAR_WORDS 3456
#define XB_SPIN_CAP (1u << 22)
__device__ __forceinline__ unsigned xb_ld(unsigned* p)              { return __hip_atomic_load(p, __ATOMIC_RELAXED, __HIP_MEMORY_SCOPE_AGENT); }
__device__ __forceinline__ unsigned xb_add(unsigned* p, unsigned v) { return __hip_atomic_fetch_add(p, v, __ATOMIC_RELAXED, __HIP_MEMORY_SCOPE_AGENT); }
__device__ __forceinline__ unsigned xb_xcc_id() { return (unsigned)__builtin_amdgcn_s_getreg((3 << 11) | 20) & 0xFu; }
#define XB_SPIN(cond, bar) do { unsigned _sp = 0; while (cond) { __builtin_amdgcn_s_sleep(1); \
    if ((++_sp & 255u) == 0u) { if (xb_ld(&(bar)[XB_TMO])) break; if (_sp > XB_SPIN_CAP) { atomicAdd(&(bar)[XB_TMO], 1u); break; } } } } while (0)
struct XcdBarrier { unsigned* bar; unsigned x; volatile LAS unsigned* st; };
__device__ __forceinline__ XcdBarrier xcd_barrier_post(unsigned* bar, volatile LAS unsigned* st) {
    XcdBarrier b; b.bar = bar; b.x = xb_xcc_id(); b.st = st;
    if (threadIdx.x == 0) (void)xb_add(&bar[XB_XCNT(b.x)], 1u);
    return b;
}
__device__ __forceinline__ void xcd_barrier_complete(unsigned* bar, unsigned x, unsigned& nloc, unsigned& nx) {
    const unsigned G = gridDim.x * gridDim.y * gridDim.z;
    unsigned sum, cnt, mine, sp = 0u;
    for (;;) {
        sum = 0u; cnt = 0u; mine = 0u;
#pragma unroll
        for (unsigned j = 0; j < 16; ++j) { const unsigned c = xb_ld(&bar[XB_XCNT(j)]); sum += c; cnt += (c > 0u) ? 1u : 0u; mine = (j == x) ? c : mine; }
        if (sum == G) break;
        __builtin_amdgcn_s_sleep(1);
        if ((++sp & 255u) == 0u) { if (xb_ld(&bar[XB_TMO])) break; if (sp > XB_SPIN_CAP) { atomicAdd(&bar[XB_TMO], 1u); break; } }
    }
    nloc = mine > 0u ? mine : 1u; nx = cnt > 0u ? cnt : 1u;
}
__device__ __forceinline__ void xcd_barrier(const XcdBarrier& b) {
    asm volatile("s_waitcnt vmcnt(0)" ::: "memory");
    __syncthreads();
    if (threadIdx.x == 0) {
        unsigned* bar = b.bar;
        __builtin_amdgcn_s_waitcnt(0);
        unsigned nloc = b.st[0], nx = b.st[1];
        if (nloc == 0u) { xcd_barrier_complete(bar, b.x, nloc, nx); b.st[0] = nloc; b.st[1] = nx; }
        const unsigned old = xb_add(&bar[XB_XSUB(b.x)], 1u);
        const unsigned gen = old / nloc;
        if (old + 1u == (gen + 1u) * nloc) {
            __builtin_amdgcn_fence(__ATOMIC_RELEASE, "agent");
            asm volatile("s_waitcnt vmcnt(0)" ::: "memory");
            const unsigned og = xb_add(&bar[XB_TOP], 1u);
            const unsigned tg = og / nx;
            if (og + 1u == (tg + 1u) * nx) xb_add(&bar[XB_TOPGEN], 1u);
            else XB_SPIN(xb_ld(&bar[XB_TOPGEN]) == tg, bar);
            __builtin_amdgcn_fence(__ATOMIC_ACQUIRE, "agent");
            xb_add(&bar[XB_XGEN(b.x)], 1u);
            asm volatile("s_waitcnt vmcnt(0)" ::: "memory");
        } else {
            XB_SPIN(xb_ld(&bar[XB_XGEN(b.x)]) == gen, bar);
            __builtin_amdgcn_fence(__ATOMIC_ACQUIRE, "agent");
            asm volatile("s_waitcnt vmcnt(0)" ::: "memory");
        }
    }
    __syncthreads();
}

namespace g8 {
constexpr int BK = 64, HALF = 128, HTB = HALF * BK * 2;
__device__ __forceinline__ int lds_byte(int r, int c) { const int st = (r >> 4) * 2 + (c >> 5), rr = r & 15, cc = c & 31, ob = rr * 64 + cc * 2; return st * 1024 + (ob ^ (((ob >> 9) & 1) << 5)); }
__device__ __forceinline__ void stage_rc(int b, int& R, int& C) { const int st = b / 1024, sb = b % 1024, swz = sb ^ (((sb >> 9) & 1) << 5); R = (st >> 1) * 16 + swz / 64; C = (st & 1) * 32 + (swz % 64) / 2; }

#define G8_SA(b, h) (((b) * 2 + (h)) * HTB)
#define G8_SB(b, h) ((4 + (b) * 2 + (h)) * HTB)
#define G8_STAGE_A(bufoff, h, kt) do { _Pragma("unroll") for (int _i = 0; _i < 2; ++_i) \
    __builtin_amdgcn_global_load_lds((const unsigned*)((Ab + (size_t)(kt) * (BK * 2)) + aoff[h][_i]), (LAS unsigned*)(lds + (bufoff) + ldsw + _i * 8192), 16, 0, 0); } while (0)
#define G8_STAGE_B(bufoff, h, kt) do { _Pragma("unroll") for (int _i = 0; _i < 2; ++_i) \
    __builtin_amdgcn_global_load_lds((const unsigned*)((Bb + (size_t)(h) * bhalf + (size_t)(kt) * (BK * 2)) + boff[_i]), (LAS unsigned*)(lds + (bufoff) + ldsw + _i * 8192), 16, 0, 0); } while (0)
#define G8_LDA(dst, b, h) do { _Pragma("unroll") for (int m = 0; m < 4; ++m) _Pragma("unroll") for (int k = 0; k < 2; ++k) dst[m][k] = *(const LAS bf16x8*)(lds + G8_SA(b, h) + la_off + m * 2048 + k * 1024); } while (0)
#define G8_LDB(dst, b, h) do { _Pragma("unroll") for (int n = 0; n < 2; ++n) _Pragma("unroll") for (int k = 0; k < 2; ++k) dst[n][k] = *(const LAS bf16x8*)(lds + G8_SB(b, h) + lb_off + n * 2048 + k * 1024); } while (0)
#define G8_MMA(ai, bj, At, Bt) do { __builtin_amdgcn_s_setprio(1); _Pragma("unroll") for (int m = 0; m < 4; ++m) _Pragma("unroll") for (int n = 0; n < 2; ++n) _Pragma("unroll") for (int k = 0; k < 2; ++k) \
    acc[ai][bj][m][n] = __builtin_amdgcn_mfma_f32_16x16x32_bf16(Bt[n][k], At[m][k], acc[ai][bj][m][n], 0, 0, 0); __builtin_amdgcn_s_setprio(0); } while (0)
#define G8_WAIT_V(n) asm volatile("s_waitcnt vmcnt(" #n ")" ::: "memory")
#define G8_WAIT_L(n) asm volatile("s_waitcnt lgkmcnt(" #n ")" ::: "memory")
#define G8_BAR __builtin_amdgcn_s_barrier()
#define G8_SCHED __builtin_amdgcn_sched_barrier(0)

template <class Epi>
__device__ __forceinline__ void gemm_unit(LAS unsigned char* lds, const char* Ab, const unsigned (&aoff)[2][2], const char* Bb, int K, const Epi& E) {
    int tid = threadIdx.x; asm volatile("" : "+v"(tid));
    const int wid = __builtin_amdgcn_readfirstlane(tid >> 6), lane = tid & 63, wr = wid >> 2, wc = wid & 3, fr = lane & 15, fq = lane >> 4;
    const int nt = K / BK;
    unsigned boff[2];
#pragma unroll
    for (int i = 0; i < 2; ++i) { int R, C; stage_rc(tid * 16 + i * 8192, R, C); const int rho = R & 31, Rb = (R & ~31) + 8 * ((rho & 15) >> 2) + 4 * (rho >> 4) + (rho & 3);
        boff[i] = (unsigned)(Rb * K + C) * 2u; }
    const size_t bhalf = (size_t)HALF * K * 2;
    const unsigned ldsw = (unsigned)wid * 1024u;
    const int la_off = lds_byte(wr * 64 + fr, fq * 8), lb_off = lds_byte(wc * 32 + fr, fq * 8);
    f32x4 acc[2][2][4][2];
#pragma unroll
    for (int a = 0; a < 2; ++a)
#pragma unroll
        for (int b = 0; b < 2; ++b)
#pragma unroll
            for (int m = 0; m < 4; ++m)
#pragma unroll
                for (int n = 0; n < 2; ++n) acc[a][b][m][n] = (f32x4){0.f, 0.f, 0.f, 0.f};
    bf16x8 At[4][2], B0[2][2], B1[2][2];
    G8_STAGE_B(G8_SB(0, 0), 0, 0); G8_STAGE_A(G8_SA(0, 0), 0, 0);
    G8_STAGE_B(G8_SB(0, 1), 1, 0); G8_STAGE_A(G8_SA(0, 1), 1, 0);
    if (wr == 1) G8_BAR;
    G8_WAIT_V(4); G8_BAR;
    G8_STAGE_B(G8_SB(1, 0), 0, 1); G8_STAGE_A(G8_SA(1, 0), 0, 1); G8_STAGE_B(G8_SB(1, 1), 1, 1);
    G8_WAIT_V(6); G8_BAR;
    for (int t = 0; t < nt - 2; t += 2) {
        G8_LDB(B0, 0, 0); G8_SCHED; G8_LDA(At, 0, 0); G8_STAGE_A(G8_SA(1, 1), 1, t + 1);
        G8_WAIT_L(8); G8_BAR; G8_WAIT_L(0); G8_MMA(0, 0, At, B0); G8_BAR; G8_SCHED;
        G8_LDB(B1, 0, 1); G8_STAGE_B(G8_SB(0, 0), 0, t + 2);
        G8_BAR; G8_WAIT_L(0); G8_MMA(0, 1, At, B1); G8_BAR;
        G8_LDA(At, 0, 1); G8_STAGE_A(G8_SA(0, 0), 0, t + 2);
        G8_BAR; G8_WAIT_L(0); G8_MMA(1, 0, At, B0); G8_BAR; G8_SCHED;
        G8_STAGE_B(G8_SB(0, 1), 1, t + 2);
        G8_WAIT_V(6); G8_BAR; G8_MMA(1, 1, At, B1); G8_BAR;
        G8_LDB(B0, 1, 0); G8_SCHED; G8_LDA(At, 1, 0); G8_STAGE_A(G8_SA(0, 1), 1, t + 2);
        G8_WAIT_L(8); G8_BAR; G8_WAIT_L(0); G8_MMA(0, 0, At, B0); G8_BAR; G8_SCHED;
        G8_LDB(B1, 1, 1); G8_STAGE_B(G8_SB(1, 0), 0, t + 3);
        G8_BAR; G8_WAIT_L(0); G8_MMA(0, 1, At, B1); G8_BAR;
        G8_LDA(At, 1, 1); G8_STAGE_A(G8_SA(1, 0), 0, t + 3);
        G8_BAR; G8_WAIT_L(0); G8_MMA(1, 0, At, B0); G8_BAR; G8_SCHED;
        G8_STAGE_B(G8_SB(1, 1), 1, t + 3);
        G8_WAIT_V(6); G8_BAR; G8_MMA(1, 1, At, B1); G8_BAR;
    }
    { G8_LDB(B0, 0, 0); G8_LDA(At, 0, 0); G8_STAGE_A(G8_SA(1, 1), 1, nt - 1);
      G8_BAR; G8_WAIT_L(0); G8_MMA(0, 0, At, B0); G8_BAR;
      G8_LDB(B1, 0, 1); G8_BAR; G8_WAIT_L(0); G8_MMA(0, 1, At, B1); G8_BAR;
      G8_LDA(At, 0, 1); G8_WAIT_V(4); G8_BAR; G8_WAIT_L(0); G8_MMA(1, 0, At, B0); G8_MMA(1, 1, At, B1); G8_BAR; }
    { G8_LDB(B0, 1, 0); G8_LDA(At, 1, 0); G8_WAIT_V(2); G8_BAR; G8_WAIT_L(0); G8_MMA(0, 0, At, B0); G8_BAR;
      G8_LDB(B1, 1, 1); G8_WAIT_V(0); G8_BAR; G8_WAIT_L(0); G8_MMA(0, 1, At, B1); G8_BAR;
      G8_LDA(At, 1, 1); G8_BAR; G8_WAIT_L(0); G8_MMA(1, 0, At, B0); G8_MMA(1, 1, At, B1); G8_BAR; }
    if (wr == 0) G8_BAR;
    asm volatile("" ::: "memory");
    E(acc, wr, wc, fr, fq);
    __syncthreads();
}
__device__ __forceinline__ void aoff_rows(unsigned (&aoff)[2][2], int K) {
    int tid = threadIdx.x; asm volatile("" : "+v"(tid));
#pragma unroll
    for (int i = 0; i < 2; ++i) { int R, C; stage_rc(tid * 16 + i * 8192, R, C);
#pragma unroll
        for (int h = 0; h < 2; ++h) aoff[h][i] = (unsigned)((h * HALF + R) * K + C) * 2u; }
}
__device__ __forceinline__ void tile_order(int L, int nM, int nN, int& pm, int& pn) {
    const int nwg = nM * nN; int wgid = L;
    { const int q = nwg / 8, r = nwg % 8, xcd = wgid % 8, off = wgid / 8; wgid = (xcd < r ? xcd * (q + 1) : r * (q + 1) + (xcd - r) * q) + off; }
    const int nig = 8 * nN, gid = wgid / nig, fm = gid * 8, gsz = (nM - fm) < 8 ? (nM - fm) : 8;
    pm = fm + ((wgid % nig) % gsz); pn = (wgid % nig) / gsz;
}
}

__device__ __forceinline__ void p0_transpose_item(const float* W, int K, int N, int k0, int n0, bf16_t* WTrow0  , const float* kscale, float mul, LAS float* scr, int lane) {
#pragma unroll 8
    for (int i = 0; i < 32; ++i) { const int kk = 2 * i + (lane >> 5); float v = W[(size_t)(k0 + kk) * N + n0 + (lane & 31)]; if (kscale) v *= kscale[k0 + kk]; scr[kk * 33 + (lane & 31)] = v * mul; }
    LDS_WAIT();
    const int c = lane & 7;
#pragma unroll
    for (int j = 0; j < 4; ++j) { const int n = (lane >> 3) + 8 * j; const LAS float* s = scr + (8 * c) * 33 + n;
        u32x4 o; o.x = cvt_pk_bf16(s[0 * 33], s[1 * 33]); o.y = cvt_pk_bf16(s[2 * 33], s[3 * 33]); o.z = cvt_pk_bf16(s[4 * 33], s[5 * 33]); o.w = cvt_pk_bf16(s[6 * 33], s[7 * 33]);
        *(u32x4*)(WTrow0 + (size_t)n * K + k0 + 8 * c) = o; }
    LDS_WAIT();
}

__device__ __forceinline__ void p0_transpose64(const float* W, int K, int N, int k0, int n0, bf16_t* WTrow0  , const float* kscale, LAS float* scr, int lane) {
    const int rq = lane >> 4, c4 = 4 * (lane & 15);
    f32x4 v[16];
#pragma unroll
    for (int i = 0; i < 16; ++i) v[i] = *(const f32x4*)(W + (size_t)(k0 + 4 * i + rq) * N + n0 + c4);
    if (kscale) {
#pragma unroll
        for (int i = 0; i < 16; ++i) v[i] = v[i] * kscale[k0 + 4 * i + rq];
    }
#pragma unroll
    for (int i = 0; i < 16; ++i) { LAS float* d = scr + (4 * i + rq) * 65 + c4; d[0] = v[i][0]; d[1] = v[i][1]; d[2] = v[i][2]; d[3] = v[i][3]; }
    LDS_WAIT();
#pragma unroll
    for (int c = 0; c < 8; ++c) { const LAS float* sp = scr + (8 * c) * 65 + lane;
        u32x4 o; o.x = cvt_pk_bf16(sp[0], sp[65]); o.y = cvt_pk_bf16(sp[2 * 65], sp[3 * 65]); o.z = cvt_pk_bf16(sp[4 * 65], sp[5 * 65]); o.w = cvt_pk_bf16(sp[6 * 65], sp[7 * 65]);
        *(u32x4*)(WTrow0 + (size_t)lane * K + k0 + 8 * c) = o; }
    LDS_WAIT();
}
__device__ __forceinline__ void p0_expert_weights(const Params& p, LAS unsigned char* lds, int gw, int NGW) {
    int tid = threadIdx.x; asm volatile("" : "+v"(tid));
    const int wave = tid >> 6, lane = tid & 63;
    LAS float* scr = (LAS float*)(lds + wave * 16640);
    bf16_t* wgu = (bf16_t*)(p.ws + WS_WGU); bf16_t* wdn = (bf16_t*)(p.ws + WS_WDN);
    constexpr int I_G = NE * 16 * 4, I_D = NE * 4 * 16;
    for (int it = gw; it < 2 * I_G + I_D; it += NGW) {
        int r = it;
        if (r < 2 * I_G) { const int up = r >= I_G; if (up) r -= I_G; const int e = r / 64, q = r % 64, kb = q / 4, nb = q % 4, n0 = nb * 64;
            const int drow = (n0 >> 7) * 256 + up * 128 + (n0 & 127);
            p0_transpose64((up ? p.w_up : p.w_gate) + (size_t)e * D * DE, D, DE, kb * 64, n0, wgu + ((size_t)e * 512 + drow) * D, p.norm_ffn_g, scr, lane); continue; } r -= 2 * I_G;
        { const int e = r / 64, q = r % 64, kb = q / 16, nb = q % 16, n0 = nb * 64;
            p0_transpose64(p.w_down + (size_t)e * DE * D, DE, D, kb * 64, n0, wdn + ((size_t)e * D + n0) * DE, nullptr, scr, lane); }
    }
}
__device__ __forceinline__ void phase0(const Params& p, LAS unsigned char* lds) {
    int tid = threadIdx.x; asm volatile("" : "+v"(tid));
    const int wave = tid >> 6, lane = tid & 63;
    const int gw = blockIdx.x * NWAVES + wave, NGW = gridDim.x * NWAVES;
    LAS float* scr = (LAS float*)(lds + wave * 8704);
    bf16_t* win = (bf16_t*)(p.ws + WS_WIN); bf16_t* wout = (bf16_t*)(p.ws + WS_WOUT);
    constexpr int I_IN = 16 * 104, I_OUT = 16 * 32;
    for (int it = gw; it < I_IN + I_OUT; it += NGW) {
        int r = it;
        if (r < I_IN) { const int kb = r / 104, nb = r % 104, n0 = nb * 32; p0_transpose_item(p.w_in, D, NIN, kb * 64, n0, win + (size_t)n0 * D, p.norm_mix_g, n0 < 512 ? QSCALE : 1.f, scr, lane); continue; } r -= I_IN;
        { const int kb = r / 32, nb = r % 32, n0 = nb * 32; p0_transpose_item(p.w_out, D, D, kb * 64, n0, wout + (size_t)n0 * D, nullptr, 1.f, scr, lane); }
    }
    bf16_t* xb = (bf16_t*)(p.ws + WS_B); float* rstd1 = (float*)(p.ws + WS_RSTD1);
    for (int row = gw; row < T; row += NGW) {
        const f32x4* xr = (const f32x4*)(p.x + (size_t)row * D) + lane; f32x4 v[4]; float s = 0.f;
#pragma unroll
        for (int j = 0; j < 4; ++j) { v[j] = xr[64 * j]; s += (v[j].x * v[j].x + v[j].y * v[j].y) + (v[j].z * v[j].z + v[j].w * v[j].w); }
        s = wave_sum(s);
        u32x2* o = (u32x2*)(xb + (size_t)row * D) + lane;
#pragma unroll
        for (int j = 0; j < 4; ++j) { u32x2 w; w.x = cvt_pk_bf16(v[j].x, v[j].y); w.y = cvt_pk_bf16(v[j].z, v[j].w); o[64 * j] = w; }
        if (lane == 0) rstd1[row] = 1.0f / sqrtf(s * (1.0f / D) + 1e-6f);
    }
    bf16_t* wr_hi = (bf16_t*)(p.ws + WS_WR); bf16_t* wr_lo = wr_hi + 48 * D;
    for (int i = blockIdx.x * NTHREADS + tid; i < 48 * D; i += gridDim.x * NTHREADS) {
        const int c = i / D, k = i % D; float w = 0.f;
        if (c < 4) w = p.r_grp_w[k * 4 + c]; else if (c < 36) w = p.r_exp_w[k * 32 + (c - 4)];
        w *= p.norm_ffn_g[k];
        const unsigned hi = cvt_pk_bf16(w, 0.f) & 0xffffu; const float rem = w - __uint_as_float(hi << 16);
        wr_hi[i] = (bf16_t)hi; wr_lo[i] = (bf16_t)(cvt_pk_bf16(rem, 0.f) & 0xffffu);
    }
    { bf16_t* w2t = (bf16_t*)(p.ws + WS_LT); bf16_t* a2t = w2t + 512 * 64; bf16_t* g2t = a2t + 512 * 64;
      for (int i = blockIdx.x * NTHREADS + tid; i < 512 * 256; i += gridDim.x * NTHREADS) {
          if (i < 512 * 64) { const int c = i >> 6, m = i & 63; w2t[i] = (bf16_t)(cvt_pk_bf16(p.rw_w2[m * 512 + c], 0.f) & 0xffffu); }
          else if (i < 2 * 512 * 64) { const int q = i - 512 * 64, c = q >> 6, m = q & 63; a2t[q] = (bf16_t)(cvt_pk_bf16(p.rw_a2[m * 512 + c], 0.f) & 0xffffu); }
          else { const int q = i - 2 * 512 * 64, c = q >> 7, m = q & 127; g2t[q] = (bf16_t)(cvt_pk_bf16(p.rw_g2[m * 512 + c], 0.f) & 0xffffu); } } }
    if (blockIdx.x == 0 && tid < 64) ((unsigned*)(p.ws + WS_CTL))[tid] = 0u;
}

struct EpiU {
    bf16_t* u; const float* rstd; int row0, col0;
    __device__ __forceinline__ void operator()(const f32x4 (&acc)[2][2][4][2], int wr, int wc, int fr, int fq) const {
#pragma unroll
        for (int ai = 0; ai < 2; ++ai)
#pragma unroll
            for (int m = 0; m < 4; ++m) { const int row = row0 + ai * 128 + wr * 64 + m * 16 + fr; const float rs = rstd[row]; bf16_t* rp = u + (size_t)row * NIN + col0 + wc * 32 + 8 * fq;
#pragma unroll
                for (int bj = 0; bj < 2; ++bj) { const f32x4 v0 = acc[ai][bj][m][0] * rs, v1 = acc[ai][bj][m][1] * rs;
                    *(u32x4*)(rp + bj * 128) = (u32x4){cvt_pk_bf16(v0[0], v0[1]), cvt_pk_bf16(v0[2], v0[3]), cvt_pk_bf16(v1[0], v1[1]), cvt_pk_bf16(v1[2], v1[3])}; } }
    }
};
__device__ __forceinline__ void phase1(const Params& p, LAS unsigned char* lds) {
    constexpr int nM = T / 256, nN = NIN / 256;
    unsigned aoff[2][2]; g8::aoff_rows(aoff, D);
    for (int L = blockIdx.x; L < nM * nN; L += gridDim.x) {
        int pm, pn; g8::tile_order(L, nM, nN, pm, pn);
        EpiU E{(bf16_t*)(p.ws + WS_A), (const float*)(p.ws + WS_RSTD1), pm * 256, pn * 256};
        g8::gemm_unit(lds, (const char*)(p.ws + WS_B) + (size_t)pm * 256 * D * 2, aoff, (const char*)(p.ws + WS_WIN) + (size_t)pn * 256 * D * 2, D, E);
    }
}


typedef short v4i16_t __attribute__((ext_vector_type(4)));
__device__ __forceinline__ s16x4 lds_tr16(const LAS unsigned char* p) { return __builtin_bit_cast(s16x4, __builtin_amdgcn_ds_read_tr16_b64_v4i16((LAS v4i16_t*)p)); }

__device__ __forceinline__ void attn_tile(const Params& p, LAS unsigned char* vl  , int b, int h, int qt) {
    const int lane = threadIdx.x & 63, r32 = lane & 31, hi = lane >> 5;
    const bf16_t* u = (const bf16_t*)(p.ws + WS_A);
    const size_t row0 = (size_t)b * S; const int q0 = qt * 32;
    bf16x8 qf[4];
    { const bf16_t* qp = u + (row0 + q0 + r32) * NIN + UQ + h * HD + 8 * hi;
#pragma unroll
      for (int s = 0; s < 4; ++s) qf[s] = *(const bf16x8*)(qp + 16 * s); }
    f32x16 o0, o1;
#pragma unroll
    for (int i = 0; i < 16; ++i) { o0[i] = 0.f; o1[i] = 0.f; }
    float carry = 0.f;
    const int kperm = 16 * ((r32 >> 2) & 1) + (r32 & 3) + 4 * (r32 >> 3);
    const int g = lane >> 4, i16 = lane & 15, tq = i16 >> 2, tp = i16 & 3;
    const LAS unsigned char* vrd = vl + (16 * (g >> 1) + tq) * 144 + (16 * (g & 1) + 4 * tp) * 2;
    LAS unsigned char* vwr = vl + (lane >> 1) * 144 + (lane & 1) * 64;
    for (int kb = qt; kb >= 0; --kb) {
        const int key0 = kb * 32;
        { const bf16_t* vp = u + (row0 + key0 + (lane >> 1)) * NIN + UV + h * HD + 32 * (lane & 1);
          u32x4 v0 = *(const u32x4*)(vp), v1 = *(const u32x4*)(vp + 8), v2 = *(const u32x4*)(vp + 16), v3 = *(const u32x4*)(vp + 24);
          *(LAS u32x4*)(vwr) = v0; *(LAS u32x4*)(vwr + 16) = v1; *(LAS u32x4*)(vwr + 32) = v2; *(LAS u32x4*)(vwr + 48) = v3; }
        f32x16 st;
#pragma unroll
        for (int i = 0; i < 16; ++i) st[i] = 0.f;
        { const bf16_t* kp = u + (row0 + key0 + kperm) * NIN + UK + h * HD + 8 * hi;
          bf16x8 kf[4];
#pragma unroll
          for (int s = 0; s < 4; ++s) kf[s] = *(const bf16x8*)(kp + 16 * s);
#pragma unroll
          for (int s = 0; s < 4; ++s) st = __builtin_amdgcn_mfma_f32_32x32x16_bf16(kf[s], qf[s], st, 0, 0, 0); }
        const bool diag = (kb == qt);
        float lw[16], suf[16];
        float run = 0.f;
#pragma unroll
        for (int reg = 15; reg >= 0; --reg) {
            const float z = st[reg];
            const float l = flog2(1.0f + fexp2(-fabsf(z)));
            const float sp = fmaxf(z, 0.f) + l;
            const bool valid = !diag || (16 * hi + reg < r32);
            lw[reg] = valid ? (z - sp) : -1.0e30f;
            suf[reg] = run;
            run += valid ? -sp : 0.f;
        }
        const float other = swap32(run);
        const float tot_hi = hi ? run : other, tot_lo = hi ? other : run;
        const float base = carry + (hi ? 0.f : tot_hi);
        carry += tot_lo + tot_hi;
        unsigned pk[8];
#pragma unroll
        for (int j = 0; j < 8; ++j) pk[j] = cvt_pk_bf16(fexp2(lw[2 * j] + suf[2 * j] + base), fexp2(lw[2 * j + 1] + suf[2 * j + 1] + base));
        LDS_WAIT();
#pragma unroll
        for (int s2 = 0; s2 < 2; ++s2) {
            bf16x8 pf = __builtin_bit_cast(bf16x8, (u32x4){pk[4 * s2], pk[4 * s2 + 1], pk[4 * s2 + 2], pk[4 * s2 + 3]});
#pragma unroll
            for (int dh = 0; dh < 2; ++dh) {
                const s16x4 a = lds_tr16(vrd + (8 * s2) * 144 + 64 * dh), c = lds_tr16(vrd + (8 * s2 + 4) * 144 + 64 * dh);
                bf16x8 vf; vf[0] = a[0]; vf[1] = a[1]; vf[2] = a[2]; vf[3] = a[3]; vf[4] = c[0]; vf[5] = c[1]; vf[6] = c[2]; vf[7] = c[3];
                if (dh == 0) o0 = __builtin_amdgcn_mfma_f32_32x32x16_bf16(vf, pf, o0, 0, 0, 0); else o1 = __builtin_amdgcn_mfma_f32_32x32x16_bf16(vf, pf, o1, 0, 0, 0);
            }
        }
        LDS_WAIT();
        if (__builtin_amdgcn_ballot_w64(carry > -150.0f) == 0ull) break;
    }
    float ss = 0.f;
#pragma unroll
    for (int i = 0; i < 16; ++i) ss += o0[i] * o0[i] + o1[i] * o1[i];
    ss += swap32(ss);
    const float rs = 1.0f / sqrtf(ss * (1.0f / HD) + 1e-6f);
    bf16_t* op = (bf16_t*)(p.ws + WS_B) + (row0 + q0 + r32) * D + h * HD + 4 * hi;
    const float* gp = p.sb_out_g + h * HD + 4 * hi;
#pragma unroll
    for (int dh = 0; dh < 2; ++dh)
#pragma unroll
        for (int gq = 0; gq < 4; ++gq) {
            const f32x4 gg = *(const f32x4*)(gp + 32 * dh + 8 * gq);
            const f32x16& o = dh ? o1 : o0;
            u32x2 w; w.x = cvt_pk_bf16(o[4 * gq] * rs * gg[0], o[4 * gq + 1] * rs * gg[1]); w.y = cvt_pk_bf16(o[4 * gq + 2] * rs * gg[2], o[4 * gq + 3] * rs * gg[3]);
            *(u32x2*)(op + 32 * dh + 8 * gq) = w;
        }
}

constexpr size_t ACT_OFF = (size_t)64 << 20;
namespace rk {
constexpr int C = 32, NCH = S / C, NSLOT = 16;
constexpr int SL_PS = 0, SL_QS = 8192, SL_PO = 12288, SL_QO = 16384, SL_VR = 18432, SL_GB = 22528, SL_GW = 26624, SLOT_BYTES = 30720;
constexpr int MSTR = 144;
constexpr int PM_AT = 0, PM_RT = 4608, PM_BT = 9216, PM_KT = 13824, PM_GC = 18432, PROD_LDS = 18688;
constexpr int NPROD = 6;
constexpr int L_CONS = NPROD * PROD_LDS;
constexpr int OSTR = 272;
constexpr int L_OBUF = L_CONS + 4608;
constexpr int L_FLAG = L_OBUF + 32 * OSTR;
constexpr int L_W2 = L_FLAG + 256;
constexpr int L_A2 = L_W2 + 8192;
constexpr int L_G2 = L_A2 + 8192;
constexpr int L_CST = L_G2 + 16384;
constexpr int C_MUL = 0, C_MUR = 256, C_MUK = 320, C_MUV = 384, C_W0 = 448, C_A0 = 512, C_KK = 576, C_KA = 640, C_RK = 704, C_LNB = 768, C_END = 832;
static_assert(L_CST + C_END * 4 <= 161792, "rwkv LDS layout overflows");
}
__device__ __forceinline__ bf16x8 accfrag(const f32x16& a, int s) {
    return __builtin_bit_cast(bf16x8, (u32x4){cvt_pk_bf16(a[8 * s], a[8 * s + 1]), cvt_pk_bf16(a[8 * s + 2], a[8 * s + 3]), cvt_pk_bf16(a[8 * s + 4], a[8 * s + 5]), cvt_pk_bf16(a[8 * s + 6], a[8 * s + 7])});
}
__device__ __forceinline__ bf16x8 trfrag(const LAS unsigned char* mat, int s, int nt, int lane) {
    const int g = lane >> 4, i16 = lane & 15, q = i16 >> 2, pp = i16 & 3, h = g >> 1;
    const LAS unsigned char* a = mat + (16 * s + 4 * h + q) * rk::MSTR + (32 * nt + 16 * (g & 1) + 4 * pp) * 2;
    const s16x4 x = lds_tr16(a), y = lds_tr16(a + 8 * rk::MSTR);
    bf16x8 r; r[0] = x[0]; r[1] = x[1]; r[2] = x[2]; r[3] = x[3]; r[4] = y[0]; r[5] = y[1]; r[6] = y[2]; r[7] = y[3]; return r;
}
__device__ __forceinline__ void f8_from_bf16(const u32x4 w, float (&o)[8]) {
#pragma unroll
    for (int j = 0; j < 4; ++j) { o[2 * j] = bf16_lo(w[j]); o[2 * j + 1] = bf16_hi(w[j]); }
}
__device__ __forceinline__ f32x16 mfma32(bf16x8 a, bf16x8 b, f32x16 c) { return __builtin_amdgcn_mfma_f32_32x32x16_bf16(a, b, c, 0, 0, 0); }
__device__ __forceinline__ f32x16 zero16() { f32x16 z; for (int i = 0; i < 16; ++i) z[i] = 0.f; return z; }
__device__ __forceinline__ void um8(const bf16_t* urow  , bool has_prev, const float* mu, float (&o)[8]) {
    const u32x4 c = *(const u32x4*)urow; u32x4 pv = (u32x4){0u, 0u, 0u, 0u}; if (has_prev) pv = *(const u32x4*)(urow - NIN);
    const f32x4 m0 = *(const f32x4*)mu, m1 = *(const f32x4*)(mu + 4);
    float cv[8], pf[8]; f8_from_bf16(c, cv); f8_from_bf16(pv, pf);
#pragma unroll
    for (int j = 0; j < 4; ++j) { o[j] = cv[j] + (pf[j] - cv[j]) * m0[j]; o[4 + j] = cv[4 + j] + (pf[4 + j] - cv[4 + j]) * m1[j]; }
}
__device__ __forceinline__ void lerp8(const u32x4 c, const u32x4 pv, const LAS float* mu, float (&o)[8]) {
    const f32x4 m0 = *(const LAS f32x4*)mu, m1 = *(const LAS f32x4*)(mu + 4);
    float cv[8], pf[8]; f8_from_bf16(c, cv); f8_from_bf16(pv, pf);
#pragma unroll
    for (int j = 0; j < 4; ++j) { o[j] = cv[j] + (pf[j] - cv[j]) * m0[j]; o[4 + j] = cv[4 + j] + (pf[4 + j] - cv[4 + j]) * m1[j]; }
}
__device__ __forceinline__ void lerp8(const u32x4 c, const u32x4 pv, const float* mu, float (&o)[8]) {
    const f32x4 m0 = *(const f32x4*)mu, m1 = *(const f32x4*)(mu + 4);
    float cv[8], pf[8]; f8_from_bf16(c, cv); f8_from_bf16(pv, pf);
#pragma unroll
    for (int j = 0; j < 4; ++j) { o[j] = cv[j] + (pf[j] - cv[j]) * m0[j]; o[4 + j] = cv[4 + j] + (pf[4 + j] - cv[4 + j]) * m1[j]; }
}
__device__ __forceinline__ float scan32(float x) {
    x += dppf<0x111>(x); x += dppf<0x112>(x); x += dppf<0x114>(x); x += dppf<0x118>(x);
    const float bc = __builtin_bit_cast(float, __builtin_amdgcn_update_dpp(0, __builtin_bit_cast(int, x), 0x142, 0xA, 0xF, false));
    return x + bc;
}

__device__ __forceinline__ void rk_produce(const Params& p, LAS unsigned char* lds, LAS unsigned char* pl  , unsigned char* slot, int b, int hh, int c) {
    using namespace rk;
    int lane = threadIdx.x & 63; asm volatile("" : "+v"(lane));
    const int r32 = lane & 31, h = lane >> 5;
    const bf16_t* u = (const bf16_t*)(p.ws + WS_A);
    const size_t row0 = (size_t)b * S; const int t0 = c * C; const int tt = t0 + r32; const bool hp = tt > 0;
    const bf16_t* urow = u + (row0 + tt) * NIN;
    const LAS float* cst = (const LAS float*)(lds + L_CST);
    const int jrow0 = 32 * ((r32 >> 2) & 1) + (r32 & 3) + 4 * (r32 >> 3);
    f32x16 lw[2], la[2], lg[2];
#pragma unroll
    for (int mt = 0; mt < 2; ++mt) { lw[mt] = zero16(); la[mt] = zero16(); lg[mt] = zero16(); }
    const int cb = hh * HD + 32 * h;
    u32x4 ck[4], pk4[4], cr[4], pr4[4];
    {
        const bf16_t* act = (const bf16_t*)((const unsigned char*)p.out + ACT_OFF) + (row0 + tt) * 256 + 8 * h;
        u32x4 bw[4], ba[4], bg[8];
#pragma unroll
        for (int s = 0; s < 4; ++s) { bw[s] = *(const u32x4*)(act + 16 * s); ba[s] = *(const u32x4*)(act + 64 + 16 * s); }
#pragma unroll
        for (int s = 0; s < 8; ++s) bg[s] = *(const u32x4*)(act + 128 + 16 * s);
        {
            bf16x8 fw[2][4];
#pragma unroll
            for (int mt = 0; mt < 2; ++mt)
#pragma unroll
                for (int s = 0; s < 4; ++s) { const int jl = jrow0 + 16 * mt; fw[mt][s] = *(const LAS bf16x8*)(lds + L_W2 + jl * 128 + (((2 * s + h) ^ (jl & 7)) << 4)); }
#pragma unroll
            for (int s = 0; s < 4; ++s)
#pragma unroll
                for (int mt = 0; mt < 2; ++mt) lw[mt] = mfma32(fw[mt][s], __builtin_bit_cast(bf16x8, bw[s]), lw[mt]);
        }
        {
            bf16x8 fa[2][4];
#pragma unroll
            for (int mt = 0; mt < 2; ++mt)
#pragma unroll
                for (int s = 0; s < 4; ++s) { const int jl = jrow0 + 16 * mt; fa[mt][s] = *(const LAS bf16x8*)(lds + L_A2 + jl * 128 + (((2 * s + h) ^ (jl & 7)) << 4)); }
#pragma unroll
            for (int s = 0; s < 4; ++s)
#pragma unroll
                for (int mt = 0; mt < 2; ++mt) la[mt] = mfma32(fa[mt][s], __builtin_bit_cast(bf16x8, ba[s]), la[mt]);
        }
        asm volatile("" ::: "memory");
#pragma unroll
        for (int half = 0; half < 2; ++half) {
            bf16x8 fg[2][4];
#pragma unroll
            for (int mt = 0; mt < 2; ++mt)
#pragma unroll
                for (int s4 = 0; s4 < 4; ++s4) { const int s = 4 * half + s4, jl = jrow0 + 16 * mt; fg[mt][s4] = *(const LAS bf16x8*)(lds + L_G2 + jl * 256 + (((2 * s + h) ^ (jl & 7)) << 4)); }
#pragma unroll
            for (int s4 = 0; s4 < 4; ++s4)
#pragma unroll
                for (int mt = 0; mt < 2; ++mt) lg[mt] = mfma32(fg[mt][s4], __builtin_bit_cast(bf16x8, bg[4 * half + s4]), lg[mt]);
        }
        asm volatile("" ::: "memory");
#pragma unroll
        for (int q = 0; q < 4; ++q) { const bf16_t* a = urow + URK + cb + 8 * q; const bf16_t* bq = urow + UR + cb + 8 * q;
            ck[q] = *(const u32x4*)a; cr[q] = *(const u32x4*)bq; pk4[q] = (u32x4){0u, 0u, 0u, 0u}; pr4[q] = pk4[q];
            if (hp) { pk4[q] = *(const u32x4*)(a - NIN); pr4[q] = *(const u32x4*)(bq - NIN); } }
    }
#pragma unroll
    for (int mt = 0; mt < 2; ++mt) {
        u32x4 w0, w1; w0.x = cvt_pk_bf16(lg[mt][0], lg[mt][1]); w0.y = cvt_pk_bf16(lg[mt][2], lg[mt][3]); w0.z = cvt_pk_bf16(lg[mt][4], lg[mt][5]); w0.w = cvt_pk_bf16(lg[mt][6], lg[mt][7]);
        w1.x = cvt_pk_bf16(lg[mt][8], lg[mt][9]); w1.y = cvt_pk_bf16(lg[mt][10], lg[mt][11]); w1.z = cvt_pk_bf16(lg[mt][12], lg[mt][13]); w1.w = cvt_pk_bf16(lg[mt][14], lg[mt][15]);
        u32x4* d = (u32x4*)(slot + SL_GW + r32 * 128 + (32 * h + 16 * mt) * 2); d[0] = w0; d[1] = w1;
    }
    asm volatile("" ::: "memory");
    float ssq = 0.f;
#pragma unroll
    for (int q = 0; q < 4; ++q) {
        float t8[8]; lerp8(ck[q], pk4[q], cst + C_MUK + 32 * h + 8 * q, t8);
        const f32x4 c0 = *(const LAS f32x4*)(cst + C_KK + 32 * h + 8 * q), c1 = *(const LAS f32x4*)(cst + C_KK + 32 * h + 8 * q + 4);
#pragma unroll
        for (int j = 0; j < 4; ++j) { const float x0 = t8[j] * c0[j], x1 = t8[4 + j] * c1[j]; ssq += x0 * x0 + x1 * x1; }
    }
    ssq += swap32(ssq);
    const float kinv = frsq(fmaxf(ssq, 1e-24f));
    float bonus = 0.f;
    LAS unsigned char* mAT = pl + PM_AT; LAS unsigned char* mRT = pl + PM_RT; LAS unsigned char* mBT = pl + PM_BT; LAS unsigned char* mKT = pl + PM_KT;
    LAS float* gc = (LAS float*)(pl + PM_GC);
#pragma unroll
    for (int mt = 0; mt < 2; ++mt) {
#pragma unroll
        for (int q8 = 0; q8 < 2; ++q8) {
            const int jl0 = 32 * h + 16 * mt + 8 * q8, q = 2 * mt + q8;
            float k8[8], r8[8];
            lerp8(ck[q], pk4[q], cst + C_MUK + jl0, k8);
            lerp8(cr[q], pr4[q], cst + C_MUR + jl0, r8);
            float cw0[8], ca0[8], ckk[8], cka[8], crk[8];
#pragma unroll
            for (int e = 0; e < 2; ++e) { const f32x4 a = *(const LAS f32x4*)(cst + C_W0 + jl0 + 4 * e), bq = *(const LAS f32x4*)(cst + C_A0 + jl0 + 4 * e), cc = *(const LAS f32x4*)(cst + C_KK + jl0 + 4 * e), dd = *(const LAS f32x4*)(cst + C_KA + jl0 + 4 * e), ee = *(const LAS f32x4*)(cst + C_RK + jl0 + 4 * e);
#pragma unroll
                for (int j = 0; j < 4; ++j) { cw0[4 * e + j] = a[j]; ca0[4 * e + j] = bq[j]; ckk[4 * e + j] = cc[j]; cka[4 * e + j] = dd[j]; crk[4 * e + j] = ee[j]; } }
            float oa[8], orr[8], ob[8], ok[8];
#pragma unroll
            for (int e = 0; e < 8; ++e) {
                const int reg = 8 * q8 + e;
                const float xw = cw0[e] + lw[mt][reg];
                const float spn = fmaxf(-xw, 0.f) + LN2 * flog2(1.0f + fexp2(-fabsf(xw) * LOG2E));
                const float ld = -fexp2((-spn - 0.5f) * LOG2E);
                const float al = frcp(1.0f + fexp2(-(ca0[e] + la[mt][reg]) * LOG2E));
                const float kk = k8[e] * ckk[e] * kinv;
                const float kmod = k8[e] * (1.0f + (al - 1.0f) * cka[e]);
                const float bb = kk * al;
                bonus += r8[e] * kmod * crk[e];
                const float G = scan32(ld);
                const float eG = fexp2(G * LOG2E), eGm = fexp2((G - ld) * LOG2E), eiG = fexp2(-G * LOG2E);
                oa[e] = -kk * eGm; orr[e] = r8[e] * eG; ob[e] = bb * eiG; ok[e] = kmod * eiG;
                if (r32 == 31) gc[32 * h + 16 * mt + reg] = eG;
            }
            const int off = r32 * MSTR + (32 * h + 16 * mt + 8 * q8) * 2;
            *(LAS u32x4*)(mAT + off) = (u32x4){cvt_pk_bf16(oa[0], oa[1]), cvt_pk_bf16(oa[2], oa[3]), cvt_pk_bf16(oa[4], oa[5]), cvt_pk_bf16(oa[6], oa[7])};
            *(LAS u32x4*)(mRT + off) = (u32x4){cvt_pk_bf16(orr[0], orr[1]), cvt_pk_bf16(orr[2], orr[3]), cvt_pk_bf16(orr[4], orr[5]), cvt_pk_bf16(orr[6], orr[7])};
            *(LAS u32x4*)(mBT + off) = (u32x4){cvt_pk_bf16(ob[0], ob[1]), cvt_pk_bf16(ob[2], ob[3]), cvt_pk_bf16(ob[4], ob[5]), cvt_pk_bf16(ob[6], ob[7])};
            *(LAS u32x4*)(mKT + off) = (u32x4){cvt_pk_bf16(ok[0], ok[1]), cvt_pk_bf16(ok[2], ok[3]), cvt_pk_bf16(ok[4], ok[5]), cvt_pk_bf16(ok[6], ok[7])};
            asm volatile("" ::: "memory");
        }
    }
    bonus += swap32(bonus);
    u32x4 cv4[4], pv4[4];
#pragma unroll
    for (int q = 0; q < 4; ++q) { const bf16_t* cq = urow + URV + cb + 8 * q; cv4[q] = *(const u32x4*)cq; pv4[q] = (u32x4){0u, 0u, 0u, 0u}; if (hp) pv4[q] = *(const u32x4*)(cq - NIN); }
#pragma unroll
    for (int q = 0; q < 4; ++q) {
        float v8[8]; lerp8(cv4[q], pv4[q], cst + C_MUV + 32 * h + 8 * q, v8);
        *(u32x4*)(slot + SL_VR + r32 * 128 + (32 * h + 8 * q) * 2) = (u32x4){cvt_pk_bf16(v8[0], v8[1]), cvt_pk_bf16(v8[2], v8[3]), cvt_pk_bf16(v8[4], v8[5]), cvt_pk_bf16(v8[6], v8[7])};
        const f32x4 b0 = *(const LAS f32x4*)(cst + C_LNB + 32 * h + 8 * q), b1 = *(const LAS f32x4*)(cst + C_LNB + 32 * h + 8 * q + 4);
        float gb[8];
#pragma unroll
        for (int e = 0; e < 8; ++e) gb[e] = (e < 4 ? b0[e] : b1[e - 4]) + bonus * v8[e];
        *(u32x4*)(slot + SL_GB + r32 * 128 + (32 * h + 8 * q) * 2) = (u32x4){cvt_pk_bf16(gb[0], gb[1]), cvt_pk_bf16(gb[2], gb[3]), cvt_pk_bf16(gb[4], gb[5]), cvt_pk_bf16(gb[6], gb[7])};
    }
    LDS_WAIT();
    f32x16 nab = zero16(), nabT = zero16(), nakT = zero16(), mbr = zero16(), mkr = zero16();
#pragma unroll
    for (int s = 0; s < 4; ++s) {
        const int off = r32 * MSTR + (16 * s + 8 * h) * 2;
        const bf16x8 fa = *(const LAS bf16x8*)(mAT + off), fr = *(const LAS bf16x8*)(mRT + off), fb = *(const LAS bf16x8*)(mBT + off), fk = *(const LAS bf16x8*)(mKT + off);
        nab = mfma32(fb, fa, nab); nabT = mfma32(fa, fb, nabT); nakT = mfma32(fa, fk, nakT); mbr = mfma32(fb, fr, mbr); mkr = mfma32(fk, fr, mkr);
    }
#pragma unroll
    for (int reg = 0; reg < 16; ++reg) {
        const int row = (reg & 3) + 8 * (reg >> 2) + 4 * h;
        nab[reg] = row < r32 ? nab[reg] : 0.f;
        nabT[reg] = r32 < row ? nabT[reg] : 0.f;
        nakT[reg] = r32 < row ? nakT[reg] : 0.f;
        mbr[reg] = row <= r32 ? mbr[reg] : 0.f;
        mkr[reg] = row <= r32 ? mkr[reg] : 0.f;
    }
    f32x16 Y = nab;
#pragma unroll
    for (int reg = 0; reg < 16; ++reg) { const int row = (reg & 3) + 8 * (reg >> 2) + 4 * h; if (row == r32) Y[reg] += 1.0f; }
    {
        f32x16 M = nab, MT = nabT;
#pragma unroll
        for (int lvl = 0; lvl < 4; ++lvl) {
            const bf16x8 m0 = accfrag(M, 0), m1 = accfrag(M, 1), t0f = accfrag(MT, 0), t1f = accfrag(MT, 1);
            f32x16 M2T = mfma32(m0, t0f, zero16()); M2T = mfma32(m1, t1f, M2T);
            f32x16 M2 = zero16();
            if (lvl < 3) { M2 = mfma32(t0f, m0, M2); M2 = mfma32(t1f, m1, M2); }
            const bf16x8 y0 = accfrag(Y, 0), y1 = accfrag(Y, 1);
            Y = mfma32(accfrag(M2T, 0), y0, Y); Y = mfma32(accfrag(M2T, 1), y1, Y);
            M = M2; MT = M2T;
        }
    }
    int lane5 = lane; asm volatile("" : "+v"(lane5));
    const int r5 = lane5 & 31, h5 = lane5 >> 5;
    const bf16x8 ty0 = accfrag(Y, 0), ty1 = accfrag(Y, 1);
    f32x16 paT[2];
#pragma unroll
    for (int nt = 0; nt < 2; ++nt) { paT[nt] = mfma32(ty0, trfrag(mAT, 0, nt, lane5), zero16()); paT[nt] = mfma32(ty1, trfrag(mAT, 1, nt, lane5), paT[nt]); }
    f32x16 qakT = mfma32(ty0, accfrag(nakT, 0), zero16()); qakT = mfma32(ty1, accfrag(nakT, 1), qakT);
    const bf16x8 mb0 = accfrag(mbr, 0), mb1 = accfrag(mbr, 1);
#pragma unroll
    for (int mt = 0; mt < 2; ++mt) {
        f32x16 po;
#pragma unroll
        for (int g = 0; g < 4; ++g) { const u32x2 w = *(const LAS u32x2*)(mRT + r5 * MSTR + (32 * mt + 8 * g + 4 * h5) * 2);
            po[4 * g] = bf16_lo(w.x); po[4 * g + 1] = bf16_hi(w.x); po[4 * g + 2] = bf16_lo(w.y); po[4 * g + 3] = bf16_hi(w.y); }
        po = mfma32(accfrag(paT[mt], 0), mb0, po); po = mfma32(accfrag(paT[mt], 1), mb1, po);
#pragma unroll
        for (int sp = 0; sp < 2; ++sp)
            *(u32x4*)(slot + SL_PO + r5 * 128 + (32 * mt + 16 * sp + 8 * h5) * 2) = (u32x4){cvt_pk_bf16(po[8 * sp], po[8 * sp + 1]), cvt_pk_bf16(po[8 * sp + 2], po[8 * sp + 3]), cvt_pk_bf16(po[8 * sp + 4], po[8 * sp + 5]), cvt_pk_bf16(po[8 * sp + 6], po[8 * sp + 7])};
    }
    {
        f32x16 qo = mfma32(accfrag(qakT, 0), mb0, mkr); qo = mfma32(accfrag(qakT, 1), mb1, qo);
#pragma unroll
        for (int g = 0; g < 4; ++g) *(u32x2*)(slot + SL_QO + r5 * 64 + (8 * g + 4 * h5) * 2) = (u32x2){cvt_pk_bf16(qo[4 * g], qo[4 * g + 1]), cvt_pk_bf16(qo[4 * g + 2], qo[4 * g + 3])};
    }
#pragma unroll
    for (int nt = 0; nt < 2; ++nt) {
        const bf16x8 bt0 = trfrag(mBT, 0, nt, lane5), bt1 = trfrag(mBT, 1, nt, lane5);
        const float gam = gc[32 * nt + r5];
#pragma unroll
        for (int mt = 0; mt < 2; ++mt) {
            f32x16 ps = zero16();
            if (mt == nt) {
#pragma unroll
                for (int reg = 0; reg < 16; ++reg) { const int row = (reg & 3) + 8 * (reg >> 2) + 4 * h5; ps[reg] = (row == r5) ? 1.0f : 0.f; }
            }
            ps = mfma32(accfrag(paT[mt], 0), bt0, ps); ps = mfma32(accfrag(paT[mt], 1), bt1, ps);
#pragma unroll
            for (int sp = 0; sp < 2; ++sp)
                *(u32x4*)(slot + SL_PS + (32 * nt + r5) * 128 + (32 * mt + 16 * sp + 8 * h5) * 2) = (u32x4){cvt_pk_bf16(ps[8 * sp] * gam, ps[8 * sp + 1] * gam), cvt_pk_bf16(ps[8 * sp + 2] * gam, ps[8 * sp + 3] * gam), cvt_pk_bf16(ps[8 * sp + 4] * gam, ps[8 * sp + 5] * gam), cvt_pk_bf16(ps[8 * sp + 6] * gam, ps[8 * sp + 7] * gam)};
        }
        f32x16 qs;
        { const bf16x8 k0 = trfrag(mKT, 0, nt, lane5), k1 = trfrag(mKT, 1, nt, lane5);
          const u32x4 w0 = __builtin_bit_cast(u32x4, k0), w1 = __builtin_bit_cast(u32x4, k1);
#pragma unroll
          for (int j = 0; j < 4; ++j) { qs[2 * j] = bf16_lo(w0[j]); qs[2 * j + 1] = bf16_hi(w0[j]); qs[8 + 2 * j] = bf16_lo(w1[j]); qs[8 + 2 * j + 1] = bf16_hi(w1[j]); } }
        qs = mfma32(accfrag(qakT, 0), bt0, qs); qs = mfma32(accfrag(qakT, 1), bt1, qs);
#pragma unroll
        for (int g = 0; g < 4; ++g) *(u32x2*)(slot + SL_QS + (32 * nt + r5) * 64 + (8 * g + 4 * h5) * 2) = (u32x2){cvt_pk_bf16(qs[4 * g] * gam, qs[4 * g + 1] * gam), cvt_pk_bf16(qs[4 * g + 2] * gam, qs[4 * g + 3] * gam)};
    }
    LDS_WAIT();
}

__device__ __forceinline__ u32x4 ntload16(const void* ptr) { return __builtin_nontemporal_load((const u32x4*)ptr); }
struct RkOps { u32x4 vr[4]; bf16x8 fps[2][2][2], fqs[2][2], fpo[2][2], fqo[2]; };
__device__ __forceinline__ void rk_load_ops_a(RkOps& o, const unsigned char* slot, int lane) {
    using namespace rk;
    const int r32 = lane & 31, h = lane >> 5;
#pragma unroll
    for (int k = 0; k < 4; ++k) o.vr[k] = ntload16(slot + SL_VR + lane * 64 + 16 * k);
#pragma unroll
    for (int jt = 0; jt < 2; ++jt)
#pragma unroll
        for (int s = 0; s < 2; ++s) o.fpo[jt][s] = __builtin_bit_cast(bf16x8, ntload16(slot + SL_PO + r32 * 128 + (32 * jt + 16 * s + 8 * h) * 2));
#pragma unroll
    for (int s = 0; s < 2; ++s) o.fqo[s] = __builtin_bit_cast(bf16x8, ntload16(slot + SL_QO + r32 * 64 + (16 * s + 8 * h) * 2));
}
__device__ __forceinline__ void rk_load_ops_b(RkOps& o, const unsigned char* slot, int lane) {
    using namespace rk;
    const int r32 = lane & 31, h = lane >> 5;
#pragma unroll
    for (int mt = 0; mt < 2; ++mt) {
#pragma unroll
        for (int jt = 0; jt < 2; ++jt)
#pragma unroll
            for (int s = 0; s < 2; ++s) o.fps[mt][jt][s] = __builtin_bit_cast(bf16x8, ntload16(slot + SL_PS + (32 * mt + r32) * 128 + (32 * jt + 16 * s + 8 * h) * 2));
#pragma unroll
        for (int s = 0; s < 2; ++s) o.fqs[mt][s] = __builtin_bit_cast(bf16x8, ntload16(slot + SL_QS + (32 * mt + r32) * 64 + (16 * s + 8 * h) * 2));
    }
}
#define RK_SPIN(cond) do { unsigned _sp = 0; while (cond) { __builtin_amdgcn_s_sleep(1); if (++_sp > (1u << 24)) { err[0] = 1u; break; } } asm volatile("" ::: "memory"); } while (0)

__device__ __forceinline__ void rwkv_chain(const Params& p, LAS unsigned char* lds, int b, int hh) {
    using namespace rk;
    int tid = threadIdx.x; asm volatile("" : "+v"(tid));
    volatile LAS unsigned* ready = (volatile LAS unsigned*)(lds + L_FLAG); volatile LAS unsigned* freed = ready + NSLOT; volatile LAS unsigned* ofull = freed + NSLOT; volatile LAS unsigned* ofree = ofull + 2; volatile LAS unsigned* err = ofree + 2;
    if (tid < 2 * NSLOT + 5) ready[tid] = 0u;
    {
        const bf16_t* w2t = (const bf16_t*)(p.ws + WS_LT); const bf16_t* a2t = w2t + 512 * 64; const bf16_t* g2t = a2t + 512 * 64;
        for (int i = tid; i < 64 * 8; i += NTHREADS) { const int j = i >> 3, ch = i & 7, d = j * 128 + ((ch ^ (j & 7)) << 4);
            *(LAS u32x4*)(lds + L_W2 + d) = *(const u32x4*)(w2t + (hh * HD + j) * 64 + 8 * ch); *(LAS u32x4*)(lds + L_A2 + d) = *(const u32x4*)(a2t + (hh * HD + j) * 64 + 8 * ch); }
        for (int i = tid; i < 64 * 16; i += NTHREADS) { const int j = i >> 4, ch = i & 15; *(LAS u32x4*)(lds + L_G2 + j * 256 + ((ch ^ (j & 7)) << 4)) = *(const u32x4*)(g2t + (hh * HD + j) * 128 + 8 * ch); }
        LAS float* cst = (LAS float*)(lds + L_CST);
        for (int i = tid; i < C_END; i += NTHREADS) { float v;
            if (i < 256) v = p.shift_mu[(UXW - UR) + i];
            else if (i < 320) v = p.shift_mu[hh * HD + (i - 256)];
            else if (i < 384) v = p.shift_mu[(URK - UR) + hh * HD + (i - 320)];
            else if (i < 448) v = p.shift_mu[(URV - UR) + hh * HD + (i - 384)];
            else if (i < 512) v = p.rw_w0[hh * HD + (i - 448)];
            else if (i < 576) v = p.rw_a0[hh * HD + (i - 512)];
            else if (i < 640) v = p.rw_k_k[hh * HD + (i - 576)];
            else if (i < 704) v = p.rw_k_a[hh * HD + (i - 640)];
            else if (i < 768) v = p.rw_r_k[hh * HD + (i - 704)];
            else v = p.rw_ln_b[hh * HD + (i - 768)];
            cst[i] = v; }
    }
    __syncthreads();
    asm volatile("" : "+v"(tid));
    const int wave = __builtin_amdgcn_readfirstlane(tid >> 6);
    unsigned char* ring = (unsigned char*)p.out + (size_t)(b * NH + hh) * NSLOT * SLOT_BYTES;
    if (wave == 0) {
        int lane = tid & 63; asm volatile("" : "+v"(lane));
        const int r32 = lane & 31, h = lane >> 5;
        LAS unsigned char* vs = lds + L_CONS;
        f32x16 st[2][2];
#pragma unroll
        for (int a = 0; a < 2; ++a)
#pragma unroll
            for (int d = 0; d < 2; ++d) st[a][d] = zero16();
        RkOps ops;
        RK_SPIN(ready[0] != 1u);
        rk_load_ops_a(ops, ring, lane); rk_load_ops_b(ops, ring, lane);
        for (int c = 0; c < NCH; ++c) {
            bf16x8 sf[2][2][2];
#pragma unroll
            for (int jt = 0; jt < 2; ++jt)
#pragma unroll
                for (int it = 0; it < 2; ++it) { sf[jt][it][0] = accfrag(st[jt][it], 0); sf[jt][it][1] = accfrag(st[jt][it], 1); }
            { LAS unsigned char* d = vs + (lane >> 1) * MSTR + (lane & 1) * 64;
              *(LAS u32x4*)d = ops.vr[0]; *(LAS u32x4*)(d + 16) = ops.vr[1]; *(LAS u32x4*)(d + 32) = ops.vr[2]; *(LAS u32x4*)(d + 48) = ops.vr[3]; }
            LDS_WAIT();
            bf16x8 vf[2][2];
            { const int g = lane >> 4, i16 = lane & 15, q = i16 >> 2, pp = i16 & 3;
#pragma unroll
              for (int it = 0; it < 2; ++it)
#pragma unroll
                  for (int s = 0; s < 2; ++s) { const LAS unsigned char* a = vs + (16 * s + 8 * h + q) * MSTR + (32 * it + 16 * (g & 1) + 4 * pp) * 2;
                      const s16x4 x = lds_tr16(a), y = lds_tr16(a + 4 * MSTR);
                      bf16x8 r; r[0] = x[0]; r[1] = x[1]; r[2] = x[2]; r[3] = x[3]; r[4] = y[0]; r[5] = y[1]; r[6] = y[2]; r[7] = y[3]; vf[it][s] = r; } }
            f32x16 o[2];
#pragma unroll
            for (int it = 0; it < 2; ++it) {
                o[it] = zero16();
#pragma unroll
                for (int jt = 0; jt < 2; ++jt)
#pragma unroll
                    for (int s = 0; s < 2; ++s) o[it] = mfma32(sf[jt][it][s], ops.fpo[jt][s], o[it]);
#pragma unroll
                for (int s = 0; s < 2; ++s) o[it] = mfma32(vf[it][s], ops.fqo[s], o[it]);
            }
            const unsigned char* nslot = ring + (size_t)((c + 1) % NSLOT) * SLOT_BYTES;
            if (c + 1 < NCH) { RK_SPIN(ready[(c + 1) % NSLOT] != (unsigned)(c + 2)); rk_load_ops_a(ops, nslot, lane); }
#pragma unroll
            for (int mt = 0; mt < 2; ++mt)
#pragma unroll
                for (int it = 0; it < 2; ++it) {
                    f32x16 a = zero16();
#pragma unroll
                    for (int jt = 0; jt < 2; ++jt)
#pragma unroll
                        for (int s = 0; s < 2; ++s) a = mfma32(ops.fps[mt][jt][s], sf[jt][it][s], a);
#pragma unroll
                    for (int s = 0; s < 2; ++s) a = mfma32(ops.fqs[mt][s], vf[it][s], a);
                    st[mt][it] = a;
                }
            if (c + 1 < NCH) rk_load_ops_b(ops, nslot, lane);
            if (c >= 1) RK_SPIN(ofree[0] != (unsigned)c);
            { LAS unsigned char* ob = lds + L_OBUF + r32 * OSTR;
#pragma unroll
              for (int it = 0; it < 2; ++it)
#pragma unroll
                  for (int g = 0; g < 4; ++g) *(LAS f32x4*)(ob + (32 * it + 8 * g + 4 * h) * 4) = (f32x4){o[it][4 * g], o[it][4 * g + 1], o[it][4 * g + 2], o[it][4 * g + 3]}; }
            LDS_WAIT();
            if (lane == 0) ofull[0] = (unsigned)(c + 1);
        }
    } else if (wave == 1) {
        int lane = tid & 63; asm volatile("" : "+v"(lane));
        const int r32 = lane & 31, h = lane >> 5;
        u32x4 gw[4], gb[4];
        RK_SPIN(ready[0] != 1u);
#pragma unroll
        for (int k = 0; k < 4; ++k) { gw[k] = ntload16(ring + SL_GW + r32 * 128 + (32 * h + 8 * k) * 2); gb[k] = ntload16(ring + SL_GB + r32 * 128 + (32 * h + 8 * k) * 2); }
        for (int c = 0; c < NCH; ++c) {
            const int sl = c % NSLOT;
            RK_SPIN(ofull[0] != (unsigned)(c + 1));
            float ov[32];
            { const LAS unsigned char* ob = lds + L_OBUF + r32 * OSTR + 128 * h;
#pragma unroll
              for (int k = 0; k < 8; ++k) { const f32x4 x = *(const LAS f32x4*)(ob + 16 * k); ov[4 * k] = x[0]; ov[4 * k + 1] = x[1]; ov[4 * k + 2] = x[2]; ov[4 * k + 3] = x[3]; } }
            LDS_WAIT();
            if (lane == 0) ofree[0] = (unsigned)(c + 1);
            float sm = 0.f;
#pragma unroll
            for (int k = 0; k < 32; ++k) sm += ov[k];
            sm += swap32(sm);
            const float mean = sm * (1.0f / 64.0f);
            float sv = 0.f;
#pragma unroll
            for (int k = 0; k < 32; ++k) { const float d = ov[k] - mean; sv += d * d; }
            sv += swap32(sv);
            const float rstd = 1.0f / sqrtf(sv * (1.0f / 64.0f) + 64e-5f);
            bf16_t* mrow = (bf16_t*)(p.ws + WS_B) + ((size_t)b * S + c * C + r32) * D + 512 + hh * HD + 32 * h;
#pragma unroll
            for (int k = 0; k < 4; ++k) {
                float w8[8], b8[8], r[8]; f8_from_bf16(gw[k], w8); f8_from_bf16(gb[k], b8);
                const f32x4 l0 = *(const f32x4*)(p.rw_ln_w + hh * HD + 32 * h + 8 * k), l1 = *(const f32x4*)(p.rw_ln_w + hh * HD + 32 * h + 8 * k + 4);
#pragma unroll
                for (int e = 0; e < 8; ++e) r[e] = ((ov[8 * k + e] - mean) * rstd * (e < 4 ? l0[e] : l1[e - 4]) + b8[e]) * w8[e];
                *(u32x4*)(mrow + 8 * k) = (u32x4){cvt_pk_bf16(r[0], r[1]), cvt_pk_bf16(r[2], r[3]), cvt_pk_bf16(r[4], r[5]), cvt_pk_bf16(r[6], r[7])};
            }
            if (lane == 0) freed[sl] = (unsigned)(c + 1);
            if (c + 1 < NCH) { const int sn = (c + 1) % NSLOT; const unsigned char* sp_ = ring + (size_t)sn * SLOT_BYTES; RK_SPIN(ready[sn] != (unsigned)(c + 2));
#pragma unroll
                for (int k = 0; k < 4; ++k) { gw[k] = ntload16(sp_ + SL_GW + r32 * 128 + (32 * h + 8 * k) * 2); gb[k] = ntload16(sp_ + SL_GB + r32 * 128 + (32 * h + 8 * k) * 2); } }
        }
    } else {
        int lane = tid & 63;
        if (wave - 2 < NPROD) for (int c = wave - 2; c < NCH; c += NPROD) {
            const int sl = c % NSLOT;
            if (c >= NSLOT) RK_SPIN(freed[sl] != (unsigned)(c - NSLOT + 1));
            rk_produce(p, lds, lds + (wave - 2) * PROD_LDS, ring + (size_t)sl * SLOT_BYTES, b, hh, c);
            asm volatile("s_waitcnt vmcnt(0)" ::: "memory");
            if (lane == 0) ready[sl] = (unsigned)(c + 1);
        }
    }
    __syncthreads();
}

#ifdef RWDEBUG
namespace rw {
constexpr int CH = 16;
constexpr int O_UM = 0;
constexpr int O_LW = O_UM + CH * 448 * 4;
constexpr int O_LA = O_LW + CH * 64 * 4;
constexpr int O_LG0 = O_LA + CH * 64 * 4;
constexpr int O_LG1 = O_LG0 + CH * 64 * 4;
constexpr int O_A1 = O_LG1 + CH * 64 * 4;
constexpr int O_R1 = O_A1 + CH * 64 * 4;
constexpr int O_B1 = O_R1 + CH * 64 * 4;
constexpr int O_K1 = O_B1 + CH * 64 * 4;
constexpr int O_O = O_K1 + CH * 64 * 4;
constexpr int O_WT = O_O + CH * 64 * 4;
constexpr int O_GC = O_WT + 8 * 64 * 4;
constexpr int O_SC = O_GC + 64 * 4;
constexpr int O_END = O_SC + 3 * 16 * 4;
}
__device__ __forceinline__ bf16x8 ldw_frag(const float* W, int ldw, int m0, int col) {
    unsigned w[4];
#pragma unroll
    for (int j = 0; j < 4; ++j) w[j] = cvt_pk_bf16(W[(size_t)(m0 + 2 * j) * ldw + col], W[(size_t)(m0 + 2 * j + 1) * ldw + col]);
    return __builtin_bit_cast(bf16x8, (u32x4){w[0], w[1], w[2], w[3]});
}
template <int ACT>
__device__ __forceinline__ bf16x8 act_frag(const LAS float* src) {
    const f32x4 a = *(const LAS f32x4*)src, b = *(const LAS f32x4*)(src + 4); float v[8] = {a[0], a[1], a[2], a[3], b[0], b[1], b[2], b[3]};
#pragma unroll
    for (int j = 0; j < 8; ++j) {
        if (ACT == 1) v[j] = 1.0f - 2.0f * frcp(1.0f + fexp2(v[j] * (2.0f * LOG2E)));
        if (ACT == 2) v[j] = frcp(1.0f + fexp2(-v[j] * LOG2E));
    }
    return __builtin_bit_cast(bf16x8, (u32x4){cvt_pk_bf16(v[0], v[1]), cvt_pk_bf16(v[2], v[3]), cvt_pk_bf16(v[4], v[5]), cvt_pk_bf16(v[6], v[7])});
}

__device__ __forceinline__ void rwkv_chain_seq(const Params& p, LAS unsigned char* lds, int b, int h, bf16_t* mix, int nchunks) {
    using namespace rw;
    const int tid = threadIdx.x, wave = __builtin_amdgcn_readfirstlane(tid >> 6), lane = tid & 63;
    const bf16_t* u = (const bf16_t*)(p.ws + WS_A);
    const size_t row0 = (size_t)b * S;
    LAS float* UM = (LAS float*)(lds + O_UM); LAS float* LW = (LAS float*)(lds + O_LW); LAS float* LA = (LAS float*)(lds + O_LA);
    LAS float* LG0 = (LAS float*)(lds + O_LG0); LAS float* LG1 = (LAS float*)(lds + O_LG1);
    LAS float* A1 = (LAS float*)(lds + O_A1); LAS float* R1 = (LAS float*)(lds + O_R1); LAS float* B1 = (LAS float*)(lds + O_B1); LAS float* K1 = (LAS float*)(lds + O_K1);
    LAS float* OO = (LAS float*)(lds + O_O); LAS float* WT = (LAS float*)(lds + O_WT); LAS float* GC = (LAS float*)(lds + O_GC); LAS float* SC = (LAS float*)(lds + O_SC);
    const int fc = lane & 15, fq = lane >> 4;
    bf16x8 bwa[2], bg[2];
    { const float* W = wave < 4 ? p.rw_w2 : p.rw_a2; const int col = h * HD + 16 * (wave & 3) + fc;
      bwa[0] = ldw_frag(W, 512, 8 * fq, col); bwa[1] = ldw_frag(W, 512, 32 + 8 * fq, col);
      const int ks = (wave >> 2) * 2; bg[0] = ldw_frag(p.rw_g2, 512, 32 * ks + 8 * fq, col); bg[1] = ldw_frag(p.rw_g2, 512, 32 * (ks + 1) + 8 * fq, col); }
    const int hj = h * HD + lane;
    const float c_w0 = p.rw_w0[hj], c_a0 = p.rw_a0[hj], c_kk = p.rw_k_k[hj], c_ka = p.rw_k_a[hj], c_rk = p.rw_r_k[hj], c_lnw = p.rw_ln_w[hj], c_lnb = p.rw_ln_b[hj];
    int ld_t[2], ld_c[2], ld_uc[2]; bool ld_ok[2];
#pragma unroll
    for (int r = 0; r < 2; ++r) { const int gid = tid + 512 * r; ld_ok[r] = gid < CH * 56; const int t = gid / 56, cg8 = gid % 56; ld_t[r] = t; ld_c[r] = cg8 * 8;
        ld_uc[r] = cg8 < 8 ? UR + h * HD + 8 * cg8 : cg8 < 16 ? URK + h * HD + 8 * (cg8 - 8) : cg8 < 24 ? URV + h * HD + 8 * (cg8 - 16) : UXW + 8 * (cg8 - 24); }
    const int si = 8 * wave + (lane >> 3), sj = 8 * (lane & 7);
    float st[8];
#pragma unroll
    for (int n = 0; n < 8; ++n) st[n] = 0.f;
    u32x4 cur[2], prv[2];
    auto issue_loads = [&](int t0) {
#pragma unroll
        for (int r = 0; r < 2; ++r) { cur[r] = (u32x4){0u, 0u, 0u, 0u}; prv[r] = (u32x4){0u, 0u, 0u, 0u};
            if (ld_ok[r]) { const int tt = t0 + ld_t[r]; const bf16_t* a = u + (row0 + tt) * NIN + ld_uc[r]; cur[r] = *(const u32x4*)a; if (tt > 0) prv[r] = *(const u32x4*)(a - NIN); } }
    };
    issue_loads(0);
    for (int c = 0; c < nchunks; ++c) {
        const int t0 = c * CH;
#pragma unroll
        for (int r = 0; r < 2; ++r) if (ld_ok[r]) {
            const float* mu = p.shift_mu + (ld_uc[r] - UR); const f32x4 m0 = *(const f32x4*)mu, m1 = *(const f32x4*)(mu + 4);
            float cv[8], pv[8];
#pragma unroll
            for (int j = 0; j < 4; ++j) { cv[2 * j] = bf16_lo(cur[r][j]); cv[2 * j + 1] = bf16_hi(cur[r][j]); pv[2 * j] = bf16_lo(prv[r][j]); pv[2 * j + 1] = bf16_hi(prv[r][j]); }
            f32x4 o0, o1;
#pragma unroll
            for (int j = 0; j < 4; ++j) { o0[j] = cv[j] + (pv[j] - cv[j]) * m0[j]; o1[j] = cv[4 + j] + (pv[4 + j] - cv[4 + j]) * m1[j]; }
            LAS float* d = UM + ld_t[r] * 448 + ld_c[r]; *(LAS f32x4*)d = o0; *(LAS f32x4*)(d + 4) = o1;
        }
        if (c + 1 < S / CH) issue_loads(t0 + CH);
        __syncthreads();
        {
            f32x4 acc = (f32x4){0.f, 0.f, 0.f, 0.f};
            const LAS float* src = UM + fc * 448 + (wave < 4 ? 192 : 256) + 8 * fq;
            if (wave < 4) { acc = __builtin_amdgcn_mfma_f32_16x16x32_bf16(act_frag<1>(src), bwa[0], acc, 0, 0, 0); acc = __builtin_amdgcn_mfma_f32_16x16x32_bf16(act_frag<1>(src + 32), bwa[1], acc, 0, 0, 0); }
            else          { acc = __builtin_amdgcn_mfma_f32_16x16x32_bf16(act_frag<0>(src), bwa[0], acc, 0, 0, 0); acc = __builtin_amdgcn_mfma_f32_16x16x32_bf16(act_frag<0>(src + 32), bwa[1], acc, 0, 0, 0); }
            LAS float* dst = (wave < 4 ? LW : LA) + 16 * (wave & 3) + fc;
#pragma unroll
            for (int r = 0; r < 4; ++r) dst[(4 * fq + r) * 64] = acc[r];
            f32x4 ag = (f32x4){0.f, 0.f, 0.f, 0.f};
            const LAS float* sg = UM + fc * 448 + 320 + 64 * (wave >> 2) + 8 * fq;
            ag = __builtin_amdgcn_mfma_f32_16x16x32_bf16(act_frag<2>(sg), bg[0], ag, 0, 0, 0); ag = __builtin_amdgcn_mfma_f32_16x16x32_bf16(act_frag<2>(sg + 32), bg[1], ag, 0, 0, 0);
            LAS float* dg = (wave < 4 ? LG0 : LG1) + 16 * (wave & 3) + fc;
#pragma unroll
            for (int r = 0; r < 4; ++r) dg[(4 * fq + r) * 64] = ag[r];
        }
        __syncthreads();
        float e_kk[2], e_b[2], e_k[2], e_r[2], e_ld[2];
#pragma unroll
        for (int tt = 0; tt < 2; ++tt) {
            const int t = 2 * wave + tt;
            const float xw = c_w0 + LW[t * 64 + lane];
            const float spn = (fmaxf(-xw, 0.f) + LN2 * flog2(1.0f + fexp2(-fabsf(xw) * LOG2E)));
            e_ld[tt] = -fexp2((-spn - 0.5f) * LOG2E);
            const float a = frcp(1.0f + fexp2(-(c_a0 + LA[t * 64 + lane]) * LOG2E));
            const float kraw = UM[t * 448 + 64 + lane], r = UM[t * 448 + lane];
            const float kkv = kraw * c_kk; const float ssq = wave_sum(kkv * kkv);
            const float kk = kkv * frsq(fmaxf(ssq, 1e-24f));
            const float kmod = kraw * (1.0f + (a - 1.0f) * c_ka);
            const float bb = kk * a;
            const float cbr = wave_sum(bb * r), ckr = wave_sum(kmod * r), bon = wave_sum(r * kmod * c_rk);
            if (lane == 0) { SC[t] = cbr; SC[16 + t] = ckr; SC[32 + t] = bon; }
            e_kk[tt] = kk; e_b[tt] = bb; e_k[tt] = kmod; e_r[tt] = r;
        }
        WT[wave * 64 + lane] = e_ld[0] + e_ld[1];
        __syncthreads();
        {
            float off = 0.f, tot = 0.f;
#pragma unroll
            for (int w = 0; w < 8; ++w) { const float x = WT[w * 64 + lane]; if (w < wave) off += x; tot += x; }
            const float c0 = off + e_ld[0], c1 = c0 + e_ld[1];
            const int t = 2 * wave;
            A1[t * 64 + lane] = -e_kk[0] * fexp2(off * LOG2E);       A1[(t + 1) * 64 + lane] = -e_kk[1] * fexp2(c0 * LOG2E);
            R1[t * 64 + lane] = e_r[0] * fexp2(c0 * LOG2E);          R1[(t + 1) * 64 + lane] = e_r[1] * fexp2(c1 * LOG2E);
            const float i0 = fexp2(-c0 * LOG2E), i1 = fexp2(-c1 * LOG2E);
            B1[t * 64 + lane] = e_b[0] * i0;                          B1[(t + 1) * 64 + lane] = e_b[1] * i1;
            K1[t * 64 + lane] = e_k[0] * i0;                          K1[(t + 1) * 64 + lane] = e_k[1] * i1;
            if (wave == 0) GC[lane] = fexp2(tot * LOG2E);
        }
        __syncthreads();
#pragma unroll 4
        for (int t = 0; t < CH; ++t) {
            const f32x4 a0 = *(const LAS f32x4*)(A1 + t * 64 + sj), a1 = *(const LAS f32x4*)(A1 + t * 64 + sj + 4);
            const f32x4 r0 = *(const LAS f32x4*)(R1 + t * 64 + sj), r1 = *(const LAS f32x4*)(R1 + t * 64 + sj + 4);
            const f32x4 b0 = *(const LAS f32x4*)(B1 + t * 64 + sj), b1 = *(const LAS f32x4*)(B1 + t * 64 + sj + 4);
            const f32x4 k0 = *(const LAS f32x4*)(K1 + t * 64 + sj), k1 = *(const LAS f32x4*)(K1 + t * 64 + sj + 4);
            const float v = UM[t * 448 + 128 + si], cbr = SC[t], ckr = SC[16 + t];
            float sa = (st[0] * a0[0] + st[1] * a0[1]) + (st[2] * a0[2] + st[3] * a0[3]) + ((st[4] * a1[0] + st[5] * a1[1]) + (st[6] * a1[2] + st[7] * a1[3]));
            float pp = (st[0] * r0[0] + st[1] * r0[1]) + (st[2] * r0[2] + st[3] * r0[3]) + ((st[4] * r1[0] + st[5] * r1[1]) + (st[6] * r1[2] + st[7] * r1[3]));
            sa = sum8(sa); pp = sum8(pp);
            if ((lane & 7) == 0) OO[t * 64 + si] = pp + sa * cbr + v * ckr;
#pragma unroll
            for (int n = 0; n < 4; ++n) { st[n] += sa * b0[n] + v * k0[n]; st[4 + n] += sa * b1[n] + v * k1[n]; }
        }
        {
            const f32x4 g0 = *(const LAS f32x4*)(GC + sj), g1 = *(const LAS f32x4*)(GC + sj + 4);
#pragma unroll
            for (int n = 0; n < 4; ++n) { st[n] *= g0[n]; st[4 + n] *= g1[n]; }
        }
        __syncthreads();
#pragma unroll
        for (int tt = 0; tt < 2; ++tt) {
            const int t = 2 * wave + tt;
            const float o = OO[t * 64 + lane];
            const float mean = wave_sum(o) * (1.0f / 64.0f); const float dlt = o - mean;
            const float var = wave_sum(dlt * dlt) * (1.0f / 64.0f);
            const float gn = dlt * (1.0f / sqrtf(var + 64e-5f)) * c_lnw + c_lnb;
            const float res = (gn + SC[32 + t] * UM[t * 448 + 128 + lane]) * (LG0[t * 64 + lane] + LG1[t * 64 + lane]);
            mix[(row0 + t0 + t) * D + 512 + h * HD + lane] = (bf16_t)(cvt_pk_bf16(res, 0.f) & 0xffffu);
        }
        __syncthreads();
    }
}

#endif

__device__ __forceinline__ void phase2a(const Params& p) {
    int tid = threadIdx.x; asm volatile("" : "+v"(tid));
    const int wave = tid >> 6, lane = tid & 63;
    const bf16_t* u = (const bf16_t*)(p.ws + WS_A);
    bf16_t* act = (bf16_t*)((unsigned char*)p.out + ACT_OFF);
    const f32x4 mu = *(const f32x4*)(p.shift_mu + (UXW - UR) + 4 * lane);
    for (int row = blockIdx.x * NWAVES + wave; row < T; row += gridDim.x * NWAVES) {
        const bf16_t* a = u + (size_t)row * NIN + UXW + 4 * lane;
        const u32x2 c = *(const u32x2*)a; u32x2 pv = (u32x2){0u, 0u}; if ((row & (S - 1)) != 0) pv = *(const u32x2*)(a - NIN);
        const float cv[4] = {bf16_lo(c.x), bf16_hi(c.x), bf16_lo(c.y), bf16_hi(c.y)}, pf[4] = {bf16_lo(pv.x), bf16_hi(pv.x), bf16_lo(pv.y), bf16_hi(pv.y)};
        float x[4];
#pragma unroll
        for (int j = 0; j < 4; ++j) { x[j] = cv[j] + (pf[j] - cv[j]) * mu[j];
            if (lane < 16) x[j] = 1.0f - 2.0f * frcp(1.0f + fexp2(x[j] * (2.0f * LOG2E)));
            else if (lane >= 32) x[j] = frcp(1.0f + fexp2(-x[j] * LOG2E)); }
        *(u32x2*)(act + (size_t)row * 256 + 4 * lane) = (u32x2){cvt_pk_bf16(x[0], x[1]), cvt_pk_bf16(x[2], x[3])};
    }
}

__device__ __forceinline__ void phase2(const Params& p, LAS unsigned char* lds) {
    const int nchain = NB * NH, G = gridDim.x, wave = threadIdx.x >> 6;
    const int nscan = G >= 2 * nchain ? nchain : (G > 1 ? G / 2 : 0);
    if ((int)blockIdx.x < nscan || nscan == 0) {
        const int stride = nscan == 0 ? G : nscan;
        for (int it = blockIdx.x; it < nchain; it += stride) rwkv_chain(p, lds, it / NH, it % NH);
    }
    if ((int)blockIdx.x >= nscan) {
        const int nb = G - nscan, bi = blockIdx.x - nscan;
        for (int it = bi * 8 + wave; it < NB * NH * 64; it += nb * 8) attn_tile(p, lds + wave * 4608, it / (NH * 64), (it / 64) % NH, 63 - (it % 64));
        __syncthreads();
        p0_expert_weights(p, lds, bi * 8 + wave, nb * 8);
    }
}

struct EpiH {
    const float* x; float* hout; int row0, col0;
    __device__ __forceinline__ void operator()(const f32x4 (&acc)[2][2][4][2], int wr, int wc, int fr, int fq) const {
#pragma unroll
        for (int ai = 0; ai < 2; ++ai)
#pragma unroll
            for (int m = 0; m < 4; ++m) { const size_t off = (size_t)(row0 + ai * 128 + wr * 64 + m * 16 + fr) * D + col0 + wc * 32 + 8 * fq;
#pragma unroll
                for (int bj = 0; bj < 2; ++bj)
#pragma unroll
                    for (int n = 0; n < 2; ++n) { const f32x4 xv = *(const f32x4*)(x + off + bj * 128 + n * 4); *(f32x4*)(hout + off + bj * 128 + n * 4) = xv + acc[ai][bj][m][n]; } }
    }
};
__device__ __forceinline__ void phase3(const Params& p, LAS unsigned char* lds) {
    constexpr int nM = T / 256, nN = D / 256;
    unsigned aoff[2][2]; g8::aoff_rows(aoff, D);
    for (int L = blockIdx.x; L < nM * nN; L += gridDim.x) {
        int pm, pn; g8::tile_order(L, nM, nN, pm, pn);
        EpiH E{p.x, p.out, pm * 256, pn * 256};
        g8::gemm_unit(lds, (const char*)(p.ws + WS_B) + (size_t)pm * 256 * D * 2, aoff, (const char*)(p.ws + WS_WOUT) + (size_t)pn * 256 * D * 2, D, E);
    }
}

__device__ __forceinline__ void phase4(const Params& p, LAS unsigned char* lds) {
    int tid = threadIdx.x; asm volatile("" : "+v"(tid));
    const int wave = tid >> 6, lane = tid & 63, fr = lane & 15, fq = lane >> 4;
    const float* hsrc = p.out; bf16_t* hb = (bf16_t*)(p.ws + WS_A); float* rstd2 = (float*)(p.ws + WS_RSTD2);
    const bf16_t* wr_hi = (const bf16_t*)(p.ws + WS_WR); const bf16_t* wr_lo = wr_hi + 48 * D;
    int* list = (int*)(p.ws + WS_LIST); float* listw = (float*)(p.ws + WS_LISTW); unsigned* cnt = (unsigned*)(p.ws + WS_CTL);
    LAS float* lg = (LAS float*)(lds + wave * 3072);
    LAS unsigned* lcnt = (LAS unsigned*)(lds + 8 * 3072);
    LAS unsigned* gbase = lcnt + 32;
    for (int blk = blockIdx.x; blk < T / 128; blk += gridDim.x) {
        if (tid < 32) lcnt[tid] = 0u;
        __syncthreads();
        const int tok0 = blk * 128 + wave * 16;
        f32x4 acc[3];
#pragma unroll
        for (int n = 0; n < 3; ++n) acc[n] = (f32x4){0.f, 0.f, 0.f, 0.f};
        float ss = 0.f;
        const float* hp = hsrc + (size_t)(tok0 + fr) * D + 8 * fq; bf16_t* hbp = hb + (size_t)(tok0 + fr) * D + 8 * fq;
        LAS unsigned char* wl_ = lds + 32768;
#pragma unroll 1
        for (int half = 0; half < 2; ++half) {
            __syncthreads();
            for (int i = tid; i < 2 * 48 * 64; i += NTHREADS) { const int mat = i / 3072, r = (i % 3072) >> 6, ch = i & 63;
                *(LAS u32x4*)(wl_ + mat * 49152 + r * 1024 + ((ch ^ (r & 15)) << 4)) = *(const u32x4*)((mat ? wr_lo : wr_hi) + (size_t)r * D + half * 512 + ch * 8); }
            f32x4 av[16][2];
#pragma unroll
            for (int ks = 0; ks < 16; ++ks) { av[ks][0] = *(const f32x4*)(hp + half * 512 + 32 * ks); av[ks][1] = *(const f32x4*)(hp + half * 512 + 32 * ks + 4); }
            __syncthreads();
#pragma unroll
            for (int ks = 0; ks < 16; ++ks) {
                const f32x4 v0 = av[ks][0], v1 = av[ks][1];
                ss += (v0[0] * v0[0] + v0[1] * v0[1]) + (v0[2] * v0[2] + v0[3] * v0[3]) + ((v1[0] * v1[0] + v1[1] * v1[1]) + (v1[2] * v1[2] + v1[3] * v1[3]));
                u32x4 hi; hi.x = cvt_pk_bf16(v0[0], v0[1]); hi.y = cvt_pk_bf16(v0[2], v0[3]); hi.z = cvt_pk_bf16(v1[0], v1[1]); hi.w = cvt_pk_bf16(v1[2], v1[3]);
                *(u32x4*)(hbp + half * 512 + 32 * ks) = hi;
                u32x4 lo; lo.x = cvt_pk_bf16(v0[0] - bf16_lo(hi.x), v0[1] - bf16_hi(hi.x)); lo.y = cvt_pk_bf16(v0[2] - bf16_lo(hi.y), v0[3] - bf16_hi(hi.y));
                lo.z = cvt_pk_bf16(v1[0] - bf16_lo(hi.z), v1[1] - bf16_hi(hi.z)); lo.w = cvt_pk_bf16(v1[2] - bf16_lo(hi.w), v1[3] - bf16_hi(hi.w));
                const bf16x8 ah = __builtin_bit_cast(bf16x8, hi), al = __builtin_bit_cast(bf16x8, lo);
#pragma unroll
                for (int n = 0; n < 3; ++n) {
                    const int r = 16 * n + fr, off = r * 1024 + (((4 * ks + fq) ^ (r & 15)) << 4);
                    const bf16x8 wh = *(const LAS bf16x8*)(wl_ + off), wl = *(const LAS bf16x8*)(wl_ + 49152 + off);
                    acc[n] = __builtin_amdgcn_mfma_f32_16x16x32_bf16(ah, wh, acc[n], 0, 0, 0);
                    acc[n] = __builtin_amdgcn_mfma_f32_16x16x32_bf16(al, wh, acc[n], 0, 0, 0);
                    acc[n] = __builtin_amdgcn_mfma_f32_16x16x32_bf16(ah, wl, acc[n], 0, 0, 0);
                }
            }
        }
        ss += __shfl_xor(ss, 16); ss += __shfl_xor(ss, 32);
        const float rs = 1.0f / sqrtf(ss * (1.0f / D) + 1e-6f);
        if (fq == 0) rstd2[tok0 + fr] = rs;
#pragma unroll
        for (int n = 0; n < 3; ++n)
#pragma unroll
            for (int r = 0; r < 4; ++r) lg[(4 * fq + r) * 48 + 16 * n + fr] = acc[n][r];
        LDS_WAIT();
        int e0 = 0, e1 = 0; float w0 = 0.f, w1 = 0.f; unsigned lp0 = 0, lp1 = 0;
        if (lane < 16) {
            const float rst = rs;
            const LAS float* L = lg + lane * 48;
            float gl[4]; int gi = 0; float gm;
#pragma unroll
            for (int g = 0; g < 4; ++g) gl[g] = L[g] * rst + p.r_grp_b[g];
            gm = gl[0];
#pragma unroll
            for (int g = 1; g < 4; ++g) if (gl[g] > gm) { gm = gl[g]; gi = g; }
            float gs = 0.f;
#pragma unroll
            for (int g = 0; g < 4; ++g) gs += __expf(gl[g] - gm);
            const float gval = 1.0f / gs;
            float el[8];
#pragma unroll
            for (int e = 0; e < 8; ++e) el[e] = L[4 + gi * 8 + e] * rst + p.r_exp_b[gi * 8 + e];
            int i0 = 0; float m0 = el[0];
#pragma unroll
            for (int e = 1; e < 8; ++e) if (el[e] > m0) { m0 = el[e]; i0 = e; }
            int i1 = i0 == 0 ? 1 : 0; float m1 = el[i1];
#pragma unroll
            for (int e = 0; e < 8; ++e) if (e != i0 && el[e] > m1) { m1 = el[e]; i1 = e; }
            const float x1 = __expf(m1 - m0); const float den = 1.0f / (1.0f + x1);
            e0 = gi * 8 + i0; e1 = gi * 8 + i1; w0 = gval * den; w1 = gval * x1 * den;
            lp0 = atomicAdd((unsigned*)&lcnt[e0], 1u); lp1 = atomicAdd((unsigned*)&lcnt[e1], 1u);
        }
        __syncthreads();
        if (tid < 32) gbase[tid] = atomicAdd(&cnt[tid], lcnt[tid]);
        __syncthreads();
        if (lane < 16) {
            const int tok = tok0 + lane;
            const unsigned q0 = gbase[e0] + lp0, q1 = gbase[e1] + lp1;
            list[(size_t)e0 * T + q0] = tok * 2;     listw[(size_t)e0 * T + q0] = w0;
            list[(size_t)e1 * T + q1] = tok * 2 + 1; listw[(size_t)e1 * T + q1] = w1;
        }
        __syncthreads();
    }
}

constexpr int LDS_MAP = 161792;
__device__ __forceinline__ void expert_map_build(const unsigned* cnt, LAS unsigned char* lds) {
    LAS int* pre = (LAS int*)(lds + LDS_MAP); LAS int* cn = pre + 40;
    if (threadIdx.x == 0) { int acc = 0; for (int i = 0; i < NE; ++i) { const int ci = (int)__hip_atomic_load(cnt + i, __ATOMIC_RELAXED, __HIP_MEMORY_SCOPE_AGENT); pre[i] = acc; cn[i] = ci; acc += (ci + 255) >> 8; } pre[NE] = acc; }
    __syncthreads();
}
__device__ __forceinline__ void expert_find(LAS unsigned char* lds, int mt, int& e, int& local, int& c) {
    const LAS int* pre = (const LAS int*)(lds + LDS_MAP); const LAS int* cn = pre + 40;
    int lo = 0;
#pragma unroll 1
    for (int i = 1; i < NE; ++i) if (pre[i] <= mt) lo = i;
    e = __builtin_amdgcn_readfirstlane(lo); local = mt - __builtin_amdgcn_readfirstlane(pre[e]); c = __builtin_amdgcn_readfirstlane(cn[e]);
}
__device__ __forceinline__ int expert_tiles(LAS unsigned char* lds) { return __builtin_amdgcn_readfirstlane(((const LAS int*)(lds + LDS_MAP))[NE]); }

struct EpiGU {
    bf16_t* hid; const float* rstd2; const int* lst; int cnt, p0, hrow0, ct;
    __device__ __forceinline__ void operator()(const f32x4 (&acc)[2][2][4][2], int wr, int wc, int fr, int fq) const {
#pragma unroll
        for (int ai = 0; ai < 2; ++ai)
#pragma unroll
            for (int m = 0; m < 4; ++m) { const int r = ai * 128 + wr * 64 + m * 16 + fr; const int pp = p0 + r;
                const float rs = pp < cnt ? rstd2[lst[pp] >> 1] : 0.f;
                bf16_t* op = hid + (size_t)(hrow0 + r) * DE + ct * 128 + wc * 32 + 8 * fq;
                float o[8];
#pragma unroll
                for (int n = 0; n < 2; ++n) { const f32x4 g = acc[ai][0][m][n] * rs, uu = acc[ai][1][m][n] * rs;
#pragma unroll
                    for (int j = 0; j < 4; ++j) o[4 * n + j] = g[j] * frcp(1.0f + fexp2(-g[j] * LOG2E)) * uu[j]; }
                *(u32x4*)op = (u32x4){cvt_pk_bf16(o[0], o[1]), cvt_pk_bf16(o[2], o[3]), cvt_pk_bf16(o[4], o[5]), cvt_pk_bf16(o[6], o[7])}; }
    }
};
__device__ __forceinline__ void phase5(const Params& p, LAS unsigned char* lds) {
    expert_map_build((const unsigned*)(p.ws + WS_CTL), lds);
    const int MT = expert_tiles(lds);
    const int tid = threadIdx.x;
    for (int unit = blockIdx.x; unit < MT * 2; unit += gridDim.x) {
        const int mt = unit >> 1, ct = unit & 1; int e, local, c; expert_find(lds, mt, e, local, c);
        const int* lst = (const int*)(p.ws + WS_LIST) + (size_t)e * T; const int p0 = local * 256;
        unsigned aoff[2][2];
#pragma unroll
        for (int i = 0; i < 2; ++i) { int R, C; g8::stage_rc(tid * 16 + i * 8192, R, C);
#pragma unroll
            for (int hh = 0; hh < 2; ++hh) { const int pp = p0 + hh * 128 + R; const int tok = pp < c ? (lst[pp] >> 1) : 0; aoff[hh][i] = (unsigned)(tok * D + C) * 2u; } }
        EpiGU E{(bf16_t*)(p.ws + WS_B), (const float*)(p.ws + WS_RSTD2), lst, c, p0, mt * 256, ct};
        g8::gemm_unit(lds, (const char*)(p.ws + WS_A), aoff, (const char*)(p.ws + WS_WGU) + ((size_t)e * 512 + ct * 256) * D * 2, D, E);
    }
}
struct EpiDN {
    bf16_t* y; bf16_t* dummy; const int* lst; const float* lw; int cnt, p0, col0;
    __device__ __forceinline__ void operator()(const f32x4 (&acc)[2][2][4][2], int wr, int wc, int fr, int fq) const {
#pragma unroll
        for (int ai = 0; ai < 2; ++ai)
#pragma unroll
            for (int m = 0; m < 4; ++m) { const int pp = p0 + ai * 128 + wr * 64 + m * 16 + fr;
                const bool ok = pp < cnt; const int ent = lst[pp]; const float w = lw[pp];
                bf16_t* op = (ok ? y + ((size_t)(ent & 1) * T + (ent >> 1)) * D : dummy) + col0 + wc * 32 + 8 * fq;
#pragma unroll
                for (int bj = 0; bj < 2; ++bj) { const f32x4 v0 = acc[ai][bj][m][0] * w, v1 = acc[ai][bj][m][1] * w;
                    *(u32x4*)(op + bj * 128) = (u32x4){cvt_pk_bf16(v0[0], v0[1]), cvt_pk_bf16(v0[2], v0[3]), cvt_pk_bf16(v1[0], v1[1]), cvt_pk_bf16(v1[2], v1[3])}; }
                if (m & 1) asm volatile("" ::: "memory"); }
    }
};
__device__ __forceinline__ void phase6(const Params& p, LAS unsigned char* lds) {
    expert_map_build((const unsigned*)(p.ws + WS_CTL), lds);
    const int MT = expert_tiles(lds);
    constexpr int kdn = DE;
    unsigned aoff[2][2]; g8::aoff_rows(aoff, kdn);
    for (int unit = blockIdx.x; unit < MT * 4; unit += gridDim.x) {
        const int mt = unit >> 2, pn = unit & 3; int e, local, c; expert_find(lds, mt, e, local, c);
        EpiDN E{(bf16_t*)(p.ws + WS_A + (size_t)T * D * 2), (bf16_t*)(p.ws + WS_A + (size_t)3 * T * D * 2), (const int*)(p.ws + WS_LIST) + (size_t)e * T, (const float*)(p.ws + WS_LISTW) + (size_t)e * T, c, local * 256, pn * 256};
        g8::gemm_unit(lds, (const char*)(p.ws + WS_B) + (size_t)mt * 256 * DE * 2, aoff, (const char*)(p.ws + WS_WDN) + ((size_t)e * D + pn * 256) * DE * 2, kdn, E);
    }
}

__device__ __forceinline__ void phase7(const Params& p) {
    int tid7 = threadIdx.x; asm volatile("" : "+v"(tid7));
    const int wave = tid7 >> 6, lane = tid7 & 63;
    const bf16_t* y0 = (const bf16_t*)(p.ws + WS_A + (size_t)T * D * 2); const bf16_t* y1 = y0 + (size_t)T * D;
    f32x4 g[4];
#pragma unroll
    for (int j = 0; j < 4; ++j) g[j] = *((const f32x4*)p.final_g + lane + 64 * j);
    for (int row = blockIdx.x * NWAVES + wave; row < T; row += gridDim.x * NWAVES) {
        f32x4* hr = (f32x4*)(p.out + (size_t)row * D) + lane; const u32x2* a = (const u32x2*)(y0 + (size_t)row * D) + lane; const u32x2* bq = (const u32x2*)(y1 + (size_t)row * D) + lane;
        f32x4 v[4]; float s = 0.f;
#pragma unroll
        for (int j = 0; j < 4; ++j) { v[j] = hr[64 * j]; const u32x2 ya = a[64 * j], yb = bq[64 * j];
            v[j][0] += bf16_lo(ya.x) + bf16_lo(yb.x); v[j][1] += bf16_hi(ya.x) + bf16_hi(yb.x); v[j][2] += bf16_lo(ya.y) + bf16_lo(yb.y); v[j][3] += bf16_hi(ya.y) + bf16_hi(yb.y);
            s += (v[j][0] * v[j][0] + v[j][1] * v[j][1]) + (v[j][2] * v[j][2] + v[j][3] * v[j][3]); }
        s = wave_sum(s);
        const float rs = 1.0f / sqrtf(s * (1.0f / D) + 1e-6f);
#pragma unroll
        for (int j = 0; j < 4; ++j) hr[64 * j] = v[j] * rs * g[j];
    }
}

__global__ __launch_bounds__(512) void mega(Params p) {
    extern __shared__ __attribute__((aligned(16))) unsigned char lds_raw[];
    LAS unsigned char* lds = (LAS unsigned char*)lds_raw;
    volatile LAS unsigned* bst = (volatile LAS unsigned*)(lds + LDS_MAP + 512);
    if (threadIdx.x == 0) { bst[0] = 0u; bst[1] = 0u; bst[2] = 0u; bst[3] = 0u; }
    __syncthreads();
    const XcdBarrier gb = xcd_barrier_post((unsigned*)(p.ws + WS_BAR), bst);
#define GSYNC() xcd_barrier(gb)
#ifndef PHASE_MASK
#define PHASE_MASK 0xff
#endif
#ifdef TPROBE
    volatile LAS unsigned long long* tsl = (volatile LAS unsigned long long*)(lds + LDS_MAP + 640);
    if (threadIdx.x == 0) tsl[0] = __builtin_amdgcn_s_memrealtime();
#define TS(i) do { if (threadIdx.x == 0 && ((i) == TPROBE || (i) == TPROBE + 1)) tsl[i] = __builtin_amdgcn_s_memrealtime(); } while (0)
#else
#define TS(i)
#endif
    if (PHASE_MASK & 1) phase0(p, lds); GSYNC(); TS(1);
    if (PHASE_MASK & 2) phase1(p, lds); GSYNC(); TS(2);
    if (PHASE_MASK & 4) { phase2a(p); GSYNC(); phase2(p, lds); } GSYNC(); TS(3);
#ifdef RWDEBUG
    {
        bf16_t* dbg = (bf16_t*)(p.ws + WS_A + (size_t)3 * T * D * 2 + 4096);
        float* red = (float*)(p.ws + WS_CTL + 2048);
        if (blockIdx.x == 0) {
            rwkv_chain_seq(p, lds, RWDEBUG_B, RWDEBUG_H, dbg - (size_t)RWDEBUG_B * S * D, 2 * RWDEBUG_C1);
            __syncthreads();
            const bf16_t* mix = (const bf16_t*)(p.ws + WS_B);
            float md = 0.f, mr = 0.f; int bad = 0;
            for (int i = threadIdx.x; i < (RWDEBUG_C1 - RWDEBUG_C0) * 32 * 64; i += NTHREADS) {
                const int t = RWDEBUG_C0 * 32 + i / 64, col = 512 + RWDEBUG_H * 64 + (i % 64);
                const float a = __uint_as_float((unsigned)mix[((size_t)RWDEBUG_B * S + t) * D + col] << 16), r = __uint_as_float((unsigned)dbg[(size_t)t * D + col] << 16);
                if (!(fabsf(a) < 1e30f)) bad++;
                else { md = fmaxf(md, fabsf(a - r)); } mr = fmaxf(mr, fabsf(r));
            }
            LAS float* sh = (LAS float*)lds;
            sh[threadIdx.x] = md; sh[512 + threadIdx.x] = mr; sh[1024 + threadIdx.x] = (float)bad; __syncthreads();
            if (threadIdx.x == 0) { float a = 0.f, r = 0.f, nb = 0.f; for (int i = 0; i < NTHREADS; ++i) { a = fmaxf(a, sh[i]); r = fmaxf(r, sh[512 + i]); nb += sh[1024 + i]; }
                float rel = a / fmaxf(r, 1e-20f); float code = nb > 0.f ? 40.0f : (rel < 0.03f ? 5.0f : (rel < 0.3f ? 10.0f : 20.0f));
                red[0] = code; }
        }
        GSYNC();
        const float code = ((const float*)(p.ws + WS_CTL + 2048))[0];
        for (size_t i = (size_t)blockIdx.x * NTHREADS + threadIdx.x; i < (size_t)T * D; i += (size_t)gridDim.x * NTHREADS) p.out[i] = code;
        return;
    }
#endif
    if (PHASE_MASK & 8) phase3(p, lds); GSYNC(); TS(4);
    if (PHASE_MASK & 16) phase4(p, lds); GSYNC(); TS(5);
    if (PHASE_MASK & 32) phase5(p, lds); GSYNC(); TS(6);
    if (PHASE_MASK & 64) phase6(p, lds); GSYNC(); TS(7);
    if (PHASE_MASK & 128) phase7(p);
#ifdef TPROBE
    GSYNC(); TS(8);
    float* tw = (float*)(p.ws + WS_CTL + 1024);
    if (blockIdx.x == 0 && threadIdx.x == 0) { const float t1 = (float)(tsl[TPROBE + 1] - tsl[TPROBE]) * 0.01f; tw[0] = floorf(log2f(t1) * TPQ + 0.5f) / TPQ; }
    GSYNC();
    const float c1 = tw[0];
    int tq_ = threadIdx.x; asm volatile("" : "+v"(tq_));
    for (size_t i = (size_t)blockIdx.x * NTHREADS + tq_; i < (size_t)T * D; i += (size_t)gridDim.x * NTHREADS) p.out[i] = c1;
#endif
}

extern "C" void kernel_launch(void* const* d_in, const int* in_sizes, int n_in, void* d_out, int out_size, void* d_ws, size_t ws_size, hipStream_t stream) {
    static int grid = 0;
    if (grid == 0) {
        if (n_in != 25 || out_size != T * D || ws_size < WS_END) { fprintf(stderr, "kernel_launch: unexpected sizes n_in %d out %d ws %zu (need %zu)\n", n_in, out_size, ws_size, (size_t)WS_END); grid = -1; return; }
        int dev = 0, cus = 0, per_cu = 0;
        (void)hipGetDevice(&dev); (void)hipDeviceGetAttribute(&cus, hipDeviceAttributeMultiprocessorCount, dev);
        if (hipFuncSetAttribute((const void*)mega, hipFuncAttributeMaxDynamicSharedMemorySize, LDS_BYTES) != hipSuccess) { fprintf(stderr, "kernel_launch: hipFuncSetAttribute failed\n"); grid = -1; return; }
        if (hipOccupancyMaxActiveBlocksPerMultiprocessor(&per_cu, (const void*)mega, NTHREADS, LDS_BYTES) != hipSuccess || per_cu < 1) { fprintf(stderr, "kernel_launch: occupancy query failed (%d)\n", per_cu); (void)hipGetLastError(); per_cu = 1; }
        grid = cus * 1;
    }
    if (grid < 0) return;
    Params p{};
    const float** f = (const float**)&p;
    for (int i = 0; i < 25; ++i) f[i] = (const float*)d_in[i];
    p.out = (float*)d_out; p.ws = (unsigned char*)d_ws;
    if (hipMemsetAsync((char*)d_ws + WS_BAR, 0, XCD_BAR_WORDS * 4, stream) != hipSuccess) { fprintf(stderr, "kernel_launch: memset failed\n"); return; }
    hipLaunchKernelGGL(mega, dim3(grid), dim3(NTHREADS), LDS_BYTES, stream, p);
    hipError_t e = hipPeekAtLastError();
    if (e != hipSuccess) fprintf(stderr, "launch failed: %s (grid %d)\n", hipGetErrorString(e), grid);
}
```

```cpp
#include <hip/hip_runtime.h>
#include <cstdio>
#include <cstdint>
#define TPQ 8.0f

#define LAS __attribute__((address_space(3)))
typedef unsigned short bf16_t;
typedef short bf16x8 __attribute__((ext_vector_type(8)));
typedef short s16x4 __attribute__((ext_vector_type(4)));
typedef float f32x4 __attribute__((ext_vector_type(4)));
typedef float f32x2 __attribute__((ext_vector_type(2)));
typedef float f32x16 __attribute__((ext_vector_type(16)));
typedef unsigned u32x2 __attribute__((ext_vector_type(2)));
typedef unsigned u32x4 __attribute__((ext_vector_type(4)));

constexpr int NB = 16, S = 2048, T = NB * S, D = 1024, NIN = 3328, NH = 8, HD = 64;
constexpr int UQ = 0, UK = 512, UV = 1024, UR = 1536, URK = 2048, URV = 2560, UXW = 3072, UXA = 3136, UXG = 3200;
constexpr int NE = 32, DE = 256;
constexpr float LOG2E = 1.4426950408889634f, LN2 = 0.6931471805599453f;
constexpr float QSCALE = 0.125f * LOG2E;
constexpr int NTHREADS = 512, NWAVES = 8;
constexpr int LDS_BYTES = 161792 + 1024;

constexpr size_t WS_CTL   = 0;
constexpr size_t WS_BAR   = 8192;
constexpr size_t WS_WIN   = 65536;
constexpr size_t WS_WOUT  = WS_WIN  + (size_t)NIN * D * 2;
constexpr size_t WS_WGU   = WS_WOUT + (size_t)D * D * 2;
constexpr size_t WS_WDN   = WS_WGU  + (size_t)NE * 512 * D * 2;
constexpr size_t WS_RSTD1 = WS_WDN  + (size_t)NE * D * DE * 2;
constexpr size_t WS_RSTD2 = WS_RSTD1 + (size_t)T * 4;
constexpr size_t WS_LIST  = WS_RSTD2 + (size_t)T * 4;
constexpr size_t WS_LISTW = WS_LIST + (size_t)NE * T * 4;
constexpr size_t WS_WR    = WS_LISTW + (size_t)NE * T * 4;
constexpr size_t WS_LT    = WS_WR + (size_t)2 * 48 * D * 2;
constexpr size_t WS_A     = WS_LT + (size_t)512 * 256 * 2;
constexpr size_t WS_B     = WS_A + (size_t)T * NIN * 2;
constexpr size_t WS_END   = WS_B + (size_t)T * D * 2;
constexpr int HID_ROWS = 2 * T + NE * 256;

struct Params {
    const float* x; const float* norm_mix_g; const float* w_in; const float* shift_mu; const float* sb_out_g;
    const float* rw_w0; const float* rw_w2; const float* rw_a0; const float* rw_a2; const float* rw_g2;
    const float* rw_k_k; const float* rw_k_a; const float* rw_r_k; const float* rw_ln_w; const float* rw_ln_b;
    const float* w_out; const float* norm_ffn_g; const float* r_grp_w; const float* r_grp_b; const float* r_exp_w; const float* r_exp_b;
    const float* w_gate; const float* w_up; const float* w_down; const float* final_g;
    float* out; unsigned char* ws;
};

typedef __bf16 bf16x2_t __attribute__((ext_vector_type(2)));
__device__ __forceinline__ unsigned cvt_pk_bf16(float lo, float hi) { const f32x2 v = {lo, hi}; return __builtin_bit_cast(unsigned, __builtin_convertvector(v, bf16x2_t)); }
__device__ __forceinline__ float bf16_lo(unsigned w) { return __uint_as_float(w << 16); }
__device__ __forceinline__ float bf16_hi(unsigned w) { return __uint_as_float(w & 0xffff0000u); }
__device__ __forceinline__ float fexp2(float x) { return __builtin_amdgcn_exp2f(x); }
__device__ __forceinline__ float flog2(float x) { return __builtin_amdgcn_logf(x); }
__device__ __forceinline__ float frcp(float x) { return __builtin_amdgcn_rcpf(x); }
__device__ __forceinline__ float frsq(float x) { return __builtin_amdgcn_rsqf(x); }
template <int CTRL> __device__ __forceinline__ float dppf(float v) { return __builtin_bit_cast(float, __builtin_amdgcn_update_dpp(0, __builtin_bit_cast(int, v), CTRL, 0xF, 0xF, true)); }
__device__ __forceinline__ float rlane(float v, int l) { return __builtin_bit_cast(float, __builtin_amdgcn_readlane(__builtin_bit_cast(int, v), l)); }
__device__ __forceinline__ float sum8(float v) { v += dppf<0xB1>(v); v += dppf<0x4E>(v); v += dppf<0x141>(v); return v; }
__device__ __forceinline__ float sum16(float v) { v = sum8(v); v += dppf<0x140>(v); return v; }
__device__ __forceinline__ float wave_sum(float v) { v = sum16(v); return (rlane(v, 0) + rlane(v, 16)) + (rlane(v, 32) + rlane(v, 48)); }
__device__ __forceinline__ float swap32(float v) { return __shfl_xor(v, 32); }
#define LDS_WAIT() asm volatile("s_waitcnt lgkmcnt(0)" ::: "memory")


#define XB_TMO      128
#define XB_XCNT(j)  (256  + 64 * (j))
#define XB_XSUB(j)  (1280 + 64 * (j))
#define XB_XGEN(j)  (2304 + 64 * (j))
#define XB_TOP      3328
#define XB_TOPGEN   3392
#define XCD_BAR_WORDS 3456
#define XB_SPIN_CAP (1u << 22)
__device__ __forceinline__ unsigned xb_ld(unsigned* p)              { return __hip_atomic_load(p, __ATOMIC_RELAXED, __HIP_MEMORY_SCOPE_AGENT); }
__device__ __forceinline__ unsigned xb_add(unsigned* p, unsigned v) { return __hip_atomic_fetch_add(p, v, __ATOMIC_RELAXED, __HIP_MEMORY_SCOPE_AGENT); }
__device__ __forceinline__ unsigned xb_xcc_id() { return (unsigned)__builtin_amdgcn_s_getreg((3 << 11) | 20) & 0xFu; }
#define XB_SPIN(cond, bar) do { unsigned _sp = 0; while (cond) { __builtin_amdgcn_s_sleep(1); \
    if ((++_sp & 255u) == 0u) { if (xb_ld(&(bar)[XB_TMO])) break; if (_sp > XB_SPIN_CAP) { atomicAdd(&(bar)[XB_TMO], 1u); break; } } } } while (0)
struct XcdBarrier { unsigned* bar; unsigned x; volatile LAS unsigned* st; };
__device__ __forceinline__ XcdBarrier xcd_barrier_post(unsigned* bar, volatile LAS unsigned* st) {
    XcdBarrier b; b.bar = bar; b.x = xb_xcc_id(); b.st = st;
    if (threadIdx.x == 0) (void)xb_add(&bar[XB_XCNT(b.x)], 1u);
    return b;
}
__device__ __forceinline__ void xcd_barrier_complete(unsigned* bar, unsigned x, unsigned& nloc, unsigned& nx) {
    const unsigned G = gridDim.x * gridDim.y * gridDim.z;
    unsigned sum, cnt, mine, sp = 0u;
    for (;;) {
        sum = 0u; cnt = 0u; mine = 0u;
#pragma unroll
        for (unsigned j = 0; j < 16; ++j) { const unsigned c = xb_ld(&bar[XB_XCNT(j)]); sum += c; cnt += (c > 0u) ? 1u : 0u; mine = (j == x) ? c : mine; }
        if (sum == G) break;
        __builtin_amdgcn_s_sleep(1);
        if ((++sp & 255u) == 0u) { if (xb_ld(&bar[XB_TMO])) break; if (sp > XB_SPIN_CAP) { atomicAdd(&bar[XB_TMO], 1u); break; } }
    }
    nloc = mine > 0u ? mine : 1u; nx = cnt > 0u ? cnt : 1u;
}
__device__ __forceinline__ void xcd_barrier(const XcdBarrier& b) {
    asm volatile("s_waitcnt vmcnt(0)" ::: "memory");
    __syncthreads();
    if (threadIdx.x == 0) {
        unsigned* bar = b.bar;
        __builtin_amdgcn_s_waitcnt(0);
        unsigned nloc = b.st[0], nx = b.st[1];
        if (nloc == 0u) { xcd_barrier_complete(bar, b.x, nloc, nx); b.st[0] = nloc; b.st[1] = nx; }
        const unsigned old = xb_add(&bar[XB_XSUB(b.x)], 1u);
        const unsigned gen = old / nloc;
        if (old + 1u == (gen + 1u) * nloc) {
            __builtin_amdgcn_fence(__ATOMIC_RELEASE, "agent");
            asm volatile("s_waitcnt vmcnt(0)" ::: "memory");
            const unsigned og = xb_add(&bar[XB_TOP], 1u);
            const unsigned tg = og / nx;
            if (og + 1u == (tg + 1u) * nx) xb_add(&bar[XB_TOPGEN], 1u);
            else XB_SPIN(xb_ld(&bar[XB_TOPGEN]) == tg, bar);
            __builtin_amdgcn_fence(__ATOMIC_ACQUIRE, "agent");
            xb_add(&bar[XB_XGEN(b.x)], 1u);
            asm volatile("s_waitcnt vmcnt(0)" ::: "memory");
        } else {
            XB_SPIN(xb_ld(&bar[XB_XGEN(b.x)]) == gen, bar);
            __builtin_amdgcn_fence(__ATOMIC_ACQUIRE, "agent");
            asm volatile("s_waitcnt vmcnt(0)" ::: "memory");
        }
    }
    __syncthreads();
}

namespace g8 {
constexpr int BK = 64, HALF = 128, HTB = HALF * BK * 2;
__device__ __forceinline__ int lds_byte(int r, int c) { const int st = (r >> 4) * 2 + (c >> 5), rr = r & 15, cc = c & 31, ob = rr * 64 + cc * 2; return st * 1024 + (ob ^ (((ob >> 9) & 1) << 5)); }
__device__ __forceinline__ void stage_rc(int b, int& R, int& C) { const int st = b / 1024, sb = b % 1024, swz = sb ^ (((sb >> 9) & 1) << 5); R = (st >> 1) * 16 + swz / 64; C = (st & 1) * 32 + (swz % 64) / 2; }

#define G8_SA(b, h) (((b) * 2 + (h)) * HTB)
#define G8_SB(b, h) ((4 + (b) * 2 + (h)) * HTB)
#define G8_STAGE_A(bufoff, h, kt) do { _Pragma("unroll") for (int _i = 0; _i < 2; ++_i) \
    __builtin_amdgcn_global_load_lds((const unsigned*)((Ab + (size_t)(kt) * (BK * 2)) + aoff[h][_i]), (LAS unsigned*)(lds + (bufoff) + ldsw + _i * 8192), 16, 0, 0); } while (0)
#define G8_STAGE_B(bufoff, h, kt) do { _Pragma("unroll") for (int _i = 0; _i < 2; ++_i) \
    __builtin_amdgcn_global_load_lds((const unsigned*)((Bb + (size_t)(h) * bhalf + (size_t)(kt) * (BK * 2)) + boff[_i]), (LAS unsigned*)(lds + (bufoff) + ldsw + _i * 8192), 16, 0, 0); } while (0)
#define G8_LDA(dst, b, h) do { _Pragma("unroll") for (int m = 0; m < 4; ++m) _Pragma("unroll") for (int k = 0; k < 2; ++k) dst[m][k] = *(const LAS bf16x8*)(lds + G8_SA(b, h) + la_off + m * 2048 + k * 1024); } while (0)
#define G8_LDB(dst, b, h) do { _Pragma("unroll") for (int n = 0; n < 2; ++n) _Pragma("unroll") for (int k = 0; k < 2; ++k) dst[n][k] = *(const LAS bf16x8*)(lds + G8_SB(b, h) + lb_off + n * 2048 + k * 1024); } while (0)
#define G8_MMA(ai, bj, At, Bt) do { __builtin_amdgcn_s_setprio(1); _Pragma("unroll") for (int m = 0; m < 4; ++m) _Pragma("unroll") for (int n = 0; n < 2; ++n) _Pragma("unroll") for (int k = 0; k < 2; ++k) \
    acc[ai][bj][m][n] = __builtin_amdgcn_mfma_f32_16x16x32_bf16(Bt[n][k], At[m][k], acc[ai][bj][m][n], 0, 0, 0); __builtin_amdgcn_s_setprio(0); } while (0)
#define G8_WAIT_V(n) asm volatile("s_waitcnt vmcnt(" #n ")" ::: "memory")
#define G8_WAIT_L(n) asm volatile("s_waitcnt lgkmcnt(" #n ")" ::: "memory")
#define G8_BAR __builtin_amdgcn_s_barrier()
#define G8_SCHED __builtin_amdgcn_sched_barrier(0)

template <class Epi>
__device__ __forceinline__ void gemm_unit(LAS unsigned char* lds, const char* Ab, const unsigned (&aoff)[2][2], const char* Bb, int K, const Epi& E) {
    int tid = threadIdx.x; asm volatile("" : "+v"(tid));
    const int wid = __builtin_amdgcn_readfirstlane(tid >> 6), lane = tid & 63, wr = wid >> 2, wc = wid & 3, fr = lane & 15, fq = lane >> 4;
    const int nt = K / BK;
    unsigned boff[2];
#pragma unroll
    for (int i = 0; i < 2; ++i) { int R, C; stage_rc(tid * 16 + i * 8192, R, C); const int rho = R & 31, Rb = (R & ~31) + 8 * ((rho & 15) >> 2) + 4 * (rho >> 4) + (rho & 3);
        boff[i] = (unsigned)(Rb * K + C) * 2u; }
    const size_t bhalf = (size_t)HALF * K * 2;
    const unsigned ldsw = (unsigned)wid * 1024u;
    const int la_off = lds_byte(wr * 64 + fr, fq * 8), lb_off = lds_byte(wc * 32 + fr, fq * 8);
    f32x4 acc[2][2][4][2];
#pragma unroll
    for (int a = 0; a < 2; ++a)
#pragma unroll
        for (int b = 0; b < 2; ++b)
#pragma unroll
            for (int m = 0; m < 4; ++m)
#pragma unroll
                for (int n = 0; n < 2; ++n) acc[a][b][m][n] = (f32x4){0.f, 0.f, 0.f, 0.f};
    bf16x8 At[4][2], B0[2][2], B1[2][2];
    G8_STAGE_B(G8_SB(0, 0), 0, 0); G8_STAGE_A(G8_SA(0, 0), 0, 0);
    G8_STAGE_B(G8_SB(0, 1), 1, 0); G8_STAGE_A(G8_SA(0, 1), 1, 0);
    if (wr == 1) G8_BAR;
    G8_WAIT_V(4); G8_BAR;
    G8_STAGE_B(G8_SB(1, 0), 0, 1); G8_STAGE_A(G8_SA(1, 0), 0, 1); G8_STAGE_B(G8_SB(1, 1), 1, 1);
    G8_WAIT_V(6); G8_BAR;
    for (int t = 0; t < nt - 2; t += 2) {
        G8_LDB(B0, 0, 0); G8_SCHED; G8_LDA(At, 0, 0); G8_STAGE_A(G8_SA(1, 1), 1, t + 1);
        G8_WAIT_L(8); G8_BAR; G8_WAIT_L(0); G8_MMA(0, 0, At, B0); G8_BAR; G8_SCHED;
        G8_LDB(B1, 0, 1); G8_STAGE_B(G8_SB(0, 0), 0, t + 2);
        G8_BAR; G8_WAIT_L(0); G8_MMA(0, 1, At, B1); G8_BAR;
        G8_LDA(At, 0, 1); G8_STAGE_A(G8_SA(0, 0), 0, t + 2);
        G8_BAR; G8_WAIT_L(0); G8_MMA(1, 0, At, B0); G8_BAR; G8_SCHED;
        G8_STAGE_B(G8_SB(0, 1), 1, t + 2);
        G8_WAIT_V(6); G8_BAR; G8_MMA(1, 1, At, B1); G8_BAR;
        G8_LDB(B0, 1, 0); G8_SCHED; G8_LDA(At, 1, 0); G8_STAGE_A(G8_SA(0, 1), 1, t + 2);
        G8_WAIT_L(8); G8_BAR; G8_WAIT_L(0); G8_MMA(0, 0, At, B0); G8_BAR; G8_SCHED;
        G8_LDB(B1, 1, 1); G8_STAGE_B(G8_SB(1, 0), 0, t + 3);
        G8_BAR; G8_WAIT_L(0); G8_MMA(0, 1, At, B1); G8_BAR;
        G8_LDA(At, 1, 1); G8_STAGE_A(G8_SA(1, 0), 0, t + 3);
        G8_BAR; G8_WAIT_L(0); G8_MMA(1, 0, At, B0); G8_BAR; G8_SCHED;
        G8_STAGE_B(G8_SB(1, 1), 1, t + 3);
        G8_WAIT_V(6); G8_BAR; G8_MMA(1, 1, At, B1); G8_BAR;
    }
    { G8_LDB(B0, 0, 0); G8_LDA(At, 0, 0); G8_STAGE_A(G8_SA(1, 1), 1, nt - 1);
      G8_BAR; G8_WAIT_L(0); G8_MMA(0, 0, At, B0); G8_BAR;
      G8_LDB(B1, 0, 1); G8_BAR; G8_WAIT_L(0); G8_MMA(0, 1, At, B1); G8_BAR;
      G8_LDA(At, 0, 1); G8_WAIT_V(4); G8_BAR; G8_WAIT_L(0); G8_MMA(1, 0, At, B0); G8_MMA(1, 1, At, B1); G8_BAR; }
    { G8_LDB(B0, 1, 0); G8_LDA(At, 1, 0); G8_WAIT_V(2); G8_BAR; G8_WAIT_L(0); G8_MMA(0, 0, At, B0); G8_BAR;
      G8_LDB(B1, 1, 1); G8_WAIT_V(0); G8_BAR; G8_WAIT_L(0); G8_MMA(0, 1, At, B1); G8_BAR;
      G8_LDA(At, 1, 1); G8_BAR; G8_WAIT_L(0); G8_MMA(1, 0, At, B0); G8_MMA(1, 1, At, B1); G8_BAR; }
    if (wr == 0) G8_BAR;
    asm volatile("" ::: "memory");
    E(acc, wr, wc, fr, fq);
    __syncthreads();
}
__device__ __forceinline__ void aoff_rows(unsigned (&aoff)[2][2], int K) {
    int tid = threadIdx.x; asm volatile("" : "+v"(tid));
#pragma unroll
    for (int i = 0; i < 2; ++i) { int R, C; stage_rc(tid * 16 + i * 8192, R, C);
#pragma unroll
        for (int h = 0; h < 2; ++h) aoff[h][i] = (unsigned)((h * HALF + R) * K + C) * 2u; }
}
__device__ __forceinline__ void tile_order(int L, int nM, int nN, int& pm, int& pn) {
    const int nwg = nM * nN; int wgid = L;
    { const int q = nwg / 8, r = nwg % 8, xcd = wgid % 8, off = wgid / 8; wgid = (xcd < r ? xcd * (q + 1) : r * (q + 1) + (xcd - r) * q) + off; }
    const int nig = 8 * nN, gid = wgid / nig, fm = gid * 8, gsz = (nM - fm) < 8 ? (nM - fm) : 8;
    pm = fm + ((wgid % nig) % gsz); pn = (wgid % nig) / gsz;
}
}

__device__ __forceinline__ void p0_transpose_item(const float* W, int K, int N, int k0, int n0, bf16_t* WTrow0  , const float* kscale, float mul, LAS float* scr, int lane) {
#pragma unroll 8
    for (int i = 0; i < 32; ++i) { const int kk = 2 * i + (lane >> 5); float v = W[(size_t)(k0 + kk) * N + n0 + (lane & 31)]; if (kscale) v *= kscale[k0 + kk]; scr[kk * 33 + (lane & 31)] = v * mul; }
    LDS_WAIT();
    const int c = lane & 7;
#pragma unroll
    for (int j = 0; j < 4; ++j) { const int n = (lane >> 3) + 8 * j; const LAS float* s = scr + (8 * c) * 33 + n;
        u32x4 o; o.x = cvt_pk_bf16(s[0 * 33], s[1 * 33]); o.y = cvt_pk_bf16(s[2 * 33], s[3 * 33]); o.z = cvt_pk_bf16(s[4 * 33], s[5 * 33]); o.w = cvt_pk_bf16(s[6 * 33], s[7 * 33]);
        *(u32x4*)(WTrow0 + (size_t)n * K + k0 + 8 * c) = o; }
    LDS_WAIT();
}

__device__ __forceinline__ void p0_transpose64(const float* W, int K, int N, int k0, int n0, bf16_t* WTrow0  , const float* kscale, LAS float* scr, int lane) {
    const int rq = lane >> 4, c4 = 4 * (lane & 15);
    f32x4 v[16];
#pragma unroll
    for (int i = 0; i < 16; ++i) v[i] = *(const f32x4*)(W + (size_t)(k0 + 4 * i + rq) * N + n0 + c4);
    if (kscale) {
#pragma unroll
        for (int i = 0; i < 16; ++i) v[i] = v[i] * kscale[k0 + 4 * i + rq];
    }
#pragma unroll
    for (int i = 0; i < 16; ++i) { LAS float* d = scr + (4 * i + rq) * 65 + c4; d[0] = v[i][0]; d[1] = v[i][1]; d[2] = v[i][2]; d[3] = v[i][3]; }
    LDS_WAIT();
#pragma unroll
    for (int c = 0; c < 8; ++c) { const LAS float* sp = scr + (8 * c) * 65 + lane;
        u32x4 o; o.x = cvt_pk_bf16(sp[0], sp[65]); o.y = cvt_pk_bf16(sp[2 * 65], sp[3 * 65]); o.z = cvt_pk_bf16(sp[4 * 65], sp[5 * 65]); o.w = cvt_pk_bf16(sp[6 * 65], sp[7 * 65]);
        *(u32x4*)(WTrow0 + (size_t)lane * K + k0 + 8 * c) = o; }
    LDS_WAIT();
}
__device__ __forceinline__ void p0_expert_weights(const Params& p, LAS unsigned char* lds, int gw, int NGW) {
    int tid = threadIdx.x; asm volatile("" : "+v"(tid));
    const int wave = tid >> 6, lane = tid & 63;
    LAS float* scr = (LAS float*)(lds + wave * 16640);
    bf16_t* wgu = (bf16_t*)(p.ws + WS_WGU); bf16_t* wdn = (bf16_t*)(p.ws + WS_WDN);
    constexpr int I_G = NE * 16 * 4, I_D = NE * 4 * 16;
    for (int it = gw; it < 2 * I_G + I_D; it += NGW) {
        int r = it;
        if (r < 2 * I_G) { const int up = r >= I_G; if (up) r -= I_G; const int e = r / 64, q = r % 64, kb = q / 4, nb = q % 4, n0 = nb * 64;
            const int drow = (n0 >> 7) * 256 + up * 128 + (n0 & 127);
            p0_transpose64((up ? p.w_up : p.w_gate) + (size_t)e * D * DE, D, DE, kb * 64, n0, wgu + ((size_t)e * 512 + drow) * D, p.norm_ffn_g, scr, lane); continue; } r -= 2 * I_G;
        { const int e = r / 64, q = r % 64, kb = q / 16, nb = q % 16, n0 = nb * 64;
            p0_transpose64(p.w_down + (size_t)e * DE * D, DE, D, kb * 64, n0, wdn + ((size_t)e * D + n0) * DE, nullptr, scr, lane); }
    }
}
__device__ __forceinline__ void phase0(const Params& p, LAS unsigned char* lds) {
    int tid = threadIdx.x; asm volatile("" : "+v"(tid));
    const int wave = tid >> 6, lane = tid & 63;
    const int gw = blockIdx.x * NWAVES + wave, NGW = gridDim.x * NWAVES;
    LAS float* scr = (LAS float*)(lds + wave * 8704);
    bf16_t* win = (bf16_t*)(p.ws + WS_WIN); bf16_t* wout = (bf16_t*)(p.ws + WS_WOUT);
    constexpr int I_IN = 16 * 104, I_OUT = 16 * 32;
    for (int it = gw; it < I_IN + I_OUT; it += NGW) {
        int r = it;
        if (r < I_IN) { const int kb = r / 104, nb = r % 104, n0 = nb * 32; p0_transpose_item(p.w_in, D, NIN, kb * 64, n0, win + (size_t)n0 * D, p.norm_mix_g, n0 < 512 ? QSCALE : 1.f, scr, lane); continue; } r -= I_IN;
        { const int kb = r / 32, nb = r % 32, n0 = nb * 32; p0_transpose_item(p.w_out, D, D, kb * 64, n0, wout + (size_t)n0 * D, nullptr, 1.f, scr, lane); }
    }
    bf16_t* xb = (bf16_t*)(p.ws + WS_B); float* rstd1 = (float*)(p.ws + WS_RSTD1);
    for (int row = gw; row < T; row += NGW) {
        const f32x4* xr = (const f32x4*)(p.x + (size_t)row * D) + lane; f32x4 v[4]; float s = 0.f;
#pragma unroll
        for (int j = 0; j < 4; ++j) { v[j] = xr[64 * j]; s += (v[j].x * v[j].x + v[j].y * v[j].y) + (v[j].z * v[j].z + v[j].w * v[j].w); }
        s = wave_sum(s);
        u32x2* o = (u32x2*)(xb + (size_t)row * D) + lane;
#pragma unroll
        for (int j = 0; j < 4; ++j) { u32x2 w; w.x = cvt_pk_bf16(v[j].x, v[j].y); w.y = cvt_pk_bf16(v[j].z, v[j].w); o[64 * j] = w; }
        if (lane == 0) rstd1[row] = 1.0f / sqrtf(s * (1.0f / D) + 1e-6f);
    }
    bf16_t* wr_hi = (bf16_t*)(p.ws + WS_WR); bf16_t* wr_lo = wr_hi + 48 * D;
    for (int i = blockIdx.x * NTHREADS + tid; i < 48 * D; i += gridDim.x * NTHREADS) {
        const int c = i / D, k = i % D; float w = 0.f;
        if (c < 4) w = p.r_grp_w[k * 4 + c]; else if (c < 36) w = p.r_exp_w[k * 32 + (c - 4)];
        w *= p.norm_ffn_g[k];
        const unsigned hi = cvt_pk_bf16(w, 0.f) & 0xffffu; const float rem = w - __uint_as_float(hi << 16);
        wr_hi[i] = (bf16_t)hi; wr_lo[i] = (bf16_t)(cvt_pk_bf16(rem, 0.f) & 0xffffu);
    }
    { bf16_t* w2t = (bf16_t*)(p.ws + WS_LT); bf16_t* a2t = w2t + 512 * 64; bf16_t* g2t = a2t + 512 * 64;
      for (int i = blockIdx.x * NTHREADS + tid; i < 512 * 256; i += gridDim.x * NTHREADS) {
          if (i < 512 * 64) { const int c = i >> 6, m = i & 63; w2t[i] = (bf16_t)(cvt_pk_bf16(p.rw_w2[m * 512 + c], 0.f) & 0xffffu); }
          else if (i < 2 * 512 * 64) { const int q = i - 512 * 64, c = q >> 6, m = q & 63; a2t[q] = (bf16_t)(cvt_pk_bf16(p.rw_a2[m * 512 + c], 0.f) & 0xffffu); }
          else { const int q = i - 2 * 512 * 64, c = q >> 7, m = q & 127; g2t[q] = (bf16_t)(cvt_pk_bf16(p.rw_g2[m * 512 + c], 0.f) & 0xffffu); } } }
    if (blockIdx.x == 0 && tid < 64) ((unsigned*)(p.ws + WS_CTL))[tid] = 0u;
}

struct EpiU {
    bf16_t* u; const float* rstd; int row0, col0;
    __device__ __forceinline__ void operator()(const f32x4 (&acc)[2][2][4][2], int wr, int wc, int fr, int fq) const {
#pragma unroll
        for (int ai = 0; ai < 2; ++ai)
#pragma unroll
            for (int m = 0; m < 4; ++m) { const int row = row0 + ai * 128 + wr * 64 + m * 16 + fr; const float rs = rstd[row]; bf16_t* rp = u + (size_t)row * NIN + col0 + wc * 32 + 8 * fq;
#pragma unroll
                for (int bj = 0; bj < 2; ++bj) { const f32x4 v0 = acc[ai][bj][m][0] * rs, v1 = acc[ai][bj][m][1] * rs;
                    *(u32x4*)(rp + bj * 128) = (u32x4){cvt_pk_bf16(v0[0], v0[1]), cvt_pk_bf16(v0[2], v0[3]), cvt_pk_bf16(v1[0], v1[1]), cvt_pk_bf16(v1[2], v1[3])}; } }
    }
};
__device__ __forceinline__ void phase1(const Params& p, LAS unsigned char* lds) {
    constexpr int nM = T / 256, nN = NIN / 256;
    unsigned aoff[2][2]; g8::aoff_rows(aoff, D);
    for (int L = blockIdx.x; L < nM * nN; L += gridDim.x) {
        int pm, pn; g8::tile_order(L, nM, nN, pm, pn);
        EpiU E{(bf16_t*)(p.ws + WS_A), (const float*)(p.ws + WS_RSTD1), pm * 256, pn * 256};
        g8::gemm_unit(lds, (const char*)(p.ws + WS_B) + (size_t)pm * 256 * D * 2, aoff, (const char*)(p.ws + WS_WIN) + (size_t)pn * 256 * D * 2, D, E);
    }
}


typedef short v4i16_t __attribute__((ext_vector_type(4)));
__device__ __forceinline__ s16x4 lds_tr16(const LAS unsigned char* p) { return __builtin_bit_cast(s16x4, __builtin_amdgcn_ds_read_tr16_b64_v4i16((LAS v4i16_t*)p)); }

__device__ __forceinline__ void attn_tile(const Params& p, LAS unsigned char* vl  , int b, int h, int qt) {
    const int lane = threadIdx.x & 63, r32 = lane & 31, hi = lane >> 5;
    const bf16_t* u = (const bf16_t*)(p.ws + WS_A);
    const size_t row0 = (size_t)b * S; const int q0 = qt * 32;
    bf16x8 qf[4];
    { const bf16_t* qp = u + (row0 + q0 + r32) * NIN + UQ + h * HD + 8 * hi;
#pragma unroll
      for (int s = 0; s < 4; ++s) qf[s] = *(const bf16x8*)(qp + 16 * s); }
    f32x16 o0, o1;
#pragma unroll
    for (int i = 0; i < 16; ++i) { o0[i] = 0.f; o1[i] = 0.f; }
    float carry = 0.f;
    const int kperm = 16 * ((r32 >> 2) & 1) + (r32 & 3) + 4 * (r32 >> 3);
    const int g = lane >> 4, i16 = lane & 15, tq = i16 >> 2, tp = i16 & 3;
    const LAS unsigned char* vrd = vl + (16 * (g >> 1) + tq) * 144 + (16 * (g & 1) + 4 * tp) * 2;
    LAS unsigned char* vwr = vl + (lane >> 1) * 144 + (lane & 1) * 64;
    for (int kb = qt; kb >= 0; --kb) {
        const int key0 = kb * 32;
        { const bf16_t* vp = u + (row0 + key0 + (lane >> 1)) * NIN + UV + h * HD + 32 * (lane & 1);
          u32x4 v0 = *(const u32x4*)(vp), v1 = *(const u32x4*)(vp + 8), v2 = *(const u32x4*)(vp + 16), v3 = *(const u32x4*)(vp + 24);
          *(LAS u32x4*)(vwr) = v0; *(LAS u32x4*)(vwr + 16) = v1; *(LAS u32x4*)(vwr + 32) = v2; *(LAS u32x4*)(vwr + 48) = v3; }
        f32x16 st;
#pragma unroll
        for (int i = 0; i < 16; ++i) st[i] = 0.f;
        { const bf16_t* kp = u + (row0 + key0 + kperm) * NIN + UK + h * HD + 8 * hi;
          bf16x8 kf[4];
#pragma unroll
          for (int s = 0; s < 4; ++s) kf[s] = *(const bf16x8*)(kp + 16 * s);
#pragma unroll
          for (int s = 0; s < 4; ++s) st = __builtin_amdgcn_mfma_f32_32x32x16_bf16(kf[s], qf[s], st, 0, 0, 0); }
        const bool diag = (kb == qt);
        float lw[16], suf[16];
        float run = 0.f;
#pragma unroll
        for (int reg = 15; reg >= 0; --reg) {
            const float z = st[reg];
            const float l = flog2(1.0f + fexp2(-fabsf(z)));
            const float sp = fmaxf(z, 0.f) + l;
            const bool valid = !diag || (16 * hi + reg < r32);
            lw[reg] = valid ? (z - sp) : -1.0e30f;
            suf[reg] = run;
            run += valid ? -sp : 0.f;
        }
        const float other = swap32(run);
        const float tot_hi = hi ? run : other, tot_lo = hi ? other : run;
        const float base = carry + (hi ? 0.f : tot_hi);
        carry += tot_lo + tot_hi;
        unsigned pk[8];
#pragma unroll
        for (int j = 0; j < 8; ++j) pk[j] = cvt_pk_bf16(fexp2(lw[2 * j] + suf[2 * j] + base), fexp2(lw[2 * j + 1] + suf[2 * j + 1] + base));
        LDS_WAIT();
#pragma unroll
        for (int s2 = 0; s2 < 2; ++s2) {
            bf16x8 pf = __builtin_bit_cast(bf16x8, (u32x4){pk[4 * s2], pk[4 * s2 + 1], pk[4 * s2 + 2], pk[4 * s2 + 3]});
#pragma unroll
            for (int dh = 0; dh < 2; ++dh) {
                const s16x4 a = lds_tr16(vrd + (8 * s2) * 144 + 64 * dh), c = lds_tr16(vrd + (8 * s2 + 4) * 144 + 64 * dh);
                bf16x8 vf; vf[0] = a[0]; vf[1] = a[1]; vf[2] = a[2]; vf[3] = a[3]; vf[4] = c[0]; vf[5] = c[1]; vf[6] = c[2]; vf[7] = c[3];
                if (dh == 0) o0 = __builtin_amdgcn_mfma_f32_32x32x16_bf16(vf, pf, o0, 0, 0, 0); else o1 = __builtin_amdgcn_mfma_f32_32x32x16_bf16(vf, pf, o1, 0, 0, 0);
            }
        }
        LDS_WAIT();
        if (__builtin_amdgcn_ballot_w64(carry > -150.0f) == 0ull) break;
    }
    float ss = 0.f;
#pragma unroll
    for (int i = 0; i < 16; ++i) ss += o0[i] * o0[i] + o1[i] * o1[i];
    ss += swap32(ss);
    const float rs = 1.0f / sqrtf(ss * (1.0f / HD) + 1e-6f);
    bf16_t* op = (bf16_t*)(p.ws + WS_B) + (row0 + q0 + r32) * D + h * HD + 4 * hi;
    const float* gp = p.sb_out_g + h * HD + 4 * hi;
#pragma unroll
    for (int dh = 0; dh < 2; ++dh)
#pragma unroll
        for (int gq = 0; gq < 4; ++gq) {
            const f32x4 gg = *(const f32x4*)(gp + 32 * dh + 8 * gq);
            const f32x16& o = dh ? o1 : o0;
            u32x2 w; w.x = cvt_pk_bf16(o[4 * gq] * rs * gg[0], o[4 * gq + 1] * rs * gg[1]); w.y = cvt_pk_bf16(o[4 * gq + 2] * rs * gg[2], o[4 * gq + 3] * rs * gg[3]);
            *(u32x2*)(op + 32 * dh + 8 * gq) = w;
        }
}

constexpr size_t ACT_OFF = (size_t)64 << 20;
namespace rk {
constexpr int C = 32, NCH = S / C, NSLOT = 16;
constexpr int SL_PS = 0, SL_QS = 8192, SL_PO = 12288, SL_QO = 16384, SL_VR = 18432, SL_GB = 22528, SL_GW = 26624, SLOT_BYTES = 30720;
constexpr int MSTR = 144;
constexpr int PM_AT = 0, PM_RT = 4608, PM_BT = 9216, PM_KT = 13824, PM_GC = 18432, PROD_LDS = 18688;
constexpr int NPROD = 6;
constexpr int L_CONS = NPROD * PROD_LDS;
constexpr int OSTR = 272;
constexpr int L_OBUF = L_CONS + 4608;
constexpr int L_FLAG = L_OBUF + 32 * OSTR;
constexpr int L_W2 = L_FLAG + 256;
constexpr int L_A2 = L_W2 + 8192;
constexpr int L_G2 = L_A2 + 8192;
constexpr int L_CST = L_G2 + 16384;
constexpr int C_MUL = 0, C_MUR = 256, C_MUK = 320, C_MUV = 384, C_W0 = 448, C_A0 = 512, C_KK = 576, C_KA = 640, C_RK = 704, C_LNB = 768, C_END = 832;
static_assert(L_CST + C_END * 4 <= 161792, "rwkv LDS layout overflows");
}
__device__ __forceinline__ bf16x8 accfrag(const f32x16& a, int s) {
    return __builtin_bit_cast(bf16x8, (u32x4){cvt_pk_bf16(a[8 * s], a[8 * s + 1]), cvt_pk_bf16(a[8 * s + 2], a[8 * s + 3]), cvt_pk_bf16(a[8 * s + 4], a[8 * s + 5]), cvt_pk_bf16(a[8 * s + 6], a[8 * s + 7])});
}
__device__ __forceinline__ bf16x8 trfrag(const LAS unsigned char* mat, int s, int nt, int lane) {
    const int g = lane >> 4, i16 = lane & 15, q = i16 >> 2, pp = i16 & 3, h = g >> 1;
    const LAS unsigned char* a = mat + (16 * s + 4 * h + q) * rk::MSTR + (32 * nt + 16 * (g & 1) + 4 * pp) * 2;
    const s16x4 x = lds_tr16(a), y = lds_tr16(a + 8 * rk::MSTR);
    bf16x8 r; r[0] = x[0]; r[1] = x[1]; r[2] = x[2]; r[3] = x[3]; r[4] = y[0]; r[5] = y[1]; r[6] = y[2]; r[7] = y[3]; return r;
}
__device__ __forceinline__ void f8_from_bf16(const u32x4 w, float (&o)[8]) {
#pragma unroll
    for (int j = 0; j < 4; ++j) { o[2 * j] = bf16_lo(w[j]); o[2 * j + 1] = bf16_hi(w[j]); }
}
__device__ __forceinline__ f32x16 mfma32(bf16x8 a, bf16x8 b, f32x16 c) { return __builtin_amdgcn_mfma_f32_32x32x16_bf16(a, b, c, 0, 0, 0); }
__device__ __forceinline__ f32x16 zero16() { f32x16 z; for (int i = 0; i < 16; ++i) z[i] = 0.f; return z; }
__device__ __forceinline__ void um8(const bf16_t* urow  , bool has_prev, const float* mu, float (&o)[8]) {
    const u32x4 c = *(const u32x4*)urow; u32x4 pv = (u32x4){0u, 0u, 0u, 0u}; if (has_prev) pv = *(const u32x4*)(urow - NIN);
    const f32x4 m0 = *(const f32x4*)mu, m1 = *(const f32x4*)(mu + 4);
    float cv[8], pf[8]; f8_from_bf16(c, cv); f8_from_bf16(pv, pf);
#pragma unroll
    for (int j = 0; j < 4; ++j) { o[j] = cv[j] + (pf[j] - cv[j]) * m0[j]; o[4 + j] = cv[4 + j] + (pf[4 + j] - cv[4 + j]) * m1[j]; }
}
__device__ __forceinline__ void lerp8(const u32x4 c, const u32x4 pv, const LAS float* mu, float (&o)[8]) {
    const f32x4 m0 = *(const LAS f32x4*)mu, m1 = *(const LAS f32x4*)(mu + 4);
    float cv[8], pf[8]; f8_from_bf16(c, cv); f8_from_bf16(pv, pf);
#pragma unroll
    for (int j = 0; j < 4; ++j) { o[j] = cv[j] + (pf[j] - cv[j]) * m0[j]; o[4 + j] = cv[4 + j] + (pf[4 + j] - cv[4 + j]) * m1[j]; }
}
__device__ __forceinline__ void lerp8(const u32x4 c, const u32x4 pv, const float* mu, float (&o)[8]) {
    const f32x4 m0 = *(const f32x4*)mu, m1 = *(const f32x4*)(mu + 4);
    float cv[8], pf[8]; f8_from_bf16(c, cv); f8_from_bf16(pv, pf);
#pragma unroll
    for (int j = 0; j < 4; ++j) { o[j] = cv[j] + (pf[j] - cv[j]) * m0[j]; o[4 + j] = cv[4 + j] + (pf[4 + j] - cv[4 + j]) * m1[j]; }
}
__device__ __forceinline__ float scan32(float x) {
    x += dppf<0x111>(x); x += dppf<0x112>(x); x += dppf<0x114>(x); x += dppf<0x118>(x);
    const float bc = __builtin_bit_cast(float, __builtin_amdgcn_update_dpp(0, __builtin_bit_cast(int, x), 0x142, 0xA, 0xF, false));
    return x + bc;
}

__device__ __forceinline__ void rk_produce(const Params& p, LAS unsigned char* lds, LAS unsigned char* pl  , unsigned char* slot, int b, int hh, int c) {
    using namespace rk;
    int lane = threadIdx.x & 63; asm volatile("" : "+v"(lane));
    const int r32 = lane & 31, h = lane >> 5;
    const bf16_t* u = (const bf16_t*)(p.ws + WS_A);
    const size_t row0 = (size_t)b * S; const int t0 = c * C; const int tt = t0 + r32; const bool hp = tt > 0;
    const bf16_t* urow = u + (row0 + tt) * NIN;
    const LAS float* cst = (const LAS float*)(lds + L_CST);
    const int jrow0 = 32 * ((r32 >> 2) & 1) + (r32 & 3) + 4 * (r32 >> 3);
    f32x16 lw[2], la[2], lg[2];
#pragma unroll
    for (int mt = 0; mt < 2; ++mt) { lw[mt] = zero16(); la[mt] = zero16(); lg[mt] = zero16(); }
    const int cb = hh * HD + 32 * h;
    u32x4 ck[4], pk4[4], cr[4], pr4[4];
    {
        const bf16_t* act = (const bf16_t*)((const unsigned char*)p.out + ACT_OFF) + (row0 + tt) * 256 + 8 * h;
        u32x4 bw[4], ba[4], bg[8];
#pragma unroll
        for (int s = 0; s < 4; ++s) { bw[s] = *(const u32x4*)(act + 16 * s); ba[s] = *(const u32x4*)(act + 64 + 16 * s); }
#pragma unroll
        for (int s = 0; s < 8; ++s) bg[s] = *(const u32x4*)(act + 128 + 16 * s);
        {
            bf16x8 fw[2][4];
#pragma unroll
            for (int mt = 0; mt < 2; ++mt)
#pragma unroll
                for (int s = 0; s < 4; ++s) { const int jl = jrow0 + 16 * mt; fw[mt][s] = *(const LAS bf16x8*)(lds + L_W2 + jl * 128 + (((2 * s + h) ^ (jl & 7)) << 4)); }
#pragma unroll
            for (int s = 0; s < 4; ++s)
#pragma unroll
                for (int mt = 0; mt < 2; ++mt) lw[mt] = mfma32(fw[mt][s], __builtin_bit_cast(bf16x8, bw[s]), lw[mt]);
        }
        {
            bf16x8 fa[2][4];
#pragma unroll
            for (int mt = 0; mt < 2; ++mt)
#pragma unroll
                for (int s = 0; s < 4; ++s) { const int jl = jrow0 + 16 * mt; fa[mt][s] = *(const LAS bf16x8*)(lds + L_A2 + jl * 128 + (((2 * s + h) ^ (jl & 7)) << 4)); }
#pragma unroll
            for (int s = 0; s < 4; ++s)
#pragma unroll
                for (int mt = 0; mt < 2; ++mt) la[mt] = mfma32(fa[mt][s], __builtin_bit_cast(bf16x8, ba[s]), la[mt]);
        }
        asm volatile("" ::: "memory");
#pragma unroll
        for (int half = 0; half < 2; ++half) {
            bf16x8 fg[2][4];
#pragma unroll
            for (int mt = 0; mt < 2; ++mt)
#pragma unroll
                for (int s4 = 0; s4 < 4; ++s4) { const int s = 4 * half + s4, jl = jrow0 + 16 * mt; fg[mt][s4] = *(const LAS bf16x8*)(lds + L_G2 + jl * 256 + (((2 * s + h) ^ (jl & 7)) << 4)); }
#pragma unroll
            for (int s4 = 0; s4 < 4; ++s4)
#pragma unroll
                for (int mt = 0; mt < 2; ++mt) lg[mt] = mfma32(fg[mt][s4], __builtin_bit_cast(bf16x8, bg[4 * half + s4]), lg[mt]);
        }
        asm volatile("" ::: "memory");
#pragma unroll
        for (int q = 0; q < 4; ++q) { const bf16_t* a = urow + URK + cb + 8 * q; const bf16_t* bq = urow + UR + cb + 8 * q;
            ck[q] = *(const u32x4*)a; cr[q] = *(const u32x4*)bq; pk4[q] = (u32x4){0u, 0u, 0u, 0u}; pr4[q] = pk4[q];
            if (hp) { pk4[q] = *(const u32x4*)(a - NIN); pr4[q] = *(const u32x4*)(bq - NIN); } }
    }
#pragma unroll
    for (int mt = 0; mt < 2; ++mt) {
        u32x4 w0, w1; w0.x = cvt_pk_bf16(lg[mt][0], lg[mt][1]); w0.y = cvt_pk_bf16(lg[mt][2], lg[mt][3]); w0.z = cvt_pk_bf16(lg[mt][4], lg[mt][5]); w0.w = cvt_pk_bf16(lg[mt][6], lg[mt][7]);
        w1.x = cvt_pk_bf16(lg[mt][8], lg[mt][9]); w1.y = cvt_pk_bf16(lg[mt][10], lg[mt][11]); w1.z = cvt_pk_bf16(lg[mt][12], lg[mt][13]); w1.w = cvt_pk_bf16(lg[mt][14], lg[mt][15]);
        *(u32x4*)(slot + SL_GW + (2 * mt) * 1024 + lane * 16) = w0; *(u32x4*)(slot + SL_GW + (2 * mt + 1) * 1024 + lane * 16) = w1;
    }
    asm volatile("" ::: "memory");
    float ssq = 0.f;
#pragma unroll
    for (int q = 0; q < 4; ++q) {
        float t8[8]; lerp8(ck[q], pk4[q], cst + C_MUK + 32 * h + 8 * q, t8);
        const f32x4 c0 = *(const LAS f32x4*)(cst + C_KK + 32 * h + 8 * q), c1 = *(const LAS f32x4*)(cst + C_KK + 32 * h + 8 * q + 4);
#pragma unroll
        for (int j = 0; j < 4; ++j) { const float x0 = t8[j] * c0[j], x1 = t8[4 + j] * c1[j]; ssq += x0 * x0 + x1 * x1; }
    }
    ssq += swap32(ssq);
    const float kinv = frsq(fmaxf(ssq, 1e-24f));
    float bonus = 0.f;
    LAS unsigned char* mAT = pl + PM_AT; LAS unsigned char* mRT = pl + PM_RT; LAS unsigned char* mBT = pl + PM_BT; LAS unsigned char* mKT = pl + PM_KT;
    LAS float* gc = (LAS float*)(pl + PM_GC);
#pragma unroll
    for (int mt = 0; mt < 2; ++mt) {
#pragma unroll
        for (int q8 = 0; q8 < 2; ++q8) {
            const int jl0 = 32 * h + 16 * mt + 8 * q8, q = 2 * mt + q8;
            float k8[8], r8[8];
            lerp8(ck[q], pk4[q], cst + C_MUK + jl0, k8);
            lerp8(cr[q], pr4[q], cst + C_MUR + jl0, r8);
            float cw0[8], ca0[8], ckk[8], cka[8], crk[8];
#pragma unroll
            for (int e = 0; e < 2; ++e) { const f32x4 a = *(const LAS f32x4*)(cst + C_W0 + jl0 + 4 * e), bq = *(const LAS f32x4*)(cst + C_A0 + jl0 + 4 * e), cc = *(const LAS f32x4*)(cst + C_KK + jl0 + 4 * e), dd = *(const LAS f32x4*)(cst + C_KA + jl0 + 4 * e), ee = *(const LAS f32x4*)(cst + C_RK + jl0 + 4 * e);
#pragma unroll
                for (int j = 0; j < 4; ++j) { cw0[4 * e + j] = a[j]; ca0[4 * e + j] = bq[j]; ckk[4 * e + j] = cc[j]; cka[4 * e + j] = dd[j]; crk[4 * e + j] = ee[j]; } }
            float oa[8], orr[8], ob[8], ok[8];
#pragma unroll
            for (int e = 0; e < 8; ++e) {
                const int reg = 8 * q8 + e;
                const float xw = cw0[e] + lw[mt][reg];
                const float spn = fmaxf(-xw, 0.f) + LN2 * flog2(1.0f + fexp2(-fabsf(xw) * LOG2E));
                const float ld = -fexp2((-spn - 0.5f) * LOG2E);
                const float al = frcp(1.0f + fexp2(-(ca0[e] + la[mt][reg]) * LOG2E));
                const float kk = k8[e] * ckk[e] * kinv;
                const float kmod = k8[e] * (1.0f + (al - 1.0f) * cka[e]);
                const float bb = kk * al;
                bonus += r8[e] * kmod * crk[e];
                const float G = scan32(ld);
                const float eG = fexp2(G * LOG2E), eGm = fexp2((G - ld) * LOG2E), eiG = fexp2(-G * LOG2E);
                oa[e] = -kk * eGm; orr[e] = r8[e] * eG; ob[e] = bb * eiG; ok[e] = kmod * eiG;
                if (r32 == 31) gc[32 * h + 16 * mt + reg] = eG;
            }
            const int off = r32 * MSTR + (32 * h + 16 * mt + 8 * q8) * 2;
            *(LAS u32x4*)(mAT + off) = (u32x4){cvt_pk_bf16(oa[0], oa[1]), cvt_pk_bf16(oa[2], oa[3]), cvt_pk_bf16(oa[4], oa[5]), cvt_pk_bf16(oa[6], oa[7])};
            *(LAS u32x4*)(mRT + off) = (u32x4){cvt_pk_bf16(orr[0], orr[1]), cvt_pk_bf16(orr[2], orr[3]), cvt_pk_bf16(orr[4], orr[5]), cvt_pk_bf16(orr[6], orr[7])};
            *(LAS u32x4*)(mBT + off) = (u32x4){cvt_pk_bf16(ob[0], ob[1]), cvt_pk_bf16(ob[2], ob[3]), cvt_pk_bf16(ob[4], ob[5]), cvt_pk_bf16(ob[6], ob[7])};
            *(LAS u32x4*)(mKT + off) = (u32x4){cvt_pk_bf16(ok[0], ok[1]), cvt_pk_bf16(ok[2], ok[3]), cvt_pk_bf16(ok[4], ok[5]), cvt_pk_bf16(ok[6], ok[7])};
            asm volatile("" ::: "memory");
        }
    }
    bonus += swap32(bonus);
    u32x4 cv4[4], pv4[4];
#pragma unroll
    for (int q = 0; q < 4; ++q) { const bf16_t* cq = urow + URV + cb + 8 * q; cv4[q] = *(const u32x4*)cq; pv4[q] = (u32x4){0u, 0u, 0u, 0u}; if (hp) pv4[q] = *(const u32x4*)(cq - NIN); }
#pragma unroll
    for (int q = 0; q < 4; ++q) {
        float v8[8]; lerp8(cv4[q], pv4[q], cst + C_MUV + 32 * h + 8 * q, v8);
        *(u32x4*)(slot + SL_VR + q * 1024 + lane * 16) = (u32x4){cvt_pk_bf16(v8[0], v8[1]), cvt_pk_bf16(v8[2], v8[3]), cvt_pk_bf16(v8[4], v8[5]), cvt_pk_bf16(v8[6], v8[7])};
        const f32x4 b0 = *(const LAS f32x4*)(cst + C_LNB + 32 * h + 8 * q), b1 = *(const LAS f32x4*)(cst + C_LNB + 32 * h + 8 * q + 4);
        float gb[8];
#pragma unroll
        for (int e = 0; e < 8; ++e) gb[e] = (e < 4 ? b0[e] : b1[e - 4]) + bonus * v8[e];
        *(u32x4*)(slot + SL_GB + q * 1024 + lane * 16) = (u32x4){cvt_pk_bf16(gb[0], gb[1]), cvt_pk_bf16(gb[2], gb[3]), cvt_pk_bf16(gb[4], gb[5]), cvt_pk_bf16(gb[6], gb[7])};
    }
    LDS_WAIT();
    f32x16 nab = zero16(), nabT = zero16(), nakT = zero16(), mbr = zero16(), mkr = zero16();
#pragma unroll
    for (int s = 0; s < 4; ++s) {
        const int off = r32 * MSTR + (16 * s + 8 * h) * 2;
        const bf16x8 fa = *(const LAS bf16x8*)(mAT + off), fr = *(const LAS bf16x8*)(mRT + off), fb = *(const LAS bf16x8*)(mBT + off), fk = *(const LAS bf16x8*)(mKT + off);
        nab = mfma32(fb, fa, nab); nabT = mfma32(fa, fb, nabT); nakT = mfma32(fa, fk, nakT); mbr = mfma32(fb, fr, mbr); mkr = mfma32(fk, fr, mkr);
    }
#pragma unroll
    for (int reg = 0; reg < 16; ++reg) {
        const int row = (reg & 3) + 8 * (reg >> 2) + 4 * h;
        nab[reg] = row < r32 ? nab[reg] : 0.f;
        nabT[reg] = r32 < row ? nabT[reg] : 0.f;
        nakT[reg] = r32 < row ? nakT[reg] : 0.f;
        mbr[reg] = row <= r32 ? mbr[reg] : 0.f;
        mkr[reg] = row <= r32 ? mkr[reg] : 0.f;
    }
    f32x16 Y = nab;
#pragma unroll
    for (int reg = 0; reg < 16; ++reg) { const int row = (reg & 3) + 8 * (reg >> 2) + 4 * h; if (row == r32) Y[reg] += 1.0f; }
    {
        f32x16 M = nab, MT = nabT;
#pragma unroll
        for (int lvl = 0; lvl < 4; ++lvl) {
            const bf16x8 m0 = accfrag(M, 0), m1 = accfrag(M, 1), t0f = accfrag(MT, 0), t1f = accfrag(MT, 1);
            f32x16 M2T = mfma32(m0, t0f, zero16()); M2T = mfma32(m1, t1f, M2T);
            f32x16 M2 = zero16();
            if (lvl < 3) { M2 = mfma32(t0f, m0, M2); M2 = mfma32(t1f, m1, M2); }
            const bf16x8 y0 = accfrag(Y, 0), y1 = accfrag(Y, 1);
            Y = mfma32(accfrag(M2T, 0), y0, Y); Y = mfma32(accfrag(M2T, 1), y1, Y);
            M = M2; MT = M2T;
        }
    }
    int lane5 = lane; asm volatile("" : "+v"(lane5));
    const int r5 = lane5 & 31, h5 = lane5 >> 5;
    const bf16x8 ty0 = accfrag(Y, 0), ty1 = accfrag(Y, 1);
    f32x16 paT[2];
#pragma unroll
    for (int nt = 0; nt < 2; ++nt) { paT[nt] = mfma32(ty0, trfrag(mAT, 0, nt, lane5), zero16()); paT[nt] = mfma32(ty1, trfrag(mAT, 1, nt, lane5), paT[nt]); }
    f32x16 qakT = mfma32(ty0, accfrag(nakT, 0), zero16()); qakT = mfma32(ty1, accfrag(nakT, 1), qakT);
    const bf16x8 mb0 = accfrag(mbr, 0), mb1 = accfrag(mbr, 1);
#pragma unroll
    for (int mt = 0; mt < 2; ++mt) {
        f32x16 po;
#pragma unroll
        for (int g = 0; g < 4; ++g) { const u32x2 w = *(const LAS u32x2*)(mRT + r5 * MSTR + (32 * mt + 8 * g + 4 * h5) * 2);
            po[4 * g] = bf16_lo(w.x); po[4 * g + 1] = bf16_hi(w.x); po[4 * g + 2] = bf16_lo(w.y); po[4 * g + 3] = bf16_hi(w.y); }
        po = mfma32(accfrag(paT[mt], 0), mb0, po); po = mfma32(accfrag(paT[mt], 1), mb1, po);
#pragma unroll
        for (int sp = 0; sp < 2; ++sp)
            *(u32x4*)(slot + SL_PO + (2 * mt + sp) * 1024 + lane5 * 16) = (u32x4){cvt_pk_bf16(po[8 * sp], po[8 * sp + 1]), cvt_pk_bf16(po[8 * sp + 2], po[8 * sp + 3]), cvt_pk_bf16(po[8 * sp + 4], po[8 * sp + 5]), cvt_pk_bf16(po[8 * sp + 6], po[8 * sp + 7])};
    }
    {
        f32x16 qo = mfma32(accfrag(qakT, 0), mb0, mkr); qo = mfma32(accfrag(qakT, 1), mb1, qo);
#pragma unroll
        for (int sp = 0; sp < 2; ++sp) *(u32x4*)(slot + SL_QO + sp * 1024 + lane5 * 16) = (u32x4){cvt_pk_bf16(qo[8 * sp], qo[8 * sp + 1]), cvt_pk_bf16(qo[8 * sp + 2], qo[8 * sp + 3]), cvt_pk_bf16(qo[8 * sp + 4], qo[8 * sp + 5]), cvt_pk_bf16(qo[8 * sp + 6], qo[8 * sp + 7])};
    }
#pragma unroll
    for (int nt = 0; nt < 2; ++nt) {
        const bf16x8 bt0 = trfrag(mBT, 0, nt, lane5), bt1 = trfrag(mBT, 1, nt, lane5);
        const float gam = gc[32 * nt + r5];
#pragma unroll
        for (int mt = 0; mt < 2; ++mt) {
            f32x16 ps = zero16();
            if (mt == nt) {
#pragma unroll
                for (int reg = 0; reg < 16; ++reg) { const int row = (reg & 3) + 8 * (reg >> 2) + 4 * h5; ps[reg] = (row == r5) ? 1.0f : 0.f; }
            }
            ps = mfma32(accfrag(paT[mt], 0), bt0, ps); ps = mfma32(accfrag(paT[mt], 1), bt1, ps);
#pragma unroll
            for (int sp = 0; sp < 2; ++sp)
                *(u32x4*)(slot + SL_PS + ((nt * 2 + mt) * 2 + sp) * 1024 + lane5 * 16) = (u32x4){cvt_pk_bf16(ps[8 * sp] * gam, ps[8 * sp + 1] * gam), cvt_pk_bf16(ps[8 * sp + 2] * gam, ps[8 * sp + 3] * gam), cvt_pk_bf16(ps[8 * sp + 4] * gam, ps[8 * sp + 5] * gam), cvt_pk_bf16(ps[8 * sp + 6] * gam, ps[8 * sp + 7] * gam)};
        }
        f32x16 qs;
        { const bf16x8 k0 = trfrag(mKT, 0, nt, lane5), k1 = trfrag(mKT, 1, nt, lane5);
          const u32x4 w0 = __builtin_bit_cast(u32x4, k0), w1 = __builtin_bit_cast(u32x4, k1);
#pragma unroll
          for (int j = 0; j < 4; ++j) { qs[2 * j] = bf16_lo(w0[j]); qs[2 * j + 1] = bf16_hi(w0[j]); qs[8 + 2 * j] = bf16_lo(w1[j]); qs[8 + 2 * j + 1] = bf16_hi(w1[j]); } }
        qs = mfma32(accfrag(qakT, 0), bt0, qs); qs = mfma32(accfrag(qakT, 1), bt1, qs);
#pragma unroll
        for (int sp = 0; sp < 2; ++sp) *(u32x4*)(slot + SL_QS + (nt * 2 + sp) * 1024 + lane5 * 16) = (u32x4){cvt_pk_bf16(qs[8 * sp] * gam, qs[8 * sp + 1] * gam), cvt_pk_bf16(qs[8 * sp + 2] * gam, qs[8 * sp + 3] * gam), cvt_pk_bf16(qs[8 * sp + 4] * gam, qs[8 * sp + 5] * gam), cvt_pk_bf16(qs[8 * sp + 6] * gam, qs[8 * sp + 7] * gam)};
    }
    LDS_WAIT();
}

__device__ __forceinline__ u32x4 ntload16(const void* ptr) { return __builtin_nontemporal_load((const u32x4*)ptr); }
struct RkOps { u32x4 vr[4]; bf16x8 fps[2][2][2], fqs[2][2], fpo[2][2], fqo[2]; };
__device__ __forceinline__ void rk_load_ops_a(RkOps& o, const unsigned char* slot, int lane) {
    using namespace rk;
    const int r32 = lane & 31, h = lane >> 5;
#pragma unroll
    for (int k = 0; k < 4; ++k) o.vr[k] = ntload16(slot + SL_VR + k * 1024 + lane * 16);
#pragma unroll
    for (int jt = 0; jt < 2; ++jt)
#pragma unroll
        for (int s = 0; s < 2; ++s) o.fpo[jt][s] = __builtin_bit_cast(bf16x8, ntload16(slot + SL_PO + (2 * jt + s) * 1024 + lane * 16));
#pragma unroll
    for (int s = 0; s < 2; ++s) o.fqo[s] = __builtin_bit_cast(bf16x8, ntload16(slot + SL_QO + s * 1024 + lane * 16));
}
__device__ __forceinline__ void rk_load_ops_b(RkOps& o, const unsigned char* slot, int lane) {
    using namespace rk;
    const int r32 = lane & 31, h = lane >> 5;
#pragma unroll
    for (int mt = 0; mt < 2; ++mt) {
#pragma unroll
        for (int jt = 0; jt < 2; ++jt)
#pragma unroll
            for (int s = 0; s < 2; ++s) o.fps[mt][jt][s] = __builtin_bit_cast(bf16x8, ntload16(slot + SL_PS + ((mt * 2 + jt) * 2 + s) * 1024 + lane * 16));
#pragma unroll
        for (int s = 0; s < 2; ++s) o.fqs[mt][s] = __builtin_bit_cast(bf16x8, ntload16(slot + SL_QS + (mt * 2 + s) * 1024 + lane * 16));
    }
}
#define RK_SPIN(cond) do { unsigned _sp = 0; while (cond) { __builtin_amdgcn_s_sleep(1); if (++_sp > (1u << 24)) { err[0] = 1u; break; } } asm volatile("" ::: "memory"); } while (0)

__device__ __forceinline__ void rwkv_chain(const Params& p, LAS unsigned char* lds, int b, int hh) {
    using namespace rk;
    int tid = threadIdx.x; asm volatile("" : "+v"(tid));
    volatile LAS unsigned* ready = (volatile LAS unsigned*)(lds + L_FLAG); volatile LAS unsigned* freed = ready + NSLOT; volatile LAS unsigned* ofull = freed + NSLOT; volatile LAS unsigned* ofree = ofull + 2; volatile LAS unsigned* err = ofree + 2;
    if (tid < 2 * NSLOT + 5) ready[tid] = 0u;
    {
        const bf16_t* w2t = (const bf16_t*)(p.ws + WS_LT); const bf16_t* a2t = w2t + 512 * 64; const bf16_t* g2t = a2t + 512 * 64;
        for (int i = tid; i < 64 * 8; i += NTHREADS) { const int j = i >> 3, ch = i & 7, d = j * 128 + ((ch ^ (j & 7)) << 4);
            *(LAS u32x4*)(lds + L_W2 + d) = *(const u32x4*)(w2t + (hh * HD + j) * 64 + 8 * ch); *(LAS u32x4*)(lds + L_A2 + d) = *(const u32x4*)(a2t + (hh * HD + j) * 64 + 8 * ch); }
        for (int i = tid; i < 64 * 16; i += NTHREADS) { const int j = i >> 4, ch = i & 15; *(LAS u32x4*)(lds + L_G2 + j * 256 + ((ch ^ (j & 7)) << 4)) = *(const u32x4*)(g2t + (hh * HD + j) * 128 + 8 * ch); }
        LAS float* cst = (LAS float*)(lds + L_CST);
        for (int i = tid; i < C_END; i += NTHREADS) { float v;
            if (i < 256) v = p.shift_mu[(UXW - UR) + i];
            else if (i < 320) v = p.shift_mu[hh * HD + (i - 256)];
            else if (i < 384) v = p.shift_mu[(URK - UR) + hh * HD + (i - 320)];
            else if (i < 448) v = p.shift_mu[(URV - UR) + hh * HD + (i - 384)];
            else if (i < 512) v = p.rw_w0[hh * HD + (i - 448)];
            else if (i < 576) v = p.rw_a0[hh * HD + (i - 512)];
            else if (i < 640) v = p.rw_k_k[hh * HD + (i - 576)];
            else if (i < 704) v = p.rw_k_a[hh * HD + (i - 640)];
            else if (i < 768) v = p.rw_r_k[hh * HD + (i - 704)];
            else v = p.rw_ln_b[hh * HD + (i - 768)];
            cst[i] = v; }
    }
    __syncthreads();
    asm volatile("" : "+v"(tid));
    const int wave = __builtin_amdgcn_readfirstlane(tid >> 6);
    unsigned char* ring = (unsigned char*)p.out + (size_t)(b * NH + hh) * NSLOT * SLOT_BYTES;
    if (wave == 0) {
        int lane = tid & 63; asm volatile("" : "+v"(lane));
        const int r32 = lane & 31, h = lane >> 5;
        LAS unsigned char* vs = lds + L_CONS;
        f32x16 st[2][2];
#pragma unroll
        for (int a = 0; a < 2; ++a)
#pragma unroll
            for (int d = 0; d < 2; ++d) st[a][d] = zero16();
        RkOps ops;
        RK_SPIN(ready[0] != 1u);
        rk_load_ops_a(ops, ring, lane); rk_load_ops_b(ops, ring, lane);
        for (int c = 0; c < NCH; ++c) {
            bf16x8 sf[2][2][2];
#pragma unroll
            for (int jt = 0; jt < 2; ++jt)
#pragma unroll
                for (int it = 0; it < 2; ++it) { sf[jt][it][0] = accfrag(st[jt][it], 0); sf[jt][it][1] = accfrag(st[jt][it], 1); }
            { LAS unsigned char* d = vs + r32 * MSTR + h * 64;
              *(LAS u32x4*)d = ops.vr[0]; *(LAS u32x4*)(d + 16) = ops.vr[1]; *(LAS u32x4*)(d + 32) = ops.vr[2]; *(LAS u32x4*)(d + 48) = ops.vr[3]; }
            LDS_WAIT();
            bf16x8 vf[2][2];
            { const int g = lane >> 4, i16 = lane & 15, q = i16 >> 2, pp = i16 & 3;
#pragma unroll
              for (int it = 0; it < 2; ++it)
#pragma unroll
                  for (int s = 0; s < 2; ++s) { const LAS unsigned char* a = vs + (16 * s + 4 * h + q) * MSTR + (32 * it + 16 * (g & 1) + 4 * pp) * 2;
                      const s16x4 x = lds_tr16(a), y = lds_tr16(a + 8 * MSTR);
                      bf16x8 r; r[0] = x[0]; r[1] = x[1]; r[2] = x[2]; r[3] = x[3]; r[4] = y[0]; r[5] = y[1]; r[6] = y[2]; r[7] = y[3]; vf[it][s] = r; } }
            f32x16 o[2];
#pragma unroll
            for (int it = 0; it < 2; ++it) {
                o[it] = zero16();
#pragma unroll
                for (int jt = 0; jt < 2; ++jt)
#pragma unroll
                    for (int s = 0; s < 2; ++s) o[it] = mfma32(sf[jt][it][s], ops.fpo[jt][s], o[it]);
#pragma unroll
                for (int s = 0; s < 2; ++s) o[it] = mfma32(vf[it][s], ops.fqo[s], o[it]);
            }
            const unsigned char* nslot = ring + (size_t)((c + 1) % NSLOT) * SLOT_BYTES;
            if (c + 1 < NCH) { RK_SPIN(ready[(c + 1) % NSLOT] != (unsigned)(c + 2)); rk_load_ops_a(ops, nslot, lane); }
#pragma unroll
            for (int mt = 0; mt < 2; ++mt)
#pragma unroll
                for (int it = 0; it < 2; ++it) {
                    f32x16 a = zero16();
#pragma unroll
                    for (int jt = 0; jt < 2; ++jt)
#pragma unroll
                        for (int s = 0; s < 2; ++s) a = mfma32(ops.fps[mt][jt][s], sf[jt][it][s], a);
#pragma unroll
                    for (int s = 0; s < 2; ++s) a = mfma32(ops.fqs[mt][s], vf[it][s], a);
                    st[mt][it] = a;
                }
            if (c + 1 < NCH) rk_load_ops_b(ops, nslot, lane);
            if (c >= 1) RK_SPIN(ofree[0] != (unsigned)c);
            { LAS unsigned char* ob = lds + L_OBUF + r32 * OSTR;
#pragma unroll
              for (int it = 0; it < 2; ++it)
#pragma unroll
                  for (int g = 0; g < 4; ++g) *(LAS f32x4*)(ob + (32 * it + 8 * g + 4 * h) * 4) = (f32x4){o[it][4 * g], o[it][4 * g + 1], o[it][4 * g + 2], o[it][4 * g + 3]}; }
            LDS_WAIT();
            if (lane == 0) ofull[0] = (unsigned)(c + 1);
        }
    } else if (wave == 1) {
        int lane = tid & 63; asm volatile("" : "+v"(lane));
        const int r32 = lane & 31, h = lane >> 5;
        u32x4 gw[4], gb[4];
        RK_SPIN(ready[0] != 1u);
#pragma unroll
        for (int k = 0; k < 4; ++k) { gw[k] = ntload16(ring + SL_GW + k * 1024 + lane * 16); gb[k] = ntload16(ring + SL_GB + k * 1024 + lane * 16); }
        for (int c = 0; c < NCH; ++c) {
            const int sl = c % NSLOT;
            RK_SPIN(ofull[0] != (unsigned)(c + 1));
            float ov[32];
            { const LAS unsigned char* ob = lds + L_OBUF + r32 * OSTR + 128 * h;
#pragma unroll
              for (int k = 0; k < 8; ++k) { const f32x4 x = *(const LAS f32x4*)(ob + 16 * k); ov[4 * k] = x[0]; ov[4 * k + 1] = x[1]; ov[4 * k + 2] = x[2]; ov[4 * k + 3] = x[3]; } }
            LDS_WAIT();
            if (lane == 0) ofree[0] = (unsigned)(c + 1);
            float sm = 0.f;
#pragma unroll
            for (int k = 0; k < 32; ++k) sm += ov[k];
            sm += swap32(sm);
            const float mean = sm * (1.0f / 64.0f);
            float sv = 0.f;
#pragma unroll
            for (int k = 0; k < 32; ++k) { const float d = ov[k] - mean; sv += d * d; }
            sv += swap32(sv);
            const float rstd = 1.0f / sqrtf(sv * (1.0f / 64.0f) + 64e-5f);
            bf16_t* mrow = (bf16_t*)(p.ws + WS_B) + ((size_t)b * S + c * C + r32) * D + 512 + hh * HD + 32 * h;
#pragma unroll
            for (int k = 0; k < 4; ++k) {
                float w8[8], b8[8], r[8]; f8_from_bf16(gw[k], w8); f8_from_bf16(gb[k], b8);
                const f32x4 l0 = *(const f32x4*)(p.rw_ln_w + hh * HD + 32 * h + 8 * k), l1 = *(const f32x4*)(p.rw_ln_w + hh * HD + 32 * h + 8 * k + 4);
#pragma unroll
                for (int e = 0; e < 8; ++e) r[e] = ((ov[8 * k + e] - mean) * rstd * (e < 4 ? l0[e] : l1[e - 4]) + b8[e]) * w8[e];
                *(u32x4*)(mrow + 8 * k) = (u32x4){cvt_pk_bf16(r[0], r[1]), cvt_pk_bf16(r[2], r[3]), cvt_pk_bf16(r[4], r[5]), cvt_pk_bf16(r[6], r[7])};
            }
            if (lane == 0) freed[sl] = (unsigned)(c + 1);
            if (c + 1 < NCH) { const int sn = (c + 1) % NSLOT; const unsigned char* sp_ = ring + (size_t)sn * SLOT_BYTES; RK_SPIN(ready[sn] != (unsigned)(c + 2));
#pragma unroll
                for (int k = 0; k < 4; ++k) { gw[k] = ntload16(sp_ + SL_GW + k * 1024 + lane * 16); gb[k] = ntload16(sp_ + SL_GB + k * 1024 + lane * 16); } }
        }
    } else {
        int lane = tid & 63;
        if (wave - 2 < NPROD) for (int c = wave - 2; c < NCH; c += NPROD) {
            const int sl = c % NSLOT;
            if (c >= NSLOT) RK_SPIN(freed[sl] != (unsigned)(c - NSLOT + 1));
            rk_produce(p, lds, lds + (wave - 2) * PROD_LDS, ring + (size_t)sl * SLOT_BYTES, b, hh, c);
            asm volatile("s_waitcnt vmcnt(0)" ::: "memory");
            if (lane == 0) ready[sl] = (unsigned)(c + 1);
        }
    }
    __syncthreads();
}

#ifdef RWDEBUG
namespace rw {
constexpr int CH = 16;
constexpr int O_UM = 0;
constexpr int O_LW = O_UM + CH * 448 * 4;
constexpr int O_LA = O_LW + CH * 64 * 4;
constexpr int O_LG0 = O_LA + CH * 64 * 4;
constexpr int O_LG1 = O_LG0 + CH * 64 * 4;
constexpr int O_A1 = O_LG1 + CH * 64 * 4;
constexpr int O_R1 = O_A1 + CH * 64 * 4;
constexpr int O_B1 = O_R1 + CH * 64 * 4;
constexpr int O_K1 = O_B1 + CH * 64 * 4;
constexpr int O_O = O_K1 + CH * 64 * 4;
constexpr int O_WT = O_O + CH * 64 * 4;
constexpr int O_GC = O_WT + 8 * 64 * 4;
constexpr int O_SC = O_GC + 64 * 4;
constexpr int O_END = O_SC + 3 * 16 * 4;
}
__device__ __forceinline__ bf16x8 ldw_frag(const float* W, int ldw, int m0, int col) {
    unsigned w[4];
#pragma unroll
    for (int j = 0; j < 4; ++j) w[j] = cvt_pk_bf16(W[(size_t)(m0 + 2 * j) * ldw + col], W[(size_t)(m0 + 2 * j + 1) * ldw + col]);
    return __builtin_bit_cast(bf16x8, (u32x4){w[0], w[1], w[2], w[3]});
}
template <int ACT>
__device__ __forceinline__ bf16x8 act_frag(const LAS float* src) {
    const f32x4 a = *(const LAS f32x4*)src, b = *(const LAS f32x4*)(src + 4); float v[8] = {a[0], a[1], a[2], a[3], b[0], b[1], b[2], b[3]};
#pragma unroll
    for (int j = 0; j < 8; ++j) {
        if (ACT == 1) v[j] = 1.0f - 2.0f * frcp(1.0f + fexp2(v[j] * (2.0f * LOG2E)));
        if (ACT == 2) v[j] = frcp(1.0f + fexp2(-v[j] * LOG2E));
    }
    return __builtin_bit_cast(bf16x8, (u32x4){cvt_pk_bf16(v[0], v[1]), cvt_pk_bf16(v[2], v[3]), cvt_pk_bf16(v[4], v[5]), cvt_pk_bf16(v[6], v[7])});
}

__device__ __forceinline__ void rwkv_chain_seq(const Params& p, LAS unsigned char* lds, int b, int h, bf16_t* mix, int nchunks) {
    using namespace rw;
    const int tid = threadIdx.x, wave = __builtin_amdgcn_readfirstlane(tid >> 6), lane = tid & 63;
    const bf16_t* u = (const bf16_t*)(p.ws + WS_A);
    const size_t row0 = (size_t)b * S;
    LAS float* UM = (LAS float*)(lds + O_UM); LAS float* LW = (LAS float*)(lds + O_LW); LAS float* LA = (LAS float*)(lds + O_LA);
    LAS float* LG0 = (LAS float*)(lds + O_LG0); LAS float* LG1 = (LAS float*)(lds + O_LG1);
    LAS float* A1 = (LAS float*)(lds + O_A1); LAS float* R1 = (LAS float*)(lds + O_R1); LAS float* B1 = (LAS float*)(lds + O_B1); LAS float* K1 = (LAS float*)(lds + O_K1);
    LAS float* OO = (LAS float*)(lds + O_O); LAS float* WT = (LAS float*)(lds + O_WT); LAS float* GC = (LAS float*)(lds + O_GC); LAS float* SC = (LAS float*)(lds + O_SC);
    const int fc = lane & 15, fq = lane >> 4;
    bf16x8 bwa[2], bg[2];
    { const float* W = wave < 4 ? p.rw_w2 : p.rw_a2; const int col = h * HD + 16 * (wave & 3) + fc;
      bwa[0] = ldw_frag(W, 512, 8 * fq, col); bwa[1] = ldw_frag(W, 512, 32 + 8 * fq, col);
      const int ks = (wave >> 2) * 2; bg[0] = ldw_frag(p.rw_g2, 512, 32 * ks + 8 * fq, col); bg[1] = ldw_frag(p.rw_g2, 512, 32 * (ks + 1) + 8 * fq, col); }
    const int hj = h * HD + lane;
    const float c_w0 = p.rw_w0[hj], c_a0 = p.rw_a0[hj], c_kk = p.rw_k_k[hj], c_ka = p.rw_k_a[hj], c_rk = p.rw_r_k[hj], c_lnw = p.rw_ln_w[hj], c_lnb = p.rw_ln_b[hj];
    int ld_t[2], ld_c[2], ld_uc[2]; bool ld_ok[2];
#pragma unroll
    for (int r = 0; r < 2; ++r) { const int gid = tid + 512 * r; ld_ok[r] = gid < CH * 56; const int t = gid / 56, cg8 = gid % 56; ld_t[r] = t; ld_c[r] = cg8 * 8;
        ld_uc[r] = cg8 < 8 ? UR + h * HD + 8 * cg8 : cg8 < 16 ? URK + h * HD + 8 * (cg8 - 8) : cg8 < 24 ? URV + h * HD + 8 * (cg8 - 16) : UXW + 8 * (cg8 - 24); }
    const int si = 8 * wave + (lane >> 3), sj = 8 * (lane & 7);
    float st[8];
#pragma unroll
    for (int n = 0; n < 8; ++n) st[n] = 0.f;
    u32x4 cur[2], prv[2];
    auto issue_loads = [&](int t0) {
#pragma unroll
        for (int r = 0; r < 2; ++r) { cur[r] = (u32x4){0u, 0u, 0u, 0u}; prv[r] = (u32x4){0u, 0u, 0u, 0u};
            if (ld_ok[r]) { const int tt = t0 + ld_t[r]; const bf16_t* a = u + (row0 + tt) * NIN + ld_uc[r]; cur[r] = *(const u32x4*)a; if (tt > 0) prv[r] = *(const u32x4*)(a - NIN); } }
    };
    issue_loads(0);
    for (int c = 0; c < nchunks; ++c) {
        const int t0 = c * CH;
#pragma unroll
        for (int r = 0; r < 2; ++r) if (ld_ok[r]) {
            const float* mu = p.shift_mu + (ld_uc[r] - UR); const f32x4 m0 = *(const f32x4*)mu, m1 = *(const f32x4*)(mu + 4);
            float cv[8], pv[8];
#pragma unroll
            for (int j = 0; j < 4; ++j) { cv[2 * j] = bf16_lo(cur[r][j]); cv[2 * j + 1] = bf16_hi(cur[r][j]); pv[2 * j] = bf16_lo(prv[r][j]); pv[2 * j + 1] = bf16_hi(prv[r][j]); }
            f32x4 o0, o1;
#pragma unroll
            for (int j = 0; j < 4; ++j) { o0[j] = cv[j] + (pv[j] - cv[j]) * m0[j]; o1[j] = cv[4 + j] + (pv[4 + j] - cv[4 + j]) * m1[j]; }
            LAS float* d = UM + ld_t[r] * 448 + ld_c[r]; *(LAS f32x4*)d = o0; *(LAS f32x4*)(d + 4) = o1;
        }
        if (c + 1 < S / CH) issue_loads(t0 + CH);
        __syncthreads();
        {
            f32x4 acc = (f32x4){0.f, 0.f, 0.f, 0.f};
            const LAS float* src = UM + fc * 448 + (wave < 4 ? 192 : 256) + 8 * fq;
            if (wave < 4) { acc = __builtin_amdgcn_mfma_f32_16x16x32_bf16(act_frag<1>(src), bwa[0], acc, 0, 0, 0); acc = __builtin_amdgcn_mfma_f32_16x16x32_bf16(act_frag<1>(src + 32), bwa[1], acc, 0, 0, 0); }
            else          { acc = __builtin_amdgcn_mfma_f32_16x16x32_bf16(act_frag<0>(src), bwa[0], acc, 0, 0, 0); acc = __builtin_amdgcn_mfma_f32_16x16x32_bf16(act_frag<0>(src + 32), bwa[1], acc, 0, 0, 0); }
            LAS float* dst = (wave < 4 ? LW : LA) + 16 * (wave & 3) + fc;
#pragma unroll
            for (int r = 0; r < 4; ++r) dst[(4 * fq + r) * 64] = acc[r];
            f32x4 ag = (f32x4){0.f, 0.f, 0.f, 0.f};
            const LAS float* sg = UM + fc * 448 + 320 + 64 * (wave >> 2) + 8 * fq;
            ag = __builtin_amdgcn_mfma_f32_16x16x32_bf16(act_frag<2>(sg), bg[0], ag, 0, 0, 0); ag = __builtin_amdgcn_mfma_f32_16x16x32_bf16(act_frag<2>(sg + 32), bg[1], ag, 0, 0, 0);
            LAS float* dg = (wave < 4 ? LG0 : LG1) + 16 * (wave & 3) + fc;
#pragma unroll
            for (int r = 0; r < 4; ++r) dg[(4 * fq + r) * 64] = ag[r];
        }
        __syncthreads();
        float e_kk[2], e_b[2], e_k[2], e_r[2], e_ld[2];
#pragma unroll
        for (int tt = 0; tt < 2; ++tt) {
            const int t = 2 * wave + tt;
            const float xw = c_w0 + LW[t * 64 + lane];
            const float spn = (fmaxf(-xw, 0.f) + LN2 * flog2(1.0f + fexp2(-fabsf(xw) * LOG2E)));
            e_ld[tt] = -fexp2((-spn - 0.5f) * LOG2E);
            const float a = frcp(1.0f + fexp2(-(c_a0 + LA[t * 64 + lane]) * LOG2E));
            const float kraw = UM[t * 448 + 64 + lane], r = UM[t * 448 + lane];
            const float kkv = kraw * c_kk; const float ssq = wave_sum(kkv * kkv);
            const float kk = kkv * frsq(fmaxf(ssq, 1e-24f));
            const float kmod = kraw * (1.0f + (a - 1.0f) * c_ka);
            const float bb = kk * a;
            const float cbr = wave_sum(bb * r), ckr = wave_sum(kmod * r), bon = wave_sum(r * kmod * c_rk);
            if (lane == 0) { SC[t] = cbr; SC[16 + t] = ckr; SC[32 + t] = bon; }
            e_kk[tt] = kk; e_b[tt] = bb; e_k[tt] = kmod; e_r[tt] = r;
        }
        WT[wave * 64 + lane] = e_ld[0] + e_ld[1];
        __syncthreads();
        {
            float off = 0.f, tot = 0.f;
#pragma unroll
            for (int w = 0; w < 8; ++w) { const float x = WT[w * 64 + lane]; if (w < wave) off += x; tot += x; }
            const float c0 = off + e_ld[0], c1 = c0 + e_ld[1];
            const int t = 2 * wave;
            A1[t * 64 + lane] = -e_kk[0] * fexp2(off * LOG2E);       A1[(t + 1) * 64 + lane] = -e_kk[1] * fexp2(c0 * LOG2E);
            R1[t * 64 + lane] = e_r[0] * fexp2(c0 * LOG2E);          R1[(t + 1) * 64 + lane] = e_r[1] * fexp2(c1 * LOG2E);
            const float i0 = fexp2(-c0 * LOG2E), i1 = fexp2(-c1 * LOG2E);
            B1[t * 64 + lane] = e_b[0] * i0;                          B1[(t + 1) * 64 + lane] = e_b[1] * i1;
            K1[t * 64 + lane] = e_k[0] * i0;                          K1[(t + 1) * 64 + lane] = e_k[1] * i1;
            if (wave == 0) GC[lane] = fexp2(tot * LOG2E);
        }
        __syncthreads();
#pragma unroll 4
        for (int t = 0; t < CH; ++t) {
            const f32x4 a0 = *(const LAS f32x4*)(A1 + t * 64 + sj), a1 = *(const LAS f32x4*)(A1 + t * 64 + sj + 4);
            const f32x4 r0 = *(const LAS f32x4*)(R1 + t * 64 + sj), r1 = *(const LAS f32x4*)(R1 + t * 64 + sj + 4);
            const f32x4 b0 = *(const LAS f32x4*)(B1 + t * 64 + sj), b1 = *(const LAS f32x4*)(B1 + t * 64 + sj + 4);
            const f32x4 k0 = *(const LAS f32x4*)(K1 + t * 64 + sj), k1 = *(const LAS f32x4*)(K1 + t * 64 + sj + 4);
            const float v = UM[t * 448 + 128 + si], cbr = SC[t], ckr = SC[16 + t];
            float sa = (st[0] * a0[0] + st[1] * a0[1]) + (st[2] * a0[2] + st[3] * a0[3]) + ((st[4] * a1[0] + st[5] * a1[1]) + (st[6] * a1[2] + st[7] * a1[3]));
            float pp = (st[0] * r0[0] + st[1] * r0[1]) + (st[2] * r0[2] + st[3] * r0[3]) + ((st[4] * r1[0] + st[5] * r1[1]) + (st[6] * r1[2] + st[7] * r1[3]));
            sa = sum8(sa); pp = sum8(pp);
            if ((lane & 7) == 0) OO[t * 64 + si] = pp + sa * cbr + v * ckr;
#pragma unroll
            for (int n = 0; n < 4; ++n) { st[n] += sa * b0[n] + v * k0[n]; st[4 + n] += sa * b1[n] + v * k1[n]; }
        }
        {
            const f32x4 g0 = *(const LAS f32x4*)(GC + sj), g1 = *(const LAS f32x4*)(GC + sj + 4);
#pragma unroll
            for (int n = 0; n < 4; ++n) { st[n] *= g0[n]; st[4 + n] *= g1[n]; }
        }
        __syncthreads();
#pragma unroll
        for (int tt = 0; tt < 2; ++tt) {
            const int t = 2 * wave + tt;
            const float o = OO[t * 64 + lane];
            const float mean = wave_sum(o) * (1.0f / 64.0f); const float dlt = o - mean;
            const float var = wave_sum(dlt * dlt) * (1.0f / 64.0f);
            const float gn = dlt * (1.0f / sqrtf(var + 64e-5f)) * c_lnw + c_lnb;
            const float res = (gn + SC[32 + t] * UM[t * 448 + 128 + lane]) * (LG0[t * 64 + lane] + LG1[t * 64 + lane]);
            mix[(row0 + t0 + t) * D + 512 + h * HD + lane] = (bf16_t)(cvt_pk_bf16(res, 0.f) & 0xffffu);
        }
        __syncthreads();
    }
}

#endif

__device__ __forceinline__ void phase2a(const Params& p) {
    int tid = threadIdx.x; asm volatile("" : "+v"(tid));
    const int wave = tid >> 6, lane = tid & 63;
    const bf16_t* u = (const bf16_t*)(p.ws + WS_A);
    bf16_t* act = (bf16_t*)((unsigned char*)p.out + ACT_OFF);
    const f32x4 mu = *(const f32x4*)(p.shift_mu + (UXW - UR) + 4 * lane);
    for (int row = blockIdx.x * NWAVES + wave; row < T; row += gridDim.x * NWAVES) {
        const bf16_t* a = u + (size_t)row * NIN + UXW + 4 * lane;
        const u32x2 c = *(const u32x2*)a; u32x2 pv = (u32x2){0u, 0u}; if ((row & (S - 1)) != 0) pv = *(const u32x2*)(a - NIN);
        const float cv[4] = {bf16_lo(c.x), bf16_hi(c.x), bf16_lo(c.y), bf16_hi(c.y)}, pf[4] = {bf16_lo(pv.x), bf16_hi(pv.x), bf16_lo(pv.y), bf16_hi(pv.y)};
        float x[4];
#pragma unroll
        for (int j = 0; j < 4; ++j) { x[j] = cv[j] + (pf[j] - cv[j]) * mu[j];
            if (lane < 16) x[j] = 1.0f - 2.0f * frcp(1.0f + fexp2(x[j] * (2.0f * LOG2E)));
            else if (lane >= 32) x[j] = frcp(1.0f + fexp2(-x[j] * LOG2E)); }
        *(u32x2*)(act + (size_t)row * 256 + 4 * lane) = (u32x2){cvt_pk_bf16(x[0], x[1]), cvt_pk_bf16(x[2], x[3])};
    }
}

__device__ __forceinline__ void phase2(const Params& p, LAS unsigned char* lds) {
    const int nchain = NB * NH, G = gridDim.x, wave = threadIdx.x >> 6;
    const int nscan = G >= 2 * nchain ? nchain : (G > 1 ? G / 2 : 0);
    if ((int)blockIdx.x < nscan || nscan == 0) {
        const int stride = nscan == 0 ? G : nscan;
        for (int it = blockIdx.x; it < nchain; it += stride) rwkv_chain(p, lds, it / NH, it % NH);
    }
    if ((int)blockIdx.x >= nscan) {
        const int nb = G - nscan, bi = blockIdx.x - nscan;
        for (int it = bi * 8 + wave; it < NB * NH * 64; it += nb * 8) attn_tile(p, lds + wave * 4608, it / (NH * 64), (it / 64) % NH, 63 - (it % 64));
        __syncthreads();
        p0_expert_weights(p, lds, bi * 8 + wave, nb * 8);
    }
}

struct EpiH {
    const float* x; float* hout; int row0, col0;
    __device__ __forceinline__ void operator()(const f32x4 (&acc)[2][2][4][2], int wr, int wc, int fr, int fq) const {
#pragma unroll
        for (int ai = 0; ai < 2; ++ai)
#pragma unroll
            for (int m = 0; m < 4; ++m) { const size_t off = (size_t)(row0 + ai * 128 + wr * 64 + m * 16 + fr) * D + col0 + wc * 32 + 8 * fq;
#pragma unroll
                for (int bj = 0; bj < 2; ++bj)
#pragma unroll
                    for (int n = 0; n < 2; ++n) { const f32x4 xv = *(const f32x4*)(x + off + bj * 128 + n * 4); *(f32x4*)(hout + off + bj * 128 + n * 4) = xv + acc[ai][bj][m][n]; } }
    }
};
__device__ __forceinline__ void phase3(const Params& p, LAS unsigned char* lds) {
    constexpr int nM = T / 256, nN = D / 256;
    unsigned aoff[2][2]; g8::aoff_rows(aoff, D);
    for (int L = blockIdx.x; L < nM * nN; L += gridDim.x) {
        int pm, pn; g8::tile_order(L, nM, nN, pm, pn);
        EpiH E{p.x, p.out, pm * 256, pn * 256};
        g8::gemm_unit(lds, (const char*)(p.ws + WS_B) + (size_t)pm * 256 * D * 2, aoff, (const char*)(p.ws + WS_WOUT) + (size_t)pn * 256 * D * 2, D, E);
    }
}

__device__ __forceinline__ void phase4(const Params& p, LAS unsigned char* lds) {
    int tid = threadIdx.x; asm volatile("" : "+v"(tid));
    const int wave = tid >> 6, lane = tid & 63, fr = lane & 15, fq = lane >> 4;
    const float* hsrc = p.out; bf16_t* hb = (bf16_t*)(p.ws + WS_A); float* rstd2 = (float*)(p.ws + WS_RSTD2);
    const bf16_t* wr_hi = (const bf16_t*)(p.ws + WS_WR); const bf16_t* wr_lo = wr_hi + 48 * D;
    int* list = (int*)(p.ws + WS_LIST); float* listw = (float*)(p.ws + WS_LISTW); unsigned* cnt = (unsigned*)(p.ws + WS_CTL);
    LAS float* lg = (LAS float*)(lds + wave * 3072);
    LAS unsigned* lcnt = (LAS unsigned*)(lds + 8 * 3072);
    LAS unsigned* gbase = lcnt + 32;
    for (int blk = blockIdx.x; blk < T / 128; blk += gridDim.x) {
        if (tid < 32) lcnt[tid] = 0u;
        __syncthreads();
        const int tok0 = blk * 128 + wave * 16;
        f32x4 acc[3];
#pragma unroll
        for (int n = 0; n < 3; ++n) acc[n] = (f32x4){0.f, 0.f, 0.f, 0.f};
        float ss = 0.f;
        const float* hp = hsrc + (size_t)(tok0 + fr) * D + 8 * fq; bf16_t* hbp = hb + (size_t)(tok0 + fr) * D + 8 * fq;
        LAS unsigned char* wl_ = lds + 32768;
#pragma unroll 1
        for (int half = 0; half < 2; ++half) {
            __syncthreads();
            for (int i = tid; i < 2 * 48 * 64; i += NTHREADS) { const int mat = i / 3072, r = (i % 3072) >> 6, ch = i & 63;
                *(LAS u32x4*)(wl_ + mat * 49152 + r * 1024 + ((ch ^ (r & 15)) << 4)) = *(const u32x4*)((mat ? wr_lo : wr_hi) + (size_t)r * D + half * 512 + ch * 8); }
            f32x4 av[16][2];
#pragma unroll
            for (int ks = 0; ks < 16; ++ks) { av[ks][0] = *(const f32x4*)(hp + half * 512 + 32 * ks); av[ks][1] = *(const f32x4*)(hp + half * 512 + 32 * ks + 4); }
            __syncthreads();
#pragma unroll
            for (int ks = 0; ks < 16; ++ks) {
                const f32x4 v0 = av[ks][0], v1 = av[ks][1];
                ss += (v0[0] * v0[0] + v0[1] * v0[1]) + (v0[2] * v0[2] + v0[3] * v0[3]) + ((v1[0] * v1[0] + v1[1] * v1[1]) + (v1[2] * v1[2] + v1[3] * v1[3]));
                u32x4 hi; hi.x = cvt_pk_bf16(v0[0], v0[1]); hi.y = cvt_pk_bf16(v0[2], v0[3]); hi.z = cvt_pk_bf16(v1[0], v1[1]); hi.w = cvt_pk_bf16(v1[2], v1[3]);
                *(u32x4*)(hbp + half * 512 + 32 * ks) = hi;
                u32x4 lo; lo.x = cvt_pk_bf16(v0[0] - bf16_lo(hi.x), v0[1] - bf16_hi(hi.x)); lo.y = cvt_pk_bf16(v0[2] - bf16_lo(hi.y), v0[3] - bf16_hi(hi.y));
                lo.z = cvt_pk_bf16(v1[0] - bf16_lo(hi.z), v1[1] - bf16_hi(hi.z)); lo.w = cvt_pk_bf16(v1[2] - bf16_lo(hi.w), v1[3] - bf16_hi(hi.w));
                const bf16x8 ah = __builtin_bit_cast(bf16x8, hi), al = __builtin_bit_cast(bf16x8, lo);
#pragma unroll
                for (int n = 0; n < 3; ++n) {
                    const int r = 16 * n + fr, off = r * 1024 + (((4 * ks + fq) ^ (r & 15)) << 4);
                    const bf16x8 wh = *(const LAS bf16x8*)(wl_ + off), wl = *(const LAS bf16x8*)(wl_ + 49152 + off);
                    acc[n] = __builtin_amdgcn_mfma_f32_16x16x32_bf16(ah, wh, acc[n], 0, 0, 0);
                    acc[n] = __builtin_amdgcn_mfma_f32_16x16x32_bf16(al, wh, acc[n], 0, 0, 0);
                    acc[n] = __builtin_amdgcn_mfma_f32_16x16x32_bf16(ah, wl, acc[n], 0, 0, 0);
                }
            }
        }
        ss += __shfl_xor(ss, 16); ss += __shfl_xor(ss, 32);
        const float rs = 1.0f / sqrtf(ss * (1.0f / D) + 1e-6f);
        if (fq == 0) rstd2[tok0 + fr] = rs;
#pragma unroll
        for (int n = 0; n < 3; ++n)
#pragma unroll
            for (int r = 0; r < 4; ++r) lg[(4 * fq + r) * 48 + 16 * n + fr] = acc[n][r];
        LDS_WAIT();
        int e0 = 0, e1 = 0; float w0 = 0.f, w1 = 0.f; unsigned lp0 = 0, lp1 = 0;
        if (lane < 16) {
            const float rst = rs;
            const LAS float* L = lg + lane * 48;
            float gl[4]; int gi = 0; float gm;
#pragma unroll
            for (int g = 0; g < 4; ++g) gl[g] = L[g] * rst + p.r_grp_b[g];
            gm = gl[0];
#pragma unroll
            for (int g = 1; g < 4; ++g) if (gl[g] > gm) { gm = gl[g]; gi = g; }
            float gs = 0.f;
#pragma unroll
            for (int g = 0; g < 4; ++g) gs += __expf(gl[g] - gm);
            const float gval = 1.0f / gs;
            float el[8];
#pragma unroll
            for (int e = 0; e < 8; ++e) el[e] = L[4 + gi * 8 + e] * rst + p.r_exp_b[gi * 8 + e];
            int i0 = 0; float m0 = el[0];
#pragma unroll
            for (int e = 1; e < 8; ++e) if (el[e] > m0) { m0 = el[e]; i0 = e; }
            int i1 = i0 == 0 ? 1 : 0; float m1 = el[i1];
#pragma unroll
            for (int e = 0; e < 8; ++e) if (e != i0 && el[e] > m1) { m1 = el[e]; i1 = e; }
            const float x1 = __expf(m1 - m0); const float den = 1.0f / (1.0f + x1);
            e0 = gi * 8 + i0; e1 = gi * 8 + i1; w0 = gval * den; w1 = gval * x1 * den;
            lp0 = atomicAdd((unsigned*)&lcnt[e0], 1u); lp1 = atomicAdd((unsigned*)&lcnt[e1], 1u);
        }
        __syncthreads();
        if (tid < 32) gbase[tid] = atomicAdd(&cnt[tid], lcnt[tid]);
        __syncthreads();
        if (lane < 16) {
            const int tok = tok0 + lane;
            const unsigned q0 = gbase[e0] + lp0, q1 = gbase[e1] + lp1;
            list[(size_t)e0 * T + q0] = tok * 2;     listw[(size_t)e0 * T + q0] = w0;
            list[(size_t)e1 * T + q1] = tok * 2 + 1; listw[(size_t)e1 * T + q1] = w1;
        }
        __syncthreads();
    }
}

constexpr int LDS_MAP = 161792;
__device__ __forceinline__ void expert_map_build(const unsigned* cnt, LAS unsigned char* lds) {
    LAS int* pre = (LAS int*)(lds + LDS_MAP); LAS int* cn = pre + 40;
    if (threadIdx.x == 0) { int acc = 0; for (int i = 0; i < NE; ++i) { const int ci = (int)__hip_atomic_load(cnt + i, __ATOMIC_RELAXED, __HIP_MEMORY_SCOPE_AGENT); pre[i] = acc; cn[i] = ci; acc += (ci + 255) >> 8; } pre[NE] = acc; }
    __syncthreads();
}
__device__ __forceinline__ void expert_find(LAS unsigned char* lds, int mt, int& e, int& local, int& c) {
    const LAS int* pre = (const LAS int*)(lds + LDS_MAP); const LAS int* cn = pre + 40;
    int lo = 0;
#pragma unroll 1
    for (int i = 1; i < NE; ++i) if (pre[i] <= mt) lo = i;
    e = __builtin_amdgcn_readfirstlane(lo); local = mt - __builtin_amdgcn_readfirstlane(pre[e]); c = __builtin_amdgcn_readfirstlane(cn[e]);
}
__device__ __forceinline__ int expert_tiles(LAS unsigned char* lds) { return __builtin_amdgcn_readfirstlane(((const LAS int*)(lds + LDS_MAP))[NE]); }

struct EpiGU {
    bf16_t* hid; const float* rstd2; const int* lst; int cnt, p0, hrow0, ct;
    __device__ __forceinline__ void operator()(const f32x4 (&acc)[2][2][4][2], int wr, int wc, int fr, int fq) const {
#pragma unroll
        for (int ai = 0; ai < 2; ++ai)
#pragma unroll
            for (int m = 0; m < 4; ++m) { const int r = ai * 128 + wr * 64 + m * 16 + fr; const int pp = p0 + r;
                const float rs = pp < cnt ? rstd2[lst[pp] >> 1] : 0.f;
                bf16_t* op = hid + (size_t)(hrow0 + r) * DE + ct * 128 + wc * 32 + 8 * fq;
                float o[8];
#pragma unroll
                for (int n = 0; n < 2; ++n) { const f32x4 g = acc[ai][0][m][n] * rs, uu = acc[ai][1][m][n] * rs;
#pragma unroll
                    for (int j = 0; j < 4; ++j) o[4 * n + j] = g[j] * frcp(1.0f + fexp2(-g[j] * LOG2E)) * uu[j]; }
                *(u32x4*)op = (u32x4){cvt_pk_bf16(o[0], o[1]), cvt_pk_bf16(o[2], o[3]), cvt_pk_bf16(o[4], o[5]), cvt_pk_bf16(o[6], o[7])}; }
    }
};
__device__ __forceinline__ void phase5(const Params& p, LAS unsigned char* lds) {
    expert_map_build((const unsigned*)(p.ws + WS_CTL), lds);
    const int MT = expert_tiles(lds);
    const int tid = threadIdx.x;
    for (int unit = blockIdx.x; unit < MT * 2; unit += gridDim.x) {
        const int mt = unit >> 1, ct = unit & 1; int e, local, c; expert_find(lds, mt, e, local, c);
        const int* lst = (const int*)(p.ws + WS_LIST) + (size_t)e * T; const int p0 = local * 256;
        unsigned aoff[2][2];
#pragma unroll
        for (int i = 0; i < 2; ++i) { int R, C; g8::stage_rc(tid * 16 + i * 8192, R, C);
#pragma unroll
            for (int hh = 0; hh < 2; ++hh) { const int pp = p0 + hh * 128 + R; const int tok = pp < c ? (lst[pp] >> 1) : 0; aoff[hh][i] = (unsigned)(tok * D + C) * 2u; } }
        EpiGU E{(bf16_t*)(p.ws + WS_B), (const float*)(p.ws + WS_RSTD2), lst, c, p0, mt * 256, ct};
        g8::gemm_unit(lds, (const char*)(p.ws + WS_A), aoff, (const char*)(p.ws + WS_WGU) + ((size_t)e * 512 + ct * 256) * D * 2, D, E);
    }
}
struct EpiDN {
    bf16_t* y; bf16_t* dummy; const int* lst; const float* lw; int cnt, p0, col0;
    __device__ __forceinline__ void operator()(const f32x4 (&acc)[2][2][4][2], int wr, int wc, int fr, int fq) const {
#pragma unroll
        for (int ai = 0; ai < 2; ++ai)
#pragma unroll
            for (int m = 0; m < 4; ++m) { const int pp = p0 + ai * 128 + wr * 64 + m * 16 + fr;
                const bool ok = pp < cnt; const int ent = lst[pp]; const float w = lw[pp];
                bf16_t* op = (ok ? y + ((size_t)(ent & 1) * T + (ent >> 1)) * D : dummy) + col0 + wc * 32 + 8 * fq;
#pragma unroll
                for (int bj = 0; bj < 2; ++bj) { const f32x4 v0 = acc[ai][bj][m][0] * w, v1 = acc[ai][bj][m][1] * w;
                    *(u32x4*)(op + bj * 128) = (u32x4){cvt_pk_bf16(v0[0], v0[1]), cvt_pk_bf16(v0[2], v0[3]), cvt_pk_bf16(v1[0], v1[1]), cvt_pk_bf16(v1[2], v1[3])}; }
                if (m & 1) asm volatile("" ::: "memory"); }
    }
};
__device__ __forceinline__ void phase6(const Params& p, LAS unsigned char* lds) {
    expert_map_build((const unsigned*)(p.ws + WS_CTL), lds);
    const int MT = expert_tiles(lds);
    constexpr int kdn = DE;
    unsigned aoff[2][2]; g8::aoff_rows(aoff, kdn);
    for (int unit = blockIdx.x; unit < MT * 4; unit += gridDim.x) {
        const int mt = unit >> 2, pn = unit & 3; int e, local, c; expert_find(lds, mt, e, local, c);
        EpiDN E{(bf16_t*)(p.ws + WS_A + (size_t)T * D * 2), (bf16_t*)(p.ws + WS_A + (size_t)3 * T * D * 2), (const int*)(p.ws + WS_LIST) + (size_t)e * T, (const float*)(p.ws + WS_LISTW) + (size_t)e * T, c, local * 256, pn * 256};
        g8::gemm_unit(lds, (const char*)(p.ws + WS_B) + (size_t)mt * 256 * DE * 2, aoff, (const char*)(p.ws + WS_WDN) + ((size_t)e * D + pn * 256) * DE * 2, kdn, E);
    }
}

__device__ __forceinline__ void phase7(const Params& p) {
    int tid7 = threadIdx.x; asm volatile("" : "+v"(tid7));
    const int wave = tid7 >> 6, lane = tid7 & 63;
    const bf16_t* y0 = (const bf16_t*)(p.ws + WS_A + (size_t)T * D * 2); const bf16_t* y1 = y0 + (size_t)T * D;
    f32x4 g[4];
#pragma unroll
    for (int j = 0; j < 4; ++j) g[j] = *((const f32x4*)p.final_g + lane + 64 * j);
    for (int row = blockIdx.x * NWAVES + wave; row < T; row += gridDim.x * NWAVES) {
        f32x4* hr = (f32x4*)(p.out + (size_t)row * D) + lane; const u32x2* a = (const u32x2*)(y0 + (size_t)row * D) + lane; const u32x2* bq = (const u32x2*)(y1 + (size_t)row * D) + lane;
        f32x4 v[4]; float s = 0.f;
#pragma unroll
        for (int j = 0; j < 4; ++j) { v[j] = hr[64 * j]; const u32x2 ya = a[64 * j], yb = bq[64 * j];
            v[j][0] += bf16_lo(ya.x) + bf16_lo(yb.x); v[j][1] += bf16_hi(ya.x) + bf16_hi(yb.x); v[j][2] += bf16_lo(ya.y) + bf16_lo(yb.y); v[j][3] += bf16_hi(ya.y) + bf16_hi(yb.y);
            s += (v[j][0] * v[j][0] + v[j][1] * v[j][1]) + (v[j][2] * v[j][2] + v[j][3] * v[j][3]); }
        s = wave_sum(s);
        const float rs = 1.0f / sqrtf(s * (1.0f / D) + 1e-6f);
#pragma unroll
        for (int j = 0; j < 4; ++j) hr[64 * j] = v[j] * rs * g[j];
    }
}

__global__ __launch_bounds__(512) void mega(Params p) {
    extern __shared__ __attribute__((aligned(16))) unsigned char lds_raw[];
    LAS unsigned char* lds = (LAS unsigned char*)lds_raw;
    volatile LAS unsigned* bst = (volatile LAS unsigned*)(lds + LDS_MAP + 512);
    if (threadIdx.x == 0) { bst[0] = 0u; bst[1] = 0u; bst[2] = 0u; bst[3] = 0u; }
    __syncthreads();
    const XcdBarrier gb = xcd_barrier_post((unsigned*)(p.ws + WS_BAR), bst);
#define GSYNC() xcd_barrier(gb)
#ifndef PHASE_MASK
#define PHASE_MASK 0xff
#endif
#ifdef TPROBE
    volatile LAS unsigned long long* tsl = (volatile LAS unsigned long long*)(lds + LDS_MAP + 640);
    if (threadIdx.x == 0) tsl[0] = __builtin_amdgcn_s_memrealtime();
#define TS(i) do { if (threadIdx.x == 0 && ((i) == TPROBE || (i) == TPROBE + 1)) tsl[i] = __builtin_amdgcn_s_memrealtime(); } while (0)
#else
#define TS(i)
#endif
    if (PHASE_MASK & 1) phase0(p, lds); GSYNC(); TS(1);
    if (PHASE_MASK & 2) phase1(p, lds); GSYNC(); TS(2);
    if (PHASE_MASK & 4) { phase2a(p); GSYNC(); phase2(p, lds); } GSYNC(); TS(3);
#ifdef RWDEBUG
    {
        bf16_t* dbg = (bf16_t*)(p.ws + WS_A + (size_t)3 * T * D * 2 + 4096);
        float* red = (float*)(p.ws + WS_CTL + 2048);
        if (blockIdx.x == 0) {
            rwkv_chain_seq(p, lds, RWDEBUG_B, RWDEBUG_H, dbg - (size_t)RWDEBUG_B * S * D, 2 * RWDEBUG_C1);
            __syncthreads();
            const bf16_t* mix = (const bf16_t*)(p.ws + WS_B);
            float md = 0.f, mr = 0.f; int bad = 0;
            for (int i = threadIdx.x; i < (RWDEBUG_C1 - RWDEBUG_C0) * 32 * 64; i += NTHREADS) {
                const int t = RWDEBUG_C0 * 32 + i / 64, col = 512 + RWDEBUG_H * 64 + (i % 64);
                const float a = __uint_as_float((unsigned)mix[((size_t)RWDEBUG_B * S + t) * D + col] << 16), r = __uint_as_float((unsigned)dbg[(size_t)t * D + col] << 16);
                if (!(fabsf(a) < 1e30f)) bad++;
                else { md = fmaxf(md, fabsf(a - r)); } mr = fmaxf(mr, fabsf(r));
            }
            LAS float* sh = (LAS float*)lds;
            sh[threadIdx.x] = md; sh[512 + threadIdx.x] = mr; sh[1024 + threadIdx.x] = (float)bad; __syncthreads();
            if (threadIdx.x == 0) { float a = 0.f, r = 0.f, nb = 0.f; for (int i = 0; i < NTHREADS; ++i) { a = fmaxf(a, sh[i]); r = fmaxf(r, sh[512 + i]); nb += sh[1024 + i]; }
                float rel = a / fmaxf(r, 1e-20f); float code = nb > 0.f ? 40.0f : (rel < 0.03f ? 5.0f : (rel < 0.3f ? 10.0f : 20.0f));
                red[0] = code; }
        }
        GSYNC();
        const float code = ((const float*)(p.ws + WS_CTL + 2048))[0];
        for (size_t i = (size_t)blockIdx.x * NTHREADS + threadIdx.x; i < (size_t)T * D; i += (size_t)gridDim.x * NTHREADS) p.out[i] = code;
        return;
    }
#endif
    if (PHASE_MASK & 8) phase3(p, lds); GSYNC(); TS(4);
    if (PHASE_MASK & 16) phase4(p, lds); GSYNC(); TS(5);
    if (PHASE_MASK & 32) phase5(p, lds); GSYNC(); TS(6);
    if (PHASE_MASK & 64) phase6(p, lds); GSYNC(); TS(7);
    if (PHASE_MASK & 128) phase7(p);
#ifdef TPROBE
    GSYNC(); TS(8);
    float* tw = (float*)(p.ws + WS_CTL + 1024);
    if (blockIdx.x == 0 && threadIdx.x == 0) { const float t1 = (float)(tsl[TPROBE + 1] - tsl[TPROBE]) * 0.01f; tw[0] = floorf(log2f(t1) * TPQ + 0.5f) / TPQ; }
    GSYNC();
    const float c1 = tw[0];
    int tq_ = threadIdx.x; asm volatile("" : "+v"(tq_));
    for (size_t i = (size_t)blockIdx.x * NTHREADS + tq_; i < (size_t)T * D; i += (size_t)gridDim.x * NTHREADS) p.out[i] = c1;
#endif
}

extern "C" void kernel_launch(void* const* d_in, const int* in_sizes, int n_in, void* d_out, int out_size, void* d_ws, size_t ws_size, hipStream_t stream) {
    static int grid = 0;
    if (grid == 0) {
        if (n_in != 25 || out_size != T * D || ws_size < WS_END) { fprintf(stderr, "kernel_launch: unexpected sizes n_in %d out %d ws %zu (need %zu)\n", n_in, out_size, ws_size, (size_t)WS_END); grid = -1; return; }
        int dev = 0, cus = 0, per_cu = 0;
        (void)hipGetDevice(&dev); (void)hipDeviceGetAttribute(&cus, hipDeviceAttributeMultiprocessorCount, dev);
        if (hipFuncSetAttribute((const void*)mega, hipFuncAttributeMaxDynamicSharedMemorySize, LDS_BYTES) != hipSuccess) { fprintf(stderr, "kernel_launch: hipFuncSetAttribute failed\n"); grid = -1; return; }
        if (hipOccupancyMaxActiveBlocksPerMultiprocessor(&per_cu, (const void*)mega, NTHREADS, LDS_BYTES) != hipSuccess || per_cu < 1) { fprintf(stderr, "kernel_launch: occupancy query failed (%d)\n", per_cu); (void)hipGetLastError(); per_cu = 1; }
        grid = cus * 1;
    }
    if (grid < 0) return;
    Params p{};
    const float** f = (const float**)&p;
    for (int i = 0; i < 25; ++i) f[i] = (const float*)d_in[i];
    p.out = (float*)d_out; p.ws = (unsigned char*)d_ws;
    if (hipMemsetAsync((char*)d_ws + WS_BAR, 0, XCD_BAR_WORDS * 4, stream) != hipSuccess) { fprintf(stderr, "kernel_launch: memset failed\n"); return; }
    hipLaunchKernelGGL(mega, dim3(grid), dim3(NTHREADS), LDS_BYTES, stream, p);
    hipError_t e = hipPeekAtLastError();
    if (e != hipSuccess) fprintf(stderr, "launch failed: %s (grid %d)\n", hipGetErrorString(e), grid);
}
```

```cpp
#include <hip/hip_runtime.h>
#include <cstdio>
#include <cstdint>
#define TPQ 8.0f

#define LAS __attribute__((address_space(3)))
typedef unsigned short bf16_t;
typedef short bf16x8 __attribute__((ext_vector_type(8)));
typedef short s16x4 __attribute__((ext_vector_type(4)));
typedef float f32x4 __attribute__((ext_vector_type(4)));
typedef float f32x2 __attribute__((ext_vector_type(2)));
typedef float f32x16 __attribute__((ext_vector_type(16)));
typedef unsigned u32x2 __attribute__((ext_vector_type(2)));
typedef unsigned u32x4 __attribute__((ext_vector_type(4)));

constexpr int NB = 16, S = 2048, T = NB * S, D = 1024, NIN = 3328, NH = 8, HD = 64;
constexpr int UQ = 0, UK = 512, UV = 1024, UR = 1536, URK = 2048, URV = 2560, UXW = 3072, UXA = 3136, UXG = 3200;
constexpr int NE = 32, DE = 256;
constexpr float LOG2E = 1.4426950408889634f, LN2 = 0.6931471805599453f;
constexpr float QSCALE = 0.125f * LOG2E;
constexpr int NTHREADS = 512, NWAVES = 8;
constexpr int LDS_BYTES = 161792 + 1024;

constexpr size_t WS_CTL   = 0;
constexpr size_t WS_BAR   = 8192;
constexpr size_t WS_WIN   = 65536;
constexpr size_t WS_WOUT  = WS_WIN  + (size_t)NIN * D * 2;
constexpr size_t WS_WGU   = WS_WOUT + (size_t)D * D * 2;
constexpr size_t WS_WDN   = WS_WGU  + (size_t)NE * 512 * D * 2;
constexpr size_t WS_RSTD1 = WS_WDN  + (size_t)NE * D * DE * 2;
constexpr size_t WS_RSTD2 = WS_RSTD1 + (size_t)T * 4;
constexpr size_t WS_LIST  = WS_RSTD2 + (size_t)T * 4;
constexpr size_t WS_LISTW = WS_LIST + (size_t)NE * T * 4;
constexpr size_t WS_WR    = WS_LISTW + (size_t)NE * T * 4;
constexpr size_t WS_LT    = WS_WR + (size_t)2 * 48 * D * 2;
constexpr size_t WS_A     = WS_LT + (size_t)512 * 256 * 2;
constexpr size_t WS_B     = WS_A + (size_t)T * NIN * 2;
constexpr size_t WS_END   = WS_B + (size_t)T * D * 2;
constexpr int HID_ROWS = 2 * T + NE * 256;

struct Params {
    const float* x; const float* norm_mix_g; const float* w_in; const float* shift_mu; const float* sb_out_g;
    const float* rw_w0; const float* rw_w2; const float* rw_a0; const float* rw_a2; const float* rw_g2;
    const float* rw_k_k; const float* rw_k_a; const float* rw_r_k; const float* rw_ln_w; const float* rw_ln_b;
    const float* w_out; const float* norm_ffn_g; const float* r_grp_w; const float* r_grp_b; const float* r_exp_w; const float* r_exp_b;
    const float* w_gate; const float* w_up; const float* w_down; const float* final_g;
    float* out; unsigned char* ws;
};

typedef __bf16 bf16x2_t __attribute__((ext_vector_type(2)));
__device__ __forceinline__ unsigned cvt_pk_bf16(float lo, float hi) { const f32x2 v = {lo, hi}; return __builtin_bit_cast(unsigned, __builtin_convertvector(v, bf16x2_t)); }
__device__ __forceinline__ float bf16_lo(unsigned w) { return __uint_as_float(w << 16); }
__device__ __forceinline__ float bf16_hi(unsigned w) { return __uint_as_float(w & 0xffff0000u); }
__device__ __forceinline__ float fexp2(float x) { return __builtin_amdgcn_exp2f(x); }
__device__ __forceinline__ float flog2(float x) { return __builtin_amdgcn_logf(x); }
__device__ __forceinline__ float frcp(float x) { return __builtin_amdgcn_rcpf(x); }
__device__ __forceinline__ float frsq(float x) { return __builtin_amdgcn_rsqf(x); }
template <int CTRL> __device__ __forceinline__ float dppf(float v) { return __builtin_bit_cast(float, __builtin_amdgcn_update_dpp(0, __builtin_bit_cast(int, v), CTRL, 0xF, 0xF, true)); }
__device__ __forceinline__ float rlane(float v, int l) { return __builtin_bit_cast(float, __builtin_amdgcn_readlane(__builtin_bit_cast(int, v), l)); }
__device__ __forceinline__ float sum8(float v) { v += dppf<0xB1>(v); v += dppf<0x4E>(v); v += dppf<0x141>(v); return v; }
__device__ __forceinline__ float sum16(float v) { v = sum8(v); v += dppf<0x140>(v); return v; }
__device__ __forceinline__ float wave_sum(float v) { v = sum16(v); return (rlane(v, 0) + rlane(v, 16)) + (rlane(v, 32) + rlane(v, 48)); }
__device__ __forceinline__ float swap32(float v) { return __shfl_xor(v, 32); }
#define LDS_WAIT() asm volatile("s_waitcnt lgkmcnt(0)" ::: "memory")


#define XB_TMO      128
#define XB_XCNT(j)  (256  + 64 * (j))
#define XB_XSUB(j)  (1280 + 64 * (j))
#define XB_XGEN(j)  (2304 + 64 * (j))
#define XB_TOP      3328
#define XB_TOPGEN   3392
#define XCD_BAR_WORDS 3456
#define XB_SPIN_CAP (1u << 22)
__device__ __forceinline__ unsigned xb_ld(unsigned* p)              { return __hip_atomic_load(p, __ATOMIC_RELAXED, __HIP_MEMORY_SCOPE_AGENT); }
__device__ __forceinline__ unsigned xb_add(unsigned* p, unsigned v) { return __hip_atomic_fetch_add(p, v, __ATOMIC_RELAXED, __HIP_MEMORY_SCOPE_AGENT); }
__device__ __forceinline__ unsigned xb_xcc_id() { return (unsigned)__builtin_amdgcn_s_getreg((3 << 11) | 20) & 0xFu; }
#define XB_SPIN(cond, bar) do { unsigned _sp = 0; while (cond) { __builtin_amdgcn_s_sleep(1); \
    if ((++_sp & 255u) == 0u) { if (xb_ld(&(bar)[XB_TMO])) break; if (_sp > XB_SPIN_CAP) { atomicAdd(&(bar)[XB_TMO], 1u); break; } } } } while (0)
struct XcdBarrier { unsigned* bar; unsigned x; volatile LAS unsigned* st; };
__device__ __forceinline__ XcdBarrier xcd_barrier_post(unsigned* bar, volatile LAS unsigned* st) {
    XcdBarrier b; b.bar = bar; b.x = xb_xcc_id(); b.st = st;
    if (threadIdx.x == 0) (void)xb_add(&bar[XB_XCNT(b.x)], 1u);
    return b;
}
__device__ __forceinline__ void xcd_barrier_complete(unsigned* bar, unsigned x, unsigned& nloc, unsigned& nx) {
    const unsigned G = gridDim.x * gridDim.y * gridDim.z;
    unsigned sum, cnt, mine, sp = 0u;
    for (;;) {
        sum = 0u; cnt = 0u; mine = 0u;
#pragma unroll
        for (unsigned j = 0; j < 16; ++j) { const unsigned c = xb_ld(&bar[XB_XCNT(j)]); sum += c; cnt += (c > 0u) ? 1u : 0u; mine = (j == x) ? c : mine; }
        if (sum == G) break;
        __builtin_amdgcn_s_sleep(1);
        if ((++sp & 255u) == 0u) { if (xb_ld(&bar[XB_TMO])) break; if (sp > XB_SPIN_CAP) { atomicAdd(&bar[XB_TMO], 1u); break; } }
    }
    nloc = mine > 0u ? mine : 1u; nx = cnt > 0u ? cnt : 1u;
}
__device__ __forceinline__ void xcd_barrier(const XcdBarrier& b) {
    asm volatile("s_waitcnt vmcnt(0)" ::: "memory");
    __syncthreads();
    if (threadIdx.x == 0) {
        unsigned* bar = b.bar;
        __builtin_amdgcn_s_waitcnt(0);
        unsigned nloc = b.st[0], nx = b.st[1];
        if (nloc == 0u) { xcd_barrier_complete(bar, b.x, nloc, nx); b.st[0] = nloc; b.st[1] = nx; }
        const unsigned old = xb_add(&bar[XB_XSUB(b.x)], 1u);
        const unsigned gen = old / nloc;
        if (old + 1u == (gen + 1u) * nloc) {
            __builtin_amdgcn_fence(__ATOMIC_RELEASE, "agent");
            asm volatile("s_waitcnt vmcnt(0)" ::: "memory");
            const unsigned og = xb_add(&bar[XB_TOP], 1u);
            const unsigned tg = og / nx;
            if (og + 1u == (tg + 1u) * nx) xb_add(&bar[XB_TOPGEN], 1u);
            else XB_SPIN(xb_ld(&bar[XB_TOPGEN]) == tg, bar);
            __builtin_amdgcn_fence(__ATOMIC_ACQUIRE, "agent");
            xb_add(&bar[XB_XGEN(b.x)], 1u);
            asm volatile("s_waitcnt vmcnt(0)" ::: "memory");
        } else {
            XB_SPIN(xb_ld(&bar[XB_XGEN(b.x)]) == gen, bar);
            __builtin_amdgcn_fence(__ATOMIC_ACQUIRE, "agent");
            asm volatile("s_waitcnt vmcnt(0)" ::: "memory");
        }
    }
    __syncthreads();
}

namespace g8 {
constexpr int BK = 64, HALF = 128, HTB = HALF * BK * 2;
__device__ __forceinline__ int lds_byte(int r, int c) { const int st = (r >> 4) * 2 + (c >> 5), rr = r & 15, cc = c & 31, ob = rr * 64 + cc * 2; return st * 1024 + (ob ^ (((ob >> 9) & 1) << 5)); }
__device__ __forceinline__ void stage_rc(int b, int& R, int& C) { const int st = b / 1024, sb = b % 1024, swz = sb ^ (((sb >> 9) & 1) << 5); R = (st >> 1) * 16 + swz / 64; C = (st & 1) * 32 + (swz % 64) / 2; }

#define G8_SA(b, h) (((b) * 2 + (h)) * HTB)
#define G8_SB(b, h) ((4 + (b) * 2 + (h)) * HTB)
#define G8_STAGE_A(bufoff, h, kt) do { _Pragma("unroll") for (int _i = 0; _i < 2; ++_i) \
    __builtin_amdgcn_global_load_lds((const unsigned*)((Ab + (size_t)(kt) * (BK * 2)) + aoff[h][_i]), (LAS unsigned*)(lds + (bufoff) + ldsw + _i * 8192), 16, 0, 0); } while (0)
#define G8_STAGE_B(bufoff, h, kt) do { _Pragma("unroll") for (int _i = 0; _i < 2; ++_i) \
    __builtin_amdgcn_global_load_lds((const unsigned*)((Bb + (size_t)(h) * bhalf + (size_t)(kt) * (BK * 2)) + boff[_i]), (LAS unsigned*)(lds + (bufoff) + ldsw + _i * 8192), 16, 0, 0); } while (0)
#define G8_LDA(dst, b, h) do { _Pragma("unroll") for (int m = 0; m < 4; ++m) _Pragma("unroll") for (int k = 0; k < 2; ++k) dst[m][k] = *(const LAS bf16x8*)(lds + G8_SA(b, h) + la_off + m * 2048 + k * 1024); } while (0)
#define G8_LDB(dst, b, h) do { _Pragma("unroll") for (int n = 0; n < 2; ++n) _Pragma("unroll") for (int k = 0; k < 2; ++k) dst[n][k] = *(const LAS bf16x8*)(lds + G8_SB(b, h) + lb_off + n * 2048 + k * 1024); } while (0)
#define G8_MMA(ai, bj, At, Bt) do { __builtin_amdgcn_s_setprio(1); _Pragma("unroll") for (int m = 0; m < 4; ++m) _Pragma("unroll") for (int n = 0; n < 2; ++n) _Pragma("unroll") for (int k = 0; k < 2; ++k) \
    acc[ai][bj][m][n] = __builtin_amdgcn_mfma_f32_16x16x32_bf16(Bt[n][k], At[m][k], acc[ai][bj][m][n], 0, 0, 0); __builtin_amdgcn_s_setprio(0); } while (0)
#define G8_WAIT_V(n) asm volatile("s_waitcnt vmcnt(" #n ")" ::: "memory")
#define G8_WAIT_L(n) asm volatile("s_waitcnt lgkmcnt(" #n ")" ::: "memory")
#define G8_BAR __builtin_amdgcn_s_barrier()
#define G8_SCHED __builtin_amdgcn_sched_barrier(0)

template <class Epi>
__device__ __forceinline__ void gemm_unit(LAS unsigned char* lds, const char* Ab, const unsigned (&aoff)[2][2], const char* Bb, int K, const Epi& E) {
    int tid = threadIdx.x; asm volatile("" : "+v"(tid));
    const int wid = __builtin_amdgcn_readfirstlane(tid >> 6), lane = tid & 63, wr = wid >> 2, wc = wid & 3, fr = lane & 15, fq = lane >> 4;
    const int nt = K / BK;
    unsigned boff[2];
#pragma unroll
    for (int i = 0; i < 2; ++i) { int R, C; stage_rc(tid * 16 + i * 8192, R, C); const int rho = R & 31, Rb = (R & ~31) + 8 * ((rho & 15) >> 2) + 4 * (rho >> 4) + (rho & 3);
        boff[i] = (unsigned)(Rb * K + C) * 2u; }
    const size_t bhalf = (size_t)HALF * K * 2;
    const unsigned ldsw = (unsigned)wid * 1024u;
    const int la_off = lds_byte(wr * 64 + fr, fq * 8), lb_off = lds_byte(wc * 32 + fr, fq * 8);
    f32x4 acc[2][2][4][2];
#pragma unroll
    for (int a = 0; a < 2; ++a)
#pragma unroll
        for (int b = 0; b < 2; ++b)
#pragma unroll
            for (int m = 0; m < 4; ++m)
#pragma unroll
                for (int n = 0; n < 2; ++n) acc[a][b][m][n] = (f32x4){0.f, 0.f, 0.f, 0.f};
    bf16x8 At[4][2], B0[2][2], B1[2][2];
    G8_STAGE_B(G8_SB(0, 0), 0, 0); G8_STAGE_A(G8_SA(0, 0), 0, 0);
    G8_STAGE_B(G8_SB(0, 1), 1, 0); G8_STAGE_A(G8_SA(0, 1), 1, 0);
    if (wr == 1) G8_BAR;
    G8_WAIT_V(4); G8_BAR;
    G8_STAGE_B(G8_SB(1, 0), 0, 1); G8_STAGE_A(G8_SA(1, 0), 0, 1); G8_STAGE_B(G8_SB(1, 1), 1, 1);
    G8_WAIT_V(6); G8_BAR;
    for (int t = 0; t < nt - 2; t += 2) {
        G8_LDB(B0, 0, 0); G8_SCHED; G8_LDA(At, 0, 0); G8_STAGE_A(G8_SA(1, 1), 1, t + 1);
        G8_WAIT_L(8); G8_BAR; G8_WAIT_L(0); G8_MMA(0, 0, At, B0); G8_BAR; G8_SCHED;
        G8_LDB(B1, 0, 1); G8_STAGE_B(G8_SB(0, 0), 0, t + 2);
        G8_BAR; G8_WAIT_L(0); G8_MMA(0, 1, At, B1); G8_BAR;
        G8_LDA(At, 0, 1); G8_STAGE_A(G8_SA(0, 0), 0, t + 2);
        G8_BAR; G8_WAIT_L(0); G8_MMA(1, 0, At, B0); G8_BAR; G8_SCHED;
        G8_STAGE_B(G8_SB(0, 1), 1, t + 2);
        G8_WAIT_V(6); G8_BAR; G8_MMA(1, 1, At, B1); G8_BAR;
        G8_LDB(B0, 1, 0); G8_SCHED; G8_LDA(At, 1, 0); G8_STAGE_A(G8_SA(0, 1), 1, t + 2);
        G8_WAIT_L(8); G8_BAR; G8_WAIT_L(0); G8_MMA(0, 0, At, B0); G8_BAR; G8_SCHED;
        G8_LDB(B1, 1, 1); G8_STAGE_B(G8_SB(1, 0), 0, t + 3);
        G8_BAR; G8_WAIT_L(0); G8_MMA(0, 1, At, B1); G8_BAR;
        G8_LDA(At, 1, 1); G8_STAGE_A(G8_SA(1, 0), 0, t + 3);
        G8_BAR; G8_WAIT_L(0); G8_MMA(1, 0, At, B0); G8_BAR; G8_SCHED;
        G8_STAGE_B(G8_SB(1, 1), 1, t + 3);
        G8_WAIT_V(6); G8_BAR; G8_MMA(1, 1, At, B1); G8_BAR;
    }
    { G8_LDB(B0, 0, 0); G8_LDA(At, 0, 0); G8_STAGE_A(G8_SA(1, 1), 1, nt - 1);
      G8_BAR; G8_WAIT_L(0); G8_MMA(0, 0, At, B0); G8_BAR;
      G8_LDB(B1, 0, 1); G8_BAR; G8_WAIT_L(0); G8_MMA(0, 1, At, B1); G8_BAR;
      G8_LDA(At, 0, 1); G8_WAIT_V(4); G8_BAR; G8_WAIT_L(0); G8_MMA(1, 0, At, B0); G8_MMA(1, 1, At, B1); G8_BAR; }
    { G8_LDB(B0, 1, 0); G8_LDA(At, 1, 0); G8_WAIT_V(2); G8_BAR; G8_WAIT_L(0); G8_MMA(0, 0, At, B0); G8_BAR;
      G8_LDB(B1, 1, 1); G8_WAIT_V(0); G8_BAR; G8_WAIT_L(0); G8_MMA(0, 1, At, B1); G8_BAR;
      G8_LDA(At, 1, 1); G8_BAR; G8_WAIT_L(0); G8_MMA(1, 0, At, B0); G8_MMA(1, 1, At, B1); G8_BAR; }
    if (wr == 0) G8_BAR;
    asm volatile("" ::: "memory");
    E(acc, wr, wc, fr, fq);
    __syncthreads();
}
__device__ __forceinline__ void aoff_rows(unsigned (&aoff)[2][2], int K) {
    int tid = threadIdx.x; asm volatile("" : "+v"(tid));
#pragma unroll
    for (int i = 0; i < 2; ++i) { int R, C; stage_rc(tid * 16 + i * 8192, R, C);
#pragma unroll
        for (int h = 0; h < 2; ++h) aoff[h][i] = (unsigned)((h * HALF + R) * K + C) * 2u; }
}
__device__ __forceinline__ void tile_order(int L, int nM, int nN, int& pm, int& pn) {
    const int nwg = nM * nN; int wgid = L;
    { const int q = nwg / 8, r = nwg % 8, xcd = wgid % 8, off = wgid / 8; wgid = (xcd < r ? xcd * (q + 1) : r * (q + 1) + (xcd - r) * q) + off; }
    const int nig = 8 * nN, gid = wgid / nig, fm = gid * 8, gsz = (nM - fm) < 8 ? (nM - fm) : 8;
    pm = fm + ((wgid % nig) % gsz); pn = (wgid % nig) / gsz;
}
}

__device__ __forceinline__ void p0_transpose_item(const float* W, int K, int N, int k0, int n0, bf16_t* WTrow0  , const float* kscale, float mul, LAS float* scr, int lane) {
#pragma unroll 8
    for (int i = 0; i < 32; ++i) { const int kk = 2 * i + (lane >> 5); float v = W[(size_t)(k0 + kk) * N + n0 + (lane & 31)]; if (kscale) v *= kscale[k0 + kk]; scr[kk * 33 + (lane & 31)] = v * mul; }
    LDS_WAIT();
    const int c = lane & 7;
#pragma unroll
    for (int j = 0; j < 4; ++j) { const int n = (lane >> 3) + 8 * j; const LAS float* s = scr + (8 * c) * 33 + n;
        u32x4 o; o.x = cvt_pk_bf16(s[0 * 33], s[1 * 33]); o.y = cvt_pk_bf16(s[2 * 33], s[3 * 33]); o.z = cvt_pk_bf16(s[4 * 33], s[5 * 33]); o.w = cvt_pk_bf16(s[6 * 33], s[7 * 33]);
        *(u32x4*)(WTrow0 + (size_t)n * K + k0 + 8 * c) = o; }
    LDS_WAIT();
}

__device__ __forceinline__ void p0_transpose64(const float* W, int K, int N, int k0, int n0, bf16_t* WTrow0  , const float* kscale, LAS float* scr, int lane) {
    const int rq = lane >> 4, c4 = 4 * (lane & 15);
    f32x4 v[16];
#pragma unroll
    for (int i = 0; i < 16; ++i) v[i] = *(const f32x4*)(W + (size_t)(k0 + 4 * i + rq) * N + n0 + c4);
    if (kscale) {
#pragma unroll
        for (int i = 0; i < 16; ++i) v[i] = v[i] * kscale[k0 + 4 * i + rq];
    }
#pragma unroll
    for (int i = 0; i < 16; ++i) { LAS float* d = scr + (4 * i + rq) * 65 + c4; d[0] = v[i][0]; d[1] = v[i][1]; d[2] = v[i][2]; d[3] = v[i][3]; }
    LDS_WAIT();
#pragma unroll
    for (int c = 0; c < 8; ++c) { const LAS float* sp = scr + (8 * c) * 65 + lane;
        u32x4 o; o.x = cvt_pk_bf16(sp[0], sp[65]); o.y = cvt_pk_bf16(sp[2 * 65], sp[3 * 65]); o.z = cvt_pk_bf16(sp[4 * 65], sp[5 * 65]); o.w = cvt_pk_bf16(sp[6 * 65], sp[7 * 65]);
        *(u32x4*)(WTrow0 + (size_t)lane * K + k0 + 8 * c) = o; }
    LDS_WAIT();
}
__device__ __forceinline__ void p0_expert_weights(const Params& p, LAS unsigned char* lds, int gw, int NGW) {
    int tid = threadIdx.x; asm volatile("" : "+v"(tid));
    const int wave = tid >> 6, lane = tid & 63;
    LAS float* scr = (LAS float*)(lds + wave * 16640);
    bf16_t* wgu = (bf16_t*)(p.ws + WS_WGU); bf16_t* wdn = (bf16_t*)(p.ws + WS_WDN);
    constexpr int I_G = NE * 16 * 4, I_D = NE * 4 * 16;
    for (int it = gw; it < 2 * I_G + I_D; it += NGW) {
        int r = it;
        if (r < 2 * I_G) { const int up = r >= I_G; if (up) r -= I_G; const int e = r / 64, q = r % 64, kb = q / 4, nb = q % 4, n0 = nb * 64;
            const int drow = (n0 >> 7) * 256 + up * 128 + (n0 & 127);
            p0_transpose64((up ? p.w_up : p.w_gate) + (size_t)e * D * DE, D, DE, kb * 64, n0, wgu + ((size_t)e * 512 + drow) * D, p.norm_ffn_g, scr, lane); continue; } r -= 2 * I_G;
        { const int e = r / 64, q = r % 64, kb = q / 16, nb = q % 16, n0 = nb * 64;
            p0_transpose64(p.w_down + (size_t)e * DE * D, DE, D, kb * 64, n0, wdn + ((size_t)e * D + n0) * DE, nullptr, scr, lane); }
    }
}
__device__ __forceinline__ void phase0(const Params& p, LAS unsigned char* lds) {
    int tid = threadIdx.x; asm volatile("" : "+v"(tid));
    const int wave = tid >> 6, lane = tid & 63;
    const int gw = blockIdx.x * NWAVES + wave, NGW = gridDim.x * NWAVES;
    LAS float* scr = (LAS float*)(lds + wave * 8704);
    bf16_t* win = (bf16_t*)(p.ws + WS_WIN); bf16_t* wout = (bf16_t*)(p.ws + WS_WOUT);
    constexpr int I_IN = 16 * 104, I_OUT = 16 * 32;
    for (int it = gw; it < I_IN + I_OUT; it += NGW) {
        int r = it;
        if (r < I_IN) { const int kb = r / 104, nb = r % 104, n0 = nb * 32; p0_transpose_item(p.w_in, D, NIN, kb * 64, n0, win + (size_t)n0 * D, p.norm_mix_g, n0 < 512 ? QSCALE : 1.f, scr, lane); continue; } r -= I_IN;
        { const int kb = r / 32, nb = r % 32, n0 = nb * 32; p0_transpose_item(p.w_out, D, D, kb * 64, n0, wout + (size_t)n0 * D, nullptr, 1.f, scr, lane); }
    }
    bf16_t* xb = (bf16_t*)(p.ws + WS_B); float* rstd1 = (float*)(p.ws + WS_RSTD1);
    for (int row = gw; row < T; row += NGW) {
        const f32x4* xr = (const f32x4*)(p.x + (size_t)row * D) + lane; f32x4 v[4]; float s = 0.f;
#pragma unroll
        for (int j = 0; j < 4; ++j) { v[j] = xr[64 * j]; s += (v[j].x * v[j].x + v[j].y * v[j].y) + (v[j].z * v[j].z + v[j].w * v[j].w); }
        s = wave_sum(s);
        u32x2* o = (u32x2*)(xb + (size_t)row * D) + lane;
#pragma unroll
        for (int j = 0; j < 4; ++j) { u32x2 w; w.x = cvt_pk_bf16(v[j].x, v[j].y); w.y = cvt_pk_bf16(v[j].z, v[j].w); o[64 * j] = w; }
        if (lane == 0) rstd1[row] = 1.0f / sqrtf(s * (1.0f / D) + 1e-6f);
    }
    bf16_t* wr_hi = (bf16_t*)(p.ws + WS_WR); bf16_t* wr_lo = wr_hi + 48 * D;
    for (int i = blockIdx.x * NTHREADS + tid; i < 48 * D; i += gridDim.x * NTHREADS) {
        const int c = i / D, k = i % D; float w = 0.f;
        if (c < 4) w = p.r_grp_w[k * 4 + c]; else if (c < 36) w = p.r_exp_w[k * 32 + (c - 4)];
        w *= p.norm_ffn_g[k];
        const unsigned hi = cvt_pk_bf16(w, 0.f) & 0xffffu; const float rem = w - __uint_as_float(hi << 16);
        wr_hi[i] = (bf16_t)hi; wr_lo[i] = (bf16_t)(cvt_pk_bf16(rem, 0.f) & 0xffffu);
    }
    { bf16_t* w2t = (bf16_t*)(p.ws + WS_LT); bf16_t* a2t = w2t + 512 * 64; bf16_t* g2t = a2t + 512 * 64;
      for (int i = blockIdx.x * NTHREADS + tid; i < 512 * 256; i += gridDim.x * NTHREADS) {
          if (i < 512 * 64) { const int c = i >> 6, m = i & 63; w2t[i] = (bf16_t)(cvt_pk_bf16(p.rw_w2[m * 512 + c], 0.f) & 0xffffu); }
          else if (i < 2 * 512 * 64) { const int q = i - 512 * 64, c = q >> 6, m = q & 63; a2t[q] = (bf16_t)(cvt_pk_bf16(p.rw_a2[m * 512 + c], 0.f) & 0xffffu); }
          else { const int q = i - 2 * 512 * 64, c = q >> 7, m = q & 127; g2t[q] = (bf16_t)(cvt_pk_bf16(p.rw_g2[m * 512 + c], 0.f) & 0xffffu); } } }
    if (blockIdx.x == 0 && tid < 64) ((unsigned*)(p.ws + WS_CTL))[tid] = 0u;
}

struct EpiU {
    bf16_t* u; const float* rstd; int row0, col0;
    __device__ __forceinline__ void operator()(const f32x4 (&acc)[2][2][4][2], int wr, int wc, int fr, int fq) const {
#pragma unroll
        for (int ai = 0; ai < 2; ++ai)
#pragma unroll
            for (int m = 0; m < 4; ++m) { const int row = row0 + ai * 128 + wr * 64 + m * 16 + fr; const float rs = rstd[row]; bf16_t* rp = u + (size_t)row * NIN + col0 + wc * 32 + 8 * fq;
#pragma unroll
                for (int bj = 0; bj < 2; ++bj) { const f32x4 v0 = acc[ai][bj][m][0] * rs, v1 = acc[ai][bj][m][1] * rs;
                    *(u32x4*)(rp + bj * 128) = (u32x4){cvt_pk_bf16(v0[0], v0[1]), cvt_pk_bf16(v0[2], v0[3]), cvt_pk_bf16(v1[0], v1[1]), cvt_pk_bf16(v1[2], v1[3])}; } }
    }
};
__device__ __forceinline__ void phase1(const Params& p, LAS unsigned char* lds) {
    constexpr int nM = T / 256, nN = NIN / 256;
    unsigned aoff[2][2]; g8::aoff_rows(aoff, D);
    for (int L = blockIdx.x; L < nM * nN; L += gridDim.x) {
        int pm, pn; g8::tile_order(L, nM, nN, pm, pn);
        EpiU E{(bf16_t*)(p.ws + WS_A), (const float*)(p.ws + WS_RSTD1), pm * 256, pn * 256};
        g8::gemm_unit(lds, (const char*)(p.ws + WS_B) + (size_t)pm * 256 * D * 2, aoff, (const char*)(p.ws + WS_WIN) + (size_t)pn * 256 * D * 2, D, E);
    }
}


typedef short v4i16_t __attribute__((ext_vector_type(4)));
__device__ __forceinline__ s16x4 lds_tr16(const LAS unsigned char* p) { return __builtin_bit_cast(s16x4, __builtin_amdgcn_ds_read_tr16_b64_v4i16((LAS v4i16_t*)p)); }

__device__ __forceinline__ void attn_tile(const Params& p, LAS unsigned char* vl  , int b, int h, int qt) {
    const int lane = threadIdx.x & 63, r32 = lane & 31, hi = lane >> 5;
    const bf16_t* u = (const bf16_t*)(p.ws + WS_A);
    const size_t row0 = (size_t)b * S; const int q0 = qt * 32;
    bf16x8 qf[4];
    { const bf16_t* qp = u + (row0 + q0 + r32) * NIN + UQ + h * HD + 8 * hi;
#pragma unroll
      for (int s = 0; s < 4; ++s) qf[s] = *(const bf16x8*)(qp + 16 * s); }
    f32x16 o0, o1;
#pragma unroll
    for (int i = 0; i < 16; ++i) { o0[i] = 0.f; o1[i] = 0.f; }
    float carry = 0.f;
    const int kperm = 16 * ((r32 >> 2) & 1) + (r32 & 3) + 4 * (r32 >> 3);
    const int g = lane >> 4, i16 = lane & 15, tq = i16 >> 2, tp = i16 & 3;
    const LAS unsigned char* vrd = vl + (16 * (g >> 1) + tq) * 144 + (16 * (g & 1) + 4 * tp) * 2;
    LAS unsigned char* kl = vl + 4608;
    const int lrow = lane >> 3, lchk = lane & 7;
    const bf16_t* kvp = u + (row0 + lrow) * NIN + h * HD + lchk * 8;
    u32x4 kreg[4], vreg[4];
#pragma unroll
    for (int i = 0; i < 4; ++i) { const bf16_t* a = kvp + (size_t)(qt * 32 + 8 * i) * NIN; kreg[i] = *(const u32x4*)(a + UK); vreg[i] = *(const u32x4*)(a + UV); }
    for (int kb = qt; kb >= 0; --kb) {
        const int key0 = kb * 32;
#pragma unroll
        for (int i = 0; i < 4; ++i) { *(LAS u32x4*)(kl + (8 * i + lrow) * 144 + lchk * 16) = kreg[i]; *(LAS u32x4*)(vl + (8 * i + lrow) * 144 + lchk * 16) = vreg[i]; }
        if (kb > 0) {
#pragma unroll
            for (int i = 0; i < 4; ++i) { const bf16_t* a = kvp + (size_t)(key0 - 32 + 8 * i) * NIN; kreg[i] = *(const u32x4*)(a + UK); vreg[i] = *(const u32x4*)(a + UV); }
        }
        LDS_WAIT();
        f32x16 st;
#pragma unroll
        for (int i = 0; i < 16; ++i) st[i] = 0.f;
        { const LAS unsigned char* kp = kl + kperm * 144 + 16 * hi;
          bf16x8 kf[4];
#pragma unroll
          for (int s = 0; s < 4; ++s) kf[s] = *(const LAS bf16x8*)(kp + 32 * s);
#pragma unroll
          for (int s = 0; s < 4; ++s) st = __builtin_amdgcn_mfma_f32_32x32x16_bf16(kf[s], qf[s], st, 0, 0, 0); }
        const bool diag = (kb == qt);
        float lw[16], suf[16];
        float run = 0.f;
#pragma unroll
        for (int reg = 15; reg >= 0; --reg) {
            const float z = st[reg];
            const float l = flog2(1.0f + fexp2(-fabsf(z)));
            const float sp = fmaxf(z, 0.f) + l;
            const bool valid = !diag || (16 * hi + reg < r32);
            lw[reg] = valid ? (z - sp) : -1.0e30f;
            suf[reg] = run;
            run += valid ? -sp : 0.f;
        }
        const float other = swap32(run);
        const float tot_hi = hi ? run : other, tot_lo = hi ? other : run;
        const float base = carry + (hi ? 0.f : tot_hi);
        carry += tot_lo + tot_hi;
        unsigned pk[8];
#pragma unroll
        for (int j = 0; j < 8; ++j) pk[j] = cvt_pk_bf16(fexp2(lw[2 * j] + suf[2 * j] + base), fexp2(lw[2 * j + 1] + suf[2 * j + 1] + base));
        LDS_WAIT();
#pragma unroll
        for (int s2 = 0; s2 < 2; ++s2) {
            bf16x8 pf = __builtin_bit_cast(bf16x8, (u32x4){pk[4 * s2], pk[4 * s2 + 1], pk[4 * s2 + 2], pk[4 * s2 + 3]});
#pragma unroll
            for (int dh = 0; dh < 2; ++dh) {
                const s16x4 a = lds_tr16(vrd + (8 * s2) * 144 + 64 * dh), c = lds_tr16(vrd + (8 * s2 + 4) * 144 + 64 * dh);
                bf16x8 vf; vf[0] = a[0]; vf[1] = a[1]; vf[2] = a[2]; vf[3] = a[3]; vf[4] = c[0]; vf[5] = c[1]; vf[6] = c[2]; vf[7] = c[3];
                if (dh == 0) o0 = __builtin_amdgcn_mfma_f32_32x32x16_bf16(vf, pf, o0, 0, 0, 0); else o1 = __builtin_amdgcn_mfma_f32_32x32x16_bf16(vf, pf, o1, 0, 0, 0);
            }
        }
        LDS_WAIT();
        if (__builtin_amdgcn_ballot_w64(carry > -150.0f) == 0ull) break;
    }
    float ss = 0.f;
#pragma unroll
    for (int i = 0; i < 16; ++i) ss += o0[i] * o0[i] + o1[i] * o1[i];
    ss += swap32(ss);
    const float rs = 1.0f / sqrtf(ss * (1.0f / HD) + 1e-6f);
    bf16_t* op = (bf16_t*)(p.ws + WS_B) + (row0 + q0 + r32) * D + h * HD + 4 * hi;
    const float* gp = p.sb_out_g + h * HD + 4 * hi;
#pragma unroll
    for (int dh = 0; dh < 2; ++dh)
#pragma unroll
        for (int gq = 0; gq < 4; ++gq) {
            const f32x4 gg = *(const f32x4*)(gp + 32 * dh + 8 * gq);
            const f32x16& o = dh ? o1 : o0;
            u32x2 w; w.x = cvt_pk_bf16(o[4 * gq] * rs * gg[0], o[4 * gq + 1] * rs * gg[1]); w.y = cvt_pk_bf16(o[4 * gq + 2] * rs * gg[2], o[4 * gq + 3] * rs * gg[3]);
            *(u32x2*)(op + 32 * dh + 8 * gq) = w;
        }
}

constexpr size_t ACT_OFF = (size_t)64 << 20;
namespace rk {
constexpr int C = 32, NCH = S / C, NSLOT = 16;
constexpr int SL_PS = 0, SL_QS = 8192, SL_PO = 12288, SL_QO = 16384, SL_VR = 18432, SL_GB = 22528, SL_GW = 26624, SLOT_BYTES = 30720;
constexpr int MSTR = 144;
constexpr int PM_AT = 0, PM_RT = 4608, PM_BT = 9216, PM_KT = 13824, PM_GC = 18432, PROD_LDS = 18688;
constexpr int NPROD = 6;
constexpr int L_CONS = NPROD * PROD_LDS;
constexpr int OSTR = 272;
constexpr int L_OBUF = L_CONS + 4608;
constexpr int L_FLAG = L_OBUF + 32 * OSTR;
constexpr int L_W2 = L_FLAG + 256;
constexpr int L_A2 = L_W2 + 8192;
constexpr int L_G2 = L_A2 + 8192;
constexpr int L_CST = L_G2 + 16384;
constexpr int C_MUL = 0, C_MUR = 256, C_MUK = 320, C_MUV = 384, C_W0 = 448, C_A0 = 512, C_KK = 576, C_KA = 640, C_RK = 704, C_LNB = 768, C_END = 832;
static_assert(L_CST + C_END * 4 <= 161792, "rwkv LDS layout overflows");
}
__device__ __forceinline__ bf16x8 accfrag(const f32x16& a, int s) {
    return __builtin_bit_cast(bf16x8, (u32x4){cvt_pk_bf16(a[8 * s], a[8 * s + 1]), cvt_pk_bf16(a[8 * s + 2], a[8 * s + 3]), cvt_pk_bf16(a[8 * s + 4], a[8 * s + 5]), cvt_pk_bf16(a[8 * s + 6], a[8 * s + 7])});
}
__device__ __forceinline__ bf16x8 trfrag(const LAS unsigned char* mat, int s, int nt, int lane) {
    const int g = lane >> 4, i16 = lane & 15, q = i16 >> 2, pp = i16 & 3, h = g >> 1;
    const LAS unsigned char* a = mat + (16 * s + 4 * h + q) * rk::MSTR + (32 * nt + 16 * (g & 1) + 4 * pp) * 2;
    const s16x4 x = lds_tr16(a), y = lds_tr16(a + 8 * rk::MSTR);
    bf16x8 r; r[0] = x[0]; r[1] = x[1]; r[2] = x[2]; r[3] = x[3]; r[4] = y[0]; r[5] = y[1]; r[6] = y[2]; r[7] = y[3]; return r;
}
__device__ __forceinline__ void f8_from_bf16(const u32x4 w, float (&o)[8]) {
#pragma unroll
    for (int j = 0; j < 4; ++j) { o[2 * j] = bf16_lo(w[j]); o[2 * j + 1] = bf16_hi(w[j]); }
}
__device__ __forceinline__ f32x16 mfma32(bf16x8 a, bf16x8 b, f32x16 c) { return __builtin_amdgcn_mfma_f32_32x32x16_bf16(a, b, c, 0, 0, 0); }
__device__ __forceinline__ f32x16 zero16() { f32x16 z; for (int i = 0; i < 16; ++i) z[i] = 0.f; return z; }
__device__ __forceinline__ void um8(const bf16_t* urow  , bool has_prev, const float* mu, float (&o)[8]) {
    const u32x4 c = *(const u32x4*)urow; u32x4 pv = (u32x4){0u, 0u, 0u, 0u}; if (has_prev) pv = *(const u32x4*)(urow - NIN);
    const f32x4 m0 = *(const f32x4*)mu, m1 = *(const f32x4*)(mu + 4);
    float cv[8], pf[8]; f8_from_bf16(c, cv); f8_from_bf16(pv, pf);
#pragma unroll
    for (int j = 0; j < 4; ++j) { o[j] = cv[j] + (pf[j] - cv[j]) * m0[j]; o[4 + j] = cv[4 + j] + (pf[4 + j] - cv[4 + j]) * m1[j]; }
}
__device__ __forceinline__ void lerp8(const u32x4 c, const u32x4 pv, const LAS float* mu, float (&o)[8]) {
    const f32x4 m0 = *(const LAS f32x4*)mu, m1 = *(const LAS f32x4*)(mu + 4);
    float cv[8], pf[8]; f8_from_bf16(c, cv); f8_from_bf16(pv, pf);
#pragma unroll
    for (int j = 0; j < 4; ++j) { o[j] = cv[j] + (pf[j] - cv[j]) * m0[j]; o[4 + j] = cv[4 + j] + (pf[4 + j] - cv[4 + j]) * m1[j]; }
}
__device__ __forceinline__ void lerp8(const u32x4 c, const u32x4 pv, const float* mu, float (&o)[8]) {
    const f32x4 m0 = *(const f32x4*)mu, m1 = *(const f32x4*)(mu + 4);
    float cv[8], pf[8]; f8_from_bf16(c, cv); f8_from_bf16(pv, pf);
#pragma unroll
    for (int j = 0; j < 4; ++j) { o[j] = cv[j] + (pf[j] - cv[j]) * m0[j]; o[4 + j] = cv[4 + j] + (pf[4 + j] - cv[4 + j]) * m1[j]; }
}
__device__ __forceinline__ float scan32(float x) {
    x += dppf<0x111>(x); x += dppf<0x112>(x); x += dppf<0x114>(x); x += dppf<0x118>(x);
    const float bc = __builtin_bit_cast(float, __builtin_amdgcn_update_dpp(0, __builtin_bit_cast(int, x), 0x142, 0xA, 0xF, false));
    return x + bc;
}

__device__ __forceinline__ void rk_produce(const Params& p, LAS unsigned char* lds, LAS unsigned char* pl  , unsigned char* slot, int b, int hh, int c) {
    using namespace rk;
    int lane = threadIdx.x & 63; asm volatile("" : "+v"(lane));
    const int r32 = lane & 31, h = lane >> 5;
    const bf16_t* u = (const bf16_t*)(p.ws + WS_A);
    const size_t row0 = (size_t)b * S; const int t0 = c * C; const int tt = t0 + r32; const bool hp = tt > 0;
    const bf16_t* urow = u + (row0 + tt) * NIN;
    const LAS float* cst = (const LAS float*)(lds + L_CST);
    const int jrow0 = 32 * ((r32 >> 2) & 1) + (r32 & 3) + 4 * (r32 >> 3);
    f32x16 lw[2], la[2], lg[2];
#pragma unroll
    for (int mt = 0; mt < 2; ++mt) { lw[mt] = zero16(); la[mt] = zero16(); lg[mt] = zero16(); }
    const int cb = hh * HD + 32 * h;
    u32x4 ck[4], pk4[4], cr[4], pr4[4];
    {
        const bf16_t* act = (const bf16_t*)((const unsigned char*)p.out + ACT_OFF) + (row0 + tt) * 256 + 8 * h;
        u32x4 bw[4], ba[4], bg[8];
#pragma unroll
        for (int s = 0; s < 4; ++s) { bw[s] = *(const u32x4*)(act + 16 * s); ba[s] = *(const u32x4*)(act + 64 + 16 * s); }
#pragma unroll
        for (int s = 0; s < 8; ++s) bg[s] = *(const u32x4*)(act + 128 + 16 * s);
        {
            bf16x8 fw[2][4];
#pragma unroll
            for (int mt = 0; mt < 2; ++mt)
#pragma unroll
                for (int s = 0; s < 4; ++s) { const int jl = jrow0 + 16 * mt; fw[mt][s] = *(const LAS bf16x8*)(lds + L_W2 + jl * 128 + (((2 * s + h) ^ (jl & 7)) << 4)); }
#pragma unroll
            for (int s = 0; s < 4; ++s)
#pragma unroll
                for (int mt = 0; mt < 2; ++mt) lw[mt] = mfma32(fw[mt][s], __builtin_bit_cast(bf16x8, bw[s]), lw[mt]);
        }
        {
            bf16x8 fa[2][4];
#pragma unroll
            for (int mt = 0; mt < 2; ++mt)
#pragma unroll
                for (int s = 0; s < 4; ++s) { const int jl = jrow0 + 16 * mt; fa[mt][s] = *(const LAS bf16x8*)(lds + L_A2 + jl * 128 + (((2 * s + h) ^ (jl & 7)) << 4)); }
#pragma unroll
            for (int s = 0; s < 4; ++s)
#pragma unroll
                for (int mt = 0; mt < 2; ++mt) la[mt] = mfma32(fa[mt][s], __builtin_bit_cast(bf16x8, ba[s]), la[mt]);
        }
        asm volatile("" ::: "memory");
#pragma unroll
        for (int half = 0; half < 2; ++half) {
            bf16x8 fg[2][4];
#pragma unroll
            for (int mt = 0; mt < 2; ++mt)
#pragma unroll
                for (int s4 = 0; s4 < 4; ++s4) { const int s = 4 * half + s4, jl = jrow0 + 16 * mt; fg[mt][s4] = *(const LAS bf16x8*)(lds + L_G2 + jl * 256 + (((2 * s + h) ^ (jl & 7)) << 4)); }
#pragma unroll
            for (int s4 = 0; s4 < 4; ++s4)
#pragma unroll
                for (int mt = 0; mt < 2; ++mt) lg[mt] = mfma32(fg[mt][s4], __builtin_bit_cast(bf16x8, bg[4 * half + s4]), lg[mt]);
        }
        asm volatile("" ::: "memory");
#pragma unroll
        for (int q = 0; q < 4; ++q) { const bf16_t* a = urow + URK + cb + 8 * q; const bf16_t* bq = urow + UR + cb + 8 * q;
            ck[q] = *(const u32x4*)a; cr[q] = *(const u32x4*)bq; pk4[q] = (u32x4){0u, 0u, 0u, 0u}; pr4[q] = pk4[q];
            if (hp) { pk4[q] = *(const u32x4*)(a - NIN); pr4[q] = *(const u32x4*)(bq - NIN); } }
    }
#pragma unroll
    for (int mt = 0; mt < 2; ++mt) {
        u32x4 w0, w1; w0.x = cvt_pk_bf16(lg[mt][0], lg[mt][1]); w0.y = cvt_pk_bf16(lg[mt][2], lg[mt][3]); w0.z = cvt_pk_bf16(lg[mt][4], lg[mt][5]); w0.w = cvt_pk_bf16(lg[mt][6], lg[mt][7]);
        w1.x = cvt_pk_bf16(lg[mt][8], lg[mt][9]); w1.y = cvt_pk_bf16(lg[mt][10], lg[mt][11]); w1.z = cvt_pk_bf16(lg[mt][12], lg[mt][13]); w1.w = cvt_pk_bf16(lg[mt][14], lg[mt][15]);
        *(u32x4*)(slot + SL_GW + (2 * mt) * 1024 + lane * 16) = w0; *(u32x4*)(slot + SL_GW + (2 * mt + 1) * 1024 + lane * 16) = w1;
    }
    asm volatile("" ::: "memory");
    float ssq = 0.f;
#pragma unroll
    for (int q = 0; q < 4; ++q) {
        float t8[8]; lerp8(ck[q], pk4[q], cst + C_MUK + 32 * h + 8 * q, t8);
        const f32x4 c0 = *(const LAS f32x4*)(cst + C_KK + 32 * h + 8 * q), c1 = *(const LAS f32x4*)(cst + C_KK + 32 * h + 8 * q + 4);
#pragma unroll
        for (int j = 0; j < 4; ++j) { const float x0 = t8[j] * c0[j], x1 = t8[4 + j] * c1[j]; ssq += x0 * x0 + x1 * x1; }
    }
    ssq += swap32(ssq);
    const float kinv = frsq(fmaxf(ssq, 1e-24f));
    float bonus = 0.f;
    LAS unsigned char* mAT = pl + PM_AT; LAS unsigned char* mRT = pl + PM_RT; LAS unsigned char* mBT = pl + PM_BT; LAS unsigned char* mKT = pl + PM_KT;
    LAS float* gc = (LAS float*)(pl + PM_GC);
#pragma unroll
    for (int mt = 0; mt < 2; ++mt) {
#pragma unroll
        for (int q8 = 0; q8 < 2; ++q8) {
            const int jl0 = 32 * h + 16 * mt + 8 * q8, q = 2 * mt + q8;
            float k8[8], r8[8];
            lerp8(ck[q], pk4[q], cst + C_MUK + jl0, k8);
            lerp8(cr[q], pr4[q], cst + C_MUR + jl0, r8);
            float cw0[8], ca0[8], ckk[8], cka[8], crk[8];
#pragma unroll
            for (int e = 0; e < 2; ++e) { const f32x4 a = *(const LAS f32x4*)(cst + C_W0 + jl0 + 4 * e), bq = *(const LAS f32x4*)(cst + C_A0 + jl0 + 4 * e), cc = *(const LAS f32x4*)(cst + C_KK + jl0 + 4 * e), dd = *(const LAS f32x4*)(cst + C_KA + jl0 + 4 * e), ee = *(const LAS f32x4*)(cst + C_RK + jl0 + 4 * e);
#pragma unroll
                for (int j = 0; j < 4; ++j) { cw0[4 * e + j] = a[j]; ca0[4 * e + j] = bq[j]; ckk[4 * e + j] = cc[j]; cka[4 * e + j] = dd[j]; crk[4 * e + j] = ee[j]; } }
            float oa[8], orr[8], ob[8], ok[8];
#pragma unroll
            for (int e = 0; e < 8; ++e) {
                const int reg = 8 * q8 + e;
                const float xw = cw0[e] + lw[mt][reg];
                const float spn = fmaxf(-xw, 0.f) + LN2 * flog2(1.0f + fexp2(-fabsf(xw) * LOG2E));
                const float ld = -fexp2((-spn - 0.5f) * LOG2E);
                const float al = frcp(1.0f + fexp2(-(ca0[e] + la[mt][reg]) * LOG2E));
                const float kk = k8[e] * ckk[e] * kinv;
                const float kmod = k8[e] * (1.0f + (al - 1.0f) * cka[e]);
                const float bb = kk * al;
                bonus += r8[e] * kmod * crk[e];
                const float G = scan32(ld);
                const float eG = fexp2(G * LOG2E), eGm = fexp2((G - ld) * LOG2E), eiG = fexp2(-G * LOG2E);
                oa[e] = -kk * eGm; orr[e] = r8[e] * eG; ob[e] = bb * eiG; ok[e] = kmod * eiG;
                if (r32 == 31) gc[32 * h + 16 * mt + reg] = eG;
            }
            const int off = r32 * MSTR + (32 * h + 16 * mt + 8 * q8) * 2;
            *(LAS u32x4*)(mAT + off) = (u32x4){cvt_pk_bf16(oa[0], oa[1]), cvt_pk_bf16(oa[2], oa[3]), cvt_pk_bf16(oa[4], oa[5]), cvt_pk_bf16(oa[6], oa[7])};
            *(LAS u32x4*)(mRT + off) = (u32x4){cvt_pk_bf16(orr[0], orr[1]), cvt_pk_bf16(orr[2], orr[3]), cvt_pk_bf16(orr[4], orr[5]), cvt_pk_bf16(orr[6], orr[7])};
            *(LAS u32x4*)(mBT + off) = (u32x4){cvt_pk_bf16(ob[0], ob[1]), cvt_pk_bf16(ob[2], ob[3]), cvt_pk_bf16(ob[4], ob[5]), cvt_pk_bf16(ob[6], ob[7])};
            *(LAS u32x4*)(mKT + off) = (u32x4){cvt_pk_bf16(ok[0], ok[1]), cvt_pk_bf16(ok[2], ok[3]), cvt_pk_bf16(ok[4], ok[5]), cvt_pk_bf16(ok[6], ok[7])};
            asm volatile("" ::: "memory");
        }
    }
    bonus += swap32(bonus);
    u32x4 cv4[4], pv4[4];
#pragma unroll
    for (int q = 0; q < 4; ++q) { const bf16_t* cq = urow + URV + cb + 8 * q; cv4[q] = *(const u32x4*)cq; pv4[q] = (u32x4){0u, 0u, 0u, 0u}; if (hp) pv4[q] = *(const u32x4*)(cq - NIN); }
#pragma unroll
    for (int q = 0; q < 4; ++q) {
        float v8[8]; lerp8(cv4[q], pv4[q], cst + C_MUV + 32 * h + 8 * q, v8);
        *(u32x4*)(slot + SL_VR + q * 1024 + lane * 16) = (u32x4){cvt_pk_bf16(v8[0], v8[1]), cvt_pk_bf16(v8[2], v8[3]), cvt_pk_bf16(v8[4], v8[5]), cvt_pk_bf16(v8[6], v8[7])};
        const f32x4 b0 = *(const LAS f32x4*)(cst + C_LNB + 32 * h + 8 * q), b1 = *(const LAS f32x4*)(cst + C_LNB + 32 * h + 8 * q + 4);
        float gb[8];
#pragma unroll
        for (int e = 0; e < 8; ++e) gb[e] = (e < 4 ? b0[e] : b1[e - 4]) + bonus * v8[e];
        *(u32x4*)(slot + SL_GB + q * 1024 + lane * 16) = (u32x4){cvt_pk_bf16(gb[0], gb[1]), cvt_pk_bf16(gb[2], gb[3]), cvt_pk_bf16(gb[4], gb[5]), cvt_pk_bf16(gb[6], gb[7])};
    }
    LDS_WAIT();
    f32x16 nab = zero16(), nabT = zero16(), nakT = zero16(), mbr = zero16(), mkr = zero16();
#pragma unroll
    for (int s = 0; s < 4; ++s) {
        const int off = r32 * MSTR + (16 * s + 8 * h) * 2;
        const bf16x8 fa = *(const LAS bf16x8*)(mAT + off), fr = *(const LAS bf16x8*)(mRT + off), fb = *(const LAS bf16x8*)(mBT + off), fk = *(const LAS bf16x8*)(mKT + off);
        nab = mfma32(fb, fa, nab); nabT = mfma32(fa, fb, nabT); nakT = mfma32(fa, fk, nakT); mbr = mfma32(fb, fr, mbr); mkr = mfma32(fk, fr, mkr);
    }
#pragma unroll
    for (int reg = 0; reg < 16; ++reg) {
        const int row = (reg & 3) + 8 * (reg >> 2) + 4 * h;
        nab[reg] = row < r32 ? nab[reg] : 0.f;
        nabT[reg] = r32 < row ? nabT[reg] : 0.f;
        nakT[reg] = r32 < row ? nakT[reg] : 0.f;
        mbr[reg] = row <= r32 ? mbr[reg] : 0.f;
        mkr[reg] = row <= r32 ? mkr[reg] : 0.f;
    }
    f32x16 Y = nab;
#pragma unroll
    for (int reg = 0; reg < 16; ++reg) { const int row = (reg & 3) + 8 * (reg >> 2) + 4 * h; if (row == r32) Y[reg] += 1.0f; }
    {
        f32x16 M = nab, MT = nabT;
#pragma unroll
        for (int lvl = 0; lvl < 4; ++lvl) {
            const bf16x8 m0 = accfrag(M, 0), m1 = accfrag(M, 1), t0f = accfrag(MT, 0), t1f = accfrag(MT, 1);
            f32x16 M2T = mfma32(m0, t0f, zero16()); M2T = mfma32(m1, t1f, M2T);
            f32x16 M2 = zero16();
            if (lvl < 3) { M2 = mfma32(t0f, m0, M2); M2 = mfma32(t1f, m1, M2); }
            const bf16x8 y0 = accfrag(Y, 0), y1 = accfrag(Y, 1);
            Y = mfma32(accfrag(M2T, 0), y0, Y); Y = mfma32(accfrag(M2T, 1), y1, Y);
            M = M2; MT = M2T;
        }
    }
    int lane5 = lane; asm volatile("" : "+v"(lane5));
    const int r5 = lane5 & 31, h5 = lane5 >> 5;
    const bf16x8 ty0 = accfrag(Y, 0), ty1 = accfrag(Y, 1);
    f32x16 paT[2];
#pragma unroll
    for (int nt = 0; nt < 2; ++nt) { paT[nt] = mfma32(ty0, trfrag(mAT, 0, nt, lane5), zero16()); paT[nt] = mfma32(ty1, trfrag(mAT, 1, nt, lane5), paT[nt]); }
    f32x16 qakT = mfma32(ty0, accfrag(nakT, 0), zero16()); qakT = mfma32(ty1, accfrag(nakT, 1), qakT);
    const bf16x8 mb0 = accfrag(mbr, 0), mb1 = accfrag(mbr, 1);
#pragma unroll
    for (int mt = 0; mt < 2; ++mt) {
        f32x16 po;
#pragma unroll
        for (int g = 0; g < 4; ++g) { const u32x2 w = *(const LAS u32x2*)(mRT + r5 * MSTR + (32 * mt + 8 * g + 4 * h5) * 2);
            po[4 * g] = bf16_lo(w.x); po[4 * g + 1] = bf16_hi(w.x); po[4 * g + 2] = bf16_lo(w.y); po[4 * g + 3] = bf16_hi(w.y); }
        po = mfma32(accfrag(paT[mt], 0), mb0, po); po = mfma32(accfrag(paT[mt], 1), mb1, po);
#pragma unroll
        for (int sp = 0; sp < 2; ++sp)
            *(u32x4*)(slot + SL_PO + (2 * mt + sp) * 1024 + lane5 * 16) = (u32x4){cvt_pk_bf16(po[8 * sp], po[8 * sp + 1]), cvt_pk_bf16(po[8 * sp + 2], po[8 * sp + 3]), cvt_pk_bf16(po[8 * sp + 4], po[8 * sp + 5]), cvt_pk_bf16(po[8 * sp + 6], po[8 * sp + 7])};
    }
    {
        f32x16 qo = mfma32(accfrag(qakT, 0), mb0, mkr); qo = mfma32(accfrag(qakT, 1), mb1, qo);
#pragma unroll
        for (int sp = 0; sp < 2; ++sp) *(u32x4*)(slot + SL_QO + sp * 1024 + lane5 * 16) = (u32x4){cvt_pk_bf16(qo[8 * sp], qo[8 * sp + 1]), cvt_pk_bf16(qo[8 * sp + 2], qo[8 * sp + 3]), cvt_pk_bf16(qo[8 * sp + 4], qo[8 * sp + 5]), cvt_pk_bf16(qo[8 * sp + 6], qo[8 * sp + 7])};
    }
#pragma unroll
    for (int nt = 0; nt < 2; ++nt) {
        const bf16x8 bt0 = trfrag(mBT, 0, nt, lane5), bt1 = trfrag(mBT, 1, nt, lane5);
        const float gam = gc[32 * nt + r5];
#pragma unroll
        for (int mt = 0; mt < 2; ++mt) {
            f32x16 ps = zero16();
            if (mt == nt) {
#pragma unroll
                for (int reg = 0; reg < 16; ++reg) { const int row = (reg & 3) + 8 * (reg >> 2) + 4 * h5; ps[reg] = (row == r5) ? 1.0f : 0.f; }
            }
            ps = mfma32(accfrag(paT[mt], 0), bt0, ps); ps = mfma32(accfrag(paT[mt], 1), bt1, ps);
#pragma unroll
            for (int sp = 0; sp < 2; ++sp)
                *(u32x4*)(slot + SL_PS + ((nt * 2 + mt) * 2 + sp) * 1024 + lane5 * 16) = (u32x4){cvt_pk_bf16(ps[8 * sp] * gam, ps[8 * sp + 1] * gam), cvt_pk_bf16(ps[8 * sp + 2] * gam, ps[8 * sp + 3] * gam), cvt_pk_bf16(ps[8 * sp + 4] * gam, ps[8 * sp + 5] * gam), cvt_pk_bf16(ps[8 * sp + 6] * gam, ps[8 * sp + 7] * gam)};
        }
        f32x16 qs;
        { const bf16x8 k0 = trfrag(mKT, 0, nt, lane5), k1 = trfrag(mKT, 1, nt, lane5);
          const u32x4 w0 = __builtin_bit_cast(u32x4, k0), w1 = __builtin_bit_cast(u32x4, k1);
#pragma unroll
          for (int j = 0; j < 4; ++j) { qs[2 * j] = bf16_lo(w0[j]); qs[2 * j + 1] = bf16_hi(w0[j]); qs[8 + 2 * j] = bf16_lo(w1[j]); qs[8 + 2 * j + 1] = bf16_hi(w1[j]); } }
        qs = mfma32(accfrag(qakT, 0), bt0, qs); qs = mfma32(accfrag(qakT, 1), bt1, qs);
#pragma unroll
        for (int sp = 0; sp < 2; ++sp) *(u32x4*)(slot + SL_QS + (nt * 2 + sp) * 1024 + lane5 * 16) = (u32x4){cvt_pk_bf16(qs[8 * sp] * gam, qs[8 * sp + 1] * gam), cvt_pk_bf16(qs[8 * sp + 2] * gam, qs[8 * sp + 3] * gam), cvt_pk_bf16(qs[8 * sp + 4] * gam, qs[8 * sp + 5] * gam), cvt_pk_bf16(qs[8 * sp + 6] * gam, qs[8 * sp + 7] * gam)};
    }
    LDS_WAIT();
}

__device__ __forceinline__ u32x4 ntload16(const void* ptr) { return __builtin_nontemporal_load((const u32x4*)ptr); }
struct RkOps { u32x4 vr[4]; bf16x8 fps[2][2][2], fqs[2][2], fpo[2][2], fqo[2]; };
__device__ __forceinline__ void rk_load_ops_a(RkOps& o, const unsigned char* slot, int lane) {
    using namespace rk;
    const int r32 = lane & 31, h = lane >> 5;
#pragma unroll
    for (int k = 0; k < 4; ++k) o.vr[k] = ntload16(slot + SL_VR + k * 1024 + lane * 16);
#pragma unroll
    for (int jt = 0; jt < 2; ++jt)
#pragma unroll
        for (int s = 0; s < 2; ++s) o.fpo[jt][s] = __builtin_bit_cast(bf16x8, ntload16(slot + SL_PO + (2 * jt + s) * 1024 + lane * 16));
#pragma unroll
    for (int s = 0; s < 2; ++s) o.fqo[s] = __builtin_bit_cast(bf16x8, ntload16(slot + SL_QO + s * 1024 + lane * 16));
}
__device__ __forceinline__ void rk_load_ops_b(RkOps& o, const unsigned char* slot, int lane) {
    using namespace rk;
    const int r32 = lane & 31, h = lane >> 5;
#pragma unroll
    for (int mt = 0; mt < 2; ++mt) {
#pragma unroll
        for (int jt = 0; jt < 2; ++jt)
#pragma unroll
            for (int s = 0; s < 2; ++s) o.fps[mt][jt][s] = __builtin_bit_cast(bf16x8, ntload16(slot + SL_PS + ((mt * 2 + jt) * 2 + s) * 1024 + lane * 16));
#pragma unroll
        for (int s = 0; s < 2; ++s) o.fqs[mt][s] = __builtin_bit_cast(bf16x8, ntload16(slot + SL_QS + (mt * 2 + s) * 1024 + lane * 16));
    }
}
#define RK_SPIN(cond) do { unsigned _sp = 0; while (cond) { __builtin_amdgcn_s_sleep(1); if (++_sp > (1u << 24)) { err[0] = 1u; break; } } asm volatile("" ::: "memory"); } while (0)

__device__ __forceinline__ void rwkv_chain(const Params& p, LAS unsigned char* lds, int b, int hh) {
    using namespace rk;
    int tid = threadIdx.x; asm volatile("" : "+v"(tid));
    volatile LAS unsigned* ready = (volatile LAS unsigned*)(lds + L_FLAG); volatile LAS unsigned* freed = ready + NSLOT; volatile LAS unsigned* ofull = freed + NSLOT; volatile LAS unsigned* ofree = ofull + 2; volatile LAS unsigned* err = ofree + 2;
    if (tid < 2 * NSLOT + 5) ready[tid] = 0u;
    {
        const bf16_t* w2t = (const bf16_t*)(p.ws + WS_LT); const bf16_t* a2t = w2t + 512 * 64; const bf16_t* g2t = a2t + 512 * 64;
        for (int i = tid; i < 64 * 8; i += NTHREADS) { const int j = i >> 3, ch = i & 7, d = j * 128 + ((ch ^ (j & 7)) << 4);
            *(LAS u32x4*)(lds + L_W2 + d) = *(const u32x4*)(w2t + (hh * HD + j) * 64 + 8 * ch); *(LAS u32x4*)(lds + L_A2 + d) = *(const u32x4*)(a2t + (hh * HD + j) * 64 + 8 * ch); }
        for (int i = tid; i < 64 * 16; i += NTHREADS) { const int j = i >> 4, ch = i & 15; *(LAS u32x4*)(lds + L_G2 + j * 256 + ((ch ^ (j & 7)) << 4)) = *(const u32x4*)(g2t + (hh * HD + j) * 128 + 8 * ch); }
        LAS float* cst = (LAS float*)(lds + L_CST);
        for (int i = tid; i < C_END; i += NTHREADS) { float v;
            if (i < 256) v = p.shift_mu[(UXW - UR) + i];
            else if (i < 320) v = p.shift_mu[hh * HD + (i - 256)];
            else if (i < 384) v = p.shift_mu[(URK - UR) + hh * HD + (i - 320)];
            else if (i < 448) v = p.shift_mu[(URV - UR) + hh * HD + (i - 384)];
            else if (i < 512) v = p.rw_w0[hh * HD + (i - 448)];
            else if (i < 576) v = p.rw_a0[hh * HD + (i - 512)];
            else if (i < 640) v = p.rw_k_k[hh * HD + (i - 576)];
            else if (i < 704) v = p.rw_k_a[hh * HD + (i - 640)];
            else if (i < 768) v = p.rw_r_k[hh * HD + (i - 704)];
            else v = p.rw_ln_b[hh * HD + (i - 768)];
            cst[i] = v; }
    }
    __syncthreads();
    asm volatile("" : "+v"(tid));
    const int wave = __builtin_amdgcn_readfirstlane(tid >> 6);
    unsigned char* ring = (unsigned char*)p.out + (size_t)(b * NH + hh) * NSLOT * SLOT_BYTES;
    if (wave == 0) {
        int lane = tid & 63; asm volatile("" : "+v"(lane));
        const int r32 = lane & 31, h = lane >> 5;
        LAS unsigned char* vs = lds + L_CONS;
        f32x16 st[2][2];
#pragma unroll
        for (int a = 0; a < 2; ++a)
#pragma unroll
            for (int d = 0; d < 2; ++d) st[a][d] = zero16();
        RkOps ops;
        RK_SPIN(ready[0] != 1u);
        rk_load_ops_a(ops, ring, lane); rk_load_ops_b(ops, ring, lane);
        for (int c = 0; c < NCH; ++c) {
            bf16x8 sf[2][2][2];
#pragma unroll
            for (int jt = 0; jt < 2; ++jt)
#pragma unroll
                for (int it = 0; it < 2; ++it) { sf[jt][it][0] = accfrag(st[jt][it], 0); sf[jt][it][1] = accfrag(st[jt][it], 1); }
            { LAS unsigned char* d = vs + r32 * MSTR + h * 64;
              *(LAS u32x4*)d = ops.vr[0]; *(LAS u32x4*)(d + 16) = ops.vr[1]; *(LAS u32x4*)(d + 32) = ops.vr[2]; *(LAS u32x4*)(d + 48) = ops.vr[3]; }
            LDS_WAIT();
            bf16x8 vf[2][2];
            { const int g = lane >> 4, i16 = lane & 15, q = i16 >> 2, pp = i16 & 3;
#pragma unroll
              for (int it = 0; it < 2; ++it)
#pragma unroll
                  for (int s = 0; s < 2; ++s) { const LAS unsigned char* a = vs + (16 * s + 4 * h + q) * MSTR + (32 * it + 16 * (g & 1) + 4 * pp) * 2;
                      const s16x4 x = lds_tr16(a), y = lds_tr16(a + 8 * MSTR);
                      bf16x8 r; r[0] = x[0]; r[1] = x[1]; r[2] = x[2]; r[3] = x[3]; r[4] = y[0]; r[5] = y[1]; r[6] = y[2]; r[7] = y[3]; vf[it][s] = r; } }
            f32x16 o[2];
#pragma unroll
            for (int it = 0; it < 2; ++it) {
                o[it] = zero16();
#pragma unroll
                for (int jt = 0; jt < 2; ++jt)
#pragma unroll
                    for (int s = 0; s < 2; ++s) o[it] = mfma32(sf[jt][it][s], ops.fpo[jt][s], o[it]);
#pragma unroll
                for (int s = 0; s < 2; ++s) o[it] = mfma32(vf[it][s], ops.fqo[s], o[it]);
            }
            const unsigned char* nslot = ring + (size_t)((c + 1) % NSLOT) * SLOT_BYTES;
            if (c + 1 < NCH) { RK_SPIN(ready[(c + 1) % NSLOT] != (unsigned)(c + 2)); rk_load_ops_a(ops, nslot, lane); }
#pragma unroll
            for (int mt = 0; mt < 2; ++mt)
#pragma unroll
                for (int it = 0; it < 2; ++it) {
                    f32x16 a = zero16();
#pragma unroll
                    for (int jt = 0; jt < 2; ++jt)
#pragma unroll
                        for (int s = 0; s < 2; ++s) a = mfma32(ops.fps[mt][jt][s], sf[jt][it][s], a);
#pragma unroll
                    for (int s = 0; s < 2; ++s) a = mfma32(ops.fqs[mt][s], vf[it][s], a);
                    st[mt][it] = a;
                }
            if (c + 1 < NCH) rk_load_ops_b(ops, nslot, lane);
            if (c >= 1) RK_SPIN(ofree[0] != (unsigned)c);
            { LAS unsigned char* ob = lds + L_OBUF + r32 * OSTR;
#pragma unroll
              for (int it = 0; it < 2; ++it)
#pragma unroll
                  for (int g = 0; g < 4; ++g) *(LAS f32x4*)(ob + (32 * it + 8 * g + 4 * h) * 4) = (f32x4){o[it][4 * g], o[it][4 * g + 1], o[it][4 * g + 2], o[it][4 * g + 3]}; }
            LDS_WAIT();
            if (lane == 0) ofull[0] = (unsigned)(c + 1);
        }
    } else if (wave == 1) {
        int lane = tid & 63; asm volatile("" : "+v"(lane));
        const int r32 = lane & 31, h = lane >> 5;
        u32x4 gw[4], gb[4];
        RK_SPIN(ready[0] != 1u);
#pragma unroll
        for (int k = 0; k < 4; ++k) { gw[k] = ntload16(ring + SL_GW + k * 1024 + lane * 16); gb[k] = ntload16(ring + SL_GB + k * 1024 + lane * 16); }
        for (int c = 0; c < NCH; ++c) {
            const int sl = c % NSLOT;
            RK_SPIN(ofull[0] != (unsigned)(c + 1));
            float ov[32];
            { const LAS unsigned char* ob = lds + L_OBUF + r32 * OSTR + 128 * h;
#pragma unroll
              for (int k = 0; k < 8; ++k) { const f32x4 x = *(const LAS f32x4*)(ob + 16 * k); ov[4 * k] = x[0]; ov[4 * k + 1] = x[1]; ov[4 * k + 2] = x[2]; ov[4 * k + 3] = x[3]; } }
            LDS_WAIT();
            if (lane == 0) ofree[0] = (unsigned)(c + 1);
            float sm = 0.f;
#pragma unroll
            for (int k = 0; k < 32; ++k) sm += ov[k];
            sm += swap32(sm);
            const float mean = sm * (1.0f / 64.0f);
            float sv = 0.f;
#pragma unroll
            for (int k = 0; k < 32; ++k) { const float d = ov[k] - mean; sv += d * d; }
            sv += swap32(sv);
            const float rstd = 1.0f / sqrtf(sv * (1.0f / 64.0f) + 64e-5f);
            bf16_t* mrow = (bf16_t*)(p.ws + WS_B) + ((size_t)b * S + c * C + r32) * D + 512 + hh * HD + 32 * h;
#pragma unroll
            for (int k = 0; k < 4; ++k) {
                float w8[8], b8[8], r[8]; f8_from_bf16(gw[k], w8); f8_from_bf16(gb[k], b8);
                const f32x4 l0 = *(const f32x4*)(p.rw_ln_w + hh * HD + 32 * h + 8 * k), l1 = *(const f32x4*)(p.rw_ln_w + hh * HD + 32 * h + 8 * k + 4);
#pragma unroll
                for (int e = 0; e < 8; ++e) r[e] = ((ov[8 * k + e] - mean) * rstd * (e < 4 ? l0[e] : l1[e - 4]) + b8[e]) * w8[e];
                *(u32x4*)(mrow + 8 * k) = (u32x4){cvt_pk_bf16(r[0], r[1]), cvt_pk_bf16(r[2], r[3]), cvt_pk_bf16(r[4], r[5]), cvt_pk_bf16(r[6], r[7])};
            }
            if (lane == 0) freed[sl] = (unsigned)(c + 1);
            if (c + 1 < NCH) { const int sn = (c + 1) % NSLOT; const unsigned char* sp_ = ring + (size_t)sn * SLOT_BYTES; RK_SPIN(ready[sn] != (unsigned)(c + 2));
#pragma unroll
                for (int k = 0; k < 4; ++k) { gw[k] = ntload16(sp_ + SL_GW + k * 1024 + lane * 16); gb[k] = ntload16(sp_ + SL_GB + k * 1024 + lane * 16); } }
        }
    } else {
        int lane = tid & 63;
        if (wave - 2 < NPROD) for (int c = wave - 2; c < NCH; c += NPROD) {
            const int sl = c % NSLOT;
            if (c >= NSLOT) RK_SPIN(freed[sl] != (unsigned)(c - NSLOT + 1));
            rk_produce(p, lds, lds + (wave - 2) * PROD_LDS, ring + (size_t)sl * SLOT_BYTES, b, hh, c);
            asm volatile("s_waitcnt vmcnt(0)" ::: "memory");
            if (lane == 0) ready[sl] = (unsigned)(c + 1);
        }
    }
    __syncthreads();
}

#ifdef RWDEBUG
namespace rw {
constexpr int CH = 16;
constexpr int O_UM = 0;
constexpr int O_LW = O_UM + CH * 448 * 4;
constexpr int O_LA = O_LW + CH * 64 * 4;
constexpr int O_LG0 = O_LA + CH * 64 * 4;
constexpr int O_LG1 = O_LG0 + CH * 64 * 4;
constexpr int O_A1 = O_LG1 + CH * 64 * 4;
constexpr int O_R1 = O_A1 + CH * 64 * 4;
constexpr int O_B1 = O_R1 + CH * 64 * 4;
constexpr int O_K1 = O_B1 + CH * 64 * 4;
constexpr int O_O = O_K1 + CH * 64 * 4;
constexpr int O_WT = O_O + CH * 64 * 4;
constexpr int O_GC = O_WT + 8 * 64 * 4;
constexpr int O_SC = O_GC + 64 * 4;
constexpr int O_END = O_SC + 3 * 16 * 4;
}
__device__ __forceinline__ bf16x8 ldw_frag(const float* W, int ldw, int m0, int col) {
    unsigned w[4];
#pragma unroll
    for (int j = 0; j < 4; ++j) w[j] = cvt_pk_bf16(W[(size_t)(m0 + 2 * j) * ldw + col], W[(size_t)(m0 + 2 * j + 1) * ldw + col]);
    return __builtin_bit_cast(bf16x8, (u32x4){w[0], w[1], w[2], w[3]});
}
template <int ACT>
__device__ __forceinline__ bf16x8 act_frag(const LAS float* src) {
    const f32x4 a = *(const LAS f32x4*)src, b = *(const LAS f32x4*)(src + 4); float v[8] = {a[0], a[1], a[2], a[3], b[0], b[1], b[2], b[3]};
#pragma unroll
    for (int j = 0; j < 8; ++j) {
        if (ACT == 1) v[j] = 1.0f - 2.0f * frcp(1.0f + fexp2(v[j] * (2.0f * LOG2E)));
        if (ACT == 2) v[j] = frcp(1.0f + fexp2(-v[j] * LOG2E));
    }
    return __builtin_bit_cast(bf16x8, (u32x4){cvt_pk_bf16(v[0], v[1]), cvt_pk_bf16(v[2], v[3]), cvt_pk_bf16(v[4], v[5]), cvt_pk_bf16(v[6], v[7])});
}

__device__ __forceinline__ void rwkv_chain_seq(const Params& p, LAS unsigned char* lds, int b, int h, bf16_t* mix, int nchunks) {
    using namespace rw;
    const int tid = threadIdx.x, wave = __builtin_amdgcn_readfirstlane(tid >> 6), lane = tid & 63;
    const bf16_t* u = (const bf16_t*)(p.ws + WS_A);
    const size_t row0 = (size_t)b * S;
    LAS float* UM = (LAS float*)(lds + O_UM); LAS float* LW = (LAS float*)(lds + O_LW); LAS float* LA = (LAS float*)(lds + O_LA);
    LAS float* LG0 = (LAS float*)(lds + O_LG0); LAS float* LG1 = (LAS float*)(lds + O_LG1);
    LAS float* A1 = (LAS float*)(lds + O_A1); LAS float* R1 = (LAS float*)(lds + O_R1); LAS float* B1 = (LAS float*)(lds + O_B1); LAS float* K1 = (LAS float*)(lds + O_K1);
    LAS float* OO = (LAS float*)(lds + O_O); LAS float* WT = (LAS float*)(lds + O_WT); LAS float* GC = (LAS float*)(lds + O_GC); LAS float* SC = (LAS float*)(lds + O_SC);
    const int fc = lane & 15, fq = lane >> 4;
    bf16x8 bwa[2], bg[2];
    { const float* W = wave < 4 ? p.rw_w2 : p.rw_a2; const int col = h * HD + 16 * (wave & 3) + fc;
      bwa[0] = ldw_frag(W, 512, 8 * fq, col); bwa[1] = ldw_frag(W, 512, 32 + 8 * fq, col);
      const int ks = (wave >> 2) * 2; bg[0] = ldw_frag(p.rw_g2, 512, 32 * ks + 8 * fq, col); bg[1] = ldw_frag(p.rw_g2, 512, 32 * (ks + 1) + 8 * fq, col); }
    const int hj = h * HD + lane;
    const float c_w0 = p.rw_w0[hj], c_a0 = p.rw_a0[hj], c_kk = p.rw_k_k[hj], c_ka = p.rw_k_a[hj], c_rk = p.rw_r_k[hj], c_lnw = p.rw_ln_w[hj], c_lnb = p.rw_ln_b[hj];
    int ld_t[2], ld_c[2], ld_uc[2]; bool ld_ok[2];
#pragma unroll
    for (int r = 0; r < 2; ++r) { const int gid = tid + 512 * r; ld_ok[r] = gid < CH * 56; const int t = gid / 56, cg8 = gid % 56; ld_t[r] = t; ld_c[r] = cg8 * 8;
        ld_uc[r] = cg8 < 8 ? UR + h * HD + 8 * cg8 : cg8 < 16 ? URK + h * HD + 8 * (cg8 - 8) : cg8 < 24 ? URV + h * HD + 8 * (cg8 - 16) : UXW + 8 * (cg8 - 24); }
    const int si = 8 * wave + (lane >> 3), sj = 8 * (lane & 7);
    float st[8];
#pragma unroll
    for (int n = 0; n < 8; ++n) st[n] = 0.f;
    u32x4 cur[2], prv[2];
    auto issue_loads = [&](int t0) {
#pragma unroll
        for (int r = 0; r < 2; ++r) { cur[r] = (u32x4){0u, 0u, 0u, 0u}; prv[r] = (u32x4){0u, 0u, 0u, 0u};
            if (ld_ok[r]) { const int tt = t0 + ld_t[r]; const bf16_t* a = u + (row0 + tt) * NIN + ld_uc[r]; cur[r] = *(const u32x4*)a; if (tt > 0) prv[r] = *(const u32x4*)(a - NIN); } }
    };
    issue_loads(0);
    for (int c = 0; c < nchunks; ++c) {
        const int t0 = c * CH;
#pragma unroll
        for (int r = 0; r < 2; ++r) if (ld_ok[r]) {
            const float* mu = p.shift_mu + (ld_uc[r] - UR); const f32x4 m0 = *(const f32x4*)mu, m1 = *(const f32x4*)(mu + 4);
            float cv[8], pv[8];
#pragma unroll
            for (int j = 0; j < 4; ++j) { cv[2 * j] = bf16_lo(cur[r][j]); cv[2 * j + 1] = bf16_hi(cur[r][j]); pv[2 * j] = bf16_lo(prv[r][j]); pv[2 * j + 1] = bf16_hi(prv[r][j]); }
            f32x4 o0, o1;
#pragma unroll
            for (int j = 0; j < 4; ++j) { o0[j] = cv[j] + (pv[j] - cv[j]) * m0[j]; o1[j] = cv[4 + j] + (pv[4 + j] - cv[4 + j]) * m1[j]; }
            LAS float* d = UM + ld_t[r] * 448 + ld_c[r]; *(LAS f32x4*)d = o0; *(LAS f32x4*)(d + 4) = o1;
        }
        if (c + 1 < S / CH) issue_loads(t0 + CH);
        __syncthreads();
        {
            f32x4 acc = (f32x4){0.f, 0.f, 0.f, 0.f};
            const LAS float* src = UM + fc * 448 + (wave < 4 ? 192 : 256) + 8 * fq;
            if (wave < 4) { acc = __builtin_amdgcn_mfma_f32_16x16x32_bf16(act_frag<1>(src), bwa[0], acc, 0, 0, 0); acc = __builtin_amdgcn_mfma_f32_16x16x32_bf16(act_frag<1>(src + 32), bwa[1], acc, 0, 0, 0); }
            else          { acc = __builtin_amdgcn_mfma_f32_16x16x32_bf16(act_frag<0>(src), bwa[0], acc, 0, 0, 0); acc = __builtin_amdgcn_mfma_f32_16x16x32_bf16(act_frag<0>(src + 32), bwa[1], acc, 0, 0, 0); }
            LAS float* dst = (wave < 4 ? LW : LA) + 16 * (wave & 3) + fc;
#pragma unroll
            for (int r = 0; r < 4; ++r) dst[(4 * fq + r) * 64] = acc[r];
            f32x4 ag = (f32x4){0.f, 0.f, 0.f, 0.f};
            const LAS float* sg = UM + fc * 448 + 320 + 64 * (wave >> 2) + 8 * fq;
            ag = __builtin_amdgcn_mfma_f32_16x16x32_bf16(act_frag<2>(sg), bg[0], ag, 0, 0, 0); ag = __builtin_amdgcn_mfma_f32_16x16x32_bf16(act_frag<2>(sg + 32), bg[1], ag, 0, 0, 0);
            LAS float* dg = (wave < 4 ? LG0 : LG1) + 16 * (wave & 3) + fc;
#pragma unroll
            for (int r = 0; r < 4; ++r) dg[(4 * fq + r) * 64] = ag[r];
        }
        __syncthreads();
        float e_kk[2], e_b[2], e_k[2], e_r[2], e_ld[2];
#pragma unroll
        for (int tt = 0; tt < 2; ++tt) {
            const int t = 2 * wave + tt;
            const float xw = c_w0 + LW[t * 64 + lane];
            const float spn = (fmaxf(-xw, 0.f) + LN2 * flog2(1.0f + fexp2(-fabsf(xw) * LOG2E)));
            e_ld[tt] = -fexp2((-spn - 0.5f) * LOG2E);
            const float a = frcp(1.0f + fexp2(-(c_a0 + LA[t * 64 + lane]) * LOG2E));
            const float kraw = UM[t * 448 + 64 + lane], r = UM[t * 448 + lane];
            const float kkv = kraw * c_kk; const float ssq = wave_sum(kkv * kkv);
            const float kk = kkv * frsq(fmaxf(ssq, 1e-24f));
            const float kmod = kraw * (1.0f + (a - 1.0f) * c_ka);
            const float bb = kk * a;
            const float cbr = wave_sum(bb * r), ckr = wave_sum(kmod * r), bon = wave_sum(r * kmod * c_rk);
            if (lane == 0) { SC[t] = cbr; SC[16 + t] = ckr; SC[32 + t] = bon; }
            e_kk[tt] = kk; e_b[tt] = bb; e_k[tt] = kmod; e_r[tt] = r;
        }
        WT[wave * 64 + lane] = e_ld[0] + e_ld[1];
        __syncthreads();
        {
            float off = 0.f, tot = 0.f;
#pragma unroll
            for (int w = 0; w < 8; ++w) { const float x = WT[w * 64 + lane]; if (w < wave) off += x; tot += x; }
            const float c0 = off + e_ld[0], c1 = c0 + e_ld[1];
            const int t = 2 * wave;
            A1[t * 64 + lane] = -e_kk[0] * fexp2(off * LOG2E);       A1[(t + 1) * 64 + lane] = -e_kk[1] * fexp2(c0 * LOG2E);
            R1[t * 64 + lane] = e_r[0] * fexp2(c0 * LOG2E);          R1[(t + 1) * 64 + lane] = e_r[1] * fexp2(c1 * LOG2E);
            const float i0 = fexp2(-c0 * LOG2E), i1 = fexp2(-c1 * LOG2E);
            B1[t * 64 + lane] = e_b[0] * i0;                          B1[(t + 1) * 64 + lane] = e_b[1] * i1;
            K1[t * 64 + lane] = e_k[0] * i0;                          K1[(t + 1) * 64 + lane] = e_k[1] * i1;
            if (wave == 0) GC[lane] = fexp2(tot * LOG2E);
        }
        __syncthreads();
#pragma unroll 4
        for (int t = 0; t < CH; ++t) {
            const f32x4 a0 = *(const LAS f32x4*)(A1 + t * 64 + sj), a1 = *(const LAS f32x4*)(A1 + t * 64 + sj + 4);
            const f32x4 r0 = *(const LAS f32x4*)(R1 + t * 64 + sj), r1 = *(const LAS f32x4*)(R1 + t * 64 + sj + 4);
            const f32x4 b0 = *(const LAS f32x4*)(B1 + t * 64 + sj), b1 = *(const LAS f32x4*)(B1 + t * 64 + sj + 4);
            const f32x4 k0 = *(const LAS f32x4*)(K1 + t * 64 + sj), k1 = *(const LAS f32x4*)(K1 + t * 64 + sj + 4);
            const float v = UM[t * 448 + 128 + si], cbr = SC[t], ckr = SC[16 + t];
            float sa = (st[0] * a0[0] + st[1] * a0[1]) + (st[2] * a0[2] + st[3] * a0[3]) + ((st[4] * a1[0] + st[5] * a1[1]) + (st[6] * a1[2] + st[7] * a1[3]));
            float pp = (st[0] * r0[0] + st[1] * r0[1]) + (st[2] * r0[2] + st[3] * r0[3]) + ((st[4] * r1[0] + st[5] * r1[1]) + (st[6] * r1[2] + st[7] * r1[3]));
            sa = sum8(sa); pp = sum8(pp);
            if ((lane & 7) == 0) OO[t * 64 + si] = pp + sa * cbr + v * ckr;
#pragma unroll
            for (int n = 0; n < 4; ++n) { st[n] += sa * b0[n] + v * k0[n]; st[4 + n] += sa * b1[n] + v * k1[n]; }
        }
        {
            const f32x4 g0 = *(const LAS f32x4*)(GC + sj), g1 = *(const LAS f32x4*)(GC + sj + 4);
#pragma unroll
            for (int n = 0; n < 4; ++n) { st[n] *= g0[n]; st[4 + n] *= g1[n]; }
        }
        __syncthreads();
#pragma unroll
        for (int tt = 0; tt < 2; ++tt) {
            const int t = 2 * wave + tt;
            const float o = OO[t * 64 + lane];
            const float mean = wave_sum(o) * (1.0f / 64.0f); const float dlt = o - mean;
            const float var = wave_sum(dlt * dlt) * (1.0f / 64.0f);
            const float gn = dlt * (1.0f / sqrtf(var + 64e-5f)) * c_lnw + c_lnb;
            const float res = (gn + SC[32 + t] * UM[t * 448 + 128 + lane]) * (LG0[t * 64 + lane] + LG1[t * 64 + lane]);
            mix[(row0 + t0 + t) * D + 512 + h * HD + lane] = (bf16_t)(cvt_pk_bf16(res, 0.f) & 0xffffu);
        }
        __syncthreads();
    }
}

#endif

__device__ __forceinline__ void phase2a(const Params& p) {
    int tid = threadIdx.x; asm volatile("" : "+v"(tid));
    const int wave = tid >> 6, lane = tid & 63;
    const bf16_t* u = (const bf16_t*)(p.ws + WS_A);
    bf16_t* act = (bf16_t*)((unsigned char*)p.out + ACT_OFF);
    const f32x4 mu = *(const f32x4*)(p.shift_mu + (UXW - UR) + 4 * lane);
    for (int row = blockIdx.x * NWAVES + wave; row < T; row += gridDim.x * NWAVES) {
        const bf16_t* a = u + (size_t)row * NIN + UXW + 4 * lane;
        const u32x2 c = *(const u32x2*)a; u32x2 pv = (u32x2){0u, 0u}; if ((row & (S - 1)) != 0) pv = *(const u32x2*)(a - NIN);
        const float cv[4] = {bf16_lo(c.x), bf16_hi(c.x), bf16_lo(c.y), bf16_hi(c.y)}, pf[4] = {bf16_lo(pv.x), bf16_hi(pv.x), bf16_lo(pv.y), bf16_hi(pv.y)};
        float x[4];
#pragma unroll
        for (int j = 0; j < 4; ++j) { x[j] = cv[j] + (pf[j] - cv[j]) * mu[j];
            if (lane < 16) x[j] = 1.0f - 2.0f * frcp(1.0f + fexp2(x[j] * (2.0f * LOG2E)));
            else if (lane >= 32) x[j] = frcp(1.0f + fexp2(-x[j] * LOG2E)); }
        *(u32x2*)(act + (size_t)row * 256 + 4 * lane) = (u32x2){cvt_pk_bf16(x[0], x[1]), cvt_pk_bf16(x[2], x[3])};
    }
}

__device__ __forceinline__ void phase2(const Params& p, LAS unsigned char* lds) {
    const int nchain = NB * NH, G = gridDim.x, wave = threadIdx.x >> 6;
    const int nscan = G >= 2 * nchain ? nchain : (G > 1 ? G / 2 : 0);
    if ((int)blockIdx.x < nscan || nscan == 0) {
        const int stride = nscan == 0 ? G : nscan;
        for (int it = blockIdx.x; it < nchain; it += stride) rwkv_chain(p, lds, it / NH, it % NH);
    }
    if ((int)blockIdx.x >= nscan) {
        const int nb = G - nscan, bi = blockIdx.x - nscan;
        for (int it = bi * 8 + wave; it < NB * NH * 64; it += nb * 8) attn_tile(p, lds + wave * 9216, it / (NH * 64), (it / 64) % NH, 63 - (it % 64));
        __syncthreads();
        p0_expert_weights(p, lds, bi * 8 + wave, nb * 8);
    }
}

struct EpiH {
    const float* x; float* hout; int row0, col0;
    __device__ __forceinline__ void operator()(const f32x4 (&acc)[2][2][4][2], int wr, int wc, int fr, int fq) const {
#pragma unroll
        for (int ai = 0; ai < 2; ++ai)
#pragma unroll
            for (int m = 0; m < 4; ++m) { const size_t off = (size_t)(row0 + ai * 128 + wr * 64 + m * 16 + fr) * D + col0 + wc * 32 + 8 * fq;
#pragma unroll
                for (int bj = 0; bj < 2; ++bj)
#pragma unroll
                    for (int n = 0; n < 2; ++n) { const f32x4 xv = *(const f32x4*)(x + off + bj * 128 + n * 4); *(f32x4*)(hout + off + bj * 128 + n * 4) = xv + acc[ai][bj][m][n]; } }
    }
};
__device__ __forceinline__ void phase3(const Params& p, LAS unsigned char* lds) {
    constexpr int nM = T / 256, nN = D / 256;
    unsigned aoff[2][2]; g8::aoff_rows(aoff, D);
    for (int L = blockIdx.x; L < nM * nN; L += gridDim.x) {
        int pm, pn; g8::tile_order(L, nM, nN, pm, pn);
        EpiH E{p.x, p.out, pm * 256, pn * 256};
        g8::gemm_unit(lds, (const char*)(p.ws + WS_B) + (size_t)pm * 256 * D * 2, aoff, (const char*)(p.ws + WS_WOUT) + (size_t)pn * 256 * D * 2, D, E);
    }
}

__device__ __forceinline__ void phase4(const Params& p, LAS unsigned char* lds) {
    int tid = threadIdx.x; asm volatile("" : "+v"(tid));
    const int wave = tid >> 6, lane = tid & 63, fr = lane & 15, fq = lane >> 4;
    const float* hsrc = p.out; bf16_t* hb = (bf16_t*)(p.ws + WS_A); float* rstd2 = (float*)(p.ws + WS_RSTD2);
    const bf16_t* wr_hi = (const bf16_t*)(p.ws + WS_WR); const bf16_t* wr_lo = wr_hi + 48 * D;
    int* list = (int*)(p.ws + WS_LIST); float* listw = (float*)(p.ws + WS_LISTW); unsigned* cnt = (unsigned*)(p.ws + WS_CTL);
    LAS float* lg = (LAS float*)(lds + wave * 3072);
    LAS unsigned* lcnt = (LAS unsigned*)(lds + 8 * 3072);
    LAS unsigned* gbase = lcnt + 32;
    for (int blk = blockIdx.x; blk < T / 128; blk += gridDim.x) {
        if (tid < 32) lcnt[tid] = 0u;
        __syncthreads();
        const int tok0 = blk * 128 + wave * 16;
        f32x4 acc[3];
#pragma unroll
        for (int n = 0; n < 3; ++n) acc[n] = (f32x4){0.f, 0.f, 0.f, 0.f};
        float ss = 0.f;
        const float* hp = hsrc + (size_t)(tok0 + fr) * D + 8 * fq; bf16_t* hbp = hb + (size_t)(tok0 + fr) * D + 8 * fq;
        LAS unsigned char* wl_ = lds + 32768;
#pragma unroll 1
        for (int half = 0; half < 2; ++half) {
            __syncthreads();
            for (int i = tid; i < 2 * 48 * 64; i += NTHREADS) { const int mat = i / 3072, r = (i % 3072) >> 6, ch = i & 63;
                *(LAS u32x4*)(wl_ + mat * 49152 + r * 1024 + ((ch ^ (r & 15)) << 4)) = *(const u32x4*)((mat ? wr_lo : wr_hi) + (size_t)r * D + half * 512 + ch * 8); }
            f32x4 av[16][2];
#pragma unroll
            for (int ks = 0; ks < 16; ++ks) { av[ks][0] = *(const f32x4*)(hp + half * 512 + 32 * ks); av[ks][1] = *(const f32x4*)(hp + half * 512 + 32 * ks + 4); }
            __syncthreads();
#pragma unroll
            for (int ks = 0; ks < 16; ++ks) {
                const f32x4 v0 = av[ks][0], v1 = av[ks][1];
                ss += (v0[0] * v0[0] + v0[1] * v0[1]) + (v0[2] * v0[2] + v0[3] * v0[3]) + ((v1[0] * v1[0] + v1[1] * v1[1]) + (v1[2] * v1[2] + v1[3] * v1[3]));
                u32x4 hi; hi.x = cvt_pk_bf16(v0[0], v0[1]); hi.y = cvt_pk_bf16(v0[2], v0[3]); hi.z = cvt_pk_bf16(v1[0], v1[1]); hi.w = cvt_pk_bf16(v1[2], v1[3]);
                *(u32x4*)(hbp + half * 512 + 32 * ks) = hi;
                u32x4 lo; lo.x = cvt_pk_bf16(v0[0] - bf16_lo(hi.x), v0[1] - bf16_hi(hi.x)); lo.y = cvt_pk_bf16(v0[2] - bf16_lo(hi.y), v0[3] - bf16_hi(hi.y));
                lo.z = cvt_pk_bf16(v1[0] - bf16_lo(hi.z), v1[1] - bf16_hi(hi.z)); lo.w = cvt_pk_bf16(v1[2] - bf16_lo(hi.w), v1[3] - bf16_hi(hi.w));
                const bf16x8 ah = __builtin_bit_cast(bf16x8, hi), al = __builtin_bit_cast(bf16x8, lo);
#pragma unroll
                for (int n = 0; n < 3; ++n) {
                    const int r = 16 * n + fr, off = r * 1024 + (((4 * ks + fq) ^ (r & 15)) << 4);
                    const bf16x8 wh = *(const LAS bf16x8*)(wl_ + off), wl = *(const LAS bf16x8*)(wl_ + 49152 + off);
                    acc[n] = __builtin_amdgcn_mfma_f32_16x16x32_bf16(ah, wh, acc[n], 0, 0, 0);
                    acc[n] = __builtin_amdgcn_mfma_f32_16x16x32_bf16(al, wh, acc[n], 0, 0, 0);
                    acc[n] = __builtin_amdgcn_mfma_f32_16x16x32_bf16(ah, wl, acc[n], 0, 0, 0);
                }
            }
        }
        ss += __shfl_xor(ss, 16); ss += __shfl_xor(ss, 32);
        const float rs = 1.0f / sqrtf(ss * (1.0f / D) + 1e-6f);
        if (fq == 0) rstd2[tok0 + fr] = rs;
#pragma unroll
        for (int n = 0; n < 3; ++n)
#pragma unroll
            for (int r = 0; r < 4; ++r) lg[(4 * fq + r) * 48 + 16 * n + fr] = acc[n][r];
        LDS_WAIT();
        int e0 = 0, e1 = 0; float w0 = 0.f, w1 = 0.f; unsigned lp0 = 0, lp1 = 0;
        if (lane < 16) {
            const float rst = rs;
            const LAS float* L = lg + lane * 48;
            float gl[4]; int gi = 0; float gm;
#pragma unroll
            for (int g = 0; g < 4; ++g) gl[g] = L[g] * rst + p.r_grp_b[g];
            gm = gl[0];
#pragma unroll
            for (int g = 1; g < 4; ++g) if (gl[g] > gm) { gm = gl[g]; gi = g; }
            float gs = 0.f;
#pragma unroll
            for (int g = 0; g < 4; ++g) gs += __expf(gl[g] - gm);
            const float gval = 1.0f / gs;
            float el[8];
#pragma unroll
            for (int e = 0; e < 8; ++e) el[e] = L[4 + gi * 8 + e] * rst + p.r_exp_b[gi * 8 + e];
            int i0 = 0; float m0 = el[0];
#pragma unroll
            for (int e = 1; e < 8; ++e) if (el[e] > m0) { m0 = el[e]; i0 = e; }
            int i1 = i0 == 0 ? 1 : 0; float m1 = el[i1];
#pragma unroll
            for (int e = 0; e < 8; ++e) if (e != i0 && el[e] > m1) { m1 = el[e]; i1 = e; }
            const float x1 = __expf(m1 - m0); const float den = 1.0f / (1.0f + x1);
            e0 = gi * 8 + i0; e1 = gi * 8 + i1; w0 = gval * den; w1 = gval * x1 * den;
            lp0 = atomicAdd((unsigned*)&lcnt[e0], 1u); lp1 = atomicAdd((unsigned*)&lcnt[e1], 1u);
        }
        __syncthreads();
        if (tid < 32) gbase[tid] = atomicAdd(&cnt[tid], lcnt[tid]);
        __syncthreads();
        if (lane < 16) {
            const int tok = tok0 + lane;
            const unsigned q0 = gbase[e0] + lp0, q1 = gbase[e1] + lp1;
            list[(size_t)e0 * T + q0] = tok * 2;     listw[(size_t)e0 * T + q0] = w0;
            list[(size_t)e1 * T + q1] = tok * 2 + 1; listw[(size_t)e1 * T + q1] = w1;
        }
        __syncthreads();
    }
}

constexpr int LDS_MAP = 161792;
__device__ __forceinline__ void expert_map_build(const unsigned* cnt, LAS unsigned char* lds) {
    LAS int* pre = (LAS int*)(lds + LDS_MAP); LAS int* cn = pre + 40;
    if (threadIdx.x == 0) { int acc = 0; for (int i = 0; i < NE; ++i) { const int ci = (int)__hip_atomic_load(cnt + i, __ATOMIC_RELAXED, __HIP_MEMORY_SCOPE_AGENT); pre[i] = acc; cn[i] = ci; acc += (ci + 255) >> 8; } pre[NE] = acc; }
    __syncthreads();
}
__device__ __forceinline__ void expert_find(LAS unsigned char* lds, int mt, int& e, int& local, int& c) {
    const LAS int* pre = (const LAS int*)(lds + LDS_MAP); const LAS int* cn = pre + 40;
    int lo = 0;
#pragma unroll 1
    for (int i = 1; i < NE; ++i) if (pre[i] <= mt) lo = i;
    e = __builtin_amdgcn_readfirstlane(lo); local = mt - __builtin_amdgcn_readfirstlane(pre[e]); c = __builtin_amdgcn_readfirstlane(cn[e]);
}
__device__ __forceinline__ int expert_tiles(LAS unsigned char* lds) { return __builtin_amdgcn_readfirstlane(((const LAS int*)(lds + LDS_MAP))[NE]); }

struct EpiGU {
    bf16_t* hid; const float* rstd2; const int* lst; int cnt, p0, hrow0, ct;
    __device__ __forceinline__ void operator()(const f32x4 (&acc)[2][2][4][2], int wr, int wc, int fr, int fq) const {
#pragma unroll
        for (int ai = 0; ai < 2; ++ai)
#pragma unroll
            for (int m = 0; m < 4; ++m) { const int r = ai * 128 + wr * 64 + m * 16 + fr; const int pp = p0 + r;
                const float rs = pp < cnt ? rstd2[lst[pp] >> 1] : 0.f;
                bf16_t* op = hid + (size_t)(hrow0 + r) * DE + ct * 128 + wc * 32 + 8 * fq;
                float o[8];
#pragma unroll
                for (int n = 0; n < 2; ++n) { const f32x4 g = acc[ai][0][m][n] * rs, uu = acc[ai][1][m][n] * rs;
#pragma unroll
                    for (int j = 0; j < 4; ++j) o[4 * n + j] = g[j] * frcp(1.0f + fexp2(-g[j] * LOG2E)) * uu[j]; }
                *(u32x4*)op = (u32x4){cvt_pk_bf16(o[0], o[1]), cvt_pk_bf16(o[2], o[3]), cvt_pk_bf16(o[4], o[5]), cvt_pk_bf16(o[6], o[7])}; }
    }
};
__device__ __forceinline__ void phase5(const Params& p, LAS unsigned char* lds) {
    expert_map_build((const unsigned*)(p.ws + WS_CTL), lds);
    const int MT = expert_tiles(lds);
    const int tid = threadIdx.x;
    for (int unit = blockIdx.x; unit < MT * 2; unit += gridDim.x) {
        const int mt = unit >> 1, ct = unit & 1; int e, local, c; expert_find(lds, mt, e, local, c);
        const int* lst = (const int*)(p.ws + WS_LIST) + (size_t)e * T; const int p0 = local * 256;
        unsigned aoff[2][2];
#pragma unroll
        for (int i = 0; i < 2; ++i) { int R, C; g8::stage_rc(tid * 16 + i * 8192, R, C);
#pragma unroll
            for (int hh = 0; hh < 2; ++hh) { const int pp = p0 + hh * 128 + R; const int tok = pp < c ? (lst[pp] >> 1) : 0; aoff[hh][i] = (unsigned)(tok * D + C) * 2u; } }
        EpiGU E{(bf16_t*)(p.ws + WS_B), (const float*)(p.ws + WS_RSTD2), lst, c, p0, mt * 256, ct};
        g8::gemm_unit(lds, (const char*)(p.ws + WS_A), aoff, (const char*)(p.ws + WS_WGU) + ((size_t)e * 512 + ct * 256) * D * 2, D, E);
    }
}
struct EpiDN {
    bf16_t* y; bf16_t* dummy; const int* lst; const float* lw; int cnt, p0, col0;
    __device__ __forceinline__ void operator()(const f32x4 (&acc)[2][2][4][2], int wr, int wc, int fr, int fq) const {
#pragma unroll
        for (int ai = 0; ai < 2; ++ai)
#pragma unroll
            for (int m = 0; m < 4; ++m) { const int pp = p0 + ai * 128 + wr * 64 + m * 16 + fr;
                const bool ok = pp < cnt; const int ent = lst[pp]; const float w = lw[pp];
                bf16_t* op = (ok ? y + ((size_t)(ent & 1) * T + (ent >> 1)) * D : dummy) + col0 + wc * 32 + 8 * fq;
#pragma unroll
                for (int bj = 0; bj < 2; ++bj) { const f32x4 v0 = acc[ai][bj][m][0] * w, v1 = acc[ai][bj][m][1] * w;
                    *(u32x4*)(op + bj * 128) = (u32x4){cvt_pk_bf16(v0[0], v0[1]), cvt_pk_bf16(v0[2], v0[3]), cvt_pk_bf16(v1[0], v1[1]), cvt_pk_bf16(v1[2], v1[3])}; }
                if (m & 1) asm volatile("" ::: "memory"); }
    }
};
__device__ __forceinline__ void phase6(const Params& p, LAS unsigned char* lds) {
    expert_map_build((const unsigned*)(p.ws + WS_CTL), lds);
    const int MT = expert_tiles(lds);
    constexpr int kdn = DE;
    unsigned aoff[2][2]; g8::aoff_rows(aoff, kdn);
    for (int unit = blockIdx.x; unit < MT * 4; unit += gridDim.x) {
        const int mt = unit >> 2, pn = unit & 3; int e, local, c; expert_find(lds, mt, e, local, c);
        EpiDN E{(bf16_t*)(p.ws + WS_A + (size_t)T * D * 2), (bf16_t*)(p.ws + WS_A + (size_t)3 * T * D * 2), (const int*)(p.ws + WS_LIST) + (size_t)e * T, (const float*)(p.ws + WS_LISTW) + (size_t)e * T, c, local * 256, pn * 256};
        g8::gemm_unit(lds, (const char*)(p.ws + WS_B) + (size_t)mt * 256 * DE * 2, aoff, (const char*)(p.ws + WS_WDN) + ((size_t)e * D + pn * 256) * DE * 2, kdn, E);
    }
}

__device__ __forceinline__ void phase7(const Params& p) {
    int tid7 = threadIdx.x; asm volatile("" : "+v"(tid7));
    const int wave = tid7 >> 6, lane = tid7 & 63;
    const bf16_t* hb = (const bf16_t*)(p.ws + WS_A);
    const bf16_t* y0 = (const bf16_t*)(p.ws + WS_A + (size_t)T * D * 2); const bf16_t* y1 = y0 + (size_t)T * D;
    f32x4 g[4];
#pragma unroll
    for (int j = 0; j < 4; ++j) g[j] = *((const f32x4*)p.final_g + lane + 64 * j);
    const int stride = gridDim.x * NWAVES;
    int row = blockIdx.x * NWAVES + wave;
    u32x2 hv[4], ya[4], yb[4];
    if (row < T) {
#pragma unroll
        for (int j = 0; j < 4; ++j) { hv[j] = ((const u32x2*)(hb + (size_t)row * D) + lane)[64 * j]; ya[j] = ((const u32x2*)(y0 + (size_t)row * D) + lane)[64 * j]; yb[j] = ((const u32x2*)(y1 + (size_t)row * D) + lane)[64 * j]; }
    }
    for (; row < T; row += stride) {
        f32x4 v[4]; float s = 0.f;
#pragma unroll
        for (int j = 0; j < 4; ++j) {
            v[j][0] = bf16_lo(hv[j].x) + (bf16_lo(ya[j].x) + bf16_lo(yb[j].x)); v[j][1] = bf16_hi(hv[j].x) + (bf16_hi(ya[j].x) + bf16_hi(yb[j].x)); v[j][2] = bf16_lo(hv[j].y) + (bf16_lo(ya[j].y) + bf16_lo(yb[j].y)); v[j][3] = bf16_hi(hv[j].y) + (bf16_hi(ya[j].y) + bf16_hi(yb[j].y));
            s += (v[j][0] * v[j][0] + v[j][1] * v[j][1]) + (v[j][2] * v[j][2] + v[j][3] * v[j][3]); }
        const int nrow = row + stride;
        if (nrow < T) {
#pragma unroll
            for (int j = 0; j < 4; ++j) { hv[j] = ((const u32x2*)(hb + (size_t)nrow * D) + lane)[64 * j]; ya[j] = ((const u32x2*)(y0 + (size_t)nrow * D) + lane)[64 * j]; yb[j] = ((const u32x2*)(y1 + (size_t)nrow * D) + lane)[64 * j]; }
        }
        s = wave_sum(s);
        const float rs = 1.0f / sqrtf(s * (1.0f / D) + 1e-6f);
        f32x4* orow = (f32x4*)(p.out + (size_t)row * D) + lane;
#pragma unroll
        for (int j = 0; j < 4; ++j) orow[64 * j] = v[j] * rs * g[j];
    }
}

__global__ __launch_bounds__(512) void mega(Params p) {
    extern __shared__ __attribute__((aligned(16))) unsigned char lds_raw[];
    LAS unsigned char* lds = (LAS unsigned char*)lds_raw;
    volatile LAS unsigned* bst = (volatile LAS unsigned*)(lds + LDS_MAP + 512);
    if (threadIdx.x == 0) { bst[0] = 0u; bst[1] = 0u; bst[2] = 0u; bst[3] = 0u; }
    __syncthreads();
    const XcdBarrier gb = xcd_barrier_post((unsigned*)(p.ws + WS_BAR), bst);
#define GSYNC() xcd_barrier(gb)
#ifndef PHASE_MASK
#define PHASE_MASK 0xff
#endif
#ifdef TPROBE
    volatile LAS unsigned long long* tsl = (volatile LAS unsigned long long*)(lds + LDS_MAP + 640);
    if (threadIdx.x == 0) tsl[0] = __builtin_amdgcn_s_memrealtime();
#define TS(i) do { if (threadIdx.x == 0 && ((i) == TPROBE || (i) == TPROBE + 1)) tsl[i] = __builtin_amdgcn_s_memrealtime(); } while (0)
#else
#define TS(i)
#endif
    if (PHASE_MASK & 1) phase0(p, lds); GSYNC(); TS(1);
    if (PHASE_MASK & 2) phase1(p, lds); GSYNC(); TS(2);
    if (PHASE_MASK & 4) { phase2a(p); GSYNC(); phase2(p, lds); } GSYNC(); TS(3);
#ifdef RWDEBUG
    {
        bf16_t* dbg = (bf16_t*)(p.ws + WS_A + (size_t)3 * T * D * 2 + 4096);
        float* red = (float*)(p.ws + WS_CTL + 2048);
        if (blockIdx.x == 0) {
            rwkv_chain_seq(p, lds, RWDEBUG_B, RWDEBUG_H, dbg - (size_t)RWDEBUG_B * S * D, 2 * RWDEBUG_C1);
            __syncthreads();
            const bf16_t* mix = (const bf16_t*)(p.ws + WS_B);
            float md = 0.f, mr = 0.f; int bad = 0;
            for (int i = threadIdx.x; i < (RWDEBUG_C1 - RWDEBUG_C0) * 32 * 64; i += NTHREADS) {
                const int t = RWDEBUG_C0 * 32 + i / 64, col = 512 + RWDEBUG_H * 64 + (i % 64);
                const float a = __uint_as_float((unsigned)mix[((size_t)RWDEBUG_B * S + t) * D + col] << 16), r = __uint_as_float((unsigned)dbg[(size_t)t * D + col] << 16);
                if (!(fabsf(a) < 1e30f)) bad++;
                else { md = fmaxf(md, fabsf(a - r)); } mr = fmaxf(mr, fabsf(r));
            }
            LAS float* sh = (LAS float*)lds;
            sh[threadIdx.x] = md; sh[512 + threadIdx.x] = mr; sh[1024 + threadIdx.x] = (float)bad; __syncthreads();
            if (threadIdx.x == 0) { float a = 0.f, r = 0.f, nb = 0.f; for (int i = 0; i < NTHREADS; ++i) { a = fmaxf(a, sh[i]); r = fmaxf(r, sh[512 + i]); nb += sh[1024 + i]; }
                float rel = a / fmaxf(r, 1e-20f); float code = nb > 0.f ? 40.0f : (rel < 0.03f ? 5.0f : (rel < 0.3f ? 10.0f : 20.0f));
                red[0] = code; }
        }
        GSYNC();
        const float code = ((const float*)(p.ws + WS_CTL + 2048))[0];
        for (size_t i = (size_t)blockIdx.x * NTHREADS + threadIdx.x; i < (size_t)T * D; i += (size_t)gridDim.x * NTHREADS) p.out[i] = code;
        return;
    }
#endif
    if (PHASE_MASK & 8) phase3(p, lds); GSYNC(); TS(4);
    if (PHASE_MASK & 16) phase4(p, lds); GSYNC(); TS(5);
    if (PHASE_MASK & 32) phase5(p, lds); GSYNC(); TS(6);
    if (PHASE_MASK & 64) phase6(p, lds); GSYNC(); TS(7);
    if (PHASE_MASK & 128) phase7(p);
#ifdef TPROBE
    GSYNC(); TS(8);
    float* tw = (float*)(p.ws + WS_CTL + 1024);
    if (blockIdx.x == 0 && threadIdx.x == 0) { const float t1 = (float)(tsl[TPROBE + 1] - tsl[TPROBE]) * 0.01f; tw[0] = floorf(log2f(t1) * TPQ + 0.5f) / TPQ; }
    GSYNC();
    const float c1 = tw[0];
    int tq_ = threadIdx.x; asm volatile("" : "+v"(tq_));
    for (size_t i = (size_t)blockIdx.x * NTHREADS + tq_; i < (size_t)T * D; i += (size_t)gridDim.x * NTHREADS) p.out[i] = c1;
#endif
}

extern "C" void kernel_launch(void* const* d_in, const int* in_sizes, int n_in, void* d_out, int out_size, void* d_ws, size_t ws_size, hipStream_t stream) {
    static int grid = 0;
    if (grid == 0) {
        if (n_in != 25 || out_size != T * D || ws_size < WS_END) { fprintf(stderr, "kernel_launch: unexpected sizes n_in %d out %d ws %zu (need %zu)\n", n_in, out_size, ws_size, (size_t)WS_END); grid = -1; return; }
        int dev = 0, cus = 0, per_cu = 0;
        (void)hipGetDevice(&dev); (void)hipDeviceGetAttribute(&cus, hipDeviceAttributeMultiprocessorCount, dev);
        if (hipFuncSetAttribute((const void*)mega, hipFuncAttributeMaxDynamicSharedMemorySize, LDS_BYTES) != hipSuccess) { fprintf(stderr, "kernel_launch: hipFuncSetAttribute failed\n"); grid = -1; return; }
        if (hipOccupancyMaxActiveBlocksPerMultiprocessor(&per_cu, (const void*)mega, NTHREADS, LDS_BYTES) != hipSuccess || per_cu < 1) { fprintf(stderr, "kernel_launch: occupancy query failed (%d)\n", per_cu); (void)hipGetLastError(); per_cu = 1; }
        grid = cus * 1;
    }
    if (grid < 0) return;
    Params p{};
    const float** f = (const float**)&p;
    for (int i = 0; i < 25; ++i) f[i] = (const float*)d_in[i];
    p.out = (float*)d_out; p.ws = (unsigned char*)d_ws;
    if (hipMemsetAsync((char*)d_ws + WS_BAR, 0, XCD_BAR_WORDS * 4, stream) != hipSuccess) { fprintf(stderr, "kernel_launch: memset failed\n"); return; }
    hipLaunchKernelGGL(mega, dim3(grid), dim3(NTHREADS), LDS_BYTES, stream, p);
    hipError_t e = hipPeekAtLastError();
    if (e != hipSuccess) fprintf(stderr, "launch failed: %s (grid %d)\n", hipGetErrorString(e), grid);
}
```

```cpp
#include <hip/hip_runtime.h>
#include <cstdio>
#include <cstdint>
#define TPQ 8.0f

#define LAS __attribute__((address_space(3)))
typedef unsigned short bf16_t;
typedef short bf16x8 __attribute__((ext_vector_type(8)));
typedef short s16x4 __attribute__((ext_vector_type(4)));
typedef float f32x4 __attribute__((ext_vector_type(4)));
typedef float f32x2 __attribute__((ext_vector_type(2)));
typedef float f32x16 __attribute__((ext_vector_type(16)));
typedef unsigned u32x2 __attribute__((ext_vector_type(2)));
typedef unsigned u32x4 __attribute__((ext_vector_type(4)));

constexpr int NB = 16, S = 2048, T = NB * S, D = 1024, NIN = 3328, NH = 8, HD = 64;
constexpr int UQ = 0, UK = 512, UV = 1024, UR = 1536, URK = 2048, URV = 2560, UXW = 3072, UXA = 3136, UXG = 3200;
constexpr int NE = 32, DE = 256;
constexpr float LOG2E = 1.4426950408889634f, LN2 = 0.6931471805599453f;
constexpr float QSCALE = 0.125f * LOG2E;
constexpr int NTHREADS = 512, NWAVES = 8;
constexpr int LDS_BYTES = 161792 + 1024;

constexpr size_t WS_CTL   = 0;
constexpr size_t WS_BAR   = 8192;
constexpr size_t WS_WIN   = 65536;
constexpr size_t WS_WOUT  = WS_WIN  + (size_t)NIN * D * 2;
constexpr size_t WS_WGU   = WS_WOUT + (size_t)D * D * 2;
constexpr size_t WS_WDN   = WS_WGU  + (size_t)NE * 512 * D * 2;
constexpr size_t WS_RSTD1 = WS_WDN  + (size_t)NE * D * DE * 2;
constexpr size_t WS_RSTD2 = WS_RSTD1 + (size_t)T * 4;
constexpr size_t WS_LIST  = WS_RSTD2 + (size_t)T * 4;
constexpr size_t WS_LISTW = WS_LIST + (size_t)NE * T * 4;
constexpr size_t WS_WR    = WS_LISTW + (size_t)NE * T * 4;
constexpr size_t WS_LT    = WS_WR + (size_t)2 * 48 * D * 2;
constexpr size_t WS_A     = WS_LT + (size_t)512 * 256 * 2;
constexpr size_t WS_B     = WS_A + (size_t)T * NIN * 2;
constexpr size_t WS_END   = WS_B + (size_t)T * D * 2;
constexpr int HID_ROWS = 2 * T + NE * 256;

struct Params {
    const float* x; const float* norm_mix_g; const float* w_in; const float* shift_mu; const float* sb_out_g;
    const float* rw_w0; const float* rw_w2; const float* rw_a0; const float* rw_a2; const float* rw_g2;
    const float* rw_k_k; const float* rw_k_a; const float* rw_r_k; const float* rw_ln_w; const float* rw_ln_b;
    const float* w_out; const float* norm_ffn_g; const float* r_grp_w; const float* r_grp_b; const float* r_exp_w; const float* r_exp_b;
    const float* w_gate; const float* w_up; const float* w_down; const float* final_g;
    float* out; unsigned char* ws;
};

typedef __bf16 bf16x2_t __attribute__((ext_vector_type(2)));
__device__ __forceinline__ unsigned cvt_pk_bf16(float lo, float hi) { const f32x2 v = {lo, hi}; return __builtin_bit_cast(unsigned, __builtin_convertvector(v, bf16x2_t)); }
__device__ __forceinline__ float bf16_lo(unsigned w) { return __uint_as_float(w << 16); }
__device__ __forceinline__ float bf16_hi(unsigned w) { return __uint_as_float(w & 0xffff0000u); }
__device__ __forceinline__ float fexp2(float x) { return __builtin_amdgcn_exp2f(x); }
__device__ __forceinline__ float flog2(float x) { return __builtin_amdgcn_logf(x); }
__device__ __forceinline__ float frcp(float x) { return __builtin_amdgcn_rcpf(x); }
__device__ __forceinline__ float frsq(float x) { return __builtin_amdgcn_rsqf(x); }
template <int CTRL> __device__ __forceinline__ float dppf(float v) { return __builtin_bit_cast(float, __builtin_amdgcn_update_dpp(0, __builtin_bit_cast(int, v), CTRL, 0xF, 0xF, true)); }
__device__ __forceinline__ float rlane(float v, int l) { return __builtin_bit_cast(float, __builtin_amdgcn_readlane(__builtin_bit_cast(int, v), l)); }
__device__ __forceinline__ float sum8(float v) { v += dppf<0xB1>(v); v += dppf<0x4E>(v); v += dppf<0x141>(v); return v; }
__device__ __forceinline__ float sum16(float v) { v = sum8(v); v += dppf<0x140>(v); return v; }
__device__ __forceinline__ float wave_sum(float v) { v = sum16(v); return (rlane(v, 0) + rlane(v, 16)) + (rlane(v, 32) + rlane(v, 48)); }
__device__ __forceinline__ float swap32(float v) { return __shfl_xor(v, 32); }
#define LDS_WAIT() asm volatile("s_waitcnt lgkmcnt(0)" ::: "memory")


#define XB_TMO      128
#define XB_XCNT(j)  (256  + 64 * (j))
#define XB_XSUB(j)  (1280 + 64 * (j))
#define XB_XGEN(j)  (2304 + 64 * (j))
#define XB_TOP      3328
#define XB_TOPGEN   3392
#define XCD_BAR_WORDS 3456
#define XB_SPIN_CAP (1u << 22)
__device__ __forceinline__ unsigned xb_ld(unsigned* p)              { return __hip_atomic_load(p, __ATOMIC_RELAXED, __HIP_MEMORY_SCOPE_AGENT); }
__device__ __forceinline__ unsigned xb_add(unsigned* p, unsigned v) { return __hip_atomic_fetch_add(p, v, __ATOMIC_RELAXED, __HIP_MEMORY_SCOPE_AGENT); }
__device__ __forceinline__ unsigned xb_xcc_id() { return (unsigned)__builtin_amdgcn_s_getreg((3 << 11) | 20) & 0xFu; }
#define XB_SPIN(cond, bar) do { unsigned _sp = 0; while (cond) { __builtin_amdgcn_s_sleep(1); \
    if ((++_sp & 255u) == 0u) { if (xb_ld(&(bar)[XB_TMO])) break; if (_sp > XB_SPIN_CAP) { atomicAdd(&(bar)[XB_TMO], 1u); break; } } } } while (0)
struct XcdBarrier { unsigned* bar; unsigned x; volatile LAS unsigned* st; };
__device__ __forceinline__ XcdBarrier xcd_barrier_post(unsigned* bar, volatile LAS unsigned* st) {
    XcdBarrier b; b.bar = bar; b.x = xb_xcc_id(); b.st = st;
    if (threadIdx.x == 0) (void)xb_add(&bar[XB_XCNT(b.x)], 1u);
    return b;
}
__device__ __forceinline__ void xcd_barrier_complete(unsigned* bar, unsigned x, unsigned& nloc, unsigned& nx) {
    const unsigned G = gridDim.x * gridDim.y * gridDim.z;
    unsigned sum, cnt, mine, sp = 0u;
    for (;;) {
        sum = 0u; cnt = 0u; mine = 0u;
#pragma unroll
        for (unsigned j = 0; j < 16; ++j) { const unsigned c = xb_ld(&bar[XB_XCNT(j)]); sum += c; cnt += (c > 0u) ? 1u : 0u; mine = (j == x) ? c : mine; }
        if (sum == G) break;
        __builtin_amdgcn_s_sleep(1);
        if ((++sp & 255u) == 0u) { if (xb_ld(&bar[XB_TMO])) break; if (sp > XB_SPIN_CAP) { atomicAdd(&bar[XB_TMO], 1u); break; } }
    }
    nloc = mine > 0u ? mine : 1u; nx = cnt > 0u ? cnt : 1u;
}
__device__ __forceinline__ void xcd_barrier(const XcdBarrier& b) {
    asm volatile("s_waitcnt vmcnt(0)" ::: "memory");
    __syncthreads();
    if (threadIdx.x == 0) {
        unsigned* bar = b.bar;
        __builtin_amdgcn_s_waitcnt(0);
        unsigned nloc = b.st[0], nx = b.st[1];
        if (nloc == 0u) { xcd_barrier_complete(bar, b.x, nloc, nx); b.st[0] = nloc; b.st[1] = nx; }
        const unsigned old = xb_add(&bar[XB_XSUB(b.x)], 1u);
        const unsigned gen = old / nloc;
        if (old + 1u == (gen + 1u) * nloc) {
            __builtin_amdgcn_fence(__ATOMIC_RELEASE, "agent");
            asm volatile("s_waitcnt vmcnt(0)" ::: "memory");
            const unsigned og = xb_add(&bar[XB_TOP], 1u);
            const unsigned tg = og / nx;
            if (og + 1u == (tg + 1u) * nx) xb_add(&bar[XB_TOPGEN], 1u);
            else XB_SPIN(xb_ld(&bar[XB_TOPGEN]) == tg, bar);
            __builtin_amdgcn_fence(__ATOMIC_ACQUIRE, "agent");
            xb_add(&bar[XB_XGEN(b.x)], 1u);
            asm volatile("s_waitcnt vmcnt(0)" ::: "memory");
        } else {
            XB_SPIN(xb_ld(&bar[XB_XGEN(b.x)]) == gen, bar);
            __builtin_amdgcn_fence(__ATOMIC_ACQUIRE, "agent");
            asm volatile("s_waitcnt vmcnt(0)" ::: "memory");
        }
    }
    __syncthreads();
}

namespace g8 {
constexpr int BK = 64, HALF = 128, HTB = HALF * BK * 2;
__device__ __forceinline__ int lds_byte(int r, int c) { const int st = (r >> 4) * 2 + (c >> 5), rr = r & 15, cc = c & 31, ob = rr * 64 + cc * 2; return st * 1024 + (ob ^ (((ob >> 9) & 1) << 5)); }
__device__ __forceinline__ void stage_rc(int b, int& R, int& C) { const int st = b / 1024, sb = b % 1024, swz = sb ^ (((sb >> 9) & 1) << 5); R = (st >> 1) * 16 + swz / 64; C = (st & 1) * 32 + (swz % 64) / 2; }

#define G8_SA(b, h) (((b) * 2 + (h)) * HTB)
#define G8_SB(b, h) ((4 + (b) * 2 + (h)) * HTB)
#define G8_STAGE_A(bufoff, h, kt) do { _Pragma("unroll") for (int _i = 0; _i < 2; ++_i) \
    __builtin_amdgcn_global_load_lds((const unsigned*)((Ab + (size_t)(kt) * (BK * 2)) + aoff[h][_i]), (LAS unsigned*)(lds + (bufoff) + ldsw + _i * 8192), 16, 0, 0); } while (0)
#define G8_STAGE_B(bufoff, h, kt) do { _Pragma("unroll") for (int _i = 0; _i < 2; ++_i) \
    __builtin_amdgcn_global_load_lds((const unsigned*)((Bb + (size_t)(h) * bhalf + (size_t)(kt) * (BK * 2)) + boff[_i]), (LAS unsigned*)(lds + (bufoff) + ldsw + _i * 8192), 16, 0, 0); } while (0)
#define G8_LDA(dst, b, h) do { _Pragma("unroll") for (int m = 0; m < 4; ++m) _Pragma("unroll") for (int k = 0; k < 2; ++k) dst[m][k] = *(const LAS bf16x8*)(lds + G8_SA(b, h) + la_off + m * 2048 + k * 1024); } while (0)
#define G8_LDB(dst, b, h) do { _Pragma("unroll") for (int n = 0; n < 2; ++n) _Pragma("unroll") for (int k = 0; k < 2; ++k) dst[n][k] = *(const LAS bf16x8*)(lds + G8_SB(b, h) + lb_off + n * 2048 + k * 1024); } while (0)
#define G8_MMA(ai, bj, At, Bt) do { __builtin_amdgcn_s_setprio(1); _Pragma("unroll") for (int m = 0; m < 4; ++m) _Pragma("unroll") for (int n = 0; n < 2; ++n) _Pragma("unroll") for (int k = 0; k < 2; ++k) \
    acc[ai][bj][m][n] = __builtin_amdgcn_mfma_f32_16x16x32_bf16(Bt[n][k], At[m][k], acc[ai][bj][m][n], 0, 0, 0); __builtin_amdgcn_s_setprio(0); } while (0)
#define G8_WAIT_V(n) asm volatile("s_waitcnt vmcnt(" #n ")" ::: "memory")
#define G8_WAIT_L(n) asm volatile("s_waitcnt lgkmcnt(" #n ")" ::: "memory")
#define G8_BAR __builtin_amdgcn_s_barrier()
#define G8_SCHED __builtin_amdgcn_sched_barrier(0)

template <class Epi>
__device__ __forceinline__ void gemm_unit(LAS unsigned char* lds, const char* Ab, const unsigned (&aoff)[2][2], const char* Bb, int K, const Epi& E) {
    int tid = threadIdx.x; asm volatile("" : "+v"(tid));
    const int wid = __builtin_amdgcn_readfirstlane(tid >> 6), lane = tid & 63, wr = wid >> 2, wc = wid & 3, fr = lane & 15, fq = lane >> 4;
    const int nt = K / BK;
    unsigned boff[2];
#pragma unroll
    for (int i = 0; i < 2; ++i) { int R, C; stage_rc(tid * 16 + i * 8192, R, C); const int rho = R & 31, Rb = (R & ~31) + 8 * ((rho & 15) >> 2) + 4 * (rho >> 4) + (rho & 3);
        boff[i] = (unsigned)(Rb * K + C) * 2u; }
    const size_t bhalf = (size_t)HALF * K * 2;
    const unsigned ldsw = (unsigned)wid * 1024u;
    const int la_off = lds_byte(wr * 64 + fr, fq * 8), lb_off = lds_byte(wc * 32 + fr, fq * 8);
    f32x4 acc[2][2][4][2];
#pragma unroll
    for (int a = 0; a < 2; ++a)
#pragma unroll
        for (int b = 0; b < 2; ++b)
#pragma unroll
            for (int m = 0; m < 4; ++m)
#pragma unroll
                for (int n = 0; n < 2; ++n) acc[a][b][m][n] = (f32x4){0.f, 0.f, 0.f, 0.f};
    bf16x8 At[4][2], B0[2][2], B1[2][2];
    G8_STAGE_B(G8_SB(0, 0), 0, 0); G8_STAGE_A(G8_SA(0, 0), 0, 0);
    G8_STAGE_B(G8_SB(0, 1), 1, 0); G8_STAGE_A(G8_SA(0, 1), 1, 0);
    if (wr == 1) G8_BAR;
    G8_WAIT_V(4); G8_BAR;
    G8_STAGE_B(G8_SB(1, 0), 0, 1); G8_STAGE_A(G8_SA(1, 0), 0, 1); G8_STAGE_B(G8_SB(1, 1), 1, 1);
    G8_WAIT_V(6); G8_BAR;
    for (int t = 0; t < nt - 2; t += 2) {
        G8_LDB(B0, 0, 0); G8_SCHED; G8_LDA(At, 0, 0); G8_STAGE_A(G8_SA(1, 1), 1, t + 1);
        G8_WAIT_L(8); G8_BAR; G8_WAIT_L(0); G8_MMA(0, 0, At, B0); G8_BAR; G8_SCHED;
        G8_LDB(B1, 0, 1); G8_STAGE_B(G8_SB(0, 0), 0, t + 2);
        G8_BAR; G8_WAIT_L(0); G8_MMA(0, 1, At, B1); G8_BAR;
        G8_LDA(At, 0, 1); G8_STAGE_A(G8_SA(0, 0), 0, t + 2);
        G8_BAR; G8_WAIT_L(0); G8_MMA(1, 0, At, B0); G8_BAR; G8_SCHED;
        G8_STAGE_B(G8_SB(0, 1), 1, t + 2);
        G8_WAIT_V(6); G8_BAR; G8_MMA(1, 1, At, B1); G8_BAR;
        G8_LDB(B0, 1, 0); G8_SCHED; G8_LDA(At, 1, 0); G8_STAGE_A(G8_SA(0, 1), 1, t + 2);
        G8_WAIT_L(8); G8_BAR; G8_WAIT_L(0); G8_MMA(0, 0, At, B0); G8_BAR; G8_SCHED;
        G8_LDB(B1, 1, 1); G8_STAGE_B(G8_SB(1, 0), 0, t + 3);
        G8_BAR; G8_WAIT_L(0); G8_MMA(0, 1, At, B1); G8_BAR;
        G8_LDA(At, 1, 1); G8_STAGE_A(G8_SA(1, 0), 0, t + 3);
        G8_BAR; G8_WAIT_L(0); G8_MMA(1, 0, At, B0); G8_BAR; G8_SCHED;
        G8_STAGE_B(G8_SB(1, 1), 1, t + 3);
        G8_WAIT_V(6); G8_BAR; G8_MMA(1, 1, At, B1); G8_BAR;
    }
    { G8_LDB(B0, 0, 0); G8_LDA(At, 0, 0); G8_STAGE_A(G8_SA(1, 1), 1, nt - 1);
      G8_BAR; G8_WAIT_L(0); G8_MMA(0, 0, At, B0); G8_BAR;
      G8_LDB(B1, 0, 1); G8_BAR; G8_WAIT_L(0); G8_MMA(0, 1, At, B1); G8_BAR;
      G8_LDA(At, 0, 1); G8_WAIT_V(4); G8_BAR; G8_WAIT_L(0); G8_MMA(1, 0, At, B0); G8_MMA(1, 1, At, B1); G8_BAR; }
    { G8_LDB(B0, 1, 0); G8_LDA(At, 1, 0); G8_WAIT_V(2); G8_BAR; G8_WAIT_L(0); G8_MMA(0, 0, At, B0); G8_BAR;
      G8_LDB(B1, 1, 1); G8_WAIT_V(0); G8_BAR; G8_WAIT_L(0); G8_MMA(0, 1, At, B1); G8_BAR;
      G8_LDA(At, 1, 1); G8_BAR; G8_WAIT_L(0); G8_MMA(1, 0, At, B0); G8_MMA(1, 1, At, B1); G8_BAR; }
    if (wr == 0) G8_BAR;
    asm volatile("" ::: "memory");
    E(acc, wr, wc, fr, fq);
    __syncthreads();
}
__device__ __forceinline__ void aoff_rows(unsigned (&aoff)[2][2], int K) {
    int tid = threadIdx.x; asm volatile("" : "+v"(tid));
#pragma unroll
    for (int i = 0; i < 2; ++i) { int R, C; stage_rc(tid * 16 + i * 8192, R, C);
#pragma unroll
        for (int h = 0; h < 2; ++h) aoff[h][i] = (unsigned)((h * HALF + R) * K + C) * 2u; }
}
__device__ __forceinline__ void tile_order(int L, int nM, int nN, int& pm, int& pn) {
    const int nwg = nM * nN; int wgid = L;
    { const int q = nwg / 8, r = nwg % 8, xcd = wgid % 8, off = wgid / 8; wgid = (xcd < r ? xcd * (q + 1) : r * (q + 1) + (xcd - r) * q) + off; }
    const int nig = 8 * nN, gid = wgid / nig, fm = gid * 8, gsz = (nM - fm) < 8 ? (nM - fm) : 8;
    pm = fm + ((wgid % nig) % gsz); pn = (wgid % nig) / gsz;
}
}

__device__ __forceinline__ void p0_transpose_item(const float* W, int K, int N, int k0, int n0, bf16_t* WTrow0  , const float* kscale, float mul, LAS float* scr, int lane) {
#pragma unroll 8
    for (int i = 0; i < 32; ++i) { const int kk = 2 * i + (lane >> 5); float v = W[(size_t)(k0 + kk) * N + n0 + (lane & 31)]; if (kscale) v *= kscale[k0 + kk]; scr[kk * 33 + (lane & 31)] = v * mul; }
    LDS_WAIT();
    const int c = lane & 7;
#pragma unroll
    for (int j = 0; j < 4; ++j) { const int n = (lane >> 3) + 8 * j; const LAS float* s = scr + (8 * c) * 33 + n;
        u32x4 o; o.x = cvt_pk_bf16(s[0 * 33], s[1 * 33]); o.y = cvt_pk_bf16(s[2 * 33], s[3 * 33]); o.z = cvt_pk_bf16(s[4 * 33], s[5 * 33]); o.w = cvt_pk_bf16(s[6 * 33], s[7 * 33]);
        *(u32x4*)(WTrow0 + (size_t)n * K + k0 + 8 * c) = o; }
    LDS_WAIT();
}

__device__ __forceinline__ void p0_transpose64(const float* W, int K, int N, int k0, int n0, bf16_t* WTrow0  , const float* kscale, LAS float* scr, int lane) {
    const int rq = lane >> 4, c4 = 4 * (lane & 15);
    f32x4 v[16];
#pragma unroll
    for (int i = 0; i < 16; ++i) v[i] = *(const f32x4*)(W + (size_t)(k0 + 4 * i + rq) * N + n0 + c4);
    if (kscale) {
#pragma unroll
        for (int i = 0; i < 16; ++i) v[i] = v[i] * kscale[k0 + 4 * i + rq];
    }
#pragma unroll
    for (int i = 0; i < 16; ++i) { LAS float* d = scr + (4 * i + rq) * 65 + c4; d[0] = v[i][0]; d[1] = v[i][1]; d[2] = v[i][2]; d[3] = v[i][3]; }
    LDS_WAIT();
#pragma unroll
    for (int c = 0; c < 8; ++c) { const LAS float* sp = scr + (8 * c) * 65 + lane;
        u32x4 o; o.x = cvt_pk_bf16(sp[0], sp[65]); o.y = cvt_pk_bf16(sp[2 * 65], sp[3 * 65]); o.z = cvt_pk_bf16(sp[4 * 65], sp[5 * 65]); o.w = cvt_pk_bf16(sp[6 * 65], sp[7 * 65]);
        *(u32x4*)(WTrow0 + (size_t)lane * K + k0 + 8 * c) = o; }
    LDS_WAIT();
}
__device__ __forceinline__ void p0_expert_weights(const Params& p, LAS unsigned char* lds, int gw, int NGW) {
    int tid = threadIdx.x; asm volatile("" : "+v"(tid));
    const int wave = tid >> 6, lane = tid & 63;
    LAS float* scr = (LAS float*)(lds + wave * 16640);
    bf16_t* wgu = (bf16_t*)(p.ws + WS_WGU); bf16_t* wdn = (bf16_t*)(p.ws + WS_WDN);
    constexpr int I_G = NE * 16 * 4, I_D = NE * 4 * 16;
    for (int it = gw; it < 2 * I_G + I_D; it += NGW) {
        int r = it;
        if (r < 2 * I_G) { const int up = r >= I_G; if (up) r -= I_G; const int e = r / 64, q = r % 64, kb = q / 4, nb = q % 4, n0 = nb * 64;
            const int drow = (n0 >> 7) * 256 + up * 128 + (n0 & 127);
            p0_transpose64((up ? p.w_up : p.w_gate) + (size_t)e * D * DE, D, DE, kb * 64, n0, wgu + ((size_t)e * 512 + drow) * D, p.norm_ffn_g, scr, lane); continue; } r -= 2 * I_G;
        { const int e = r / 64, q = r % 64, kb = q / 16, nb = q % 16, n0 = nb * 64;
            p0_transpose64(p.w_down + (size_t)e * DE * D, DE, D, kb * 64, n0, wdn + ((size_t)e * D + n0) * DE, nullptr, scr, lane); }
    }
}
__device__ __forceinline__ void phase0(const Params& p, LAS unsigned char* lds) {
    int tid = threadIdx.x; asm volatile("" : "+v"(tid));
    const int wave = tid >> 6, lane = tid & 63;
    const int gw = blockIdx.x * NWAVES + wave, NGW = gridDim.x * NWAVES;
    LAS float* scr = (LAS float*)(lds + wave * 8704);
    bf16_t* win = (bf16_t*)(p.ws + WS_WIN); bf16_t* wout = (bf16_t*)(p.ws + WS_WOUT);
    constexpr int I_IN = 16 * 104, I_OUT = 16 * 32;
    for (int it = gw; it < I_IN + I_OUT; it += NGW) {
        int r = it;
        if (r < I_IN) { const int kb = r / 104, nb = r % 104, n0 = nb * 32; p0_transpose_item(p.w_in, D, NIN, kb * 64, n0, win + (size_t)n0 * D, p.norm_mix_g, n0 < 512 ? QSCALE : 1.f, scr, lane); continue; } r -= I_IN;
        { const int kb = r / 32, nb = r % 32, n0 = nb * 32; p0_transpose_item(p.w_out, D, D, kb * 64, n0, wout + (size_t)n0 * D, nullptr, 1.f, scr, lane); }
    }
    bf16_t* xb = (bf16_t*)(p.ws + WS_B); float* rstd1 = (float*)(p.ws + WS_RSTD1);
    {
        f32x4 nv[4];
        if (gw < T) {
#pragma unroll
            for (int j = 0; j < 4; ++j) nv[j] = ((const f32x4*)(p.x + (size_t)gw * D) + lane)[64 * j];
        }
        for (int row = gw; row < T; row += NGW) {
            f32x4 v[4]; float s = 0.f;
#pragma unroll
            for (int j = 0; j < 4; ++j) { v[j] = nv[j]; s += (v[j].x * v[j].x + v[j].y * v[j].y) + (v[j].z * v[j].z + v[j].w * v[j].w); }
            if (row + NGW < T) {
#pragma unroll
                for (int j = 0; j < 4; ++j) nv[j] = ((const f32x4*)(p.x + (size_t)(row + NGW) * D) + lane)[64 * j];
            }
            s = wave_sum(s);
            u32x2* o = (u32x2*)(xb + (size_t)row * D) + lane;
#pragma unroll
            for (int j = 0; j < 4; ++j) { u32x2 w; w.x = cvt_pk_bf16(v[j].x, v[j].y); w.y = cvt_pk_bf16(v[j].z, v[j].w); o[64 * j] = w; }
            if (lane == 0) rstd1[row] = 1.0f / sqrtf(s * (1.0f / D) + 1e-6f);
        }
    }
    bf16_t* wr_hi = (bf16_t*)(p.ws + WS_WR); bf16_t* wr_lo = wr_hi + 48 * D;
    for (int i = blockIdx.x * NTHREADS + tid; i < 48 * D; i += gridDim.x * NTHREADS) {
        const int c = i / D, k = i % D; float w = 0.f;
        if (c < 4) w = p.r_grp_w[k * 4 + c]; else if (c < 36) w = p.r_exp_w[k * 32 + (c - 4)];
        w *= p.norm_ffn_g[k];
        const unsigned hi = cvt_pk_bf16(w, 0.f) & 0xffffu; const float rem = w - __uint_as_float(hi << 16);
        wr_hi[i] = (bf16_t)hi; wr_lo[i] = (bf16_t)(cvt_pk_bf16(rem, 0.f) & 0xffffu);
    }
    { bf16_t* w2t = (bf16_t*)(p.ws + WS_LT); bf16_t* a2t = w2t + 512 * 64; bf16_t* g2t = a2t + 512 * 64;
      for (int i = blockIdx.x * NTHREADS + tid; i < 512 * 256; i += gridDim.x * NTHREADS) {
          if (i < 512 * 64) { const int c = i >> 6, m = i & 63; w2t[i] = (bf16_t)(cvt_pk_bf16(p.rw_w2[m * 512 + c], 0.f) & 0xffffu); }
          else if (i < 2 * 512 * 64) { const int q = i - 512 * 64, c = q >> 6, m = q & 63; a2t[q] = (bf16_t)(cvt_pk_bf16(p.rw_a2[m * 512 + c], 0.f) & 0xffffu); }
          else { const int q = i - 2 * 512 * 64, c = q >> 7, m = q & 127; g2t[q] = (bf16_t)(cvt_pk_bf16(p.rw_g2[m * 512 + c], 0.f) & 0xffffu); } } }
    if (blockIdx.x == 0 && tid < 64) ((unsigned*)(p.ws + WS_CTL))[tid] = 0u;
}

struct EpiU {
    bf16_t* u; const float* rstd; int row0, col0;
    __device__ __forceinline__ void operator()(const f32x4 (&acc)[2][2][4][2], int wr, int wc, int fr, int fq) const {
#pragma unroll
        for (int ai = 0; ai < 2; ++ai)
#pragma unroll
            for (int m = 0; m < 4; ++m) { const int row = row0 + ai * 128 + wr * 64 + m * 16 + fr; const float rs = rstd[row]; bf16_t* rp = u + (size_t)row * NIN + col0 + wc * 32 + 8 * fq;
#pragma unroll
                for (int bj = 0; bj < 2; ++bj) { const f32x4 v0 = acc[ai][bj][m][0] * rs, v1 = acc[ai][bj][m][1] * rs;
                    *(u32x4*)(rp + bj * 128) = (u32x4){cvt_pk_bf16(v0[0], v0[1]), cvt_pk_bf16(v0[2], v0[3]), cvt_pk_bf16(v1[0], v1[1]), cvt_pk_bf16(v1[2], v1[3])}; } }
    }
};
__device__ __forceinline__ void phase1(const Params& p, LAS unsigned char* lds) {
    constexpr int nM = T / 256, nN = NIN / 256;
    unsigned aoff[2][2]; g8::aoff_rows(aoff, D);
    for (int L = blockIdx.x; L < nM * nN; L += gridDim.x) {
        int pm, pn; g8::tile_order(L, nM, nN, pm, pn);
        EpiU E{(bf16_t*)(p.ws + WS_A), (const float*)(p.ws + WS_RSTD1), pm * 256, pn * 256};
        g8::gemm_unit(lds, (const char*)(p.ws + WS_B) + (size_t)pm * 256 * D * 2, aoff, (const char*)(p.ws + WS_WIN) + (size_t)pn * 256 * D * 2, D, E);
    }
}


typedef short v4i16_t __attribute__((ext_vector_type(4)));
__device__ __forceinline__ s16x4 lds_tr16(const LAS unsigned char* p) { return __builtin_bit_cast(s16x4, __builtin_amdgcn_ds_read_tr16_b64_v4i16((LAS v4i16_t*)p)); }

__device__ __forceinline__ void attn_tile(const Params& p, LAS unsigned char* vl  , int b, int h, int qt) {
    const int lane = threadIdx.x & 63, r32 = lane & 31, hi = lane >> 5;
    const bf16_t* u = (const bf16_t*)(p.ws + WS_A);
    const size_t row0 = (size_t)b * S; const int q0 = qt * 32;
    bf16x8 qf[4];
    { const bf16_t* qp = u + (row0 + q0 + r32) * NIN + UQ + h * HD + 8 * hi;
#pragma unroll
      for (int s = 0; s < 4; ++s) qf[s] = *(const bf16x8*)(qp + 16 * s); }
    f32x16 o0, o1;
#pragma unroll
    for (int i = 0; i < 16; ++i) { o0[i] = 0.f; o1[i] = 0.f; }
    float carry = 0.f;
    const int kperm = 16 * ((r32 >> 2) & 1) + (r32 & 3) + 4 * (r32 >> 3);
    const int g = lane >> 4, i16 = lane & 15, tq = i16 >> 2, tp = i16 & 3;
    const LAS unsigned char* vrd = vl + (16 * (g >> 1) + tq) * 144 + (16 * (g & 1) + 4 * tp) * 2;
    LAS unsigned char* kl = vl + 4608;
    const int lrow = lane >> 3, lchk = lane & 7;
    const bf16_t* kvp = u + (row0 + lrow) * NIN + h * HD + lchk * 8;
    u32x4 kreg[4], vreg[4];
#pragma unroll
    for (int i = 0; i < 4; ++i) { const bf16_t* a = kvp + (size_t)(qt * 32 + 8 * i) * NIN; kreg[i] = *(const u32x4*)(a + UK); vreg[i] = *(const u32x4*)(a + UV); }
    for (int kb = qt; kb >= 0; --kb) {
        const int key0 = kb * 32;
#pragma unroll
        for (int i = 0; i < 4; ++i) { *(LAS u32x4*)(kl + (8 * i + lrow) * 144 + lchk * 16) = kreg[i]; *(LAS u32x4*)(vl + (8 * i + lrow) * 144 + lchk * 16) = vreg[i]; }
        if (kb > 0) {
#pragma unroll
            for (int i = 0; i < 4; ++i) { const bf16_t* a = kvp + (size_t)(key0 - 32 + 8 * i) * NIN; kreg[i] = *(const u32x4*)(a + UK); vreg[i] = *(const u32x4*)(a + UV); }
        }
        LDS_WAIT();
        f32x16 st;
#pragma unroll
        for (int i = 0; i < 16; ++i) st[i] = 0.f;
        { const LAS unsigned char* kp = kl + kperm * 144 + 16 * hi;
          bf16x8 kf[4];
#pragma unroll
          for (int s = 0; s < 4; ++s) kf[s] = *(const LAS bf16x8*)(kp + 32 * s);
#pragma unroll
          for (int s = 0; s < 4; ++s) st = __builtin_amdgcn_mfma_f32_32x32x16_bf16(kf[s], qf[s], st, 0, 0, 0); }
        const bool diag = (kb == qt);
        float lw[16], suf[16];
        float run = 0.f;
#pragma unroll
        for (int reg = 15; reg >= 0; --reg) {
            const float z = st[reg];
            const float l = flog2(1.0f + fexp2(-fabsf(z)));
            const float sp = fmaxf(z, 0.f) + l;
            const bool valid = !diag || (16 * hi + reg < r32);
            lw[reg] = valid ? (z - sp) : -1.0e30f;
            suf[reg] = run;
            run += valid ? -sp : 0.f;
        }
        const float other = swap32(run);
        const float tot_hi = hi ? run : other, tot_lo = hi ? other : run;
        const float base = carry + (hi ? 0.f : tot_hi);
        carry += tot_lo + tot_hi;
        unsigned pk[8];
#pragma unroll
        for (int j = 0; j < 8; ++j) pk[j] = cvt_pk_bf16(fexp2(lw[2 * j] + suf[2 * j] + base), fexp2(lw[2 * j + 1] + suf[2 * j + 1] + base));
        LDS_WAIT();
#pragma unroll
        for (int s2 = 0; s2 < 2; ++s2) {
            bf16x8 pf = __builtin_bit_cast(bf16x8, (u32x4){pk[4 * s2], pk[4 * s2 + 1], pk[4 * s2 + 2], pk[4 * s2 + 3]});
#pragma unroll
            for (int dh = 0; dh < 2; ++dh) {
                const s16x4 a = lds_tr16(vrd + (8 * s2) * 144 + 64 * dh), c = lds_tr16(vrd + (8 * s2 + 4) * 144 + 64 * dh);
                bf16x8 vf; vf[0] = a[0]; vf[1] = a[1]; vf[2] = a[2]; vf[3] = a[3]; vf[4] = c[0]; vf[5] = c[1]; vf[6] = c[2]; vf[7] = c[3];
                if (dh == 0) o0 = __builtin_amdgcn_mfma_f32_32x32x16_bf16(vf, pf, o0, 0, 0, 0); else o1 = __builtin_amdgcn_mfma_f32_32x32x16_bf16(vf, pf, o1, 0, 0, 0);
            }
        }
        LDS_WAIT();
        if (__builtin_amdgcn_ballot_w64(carry > -150.0f) == 0ull) break;
    }
    float ss = 0.f;
#pragma unroll
    for (int i = 0; i < 16; ++i) ss += o0[i] * o0[i] + o1[i] * o1[i];
    ss += swap32(ss);
    const float rs = 1.0f / sqrtf(ss * (1.0f / HD) + 1e-6f);
    bf16_t* op = (bf16_t*)(p.ws + WS_B) + (row0 + q0 + r32) * D + h * HD + 4 * hi;
    const float* gp = p.sb_out_g + h * HD + 4 * hi;
#pragma unroll
    for (int dh = 0; dh < 2; ++dh)
#pragma unroll
        for (int gq = 0; gq < 4; ++gq) {
            const f32x4 gg = *(const f32x4*)(gp + 32 * dh + 8 * gq);
            const f32x16& o = dh ? o1 : o0;
            u32x2 w; w.x = cvt_pk_bf16(o[4 * gq] * rs * gg[0], o[4 * gq + 1] * rs * gg[1]); w.y = cvt_pk_bf16(o[4 * gq + 2] * rs * gg[2], o[4 * gq + 3] * rs * gg[3]);
            *(u32x2*)(op + 32 * dh + 8 * gq) = w;
        }
}

constexpr size_t ACT_OFF = (size_t)64 << 20;
namespace rk {
constexpr int C = 32, NCH = S / C, NSLOT = 16;
constexpr int SL_PS = 0, SL_QS = 8192, SL_PO = 12288, SL_QO = 16384, SL_VR = 18432, SL_GB = 22528, SL_GW = 26624, SLOT_BYTES = 30720;
constexpr int MSTR = 144;
constexpr int PM_AT = 0, PM_RT = 4608, PM_BT = 9216, PM_KT = 13824, PM_GC = 18432, PROD_LDS = 18688;
constexpr int NPROD = 6;
constexpr int L_CONS = NPROD * PROD_LDS;
constexpr int OSTR = 272;
constexpr int L_OBUF = L_CONS + 4608;
constexpr int L_FLAG = L_OBUF + 32 * OSTR;
constexpr int L_W2 = L_FLAG + 256;
constexpr int L_A2 = L_W2 + 8192;
constexpr int L_G2 = L_A2 + 8192;
constexpr int L_CST = L_G2 + 16384;
constexpr int C_MUL = 0, C_MUR = 256, C_MUK = 320, C_MUV = 384, C_W0 = 448, C_A0 = 512, C_KK = 576, C_KA = 640, C_RK = 704, C_LNB = 768, C_END = 832;
static_assert(L_CST + C_END * 4 <= 161792, "rwkv LDS layout overflows");
}
__device__ __forceinline__ bf16x8 accfrag(const f32x16& a, int s) {
    return __builtin_bit_cast(bf16x8, (u32x4){cvt_pk_bf16(a[8 * s], a[8 * s + 1]), cvt_pk_bf16(a[8 * s + 2], a[8 * s + 3]), cvt_pk_bf16(a[8 * s + 4], a[8 * s + 5]), cvt_pk_bf16(a[8 * s + 6], a[8 * s + 7])});
}
__device__ __forceinline__ bf16x8 trfrag(const LAS unsigned char* mat, int s, int nt, int lane) {
    const int g = lane >> 4, i16 = lane & 15, q = i16 >> 2, pp = i16 & 3, h = g >> 1;
    const LAS unsigned char* a = mat + (16 * s + 4 * h + q) * rk::MSTR + (32 * nt + 16 * (g & 1) + 4 * pp) * 2;
    const s16x4 x = lds_tr16(a), y = lds_tr16(a + 8 * rk::MSTR);
    bf16x8 r; r[0] = x[0]; r[1] = x[1]; r[2] = x[2]; r[3] = x[3]; r[4] = y[0]; r[5] = y[1]; r[6] = y[2]; r[7] = y[3]; return r;
}
__device__ __forceinline__ void f8_from_bf16(const u32x4 w, float (&o)[8]) {
#pragma unroll
    for (int j = 0; j < 4; ++j) { o[2 * j] = bf16_lo(w[j]); o[2 * j + 1] = bf16_hi(w[j]); }
}
__device__ __forceinline__ f32x16 mfma32(bf16x8 a, bf16x8 b, f32x16 c) { return __builtin_amdgcn_mfma_f32_32x32x16_bf16(a, b, c, 0, 0, 0); }
__device__ __forceinline__ f32x16 zero16() { f32x16 z; for (int i = 0; i < 16; ++i) z[i] = 0.f; return z; }
__device__ __forceinline__ void um8(const bf16_t* urow  , bool has_prev, const float* mu, float (&o)[8]) {
    const u32x4 c = *(const u32x4*)urow; u32x4 pv = (u32x4){0u, 0u, 0u, 0u}; if (has_prev) pv = *(const u32x4*)(urow - NIN);
    const f32x4 m0 = *(const f32x4*)mu, m1 = *(const f32x4*)(mu + 4);
    float cv[8], pf[8]; f8_from_bf16(c, cv); f8_from_bf16(pv, pf);
#pragma unroll
    for (int j = 0; j < 4; ++j) { o[j] = cv[j] + (pf[j] - cv[j]) * m0[j]; o[4 + j] = cv[4 + j] + (pf[4 + j] - cv[4 + j]) * m1[j]; }
}
__device__ __forceinline__ void lerp8(const u32x4 c, const u32x4 pv, const LAS float* mu, float (&o)[8]) {
    const f32x4 m0 = *(const LAS f32x4*)mu, m1 = *(const LAS f32x4*)(mu + 4);
    float cv[8], pf[8]; f8_from_bf16(c, cv); f8_from_bf16(pv, pf);
#pragma unroll
    for (int j = 0; j < 4; ++j) { o[j] = cv[j] + (pf[j] - cv[j]) * m0[j]; o[4 + j] = cv[4 + j] + (pf[4 + j] - cv[4 + j]) * m1[j]; }
}
__device__ __forceinline__ void lerp8(const u32x4 c, const u32x4 pv, const float* mu, float (&o)[8]) {
    const f32x4 m0 = *(const f32x4*)mu, m1 = *(const f32x4*)(mu + 4);
    float cv[8], pf[8]; f8_from_bf16(c, cv); f8_from_bf16(pv, pf);
#pragma unroll
    for (int j = 0; j < 4; ++j) { o[j] = cv[j] + (pf[j] - cv[j]) * m0[j]; o[4 + j] = cv[4 + j] + (pf[4 + j] - cv[4 + j]) * m1[j]; }
}
__device__ __forceinline__ float scan32(float x) {
    x += dppf<0x111>(x); x += dppf<0x112>(x); x += dppf<0x114>(x); x += dppf<0x118>(x);
    const float bc = __builtin_bit_cast(float, __builtin_amdgcn_update_dpp(0, __builtin_bit_cast(int, x), 0x142, 0xA, 0xF, false));
    return x + bc;
}

__device__ __forceinline__ void rk_produce(const Params& p, LAS unsigned char* lds, LAS unsigned char* pl  , unsigned char* slot, int b, int hh, int c) {
    using namespace rk;
    int lane = threadIdx.x & 63; asm volatile("" : "+v"(lane));
    const int r32 = lane & 31, h = lane >> 5;
    const bf16_t* u = (const bf16_t*)(p.ws + WS_A);
    const size_t row0 = (size_t)b * S; const int t0 = c * C; const int tt = t0 + r32; const bool hp = tt > 0;
    const bf16_t* urow = u + (row0 + tt) * NIN;
    const LAS float* cst = (const LAS float*)(lds + L_CST);
    const int jrow0 = 32 * ((r32 >> 2) & 1) + (r32 & 3) + 4 * (r32 >> 3);
    f32x16 lw[2], la[2], lg[2];
#pragma unroll
    for (int mt = 0; mt < 2; ++mt) { lw[mt] = zero16(); la[mt] = zero16(); lg[mt] = zero16(); }
    const int cb = hh * HD + 32 * h;
    u32x4 ck[4], pk4[4], cr[4], pr4[4];
    {
        const bf16_t* act = (const bf16_t*)((const unsigned char*)p.out + ACT_OFF) + (row0 + tt) * 256 + 8 * h;
        u32x4 bw[4], ba[4], bg[8];
#pragma unroll
        for (int s = 0; s < 4; ++s) { bw[s] = *(const u32x4*)(act + 16 * s); ba[s] = *(const u32x4*)(act + 64 + 16 * s); }
#pragma unroll
        for (int s = 0; s < 8; ++s) bg[s] = *(const u32x4*)(act + 128 + 16 * s);
        {
            bf16x8 fw[2][4];
#pragma unroll
            for (int mt = 0; mt < 2; ++mt)
#pragma unroll
                for (int s = 0; s < 4; ++s) { const int jl = jrow0 + 16 * mt; fw[mt][s] = *(const LAS bf16x8*)(lds + L_W2 + jl * 128 + (((2 * s + h) ^ (jl & 7)) << 4)); }
#pragma unroll
            for (int s = 0; s < 4; ++s)
#pragma unroll
                for (int mt = 0; mt < 2; ++mt) lw[mt] = mfma32(fw[mt][s], __builtin_bit_cast(bf16x8, bw[s]), lw[mt]);
        }
        {
            bf16x8 fa[2][4];
#pragma unroll
            for (int mt = 0; mt < 2; ++mt)
#pragma unroll
                for (int s = 0; s < 4; ++s) { const int jl = jrow0 + 16 * mt; fa[mt][s] = *(const LAS bf16x8*)(lds + L_A2 + jl * 128 + (((2 * s + h) ^ (jl & 7)) << 4)); }
#pragma unroll
            for (int s = 0; s < 4; ++s)
#pragma unroll
                for (int mt = 0; mt < 2; ++mt) la[mt] = mfma32(fa[mt][s], __builtin_bit_cast(bf16x8, ba[s]), la[mt]);
        }
        asm volatile("" ::: "memory");
#pragma unroll
        for (int half = 0; half < 2; ++half) {
            bf16x8 fg[2][4];
#pragma unroll
            for (int mt = 0; mt < 2; ++mt)
#pragma unroll
                for (int s4 = 0; s4 < 4; ++s4) { const int s = 4 * half + s4, jl = jrow0 + 16 * mt; fg[mt][s4] = *(const LAS bf16x8*)(lds + L_G2 + jl * 256 + (((2 * s + h) ^ (jl & 7)) << 4)); }
#pragma unroll
            for (int s4 = 0; s4 < 4; ++s4)
#pragma unroll
                for (int mt = 0; mt < 2; ++mt) lg[mt] = mfma32(fg[mt][s4], __builtin_bit_cast(bf16x8, bg[4 * half + s4]), lg[mt]);
        }
        asm volatile("" ::: "memory");
#pragma unroll
        for (int q = 0; q < 4; ++q) { const bf16_t* a = urow + URK + cb + 8 * q; const bf16_t* bq = urow + UR + cb + 8 * q;
            ck[q] = *(const u32x4*)a; cr[q] = *(const u32x4*)bq; pk4[q] = (u32x4){0u, 0u, 0u, 0u}; pr4[q] = pk4[q];
            if (hp) { pk4[q] = *(const u32x4*)(a - NIN); pr4[q] = *(const u32x4*)(bq - NIN); } }
    }
#pragma unroll
    for (int mt = 0; mt < 2; ++mt) {
        u32x4 w0, w1; w0.x = cvt_pk_bf16(lg[mt][0], lg[mt][1]); w0.y = cvt_pk_bf16(lg[mt][2], lg[mt][3]); w0.z = cvt_pk_bf16(lg[mt][4], lg[mt][5]); w0.w = cvt_pk_bf16(lg[mt][6], lg[mt][7]);
        w1.x = cvt_pk_bf16(lg[mt][8], lg[mt][9]); w1.y = cvt_pk_bf16(lg[mt][10], lg[mt][11]); w1.z = cvt_pk_bf16(lg[mt][12], lg[mt][13]); w1.w = cvt_pk_bf16(lg[mt][14], lg[mt][15]);
        *(u32x4*)(slot + SL_GW + (2 * mt) * 1024 + lane * 16) = w0; *(u32x4*)(slot + SL_GW + (2 * mt + 1) * 1024 + lane * 16) = w1;
    }
    asm volatile("" ::: "memory");
    float ssq = 0.f;
#pragma unroll
    for (int q = 0; q < 4; ++q) {
        float t8[8]; lerp8(ck[q], pk4[q], cst + C_MUK + 32 * h + 8 * q, t8);
        const f32x4 c0 = *(const LAS f32x4*)(cst + C_KK + 32 * h + 8 * q), c1 = *(const LAS f32x4*)(cst + C_KK + 32 * h + 8 * q + 4);
#pragma unroll
        for (int j = 0; j < 4; ++j) { const float x0 = t8[j] * c0[j], x1 = t8[4 + j] * c1[j]; ssq += x0 * x0 + x1 * x1; }
    }
    ssq += swap32(ssq);
    const float kinv = frsq(fmaxf(ssq, 1e-24f));
    float bonus = 0.f;
    LAS unsigned char* mAT = pl + PM_AT; LAS unsigned char* mRT = pl + PM_RT; LAS unsigned char* mBT = pl + PM_BT; LAS unsigned char* mKT = pl + PM_KT;
    LAS float* gc = (LAS float*)(pl + PM_GC);
#pragma unroll
    for (int mt = 0; mt < 2; ++mt) {
#pragma unroll
        for (int q8 = 0; q8 < 2; ++q8) {
            const int jl0 = 32 * h + 16 * mt + 8 * q8, q = 2 * mt + q8;
            float k8[8], r8[8];
            lerp8(ck[q], pk4[q], cst + C_MUK + jl0, k8);
            lerp8(cr[q], pr4[q], cst + C_MUR + jl0, r8);
            float cw0[8], ca0[8], ckk[8], cka[8], crk[8];
#pragma unroll
            for (int e = 0; e < 2; ++e) { const f32x4 a = *(const LAS f32x4*)(cst + C_W0 + jl0 + 4 * e), bq = *(const LAS f32x4*)(cst + C_A0 + jl0 + 4 * e), cc = *(const LAS f32x4*)(cst + C_KK + jl0 + 4 * e), dd = *(const LAS f32x4*)(cst + C_KA + jl0 + 4 * e), ee = *(const LAS f32x4*)(cst + C_RK + jl0 + 4 * e);
#pragma unroll
                for (int j = 0; j < 4; ++j) { cw0[4 * e + j] = a[j]; ca0[4 * e + j] = bq[j]; ckk[4 * e + j] = cc[j]; cka[4 * e + j] = dd[j]; crk[4 * e + j] = ee[j]; } }
            float oa[8], orr[8], ob[8], ok[8];
#pragma unroll
            for (int e = 0; e < 8; ++e) {
                const int reg = 8 * q8 + e;
                const float xw = cw0[e] + lw[mt][reg];
                const float spn = fmaxf(-xw, 0.f) + LN2 * flog2(1.0f + fexp2(-fabsf(xw) * LOG2E));
                const float ld = -fexp2((-spn - 0.5f) * LOG2E);
                const float al = frcp(1.0f + fexp2(-(ca0[e] + la[mt][reg]) * LOG2E));
                const float kk = k8[e] * ckk[e] * kinv;
                const float kmod = k8[e] * (1.0f + (al - 1.0f) * cka[e]);
                const float bb = kk * al;
                bonus += r8[e] * kmod * crk[e];
                const float G = scan32(ld);
                const float eG = fexp2(G * LOG2E), eGm = fexp2((G - ld) * LOG2E), eiG = fexp2(-G * LOG2E);
                oa[e] = -kk * eGm; orr[e] = r8[e] * eG; ob[e] = bb * eiG; ok[e] = kmod * eiG;
                if (r32 == 31) gc[32 * h + 16 * mt + reg] = eG;
            }
            const int off = r32 * MSTR + (32 * h + 16 * mt + 8 * q8) * 2;
            *(LAS u32x4*)(mAT + off) = (u32x4){cvt_pk_bf16(oa[0], oa[1]), cvt_pk_bf16(oa[2], oa[3]), cvt_pk_bf16(oa[4], oa[5]), cvt_pk_bf16(oa[6], oa[7])};
            *(LAS u32x4*)(mRT + off) = (u32x4){cvt_pk_bf16(orr[0], orr[1]), cvt_pk_bf16(orr[2], orr[3]), cvt_pk_bf16(orr[4], orr[5]), cvt_pk_bf16(orr[6], orr[7])};
            *(LAS u32x4*)(mBT + off) = (u32x4){cvt_pk_bf16(ob[0], ob[1]), cvt_pk_bf16(ob[2], ob[3]), cvt_pk_bf16(ob[4], ob[5]), cvt_pk_bf16(ob[6], ob[7])};
            *(LAS u32x4*)(mKT + off) = (u32x4){cvt_pk_bf16(ok[0], ok[1]), cvt_pk_bf16(ok[2], ok[3]), cvt_pk_bf16(ok[4], ok[5]), cvt_pk_bf16(ok[6], ok[7])};
            asm volatile("" ::: "memory");
        }
    }
    bonus += swap32(bonus);
    u32x4 cv4[4], pv4[4];
#pragma unroll
    for (int q = 0; q < 4; ++q) { const bf16_t* cq = urow + URV + cb + 8 * q; cv4[q] = *(const u32x4*)cq; pv4[q] = (u32x4){0u, 0u, 0u, 0u}; if (hp) pv4[q] = *(const u32x4*)(cq - NIN); }
#pragma unroll
    for (int q = 0; q < 4; ++q) {
        float v8[8]; lerp8(cv4[q], pv4[q], cst + C_MUV + 32 * h + 8 * q, v8);
        *(u32x4*)(slot + SL_VR + q * 1024 + lane * 16) = (u32x4){cvt_pk_bf16(v8[0], v8[1]), cvt_pk_bf16(v8[2], v8[3]), cvt_pk_bf16(v8[4], v8[5]), cvt_pk_bf16(v8[6], v8[7])};
        const f32x4 b0 = *(const LAS f32x4*)(cst + C_LNB + 32 * h + 8 * q), b1 = *(const LAS f32x4*)(cst + C_LNB + 32 * h + 8 * q + 4);
        float gb[8];
#pragma unroll
        for (int e = 0; e < 8; ++e) gb[e] = (e < 4 ? b0[e] : b1[e - 4]) + bonus * v8[e];
        *(u32x4*)(slot + SL_GB + q * 1024 + lane * 16) = (u32x4){cvt_pk_bf16(gb[0], gb[1]), cvt_pk_bf16(gb[2], gb[3]), cvt_pk_bf16(gb[4], gb[5]), cvt_pk_bf16(gb[6], gb[7])};
    }
    LDS_WAIT();
    f32x16 nab = zero16(), nabT = zero16(), nakT = zero16(), mbr = zero16(), mkr = zero16();
#pragma unroll
    for (int s = 0; s < 4; ++s) {
        const int off = r32 * MSTR + (16 * s + 8 * h) * 2;
        const bf16x8 fa = *(const LAS bf16x8*)(mAT + off), fr = *(const LAS bf16x8*)(mRT + off), fb = *(const LAS bf16x8*)(mBT + off), fk = *(const LAS bf16x8*)(mKT + off);
        nab = mfma32(fb, fa, nab); nabT = mfma32(fa, fb, nabT); nakT = mfma32(fa, fk, nakT); mbr = mfma32(fb, fr, mbr); mkr = mfma32(fk, fr, mkr);
    }
#pragma unroll
    for (int reg = 0; reg < 16; ++reg) {
        const int row = (reg & 3) + 8 * (reg >> 2) + 4 * h;
        nab[reg] = row < r32 ? nab[reg] : 0.f;
        nabT[reg] = r32 < row ? nabT[reg] : 0.f;
        nakT[reg] = r32 < row ? nakT[reg] : 0.f;
        mbr[reg] = row <= r32 ? mbr[reg] : 0.f;
        mkr[reg] = row <= r32 ? mkr[reg] : 0.f;
    }
    f32x16 Y = nab;
#pragma unroll
    for (int reg = 0; reg < 16; ++reg) { const int row = (reg & 3) + 8 * (reg >> 2) + 4 * h; if (row == r32) Y[reg] += 1.0f; }
    {
        f32x16 M = nab, MT = nabT;
#pragma unroll
        for (int lvl = 0; lvl < 4; ++lvl) {
            const bf16x8 m0 = accfrag(M, 0), m1 = accfrag(M, 1), t0f = accfrag(MT, 0), t1f = accfrag(MT, 1);
            f32x16 M2T = mfma32(m0, t0f, zero16()); M2T = mfma32(m1, t1f, M2T);
            f32x16 M2 = zero16();
            if (lvl < 3) { M2 = mfma32(t0f, m0, M2); M2 = mfma32(t1f, m1, M2); }
            const bf16x8 y0 = accfrag(Y, 0), y1 = accfrag(Y, 1);
            Y = mfma32(accfrag(M2T, 0), y0, Y); Y = mfma32(accfrag(M2T, 1), y1, Y);
            M = M2; MT = M2T;
        }
    }
    int lane5 = lane; asm volatile("" : "+v"(lane5));
    const int r5 = lane5 & 31, h5 = lane5 >> 5;
    const bf16x8 ty0 = accfrag(Y, 0), ty1 = accfrag(Y, 1);
    f32x16 paT[2];
#pragma unroll
    for (int nt = 0; nt < 2; ++nt) { paT[nt] = mfma32(ty0, trfrag(mAT, 0, nt, lane5), zero16()); paT[nt] = mfma32(ty1, trfrag(mAT, 1, nt, lane5), paT[nt]); }
    f32x16 qakT = mfma32(ty0, accfrag(nakT, 0), zero16()); qakT = mfma32(ty1, accfrag(nakT, 1), qakT);
    const bf16x8 mb0 = accfrag(mbr, 0), mb1 = accfrag(mbr, 1);
#pragma unroll
    for (int mt = 0; mt < 2; ++mt) {
        f32x16 po;
#pragma unroll
        for (int g = 0; g < 4; ++g) { const u32x2 w = *(const LAS u32x2*)(mRT + r5 * MSTR + (32 * mt + 8 * g + 4 * h5) * 2);
            po[4 * g] = bf16_lo(w.x); po[4 * g + 1] = bf16_hi(w.x); po[4 * g + 2] = bf16_lo(w.y); po[4 * g + 3] = bf16_hi(w.y); }
        po = mfma32(accfrag(paT[mt], 0), mb0, po); po = mfma32(accfrag(paT[mt], 1), mb1, po);
#pragma unroll
        for (int sp = 0; sp < 2; ++sp)
            *(u32x4*)(slot + SL_PO + (2 * mt + sp) * 1024 + lane5 * 16) = (u32x4){cvt_pk_bf16(po[8 * sp], po[8 * sp + 1]), cvt_pk_bf16(po[8 * sp + 2], po[8 * sp + 3]), cvt_pk_bf16(po[8 * sp + 4], po[8 * sp + 5]), cvt_pk_bf16(po[8 * sp + 6], po[8 * sp + 7])};
    }
    {
        f32x16 qo = mfma32(accfrag(qakT, 0), mb0, mkr); qo = mfma32(accfrag(qakT, 1), mb1, qo);
#pragma unroll
        for (int sp = 0; sp < 2; ++sp) *(u32x4*)(slot + SL_QO + sp * 1024 + lane5 * 16) = (u32x4){cvt_pk_bf16(qo[8 * sp], qo[8 * sp + 1]), cvt_pk_bf16(qo[8 * sp + 2], qo[8 * sp + 3]), cvt_pk_bf16(qo[8 * sp + 4], qo[8 * sp + 5]), cvt_pk_bf16(qo[8 * sp + 6], qo[8 * sp + 7])};
    }
#pragma unroll
    for (int nt = 0; nt < 2; ++nt) {
        const bf16x8 bt0 = trfrag(mBT, 0, nt, lane5), bt1 = trfrag(mBT, 1, nt, lane5);
        const float gam = gc[32 * nt + r5];
#pragma unroll
        for (int mt = 0; mt < 2; ++mt) {
            f32x16 ps = zero16();
            if (mt == nt) {
#pragma unroll
                for (int reg = 0; reg < 16; ++reg) { const int row = (reg & 3) + 8 * (reg >> 2) + 4 * h5; ps[reg] = (row == r5) ? 1.0f : 0.f; }
            }
            ps = mfma32(accfrag(paT[mt], 0), bt0, ps); ps = mfma32(accfrag(paT[mt], 1), bt1, ps);
#pragma unroll
            for (int sp = 0; sp < 2; ++sp)
                *(u32x4*)(slot + SL_PS + ((nt * 2 + mt) * 2 + sp) * 1024 + lane5 * 16) = (u32x4){cvt_pk_bf16(ps[8 * sp] * gam, ps[8 * sp + 1] * gam), cvt_pk_bf16(ps[8 * sp + 2] * gam, ps[8 * sp + 3] * gam), cvt_pk_bf16(ps[8 * sp + 4] * gam, ps[8 * sp + 5] * gam), cvt_pk_bf16(ps[8 * sp + 6] * gam, ps[8 * sp + 7] * gam)};
        }
        f32x16 qs;
        { const bf16x8 k0 = trfrag(mKT, 0, nt, lane5), k1 = trfrag(mKT, 1, nt, lane5);
          const u32x4 w0 = __builtin_bit_cast(u32x4, k0), w1 = __builtin_bit_cast(u32x4, k1);
#pragma unroll
          for (int j = 0; j < 4; ++j) { qs[2 * j] = bf16_lo(w0[j]); qs[2 * j + 1] = bf16_hi(w0[j]); qs[8 + 2 * j] = bf16_lo(w1[j]); qs[8 + 2 * j + 1] = bf16_hi(w1[j]); } }
        qs = mfma32(accfrag(qakT, 0), bt0, qs); qs = mfma32(accfrag(qakT, 1), bt1, qs);
#pragma unroll
        for (int sp = 0; sp < 2; ++sp) *(u32x4*)(slot + SL_QS + (nt * 2 + sp) * 1024 + lane5 * 16) = (u32x4){cvt_pk_bf16(qs[8 * sp] * gam, qs[8 * sp + 1] * gam), cvt_pk_bf16(qs[8 * sp + 2] * gam, qs[8 * sp + 3] * gam), cvt_pk_bf16(qs[8 * sp + 4] * gam, qs[8 * sp + 5] * gam), cvt_pk_bf16(qs[8 * sp + 6] * gam, qs[8 * sp + 7] * gam)};
    }
    LDS_WAIT();
}

__device__ __forceinline__ u32x4 ntload16(const void* ptr) { return __builtin_nontemporal_load((const u32x4*)ptr); }
struct RkOps { u32x4 vr[4]; bf16x8 fps[2][2][2], fqs[2][2], fpo[2][2], fqo[2]; };
__device__ __forceinline__ void rk_load_ops_a(RkOps& o, const unsigned char* slot, int lane) {
    using namespace rk;
    const int r32 = lane & 31, h = lane >> 5;
#pragma unroll
    for (int k = 0; k < 4; ++k) o.vr[k] = ntload16(slot + SL_VR + k * 1024 + lane * 16);
#pragma unroll
    for (int jt = 0; jt < 2; ++jt)
#pragma unroll
        for (int s = 0; s < 2; ++s) o.fpo[jt][s] = __builtin_bit_cast(bf16x8, ntload16(slot + SL_PO + (2 * jt + s) * 1024 + lane * 16));
#pragma unroll
    for (int s = 0; s < 2; ++s) o.fqo[s] = __builtin_bit_cast(bf16x8, ntload16(slot + SL_QO + s * 1024 + lane * 16));
}
__device__ __forceinline__ void rk_load_ops_b(RkOps& o, const unsigned char* slot, int lane) {
    using namespace rk;
    const int r32 = lane & 31, h = lane >> 5;
#pragma unroll
    for (int mt = 0; mt < 2; ++mt) {
#pragma unroll
        for (int jt = 0; jt < 2; ++jt)
#pragma unroll
            for (int s = 0; s < 2; ++s) o.fps[mt][jt][s] = __builtin_bit_cast(bf16x8, ntload16(slot + SL_PS + ((mt * 2 + jt) * 2 + s) * 1024 + lane * 16));
#pragma unroll
        for (int s = 0; s < 2; ++s) o.fqs[mt][s] = __builtin_bit_cast(bf16x8, ntload16(slot + SL_QS + (mt * 2 + s) * 1024 + lane * 16));
    }
}
#define RK_SPIN(cond) do { unsigned _sp = 0; while (cond) { __builtin_amdgcn_s_sleep(1); if (++_sp > (1u << 24)) { err[0] = 1u; break; } } asm volatile("" ::: "memory"); } while (0)

__device__ __forceinline__ void rwkv_chain(const Params& p, LAS unsigned char* lds, int b, int hh) {
    using namespace rk;
    int tid = threadIdx.x; asm volatile("" : "+v"(tid));
    volatile LAS unsigned* ready = (volatile LAS unsigned*)(lds + L_FLAG); volatile LAS unsigned* freed = ready + NSLOT; volatile LAS unsigned* ofull = freed + NSLOT; volatile LAS unsigned* ofree = ofull + 2; volatile LAS unsigned* err = ofree + 2;
    if (tid < 2 * NSLOT + 5) ready[tid] = 0u;
    {
        const bf16_t* w2t = (const bf16_t*)(p.ws + WS_LT); const bf16_t* a2t = w2t + 512 * 64; const bf16_t* g2t = a2t + 512 * 64;
        for (int i = tid; i < 64 * 8; i += NTHREADS) { const int j = i >> 3, ch = i & 7, d = j * 128 + ((ch ^ (j & 7)) << 4);
            *(LAS u32x4*)(lds + L_W2 + d) = *(const u32x4*)(w2t + (hh * HD + j) * 64 + 8 * ch); *(LAS u32x4*)(lds + L_A2 + d) = *(const u32x4*)(a2t + (hh * HD + j) * 64 + 8 * ch); }
        for (int i = tid; i < 64 * 16; i += NTHREADS) { const int j = i >> 4, ch = i & 15; *(LAS u32x4*)(lds + L_G2 + j * 256 + ((ch ^ (j & 7)) << 4)) = *(const u32x4*)(g2t + (hh * HD + j) * 128 + 8 * ch); }
        LAS float* cst = (LAS float*)(lds + L_CST);
        for (int i = tid; i < C_END; i += NTHREADS) { float v;
            if (i < 256) v = p.shift_mu[(UXW - UR) + i];
            else if (i < 320) v = p.shift_mu[hh * HD + (i - 256)];
            else if (i < 384) v = p.shift_mu[(URK - UR) + hh * HD + (i - 320)];
            else if (i < 448) v = p.shift_mu[(URV - UR) + hh * HD + (i - 384)];
            else if (i < 512) v = p.rw_w0[hh * HD + (i - 448)];
            else if (i < 576) v = p.rw_a0[hh * HD + (i - 512)];
            else if (i < 640) v = p.rw_k_k[hh * HD + (i - 576)];
            else if (i < 704) v = p.rw_k_a[hh * HD + (i - 640)];
            else if (i < 768) v = p.rw_r_k[hh * HD + (i - 704)];
            else v = p.rw_ln_b[hh * HD + (i - 768)];
            cst[i] = v; }
    }
    __syncthreads();
    asm volatile("" : "+v"(tid));
    const int wave = __builtin_amdgcn_readfirstlane(tid >> 6);
    unsigned char* ring = (unsigned char*)p.out + (size_t)(b * NH + hh) * NSLOT * SLOT_BYTES;
    if (wave == 0) {
        int lane = tid & 63; asm volatile("" : "+v"(lane));
        const int r32 = lane & 31, h = lane >> 5;
        LAS unsigned char* vs = lds + L_CONS;
        f32x16 st[2][2];
#pragma unroll
        for (int a = 0; a < 2; ++a)
#pragma unroll
            for (int d = 0; d < 2; ++d) st[a][d] = zero16();
        RkOps ops;
        RK_SPIN(ready[0] != 1u);
        rk_load_ops_a(ops, ring, lane); rk_load_ops_b(ops, ring, lane);
        for (int c = 0; c < NCH; ++c) {
            bf16x8 sf[2][2][2];
#pragma unroll
            for (int jt = 0; jt < 2; ++jt)
#pragma unroll
                for (int it = 0; it < 2; ++it) { sf[jt][it][0] = accfrag(st[jt][it], 0); sf[jt][it][1] = accfrag(st[jt][it], 1); }
            { LAS unsigned char* d = vs + r32 * MSTR + h * 64;
              *(LAS u32x4*)d = ops.vr[0]; *(LAS u32x4*)(d + 16) = ops.vr[1]; *(LAS u32x4*)(d + 32) = ops.vr[2]; *(LAS u32x4*)(d + 48) = ops.vr[3]; }
            LDS_WAIT();
            bf16x8 vf[2][2];
            { const int g = lane >> 4, i16 = lane & 15, q = i16 >> 2, pp = i16 & 3;
#pragma unroll
              for (int it = 0; it < 2; ++it)
#pragma unroll
                  for (int s = 0; s < 2; ++s) { const LAS unsigned char* a = vs + (16 * s + 4 * h + q) * MSTR + (32 * it + 16 * (g & 1) + 4 * pp) * 2;
                      const s16x4 x = lds_tr16(a), y = lds_tr16(a + 8 * MSTR);
                      bf16x8 r; r[0] = x[0]; r[1] = x[1]; r[2] = x[2]; r[3] = x[3]; r[4] = y[0]; r[5] = y[1]; r[6] = y[2]; r[7] = y[3]; vf[it][s] = r; } }
            f32x16 o[2];
#pragma unroll
            for (int it = 0; it < 2; ++it) {
                o[it] = zero16();
#pragma unroll
                for (int jt = 0; jt < 2; ++jt)
#pragma unroll
                    for (int s = 0; s < 2; ++s) o[it] = mfma32(sf[jt][it][s], ops.fpo[jt][s], o[it]);
#pragma unroll
                for (int s = 0; s < 2; ++s) o[it] = mfma32(vf[it][s], ops.fqo[s], o[it]);
            }
            const unsigned char* nslot = ring + (size_t)((c + 1) % NSLOT) * SLOT_BYTES;
            if (c + 1 < NCH) { RK_SPIN(ready[(c + 1) % NSLOT] != (unsigned)(c + 2)); rk_load_ops_a(ops, nslot, lane); }
#pragma unroll
            for (int mt = 0; mt < 2; ++mt)
#pragma unroll
                for (int it = 0; it < 2; ++it) {
                    f32x16 a = zero16();
#pragma unroll
                    for (int jt = 0; jt < 2; ++jt)
#pragma unroll
                        for (int s = 0; s < 2; ++s) a = mfma32(ops.fps[mt][jt][s], sf[jt][it][s], a);
#pragma unroll
                    for (int s = 0; s < 2; ++s) a = mfma32(ops.fqs[mt][s], vf[it][s], a);
                    st[mt][it] = a;
                }
            if (c + 1 < NCH) rk_load_ops_b(ops, nslot, lane);
            if (c >= 1) RK_SPIN(ofree[0] != (unsigned)c);
            { LAS unsigned char* ob = lds + L_OBUF + r32 * OSTR;
#pragma unroll
              for (int it = 0; it < 2; ++it)
#pragma unroll
                  for (int g = 0; g < 4; ++g) *(LAS f32x4*)(ob + (32 * it + 8 * g + 4 * h) * 4) = (f32x4){o[it][4 * g], o[it][4 * g + 1], o[it][4 * g + 2], o[it][4 * g + 3]}; }
            LDS_WAIT();
            if (lane == 0) ofull[0] = (unsigned)(c + 1);
        }
    } else if (wave == 1) {
        int lane = tid & 63; asm volatile("" : "+v"(lane));
        const int r32 = lane & 31, h = lane >> 5;
        u32x4 gw[4], gb[4];
        RK_SPIN(ready[0] != 1u);
#pragma unroll
        for (int k = 0; k < 4; ++k) { gw[k] = ntload16(ring + SL_GW + k * 1024 + lane * 16); gb[k] = ntload16(ring + SL_GB + k * 1024 + lane * 16); }
        for (int c = 0; c < NCH; ++c) {
            const int sl = c % NSLOT;
            RK_SPIN(ofull[0] != (unsigned)(c + 1));
            float ov[32];
            { const LAS unsigned char* ob = lds + L_OBUF + r32 * OSTR + 128 * h;
#pragma unroll
              for (int k = 0; k < 8; ++k) { const f32x4 x = *(const LAS f32x4*)(ob + 16 * k); ov[4 * k] = x[0]; ov[4 * k + 1] = x[1]; ov[4 * k + 2] = x[2]; ov[4 * k + 3] = x[3]; } }
            LDS_WAIT();
            if (lane == 0) ofree[0] = (unsigned)(c + 1);
            float sm = 0.f;
#pragma unroll
            for (int k = 0; k < 32; ++k) sm += ov[k];
            sm += swap32(sm);
            const float mean = sm * (1.0f / 64.0f);
            float sv = 0.f;
#pragma unroll
            for (int k = 0; k < 32; ++k) { const float d = ov[k] - mean; sv += d * d; }
            sv += swap32(sv);
            const float rstd = 1.0f / sqrtf(sv * (1.0f / 64.0f) + 64e-5f);
            bf16_t* mrow = (bf16_t*)(p.ws + WS_B) + ((size_t)b * S + c * C + r32) * D + 512 + hh * HD + 32 * h;
#pragma unroll
            for (int k = 0; k < 4; ++k) {
                float w8[8], b8[8], r[8]; f8_from_bf16(gw[k], w8); f8_from_bf16(gb[k], b8);
                const f32x4 l0 = *(const f32x4*)(p.rw_ln_w + hh * HD + 32 * h + 8 * k), l1 = *(const f32x4*)(p.rw_ln_w + hh * HD + 32 * h + 8 * k + 4);
#pragma unroll
                for (int e = 0; e < 8; ++e) r[e] = ((ov[8 * k + e] - mean) * rstd * (e < 4 ? l0[e] : l1[e - 4]) + b8[e]) * w8[e];
                *(u32x4*)(mrow + 8 * k) = (u32x4){cvt_pk_bf16(r[0], r[1]), cvt_pk_bf16(r[2], r[3]), cvt_pk_bf16(r[4], r[5]), cvt_pk_bf16(r[6], r[7])};
            }
            if (lane == 0) freed[sl] = (unsigned)(c + 1);
            if (c + 1 < NCH) { const int sn = (c + 1) % NSLOT; const unsigned char* sp_ = ring + (size_t)sn * SLOT_BYTES; RK_SPIN(ready[sn] != (unsigned)(c + 2));
#pragma unroll
                for (int k = 0; k < 4; ++k) { gw[k] = ntload16(sp_ + SL_GW + k * 1024 + lane * 16); gb[k] = ntload16(sp_ + SL_GB + k * 1024 + lane * 16); } }
        }
    } else {
        int lane = tid & 63;
        if (wave - 2 < NPROD) for (int c = wave - 2; c < NCH; c += NPROD) {
            const int sl = c % NSLOT;
            if (c >= NSLOT) RK_SPIN(freed[sl] != (unsigned)(c - NSLOT + 1));
            rk_produce(p, lds, lds + (wave - 2) * PROD_LDS, ring + (size_t)sl * SLOT_BYTES, b, hh, c);
            asm volatile("s_waitcnt vmcnt(0)" ::: "memory");
            if (lane == 0) ready[sl] = (unsigned)(c + 1);
        }
    }
    __syncthreads();
}

#ifdef RWDEBUG
namespace rw {
constexpr int CH = 16;
constexpr int O_UM = 0;
constexpr int O_LW = O_UM + CH * 448 * 4;
constexpr int O_LA = O_LW + CH * 64 * 4;
constexpr int O_LG0 = O_LA + CH * 64 * 4;
constexpr int O_LG1 = O_LG0 + CH * 64 * 4;
constexpr int O_A1 = O_LG1 + CH * 64 * 4;
constexpr int O_R1 = O_A1 + CH * 64 * 4;
constexpr int O_B1 = O_R1 + CH * 64 * 4;
constexpr int O_K1 = O_B1 + CH * 64 * 4;
constexpr int O_O = O_K1 + CH * 64 * 4;
constexpr int O_WT = O_O + CH * 64 * 4;
constexpr int O_GC = O_WT + 8 * 64 * 4;
constexpr int O_SC = O_GC + 64 * 4;
constexpr int O_END = O_SC + 3 * 16 * 4;
}
__device__ __forceinline__ bf16x8 ldw_frag(const float* W, int ldw, int m0, int col) {
    unsigned w[4];
#pragma unroll
    for (int j = 0; j < 4; ++j) w[j] = cvt_pk_bf16(W[(size_t)(m0 + 2 * j) * ldw + col], W[(size_t)(m0 + 2 * j + 1) * ldw + col]);
    return __builtin_bit_cast(bf16x8, (u32x4){w[0], w[1], w[2], w[3]});
}
template <int ACT>
__device__ __forceinline__ bf16x8 act_frag(const LAS float* src) {
    const f32x4 a = *(const LAS f32x4*)src, b = *(const LAS f32x4*)(src + 4); float v[8] = {a[0], a[1], a[2], a[3], b[0], b[1], b[2], b[3]};
#pragma unroll
    for (int j = 0; j < 8; ++j) {
        if (ACT == 1) v[j] = 1.0f - 2.0f * frcp(1.0f + fexp2(v[j] * (2.0f * LOG2E)));
        if (ACT == 2) v[j] = frcp(1.0f + fexp2(-v[j] * LOG2E));
    }
    return __builtin_bit_cast(bf16x8, (u32x4){cvt_pk_bf16(v[0], v[1]), cvt_pk_bf16(v[2], v[3]), cvt_pk_bf16(v[4], v[5]), cvt_pk_bf16(v[6], v[7])});
}

__device__ __forceinline__ void rwkv_chain_seq(const Params& p, LAS unsigned char* lds, int b, int h, bf16_t* mix, int nchunks) {
    using namespace rw;
    const int tid = threadIdx.x, wave = __builtin_amdgcn_readfirstlane(tid >> 6), lane = tid & 63;
    const bf16_t* u = (const bf16_t*)(p.ws + WS_A);
    const size_t row0 = (size_t)b * S;
    LAS float* UM = (LAS float*)(lds + O_UM); LAS float* LW = (LAS float*)(lds + O_LW); LAS float* LA = (LAS float*)(lds + O_LA);
    LAS float* LG0 = (LAS float*)(lds + O_LG0); LAS float* LG1 = (LAS float*)(lds + O_LG1);
    LAS float* A1 = (LAS float*)(lds + O_A1); LAS float* R1 = (LAS float*)(lds + O_R1); LAS float* B1 = (LAS float*)(lds + O_B1); LAS float* K1 = (LAS float*)(lds + O_K1);
    LAS float* OO = (LAS float*)(lds + O_O); LAS float* WT = (LAS float*)(lds + O_WT); LAS float* GC = (LAS float*)(lds + O_GC); LAS float* SC = (LAS float*)(lds + O_SC);
    const int fc = lane & 15, fq = lane >> 4;
    bf16x8 bwa[2], bg[2];
    { const float* W = wave < 4 ? p.rw_w2 : p.rw_a2; const int col = h * HD + 16 * (wave & 3) + fc;
      bwa[0] = ldw_frag(W, 512, 8 * fq, col); bwa[1] = ldw_frag(W, 512, 32 + 8 * fq, col);
      const int ks = (wave >> 2) * 2; bg[0] = ldw_frag(p.rw_g2, 512, 32 * ks + 8 * fq, col); bg[1] = ldw_frag(p.rw_g2, 512, 32 * (ks + 1) + 8 * fq, col); }
    const int hj = h * HD + lane;
    const float c_w0 = p.rw_w0[hj], c_a0 = p.rw_a0[hj], c_kk = p.rw_k_k[hj], c_ka = p.rw_k_a[hj], c_rk = p.rw_r_k[hj], c_lnw = p.rw_ln_w[hj], c_lnb = p.rw_ln_b[hj];
    int ld_t[2], ld_c[2], ld_uc[2]; bool ld_ok[2];
#pragma unroll
    for (int r = 0; r < 2; ++r) { const int gid = tid + 512 * r; ld_ok[r] = gid < CH * 56; const int t = gid / 56, cg8 = gid % 56; ld_t[r] = t; ld_c[r] = cg8 * 8;
        ld_uc[r] = cg8 < 8 ? UR + h * HD + 8 * cg8 : cg8 < 16 ? URK + h * HD + 8 * (cg8 - 8) : cg8 < 24 ? URV + h * HD + 8 * (cg8 - 16) : UXW + 8 * (cg8 - 24); }
    const int si = 8 * wave + (lane >> 3), sj = 8 * (lane & 7);
    float st[8];
#pragma unroll
    for (int n = 0; n < 8; ++n) st[n] = 0.f;
    u32x4 cur[2], prv[2];
    auto issue_loads = [&](int t0) {
#pragma unroll
        for (int r = 0; r < 2; ++r) { cur[r] = (u32x4){0u, 0u, 0u, 0u}; prv[r] = (u32x4){0u, 0u, 0u, 0u};
            if (ld_ok[r]) { const int tt = t0 + ld_t[r]; const bf16_t* a = u + (row0 + tt) * NIN + ld_uc[r]; cur[r] = *(const u32x4*)a; if (tt > 0) prv[r] = *(const u32x4*)(a - NIN); } }
    };
    issue_loads(0);
    for (int c = 0; c < nchunks; ++c) {
        const int t0 = c * CH;
#pragma unroll
        for (int r = 0; r < 2; ++r) if (ld_ok[r]) {
            const float* mu = p.shift_mu + (ld_uc[r] - UR); const f32x4 m0 = *(const f32x4*)mu, m1 = *(const f32x4*)(mu + 4);
            float cv[8], pv[8];
#pragma unroll
            for (int j = 0; j < 4; ++j) { cv[2 * j] = bf16_lo(cur[r][j]); cv[2 * j + 1] = bf16_hi(cur[r][j]); pv[2 * j] = bf16_lo(prv[r][j]); pv[2 * j + 1] = bf16_hi(prv[r][j]); }
            f32x4 o0, o1;
#pragma unroll
            for (int j = 0; j < 4; ++j) { o0[j] = cv[j] + (pv[j] - cv[j]) * m0[j]; o1[j] = cv[4 + j] + (pv[4 + j] - cv[4 + j]) * m1[j]; }
            LAS float* d = UM + ld_t[r] * 448 + ld_c[r]; *(LAS f32x4*)d = o0; *(LAS f32x4*)(d + 4) = o1;
        }
        if (c + 1 < S / CH) issue_loads(t0 + CH);
        __syncthreads();
        {
            f32x4 acc = (f32x4){0.f, 0.f, 0.f, 0.f};
            const LAS float* src = UM + fc * 448 + (wave < 4 ? 192 : 256) + 8 * fq;
            if (wave < 4) { acc = __builtin_amdgcn_mfma_f32_16x16x32_bf16(act_frag<1>(src), bwa[0], acc, 0, 0, 0); acc = __builtin_amdgcn_mfma_f32_16x16x32_bf16(act_frag<1>(src + 32), bwa[1], acc, 0, 0, 0); }
            else          { acc = __builtin_amdgcn_mfma_f32_16x16x32_bf16(act_frag<0>(src), bwa[0], acc, 0, 0, 0); acc = __builtin_amdgcn_mfma_f32_16x16x32_bf16(act_frag<0>(src + 32), bwa[1], acc, 0, 0, 0); }
            LAS float* dst = (wave < 4 ? LW : LA) + 16 * (wave & 3) + fc;
#pragma unroll
            for (int r = 0; r < 4; ++r) dst[(4 * fq + r) * 64] = acc[r];
            f32x4 ag = (f32x4){0.f, 0.f, 0.f, 0.f};
            const LAS float* sg = UM + fc * 448 + 320 + 64 * (wave >> 2) + 8 * fq;
            ag = __builtin_amdgcn_mfma_f32_16x16x32_bf16(act_frag<2>(sg), bg[0], ag, 0, 0, 0); ag = __builtin_amdgcn_mfma_f32_16x16x32_bf16(act_frag<2>(sg + 32), bg[1], ag, 0, 0, 0);
            LAS float* dg = (wave < 4 ? LG0 : LG1) + 16 * (wave & 3) + fc;
#pragma unroll
            for (int r = 0; r < 4; ++r) dg[(4 * fq + r) * 64] = ag[r];
        }
        __syncthreads();
        float e_kk[2], e_b[2], e_k[2], e_r[2], e_ld[2];
#pragma unroll
        for (int tt = 0; tt < 2; ++tt) {
            const int t = 2 * wave + tt;
            const float xw = c_w0 + LW[t * 64 + lane];
            const float spn = (fmaxf(-xw, 0.f) + LN2 * flog2(1.0f + fexp2(-fabsf(xw) * LOG2E)));
            e_ld[tt] = -fexp2((-spn - 0.5f) * LOG2E);
            const float a = frcp(1.0f + fexp2(-(c_a0 + LA[t * 64 + lane]) * LOG2E));
            const float kraw = UM[t * 448 + 64 + lane], r = UM[t * 448 + lane];
            const float kkv = kraw * c_kk; const float ssq = wave_sum(kkv * kkv);
            const float kk = kkv * frsq(fmaxf(ssq, 1e-24f));
            const float kmod = kraw * (1.0f + (a - 1.0f) * c_ka);
            const float bb = kk * a;
            const float cbr = wave_sum(bb * r), ckr = wave_sum(kmod * r), bon = wave_sum(r * kmod * c_rk);
            if (lane == 0) { SC[t] = cbr; SC[16 + t] = ckr; SC[32 + t] = bon; }
            e_kk[tt] = kk; e_b[tt] = bb; e_k[tt] = kmod; e_r[tt] = r;
        }
        WT[wave * 64 + lane] = e_ld[0] + e_ld[1];
        __syncthreads();
        {
            float off = 0.f, tot = 0.f;
#pragma unroll
            for (int w = 0; w < 8; ++w) { const float x = WT[w * 64 + lane]; if (w < wave) off += x; tot += x; }
            const float c0 = off + e_ld[0], c1 = c0 + e_ld[1];
            const int t = 2 * wave;
            A1[t * 64 + lane] = -e_kk[0] * fexp2(off * LOG2E);       A1[(t + 1) * 64 + lane] = -e_kk[1] * fexp2(c0 * LOG2E);
            R1[t * 64 + lane] = e_r[0] * fexp2(c0 * LOG2E);          R1[(t + 1) * 64 + lane] = e_r[1] * fexp2(c1 * LOG2E);
            const float i0 = fexp2(-c0 * LOG2E), i1 = fexp2(-c1 * LOG2E);
            B1[t * 64 + lane] = e_b[0] * i0;                          B1[(t + 1) * 64 + lane] = e_b[1] * i1;
            K1[t * 64 + lane] = e_k[0] * i0;                          K1[(t + 1) * 64 + lane] = e_k[1] * i1;
            if (wave == 0) GC[lane] = fexp2(tot * LOG2E);
        }
        __syncthreads();
#pragma unroll 4
        for (int t = 0; t < CH; ++t) {
            const f32x4 a0 = *(const LAS f32x4*)(A1 + t * 64 + sj), a1 = *(const LAS f32x4*)(A1 + t * 64 + sj + 4);
            const f32x4 r0 = *(const LAS f32x4*)(R1 + t * 64 + sj), r1 = *(const LAS f32x4*)(R1 + t * 64 + sj + 4);
            const f32x4 b0 = *(const LAS f32x4*)(B1 + t * 64 + sj), b1 = *(const LAS f32x4*)(B1 + t * 64 + sj + 4);
            const f32x4 k0 = *(const LAS f32x4*)(K1 + t * 64 + sj), k1 = *(const LAS f32x4*)(K1 + t * 64 + sj + 4);
            const float v = UM[t * 448 + 128 + si], cbr = SC[t], ckr = SC[16 + t];
            float sa = (st[0] * a0[0] + st[1] * a0[1]) + (st[2] * a0[2] + st[3] * a0[3]) + ((st[4] * a1[0] + st[5] * a1[1]) + (st[6] * a1[2] + st[7] * a1[3]));
            float pp = (st[0] * r0[0] + st[1] * r0[1]) + (st[2] * r0[2] + st[3] * r0[3]) + ((st[4] * r1[0] + st[5] * r1[1]) + (st[6] * r1[2] + st[7] * r1[3]));
            sa = sum8(sa); pp = sum8(pp);
            if ((lane & 7) == 0) OO[t * 64 + si] = pp + sa * cbr + v * ckr;
#pragma unroll
            for (int n = 0; n < 4; ++n) { st[n] += sa * b0[n] + v * k0[n]; st[4 + n] += sa * b1[n] + v * k1[n]; }
        }
        {
            const f32x4 g0 = *(const LAS f32x4*)(GC + sj), g1 = *(const LAS f32x4*)(GC + sj + 4);
#pragma unroll
            for (int n = 0; n < 4; ++n) { st[n] *= g0[n]; st[4 + n] *= g1[n]; }
        }
        __syncthreads();
#pragma unroll
        for (int tt = 0; tt < 2; ++tt) {
            const int t = 2 * wave + tt;
            const float o = OO[t * 64 + lane];
            const float mean = wave_sum(o) * (1.0f / 64.0f); const float dlt = o - mean;
            const float var = wave_sum(dlt * dlt) * (1.0f / 64.0f);
            const float gn = dlt * (1.0f / sqrtf(var + 64e-5f)) * c_lnw + c_lnb;
            const float res = (gn + SC[32 + t] * UM[t * 448 + 128 + lane]) * (LG0[t * 64 + lane] + LG1[t * 64 + lane]);
            mix[(row0 + t0 + t) * D + 512 + h * HD + lane] = (bf16_t)(cvt_pk_bf16(res, 0.f) & 0xffffu);
        }
        __syncthreads();
    }
}

#endif

__device__ __forceinline__ void phase2a(const Params& p) {
    int tid = threadIdx.x; asm volatile("" : "+v"(tid));
    const int wave = tid >> 6, lane = tid & 63;
    const bf16_t* u = (const bf16_t*)(p.ws + WS_A);
    bf16_t* act = (bf16_t*)((unsigned char*)p.out + ACT_OFF);
    const f32x4 mu = *(const f32x4*)(p.shift_mu + (UXW - UR) + 4 * lane);
    const int stride = gridDim.x * NWAVES;
    int row = blockIdx.x * NWAVES + wave;
    u32x2 c = (u32x2){0u, 0u}, pv = (u32x2){0u, 0u};
    if (row < T) { const bf16_t* a = u + (size_t)row * NIN + UXW + 4 * lane; c = *(const u32x2*)a; if ((row & (S - 1)) != 0) pv = *(const u32x2*)(a - NIN); }
    for (; row < T; row += stride) {
        const float cv[4] = {bf16_lo(c.x), bf16_hi(c.x), bf16_lo(c.y), bf16_hi(c.y)}, pf[4] = {bf16_lo(pv.x), bf16_hi(pv.x), bf16_lo(pv.y), bf16_hi(pv.y)};
        const int nrow = row + stride;
        if (nrow < T) { const bf16_t* a = u + (size_t)nrow * NIN + UXW + 4 * lane; c = *(const u32x2*)a; pv = (u32x2){0u, 0u}; if ((nrow & (S - 1)) != 0) pv = *(const u32x2*)(a - NIN); }
        float x[4];
#pragma unroll
        for (int j = 0; j < 4; ++j) { x[j] = cv[j] + (pf[j] - cv[j]) * mu[j];
            if (lane < 16) x[j] = 1.0f - 2.0f * frcp(1.0f + fexp2(x[j] * (2.0f * LOG2E)));
            else if (lane >= 32) x[j] = frcp(1.0f + fexp2(-x[j] * LOG2E)); }
        *(u32x2*)(act + (size_t)row * 256 + 4 * lane) = (u32x2){cvt_pk_bf16(x[0], x[1]), cvt_pk_bf16(x[2], x[3])};
    }
}

__device__ __forceinline__ void phase2(const Params& p, LAS unsigned char* lds) {
    const int nchain = NB * NH, G = gridDim.x, wave = threadIdx.x >> 6;
    const int nscan = G >= 2 * nchain ? nchain : (G > 1 ? G / 2 : 0);
    if ((int)blockIdx.x < nscan || nscan == 0) {
        const int stride = nscan == 0 ? G : nscan;
        for (int it = blockIdx.x; it < nchain; it += stride) rwkv_chain(p, lds, it / NH, it % NH);
    }
    if ((int)blockIdx.x >= nscan) {
        const int nb = G - nscan, bi = blockIdx.x - nscan;
        for (int it = bi * 8 + wave; it < NB * NH * 64; it += nb * 8) attn_tile(p, lds + wave * 9216, it / (NH * 64), (it / 64) % NH, 63 - (it % 64));
        __syncthreads();
        p0_expert_weights(p, lds, bi * 8 + wave, nb * 8);
    }
}

struct EpiH {
    const float* x; float* hout; int row0, col0;
    __device__ __forceinline__ void operator()(const f32x4 (&acc)[2][2][4][2], int wr, int wc, int fr, int fq) const {
#pragma unroll
        for (int ai = 0; ai < 2; ++ai)
#pragma unroll
            for (int m = 0; m < 4; ++m) { const size_t off = (size_t)(row0 + ai * 128 + wr * 64 + m * 16 + fr) * D + col0 + wc * 32 + 8 * fq;
#pragma unroll
                for (int bj = 0; bj < 2; ++bj)
#pragma unroll
                    for (int n = 0; n < 2; ++n) { const f32x4 xv = *(const f32x4*)(x + off + bj * 128 + n * 4); *(f32x4*)(hout + off + bj * 128 + n * 4) = xv + acc[ai][bj][m][n]; } }
    }
};
__device__ __forceinline__ void phase3(const Params& p, LAS unsigned char* lds) {
    constexpr int nM = T / 256, nN = D / 256;
    unsigned aoff[2][2]; g8::aoff_rows(aoff, D);
    for (int L = blockIdx.x; L < nM * nN; L += gridDim.x) {
        int pm, pn; g8::tile_order(L, nM, nN, pm, pn);
        EpiH E{p.x, p.out, pm * 256, pn * 256};
        g8::gemm_unit(lds, (const char*)(p.ws + WS_B) + (size_t)pm * 256 * D * 2, aoff, (const char*)(p.ws + WS_WOUT) + (size_t)pn * 256 * D * 2, D, E);
    }
}

__device__ __forceinline__ void phase4(const Params& p, LAS unsigned char* lds) {
    int tid = threadIdx.x; asm volatile("" : "+v"(tid));
    const int wave = tid >> 6, lane = tid & 63, fr = lane & 15, fq = lane >> 4;
    const float* hsrc = p.out; bf16_t* hb = (bf16_t*)(p.ws + WS_A); float* rstd2 = (float*)(p.ws + WS_RSTD2);
    const bf16_t* wr_hi = (const bf16_t*)(p.ws + WS_WR); const bf16_t* wr_lo = wr_hi + 48 * D;
    int* list = (int*)(p.ws + WS_LIST); float* listw = (float*)(p.ws + WS_LISTW); unsigned* cnt = (unsigned*)(p.ws + WS_CTL);
    LAS float* lg = (LAS float*)(lds + wave * 3072);
    LAS unsigned* lcnt = (LAS unsigned*)(lds + 8 * 3072);
    LAS unsigned* gbase = lcnt + 32;
    for (int blk = blockIdx.x; blk < T / 128; blk += gridDim.x) {
        if (tid < 32) lcnt[tid] = 0u;
        __syncthreads();
        const int tok0 = blk * 128 + wave * 16;
        f32x4 acc[3];
#pragma unroll
        for (int n = 0; n < 3; ++n) acc[n] = (f32x4){0.f, 0.f, 0.f, 0.f};
        float ss = 0.f;
        const float* hp = hsrc + (size_t)(tok0 + fr) * D + 8 * fq; bf16_t* hbp = hb + (size_t)(tok0 + fr) * D + 8 * fq;
        LAS unsigned char* wl_ = lds + 32768;
#pragma unroll 1
        for (int half = 0; half < 2; ++half) {
            __syncthreads();
            for (int i = tid; i < 2 * 48 * 64; i += NTHREADS) { const int mat = i / 3072, r = (i % 3072) >> 6, ch = i & 63;
                *(LAS u32x4*)(wl_ + mat * 49152 + r * 1024 + ((ch ^ (r & 15)) << 4)) = *(const u32x4*)((mat ? wr_lo : wr_hi) + (size_t)r * D + half * 512 + ch * 8); }
            f32x4 av[16][2];
#pragma unroll
            for (int ks = 0; ks < 16; ++ks) { av[ks][0] = *(const f32x4*)(hp + half * 512 + 32 * ks); av[ks][1] = *(const f32x4*)(hp + half * 512 + 32 * ks + 4); }
            __syncthreads();
#pragma unroll
            for (int ks = 0; ks < 16; ++ks) {
                const f32x4 v0 = av[ks][0], v1 = av[ks][1];
                ss += (v0[0] * v0[0] + v0[1] * v0[1]) + (v0[2] * v0[2] + v0[3] * v0[3]) + ((v1[0] * v1[0] + v1[1] * v1[1]) + (v1[2] * v1[2] + v1[3] * v1[3]));
                u32x4 hi; hi.x = cvt_pk_bf16(v0[0], v0[1]); hi.y = cvt_pk_bf16(v0[2], v0[3]); hi.z = cvt_pk_bf16(v1[0], v1[1]); hi.w = cvt_pk_bf16(v1[2], v1[3]);
                *(u32x4*)(hbp + half * 512 + 32 * ks) = hi;
                u32x4 lo; lo.x = cvt_pk_bf16(v0[0] - bf16_lo(hi.x), v0[1] - bf16_hi(hi.x)); lo.y = cvt_pk_bf16(v0[2] - bf16_lo(hi.y), v0[3] - bf16_hi(hi.y));
                lo.z = cvt_pk_bf16(v1[0] - bf16_lo(hi.z), v1[1] - bf16_hi(hi.z)); lo.w = cvt_pk_bf16(v1[2] - bf16_lo(hi.w), v1[3] - bf16_hi(hi.w));
                const bf16x8 ah = __builtin_bit_cast(bf16x8, hi), al = __builtin_bit_cast(bf16x8, lo);
#pragma unroll
                for (int n = 0; n < 3; ++n) {
                    const int r = 16 * n + fr, off = r * 1024 + (((4 * ks + fq) ^ (r & 15)) << 4);
                    const bf16x8 wh = *(const LAS bf16x8*)(wl_ + off), wl = *(const LAS bf16x8*)(wl_ + 49152 + off);
                    acc[n] = __builtin_amdgcn_mfma_f32_16x16x32_bf16(ah, wh, acc[n], 0, 0, 0);
                    acc[n] = __builtin_amdgcn_mfma_f32_16x16x32_bf16(al, wh, acc[n], 0, 0, 0);
                    acc[n] = __builtin_amdgcn_mfma_f32_16x16x32_bf16(ah, wl, acc[n], 0, 0, 0);
                }
            }
        }
        ss += __shfl_xor(ss, 16); ss += __shfl_xor(ss, 32);
        const float rs = 1.0f / sqrtf(ss * (1.0f / D) + 1e-6f);
        if (fq == 0) rstd2[tok0 + fr] = rs;
#pragma unroll
        for (int n = 0; n < 3; ++n)
#pragma unroll
            for (int r = 0; r < 4; ++r) lg[(4 * fq + r) * 48 + 16 * n + fr] = acc[n][r];
        LDS_WAIT();
        int e0 = 0, e1 = 0; float w0 = 0.f, w1 = 0.f; unsigned lp0 = 0, lp1 = 0;
        if (lane < 16) {
            const float rst = rs;
            const LAS float* L = lg + lane * 48;
            float gl[4]; int gi = 0; float gm;
#pragma unroll
            for (int g = 0; g < 4; ++g) gl[g] = L[g] * rst + p.r_grp_b[g];
            gm = gl[0];
#pragma unroll
            for (int g = 1; g < 4; ++g) if (gl[g] > gm) { gm = gl[g]; gi = g; }
            float gs = 0.f;
#pragma unroll
            for (int g = 0; g < 4; ++g) gs += __expf(gl[g] - gm);
            const float gval = 1.0f / gs;
            float el[8];
#pragma unroll
            for (int e = 0; e < 8; ++e) el[e] = L[4 + gi * 8 + e] * rst + p.r_exp_b[gi * 8 + e];
            int i0 = 0; float m0 = el[0];
#pragma unroll
            for (int e = 1; e < 8; ++e) if (el[e] > m0) { m0 = el[e]; i0 = e; }
            int i1 = i0 == 0 ? 1 : 0; float m1 = el[i1];
#pragma unroll
            for (int e = 0; e < 8; ++e) if (e != i0 && el[e] > m1) { m1 = el[e]; i1 = e; }
            const float x1 = __expf(m1 - m0); const float den = 1.0f / (1.0f + x1);
            e0 = gi * 8 + i0; e1 = gi * 8 + i1; w0 = gval * den; w1 = gval * x1 * den;
            lp0 = atomicAdd((unsigned*)&lcnt[e0], 1u); lp1 = atomicAdd((unsigned*)&lcnt[e1], 1u);
        }
        __syncthreads();
        if (tid < 32) gbase[tid] = atomicAdd(&cnt[tid], lcnt[tid]);
        __syncthreads();
        if (lane < 16) {
            const int tok = tok0 + lane;
            const unsigned q0 = gbase[e0] + lp0, q1 = gbase[e1] + lp1;
            list[(size_t)e0 * T + q0] = tok * 2;     listw[(size_t)e0 * T + q0] = w0;
            list[(size_t)e1 * T + q1] = tok * 2 + 1; listw[(size_t)e1 * T + q1] = w1;
        }
        __syncthreads();
    }
}

constexpr int LDS_MAP = 161792;
__device__ __forceinline__ void expert_map_build(const unsigned* cnt, LAS unsigned char* lds) {
    LAS int* pre = (LAS int*)(lds + LDS_MAP); LAS int* cn = pre + 40;
    if (threadIdx.x == 0) { int acc = 0; for (int i = 0; i < NE; ++i) { const int ci = (int)__hip_atomic_load(cnt + i, __ATOMIC_RELAXED, __HIP_MEMORY_SCOPE_AGENT); pre[i] = acc; cn[i] = ci; acc += (ci + 255) >> 8; } pre[NE] = acc; }
    __syncthreads();
}
__device__ __forceinline__ void expert_find(LAS unsigned char* lds, int mt, int& e, int& local, int& c) {
    const LAS int* pre = (const LAS int*)(lds + LDS_MAP); const LAS int* cn = pre + 40;
    int lo = 0;
#pragma unroll 1
    for (int i = 1; i < NE; ++i) if (pre[i] <= mt) lo = i;
    e = __builtin_amdgcn_readfirstlane(lo); local = mt - __builtin_amdgcn_readfirstlane(pre[e]); c = __builtin_amdgcn_readfirstlane(cn[e]);
}
__device__ __forceinline__ int expert_tiles(LAS unsigned char* lds) { return __builtin_amdgcn_readfirstlane(((const LAS int*)(lds + LDS_MAP))[NE]); }

struct EpiGU {
    bf16_t* hid; const float* rstd2; const int* lst; int cnt, p0, hrow0, ct;
    __device__ __forceinline__ void operator()(const f32x4 (&acc)[2][2][4][2], int wr, int wc, int fr, int fq) const {
#pragma unroll
        for (int ai = 0; ai < 2; ++ai)
#pragma unroll
            for (int m = 0; m < 4; ++m) { const int r = ai * 128 + wr * 64 + m * 16 + fr; const int pp = p0 + r;
                const float rs = pp < cnt ? rstd2[lst[pp] >> 1] : 0.f;
                bf16_t* op = hid + (size_t)(hrow0 + r) * DE + ct * 128 + wc * 32 + 8 * fq;
                float o[8];
#pragma unroll
                for (int n = 0; n < 2; ++n) { const f32x4 g = acc[ai][0][m][n] * rs, uu = acc[ai][1][m][n] * rs;
#pragma unroll
                    for (int j = 0; j < 4; ++j) o[4 * n + j] = g[j] * frcp(1.0f + fexp2(-g[j] * LOG2E)) * uu[j]; }
                *(u32x4*)op = (u32x4){cvt_pk_bf16(o[0], o[1]), cvt_pk_bf16(o[2], o[3]), cvt_pk_bf16(o[4], o[5]), cvt_pk_bf16(o[6], o[7])}; }
    }
};
__device__ __forceinline__ void phase5(const Params& p, LAS unsigned char* lds) {
    expert_map_build((const unsigned*)(p.ws + WS_CTL), lds);
    const int MT = expert_tiles(lds);
    const int tid = threadIdx.x;
    for (int unit = blockIdx.x; unit < MT * 2; unit += gridDim.x) {
        const int mt = unit >> 1, ct = unit & 1; int e, local, c; expert_find(lds, mt, e, local, c);
        const int* lst = (const int*)(p.ws + WS_LIST) + (size_t)e * T; const int p0 = local * 256;
        unsigned aoff[2][2];
#pragma unroll
        for (int i = 0; i < 2; ++i) { int R, C; g8::stage_rc(tid * 16 + i * 8192, R, C);
#pragma unroll
            for (int hh = 0; hh < 2; ++hh) { const int pp = p0 + hh * 128 + R; const int tok = pp < c ? (lst[pp] >> 1) : 0; aoff[hh][i] = (unsigned)(tok * D + C) * 2u; } }
        EpiGU E{(bf16_t*)(p.ws + WS_B), (const float*)(p.ws + WS_RSTD2), lst, c, p0, mt * 256, ct};
        g8::gemm_unit(lds, (const char*)(p.ws + WS_A), aoff, (const char*)(p.ws + WS_WGU) + ((size_t)e * 512 + ct * 256) * D * 2, D, E);
    }
}
struct EpiDN {
    bf16_t* y; bf16_t* dummy; const int* lst; const float* lw; int cnt, p0, col0;
    __device__ __forceinline__ void operator()(const f32x4 (&acc)[2][2][4][2], int wr, int wc, int fr, int fq) const {
#pragma unroll
        for (int ai = 0; ai < 2; ++ai)
#pragma unroll
            for (int m = 0; m < 4; ++m) { const int pp = p0 + ai * 128 + wr * 64 + m * 16 + fr;
                const bool ok = pp < cnt; const int ent = lst[pp]; const float w = lw[pp];
                bf16_t* op = (ok ? y + ((size_t)(ent & 1) * T + (ent >> 1)) * D : dummy) + col0 + wc * 32 + 8 * fq;
#pragma unroll
                for (int bj = 0; bj < 2; ++bj) { const f32x4 v0 = acc[ai][bj][m][0] * w, v1 = acc[ai][bj][m][1] * w;
                    *(u32x4*)(op + bj * 128) = (u32x4){cvt_pk_bf16(v0[0], v0[1]), cvt_pk_bf16(v0[2], v0[3]), cvt_pk_bf16(v1[0], v1[1]), cvt_pk_bf16(v1[2], v1[3])}; }
                if (m & 1) asm volatile("" ::: "memory"); }
    }
};
__device__ __forceinline__ void phase6(const Params& p, LAS unsigned char* lds) {
    expert_map_build((const unsigned*)(p.ws + WS_CTL), lds);
    const int MT = expert_tiles(lds);
    constexpr int kdn = DE;
    unsigned aoff[2][2]; g8::aoff_rows(aoff, kdn);
    for (int unit = blockIdx.x; unit < MT * 4; unit += gridDim.x) {
        const int mt = unit >> 2, pn = unit & 3; int e, local, c; expert_find(lds, mt, e, local, c);
        EpiDN E{(bf16_t*)(p.ws + WS_A + (size_t)T * D * 2), (bf16_t*)(p.ws + WS_A + (size_t)3 * T * D * 2), (const int*)(p.ws + WS_LIST) + (size_t)e * T, (const float*)(p.ws + WS_LISTW) + (size_t)e * T, c, local * 256, pn * 256};
        g8::gemm_unit(lds, (const char*)(p.ws + WS_B) + (size_t)mt * 256 * DE * 2, aoff, (const char*)(p.ws + WS_WDN) + ((size_t)e * D + pn * 256) * DE * 2, kdn, E);
    }
}

__device__ __forceinline__ void phase7(const Params& p) {
    int tid7 = threadIdx.x; asm volatile("" : "+v"(tid7));
    const int wave = tid7 >> 6, lane = tid7 & 63;
    const bf16_t* hb = (const bf16_t*)(p.ws + WS_A);
    const bf16_t* y0 = (const bf16_t*)(p.ws + WS_A + (size_t)T * D * 2); const bf16_t* y1 = y0 + (size_t)T * D;
    f32x4 g[4];
#pragma unroll
    for (int j = 0; j < 4; ++j) g[j] = *((const f32x4*)p.final_g + lane + 64 * j);
    const int stride = gridDim.x * NWAVES;
    int row = blockIdx.x * NWAVES + wave;
    u32x2 hv[4], ya[4], yb[4];
    if (row < T) {
#pragma unroll
        for (int j = 0; j < 4; ++j) { hv[j] = ((const u32x2*)(hb + (size_t)row * D) + lane)[64 * j]; ya[j] = ((const u32x2*)(y0 + (size_t)row * D) + lane)[64 * j]; yb[j] = ((const u32x2*)(y1 + (size_t)row * D) + lane)[64 * j]; }
    }
    for (; row < T; row += stride) {
        f32x4 v[4]; float s = 0.f;
#pragma unroll
        for (int j = 0; j < 4; ++j) {
            v[j][0] = bf16_lo(hv[j].x) + (bf16_lo(ya[j].x) + bf16_lo(yb[j].x)); v[j][1] = bf16_hi(hv[j].x) + (bf16_hi(ya[j].x) + bf16_hi(yb[j].x)); v[j][2] = bf16_lo(hv[j].y) + (bf16_lo(ya[j].y) + bf16_lo(yb[j].y)); v[j][3] = bf16_hi(hv[j].y) + (bf16_hi(ya[j].y) + bf16_hi(yb[j].y));
            s += (v[j][0] * v[j][0] + v[j][1] * v[j][1]) + (v[j][2] * v[j][2] + v[j][3] * v[j][3]); }
        const int nrow = row + stride;
        if (nrow < T) {
#pragma unroll
            for (int j = 0; j < 4; ++j) { hv[j] = ((const u32x2*)(hb + (size_t)nrow * D) + lane)[64 * j]; ya[j] = ((const u32x2*)(y0 + (size_t)nrow * D) + lane)[64 * j]; yb[j] = ((const u32x2*)(y1 + (size_t)nrow * D) + lane)[64 * j]; }
        }
        s = wave_sum(s);
        const float rs = 1.0f / sqrtf(s * (1.0f / D) + 1e-6f);
        f32x4* orow = (f32x4*)(p.out + (size_t)row * D) + lane;
#pragma unroll
        for (int j = 0; j < 4; ++j) orow[64 * j] = v[j] * rs * g[j];
    }
}

__global__ __launch_bounds__(512) void mega(Params p) {
    extern __shared__ __attribute__((aligned(16))) unsigned char lds_raw[];
    LAS unsigned char* lds = (LAS unsigned char*)lds_raw;
    volatile LAS unsigned* bst = (volatile LAS unsigned*)(lds + LDS_MAP + 512);
    if (threadIdx.x == 0) { bst[0] = 0u; bst[1] = 0u; bst[2] = 0u; bst[3] = 0u; }
    __syncthreads();
    const XcdBarrier gb = xcd_barrier_post((unsigned*)(p.ws + WS_BAR), bst);
#define GSYNC() xcd_barrier(gb)
#ifndef PHASE_MASK
#define PHASE_MASK 0xff
#endif
#ifdef TPROBE
    volatile LAS unsigned long long* tsl = (volatile LAS unsigned long long*)(lds + LDS_MAP + 640);
    if (threadIdx.x == 0) tsl[0] = __builtin_amdgcn_s_memrealtime();
#define TS(i) do { if (threadIdx.x == 0 && ((i) == TPROBE || (i) == TPROBE + 1)) tsl[i] = __builtin_amdgcn_s_memrealtime(); } while (0)
#else
#define TS(i)
#endif
    if (PHASE_MASK & 1) phase0(p, lds); GSYNC(); TS(1);
    if (PHASE_MASK & 2) phase1(p, lds); GSYNC(); TS(2);
    if (PHASE_MASK & 4) { phase2a(p); GSYNC(); phase2(p, lds); } GSYNC(); TS(3);
#ifdef RWDEBUG
    {
        bf16_t* dbg = (bf16_t*)(p.ws + WS_A + (size_t)3 * T * D * 2 + 4096);
        float* red = (float*)(p.ws + WS_CTL + 2048);
        if (blockIdx.x == 0) {
            rwkv_chain_seq(p, lds, RWDEBUG_B, RWDEBUG_H, dbg - (size_t)RWDEBUG_B * S * D, 2 * RWDEBUG_C1);
            __syncthreads();
            const bf16_t* mix = (const bf16_t*)(p.ws + WS_B);
            float md = 0.f, mr = 0.f; int bad = 0;
            for (int i = threadIdx.x; i < (RWDEBUG_C1 - RWDEBUG_C0) * 32 * 64; i += NTHREADS) {
                const int t = RWDEBUG_C0 * 32 + i / 64, col = 512 + RWDEBUG_H * 64 + (i % 64);
                const float a = __uint_as_float((unsigned)mix[((size_t)RWDEBUG_B * S + t) * D + col] << 16), r = __uint_as_float((unsigned)dbg[(size_t)t * D + col] << 16);
                if (!(fabsf(a) < 1e30f)) bad++;
                else { md = fmaxf(md, fabsf(a - r)); } mr = fmaxf(mr, fabsf(r));
            }
            LAS float* sh = (LAS float*)lds;
            sh[threadIdx.x] = md; sh[512 + threadIdx.x] = mr; sh[1024 + threadIdx.x] = (float)bad; __syncthreads();
            if (threadIdx.x == 0) { float a = 0.f, r = 0.f, nb = 0.f; for (int i = 0; i < NTHREADS; ++i) { a = fmaxf(a, sh[i]); r = fmaxf(r, sh[512 + i]); nb += sh[1024 + i]; }
                float rel = a / fmaxf(r, 1e-20f); float code = nb > 0.f ? 40.0f : (rel < 0.03f ? 5.0f : (rel < 0.3f ? 10.0f : 20.0f));
                red[0] = code; }
        }
        GSYNC();
        const float code = ((const float*)(p.ws + WS_CTL + 2048))[0];
        for (size_t i = (size_t)blockIdx.x * NTHREADS + threadIdx.x; i < (size_t)T * D; i += (size_t)gridDim.x * NTHREADS) p.out[i] = code;
        return;
    }
#endif
    if (PHASE_MASK & 8) phase3(p, lds); GSYNC(); TS(4);
    if (PHASE_MASK & 16) phase4(p, lds); GSYNC(); TS(5);
    if (PHASE_MASK & 32) phase5(p, lds); GSYNC(); TS(6);
    if (PHASE_MASK & 64) phase6(p, lds); GSYNC(); TS(7);
    if (PHASE_MASK & 128) phase7(p);
#ifdef TPROBE
    GSYNC(); TS(8);
    float* tw = (float*)(p.ws + WS_CTL + 1024);
    if (blockIdx.x == 0 && threadIdx.x == 0) { const float t1 = (float)(tsl[TPROBE + 1] - tsl[TPROBE]) * 0.01f; tw[0] = floorf(log2f(t1) * TPQ + 0.5f) / TPQ; }
    GSYNC();
    const float c1 = tw[0];
    int tq_ = threadIdx.x; asm volatile("" : "+v"(tq_));
    for (size_t i = (size_t)blockIdx.x * NTHREADS + tq_; i < (size_t)T * D; i += (size_t)gridDim.x * NTHREADS) p.out[i] = c1;
#endif
}

extern "C" void kernel_launch(void* const* d_in, const int* in_sizes, int n_in, void* d_out, int out_size, void* d_ws, size_t ws_size, hipStream_t stream) {
    static int grid = 0;
    if (grid == 0) {
        if (n_in != 25 || out_size != T * D || ws_size < WS_END) { fprintf(stderr, "kernel_launch: unexpected sizes n_in %d out %d ws %zu (need %zu)\n", n_in, out_size, ws_size, (size_t)WS_END); grid = -1; return; }
        int dev = 0, cus = 0, per_cu = 0;
        (void)hipGetDevice(&dev); (void)hipDeviceGetAttribute(&cus, hipDeviceAttributeMultiprocessorCount, dev);
        if (hipFuncSetAttribute((const void*)mega, hipFuncAttributeMaxDynamicSharedMemorySize, LDS_BYTES) != hipSuccess) { fprintf(stderr, "kernel_launch: hipFuncSetAttribute failed\n"); grid = -1; return; }
        if (hipOccupancyMaxActiveBlocksPerMultiprocessor(&per_cu, (const void*)mega, NTHREADS, LDS_BYTES) != hipSuccess || per_cu < 1) { fprintf(stderr, "kernel_launch: occupancy query failed (%d)\n", per_cu); (void)hipGetLastError(); per_cu = 1; }
        grid = cus * 1;
    }
    if (grid < 0) return;
    Params p{};
    const float** f = (const float**)&p;
    for (int i = 0; i < 25; ++i) f[i] = (const float*)d_in[i];
    p.out = (float*)d_out; p.ws = (unsigned char*)d_ws;
    if (hipMemsetAsync((char*)d_ws + WS_BAR, 0, XCD_BAR_WORDS * 4, stream) != hipSuccess) { fprintf(stderr, "kernel_launch: memset failed\n"); return; }
    hipLaunchKernelGGL(mega, dim3(grid), dim3(NTHREADS), LDS_BYTES, stream, p);
    hipError_t e = hipPeekAtLastError();
    if (e != hipSuccess) fprintf(stderr, "launch failed: %s (grid %d)\n", hipGetErrorString(e), grid);
}
```

```cpp
#include <hip/hip_runtime.h>
#include <cstdio>
#include <cstdint>
#define TPQ 8.0f

#define LAS __attribute__((address_space(3)))
typedef unsigned short bf16_t;
typedef short bf16x8 __attribute__((ext_vector_type(8)));
typedef short s16x4 __attribute__((ext_vector_type(4)));
typedef float f32x4 __attribute__((ext_vector_type(4)));
typedef float f32x2 __attribute__((ext_vector_type(2)));
typedef float f32x16 __attribute__((ext_vector_type(16)));
typedef unsigned u32x2 __attribute__((ext_vector_type(2)));
typedef unsigned u32x4 __attribute__((ext_vector_type(4)));

constexpr int NB = 16, S = 2048, T = NB * S, D = 1024, NIN = 3328, NH = 8, HD = 64;
constexpr int UQ = 0, UK = 512, UV = 1024, UR = 1536, URK = 2048, URV = 2560, UXW = 3072, UXA = 3136, UXG = 3200;
constexpr int NE = 32, DE = 256;
constexpr float LOG2E = 1.4426950408889634f, LN2 = 0.6931471805599453f;
constexpr float QSCALE = 0.125f * LOG2E;
constexpr int NTHREADS = 512, NWAVES = 8;
constexpr int LDS_BYTES = 161792 + 1024;

constexpr size_t WS_CTL   = 0;
constexpr size_t WS_BAR   = 8192;
constexpr size_t WS_WIN   = 65536;
constexpr size_t WS_WOUT  = WS_WIN  + (size_t)NIN * D * 2;
constexpr size_t WS_WGU   = WS_WOUT + (size_t)D * D * 2;
constexpr size_t WS_WDN   = WS_WGU  + (size_t)NE * 512 * D * 2;
constexpr size_t WS_RSTD1 = WS_WDN  + (size_t)NE * D * DE * 2;
constexpr size_t WS_RSTD2 = WS_RSTD1 + (size_t)T * 4;
constexpr size_t WS_LIST  = WS_RSTD2 + (size_t)T * 4;
constexpr size_t WS_LISTW = WS_LIST + (size_t)NE * T * 4;
constexpr size_t WS_WR    = WS_LISTW + (size_t)NE * T * 4;
constexpr size_t WS_LT    = WS_WR + (size_t)2 * 48 * D * 2;
constexpr size_t WS_A     = WS_LT + (size_t)512 * 256 * 2;
constexpr size_t WS_B     = WS_A + (size_t)T * NIN * 2;
constexpr size_t WS_END   = WS_B + (size_t)T * D * 2;
constexpr int HID_ROWS = 2 * T + NE * 256;

struct Params {
    const float* x; const float* norm_mix_g; const float* w_in; const float* shift_mu; const float* sb_out_g;
    const float* rw_w0; const float* rw_w2; const float* rw_a0; const float* rw_a2; const float* rw_g2;
    const float* rw_k_k; const float* rw_k_a; const float* rw_r_k; const float* rw_ln_w; const float* rw_ln_b;
    const float* w_out; const float* norm_ffn_g; const float* r_grp_w; const float* r_grp_b; const float* r_exp_w; const float* r_exp_b;
    const float* w_gate; const float* w_up; const float* w_down; const float* final_g;
    float* out; unsigned char* ws;
};

typedef __bf16 bf16x2_t __attribute__((ext_vector_type(2)));
__device__ __forceinline__ unsigned cvt_pk_bf16(float lo, float hi) { const f32x2 v = {lo, hi}; return __builtin_bit_cast(unsigned, __builtin_convertvector(v, bf16x2_t)); }
__device__ __forceinline__ float bf16_lo(unsigned w) { return __uint_as_float(w << 16); }
__device__ __forceinline__ float bf16_hi(unsigned w) { return __uint_as_float(w & 0xffff0000u); }
__device__ __forceinline__ float fexp2(float x) { return __builtin_amdgcn_exp2f(x); }
__device__ __forceinline__ float flog2(float x) { return __builtin_amdgcn_logf(x); }
__device__ __forceinline__ float frcp(float x) { return __builtin_amdgcn_rcpf(x); }
__device__ __forceinline__ float frsq(float x) { return __builtin_amdgcn_rsqf(x); }
template <int CTRL> __device__ __forceinline__ float dppf(float v) { return __builtin_bit_cast(float, __builtin_amdgcn_update_dpp(0, __builtin_bit_cast(int, v), CTRL, 0xF, 0xF, true)); }
__device__ __forceinline__ float rlane(float v, int l) { return __builtin_bit_cast(float, __builtin_amdgcn_readlane(__builtin_bit_cast(int, v), l)); }
__device__ __forceinline__ float sum8(float v) { v += dppf<0xB1>(v); v += dppf<0x4E>(v); v += dppf<0x141>(v); return v; }
__device__ __forceinline__ float sum16(float v) { v = sum8(v); v += dppf<0x140>(v); return v; }
__device__ __forceinline__ float wave_sum(float v) { v = sum16(v); return (rlane(v, 0) + rlane(v, 16)) + (rlane(v, 32) + rlane(v, 48)); }
__device__ __forceinline__ float swap32(float v) { return __shfl_xor(v, 32); }
#define LDS_WAIT() asm volatile("s_waitcnt lgkmcnt(0)" ::: "memory")


#define XB_TMO      128
#define XB_XCNT(j)  (256  + 64 * (j))
#define XB_XSUB(j)  (1280 + 64 * (j))
#define XB_XGEN(j)  (2304 + 64 * (j))
#define XB_TOP      3328
#define XB_TOPGEN   3392
#define XCD_BAR_WORDS 3456
#define XB_SPIN_CAP (1u << 22)
__device__ __forceinline__ unsigned xb_ld(unsigned* p)              { return __hip_atomic_load(p, __ATOMIC_RELAXED, __HIP_MEMORY_SCOPE_AGENT); }
__device__ __forceinline__ unsigned xb_add(unsigned* p, unsigned v) { return __hip_atomic_fetch_add(p, v, __ATOMIC_RELAXED, __HIP_MEMORY_SCOPE_AGENT); }
__device__ __forceinline__ unsigned xb_xcc_id() { return (unsigned)__builtin_amdgcn_s_getreg((3 << 11) | 20) & 0xFu; }
#define XB_SPIN(cond, bar) do { unsigned _sp = 0; while (cond) { __builtin_amdgcn_s_sleep(1); \
    if ((++_sp & 255u) == 0u) { if (xb_ld(&(bar)[XB_TMO])) break; if (_sp > XB_SPIN_CAP) { atomicAdd(&(bar)[XB_TMO], 1u); break; } } } } while (0)
struct XcdBarrier { unsigned* bar; unsigned x; volatile LAS unsigned* st; };
__device__ __forceinline__ XcdBarrier xcd_barrier_post(unsigned* bar, volatile LAS unsigned* st) {
    XcdBarrier b; b.bar = bar; b.x = xb_xcc_id(); b.st = st;
    if (threadIdx.x == 0) (void)xb_add(&bar[XB_XCNT(b.x)], 1u);
    return b;
}
__device__ __forceinline__ void xcd_barrier_complete(unsigned* bar, unsigned x, unsigned& nloc, unsigned& nx) {
    const unsigned G = gridDim.x * gridDim.y * gridDim.z;
    unsigned sum, cnt, mine, sp = 0u;
    for (;;) {
        sum = 0u; cnt = 0u; mine = 0u;
#pragma unroll
        for (unsigned j = 0; j < 16; ++j) { const unsigned c = xb_ld(&bar[XB_XCNT(j)]); sum += c; cnt += (c > 0u) ? 1u : 0u; mine = (j == x) ? c : mine; }
        if (sum == G) break;
        __builtin_amdgcn_s_sleep(1);
        if ((++sp & 255u) == 0u) { if (xb_ld(&bar[XB_TMO])) break; if (sp > XB_SPIN_CAP) { atomicAdd(&bar[XB_TMO], 1u); break; } }
    }
    nloc = mine > 0u ? mine : 1u; nx = cnt > 0u ? cnt : 1u;
}
__device__ __forceinline__ void xcd_barrier(const XcdBarrier& b) {
    asm volatile("s_waitcnt vmcnt(0)" ::: "memory");
    __syncthreads();
    if (threadIdx.x == 0) {
        unsigned* bar = b.bar;
        __builtin_amdgcn_s_waitcnt(0);
        unsigned nloc = b.st[0], nx = b.st[1];
        if (nloc == 0u) { xcd_barrier_complete(bar, b.x, nloc, nx); b.st[0] = nloc; b.st[1] = nx; }
        const unsigned old = xb_add(&bar[XB_XSUB(b.x)], 1u);
        const unsigned gen = old / nloc;
        if (old + 1u == (gen + 1u) * nloc) {
            __builtin_amdgcn_fence(__ATOMIC_RELEASE, "agent");
            asm volatile("s_waitcnt vmcnt(0)" ::: "memory");
            const unsigned og = xb_add(&bar[XB_TOP], 1u);
            const unsigned tg = og / nx;
            if (og + 1u == (tg + 1u) * nx) xb_add(&bar[XB_TOPGEN], 1u);
            else XB_SPIN(xb_ld(&bar[XB_TOPGEN]) == tg, bar);
            __builtin_amdgcn_fence(__ATOMIC_ACQUIRE, "agent");
            xb_add(&bar[XB_XGEN(b.x)], 1u);
            asm volatile("s_waitcnt vmcnt(0)" ::: "memory");
        } else {
            XB_SPIN(xb_ld(&bar[XB_XGEN(b.x)]) == gen, bar);
            __builtin_amdgcn_fence(__ATOMIC_ACQUIRE, "agent");
            asm volatile("s_waitcnt vmcnt(0)" ::: "memory");
        }
    }
    __syncthreads();
}

namespace g8 {
constexpr int BK = 64, HALF = 128, HTB = HALF * BK * 2;
__device__ __forceinline__ int lds_byte(int r, int c) { const int st = (r >> 4) * 2 + (c >> 5), rr = r & 15, cc = c & 31, ob = rr * 64 + cc * 2; return st * 1024 + (ob ^ (((ob >> 9) & 1) << 5)); }
__device__ __forceinline__ void stage_rc(int b, int& R, int& C) { const int st = b / 1024, sb = b % 1024, swz = sb ^ (((sb >> 9) & 1) << 5); R = (st >> 1) * 16 + swz / 64; C = (st & 1) * 32 + (swz % 64) / 2; }

#define G8_SA(b, h) (((b) * 2 + (h)) * HTB)
#define G8_SB(b, h) ((4 + (b) * 2 + (h)) * HTB)
#define G8_STAGE_A(bufoff, h, kt) do { _Pragma("unroll") for (int _i = 0; _i < 2; ++_i) \
    __builtin_amdgcn_global_load_lds((const unsigned*)((Ab + (size_t)(kt) * (BK * 2)) + aoff[h][_i]), (LAS unsigned*)(lds + (bufoff) + ldsw + _i * 8192), 16, 0, 0); } while (0)
#define G8_STAGE_B(bufoff, h, kt) do { _Pragma("unroll") for (int _i = 0; _i < 2; ++_i) \
    __builtin_amdgcn_global_load_lds((const unsigned*)((Bb + (size_t)(h) * bhalf + (size_t)(kt) * (BK * 2)) + boff[_i]), (LAS unsigned*)(lds + (bufoff) + ldsw + _i * 8192), 16, 0, 0); } while (0)
#define G8_LDA(dst, b, h) do { _Pragma("unroll") for (int m = 0; m < 4; ++m) _Pragma("unroll") for (int k = 0; k < 2; ++k) dst[m][k] = *(const LAS bf16x8*)(lds + G8_SA(b, h) + la_off + m * 2048 + k * 1024); } while (0)
#define G8_LDB(dst, b, h) do { _Pragma("unroll") for (int n = 0; n < 2; ++n) _Pragma("unroll") for (int k = 0; k < 2; ++k) dst[n][k] = *(const LAS bf16x8*)(lds + G8_SB(b, h) + lb_off + n * 2048 + k * 1024); } while (0)
#define G8_MMA(ai, bj, At, Bt) do { __builtin_amdgcn_s_setprio(1); _Pragma("unroll") for (int m = 0; m < 4; ++m) _Pragma("unroll") for (int n = 0; n < 2; ++n) _Pragma("unroll") for (int k = 0; k < 2; ++k) \
    acc[ai][bj][m][n] = __builtin_amdgcn_mfma_f32_16x16x32_bf16(Bt[n][k], At[m][k], acc[ai][bj][m][n], 0, 0, 0); __builtin_amdgcn_s_setprio(0); } while (0)
#define G8_WAIT_V(n) asm volatile("s_waitcnt vmcnt(" #n ")" ::: "memory")
#define G8_WAIT_L(n) asm volatile("s_waitcnt lgkmcnt(" #n ")" ::: "memory")
#define G8_BAR __builtin_amdgcn_s_barrier()
#define G8_SCHED __builtin_amdgcn_sched_barrier(0)

template <class Epi>
__device__ __forceinline__ void gemm_unit(LAS unsigned char* lds, const char* Ab, const unsigned (&aoff)[2][2], const char* Bb, int K, const Epi& E) {
    int tid = threadIdx.x; asm volatile("" : "+v"(tid));
    const int wid = __builtin_amdgcn_readfirstlane(tid >> 6), lane = tid & 63, wr = wid >> 2, wc = wid & 3, fr = lane & 15, fq = lane >> 4;
    const int nt = K / BK;
    unsigned boff[2];
#pragma unroll
    for (int i = 0; i < 2; ++i) { int R, C; stage_rc(tid * 16 + i * 8192, R, C); const int rho = R & 31, Rb = (R & ~31) + 8 * ((rho & 15) >> 2) + 4 * (rho >> 4) + (rho & 3);
        boff[i] = (unsigned)(Rb * K + C) * 2u; }
    const size_t bhalf = (size_t)HALF * K * 2;
    const unsigned ldsw = (unsigned)wid * 1024u;
    const int la_off = lds_byte(wr * 64 + fr, fq * 8), lb_off = lds_byte(wc * 32 + fr, fq * 8);
    f32x4 acc[2][2][4][2];
#pragma unroll
    for (int a = 0; a < 2; ++a)
#pragma unroll
        for (int b = 0; b < 2; ++b)
#pragma unroll
            for (int m = 0; m < 4; ++m)
#pragma unroll
                for (int n = 0; n < 2; ++n) acc[a][b][m][n] = (f32x4){0.f, 0.f, 0.f, 0.f};
    bf16x8 At[4][2], B0[2][2], B1[2][2];
    G8_STAGE_B(G8_SB(0, 0), 0, 0); G8_STAGE_A(G8_SA(0, 0), 0, 0);
    G8_STAGE_B(G8_SB(0, 1), 1, 0); G8_STAGE_A(G8_SA(0, 1), 1, 0);
    if (wr == 1) G8_BAR;
    G8_WAIT_V(4); G8_BAR;
    G8_STAGE_B(G8_SB(1, 0), 0, 1); G8_STAGE_A(G8_SA(1, 0), 0, 1); G8_STAGE_B(G8_SB(1, 1), 1, 1);
    G8_WAIT_V(6); G8_BAR;
    for (int t = 0; t < nt - 2; t += 2) {
        G8_LDB(B0, 0, 0); G8_SCHED; G8_LDA(At, 0, 0); G8_STAGE_A(G8_SA(1, 1), 1, t + 1);
        G8_WAIT_L(8); G8_BAR; G8_WAIT_L(0); G8_MMA(0, 0, At, B0); G8_BAR; G8_SCHED;
        G8_LDB(B1, 0, 1); G8_STAGE_B(G8_SB(0, 0), 0, t + 2);
        G8_BAR; G8_WAIT_L(0); G8_MMA(0, 1, At, B1); G8_BAR;
        G8_LDA(At, 0, 1); G8_STAGE_A(G8_SA(0, 0), 0, t + 2);
        G8_BAR; G8_WAIT_L(0); G8_MMA(1, 0, At, B0); G8_BAR; G8_SCHED;
        G8_STAGE_B(G8_SB(0, 1), 1, t + 2);
        G8_WAIT_V(6); G8_BAR; G8_MMA(1, 1, At, B1); G8_BAR;
        G8_LDB(B0, 1, 0); G8_SCHED; G8_LDA(At, 1, 0); G8_STAGE_A(G8_SA(0, 1), 1, t + 2);
        G8_WAIT_L(8); G8_BAR; G8_WAIT_L(0); G8_MMA(0, 0, At, B0); G8_BAR; G8_SCHED;
        G8_LDB(B1, 1, 1); G8_STAGE_B(G8_SB(1, 0), 0, t + 3);
        G8_BAR; G8_WAIT_L(0); G8_MMA(0, 1, At, B1); G8_BAR;
        G8_LDA(At, 1, 1); G8_STAGE_A(G8_SA(1, 0), 0, t + 3);
        G8_BAR; G8_WAIT_L(0); G8_MMA(1, 0, At, B0); G8_BAR; G8_SCHED;
        G8_STAGE_B(G8_SB(1, 1), 1, t + 3);
        G8_WAIT_V(6); G8_BAR; G8_MMA(1, 1, At, B1); G8_BAR;
    }
    { G8_LDB(B0, 0, 0); G8_LDA(At, 0, 0); G8_STAGE_A(G8_SA(1, 1), 1, nt - 1);
      G8_BAR; G8_WAIT_L(0); G8_MMA(0, 0, At, B0); G8_BAR;
      G8_LDB(B1, 0, 1); G8_BAR; G8_WAIT_L(0); G8_MMA(0, 1, At, B1); G8_BAR;
      G8_LDA(At, 0, 1); G8_WAIT_V(4); G8_BAR; G8_WAIT_L(0); G8_MMA(1, 0, At, B0); G8_MMA(1, 1, At, B1); G8_BAR; }
    { G8_LDB(B0, 1, 0); G8_LDA(At, 1, 0); G8_WAIT_V(2); G8_BAR; G8_WAIT_L(0); G8_MMA(0, 0, At, B0); G8_BAR;
      G8_LDB(B1, 1, 1); G8_WAIT_V(0); G8_BAR; G8_WAIT_L(0); G8_MMA(0, 1, At, B1); G8_BAR;
      G8_LDA(At, 1, 1); G8_BAR; G8_WAIT_L(0); G8_MMA(1, 0, At, B0); G8_MMA(1, 1, At, B1); G8_BAR; }
    if (wr == 0) G8_BAR;
    asm volatile("" ::: "memory");
    E(acc, wr, wc, fr, fq);
    __syncthreads();
}
__device__ __forceinline__ void aoff_rows(unsigned (&aoff)[2][2], int K) {
    int tid = threadIdx.x; asm volatile("" : "+v"(tid));
#pragma unroll
    for (int i = 0; i < 2; ++i) { int R, C; stage_rc(tid * 16 + i * 8192, R, C);
#pragma unroll
        for (int h = 0; h < 2; ++h) aoff[h][i] = (unsigned)((h * HALF + R) * K + C) * 2u; }
}
__device__ __forceinline__ void tile_order(int L, int nM, int nN, int& pm, int& pn) {
    const int nwg = nM * nN; int wgid = L;
    { const int q = nwg / 8, r = nwg % 8, xcd = wgid % 8, off = wgid / 8; wgid = (xcd < r ? xcd * (q + 1) : r * (q + 1) + (xcd - r) * q) + off; }
    const int nig = 8 * nN, gid = wgid / nig, fm = gid * 8, gsz = (nM - fm) < 8 ? (nM - fm) : 8;
    pm = fm + ((wgid % nig) % gsz); pn = (wgid % nig) / gsz;
}
}

__device__ __forceinline__ void p0_transpose_item(const float* W, int K, int N, int k0, int n0, bf16_t* WTrow0  , const float* kscale, float mul, LAS float* scr, int lane) {
#pragma unroll 8
    for (int i = 0; i < 32; ++i) { const int kk = 2 * i + (lane >> 5); float v = W[(size_t)(k0 + kk) * N + n0 + (lane & 31)]; if (kscale) v *= kscale[k0 + kk]; scr[kk * 33 + (lane & 31)] = v * mul; }
    LDS_WAIT();
    const int c = lane & 7;
#pragma unroll
    for (int j = 0; j < 4; ++j) { const int n = (lane >> 3) + 8 * j; const LAS float* s = scr + (8 * c) * 33 + n;
        u32x4 o; o.x = cvt_pk_bf16(s[0 * 33], s[1 * 33]); o.y = cvt_pk_bf16(s[2 * 33], s[3 * 33]); o.z = cvt_pk_bf16(s[4 * 33], s[5 * 33]); o.w = cvt_pk_bf16(s[6 * 33], s[7 * 33]);
        *(u32x4*)(WTrow0 + (size_t)n * K + k0 + 8 * c) = o; }
    LDS_WAIT();
}

__device__ __forceinline__ void p0_transpose64(const float* W, int K, int N, int k0, int n0, bf16_t* WTrow0  , const float* kscale, LAS float* scr, int lane) {
    const int rq = lane >> 4, c4 = 4 * (lane & 15);
    f32x4 v[16];
#pragma unroll
    for (int i = 0; i < 16; ++i) v[i] = *(const f32x4*)(W + (size_t)(k0 + 4 * i + rq) * N + n0 + c4);
    if (kscale) {
#pragma unroll
        for (int i = 0; i < 16; ++i) v[i] = v[i] * kscale[k0 + 4 * i + rq];
    }
#pragma unroll
    for (int i = 0; i < 16; ++i) { LAS float* d = scr + (4 * i + rq) * 65 + c4; d[0] = v[i][0]; d[1] = v[i][1]; d[2] = v[i][2]; d[3] = v[i][3]; }
    LDS_WAIT();
#pragma unroll
    for (int c = 0; c < 8; ++c) { const LAS float* sp = scr + (8 * c) * 65 + lane;
        u32x4 o; o.x = cvt_pk_bf16(sp[0], sp[65]); o.y = cvt_pk_bf16(sp[2 * 65], sp[3 * 65]); o.z = cvt_pk_bf16(sp[4 * 65], sp[5 * 65]); o.w = cvt_pk_bf16(sp[6 * 65], sp[7 * 65]);
        *(u32x4*)(WTrow0 + (size_t)lane * K + k0 + 8 * c) = o; }
    LDS_WAIT();
}
__device__ __forceinline__ void p0_expert_weights(const Params& p, LAS unsigned char* lds, int gw, int NGW) {
    int tid = threadIdx.x; asm volatile("" : "+v"(tid));
    const int wave = tid >> 6, lane = tid & 63;
    LAS float* scr = (LAS float*)(lds + wave * 16640);
    bf16_t* wgu = (bf16_t*)(p.ws + WS_WGU); bf16_t* wdn = (bf16_t*)(p.ws + WS_WDN);
    constexpr int I_G = NE * 16 * 4, I_D = NE * 4 * 16;
    for (int it = gw; it < 2 * I_G + I_D; it += NGW) {
        int r = it;
        if (r < 2 * I_G) { const int up = r >= I_G; if (up) r -= I_G; const int e = r / 64, q = r % 64, kb = q / 4, nb = q % 4, n0 = nb * 64;
            const int drow = (n0 >> 7) * 256 + up * 128 + (n0 & 127);
            p0_transpose64((up ? p.w_up : p.w_gate) + (size_t)e * D * DE, D, DE, kb * 64, n0, wgu + ((size_t)e * 512 + drow) * D, p.norm_ffn_g, scr, lane); continue; } r -= 2 * I_G;
        { const int e = r / 64, q = r % 64, kb = q / 16, nb = q % 16, n0 = nb * 64;
            p0_transpose64(p.w_down + (size_t)e * DE * D, DE, D, kb * 64, n0, wdn + ((size_t)e * D + n0) * DE, nullptr, scr, lane); }
    }
}
__device__ __forceinline__ void phase0(const Params& p, LAS unsigned char* lds) {
    int tid = threadIdx.x; asm volatile("" : "+v"(tid));
    const int wave = tid >> 6, lane = tid & 63;
    const int gw = blockIdx.x * NWAVES + wave, NGW = gridDim.x * NWAVES;
    LAS float* scr = (LAS float*)(lds + wave * 8704);
    bf16_t* win = (bf16_t*)(p.ws + WS_WIN); bf16_t* wout = (bf16_t*)(p.ws + WS_WOUT);
    constexpr int I_IN = 16 * 104, I_OUT = 16 * 32;
    for (int it = gw; it < I_IN + I_OUT; it += NGW) {
        int r = it;
        if (r < I_IN) { const int kb = r / 104, nb = r % 104, n0 = nb * 32; p0_transpose_item(p.w_in, D, NIN, kb * 64, n0, win + (size_t)n0 * D, p.norm_mix_g, n0 < 512 ? QSCALE : 1.f, scr, lane); continue; } r -= I_IN;
        { const int kb = r / 32, nb = r % 32, n0 = nb * 32; p0_transpose_item(p.w_out, D, D, kb * 64, n0, wout + (size_t)n0 * D, nullptr, 1.f, scr, lane); }
    }
    bf16_t* xb = (bf16_t*)(p.ws + WS_B); float* rstd1 = (float*)(p.ws + WS_RSTD1);
    {
        f32x4 nv[4];
        if (gw < T) {
#pragma unroll
            for (int j = 0; j < 4; ++j) nv[j] = ((const f32x4*)(p.x + (size_t)gw * D) + lane)[64 * j];
        }
        for (int row = gw; row < T; row += NGW) {
            f32x4 v[4]; float s = 0.f;
#pragma unroll
            for (int j = 0; j < 4; ++j) { v[j] = nv[j]; s += (v[j].x * v[j].x + v[j].y * v[j].y) + (v[j].z * v[j].z + v[j].w * v[j].w); }
            if (row + NGW < T) {
#pragma unroll
                for (int j = 0; j < 4; ++j) nv[j] = ((const f32x4*)(p.x + (size_t)(row + NGW) * D) + lane)[64 * j];
            }
            s = wave_sum(s);
            u32x2* o = (u32x2*)(xb + (size_t)row * D) + lane;
#pragma unroll
            for (int j = 0; j < 4; ++j) { u32x2 w; w.x = cvt_pk_bf16(v[j].x, v[j].y); w.y = cvt_pk_bf16(v[j].z, v[j].w); o[64 * j] = w; }
            if (lane == 0) rstd1[row] = 1.0f / sqrtf(s * (1.0f / D) + 1e-6f);
        }
    }
    bf16_t* wr_hi = (bf16_t*)(p.ws + WS_WR); bf16_t* wr_lo = wr_hi + 48 * D;
    for (int i = blockIdx.x * NTHREADS + tid; i < 48 * D; i += gridDim.x * NTHREADS) {
        const int c = i / D, k = i % D; float w = 0.f;
        if (c < 4) w = p.r_grp_w[k * 4 + c]; else if (c < 36) w = p.r_exp_w[k * 32 + (c - 4)];
        w *= p.norm_ffn_g[k];
        const unsigned hi = cvt_pk_bf16(w, 0.f) & 0xffffu; const float rem = w - __uint_as_float(hi << 16);
        wr_hi[i] = (bf16_t)hi; wr_lo[i] = (bf16_t)(cvt_pk_bf16(rem, 0.f) & 0xffffu);
    }
    { bf16_t* w2t = (bf16_t*)(p.ws + WS_LT); bf16_t* a2t = w2t + 512 * 64; bf16_t* g2t = a2t + 512 * 64;
      for (int i = blockIdx.x * NTHREADS + tid; i < 512 * 256; i += gridDim.x * NTHREADS) {
          if (i < 512 * 64) { const int c = i >> 6, m = i & 63; w2t[i] = (bf16_t)(cvt_pk_bf16(p.rw_w2[m * 512 + c], 0.f) & 0xffffu); }
          else if (i < 2 * 512 * 64) { const int q = i - 512 * 64, c = q >> 6, m = q & 63; a2t[q] = (bf16_t)(cvt_pk_bf16(p.rw_a2[m * 512 + c], 0.f) & 0xffffu); }
          else { const int q = i - 2 * 512 * 64, c = q >> 7, m = q & 127; g2t[q] = (bf16_t)(cvt_pk_bf16(p.rw_g2[m * 512 + c], 0.f) & 0xffffu); } } }
    if (blockIdx.x == 0 && tid < 64) ((unsigned*)(p.ws + WS_CTL))[tid] = 0u;
}

struct EpiU {
    bf16_t* u; const float* rstd; int row0, col0;
    __device__ __forceinline__ void operator()(const f32x4 (&acc)[2][2][4][2], int wr, int wc, int fr, int fq) const {
#pragma unroll
        for (int ai = 0; ai < 2; ++ai)
#pragma unroll
            for (int m = 0; m < 4; ++m) { const int row = row0 + ai * 128 + wr * 64 + m * 16 + fr; const float rs = rstd[row]; bf16_t* rp = u + (size_t)row * NIN + col0 + wc * 32 + 8 * fq;
#pragma unroll
                for (int bj = 0; bj < 2; ++bj) { const f32x4 v0 = acc[ai][bj][m][0] * rs, v1 = acc[ai][bj][m][1] * rs;
                    *(u32x4*)(rp + bj * 128) = (u32x4){cvt_pk_bf16(v0[0], v0[1]), cvt_pk_bf16(v0[2], v0[3]), cvt_pk_bf16(v1[0], v1[1]), cvt_pk_bf16(v1[2], v1[3])}; } }
    }
};
__device__ __forceinline__ void phase1(const Params& p, LAS unsigned char* lds) {
    constexpr int nM = T / 256, nN = NIN / 256;
    unsigned aoff[2][2]; g8::aoff_rows(aoff, D);
    for (int L = blockIdx.x; L < nM * nN; L += gridDim.x) {
        int pm, pn; g8::tile_order(L, nM, nN, pm, pn);
        EpiU E{(bf16_t*)(p.ws + WS_A), (const float*)(p.ws + WS_RSTD1), pm * 256, pn * 256};
        g8::gemm_unit(lds, (const char*)(p.ws + WS_B) + (size_t)pm * 256 * D * 2, aoff, (const char*)(p.ws + WS_WIN) + (size_t)pn * 256 * D * 2, D, E);
    }
}


typedef short v4i16_t __attribute__((ext_vector_type(4)));
__device__ __forceinline__ s16x4 lds_tr16(const LAS unsigned char* p) { return __builtin_bit_cast(s16x4, __builtin_amdgcn_ds_read_tr16_b64_v4i16((LAS v4i16_t*)p)); }

__device__ __forceinline__ void attn_tile(const Params& p, LAS unsigned char* vl  , int b, int h, int qt) {
    const int lane = threadIdx.x & 63, r32 = lane & 31, hi = lane >> 5;
    const bf16_t* u = (const bf16_t*)(p.ws + WS_A);
    const size_t row0 = (size_t)b * S; const int q0 = qt * 32;
    bf16x8 qf[4];
    { const bf16_t* qp = u + (row0 + q0 + r32) * NIN + UQ + h * HD + 8 * hi;
#pragma unroll
      for (int s = 0; s < 4; ++s) qf[s] = *(const bf16x8*)(qp + 16 * s); }
    f32x16 o0, o1;
#pragma unroll
    for (int i = 0; i < 16; ++i) { o0[i] = 0.f; o1[i] = 0.f; }
    float carry = 0.f;
    const int kperm = 16 * ((r32 >> 2) & 1) + (r32 & 3) + 4 * (r32 >> 3);
    const int g = lane >> 4, i16 = lane & 15, tq = i16 >> 2, tp = i16 & 3;
    const LAS unsigned char* vrd = vl + (16 * (g >> 1) + tq) * 144 + (16 * (g & 1) + 4 * tp) * 2;
    LAS unsigned char* kl = vl + 4608;
    const int lrow = lane >> 3, lchk = lane & 7;
    const bf16_t* kvp = u + (row0 + lrow) * NIN + h * HD + lchk * 8;
    u32x4 kreg[4], vreg[4];
#pragma unroll
    for (int i = 0; i < 4; ++i) { const bf16_t* a = kvp + (size_t)(qt * 32 + 8 * i) * NIN; kreg[i] = *(const u32x4*)(a + UK); vreg[i] = *(const u32x4*)(a + UV); }
    for (int kb = qt; kb >= 0; --kb) {
        const int key0 = kb * 32;
#pragma unroll
        for (int i = 0; i < 4; ++i) { *(LAS u32x4*)(kl + (8 * i + lrow) * 144 + lchk * 16) = kreg[i]; *(LAS u32x4*)(vl + (8 * i + lrow) * 144 + lchk * 16) = vreg[i]; }
        if (kb > 0) {
#pragma unroll
            for (int i = 0; i < 4; ++i) { const bf16_t* a = kvp + (size_t)(key0 - 32 + 8 * i) * NIN; kreg[i] = *(const u32x4*)(a + UK); vreg[i] = *(const u32x4*)(a + UV); }
        }
        LDS_WAIT();
        f32x16 st;
#pragma unroll
        for (int i = 0; i < 16; ++i) st[i] = 0.f;
        { const LAS unsigned char* kp = kl + kperm * 144 + 16 * hi;
          bf16x8 kf[4];
#pragma unroll
          for (int s = 0; s < 4; ++s) kf[s] = *(const LAS bf16x8*)(kp + 32 * s);
#pragma unroll
          for (int s = 0; s < 4; ++s) st = __builtin_amdgcn_mfma_f32_32x32x16_bf16(kf[s], qf[s], st, 0, 0, 0); }
        const bool diag = (kb == qt);
        float lw[16], suf[16];
        float run = 0.f;
#pragma unroll
        for (int reg = 15; reg >= 0; --reg) {
            const float z = st[reg];
            const float l = flog2(1.0f + fexp2(-fabsf(z)));
            const float sp = fmaxf(z, 0.f) + l;
            const bool valid = !diag || (16 * hi + reg < r32);
            lw[reg] = valid ? (z - sp) : -1.0e30f;
            suf[reg] = run;
            run += valid ? -sp : 0.f;
        }
        const float other = swap32(run);
        const float tot_hi = hi ? run : other, tot_lo = hi ? other : run;
        const float base = carry + (hi ? 0.f : tot_hi);
        carry += tot_lo + tot_hi;
        unsigned pk[8];
#pragma unroll
        for (int j = 0; j < 8; ++j) pk[j] = cvt_pk_bf16(fexp2(lw[2 * j] + suf[2 * j] + base), fexp2(lw[2 * j + 1] + suf[2 * j + 1] + base));
        LDS_WAIT();
#pragma unroll
        for (int s2 = 0; s2 < 2; ++s2) {
            bf16x8 pf = __builtin_bit_cast(bf16x8, (u32x4){pk[4 * s2], pk[4 * s2 + 1], pk[4 * s2 + 2], pk[4 * s2 + 3]});
#pragma unroll
            for (int dh = 0; dh < 2; ++dh) {
                const s16x4 a = lds_tr16(vrd + (8 * s2) * 144 + 64 * dh), c = lds_tr16(vrd + (8 * s2 + 4) * 144 + 64 * dh);
                bf16x8 vf; vf[0] = a[0]; vf[1] = a[1]; vf[2] = a[2]; vf[3] = a[3]; vf[4] = c[0]; vf[5] = c[1]; vf[6] = c[2]; vf[7] = c[3];
                if (dh == 0) o0 = __builtin_amdgcn_mfma_f32_32x32x16_bf16(vf, pf, o0, 0, 0, 0); else o1 = __builtin_amdgcn_mfma_f32_32x32x16_bf16(vf, pf, o1, 0, 0, 0);
            }
        }
        LDS_WAIT();
        if (__builtin_amdgcn_ballot_w64(carry > -150.0f) == 0ull) break;
    }
    float ss = 0.f;
#pragma unroll
    for (int i = 0; i < 16; ++i) ss += o0[i] * o0[i] + o1[i] * o1[i];
    ss += swap32(ss);
    const float rs = 1.0f / sqrtf(ss * (1.0f / HD) + 1e-6f);
    bf16_t* op = (bf16_t*)(p.ws + WS_B) + (row0 + q0 + r32) * D + h * HD + 4 * hi;
    const float* gp = p.sb_out_g + h * HD + 4 * hi;
#pragma unroll
    for (int dh = 0; dh < 2; ++dh)
#pragma unroll
        for (int gq = 0; gq < 4; ++gq) {
            const f32x4 gg = *(const f32x4*)(gp + 32 * dh + 8 * gq);
            const f32x16& o = dh ? o1 : o0;
            u32x2 w; w.x = cvt_pk_bf16(o[4 * gq] * rs * gg[0], o[4 * gq + 1] * rs * gg[1]); w.y = cvt_pk_bf16(o[4 * gq + 2] * rs * gg[2], o[4 * gq + 3] * rs * gg[3]);
            *(u32x2*)(op + 32 * dh + 8 * gq) = w;
        }
}

constexpr size_t ACT_OFF = (size_t)64 << 20;
namespace rk {
constexpr int C = 32, NCH = S / C, NSLOT = 16;
constexpr int SL_PS = 0, SL_QS = 8192, SL_PO = 12288, SL_QO = 16384, SL_VR = 18432, SL_GB = 22528, SL_GW = 26624, SLOT_BYTES = 30720;
constexpr int MSTR = 144;
constexpr int PM_AT = 0, PM_RT = 4608, PM_BT = 9216, PM_KT = 13824, PM_GC = 18432, PROD_LDS = 18688;
constexpr int NPROD = 6;
constexpr int L_CONS = NPROD * PROD_LDS;
constexpr int OSTR = 272;
constexpr int L_OBUF = L_CONS + 4608;
constexpr int L_FLAG = L_OBUF + 32 * OSTR;
constexpr int L_W2 = L_FLAG + 256;
constexpr int L_A2 = L_W2 + 8192;
constexpr int L_G2 = L_A2 + 8192;
constexpr int L_CST = L_G2 + 16384;
constexpr int C_MUL = 0, C_MUR = 256, C_MUK = 320, C_MUV = 384, C_W0 = 448, C_A0 = 512, C_KK = 576, C_KA = 640, C_RK = 704, C_LNB = 768, C_END = 832;
static_assert(L_CST + C_END * 4 <= 161792, "rwkv LDS layout overflows");
}
__device__ __forceinline__ bf16x8 accfrag(const f32x16& a, int s) {
    return __builtin_bit_cast(bf16x8, (u32x4){cvt_pk_bf16(a[8 * s], a[8 * s + 1]), cvt_pk_bf16(a[8 * s + 2], a[8 * s + 3]), cvt_pk_bf16(a[8 * s + 4], a[8 * s + 5]), cvt_pk_bf16(a[8 * s + 6], a[8 * s + 7])});
}
__device__ __forceinline__ bf16x8 trfrag(const LAS unsigned char* mat, int s, int nt, int lane) {
    const int g = lane >> 4, i16 = lane & 15, q = i16 >> 2, pp = i16 & 3, h = g >> 1;
    const LAS unsigned char* a = mat + (16 * s + 4 * h + q) * rk::MSTR + (32 * nt + 16 * (g & 1) + 4 * pp) * 2;
    const s16x4 x = lds_tr16(a), y = lds_tr16(a + 8 * rk::MSTR);
    bf16x8 r; r[0] = x[0]; r[1] = x[1]; r[2] = x[2]; r[3] = x[3]; r[4] = y[0]; r[5] = y[1]; r[6] = y[2]; r[7] = y[3]; return r;
}
__device__ __forceinline__ void f8_from_bf16(const u32x4 w, float (&o)[8]) {
#pragma unroll
    for (int j = 0; j < 4; ++j) { o[2 * j] = bf16_lo(w[j]); o[2 * j + 1] = bf16_hi(w[j]); }
}
__device__ __forceinline__ f32x16 mfma32(bf16x8 a, bf16x8 b, f32x16 c) { return __builtin_amdgcn_mfma_f32_32x32x16_bf16(a, b, c, 0, 0, 0); }
__device__ __forceinline__ f32x16 zero16() { f32x16 z; for (int i = 0; i < 16; ++i) z[i] = 0.f; return z; }
__device__ __forceinline__ void um8(const bf16_t* urow  , bool has_prev, const float* mu, float (&o)[8]) {
    const u32x4 c = *(const u32x4*)urow; u32x4 pv = (u32x4){0u, 0u, 0u, 0u}; if (has_prev) pv = *(const u32x4*)(urow - NIN);
    const f32x4 m0 = *(const f32x4*)mu, m1 = *(const f32x4*)(mu + 4);
    float cv[8], pf[8]; f8_from_bf16(c, cv); f8_from_bf16(pv, pf);
#pragma unroll
    for (int j = 0; j < 4; ++j) { o[j] = cv[j] + (pf[j] - cv[j]) * m0[j]; o[4 + j] = cv[4 + j] + (pf[4 + j] - cv[4 + j]) * m1[j]; }
}
__device__ __forceinline__ void lerp8(const u32x4 c, const u32x4 pv, const LAS float* mu, float (&o)[8]) {
    const f32x4 m0 = *(const LAS f32x4*)mu, m1 = *(const LAS f32x4*)(mu + 4);
    float cv[8], pf[8]; f8_from_bf16(c, cv); f8_from_bf16(pv, pf);
#pragma unroll
    for (int j = 0; j < 4; ++j) { o[j] = cv[j] + (pf[j] - cv[j]) * m0[j]; o[4 + j] = cv[4 + j] + (pf[4 + j] - cv[4 + j]) * m1[j]; }
}
__device__ __forceinline__ void lerp8(const u32x4 c, const u32x4 pv, const float* mu, float (&o)[8]) {
    const f32x4 m0 = *(const f32x4*)mu, m1 = *(const f32x4*)(mu + 4);
    float cv[8], pf[8]; f8_from_bf16(c, cv); f8_from_bf16(pv, pf);
#pragma unroll
    for (int j = 0; j < 4; ++j) { o[j] = cv[j] + (pf[j] - cv[j]) * m0[j]; o[4 + j] = cv[4 + j] + (pf[4 + j] - cv[4 + j]) * m1[j]; }
}
__device__ __forceinline__ float scan32(float x) {
    x += dppf<0x111>(x); x += dppf<0x112>(x); x += dppf<0x114>(x); x += dppf<0x118>(x);
    const float bc = __builtin_bit_cast(float, __builtin_amdgcn_update_dpp(0, __builtin_bit_cast(int, x), 0x142, 0xA, 0xF, false));
    return x + bc;
}

__device__ __forceinline__ void rk_produce(const Params& p, LAS unsigned char* lds, LAS unsigned char* pl  , unsigned char* slot, int b, int hh, int c) {
    using namespace rk;
    int lane = threadIdx.x & 63; asm volatile("" : "+v"(lane));
    const int r32 = lane & 31, h = lane >> 5;
    const bf16_t* u = (const bf16_t*)(p.ws + WS_A);
    const size_t row0 = (size_t)b * S; const int t0 = c * C; const int tt = t0 + r32; const bool hp = tt > 0;
    const bf16_t* urow = u + (row0 + tt) * NIN;
    const LAS float* cst = (const LAS float*)(lds + L_CST);
    const int jrow0 = 32 * ((r32 >> 2) & 1) + (r32 & 3) + 4 * (r32 >> 3);
    f32x16 lw[2], la[2], lg[2];
#pragma unroll
    for (int mt = 0; mt < 2; ++mt) { lw[mt] = zero16(); la[mt] = zero16(); lg[mt] = zero16(); }
    const int cb = hh * HD + 32 * h;
    u32x4 ck[4], pk4[4], cr[4], pr4[4];
    {
        const bf16_t* act = (const bf16_t*)((const unsigned char*)p.out + ACT_OFF) + (row0 + tt) * 256 + 8 * h;
        u32x4 bw[4], ba[4], bg[8];
#pragma unroll
        for (int s = 0; s < 4; ++s) { bw[s] = *(const u32x4*)(act + 16 * s); ba[s] = *(const u32x4*)(act + 64 + 16 * s); }
#pragma unroll
        for (int s = 0; s < 8; ++s) bg[s] = *(const u32x4*)(act + 128 + 16 * s);
        {
            bf16x8 fw[2][4];
#pragma unroll
            for (int mt = 0; mt < 2; ++mt)
#pragma unroll
                for (int s = 0; s < 4; ++s) { const int jl = jrow0 + 16 * mt; fw[mt][s] = *(const LAS bf16x8*)(lds + L_W2 + jl * 128 + (((2 * s + h) ^ (jl & 7)) << 4)); }
#pragma unroll
            for (int s = 0; s < 4; ++s)
#pragma unroll
                for (int mt = 0; mt < 2; ++mt) lw[mt] = mfma32(fw[mt][s], __builtin_bit_cast(bf16x8, bw[s]), lw[mt]);
        }
        {
            bf16x8 fa[2][4];
#pragma unroll
            for (int mt = 0; mt < 2; ++mt)
#pragma unroll
                for (int s = 0; s < 4; ++s) { const int jl = jrow0 + 16 * mt; fa[mt][s] = *(const LAS bf16x8*)(lds + L_A2 + jl * 128 + (((2 * s + h) ^ (jl & 7)) << 4)); }
#pragma unroll
            for (int s = 0; s < 4; ++s)
#pragma unroll
                for (int mt = 0; mt < 2; ++mt) la[mt] = mfma32(fa[mt][s], __builtin_bit_cast(bf16x8, ba[s]), la[mt]);
        }
        asm volatile("" ::: "memory");
#pragma unroll
        for (int half = 0; half < 2; ++half) {
            bf16x8 fg[2][4];
#pragma unroll
            for (int mt = 0; mt < 2; ++mt)
#pragma unroll
                for (int s4 = 0; s4 < 4; ++s4) { const int s = 4 * half + s4, jl = jrow0 + 16 * mt; fg[mt][s4] = *(const LAS bf16x8*)(lds + L_G2 + jl * 256 + (((2 * s + h) ^ (jl & 7)) << 4)); }
#pragma unroll
            for (int s4 = 0; s4 < 4; ++s4)
#pragma unroll
                for (int mt = 0; mt < 2; ++mt) lg[mt] = mfma32(fg[mt][s4], __builtin_bit_cast(bf16x8, bg[4 * half + s4]), lg[mt]);
        }
        asm volatile("" ::: "memory");
#pragma unroll
        for (int q = 0; q < 4; ++q) { const bf16_t* a = urow + URK + cb + 8 * q; const bf16_t* bq = urow + UR + cb + 8 * q;
            ck[q] = *(const u32x4*)a; cr[q] = *(const u32x4*)bq; pk4[q] = (u32x4){0u, 0u, 0u, 0u}; pr4[q] = pk4[q];
            if (hp) { pk4[q] = *(const u32x4*)(a - NIN); pr4[q] = *(const u32x4*)(bq - NIN); } }
    }
#pragma unroll
    for (int mt = 0; mt < 2; ++mt) {
        u32x4 w0, w1; w0.x = cvt_pk_bf16(lg[mt][0], lg[mt][1]); w0.y = cvt_pk_bf16(lg[mt][2], lg[mt][3]); w0.z = cvt_pk_bf16(lg[mt][4], lg[mt][5]); w0.w = cvt_pk_bf16(lg[mt][6], lg[mt][7]);
        w1.x = cvt_pk_bf16(lg[mt][8], lg[mt][9]); w1.y = cvt_pk_bf16(lg[mt][10], lg[mt][11]); w1.z = cvt_pk_bf16(lg[mt][12], lg[mt][13]); w1.w = cvt_pk_bf16(lg[mt][14], lg[mt][15]);
        *(u32x4*)(slot + SL_GW + (2 * mt) * 1024 + lane * 16) = w0; *(u32x4*)(slot + SL_GW + (2 * mt + 1) * 1024 + lane * 16) = w1;
    }
    asm volatile("" ::: "memory");
    float ssq = 0.f;
#pragma unroll
    for (int q = 0; q < 4; ++q) {
        float t8[8]; lerp8(ck[q], pk4[q], cst + C_MUK + 32 * h + 8 * q, t8);
        const f32x4 c0 = *(const LAS f32x4*)(cst + C_KK + 32 * h + 8 * q), c1 = *(const LAS f32x4*)(cst + C_KK + 32 * h + 8 * q + 4);
#pragma unroll
        for (int j = 0; j < 4; ++j) { const float x0 = t8[j] * c0[j], x1 = t8[4 + j] * c1[j]; ssq += x0 * x0 + x1 * x1; }
    }
    ssq += swap32(ssq);
    const float kinv = frsq(fmaxf(ssq, 1e-24f));
    float bonus = 0.f;
    LAS unsigned char* mAT = pl + PM_AT; LAS unsigned char* mRT = pl + PM_RT; LAS unsigned char* mBT = pl + PM_BT; LAS unsigned char* mKT = pl + PM_KT;
    LAS float* gc = (LAS float*)(pl + PM_GC);
#pragma unroll
    for (int mt = 0; mt < 2; ++mt) {
#pragma unroll
        for (int q8 = 0; q8 < 2; ++q8) {
            const int jl0 = 32 * h + 16 * mt + 8 * q8, q = 2 * mt + q8;
            float k8[8], r8[8];
            lerp8(ck[q], pk4[q], cst + C_MUK + jl0, k8);
            lerp8(cr[q], pr4[q], cst + C_MUR + jl0, r8);
            float cw0[8], ca0[8], ckk[8], cka[8], crk[8];
#pragma unroll
            for (int e = 0; e < 2; ++e) { const f32x4 a = *(const LAS f32x4*)(cst + C_W0 + jl0 + 4 * e), bq = *(const LAS f32x4*)(cst + C_A0 + jl0 + 4 * e), cc = *(const LAS f32x4*)(cst + C_KK + jl0 + 4 * e), dd = *(const LAS f32x4*)(cst + C_KA + jl0 + 4 * e), ee = *(const LAS f32x4*)(cst + C_RK + jl0 + 4 * e);
#pragma unroll
                for (int j = 0; j < 4; ++j) { cw0[4 * e + j] = a[j]; ca0[4 * e + j] = bq[j]; ckk[4 * e + j] = cc[j]; cka[4 * e + j] = dd[j]; crk[4 * e + j] = ee[j]; } }
            float oa[8], orr[8], ob[8], ok[8];
#pragma unroll
            for (int e = 0; e < 8; ++e) {
                const int reg = 8 * q8 + e;
                const float xw = cw0[e] + lw[mt][reg];
                const float spn = fmaxf(-xw, 0.f) + LN2 * flog2(1.0f + fexp2(-fabsf(xw) * LOG2E));
                const float ld = -fexp2((-spn - 0.5f) * LOG2E);
                const float al = frcp(1.0f + fexp2(-(ca0[e] + la[mt][reg]) * LOG2E));
                const float kk = k8[e] * ckk[e] * kinv;
                const float kmod = k8[e] * (1.0f + (al - 1.0f) * cka[e]);
                const float bb = kk * al;
                bonus += r8[e] * kmod * crk[e];
                const float G = scan32(ld);
                const float eG = fexp2(G * LOG2E), eGm = fexp2((G - ld) * LOG2E), eiG = fexp2(-G * LOG2E);
                oa[e] = -kk * eGm; orr[e] = r8[e] * eG; ob[e] = bb * eiG; ok[e] = kmod * eiG;
                if (r32 == 31) gc[32 * h + 16 * mt + reg] = eG;
            }
            const int off = r32 * MSTR + (32 * h + 16 * mt + 8 * q8) * 2;
            *(LAS u32x4*)(mAT + off) = (u32x4){cvt_pk_bf16(oa[0], oa[1]), cvt_pk_bf16(oa[2], oa[3]), cvt_pk_bf16(oa[4], oa[5]), cvt_pk_bf16(oa[6], oa[7])};
            *(LAS u32x4*)(mRT + off) = (u32x4){cvt_pk_bf16(orr[0], orr[1]), cvt_pk_bf16(orr[2], orr[3]), cvt_pk_bf16(orr[4], orr[5]), cvt_pk_bf16(orr[6], orr[7])};
            *(LAS u32x4*)(mBT + off) = (u32x4){cvt_pk_bf16(ob[0], ob[1]), cvt_pk_bf16(ob[2], ob[3]), cvt_pk_bf16(ob[4], ob[5]), cvt_pk_bf16(ob[6], ob[7])};
            *(LAS u32x4*)(mKT + off) = (u32x4){cvt_pk_bf16(ok[0], ok[1]), cvt_pk_bf16(ok[2], ok[3]), cvt_pk_bf16(ok[4], ok[5]), cvt_pk_bf16(ok[6], ok[7])};
            asm volatile("" ::: "memory");
        }
    }
    bonus += swap32(bonus);
    u32x4 cv4[4], pv4[4];
#pragma unroll
    for (int q = 0; q < 4; ++q) { const bf16_t* cq = urow + URV + cb + 8 * q; cv4[q] = *(const u32x4*)cq; pv4[q] = (u32x4){0u, 0u, 0u, 0u}; if (hp) pv4[q] = *(const u32x4*)(cq - NIN); }
#pragma unroll
    for (int q = 0; q < 4; ++q) {
        float v8[8]; lerp8(cv4[q], pv4[q], cst + C_MUV + 32 * h + 8 * q, v8);
        *(u32x4*)(slot + SL_VR + q * 1024 + lane * 16) = (u32x4){cvt_pk_bf16(v8[0], v8[1]), cvt_pk_bf16(v8[2], v8[3]), cvt_pk_bf16(v8[4], v8[5]), cvt_pk_bf16(v8[6], v8[7])};
        const f32x4 b0 = *(const LAS f32x4*)(cst + C_LNB + 32 * h + 8 * q), b1 = *(const LAS f32x4*)(cst + C_LNB + 32 * h + 8 * q + 4);
        float gb[8];
#pragma unroll
        for (int e = 0; e < 8; ++e) gb[e] = (e < 4 ? b0[e] : b1[e - 4]) + bonus * v8[e];
        *(u32x4*)(slot + SL_GB + q * 1024 + lane * 16) = (u32x4){cvt_pk_bf16(gb[0], gb[1]), cvt_pk_bf16(gb[2], gb[3]), cvt_pk_bf16(gb[4], gb[5]), cvt_pk_bf16(gb[6], gb[7])};
    }
    LDS_WAIT();
    f32x16 nab = zero16(), nabT = zero16(), nakT = zero16(), mbr = zero16(), mkr = zero16();
#pragma unroll
    for (int s = 0; s < 4; ++s) {
        const int off = r32 * MSTR + (16 * s + 8 * h) * 2;
        const bf16x8 fa = *(const LAS bf16x8*)(mAT + off), fr = *(const LAS bf16x8*)(mRT + off), fb = *(const LAS bf16x8*)(mBT + off), fk = *(const LAS bf16x8*)(mKT + off);
        nab = mfma32(fb, fa, nab); nabT = mfma32(fa, fb, nabT); nakT = mfma32(fa, fk, nakT); mbr = mfma32(fb, fr, mbr); mkr = mfma32(fk, fr, mkr);
    }
#pragma unroll
    for (int reg = 0; reg < 16; ++reg) {
        const int row = (reg & 3) + 8 * (reg >> 2) + 4 * h;
        nab[reg] = row < r32 ? nab[reg] : 0.f;
        nabT[reg] = r32 < row ? nabT[reg] : 0.f;
        nakT[reg] = r32 < row ? nakT[reg] : 0.f;
        mbr[reg] = row <= r32 ? mbr[reg] : 0.f;
        mkr[reg] = row <= r32 ? mkr[reg] : 0.f;
    }
    f32x16 Y = nab;
#pragma unroll
    for (int reg = 0; reg < 16; ++reg) { const int row = (reg & 3) + 8 * (reg >> 2) + 4 * h; if (row == r32) Y[reg] += 1.0f; }
    {
        f32x16 M = nab, MT = nabT;
#pragma unroll
        for (int lvl = 0; lvl < 4; ++lvl) {
            const bf16x8 m0 = accfrag(M, 0), m1 = accfrag(M, 1), t0f = accfrag(MT, 0), t1f = accfrag(MT, 1);
            f32x16 M2T = mfma32(m0, t0f, zero16()); M2T = mfma32(m1, t1f, M2T);
            f32x16 M2 = zero16();
            if (lvl < 3) { M2 = mfma32(t0f, m0, M2); M2 = mfma32(t1f, m1, M2); }
            const bf16x8 y0 = accfrag(Y, 0), y1 = accfrag(Y, 1);
            Y = mfma32(accfrag(M2T, 0), y0, Y); Y = mfma32(accfrag(M2T, 1), y1, Y);
            M = M2; MT = M2T;
        }
    }
    int lane5 = lane; asm volatile("" : "+v"(lane5));
    const int r5 = lane5 & 31, h5 = lane5 >> 5;
    const bf16x8 ty0 = accfrag(Y, 0), ty1 = accfrag(Y, 1);
    f32x16 paT[2];
#pragma unroll
    for (int nt = 0; nt < 2; ++nt) { paT[nt] = mfma32(ty0, trfrag(mAT, 0, nt, lane5), zero16()); paT[nt] = mfma32(ty1, trfrag(mAT, 1, nt, lane5), paT[nt]); }
    f32x16 qakT = mfma32(ty0, accfrag(nakT, 0), zero16()); qakT = mfma32(ty1, accfrag(nakT, 1), qakT);
    const bf16x8 mb0 = accfrag(mbr, 0), mb1 = accfrag(mbr, 1);
#pragma unroll
    for (int mt = 0; mt < 2; ++mt) {
        f32x16 po;
#pragma unroll
        for (int g = 0; g < 4; ++g) { const u32x2 w = *(const LAS u32x2*)(mRT + r5 * MSTR + (32 * mt + 8 * g + 4 * h5) * 2);
            po[4 * g] = bf16_lo(w.x); po[4 * g + 1] = bf16_hi(w.x); po[4 * g + 2] = bf16_lo(w.y); po[4 * g + 3] = bf16_hi(w.y); }
        po = mfma32(accfrag(paT[mt], 0), mb0, po); po = mfma32(accfrag(paT[mt], 1), mb1, po);
#pragma unroll
        for (int sp = 0; sp < 2; ++sp)
            *(u32x4*)(slot + SL_PO + (2 * mt + sp) * 1024 + lane5 * 16) = (u32x4){cvt_pk_bf16(po[8 * sp], po[8 * sp + 1]), cvt_pk_bf16(po[8 * sp + 2], po[8 * sp + 3]), cvt_pk_bf16(po[8 * sp + 4], po[8 * sp + 5]), cvt_pk_bf16(po[8 * sp + 6], po[8 * sp + 7])};
    }
    {
        f32x16 qo = mfma32(accfrag(qakT, 0), mb0, mkr); qo = mfma32(accfrag(qakT, 1), mb1, qo);
#pragma unroll
        for (int sp = 0; sp < 2; ++sp) *(u32x4*)(slot + SL_QO + sp * 1024 + lane5 * 16) = (u32x4){cvt_pk_bf16(qo[8 * sp], qo[8 * sp + 1]), cvt_pk_bf16(qo[8 * sp + 2], qo[8 * sp + 3]), cvt_pk_bf16(qo[8 * sp + 4], qo[8 * sp + 5]), cvt_pk_bf16(qo[8 * sp + 6], qo[8 * sp + 7])};
    }
#pragma unroll
    for (int nt = 0; nt < 2; ++nt) {
        const bf16x8 bt0 = trfrag(mBT, 0, nt, lane5), bt1 = trfrag(mBT, 1, nt, lane5);
        const float gam = gc[32 * nt + r5];
#pragma unroll
        for (int mt = 0; mt < 2; ++mt) {
            f32x16 ps = zero16();
            if (mt == nt) {
#pragma unroll
                for (int reg = 0; reg < 16; ++reg) { const int row = (reg & 3) + 8 * (reg >> 2) + 4 * h5; ps[reg] = (row == r5) ? 1.0f : 0.f; }
            }
            ps = mfma32(accfrag(paT[mt], 0), bt0, ps); ps = mfma32(accfrag(paT[mt], 1), bt1, ps);
#pragma unroll
            for (int sp = 0; sp < 2; ++sp)
                *(u32x4*)(slot + SL_PS + ((nt * 2 + mt) * 2 + sp) * 1024 + lane5 * 16) = (u32x4){cvt_pk_bf16(ps[8 * sp] * gam, ps[8 * sp + 1] * gam), cvt_pk_bf16(ps[8 * sp + 2] * gam, ps[8 * sp + 3] * gam), cvt_pk_bf16(ps[8 * sp + 4] * gam, ps[8 * sp + 5] * gam), cvt_pk_bf16(ps[8 * sp + 6] * gam, ps[8 * sp + 7] * gam)};
        }
        f32x16 qs;
        { const bf16x8 k0 = trfrag(mKT, 0, nt, lane5), k1 = trfrag(mKT, 1, nt, lane5);
          const u32x4 w0 = __builtin_bit_cast(u32x4, k0), w1 = __builtin_bit_cast(u32x4, k1);
#pragma unroll
          for (int j = 0; j < 4; ++j) { qs[2 * j] = bf16_lo(w0[j]); qs[2 * j + 1] = bf16_hi(w0[j]); qs[8 + 2 * j] = bf16_lo(w1[j]); qs[8 + 2 * j + 1] = bf16_hi(w1[j]); } }
        qs = mfma32(accfrag(qakT, 0), bt0, qs); qs = mfma32(accfrag(qakT, 1), bt1, qs);
#pragma unroll
        for (int sp = 0; sp < 2; ++sp) *(u32x4*)(slot + SL_QS + (nt * 2 + sp) * 1024 + lane5 * 16) = (u32x4){cvt_pk_bf16(qs[8 * sp] * gam, qs[8 * sp + 1] * gam), cvt_pk_bf16(qs[8 * sp + 2] * gam, qs[8 * sp + 3] * gam), cvt_pk_bf16(qs[8 * sp + 4] * gam, qs[8 * sp + 5] * gam), cvt_pk_bf16(qs[8 * sp + 6] * gam, qs[8 * sp + 7] * gam)};
    }
    LDS_WAIT();
}

__device__ __forceinline__ u32x4 ntload16(const void* ptr) { return __builtin_nontemporal_load((const u32x4*)ptr); }
struct RkOps { u32x4 vr[4]; bf16x8 fps[2][2][2], fqs[2][2], fpo[2][2], fqo[2]; };
__device__ __forceinline__ void rk_load_ops_a(RkOps& o, const unsigned char* slot, int lane) {
    using namespace rk;
    const int r32 = lane & 31, h = lane >> 5;
#pragma unroll
    for (int k = 0; k < 4; ++k) o.vr[k] = ntload16(slot + SL_VR + k * 1024 + lane * 16);
#pragma unroll
    for (int jt = 0; jt < 2; ++jt)
#pragma unroll
        for (int s = 0; s < 2; ++s) o.fpo[jt][s] = __builtin_bit_cast(bf16x8, ntload16(slot + SL_PO + (2 * jt + s) * 1024 + lane * 16));
#pragma unroll
    for (int s = 0; s < 2; ++s) o.fqo[s] = __builtin_bit_cast(bf16x8, ntload16(slot + SL_QO + s * 1024 + lane * 16));
}
__device__ __forceinline__ void rk_load_ops_b(RkOps& o, const unsigned char* slot, int lane) {
    using namespace rk;
    const int r32 = lane & 31, h = lane >> 5;
#pragma unroll
    for (int mt = 0; mt < 2; ++mt) {
#pragma unroll
        for (int jt = 0; jt < 2; ++jt)
#pragma unroll
            for (int s = 0; s < 2; ++s) o.fps[mt][jt][s] = __builtin_bit_cast(bf16x8, ntload16(slot + SL_PS + ((mt * 2 + jt) * 2 + s) * 1024 + lane * 16));
#pragma unroll
        for (int s = 0; s < 2; ++s) o.fqs[mt][s] = __builtin_bit_cast(bf16x8, ntload16(slot + SL_QS + (mt * 2 + s) * 1024 + lane * 16));
    }
}
#define RK_SPIN(cond) do { unsigned _sp = 0; while (cond) { __builtin_amdgcn_s_sleep(1); if (++_sp > (1u << 24)) { err[0] = 1u; break; } } asm volatile("" ::: "memory"); } while (0)

__device__ __forceinline__ void rwkv_chain(const Params& p, LAS unsigned char* lds, int b, int hh) {
    using namespace rk;
    int tid = threadIdx.x; asm volatile("" : "+v"(tid));
    volatile LAS unsigned* ready = (volatile LAS unsigned*)(lds + L_FLAG); volatile LAS unsigned* freed = ready + NSLOT; volatile LAS unsigned* ofull = freed + NSLOT; volatile LAS unsigned* ofree = ofull + 2; volatile LAS unsigned* err = ofree + 2;
    if (tid < 2 * NSLOT + 5) ready[tid] = 0u;
    {
        const bf16_t* w2t = (const bf16_t*)(p.ws + WS_LT); const bf16_t* a2t = w2t + 512 * 64; const bf16_t* g2t = a2t + 512 * 64;
        for (int i = tid; i < 64 * 8; i += NTHREADS) { const int j = i >> 3, ch = i & 7, d = j * 128 + ((ch ^ (j & 7)) << 4);
            *(LAS u32x4*)(lds + L_W2 + d) = *(const u32x4*)(w2t + (hh * HD + j) * 64 + 8 * ch); *(LAS u32x4*)(lds + L_A2 + d) = *(const u32x4*)(a2t + (hh * HD + j) * 64 + 8 * ch); }
        for (int i = tid; i < 64 * 16; i += NTHREADS) { const int j = i >> 4, ch = i & 15; *(LAS u32x4*)(lds + L_G2 + j * 256 + ((ch ^ (j & 7)) << 4)) = *(const u32x4*)(g2t + (hh * HD + j) * 128 + 8 * ch); }
        LAS float* cst = (LAS float*)(lds + L_CST);
        for (int i = tid; i < C_END; i += NTHREADS) { float v;
            if (i < 256) v = p.shift_mu[(UXW - UR) + i];
            else if (i < 320) v = p.shift_mu[hh * HD + (i - 256)];
            else if (i < 384) v = p.shift_mu[(URK - UR) + hh * HD + (i - 320)];
            else if (i < 448) v = p.shift_mu[(URV - UR) + hh * HD + (i - 384)];
            else if (i < 512) v = p.rw_w0[hh * HD + (i - 448)];
            else if (i < 576) v = p.rw_a0[hh * HD + (i - 512)];
            else if (i < 640) v = p.rw_k_k[hh * HD + (i - 576)];
            else if (i < 704) v = p.rw_k_a[hh * HD + (i - 640)];
            else if (i < 768) v = p.rw_r_k[hh * HD + (i - 704)];
            else v = p.rw_ln_b[hh * HD + (i - 768)];
            cst[i] = v; }
    }
    __syncthreads();
    asm volatile("" : "+v"(tid));
    const int wave = __builtin_amdgcn_readfirstlane(tid >> 6);
    unsigned char* ring = (unsigned char*)p.out + (size_t)(b * NH + hh) * NSLOT * SLOT_BYTES;
    if (wave == 0) {
        int lane = tid & 63; asm volatile("" : "+v"(lane));
        const int r32 = lane & 31, h = lane >> 5;
        LAS unsigned char* vs = lds + L_CONS;
        f32x16 st[2][2];
#pragma unroll
        for (int a = 0; a < 2; ++a)
#pragma unroll
            for (int d = 0; d < 2; ++d) st[a][d] = zero16();
        RkOps ops;
        RK_SPIN(ready[0] != 1u);
        rk_load_ops_a(ops, ring, lane); rk_load_ops_b(ops, ring, lane);
        for (int c = 0; c < NCH; ++c) {
            bf16x8 sf[2][2][2];
#pragma unroll
            for (int jt = 0; jt < 2; ++jt)
#pragma unroll
                for (int it = 0; it < 2; ++it) { sf[jt][it][0] = accfrag(st[jt][it], 0); sf[jt][it][1] = accfrag(st[jt][it], 1); }
            { LAS unsigned char* d = vs + r32 * MSTR + h * 64;
              *(LAS u32x4*)d = ops.vr[0]; *(LAS u32x4*)(d + 16) = ops.vr[1]; *(LAS u32x4*)(d + 32) = ops.vr[2]; *(LAS u32x4*)(d + 48) = ops.vr[3]; }
            LDS_WAIT();
            bf16x8 vf[2][2];
            { const int g = lane >> 4, i16 = lane & 15, q = i16 >> 2, pp = i16 & 3;
#pragma unroll
              for (int it = 0; it < 2; ++it)
#pragma unroll
                  for (int s = 0; s < 2; ++s) { const LAS unsigned char* a = vs + (16 * s + 4 * h + q) * MSTR + (32 * it + 16 * (g & 1) + 4 * pp) * 2;
                      const s16x4 x = lds_tr16(a), y = lds_tr16(a + 8 * MSTR);
                      bf16x8 r; r[0] = x[0]; r[1] = x[1]; r[2] = x[2]; r[3] = x[3]; r[4] = y[0]; r[5] = y[1]; r[6] = y[2]; r[7] = y[3]; vf[it][s] = r; } }
            f32x16 o[2];
#pragma unroll
            for (int it = 0; it < 2; ++it) {
                o[it] = zero16();
#pragma unroll
                for (int jt = 0; jt < 2; ++jt)
#pragma unroll
                    for (int s = 0; s < 2; ++s) o[it] = mfma32(sf[jt][it][s], ops.fpo[jt][s], o[it]);
#pragma unroll
                for (int s = 0; s < 2; ++s) o[it] = mfma32(vf[it][s], ops.fqo[s], o[it]);
            }
            const unsigned char* nslot = ring + (size_t)((c + 1) % NSLOT) * SLOT_BYTES;
            if (c + 1 < NCH) { RK_SPIN(ready[(c + 1) % NSLOT] != (unsigned)(c + 2)); rk_load_ops_a(ops, nslot, lane); }
#pragma unroll
            for (int mt = 0; mt < 2; ++mt)
#pragma unroll
                for (int it = 0; it < 2; ++it) {
                    f32x16 a = zero16();
#pragma unroll
                    for (int jt = 0; jt < 2; ++jt)
#pragma unroll
                        for (int s = 0; s < 2; ++s) a = mfma32(ops.fps[mt][jt][s], sf[jt][it][s], a);
#pragma unroll
                    for (int s = 0; s < 2; ++s) a = mfma32(ops.fqs[mt][s], vf[it][s], a);
                    st[mt][it] = a;
                }
            if (c + 1 < NCH) rk_load_ops_b(ops, nslot, lane);
            if (c >= 1) RK_SPIN(ofree[0] != (unsigned)c);
            { LAS unsigned char* ob = lds + L_OBUF + r32 * OSTR;
#pragma unroll
              for (int it = 0; it < 2; ++it)
#pragma unroll
                  for (int g = 0; g < 4; ++g) *(LAS f32x4*)(ob + (32 * it + 8 * g + 4 * h) * 4) = (f32x4){o[it][4 * g], o[it][4 * g + 1], o[it][4 * g + 2], o[it][4 * g + 3]}; }
            LDS_WAIT();
            if (lane == 0) ofull[0] = (unsigned)(c + 1);
        }
    } else if (wave == 1) {
        int lane = tid & 63; asm volatile("" : "+v"(lane));
        const int r32 = lane & 31, h = lane >> 5;
        u32x4 gw[4], gb[4];
        RK_SPIN(ready[0] != 1u);
#pragma unroll
        for (int k = 0; k < 4; ++k) { gw[k] = ntload16(ring + SL_GW + k * 1024 + lane * 16); gb[k] = ntload16(ring + SL_GB + k * 1024 + lane * 16); }
        for (int c = 0; c < NCH; ++c) {
            const int sl = c % NSLOT;
            RK_SPIN(ofull[0] != (unsigned)(c + 1));
            float ov[32];
            { const LAS unsigned char* ob = lds + L_OBUF + r32 * OSTR + 128 * h;
#pragma unroll
              for (int k = 0; k < 8; ++k) { const f32x4 x = *(const LAS f32x4*)(ob + 16 * k); ov[4 * k] = x[0]; ov[4 * k + 1] = x[1]; ov[4 * k + 2] = x[2]; ov[4 * k + 3] = x[3]; } }
            LDS_WAIT();
            if (lane == 0) ofree[0] = (unsigned)(c + 1);
            float sm = 0.f;
#pragma unroll
            for (int k = 0; k < 32; ++k) sm += ov[k];
            sm += swap32(sm);
            const float mean = sm * (1.0f / 64.0f);
            float sv = 0.f;
#pragma unroll
            for (int k = 0; k < 32; ++k) { const float d = ov[k] - mean; sv += d * d; }
            sv += swap32(sv);
            const float rstd = 1.0f / sqrtf(sv * (1.0f / 64.0f) + 64e-5f);
            bf16_t* mrow = (bf16_t*)(p.ws + WS_B) + ((size_t)b * S + c * C + r32) * D + 512 + hh * HD + 32 * h;
#pragma unroll
            for (int k = 0; k < 4; ++k) {
                float w8[8], b8[8], r[8]; f8_from_bf16(gw[k], w8); f8_from_bf16(gb[k], b8);
                const f32x4 l0 = *(const f32x4*)(p.rw_ln_w + hh * HD + 32 * h + 8 * k), l1 = *(const f32x4*)(p.rw_ln_w + hh * HD + 32 * h + 8 * k + 4);
#pragma unroll
                for (int e = 0; e < 8; ++e) r[e] = ((ov[8 * k + e] - mean) * rstd * (e < 4 ? l0[e] : l1[e - 4]) + b8[e]) * w8[e];
                *(u32x4*)(mrow + 8 * k) = (u32x4){cvt_pk_bf16(r[0], r[1]), cvt_pk_bf16(r[2], r[3]), cvt_pk_bf16(r[4], r[5]), cvt_pk_bf16(r[6], r[7])};
            }
            if (lane == 0) freed[sl] = (unsigned)(c + 1);
            if (c + 1 < NCH) { const int sn = (c + 1) % NSLOT; const unsigned char* sp_ = ring + (size_t)sn * SLOT_BYTES; RK_SPIN(ready[sn] != (unsigned)(c + 2));
#pragma unroll
                for (int k = 0; k < 4; ++k) { gw[k] = ntload16(sp_ + SL_GW + k * 1024 + lane * 16); gb[k] = ntload16(sp_ + SL_GB + k * 1024 + lane * 16); } }
        }
    } else {
        int lane = tid & 63;
        if (wave - 2 < NPROD) for (int c = wave - 2; c < NCH; c += NPROD) {
            const int sl = c % NSLOT;
            if (c >= NSLOT) RK_SPIN(freed[sl] != (unsigned)(c - NSLOT + 1));
            rk_produce(p, lds, lds + (wave - 2) * PROD_LDS, ring + (size_t)sl * SLOT_BYTES, b, hh, c);
            asm volatile("s_waitcnt vmcnt(0)" ::: "memory");
            if (lane == 0) ready[sl] = (unsigned)(c + 1);
        }
    }
    __syncthreads();
}

#ifdef RWDEBUG
namespace rw {
constexpr int CH = 16;
constexpr int O_UM = 0;
constexpr int O_LW = O_UM + CH * 448 * 4;
constexpr int O_LA = O_LW + CH * 64 * 4;
constexpr int O_LG0 = O_LA + CH * 64 * 4;
constexpr int O_LG1 = O_LG0 + CH * 64 * 4;
constexpr int O_A1 = O_LG1 + CH * 64 * 4;
constexpr int O_R1 = O_A1 + CH * 64 * 4;
constexpr int O_B1 = O_R1 + CH * 64 * 4;
constexpr int O_K1 = O_B1 + CH * 64 * 4;
constexpr int O_O = O_K1 + CH * 64 * 4;
constexpr int O_WT = O_O + CH * 64 * 4;
constexpr int O_GC = O_WT + 8 * 64 * 4;
constexpr int O_SC = O_GC + 64 * 4;
constexpr int O_END = O_SC + 3 * 16 * 4;
}
__device__ __forceinline__ bf16x8 ldw_frag(const float* W, int ldw, int m0, int col) {
    unsigned w[4];
#pragma unroll
    for (int j = 0; j < 4; ++j) w[j] = cvt_pk_bf16(W[(size_t)(m0 + 2 * j) * ldw + col], W[(size_t)(m0 + 2 * j + 1) * ldw + col]);
    return __builtin_bit_cast(bf16x8, (u32x4){w[0], w[1], w[2], w[3]});
}
template <int ACT>
__device__ __forceinline__ bf16x8 act_frag(const LAS float* src) {
    const f32x4 a = *(const LAS f32x4*)src, b = *(const LAS f32x4*)(src + 4); float v[8] = {a[0], a[1], a[2], a[3], b[0], b[1], b[2], b[3]};
#pragma unroll
    for (int j = 0; j < 8; ++j) {
        if (ACT == 1) v[j] = 1.0f - 2.0f * frcp(1.0f + fexp2(v[j] * (2.0f * LOG2E)));
        if (ACT == 2) v[j] = frcp(1.0f + fexp2(-v[j] * LOG2E));
    }
    return __builtin_bit_cast(bf16x8, (u32x4){cvt_pk_bf16(v[0], v[1]), cvt_pk_bf16(v[2], v[3]), cvt_pk_bf16(v[4], v[5]), cvt_pk_bf16(v[6], v[7])});
}

__device__ __forceinline__ void rwkv_chain_seq(const Params& p, LAS unsigned char* lds, int b, int h, bf16_t* mix, int nchunks) {
    using namespace rw;
    const int tid = threadIdx.x, wave = __builtin_amdgcn_readfirstlane(tid >> 6), lane = tid & 63;
    const bf16_t* u = (const bf16_t*)(p.ws + WS_A);
    const size_t row0 = (size_t)b * S;
    LAS float* UM = (LAS float*)(lds + O_UM); LAS float* LW = (LAS float*)(lds + O_LW); LAS float* LA = (LAS float*)(lds + O_LA);
    LAS float* LG0 = (LAS float*)(lds + O_LG0); LAS float* LG1 = (LAS float*)(lds + O_LG1);
    LAS float* A1 = (LAS float*)(lds + O_A1); LAS float* R1 = (LAS float*)(lds + O_R1); LAS float* B1 = (LAS float*)(lds + O_B1); LAS float* K1 = (LAS float*)(lds + O_K1);
    LAS float* OO = (LAS float*)(lds + O_O); LAS float* WT = (LAS float*)(lds + O_WT); LAS float* GC = (LAS float*)(lds + O_GC); LAS float* SC = (LAS float*)(lds + O_SC);
    const int fc = lane & 15, fq = lane >> 4;
    bf16x8 bwa[2], bg[2];
    { const float* W = wave < 4 ? p.rw_w2 : p.rw_a2; const int col = h * HD + 16 * (wave & 3) + fc;
      bwa[0] = ldw_frag(W, 512, 8 * fq, col); bwa[1] = ldw_frag(W, 512, 32 + 8 * fq, col);
      const int ks = (wave >> 2) * 2; bg[0] = ldw_frag(p.rw_g2, 512, 32 * ks + 8 * fq, col); bg[1] = ldw_frag(p.rw_g2, 512, 32 * (ks + 1) + 8 * fq, col); }
    const int hj = h * HD + lane;
    const float c_w0 = p.rw_w0[hj], c_a0 = p.rw_a0[hj], c_kk = p.rw_k_k[hj], c_ka = p.rw_k_a[hj], c_rk = p.rw_r_k[hj], c_lnw = p.rw_ln_w[hj], c_lnb = p.rw_ln_b[hj];
    int ld_t[2], ld_c[2], ld_uc[2]; bool ld_ok[2];
#pragma unroll
    for (int r = 0; r < 2; ++r) { const int gid = tid + 512 * r; ld_ok[r] = gid < CH * 56; const int t = gid / 56, cg8 = gid % 56; ld_t[r] = t; ld_c[r] = cg8 * 8;
        ld_uc[r] = cg8 < 8 ? UR + h * HD + 8 * cg8 : cg8 < 16 ? URK + h * HD + 8 * (cg8 - 8) : cg8 < 24 ? URV + h * HD + 8 * (cg8 - 16) : UXW + 8 * (cg8 - 24); }
    const int si = 8 * wave + (lane >> 3), sj = 8 * (lane & 7);
    float st[8];
#pragma unroll
    for (int n = 0; n < 8; ++n) st[n] = 0.f;
    u32x4 cur[2], prv[2];
    auto issue_loads = [&](int t0) {
#pragma unroll
        for (int r = 0; r < 2; ++r) { cur[r] = (u32x4){0u, 0u, 0u, 0u}; prv[r] = (u32x4){0u, 0u, 0u, 0u};
            if (ld_ok[r]) { const int tt = t0 + ld_t[r]; const bf16_t* a = u + (row0 + tt) * NIN + ld_uc[r]; cur[r] = *(const u32x4*)a; if (tt > 0) prv[r] = *(const u32x4*)(a - NIN); } }
    };
    issue_loads(0);
    for (int c = 0; c < nchunks; ++c) {
        const int t0 = c * CH;
#pragma unroll
        for (int r = 0; r < 2; ++r) if (ld_ok[r]) {
            const float* mu = p.shift_mu + (ld_uc[r] - UR); const f32x4 m0 = *(const f32x4*)mu, m1 = *(const f32x4*)(mu + 4);
            float cv[8], pv[8];
#pragma unroll
            for (int j = 0; j < 4; ++j) { cv[2 * j] = bf16_lo(cur[r][j]); cv[2 * j + 1] = bf16_hi(cur[r][j]); pv[2 * j] = bf16_lo(prv[r][j]); pv[2 * j + 1] = bf16_hi(prv[r][j]); }
            f32x4 o0, o1;
#pragma unroll
            for (int j = 0; j < 4; ++j) { o0[j] = cv[j] + (pv[j] - cv[j]) * m0[j]; o1[j] = cv[4 + j] + (pv[4 + j] - cv[4 + j]) * m1[j]; }
            LAS float* d = UM + ld_t[r] * 448 + ld_c[r]; *(LAS f32x4*)d = o0; *(LAS f32x4*)(d + 4) = o1;
        }
        if (c + 1 < S / CH) issue_loads(t0 + CH);
        __syncthreads();
        {
            f32x4 acc = (f32x4){0.f, 0.f, 0.f, 0.f};
            const LAS float* src = UM + fc * 448 + (wave < 4 ? 192 : 256) + 8 * fq;
            if (wave < 4) { acc = __builtin_amdgcn_mfma_f32_16x16x32_bf16(act_frag<1>(src), bwa[0], acc, 0, 0, 0); acc = __builtin_amdgcn_mfma_f32_16x16x32_bf16(act_frag<1>(src + 32), bwa[1], acc, 0, 0, 0); }
            else          { acc = __builtin_amdgcn_mfma_f32_16x16x32_bf16(act_frag<0>(src), bwa[0], acc, 0, 0, 0); acc = __builtin_amdgcn_mfma_f32_16x16x32_bf16(act_frag<0>(src + 32), bwa[1], acc, 0, 0, 0); }
            LAS float* dst = (wave < 4 ? LW : LA) + 16 * (wave & 3) + fc;
#pragma unroll
            for (int r = 0; r < 4; ++r) dst[(4 * fq + r) * 64] = acc[r];
            f32x4 ag = (f32x4){0.f, 0.f, 0.f, 0.f};
            const LAS float* sg = UM + fc * 448 + 320 + 64 * (wave >> 2) + 8 * fq;
            ag = __builtin_amdgcn_mfma_f32_16x16x32_bf16(act_frag<2>(sg), bg[0], ag, 0, 0, 0); ag = __builtin_amdgcn_mfma_f32_16x16x32_bf16(act_frag<2>(sg + 32), bg[1], ag, 0, 0, 0);
            LAS float* dg = (wave < 4 ? LG0 : LG1) + 16 * (wave & 3) + fc;
#pragma unroll
            for (int r = 0; r < 4; ++r) dg[(4 * fq + r) * 64] = ag[r];
        }
        __syncthreads();
        float e_kk[2], e_b[2], e_k[2], e_r[2], e_ld[2];
#pragma unroll
        for (int tt = 0; tt < 2; ++tt) {
            const int t = 2 * wave + tt;
            const float xw = c_w0 + LW[t * 64 + lane];
            const float spn = (fmaxf(-xw, 0.f) + LN2 * flog2(1.0f + fexp2(-fabsf(xw) * LOG2E)));
            e_ld[tt] = -fexp2((-spn - 0.5f) * LOG2E);
            const float a = frcp(1.0f + fexp2(-(c_a0 + LA[t * 64 + lane]) * LOG2E));
            const float kraw = UM[t * 448 + 64 + lane], r = UM[t * 448 + lane];
            const float kkv = kraw * c_kk; const float ssq = wave_sum(kkv * kkv);
            const float kk = kkv * frsq(fmaxf(ssq, 1e-24f));
            const float kmod = kraw * (1.0f + (a - 1.0f) * c_ka);
            const float bb = kk * a;
            const float cbr = wave_sum(bb * r), ckr = wave_sum(kmod * r), bon = wave_sum(r * kmod * c_rk);
            if (lane == 0) { SC[t] = cbr; SC[16 + t] = ckr; SC[32 + t] = bon; }
            e_kk[tt] = kk; e_b[tt] = bb; e_k[tt] = kmod; e_r[tt] = r;
        }
        WT[wave * 64 + lane] = e_ld[0] + e_ld[1];
        __syncthreads();
        {
            float off = 0.f, tot = 0.f;
#pragma unroll
            for (int w = 0; w < 8; ++w) { const float x = WT[w * 64 + lane]; if (w < wave) off += x; tot += x; }
            const float c0 = off + e_ld[0], c1 = c0 + e_ld[1];
            const int t = 2 * wave;
            A1[t * 64 + lane] = -e_kk[0] * fexp2(off * LOG2E);       A1[(t + 1) * 64 + lane] = -e_kk[1] * fexp2(c0 * LOG2E);
            R1[t * 64 + lane] = e_r[0] * fexp2(c0 * LOG2E);          R1[(t + 1) * 64 + lane] = e_r[1] * fexp2(c1 * LOG2E);
            const float i0 = fexp2(-c0 * LOG2E), i1 = fexp2(-c1 * LOG2E);
            B1[t * 64 + lane] = e_b[0] * i0;                          B1[(t + 1) * 64 + lane] = e_b[1] * i1;
            K1[t * 64 + lane] = e_k[0] * i0;                          K1[(t + 1) * 64 + lane] = e_k[1] * i1;
            if (wave == 0) GC[lane] = fexp2(tot * LOG2E);
        }
        __syncthreads();
#pragma unroll 4
        for (int t = 0; t < CH; ++t) {
            const f32x4 a0 = *(const LAS f32x4*)(A1 + t * 64 + sj), a1 = *(const LAS f32x4*)(A1 + t * 64 + sj + 4);
            const f32x4 r0 = *(const LAS f32x4*)(R1 + t * 64 + sj), r1 = *(const LAS f32x4*)(R1 + t * 64 + sj + 4);
            const f32x4 b0 = *(const LAS f32x4*)(B1 + t * 64 + sj), b1 = *(const LAS f32x4*)(B1 + t * 64 + sj + 4);
            const f32x4 k0 = *(const LAS f32x4*)(K1 + t * 64 + sj), k1 = *(const LAS f32x4*)(K1 + t * 64 + sj + 4);
            const float v = UM[t * 448 + 128 + si], cbr = SC[t], ckr = SC[16 + t];
            float sa = (st[0] * a0[0] + st[1] * a0[1]) + (st[2] * a0[2] + st[3] * a0[3]) + ((st[4] * a1[0] + st[5] * a1[1]) + (st[6] * a1[2] + st[7] * a1[3]));
            float pp = (st[0] * r0[0] + st[1] * r0[1]) + (st[2] * r0[2] + st[3] * r0[3]) + ((st[4] * r1[0] + st[5] * r1[1]) + (st[6] * r1[2] + st[7] * r1[3]));
            sa = sum8(sa); pp = sum8(pp);
            if ((lane & 7) == 0) OO[t * 64 + si] = pp + sa * cbr + v * ckr;
#pragma unroll
            for (int n = 0; n < 4; ++n) { st[n] += sa * b0[n] + v * k0[n]; st[4 + n] += sa * b1[n] + v * k1[n]; }
        }
        {
            const f32x4 g0 = *(const LAS f32x4*)(GC + sj), g1 = *(const LAS f32x4*)(GC + sj + 4);
#pragma unroll
            for (int n = 0; n < 4; ++n) { st[n] *= g0[n]; st[4 + n] *= g1[n]; }
        }
        __syncthreads();
#pragma unroll
        for (int tt = 0; tt < 2; ++tt) {
            const int t = 2 * wave + tt;
            const float o = OO[t * 64 + lane];
            const float mean = wave_sum(o) * (1.0f / 64.0f); const float dlt = o - mean;
            const float var = wave_sum(dlt * dlt) * (1.0f / 64.0f);
            const float gn = dlt * (1.0f / sqrtf(var + 64e-5f)) * c_lnw + c_lnb;
            const float res = (gn + SC[32 + t] * UM[t * 448 + 128 + lane]) * (LG0[t * 64 + lane] + LG1[t * 64 + lane]);
            mix[(row0 + t0 + t) * D + 512 + h * HD + lane] = (bf16_t)(cvt_pk_bf16(res, 0.f) & 0xffffu);
        }
        __syncthreads();
    }
}

#endif

__device__ __forceinline__ void phase2a(const Params& p) {
    int tid = threadIdx.x; asm volatile("" : "+v"(tid));
    const int wave = tid >> 6, lane = tid & 63;
    const bf16_t* u = (const bf16_t*)(p.ws + WS_A);
    bf16_t* act = (bf16_t*)((unsigned char*)p.out + ACT_OFF);
    const f32x4 mu = *(const f32x4*)(p.shift_mu + (UXW - UR) + 4 * lane);
    const int stride = gridDim.x * NWAVES;
    int row = blockIdx.x * NWAVES + wave;
    u32x2 c = (u32x2){0u, 0u}, pv = (u32x2){0u, 0u};
    if (row < T) { const bf16_t* a = u + (size_t)row * NIN + UXW + 4 * lane; c = *(const u32x2*)a; if ((row & (S - 1)) != 0) pv = *(const u32x2*)(a - NIN); }
    for (; row < T; row += stride) {
        const float cv[4] = {bf16_lo(c.x), bf16_hi(c.x), bf16_lo(c.y), bf16_hi(c.y)}, pf[4] = {bf16_lo(pv.x), bf16_hi(pv.x), bf16_lo(pv.y), bf16_hi(pv.y)};
        const int nrow = row + stride;
        if (nrow < T) { const bf16_t* a = u + (size_t)nrow * NIN + UXW + 4 * lane; c = *(const u32x2*)a; pv = (u32x2){0u, 0u}; if ((nrow & (S - 1)) != 0) pv = *(const u32x2*)(a - NIN); }
        float x[4];
#pragma unroll
        for (int j = 0; j < 4; ++j) { x[j] = cv[j] + (pf[j] - cv[j]) * mu[j];
            if (lane < 16) x[j] = 1.0f - 2.0f * frcp(1.0f + fexp2(x[j] * (2.0f * LOG2E)));
            else if (lane >= 32) x[j] = frcp(1.0f + fexp2(-x[j] * LOG2E)); }
        *(u32x2*)(act + (size_t)row * 256 + 4 * lane) = (u32x2){cvt_pk_bf16(x[0], x[1]), cvt_pk_bf16(x[2], x[3])};
    }
}

__device__ __forceinline__ void phase2(const Params& p, LAS unsigned char* lds) {
    const int nchain = NB * NH, G = gridDim.x, wave = threadIdx.x >> 6;
    const int nscan = G >= 2 * nchain ? nchain : (G > 1 ? G / 2 : 0);
    if ((int)blockIdx.x < nscan || nscan == 0) {
        const int stride = nscan == 0 ? G : nscan;
        for (int it = blockIdx.x; it < nchain; it += stride) rwkv_chain(p, lds, it / NH, it % NH);
    }
    if ((int)blockIdx.x >= nscan) {
        const int nb = G - nscan, bi = blockIdx.x - nscan;
        for (int it = bi * 8 + wave; it < NB * NH * 64; it += nb * 8) attn_tile(p, lds + wave * 9216, it / (NH * 64), (it / 64) % NH, 63 - (it % 64));
        __syncthreads();
        p0_expert_weights(p, lds, bi * 8 + wave, nb * 8);
    }
}

struct EpiH {
    const float* x; bf16_t* hb; int row0, col0;
    __device__ __forceinline__ void operator()(const f32x4 (&acc)[2][2][4][2], int wr, int wc, int fr, int fq) const {
#pragma unroll
        for (int ai = 0; ai < 2; ++ai)
#pragma unroll
            for (int m = 0; m < 4; ++m) { const size_t off = (size_t)(row0 + ai * 128 + wr * 64 + m * 16 + fr) * D + col0 + wc * 32 + 8 * fq;
#pragma unroll
                for (int bj = 0; bj < 2; ++bj) { const f32x4 v0 = *(const f32x4*)(x + off + bj * 128) + acc[ai][bj][m][0], v1 = *(const f32x4*)(x + off + bj * 128 + 4) + acc[ai][bj][m][1];
                    *(u32x4*)(hb + off + bj * 128) = (u32x4){cvt_pk_bf16(v0[0], v0[1]), cvt_pk_bf16(v0[2], v0[3]), cvt_pk_bf16(v1[0], v1[1]), cvt_pk_bf16(v1[2], v1[3])}; }
                if (m & 1) asm volatile("" ::: "memory"); }
    }
};
__device__ __forceinline__ void phase3(const Params& p, LAS unsigned char* lds) {
    constexpr int nM = T / 256, nN = D / 256;
    unsigned aoff[2][2]; g8::aoff_rows(aoff, D);
    for (int L = blockIdx.x; L < nM * nN; L += gridDim.x) {
        int pm, pn; g8::tile_order(L, nM, nN, pm, pn);
        EpiH E{p.x, (bf16_t*)(p.ws + WS_A), pm * 256, pn * 256};
        g8::gemm_unit(lds, (const char*)(p.ws + WS_B) + (size_t)pm * 256 * D * 2, aoff, (const char*)(p.ws + WS_WOUT) + (size_t)pn * 256 * D * 2, D, E);
    }
}

__device__ __forceinline__ void phase4(const Params& p, LAS unsigned char* lds) {
    int tid = threadIdx.x; asm volatile("" : "+v"(tid));
    const int wave = tid >> 6, lane = tid & 63, fr = lane & 15, fq = lane >> 4;
    const float* hsrc = p.out; bf16_t* hb = (bf16_t*)(p.ws + WS_A); float* rstd2 = (float*)(p.ws + WS_RSTD2);
    const bf16_t* wr_hi = (const bf16_t*)(p.ws + WS_WR); const bf16_t* wr_lo = wr_hi + 48 * D;
    int* list = (int*)(p.ws + WS_LIST); float* listw = (float*)(p.ws + WS_LISTW); unsigned* cnt = (unsigned*)(p.ws + WS_CTL);
    LAS float* lg = (LAS float*)(lds + wave * 3072);
    LAS unsigned* lcnt = (LAS unsigned*)(lds + 8 * 3072);
    LAS unsigned* gbase = lcnt + 32;
    for (int blk = blockIdx.x; blk < T / 128; blk += gridDim.x) {
        if (tid < 32) lcnt[tid] = 0u;
        __syncthreads();
        const int tok0 = blk * 128 + wave * 16;
        f32x4 acc[3];
#pragma unroll
        for (int n = 0; n < 3; ++n) acc[n] = (f32x4){0.f, 0.f, 0.f, 0.f};
        float ss = 0.f;
        const bf16_t* hbp = hb + (size_t)(tok0 + fr) * D + 8 * fq;
        LAS unsigned char* wl_ = lds + 32768;
#pragma unroll 1
        for (int half = 0; half < 2; ++half) {
            __syncthreads();
            for (int i = tid; i < 2 * 48 * 64; i += NTHREADS) { const int mat = i / 3072, r = (i % 3072) >> 6, ch = i & 63;
                *(LAS u32x4*)(wl_ + mat * 49152 + r * 1024 + ((ch ^ (r & 15)) << 4)) = *(const u32x4*)((mat ? wr_lo : wr_hi) + (size_t)r * D + half * 512 + ch * 8); }
            u32x4 av[16];
#pragma unroll
            for (int ks = 0; ks < 16; ++ks) av[ks] = *(const u32x4*)(hbp + half * 512 + 32 * ks);
            __syncthreads();
#pragma unroll
            for (int ks = 0; ks < 16; ++ks) {
                float f[8]; f8_from_bf16(av[ks], f);
                ss += (f[0] * f[0] + f[1] * f[1]) + (f[2] * f[2] + f[3] * f[3]) + ((f[4] * f[4] + f[5] * f[5]) + (f[6] * f[6] + f[7] * f[7]));
                const bf16x8 ah = __builtin_bit_cast(bf16x8, av[ks]);
#pragma unroll
                for (int n = 0; n < 3; ++n) {
                    const int r = 16 * n + fr, off = r * 1024 + (((4 * ks + fq) ^ (r & 15)) << 4);
                    const bf16x8 wh = *(const LAS bf16x8*)(wl_ + off), wl = *(const LAS bf16x8*)(wl_ + 49152 + off);
                    acc[n] = __builtin_amdgcn_mfma_f32_16x16x32_bf16(ah, wh, acc[n], 0, 0, 0);
                    acc[n] = __builtin_amdgcn_mfma_f32_16x16x32_bf16(ah, wl, acc[n], 0, 0, 0);
                }
            }
        }
        ss += __shfl_xor(ss, 16); ss += __shfl_xor(ss, 32);
        const float rs = 1.0f / sqrtf(ss * (1.0f / D) + 1e-6f);
        if (fq == 0) rstd2[tok0 + fr] = rs;
#pragma unroll
        for (int n = 0; n < 3; ++n)
#pragma unroll
            for (int r = 0; r < 4; ++r) lg[(4 * fq + r) * 48 + 16 * n + fr] = acc[n][r];
        LDS_WAIT();
        int e0 = 0, e1 = 0; float w0 = 0.f, w1 = 0.f; unsigned lp0 = 0, lp1 = 0;
        if (lane < 16) {
            const float rst = rs;
            const LAS float* L = lg + lane * 48;
            float gl[4]; int gi = 0; float gm;
#pragma unroll
            for (int g = 0; g < 4; ++g) gl[g] = L[g] * rst + p.r_grp_b[g];
            gm = gl[0];
#pragma unroll
            for (int g = 1; g < 4; ++g) if (gl[g] > gm) { gm = gl[g]; gi = g; }
            float gs = 0.f;
#pragma unroll
            for (int g = 0; g < 4; ++g) gs += __expf(gl[g] - gm);
            const float gval = 1.0f / gs;
            float el[8];
#pragma unroll
            for (int e = 0; e < 8; ++e) el[e] = L[4 + gi * 8 + e] * rst + p.r_exp_b[gi * 8 + e];
            int i0 = 0; float m0 = el[0];
#pragma unroll
            for (int e = 1; e < 8; ++e) if (el[e] > m0) { m0 = el[e]; i0 = e; }
            int i1 = i0 == 0 ? 1 : 0; float m1 = el[i1];
#pragma unroll
            for (int e = 0; e < 8; ++e) if (e != i0 && el[e] > m1) { m1 = el[e]; i1 = e; }
            const float x1 = __expf(m1 - m0); const float den = 1.0f / (1.0f + x1);
            e0 = gi * 8 + i0; e1 = gi * 8 + i1; w0 = gval * den; w1 = gval * x1 * den;
            lp0 = atomicAdd((unsigned*)&lcnt[e0], 1u); lp1 = atomicAdd((unsigned*)&lcnt[e1], 1u);
        }
        __syncthreads();
        if (tid < 32) gbase[tid] = atomicAdd(&cnt[tid], lcnt[tid]);
        __syncthreads();
        if (lane < 16) {
            const int tok = tok0 + lane;
            const unsigned q0 = gbase[e0] + lp0, q1 = gbase[e1] + lp1;
            list[(size_t)e0 * T + q0] = tok * 2;     listw[(size_t)e0 * T + q0] = w0;
            list[(size_t)e1 * T + q1] = tok * 2 + 1; listw[(size_t)e1 * T + q1] = w1;
        }
        __syncthreads();
    }
}

constexpr int LDS_MAP = 161792;
__device__ __forceinline__ void expert_map_build(const unsigned* cnt, LAS unsigned char* lds) {
    LAS int* pre = (LAS int*)(lds + LDS_MAP); LAS int* cn = pre + 40;
    if (threadIdx.x == 0) { int acc = 0; for (int i = 0; i < NE; ++i) { const int ci = (int)__hip_atomic_load(cnt + i, __ATOMIC_RELAXED, __HIP_MEMORY_SCOPE_AGENT); pre[i] = acc; cn[i] = ci; acc += (ci + 255) >> 8; } pre[NE] = acc; }
    __syncthreads();
}
__device__ __forceinline__ void expert_find(LAS unsigned char* lds, int mt, int& e, int& local, int& c) {
    const LAS int* pre = (const LAS int*)(lds + LDS_MAP); const LAS int* cn = pre + 40;
    int lo = 0;
#pragma unroll 1
    for (int i = 1; i < NE; ++i) if (pre[i] <= mt) lo = i;
    e = __builtin_amdgcn_readfirstlane(lo); local = mt - __builtin_amdgcn_readfirstlane(pre[e]); c = __builtin_amdgcn_readfirstlane(cn[e]);
}
__device__ __forceinline__ int expert_tiles(LAS unsigned char* lds) { return __builtin_amdgcn_readfirstlane(((const LAS int*)(lds + LDS_MAP))[NE]); }

struct EpiGU {
    bf16_t* hid; const float* rstd2; const int* lst; int cnt, p0, hrow0, ct;
    __device__ __forceinline__ void operator()(const f32x4 (&acc)[2][2][4][2], int wr, int wc, int fr, int fq) const {
#pragma unroll
        for (int ai = 0; ai < 2; ++ai)
#pragma unroll
            for (int m = 0; m < 4; ++m) { const int r = ai * 128 + wr * 64 + m * 16 + fr; const int pp = p0 + r;
                const float rs = pp < cnt ? rstd2[lst[pp] >> 1] : 0.f;
                bf16_t* op = hid + (size_t)(hrow0 + r) * DE + ct * 128 + wc * 32 + 8 * fq;
                float o[8];
#pragma unroll
                for (int n = 0; n < 2; ++n) { const f32x4 g = acc[ai][0][m][n] * rs, uu = acc[ai][1][m][n] * rs;
#pragma unroll
                    for (int j = 0; j < 4; ++j) o[4 * n + j] = g[j] * frcp(1.0f + fexp2(-g[j] * LOG2E)) * uu[j]; }
                *(u32x4*)op = (u32x4){cvt_pk_bf16(o[0], o[1]), cvt_pk_bf16(o[2], o[3]), cvt_pk_bf16(o[4], o[5]), cvt_pk_bf16(o[6], o[7])}; }
    }
};
__device__ __forceinline__ void phase5(const Params& p, LAS unsigned char* lds) {
    expert_map_build((const unsigned*)(p.ws + WS_CTL), lds);
    const int MT = expert_tiles(lds);
    const int tid = threadIdx.x;
    for (int unit = blockIdx.x; unit < MT * 2; unit += gridDim.x) {
        const int mt = unit >> 1, ct = unit & 1; int e, local, c; expert_find(lds, mt, e, local, c);
        const int* lst = (const int*)(p.ws + WS_LIST) + (size_t)e * T; const int p0 = local * 256;
        unsigned aoff[2][2];
#pragma unroll
        for (int i = 0; i < 2; ++i) { int R, C; g8::stage_rc(tid * 16 + i * 8192, R, C);
#pragma unroll
            for (int hh = 0; hh < 2; ++hh) { const int pp = p0 + hh * 128 + R; const int tok = pp < c ? (lst[pp] >> 1) : 0; aoff[hh][i] = (unsigned)(tok * D + C) * 2u; } }
        EpiGU E{(bf16_t*)(p.ws + WS_B), (const float*)(p.ws + WS_RSTD2), lst, c, p0, mt * 256, ct};
        g8::gemm_unit(lds, (const char*)(p.ws + WS_A), aoff, (const char*)(p.ws + WS_WGU) + ((size_t)e * 512 + ct * 256) * D * 2, D, E);
    }
}
struct EpiDN {
    bf16_t* y; bf16_t* dummy; const int* lst; const float* lw; int cnt, p0, col0;
    __device__ __forceinline__ void operator()(const f32x4 (&acc)[2][2][4][2], int wr, int wc, int fr, int fq) const {
#pragma unroll
        for (int ai = 0; ai < 2; ++ai)
#pragma unroll
            for (int m = 0; m < 4; ++m) { const int pp = p0 + ai * 128 + wr * 64 + m * 16 + fr;
                const bool ok = pp < cnt; const int ent = lst[pp]; const float w = lw[pp];
                bf16_t* op = (ok ? y + ((size_t)(ent & 1) * T + (ent >> 1)) * D : dummy) + col0 + wc * 32 + 8 * fq;
#pragma unroll
                for (int bj = 0; bj < 2; ++bj) { const f32x4 v0 = acc[ai][bj][m][0] * w, v1 = acc[ai][bj][m][1] * w;
                    *(u32x4*)(op + bj * 128) = (u32x4){cvt_pk_bf16(v0[0], v0[1]), cvt_pk_bf16(v0[2], v0[3]), cvt_pk_bf16(v1[0], v1[1]), cvt_pk_bf16(v1[2], v1[3])}; }
                if (m & 1) asm volatile("" ::: "memory"); }
    }
};
__device__ __forceinline__ void phase6(const Params& p, LAS unsigned char* lds) {
    expert_map_build((const unsigned*)(p.ws + WS_CTL), lds);
    const int MT = expert_tiles(lds);
    constexpr int kdn = DE;
    unsigned aoff[2][2]; g8::aoff_rows(aoff, kdn);
    for (int unit = blockIdx.x; unit < MT * 4; unit += gridDim.x) {
        const int mt = unit >> 2, pn = unit & 3; int e, local, c; expert_find(lds, mt, e, local, c);
        EpiDN E{(bf16_t*)(p.ws + WS_A + (size_t)T * D * 2), (bf16_t*)(p.ws + WS_A + (size_t)3 * T * D * 2), (const int*)(p.ws + WS_LIST) + (size_t)e * T, (const float*)(p.ws + WS_LISTW) + (size_t)e * T, c, local * 256, pn * 256};
        g8::gemm_unit(lds, (const char*)(p.ws + WS_B) + (size_t)mt * 256 * DE * 2, aoff, (const char*)(p.ws + WS_WDN) + ((size_t)e * D + pn * 256) * DE * 2, kdn, E);
    }
}

__device__ __forceinline__ void phase7(const Params& p) {
    int tid7 = threadIdx.x; asm volatile("" : "+v"(tid7));
    const int wave = tid7 >> 6, lane = tid7 & 63;
    const bf16_t* hb = (const bf16_t*)(p.ws + WS_A);
    const bf16_t* y0 = (const bf16_t*)(p.ws + WS_A + (size_t)T * D * 2); const bf16_t* y1 = y0 + (size_t)T * D;
    f32x4 g[4];
#pragma unroll
    for (int j = 0; j < 4; ++j) g[j] = *((const f32x4*)p.final_g + lane + 64 * j);
    const int stride = gridDim.x * NWAVES;
    int row = blockIdx.x * NWAVES + wave;
    u32x2 hv[4], ya[4], yb[4];
    if (row < T) {
#pragma unroll
        for (int j = 0; j < 4; ++j) { hv[j] = ((const u32x2*)(hb + (size_t)row * D) + lane)[64 * j]; ya[j] = ((const u32x2*)(y0 + (size_t)row * D) + lane)[64 * j]; yb[j] = ((const u32x2*)(y1 + (size_t)row * D) + lane)[64 * j]; }
    }
    for (; row < T; row += stride) {
        f32x4 v[4]; float s = 0.f;
#pragma unroll
        for (int j = 0; j < 4; ++j) {
            v[j][0] = bf16_lo(hv[j].x) + (bf16_lo(ya[j].x) + bf16_lo(yb[j].x)); v[j][1] = bf16_hi(hv[j].x) + (bf16_hi(ya[j].x) + bf16_hi(yb[j].x)); v[j][2] = bf16_lo(hv[j].y) + (bf16_lo(ya[j].y) + bf16_lo(yb[j].y)); v[j][3] = bf16_hi(hv[j].y) + (bf16_hi(ya[j].y) + bf16_hi(yb[j].y));
            s += (v[j][0] * v[j][0] + v[j][1] * v[j][1]) + (v[j][2] * v[j][2] + v[j][3] * v[j][3]); }
        const int nrow = row + stride;
        if (nrow < T) {
#pragma unroll
            for (int j = 0; j < 4; ++j) { hv[j] = ((const u32x2*)(hb + (size_t)nrow * D) + lane)[64 * j]; ya[j] = ((const u32x2*)(y0 + (size_t)nrow * D) + lane)[64 * j]; yb[j] = ((const u32x2*)(y1 + (size_t)nrow * D) + lane)[64 * j]; }
        }
        s = wave_sum(s);
        const float rs = 1.0f / sqrtf(s * (1.0f / D) + 1e-6f);
        f32x4* orow = (f32x4*)(p.out + (size_t)row * D) + lane;
#pragma unroll
        for (int j = 0; j < 4; ++j) orow[64 * j] = v[j] * rs * g[j];
    }
}

__global__ __launch_bounds__(512) void mega(Params p) {
    extern __shared__ __attribute__((aligned(16))) unsigned char lds_raw[];
    LAS unsigned char* lds = (LAS unsigned char*)lds_raw;
    volatile LAS unsigned* bst = (volatile LAS unsigned*)(lds + LDS_MAP + 512);
    if (threadIdx.x == 0) { bst[0] = 0u; bst[1] = 0u; bst[2] = 0u; bst[3] = 0u; }
    __syncthreads();
    const XcdBarrier gb = xcd_barrier_post((unsigned*)(p.ws + WS_BAR), bst);
#define GSYNC() xcd_barrier(gb)
#ifndef PHASE_MASK
#define PHASE_MASK 0xff
#endif
#ifdef TPROBE
    volatile LAS unsigned long long* tsl = (volatile LAS unsigned long long*)(lds + LDS_MAP + 640);
    if (threadIdx.x == 0) tsl[0] = __builtin_amdgcn_s_memrealtime();
#define TS(i) do { if (threadIdx.x == 0 && ((i) == TPROBE || (i) == TPROBE + 1)) tsl[i] = __builtin_amdgcn_s_memrealtime(); } while (0)
#else
#define TS(i)
#endif
    if (PHASE_MASK & 1) phase0(p, lds); GSYNC(); TS(1);
    if (PHASE_MASK & 2) phase1(p, lds); GSYNC(); TS(2);
    if (PHASE_MASK & 4) { phase2a(p); GSYNC(); phase2(p, lds); } GSYNC(); TS(3);
#ifdef RWDEBUG
    {
        bf16_t* dbg = (bf16_t*)(p.ws + WS_A + (size_t)3 * T * D * 2 + 4096);
        float* red = (float*)(p.ws + WS_CTL + 2048);
        if (blockIdx.x == 0) {
            rwkv_chain_seq(p, lds, RWDEBUG_B, RWDEBUG_H, dbg - (size_t)RWDEBUG_B * S * D, 2 * RWDEBUG_C1);
            __syncthreads();
            const bf16_t* mix = (const bf16_t*)(p.ws + WS_B);
            float md = 0.f, mr = 0.f; int bad = 0;
            for (int i = threadIdx.x; i < (RWDEBUG_C1 - RWDEBUG_C0) * 32 * 64; i += NTHREADS) {
                const int t = RWDEBUG_C0 * 32 + i / 64, col = 512 + RWDEBUG_H * 64 + (i % 64);
                const float a = __uint_as_float((unsigned)mix[((size_t)RWDEBUG_B * S + t) * D + col] << 16), r = __uint_as_float((unsigned)dbg[(size_t)t * D + col] << 16);
                if (!(fabsf(a) < 1e30f)) bad++;
                else { md = fmaxf(md, fabsf(a - r)); } mr = fmaxf(mr, fabsf(r));
            }
            LAS float* sh = (LAS float*)lds;
            sh[threadIdx.x] = md; sh[512 + threadIdx.x] = mr; sh[1024 + threadIdx.x] = (float)bad; __syncthreads();
            if (threadIdx.x == 0) { float a = 0.f, r = 0.f, nb = 0.f; for (int i = 0; i < NTHREADS; ++i) { a = fmaxf(a, sh[i]); r = fmaxf(r, sh[512 + i]); nb += sh[1024 + i]; }
                float rel = a / fmaxf(r, 1e-20f); float code = nb > 0.f ? 40.0f : (rel < 0.03f ? 5.0f : (rel < 0.3f ? 10.0f : 20.0f));
                red[0] = code; }
        }
        GSYNC();
        const float code = ((const float*)(p.ws + WS_CTL + 2048))[0];
        for (size_t i = (size_t)blockIdx.x * NTHREADS + threadIdx.x; i < (size_t)T * D; i += (size_t)gridDim.x * NTHREADS) p.out[i] = code;
        return;
    }
#endif
    if (PHASE_MASK & 8) phase3(p, lds); GSYNC(); TS(4);
    if (PHASE_MASK & 16) phase4(p, lds); GSYNC(); TS(5);
    if (PHASE_MASK & 32) phase5(p, lds); GSYNC(); TS(6);
    if (PHASE_MASK & 64) phase6(p, lds); GSYNC(); TS(7);
    if (PHASE_MASK & 128) phase7(p);
#ifdef TPROBE
    GSYNC(); TS(8);
    float* tw = (float*)(p.ws + WS_CTL + 1024);
    if (blockIdx.x == 0 && threadIdx.x == 0) { const float t1 = (float)(tsl[TPROBE + 1] - tsl[TPROBE]) * 0.01f; tw[0] = floorf(log2f(t1) * TPQ + 0.5f) / TPQ; }
    GSYNC();
    const float c1 = tw[0];
    int tq_ = threadIdx.x; asm volatile("" : "+v"(tq_));
    for (size_t i = (size_t)blockIdx.x * NTHREADS + tq_; i < (size_t)T * D; i += (size_t)gridDim.x * NTHREADS) p.out[i] = c1;
#endif
}

extern "C" void kernel_launch(void* const* d_in, const int* in_sizes, int n_in, void* d_out, int out_size, void* d_ws, size_t ws_size, hipStream_t stream) {
    static int grid = 0;
    if (grid == 0) {
        if (n_in != 25 || out_size != T * D || ws_size < WS_END) { fprintf(stderr, "kernel_launch: unexpected sizes n_in %d out %d ws %zu (need %zu)\n", n_in, out_size, ws_size, (size_t)WS_END); grid = -1; return; }
        int dev = 0, cus = 0, per_cu = 0;
        (void)hipGetDevice(&dev); (void)hipDeviceGetAttribute(&cus, hipDeviceAttributeMultiprocessorCount, dev);
        if (hipFuncSetAttribute((const void*)mega, hipFuncAttributeMaxDynamicSharedMemorySize, LDS_BYTES) != hipSuccess) { fprintf(stderr, "kernel_launch: hipFuncSetAttribute failed\n"); grid = -1; return; }
        if (hipOccupancyMaxActiveBlocksPerMultiprocessor(&per_cu, (const void*)mega, NTHREADS, LDS_BYTES) != hipSuccess || per_cu < 1) { fprintf(stderr, "kernel_launch: occupancy query failed (%d)\n", per_cu); (void)hipGetLastError(); per_cu = 1; }
        grid = cus * 1;
    }
    if (grid < 0) return;
    Params p{};
    const float** f = (const float**)&p;
    for (int i = 0; i < 25; ++i) f[i] = (const float*)d_in[i];
    p.out = (float*)d_out; p.ws = (unsigned char*)d_ws;
    if (hipMemsetAsync((char*)d_ws + WS_BAR, 0, XCD_BAR_WORDS * 4, stream) != hipSuccess) { fprintf(stderr, "kernel_launch: memset failed\n"); return; }
    hipLaunchKernelGGL(mega, dim3(grid), dim3(NTHREADS), LDS_BYTES, stream, p);
    hipError_t e = hipPeekAtLastError();
    if (e != hipSuccess) fprintf(stderr, "launch failed: %s (grid %d)\n", hipGetErrorString(e), grid);
}
```

```cpp
#include <hip/hip_runtime.h>
#include <cstdio>
#include <cstdint>
#define TPQ 8.0f

#define LAS __attribute__((address_space(3)))
typedef unsigned short bf16_t;
typedef short bf16x8 __attribute__((ext_vector_type(8)));
typedef short s16x4 __attribute__((ext_vector_type(4)));
typedef float f32x4 __attribute__((ext_vector_type(4)));
typedef float f32x2 __attribute__((ext_vector_type(2)));
typedef float f32x16 __attribute__((ext_vector_type(16)));
typedef unsigned u32x2 __attribute__((ext_vector_type(2)));
typedef unsigned u32x4 __attribute__((ext_vector_type(4)));

constexpr int NB = 16, S = 2048, T = NB * S, D = 1024, NIN = 3328, NH = 8, HD = 64;
constexpr int UQ = 0, UK = 512, UV = 1024, UR = 1536, URK = 2048, URV = 2560, UXW = 3072, UXA = 3136, UXG = 3200;
constexpr int NE = 32, DE = 256;
constexpr float LOG2E = 1.4426950408889634f, LN2 = 0.6931471805599453f;
constexpr float QSCALE = 0.125f * LOG2E;
constexpr int NTHREADS = 512, NWAVES = 8;
constexpr int LDS_BYTES = 161792 + 1024;

constexpr size_t WS_CTL   = 0;
constexpr size_t WS_BAR   = 8192;
constexpr size_t WS_WIN   = 65536;
constexpr size_t WS_WOUT  = WS_WIN  + (size_t)NIN * D * 2;
constexpr size_t WS_WGU   = WS_WOUT + (size_t)D * D * 2;
constexpr size_t WS_WDN   = WS_WGU  + (size_t)NE * 512 * D * 2;
constexpr size_t WS_RSTD1 = WS_WDN  + (size_t)NE * D * DE * 2;
constexpr size_t WS_RSTD2 = WS_RSTD1 + (size_t)T * 4;
constexpr size_t WS_LIST  = WS_RSTD2 + (size_t)T * 4;
constexpr size_t WS_LISTW = WS_LIST + (size_t)NE * T * 4;
constexpr size_t WS_LISTR = WS_LISTW + (size_t)NE * T * 4;
constexpr size_t WS_WR    = WS_LISTR + (size_t)NE * T * 4;
constexpr size_t WS_LT    = WS_WR + (size_t)2 * 48 * D * 2;
constexpr size_t WS_A     = WS_LT + (size_t)512 * 256 * 2;
constexpr size_t WS_B     = WS_A + (size_t)T * NIN * 2;
constexpr size_t WS_END   = WS_B + (size_t)T * D * 2;
constexpr int HID_ROWS = 2 * T + NE * 256;

struct Params {
    const float* x; const float* norm_mix_g; const float* w_in; const float* shift_mu; const float* sb_out_g;
    const float* rw_w0; const float* rw_w2; const float* rw_a0; const float* rw_a2; const float* rw_g2;
    const float* rw_k_k; const float* rw_k_a; const float* rw_r_k; const float* rw_ln_w; const float* rw_ln_b;
    const float* w_out; const float* norm_ffn_g; const float* r_grp_w; const float* r_grp_b; const float* r_exp_w; const float* r_exp_b;
    const float* w_gate; const float* w_up; const float* w_down; const float* final_g;
    float* out; unsigned char* ws;
};

typedef __bf16 bf16x2_t __attribute__((ext_vector_type(2)));
__device__ __forceinline__ unsigned cvt_pk_bf16(float lo, float hi) { const f32x2 v = {lo, hi}; return __builtin_bit_cast(unsigned, __builtin_convertvector(v, bf16x2_t)); }
__device__ __forceinline__ float bf16_lo(unsigned w) { return __uint_as_float(w << 16); }
__device__ __forceinline__ float bf16_hi(unsigned w) { return __uint_as_float(w & 0xffff0000u); }
__device__ __forceinline__ float fexp2(float x) { return __builtin_amdgcn_exp2f(x); }
__device__ __forceinline__ float flog2(float x) { return __builtin_amdgcn_logf(x); }
__device__ __forceinline__ float frcp(float x) { return __builtin_amdgcn_rcpf(x); }
__device__ __forceinline__ float frsq(float x) { return __builtin_amdgcn_rsqf(x); }
template <int CTRL> __device__ __forceinline__ float dppf(float v) { return __builtin_bit_cast(float, __builtin_amdgcn_update_dpp(0, __builtin_bit_cast(int, v), CTRL, 0xF, 0xF, true)); }
__device__ __forceinline__ float rlane(float v, int l) { return __builtin_bit_cast(float, __builtin_amdgcn_readlane(__builtin_bit_cast(int, v), l)); }
__device__ __forceinline__ float sum8(float v) { v += dppf<0xB1>(v); v += dppf<0x4E>(v); v += dppf<0x141>(v); return v; }
__device__ __forceinline__ float sum16(float v) { v = sum8(v); v += dppf<0x140>(v); return v; }
__device__ __forceinline__ float wave_sum(float v) { v = sum16(v); return (rlane(v, 0) + rlane(v, 16)) + (rlane(v, 32) + rlane(v, 48)); }
__device__ __forceinline__ float swap32(float v) { return __shfl_xor(v, 32); }
#define LDS_WAIT() asm volatile("s_waitcnt lgkmcnt(0)" ::: "memory")


#define XB_TMO      128
#define XB_XCNT(j)  (256  + 64 * (j))
#define XB_XSUB(j)  (1280 + 64 * (j))
#define XB_XGEN(j)  (2304 + 64 * (j))
#define XB_TOP      3328
#define XB_TOPGEN   3392
#define XCD_BAR_WORDS 3456
#define XB_SPIN_CAP (1u << 22)
__device__ __forceinline__ unsigned xb_ld(unsigned* p)              { return __hip_atomic_load(p, __ATOMIC_RELAXED, __HIP_MEMORY_SCOPE_AGENT); }
__device__ __forceinline__ unsigned xb_add(unsigned* p, unsigned v) { return __hip_atomic_fetch_add(p, v, __ATOMIC_RELAXED, __HIP_MEMORY_SCOPE_AGENT); }
__device__ __forceinline__ unsigned xb_xcc_id() { return (unsigned)__builtin_amdgcn_s_getreg((3 << 11) | 20) & 0xFu; }
#define XB_SPIN(cond, bar) do { unsigned _sp = 0; while (cond) { __builtin_amdgcn_s_sleep(1); \
    if ((++_sp & 255u) == 0u) { if (xb_ld(&(bar)[XB_TMO])) break; if (_sp > XB_SPIN_CAP) { atomicAdd(&(bar)[XB_TMO], 1u); break; } } } } while (0)
struct XcdBarrier { unsigned* bar; unsigned x; volatile LAS unsigned* st; };
__device__ __forceinline__ XcdBarrier xcd_barrier_post(unsigned* bar, volatile LAS unsigned* st) {
    XcdBarrier b; b.bar = bar; b.x = xb_xcc_id(); b.st = st;
    if (threadIdx.x == 0) (void)xb_add(&bar[XB_XCNT(b.x)], 1u);
    return b;
}
__device__ __forceinline__ void xcd_barrier_complete(unsigned* bar, unsigned x, unsigned& nloc, unsigned& nx) {
    const unsigned G = gridDim.x * gridDim.y * gridDim.z;
    unsigned sum, cnt, mine, sp = 0u;
    for (;;) {
        sum = 0u; cnt = 0u; mine = 0u;
#pragma unroll
        for (unsigned j = 0; j < 16; ++j) { const unsigned c = xb_ld(&bar[XB_XCNT(j)]); sum += c; cnt += (c > 0u) ? 1u : 0u; mine = (j == x) ? c : mine; }
        if (sum == G) break;
        __builtin_amdgcn_s_sleep(1);
        if ((++sp & 255u) == 0u) { if (xb_ld(&bar[XB_TMO])) break; if (sp > XB_SPIN_CAP) { atomicAdd(&bar[XB_TMO], 1u); break; } }
    }
    nloc = mine > 0u ? mine : 1u; nx = cnt > 0u ? cnt : 1u;
}
__device__ __forceinline__ void xcd_barrier(const XcdBarrier& b) {
    asm volatile("s_waitcnt vmcnt(0)" ::: "memory");
    __syncthreads();
    if (threadIdx.x == 0) {
        unsigned* bar = b.bar;
        __builtin_amdgcn_s_waitcnt(0);
        unsigned nloc = b.st[0], nx = b.st[1];
        if (nloc == 0u) { xcd_barrier_complete(bar, b.x, nloc, nx); b.st[0] = nloc; b.st[1] = nx; }
        const unsigned old = xb_add(&bar[XB_XSUB(b.x)], 1u);
        const unsigned gen = old / nloc;
        if (old + 1u == (gen + 1u) * nloc) {
            __builtin_amdgcn_fence(__ATOMIC_RELEASE, "agent");
            asm volatile("s_waitcnt vmcnt(0)" ::: "memory");
            const unsigned og = xb_add(&bar[XB_TOP], 1u);
            const unsigned tg = og / nx;
            if (og + 1u == (tg + 1u) * nx) xb_add(&bar[XB_TOPGEN], 1u);
            else XB_SPIN(xb_ld(&bar[XB_TOPGEN]) == tg, bar);
            __builtin_amdgcn_fence(__ATOMIC_ACQUIRE, "agent");
            xb_add(&bar[XB_XGEN(b.x)], 1u);
            asm volatile("s_waitcnt vmcnt(0)" ::: "memory");
        } else {
            XB_SPIN(xb_ld(&bar[XB_XGEN(b.x)]) == gen, bar);
            __builtin_amdgcn_fence(__ATOMIC_ACQUIRE, "agent");
            asm volatile("s_waitcnt vmcnt(0)" ::: "memory");
        }
    }
    __syncthreads();
}

namespace g8 {
constexpr int BK = 64, HALF = 128, HTB = HALF * BK * 2;
__device__ __forceinline__ int lds_byte(int r, int c) { const int st = (r >> 4) * 2 + (c >> 5), rr = r & 15, cc = c & 31, ob = rr * 64 + cc * 2; return st * 1024 + (ob ^ (((ob >> 9) & 1) << 5)); }
__device__ __forceinline__ void stage_rc(int b, int& R, int& C) { const int st = b / 1024, sb = b % 1024, swz = sb ^ (((sb >> 9) & 1) << 5); R = (st >> 1) * 16 + swz / 64; C = (st & 1) * 32 + (swz % 64) / 2; }

#define G8_SA(b, h) (((b) * 2 + (h)) * HTB)
#define G8_SB(b, h) ((4 + (b) * 2 + (h)) * HTB)
#define G8_STAGE_A(bufoff, h, kt) do { _Pragma("unroll") for (int _i = 0; _i < 2; ++_i) \
    __builtin_amdgcn_global_load_lds((const unsigned*)((Ab + (size_t)(kt) * (BK * 2)) + aoff[h][_i]), (LAS unsigned*)(lds + (bufoff) + ldsw + _i * 8192), 16, 0, 0); } while (0)
#define G8_STAGE_B(bufoff, h, kt) do { _Pragma("unroll") for (int _i = 0; _i < 2; ++_i) \
    __builtin_amdgcn_global_load_lds((const unsigned*)((Bb + (size_t)(h) * bhalf + (size_t)(kt) * (BK * 2)) + boff[_i]), (LAS unsigned*)(lds + (bufoff) + ldsw + _i * 8192), 16, 0, 0); } while (0)
#define G8_LDA(dst, b, h) do { _Pragma("unroll") for (int m = 0; m < 4; ++m) _Pragma("unroll") for (int k = 0; k < 2; ++k) dst[m][k] = *(const LAS bf16x8*)(lds + G8_SA(b, h) + la_off + m * 2048 + k * 1024); } while (0)
#define G8_LDB(dst, b, h) do { _Pragma("unroll") for (int n = 0; n < 2; ++n) _Pragma("unroll") for (int k = 0; k < 2; ++k) dst[n][k] = *(const LAS bf16x8*)(lds + G8_SB(b, h) + lb_off + n * 2048 + k * 1024); } while (0)
#define G8_MMA(ai, bj, At, Bt) do { __builtin_amdgcn_s_setprio(1); _Pragma("unroll") for (int m = 0; m < 4; ++m) _Pragma("unroll") for (int n = 0; n < 2; ++n) _Pragma("unroll") for (int k = 0; k < 2; ++k) \
    acc[ai][bj][m][n] = __builtin_amdgcn_mfma_f32_16x16x32_bf16(Bt[n][k], At[m][k], acc[ai][bj][m][n], 0, 0, 0); __builtin_amdgcn_s_setprio(0); } while (0)
#define G8_WAIT_V(n) asm volatile("s_waitcnt vmcnt(" #n ")" ::: "memory")
#define G8_WAIT_L(n) asm volatile("s_waitcnt lgkmcnt(" #n ")" ::: "memory")
#define G8_BAR __builtin_amdgcn_s_barrier()
#define G8_SCHED __builtin_amdgcn_sched_barrier(0)

template <class Epi>
__device__ __forceinline__ void gemm_unit(LAS unsigned char* lds, const char* Ab, const unsigned (&aoff)[2][2], const char* Bb, int K, const Epi& E, const unsigned* meta0 = nullptr, const unsigned* meta1 = nullptr) {
    int tid = threadIdx.x; asm volatile("" : "+v"(tid));
    const int wid = __builtin_amdgcn_readfirstlane(tid >> 6), lane = tid & 63, wr = wid >> 2, wc = wid & 3, fr = lane & 15, fq = lane >> 4;
    const int nt = K / BK;
    unsigned boff[2];
#pragma unroll
    for (int i = 0; i < 2; ++i) { int R, C; stage_rc(tid * 16 + i * 8192, R, C); const int rho = R & 31, Rb = (R & ~31) + 8 * ((rho & 15) >> 2) + 4 * (rho >> 4) + (rho & 3);
        boff[i] = (unsigned)(Rb * K + C) * 2u; }
    const size_t bhalf = (size_t)HALF * K * 2;
    const unsigned ldsw = (unsigned)wid * 1024u;
    const int la_off = lds_byte(wr * 64 + fr, fq * 8), lb_off = lds_byte(wc * 32 + fr, fq * 8);
    f32x4 acc[2][2][4][2];
#pragma unroll
    for (int a = 0; a < 2; ++a)
#pragma unroll
        for (int b = 0; b < 2; ++b)
#pragma unroll
            for (int m = 0; m < 4; ++m)
#pragma unroll
                for (int n = 0; n < 2; ++n) acc[a][b][m][n] = (f32x4){0.f, 0.f, 0.f, 0.f};
    bf16x8 At[4][2], B0[2][2], B1[2][2];
    if (meta0) { if (wid < 4) __builtin_amdgcn_global_load_lds(meta0 + wid * 64 + lane, (LAS unsigned*)(lds + 131072 + wid * 256), 4, 0, 0);
                 else if (meta1) __builtin_amdgcn_global_load_lds(meta1 + (wid - 4) * 64 + lane, (LAS unsigned*)(lds + 131072 + 1024 + (wid - 4) * 256), 4, 0, 0); }
    G8_STAGE_B(G8_SB(0, 0), 0, 0); G8_STAGE_A(G8_SA(0, 0), 0, 0);
    G8_STAGE_B(G8_SB(0, 1), 1, 0); G8_STAGE_A(G8_SA(0, 1), 1, 0);
    if (wr == 1) G8_BAR;
    G8_WAIT_V(4); G8_BAR;
    G8_STAGE_B(G8_SB(1, 0), 0, 1); G8_STAGE_A(G8_SA(1, 0), 0, 1); G8_STAGE_B(G8_SB(1, 1), 1, 1);
    G8_WAIT_V(6); G8_BAR;
    for (int t = 0; t < nt - 2; t += 2) {
        G8_LDB(B0, 0, 0); G8_SCHED; G8_LDA(At, 0, 0); G8_STAGE_A(G8_SA(1, 1), 1, t + 1);
        G8_WAIT_L(8); G8_BAR; G8_WAIT_L(0); G8_MMA(0, 0, At, B0); G8_BAR; G8_SCHED;
        G8_LDB(B1, 0, 1); G8_STAGE_B(G8_SB(0, 0), 0, t + 2);
        G8_BAR; G8_WAIT_L(0); G8_MMA(0, 1, At, B1); G8_BAR;
        G8_LDA(At, 0, 1); G8_STAGE_A(G8_SA(0, 0), 0, t + 2);
        G8_BAR; G8_WAIT_L(0); G8_MMA(1, 0, At, B0); G8_BAR; G8_SCHED;
        G8_STAGE_B(G8_SB(0, 1), 1, t + 2);
        G8_WAIT_V(6); G8_BAR; G8_MMA(1, 1, At, B1); G8_BAR;
        G8_LDB(B0, 1, 0); G8_SCHED; G8_LDA(At, 1, 0); G8_STAGE_A(G8_SA(0, 1), 1, t + 2);
        G8_WAIT_L(8); G8_BAR; G8_WAIT_L(0); G8_MMA(0, 0, At, B0); G8_BAR; G8_SCHED;
        G8_LDB(B1, 1, 1); G8_STAGE_B(G8_SB(1, 0), 0, t + 3);
        G8_BAR; G8_WAIT_L(0); G8_MMA(0, 1, At, B1); G8_BAR;
        G8_LDA(At, 1, 1); G8_STAGE_A(G8_SA(1, 0), 0, t + 3);
        G8_BAR; G8_WAIT_L(0); G8_MMA(1, 0, At, B0); G8_BAR; G8_SCHED;
        G8_STAGE_B(G8_SB(1, 1), 1, t + 3);
        G8_WAIT_V(6); G8_BAR; G8_MMA(1, 1, At, B1); G8_BAR;
    }
    { G8_LDB(B0, 0, 0); G8_LDA(At, 0, 0); G8_STAGE_A(G8_SA(1, 1), 1, nt - 1);
      G8_BAR; G8_WAIT_L(0); G8_MMA(0, 0, At, B0); G8_BAR;
      G8_LDB(B1, 0, 1); G8_BAR; G8_WAIT_L(0); G8_MMA(0, 1, At, B1); G8_BAR;
      G8_LDA(At, 0, 1); G8_WAIT_V(4); G8_BAR; G8_WAIT_L(0); G8_MMA(1, 0, At, B0); G8_MMA(1, 1, At, B1); G8_BAR; }
    { G8_LDB(B0, 1, 0); G8_LDA(At, 1, 0); G8_WAIT_V(2); G8_BAR; G8_WAIT_L(0); G8_MMA(0, 0, At, B0); G8_BAR;
      G8_LDB(B1, 1, 1); G8_WAIT_V(0); G8_BAR; G8_WAIT_L(0); G8_MMA(0, 1, At, B1); G8_BAR;
      G8_LDA(At, 1, 1); G8_BAR; G8_WAIT_L(0); G8_MMA(1, 0, At, B0); G8_MMA(1, 1, At, B1); G8_BAR; }
    if (wr == 0) G8_BAR;
    asm volatile("" ::: "memory");
    unsigned m0[8], m1[8];
#pragma unroll
    for (int ai = 0; ai < 2; ++ai)
#pragma unroll
        for (int m = 0; m < 4; ++m) { const int rl = ai * 128 + wr * 64 + m * 16 + fr; m0[ai * 4 + m] = ((const LAS unsigned*)(lds + 131072))[rl]; m1[ai * 4 + m] = ((const LAS unsigned*)(lds + 131072 + 1024))[rl]; }
    E(acc, m0, m1, wr, wc, fr, fq);
    __syncthreads();
}

struct UnitIO { const char* Ab; const char* Bb; const unsigned* meta0; const unsigned* meta1; unsigned aoff[2][2]; };
#define G8_STAGE_AX(bufoff, h, kt, AB, AOFF) do { _Pragma("unroll") for (int _i = 0; _i < 2; ++_i) \
    __builtin_amdgcn_global_load_lds((const unsigned*)(((AB) + (size_t)(kt) * (BK * 2)) + (AOFF)[h][_i]), (LAS unsigned*)(lds + (bufoff) + ldsw + _i * 8192), 16, 0, 0); } while (0)
#define G8_STAGE_BX(bufoff, h, kt, BB) do { _Pragma("unroll") for (int _i = 0; _i < 2; ++_i) \
    __builtin_amdgcn_global_load_lds((const unsigned*)(((BB) + (size_t)(h) * bhalf + (size_t)(kt) * (BK * 2)) + boff[_i]), (LAS unsigned*)(lds + (bufoff) + ldsw + _i * 8192), 16, 0, 0); } while (0)
template <int N> __device__ __forceinline__ void wait_v() { asm volatile("s_waitcnt vmcnt(%0)" :: "n"(N) : "memory"); }
template <int NEPI, class Epi>
__device__ __forceinline__ void gemm_unit_p(LAS unsigned char* lds, const UnitIO& io, int K, const Epi& E, int parity, bool primed, bool has_next, const UnitIO& nx) {
    int tid = threadIdx.x; asm volatile("" : "+v"(tid));
    const int wid = __builtin_amdgcn_readfirstlane(tid >> 6), lane = tid & 63, wr = wid >> 2, wc = wid & 3, fr = lane & 15, fq = lane >> 4;
    const int nt = K / BK;
    unsigned boff[2];
#pragma unroll
    for (int i = 0; i < 2; ++i) { int R, C; stage_rc(tid * 16 + i * 8192, R, C); const int rho = R & 31, Rb = (R & ~31) + 8 * ((rho & 15) >> 2) + 4 * (rho >> 4) + (rho & 3);
        boff[i] = (unsigned)(Rb * K + C) * 2u; }
    const size_t bhalf = (size_t)HALF * K * 2;
    const unsigned ldsw = (unsigned)wid * 1024u;
    const int la_off = lds_byte(wr * 64 + fr, fq * 8), lb_off = lds_byte(wc * 32 + fr, fq * 8);
    const char* Ab = io.Ab; const char* Bb = io.Bb; const unsigned (&aoff)[2][2] = io.aoff;
    f32x4 acc[2][2][4][2];
#pragma unroll
    for (int a = 0; a < 2; ++a)
#pragma unroll
        for (int b = 0; b < 2; ++b)
#pragma unroll
            for (int m = 0; m < 4; ++m)
#pragma unroll
                for (int n = 0; n < 2; ++n) acc[a][b][m][n] = (f32x4){0.f, 0.f, 0.f, 0.f};
    bf16x8 At[4][2], B0[2][2], B1[2][2];
    LAS unsigned char* mbuf = lds + 131072 + parity * 2048;
    if (!primed) {
        if (io.meta0) { if (wid < 4) __builtin_amdgcn_global_load_lds(io.meta0 + wid * 64 + lane, (LAS unsigned*)(mbuf + wid * 256), 4, 0, 0);
                        else if (io.meta1) __builtin_amdgcn_global_load_lds(io.meta1 + (wid - 4) * 64 + lane, (LAS unsigned*)(mbuf + 1024 + (wid - 4) * 256), 4, 0, 0); }
        G8_STAGE_B(G8_SB(0, 0), 0, 0); G8_STAGE_A(G8_SA(0, 0), 0, 0);
        G8_STAGE_B(G8_SB(0, 1), 1, 0); G8_STAGE_A(G8_SA(0, 1), 1, 0);
        if (wr == 1) G8_BAR;
        G8_WAIT_V(4); G8_BAR;
        G8_STAGE_B(G8_SB(1, 0), 0, 1); G8_STAGE_A(G8_SA(1, 0), 0, 1); G8_STAGE_B(G8_SB(1, 1), 1, 1);
        G8_WAIT_V(6); G8_BAR;
    } else {
        if (wr == 1) G8_BAR;
        wait_v<4 + NEPI>(); G8_BAR;
        G8_STAGE_B(G8_SB(1, 0), 0, 1); G8_STAGE_A(G8_SA(1, 0), 0, 1); G8_STAGE_B(G8_SB(1, 1), 1, 1);
        wait_v<6 + NEPI>(); G8_BAR;
    }
    for (int t = 0; t < nt - 2; t += 2) {
        G8_LDB(B0, 0, 0); G8_SCHED; G8_LDA(At, 0, 0); G8_STAGE_A(G8_SA(1, 1), 1, t + 1);
        G8_WAIT_L(8); G8_BAR; G8_WAIT_L(0); G8_MMA(0, 0, At, B0); G8_BAR; G8_SCHED;
        G8_LDB(B1, 0, 1); G8_STAGE_B(G8_SB(0, 0), 0, t + 2);
        G8_BAR; G8_WAIT_L(0); G8_MMA(0, 1, At, B1); G8_BAR;
        G8_LDA(At, 0, 1); G8_STAGE_A(G8_SA(0, 0), 0, t + 2);
        G8_BAR; G8_WAIT_L(0); G8_MMA(1, 0, At, B0); G8_BAR; G8_SCHED;
        G8_STAGE_B(G8_SB(0, 1), 1, t + 2);
        G8_WAIT_V(6); G8_BAR; G8_MMA(1, 1, At, B1); G8_BAR;
        G8_LDB(B0, 1, 0); G8_SCHED; G8_LDA(At, 1, 0); G8_STAGE_A(G8_SA(0, 1), 1, t + 2);
        G8_WAIT_L(8); G8_BAR; G8_WAIT_L(0); G8_MMA(0, 0, At, B0); G8_BAR; G8_SCHED;
        G8_LDB(B1, 1, 1); G8_STAGE_B(G8_SB(1, 0), 0, t + 3);
        G8_BAR; G8_WAIT_L(0); G8_MMA(0, 1, At, B1); G8_BAR;
        G8_LDA(At, 1, 1); G8_STAGE_A(G8_SA(1, 0), 0, t + 3);
        G8_BAR; G8_WAIT_L(0); G8_MMA(1, 0, At, B0); G8_BAR; G8_SCHED;
        G8_STAGE_B(G8_SB(1, 1), 1, t + 3);
        G8_WAIT_V(6); G8_BAR; G8_MMA(1, 1, At, B1); G8_BAR;
    }
    { G8_LDB(B0, 0, 0); G8_LDA(At, 0, 0); G8_STAGE_A(G8_SA(1, 1), 1, nt - 1);
      G8_BAR; G8_WAIT_L(0); G8_MMA(0, 0, At, B0); G8_BAR;
      G8_LDB(B1, 0, 1); G8_BAR; G8_WAIT_L(0); G8_MMA(0, 1, At, B1); G8_BAR;
      G8_LDA(At, 0, 1); G8_WAIT_V(4); G8_BAR; G8_WAIT_L(0); G8_MMA(1, 0, At, B0); G8_MMA(1, 1, At, B1); G8_BAR; }
    { G8_LDB(B0, 1, 0); G8_LDA(At, 1, 0); G8_WAIT_V(2); G8_BAR; G8_WAIT_L(0); G8_MMA(0, 0, At, B0); G8_BAR;
      G8_LDB(B1, 1, 1); G8_WAIT_V(0); G8_BAR; G8_WAIT_L(0); G8_MMA(0, 1, At, B1); G8_BAR;
      G8_LDA(At, 1, 1); G8_BAR; G8_WAIT_L(0); G8_MMA(1, 0, At, B0); G8_MMA(1, 1, At, B1); G8_BAR; }
    if (wr == 0) G8_BAR;
    asm volatile("" ::: "memory");
    unsigned m0[8], m1[8];
#pragma unroll
    for (int ai = 0; ai < 2; ++ai)
#pragma unroll
        for (int m = 0; m < 4; ++m) { const int rl = ai * 128 + wr * 64 + m * 16 + fr; m0[ai * 4 + m] = ((const LAS unsigned*)mbuf)[rl]; m1[ai * 4 + m] = ((const LAS unsigned*)(mbuf + 1024))[rl]; }
    G8_WAIT_L(0);
    if (has_next) {
        LAS unsigned char* nb = lds + 131072 + (parity ^ 1) * 2048;
        if (nx.meta0) { if (wid < 4) __builtin_amdgcn_global_load_lds(nx.meta0 + wid * 64 + lane, (LAS unsigned*)(nb + wid * 256), 4, 0, 0);
                        else if (nx.meta1) __builtin_amdgcn_global_load_lds(nx.meta1 + (wid - 4) * 64 + lane, (LAS unsigned*)(nb + 1024 + (wid - 4) * 256), 4, 0, 0); }
        G8_STAGE_BX(G8_SB(0, 0), 0, 0, nx.Bb); G8_STAGE_AX(G8_SA(0, 0), 0, 0, nx.Ab, nx.aoff);
        G8_STAGE_BX(G8_SB(0, 1), 1, 0, nx.Bb); G8_STAGE_AX(G8_SA(0, 1), 1, 0, nx.Ab, nx.aoff);
        asm volatile("" ::: "memory");
    }
    E(acc, m0, m1, wr, wc, fr, fq);
    if (!has_next) __syncthreads();
}
__device__ __forceinline__ void aoff_rows(unsigned (&aoff)[2][2], int K) {
    int tid = threadIdx.x; asm volatile("" : "+v"(tid));
#pragma unroll
    for (int i = 0; i < 2; ++i) { int R, C; stage_rc(tid * 16 + i * 8192, R, C);
#pragma unroll
        for (int h = 0; h < 2; ++h) aoff[h][i] = (unsigned)((h * HALF + R) * K + C) * 2u; }
}
__device__ __forceinline__ void tile_order(int L, int nM, int nN, int& pm, int& pn) {
    const int nwg = nM * nN; int wgid = L;
    { const int q = nwg / 8, r = nwg % 8, xcd = wgid % 8, off = wgid / 8; wgid = (xcd < r ? xcd * (q + 1) : r * (q + 1) + (xcd - r) * q) + off; }
    const int nig = 8 * nN, gid = wgid / nig, fm = gid * 8, gsz = (nM - fm) < 8 ? (nM - fm) : 8;
    pm = fm + ((wgid % nig) % gsz); pn = (wgid % nig) / gsz;
}
}

__device__ __forceinline__ void p0_transpose_item(const float* W, int K, int N, int k0, int n0, bf16_t* WTrow0  , const float* kscale, float mul, LAS float* scr, int lane) {
#pragma unroll 8
    for (int i = 0; i < 32; ++i) { const int kk = 2 * i + (lane >> 5); float v = W[(size_t)(k0 + kk) * N + n0 + (lane & 31)]; if (kscale) v *= kscale[k0 + kk]; scr[kk * 33 + (lane & 31)] = v * mul; }
    LDS_WAIT();
    const int c = lane & 7;
#pragma unroll
    for (int j = 0; j < 4; ++j) { const int n = (lane >> 3) + 8 * j; const LAS float* s = scr + (8 * c) * 33 + n;
        u32x4 o; o.x = cvt_pk_bf16(s[0 * 33], s[1 * 33]); o.y = cvt_pk_bf16(s[2 * 33], s[3 * 33]); o.z = cvt_pk_bf16(s[4 * 33], s[5 * 33]); o.w = cvt_pk_bf16(s[6 * 33], s[7 * 33]);
        *(u32x4*)(WTrow0 + (size_t)n * K + k0 + 8 * c) = o; }
    LDS_WAIT();
}

__device__ __forceinline__ void p0_transpose64(const float* W, int K, int N, int k0, int n0, bf16_t* WTrow0  , const float* kscale, LAS float* scr, int lane) {
    const int rq = lane >> 4, c4 = 4 * (lane & 15);
    f32x4 v[16];
#pragma unroll
    for (int i = 0; i < 16; ++i) v[i] = *(const f32x4*)(W + (size_t)(k0 + 4 * i + rq) * N + n0 + c4);
    if (kscale) {
#pragma unroll
        for (int i = 0; i < 16; ++i) v[i] = v[i] * kscale[k0 + 4 * i + rq];
    }
#pragma unroll
    for (int i = 0; i < 16; ++i) { LAS float* d = scr + (4 * i + rq) * 65 + c4; d[0] = v[i][0]; d[1] = v[i][1]; d[2] = v[i][2]; d[3] = v[i][3]; }
    LDS_WAIT();
#pragma unroll
    for (int c = 0; c < 8; ++c) { const LAS float* sp = scr + (8 * c) * 65 + lane;
        u32x4 o; o.x = cvt_pk_bf16(sp[0], sp[65]); o.y = cvt_pk_bf16(sp[2 * 65], sp[3 * 65]); o.z = cvt_pk_bf16(sp[4 * 65], sp[5 * 65]); o.w = cvt_pk_bf16(sp[6 * 65], sp[7 * 65]);
        *(u32x4*)(WTrow0 + (size_t)lane * K + k0 + 8 * c) = o; }
    LDS_WAIT();
}
__device__ __forceinline__ void p0_expert_weights(const Params& p, LAS unsigned char* lds, int gw, int NGW) {
    int tid = threadIdx.x; asm volatile("" : "+v"(tid));
    const int wave = tid >> 6, lane = tid & 63;
    LAS float* scr = (LAS float*)(lds + wave * 16640);
    bf16_t* wgu = (bf16_t*)(p.ws + WS_WGU); bf16_t* wdn = (bf16_t*)(p.ws + WS_WDN);
    constexpr int I_G = NE * 16 * 4, I_D = NE * 4 * 16;
    for (int it = gw; it < 2 * I_G + I_D; it += NGW) {
        int r = it;
        if (r < 2 * I_G) { const int up = r >= I_G; if (up) r -= I_G; const int e = r / 64, q = r % 64, kb = q / 4, nb = q % 4, n0 = nb * 64;
            const int drow = (n0 >> 7) * 256 + up * 128 + (n0 & 127);
            p0_transpose64((up ? p.w_up : p.w_gate) + (size_t)e * D * DE, D, DE, kb * 64, n0, wgu + ((size_t)e * 512 + drow) * D, p.norm_ffn_g, scr, lane); continue; } r -= 2 * I_G;
        { const int e = r / 64, q = r % 64, kb = q / 16, nb = q % 16, n0 = nb * 64;
            p0_transpose64(p.w_down + (size_t)e * DE * D, DE, D, kb * 64, n0, wdn + ((size_t)e * D + n0) * DE, nullptr, scr, lane); }
    }
}
__device__ __forceinline__ void phase0(const Params& p, LAS unsigned char* lds) {
    int tid = threadIdx.x; asm volatile("" : "+v"(tid));
    const int wave = tid >> 6, lane = tid & 63;
    const int gw = blockIdx.x * NWAVES + wave, NGW = gridDim.x * NWAVES;
    LAS float* scr = (LAS float*)(lds + wave * 8704);
    bf16_t* win = (bf16_t*)(p.ws + WS_WIN); bf16_t* wout = (bf16_t*)(p.ws + WS_WOUT);
    constexpr int I_IN = 16 * 104, I_OUT = 16 * 32;
    for (int it = gw; it < I_IN + I_OUT; it += NGW) {
        int r = it;
        if (r < I_IN) { const int kb = r / 104, nb = r % 104, n0 = nb * 32; p0_transpose_item(p.w_in, D, NIN, kb * 64, n0, win + (size_t)n0 * D, p.norm_mix_g, n0 < 512 ? QSCALE : 1.f, scr, lane); continue; } r -= I_IN;
        { const int kb = r / 32, nb = r % 32, n0 = nb * 32; p0_transpose_item(p.w_out, D, D, kb * 64, n0, wout + (size_t)n0 * D, nullptr, 1.f, scr, lane); }
    }
    bf16_t* xb = (bf16_t*)(p.ws + WS_B); float* rstd1 = (float*)(p.ws + WS_RSTD1);
    {
        f32x4 nv[4];
        if (gw < T) {
#pragma unroll
            for (int j = 0; j < 4; ++j) nv[j] = ((const f32x4*)(p.x + (size_t)gw * D) + lane)[64 * j];
        }
        for (int row = gw; row < T; row += NGW) {
            f32x4 v[4]; float s = 0.f;
#pragma unroll
            for (int j = 0; j < 4; ++j) { v[j] = nv[j]; s += (v[j].x * v[j].x + v[j].y * v[j].y) + (v[j].z * v[j].z + v[j].w * v[j].w); }
            if (row + NGW < T) {
#pragma unroll
                for (int j = 0; j < 4; ++j) nv[j] = ((const f32x4*)(p.x + (size_t)(row + NGW) * D) + lane)[64 * j];
            }
            s = wave_sum(s);
            u32x2* o = (u32x2*)(xb + (size_t)row * D) + lane;
#pragma unroll
            for (int j = 0; j < 4; ++j) { u32x2 w; w.x = cvt_pk_bf16(v[j].x, v[j].y); w.y = cvt_pk_bf16(v[j].z, v[j].w); o[64 * j] = w; }
            if (lane == 0) rstd1[row] = 1.0f / sqrtf(s * (1.0f / D) + 1e-6f);
        }
    }
    bf16_t* wr_hi = (bf16_t*)(p.ws + WS_WR); bf16_t* wr_lo = wr_hi + 48 * D;
    for (int i = blockIdx.x * NTHREADS + tid; i < 48 * D; i += gridDim.x * NTHREADS) {
        const int c = i / D, k = i % D; float w = 0.f;
        if (c < 4) w = p.r_grp_w[k * 4 + c]; else if (c < 36) w = p.r_exp_w[k * 32 + (c - 4)];
        w *= p.norm_ffn_g[k];
        const unsigned hi = cvt_pk_bf16(w, 0.f) & 0xffffu; const float rem = w - __uint_as_float(hi << 16);
        wr_hi[i] = (bf16_t)hi; wr_lo[i] = (bf16_t)(cvt_pk_bf16(rem, 0.f) & 0xffffu);
    }
    { bf16_t* w2t = (bf16_t*)(p.ws + WS_LT); bf16_t* a2t = w2t + 512 * 64; bf16_t* g2t = a2t + 512 * 64;
      for (int i = blockIdx.x * NTHREADS + tid; i < 512 * 256; i += gridDim.x * NTHREADS) {
          if (i < 512 * 64) { const int c = i >> 6, m = i & 63; w2t[i] = (bf16_t)(cvt_pk_bf16(p.rw_w2[m * 512 + c], 0.f) & 0xffffu); }
          else if (i < 2 * 512 * 64) { const int q = i - 512 * 64, c = q >> 6, m = q & 63; a2t[q] = (bf16_t)(cvt_pk_bf16(p.rw_a2[m * 512 + c], 0.f) & 0xffffu); }
          else { const int q = i - 2 * 512 * 64, c = q >> 7, m = q & 127; g2t[q] = (bf16_t)(cvt_pk_bf16(p.rw_g2[m * 512 + c], 0.f) & 0xffffu); } } }
    if (blockIdx.x == 0 && tid < 64) ((unsigned*)(p.ws + WS_CTL))[tid] = 0u;
}

struct EpiU {
    bf16_t* u; const float* rstd; int row0, col0;
    __device__ __forceinline__ void operator()(const f32x4 (&acc)[2][2][4][2], const unsigned (&m0)[8], const unsigned (&m1)[8], int wr, int wc, int fr, int fq) const {
#pragma unroll
        for (int ai = 0; ai < 2; ++ai)
#pragma unroll
            for (int m = 0; m < 4; ++m) { const int rl = ai * 128 + wr * 64 + m * 16 + fr, row = row0 + rl; const float rs = __uint_as_float(m0[ai * 4 + m]); bf16_t* rp = u + (size_t)row * NIN + col0 + wc * 32 + 8 * fq;
#pragma unroll
                for (int bj = 0; bj < 2; ++bj) { const f32x4 v0 = acc[ai][bj][m][0] * rs, v1 = acc[ai][bj][m][1] * rs;
                    *(u32x4*)(rp + bj * 128) = (u32x4){cvt_pk_bf16(v0[0], v0[1]), cvt_pk_bf16(v0[2], v0[3]), cvt_pk_bf16(v1[0], v1[1]), cvt_pk_bf16(v1[2], v1[3])}; } }
    }
};
__device__ __forceinline__ void phase1(const Params& p, LAS unsigned char* lds) {
    constexpr int nM = T / 256, nN = NIN / 256;
    g8::UnitIO cur, nxt; g8::aoff_rows(cur.aoff, D);
#pragma unroll
    for (int a = 0; a < 2; ++a)
#pragma unroll
        for (int b = 0; b < 2; ++b) nxt.aoff[a][b] = cur.aoff[a][b];
    cur.meta1 = nullptr; nxt.meta1 = nullptr;
    int pm, pn; int L = blockIdx.x;
    if (L < nM * nN) { g8::tile_order(L, nM, nN, pm, pn); cur.Ab = (const char*)(p.ws + WS_B) + (size_t)pm * 256 * D * 2; cur.Bb = (const char*)(p.ws + WS_WIN) + (size_t)pn * 256 * D * 2; cur.meta0 = (const unsigned*)(p.ws + WS_RSTD1) + pm * 256; }
    for (int i = 0; L < nM * nN; L += gridDim.x, ++i) {
        const bool hn = L + (int)gridDim.x < nM * nN; int pm2 = 0, pn2 = 0;
        if (hn) { g8::tile_order(L + gridDim.x, nM, nN, pm2, pn2); nxt.Ab = (const char*)(p.ws + WS_B) + (size_t)pm2 * 256 * D * 2; nxt.Bb = (const char*)(p.ws + WS_WIN) + (size_t)pn2 * 256 * D * 2; nxt.meta0 = (const unsigned*)(p.ws + WS_RSTD1) + pm2 * 256; }
        EpiU E{(bf16_t*)(p.ws + WS_A), (const float*)(p.ws + WS_RSTD1), pm * 256, pn * 256};
        g8::gemm_unit_p<16>(lds, cur, D, E, i & 1, i > 0, hn, nxt);
        cur.Ab = nxt.Ab; cur.Bb = nxt.Bb; cur.meta0 = nxt.meta0; pm = pm2; pn = pn2;
    }
}


typedef short v4i16_t __attribute__((ext_vector_type(4)));
__device__ __forceinline__ s16x4 lds_tr16(const LAS unsigned char* p) { return __builtin_bit_cast(s16x4, __builtin_amdgcn_ds_read_tr16_b64_v4i16((LAS v4i16_t*)p)); }

__device__ __forceinline__ void attn_tile(const Params& p, LAS unsigned char* vl  , int b, int h, int qt) {
    const int lane = threadIdx.x & 63, r32 = lane & 31, hi = lane >> 5;
    const bf16_t* u = (const bf16_t*)(p.ws + WS_A);
    const size_t row0 = (size_t)b * S; const int q0 = qt * 32;
    bf16x8 qf[4];
    { const bf16_t* qp = u + (row0 + q0 + r32) * NIN + UQ + h * HD + 8 * hi;
#pragma unroll
      for (int s = 0; s < 4; ++s) qf[s] = *(const bf16x8*)(qp + 16 * s); }
    f32x16 o0, o1;
#pragma unroll
    for (int i = 0; i < 16; ++i) { o0[i] = 0.f; o1[i] = 0.f; }
    float carry = 0.f;
    const int kperm = 16 * ((r32 >> 2) & 1) + (r32 & 3) + 4 * (r32 >> 3);
    const int g = lane >> 4, i16 = lane & 15, tq = i16 >> 2, tp = i16 & 3;
    const LAS unsigned char* vrd = vl + (16 * (g >> 1) + tq) * 144 + (16 * (g & 1) + 4 * tp) * 2;
    LAS unsigned char* kl = vl + 4608;
    const int lrow = lane >> 3, lchk = lane & 7;
    const bf16_t* kvp = u + (row0 + lrow) * NIN + h * HD + lchk * 8;
    u32x4 kreg[4], vreg[4];
#pragma unroll
    for (int i = 0; i < 4; ++i) { const bf16_t* a = kvp + (size_t)(qt * 32 + 8 * i) * NIN; kreg[i] = *(const u32x4*)(a + UK); vreg[i] = *(const u32x4*)(a + UV); }
    for (int kb = qt; kb >= 0; --kb) {
        const int key0 = kb * 32;
#pragma unroll
        for (int i = 0; i < 4; ++i) { *(LAS u32x4*)(kl + (8 * i + lrow) * 144 + lchk * 16) = kreg[i]; *(LAS u32x4*)(vl + (8 * i + lrow) * 144 + lchk * 16) = vreg[i]; }
        if (kb > 0) {
#pragma unroll
            for (int i = 0; i < 4; ++i) { const bf16_t* a = kvp + (size_t)(key0 - 32 + 8 * i) * NIN; kreg[i] = *(const u32x4*)(a + UK); vreg[i] = *(const u32x4*)(a + UV); }
        }
        LDS_WAIT();
        f32x16 st;
#pragma unroll
        for (int i = 0; i < 16; ++i) st[i] = 0.f;
        { const LAS unsigned char* kp = kl + kperm * 144 + 16 * hi;
          bf16x8 kf[4];
#pragma unroll
          for (int s = 0; s < 4; ++s) kf[s] = *(const LAS bf16x8*)(kp + 32 * s);
#pragma unroll
          for (int s = 0; s < 4; ++s) st = __builtin_amdgcn_mfma_f32_32x32x16_bf16(kf[s], qf[s], st, 0, 0, 0); }
        const bool diag = (kb == qt);
        float lw[16], suf[16];
        float run = 0.f;
#pragma unroll
        for (int reg = 15; reg >= 0; --reg) {
            const float z = st[reg];
            const float l = flog2(1.0f + fexp2(-fabsf(z)));
            const float sp = fmaxf(z, 0.f) + l;
            const bool valid = !diag || (16 * hi + reg < r32);
            lw[reg] = valid ? (z - sp) : -1.0e30f;
            suf[reg] = run;
            run += valid ? -sp : 0.f;
        }
        const float other = swap32(run);
        const float tot_hi = hi ? run : other, tot_lo = hi ? other : run;
        const float base = carry + (hi ? 0.f : tot_hi);
        carry += tot_lo + tot_hi;
        unsigned pk[8];
#pragma unroll
        for (int j = 0; j < 8; ++j) pk[j] = cvt_pk_bf16(fexp2(lw[2 * j] + suf[2 * j] + base), fexp2(lw[2 * j + 1] + suf[2 * j + 1] + base));
        LDS_WAIT();
#pragma unroll
        for (int s2 = 0; s2 < 2; ++s2) {
            bf16x8 pf = __builtin_bit_cast(bf16x8, (u32x4){pk[4 * s2], pk[4 * s2 + 1], pk[4 * s2 + 2], pk[4 * s2 + 3]});
#pragma unroll
            for (int dh = 0; dh < 2; ++dh) {
                const s16x4 a = lds_tr16(vrd + (8 * s2) * 144 + 64 * dh), c = lds_tr16(vrd + (8 * s2 + 4) * 144 + 64 * dh);
                bf16x8 vf; vf[0] = a[0]; vf[1] = a[1]; vf[2] = a[2]; vf[3] = a[3]; vf[4] = c[0]; vf[5] = c[1]; vf[6] = c[2]; vf[7] = c[3];
                if (dh == 0) o0 = __builtin_amdgcn_mfma_f32_32x32x16_bf16(vf, pf, o0, 0, 0, 0); else o1 = __builtin_amdgcn_mfma_f32_32x32x16_bf16(vf, pf, o1, 0, 0, 0);
            }
        }
        LDS_WAIT();
        if (__builtin_amdgcn_ballot_w64(carry > -150.0f) == 0ull) break;
    }
    float ss = 0.f;
#pragma unroll
    for (int i = 0; i < 16; ++i) ss += o0[i] * o0[i] + o1[i] * o1[i];
    ss += swap32(ss);
    const float rs = 1.0f / sqrtf(ss * (1.0f / HD) + 1e-6f);
    bf16_t* op = (bf16_t*)(p.ws + WS_B) + (row0 + q0 + r32) * D + h * HD + 4 * hi;
    const float* gp = p.sb_out_g + h * HD + 4 * hi;
#pragma unroll
    for (int dh = 0; dh < 2; ++dh)
#pragma unroll
        for (int gq = 0; gq < 4; ++gq) {
            const f32x4 gg = *(const f32x4*)(gp + 32 * dh + 8 * gq);
            const f32x16& o = dh ? o1 : o0;
            u32x2 w; w.x = cvt_pk_bf16(o[4 * gq] * rs * gg[0], o[4 * gq + 1] * rs * gg[1]); w.y = cvt_pk_bf16(o[4 * gq + 2] * rs * gg[2], o[4 * gq + 3] * rs * gg[3]);
            *(u32x2*)(op + 32 * dh + 8 * gq) = w;
        }
}

constexpr size_t ACT_OFF = (size_t)64 << 20;
namespace rk {
constexpr int C = 32, NCH = S / C, NSLOT = 16;
constexpr int SL_PS = 0, SL_QS = 8192, SL_PO = 12288, SL_QO = 16384, SL_VR = 18432, SL_GB = 22528, SL_GW = 26624, SLOT_BYTES = 30720;
constexpr int MSTR = 144;
constexpr int PM_AT = 0, PM_RT = 4608, PM_BT = 9216, PM_KT = 13824, PM_GC = 18432, PROD_LDS = 18688;
constexpr int NPROD = 6;
constexpr int L_CONS = NPROD * PROD_LDS;
constexpr int OSTR = 272;
constexpr int L_OBUF = L_CONS + 4608;
constexpr int L_FLAG = L_OBUF + 32 * OSTR;
constexpr int L_W2 = L_FLAG + 256;
constexpr int L_A2 = L_W2 + 8192;
constexpr int L_G2 = L_A2 + 8192;
constexpr int L_CST = L_G2 + 16384;
constexpr int C_MUL = 0, C_MUR = 256, C_MUK = 320, C_MUV = 384, C_W0 = 448, C_A0 = 512, C_KK = 576, C_KA = 640, C_RK = 704, C_LNB = 768, C_END = 832;
static_assert(L_CST + C_END * 4 <= 161792, "rwkv LDS layout overflows");
}
__device__ __forceinline__ bf16x8 accfrag(const f32x16& a, int s) {
    return __builtin_bit_cast(bf16x8, (u32x4){cvt_pk_bf16(a[8 * s], a[8 * s + 1]), cvt_pk_bf16(a[8 * s + 2], a[8 * s + 3]), cvt_pk_bf16(a[8 * s + 4], a[8 * s + 5]), cvt_pk_bf16(a[8 * s + 6], a[8 * s + 7])});
}
__device__ __forceinline__ bf16x8 trfrag(const LAS unsigned char* mat, int s, int nt, int lane) {
    const int g = lane >> 4, i16 = lane & 15, q = i16 >> 2, pp = i16 & 3, h = g >> 1;
    const LAS unsigned char* a = mat + (16 * s + 4 * h + q) * rk::MSTR + (32 * nt + 16 * (g & 1) + 4 * pp) * 2;
    const s16x4 x = lds_tr16(a), y = lds_tr16(a + 8 * rk::MSTR);
    bf16x8 r; r[0] = x[0]; r[1] = x[1]; r[2] = x[2]; r[3] = x[3]; r[4] = y[0]; r[5] = y[1]; r[6] = y[2]; r[7] = y[3]; return r;
}
__device__ __forceinline__ void f8_from_bf16(const u32x4 w, float (&o)[8]) {
#pragma unroll
    for (int j = 0; j < 4; ++j) { o[2 * j] = bf16_lo(w[j]); o[2 * j + 1] = bf16_hi(w[j]); }
}
__device__ __forceinline__ f32x16 mfma32(bf16x8 a, bf16x8 b, f32x16 c) { return __builtin_amdgcn_mfma_f32_32x32x16_bf16(a, b, c, 0, 0, 0); }
__device__ __forceinline__ f32x16 zero16() { f32x16 z; for (int i = 0; i < 16; ++i) z[i] = 0.f; return z; }
__device__ __forceinline__ void um8(const bf16_t* urow  , bool has_prev, const float* mu, float (&o)[8]) {
    const u32x4 c = *(const u32x4*)urow; u32x4 pv = (u32x4){0u, 0u, 0u, 0u}; if (has_prev) pv = *(const u32x4*)(urow - NIN);
    const f32x4 m0 = *(const f32x4*)mu, m1 = *(const f32x4*)(mu + 4);
    float cv[8], pf[8]; f8_from_bf16(c, cv); f8_from_bf16(pv, pf);
#pragma unroll
    for (int j = 0; j < 4; ++j) { o[j] = cv[j] + (pf[j] - cv[j]) * m0[j]; o[4 + j] = cv[4 + j] + (pf[4 + j] - cv[4 + j]) * m1[j]; }
}
__device__ __forceinline__ void lerp8(const u32x4 c, const u32x4 pv, const LAS float* mu, float (&o)[8]) {
    const f32x4 m0 = *(const LAS f32x4*)mu, m1 = *(const LAS f32x4*)(mu + 4);
    float cv[8], pf[8]; f8_from_bf16(c, cv); f8_from_bf16(pv, pf);
#pragma unroll
    for (int j = 0; j < 4; ++j) { o[j] = cv[j] + (pf[j] - cv[j]) * m0[j]; o[4 + j] = cv[4 + j] + (pf[4 + j] - cv[4 + j]) * m1[j]; }
}
__device__ __forceinline__ void lerp8(const u32x4 c, const u32x4 pv, const float* mu, float (&o)[8]) {
    const f32x4 m0 = *(const f32x4*)mu, m1 = *(const f32x4*)(mu + 4);
    float cv[8], pf[8]; f8_from_bf16(c, cv); f8_from_bf16(pv, pf);
#pragma unroll
    for (int j = 0; j < 4; ++j) { o[j] = cv[j] + (pf[j] - cv[j]) * m0[j]; o[4 + j] = cv[4 + j] + (pf[4 + j] - cv[4 + j]) * m1[j]; }
}
__device__ __forceinline__ float scan32(float x) {
    x += dppf<0x111>(x); x += dppf<0x112>(x); x += dppf<0x114>(x); x += dppf<0x118>(x);
    const float bc = __builtin_bit_cast(float, __builtin_amdgcn_update_dpp(0, __builtin_bit_cast(int, x), 0x142, 0xA, 0xF, false));
    return x + bc;
}

__device__ __forceinline__ void rk_produce(const Params& p, LAS unsigned char* lds, LAS unsigned char* pl  , unsigned char* slot, int b, int hh, int c) {
    using namespace rk;
    int lane = threadIdx.x & 63; asm volatile("" : "+v"(lane));
    const int r32 = lane & 31, h = lane >> 5;
    const bf16_t* u = (const bf16_t*)(p.ws + WS_A);
    const size_t row0 = (size_t)b * S; const int t0 = c * C; const int tt = t0 + r32; const bool hp = tt > 0;
    const bf16_t* urow = u + (row0 + tt) * NIN;
    const LAS float* cst = (const LAS float*)(lds + L_CST);
    const int jrow0 = 32 * ((r32 >> 2) & 1) + (r32 & 3) + 4 * (r32 >> 3);
    f32x16 lw[2], la[2], lg[2];
#pragma unroll
    for (int mt = 0; mt < 2; ++mt) { lw[mt] = zero16(); la[mt] = zero16(); lg[mt] = zero16(); }
    const int cb = hh * HD + 32 * h;
    u32x4 ck[4], pk4[4], cr[4], pr4[4];
    {
        const bf16_t* act = (const bf16_t*)((const unsigned char*)p.out + ACT_OFF) + (row0 + tt) * 256 + 8 * h;
        u32x4 bw[4], ba[4], bg[8];
#pragma unroll
        for (int s = 0; s < 4; ++s) { bw[s] = *(const u32x4*)(act + 16 * s); ba[s] = *(const u32x4*)(act + 64 + 16 * s); }
#pragma unroll
        for (int s = 0; s < 8; ++s) bg[s] = *(const u32x4*)(act + 128 + 16 * s);
        {
            bf16x8 fw[2][4];
#pragma unroll
            for (int mt = 0; mt < 2; ++mt)
#pragma unroll
                for (int s = 0; s < 4; ++s) { const int jl = jrow0 + 16 * mt; fw[mt][s] = *(const LAS bf16x8*)(lds + L_W2 + jl * 128 + (((2 * s + h) ^ (jl & 7)) << 4)); }
#pragma unroll
            for (int s = 0; s < 4; ++s)
#pragma unroll
                for (int mt = 0; mt < 2; ++mt) lw[mt] = mfma32(fw[mt][s], __builtin_bit_cast(bf16x8, bw[s]), lw[mt]);
        }
        {
            bf16x8 fa[2][4];
#pragma unroll
            for (int mt = 0; mt < 2; ++mt)
#pragma unroll
                for (int s = 0; s < 4; ++s) { const int jl = jrow0 + 16 * mt; fa[mt][s] = *(const LAS bf16x8*)(lds + L_A2 + jl * 128 + (((2 * s + h) ^ (jl & 7)) << 4)); }
#pragma unroll
            for (int s = 0; s < 4; ++s)
#pragma unroll
                for (int mt = 0; mt < 2; ++mt) la[mt] = mfma32(fa[mt][s], __builtin_bit_cast(bf16x8, ba[s]), la[mt]);
        }
        asm volatile("" ::: "memory");
#pragma unroll
        for (int half = 0; half < 2; ++half) {
            bf16x8 fg[2][4];
#pragma unroll
            for (int mt = 0; mt < 2; ++mt)
#pragma unroll
                for (int s4 = 0; s4 < 4; ++s4) { const int s = 4 * half + s4, jl = jrow0 + 16 * mt; fg[mt][s4] = *(const LAS bf16x8*)(lds + L_G2 + jl * 256 + (((2 * s + h) ^ (jl & 7)) << 4)); }
#pragma unroll
            for (int s4 = 0; s4 < 4; ++s4)
#pragma unroll
                for (int mt = 0; mt < 2; ++mt) lg[mt] = mfma32(fg[mt][s4], __builtin_bit_cast(bf16x8, bg[4 * half + s4]), lg[mt]);
        }
        asm volatile("" ::: "memory");
#pragma unroll
        for (int q = 0; q < 4; ++q) { const bf16_t* a = urow + URK + cb + 8 * q; const bf16_t* bq = urow + UR + cb + 8 * q;
            ck[q] = *(const u32x4*)a; cr[q] = *(const u32x4*)bq; pk4[q] = (u32x4){0u, 0u, 0u, 0u}; pr4[q] = pk4[q];
            if (hp) { pk4[q] = *(const u32x4*)(a - NIN); pr4[q] = *(const u32x4*)(bq - NIN); } }
    }
#pragma unroll
    for (int mt = 0; mt < 2; ++mt) {
        u32x4 w0, w1; w0.x = cvt_pk_bf16(lg[mt][0], lg[mt][1]); w0.y = cvt_pk_bf16(lg[mt][2], lg[mt][3]); w0.z = cvt_pk_bf16(lg[mt][4], lg[mt][5]); w0.w = cvt_pk_bf16(lg[mt][6], lg[mt][7]);
        w1.x = cvt_pk_bf16(lg[mt][8], lg[mt][9]); w1.y = cvt_pk_bf16(lg[mt][10], lg[mt][11]); w1.z = cvt_pk_bf16(lg[mt][12], lg[mt][13]); w1.w = cvt_pk_bf16(lg[mt][14], lg[mt][15]);
        *(u32x4*)(slot + SL_GW + (2 * mt) * 1024 + lane * 16) = w0; *(u32x4*)(slot + SL_GW + (2 * mt + 1) * 1024 + lane * 16) = w1;
    }
    asm volatile("" ::: "memory");
    float ssq = 0.f;
#pragma unroll
    for (int q = 0; q < 4; ++q) {
        float t8[8]; lerp8(ck[q], pk4[q], cst + C_MUK + 32 * h + 8 * q, t8);
        const f32x4 c0 = *(const LAS f32x4*)(cst + C_KK + 32 * h + 8 * q), c1 = *(const LAS f32x4*)(cst + C_KK + 32 * h + 8 * q + 4);
#pragma unroll
        for (int j = 0; j < 4; ++j) { const float x0 = t8[j] * c0[j], x1 = t8[4 + j] * c1[j]; ssq += x0 * x0 + x1 * x1; }
    }
    ssq += swap32(ssq);
    const float kinv = frsq(fmaxf(ssq, 1e-24f));
    float bonus = 0.f;
    LAS unsigned char* mAT = pl + PM_AT; LAS unsigned char* mRT = pl + PM_RT; LAS unsigned char* mBT = pl + PM_BT; LAS unsigned char* mKT = pl + PM_KT;
    LAS float* gc = (LAS float*)(pl + PM_GC);
#pragma unroll
    for (int mt = 0; mt < 2; ++mt) {
#pragma unroll
        for (int q8 = 0; q8 < 2; ++q8) {
            const int jl0 = 32 * h + 16 * mt + 8 * q8, q = 2 * mt + q8;
            float k8[8], r8[8];
            lerp8(ck[q], pk4[q], cst + C_MUK + jl0, k8);
            lerp8(cr[q], pr4[q], cst + C_MUR + jl0, r8);
            float cw0[8], ca0[8], ckk[8], cka[8], crk[8];
#pragma unroll
            for (int e = 0; e < 2; ++e) { const f32x4 a = *(const LAS f32x4*)(cst + C_W0 + jl0 + 4 * e), bq = *(const LAS f32x4*)(cst + C_A0 + jl0 + 4 * e), cc = *(const LAS f32x4*)(cst + C_KK + jl0 + 4 * e), dd = *(const LAS f32x4*)(cst + C_KA + jl0 + 4 * e), ee = *(const LAS f32x4*)(cst + C_RK + jl0 + 4 * e);
#pragma unroll
                for (int j = 0; j < 4; ++j) { cw0[4 * e + j] = a[j]; ca0[4 * e + j] = bq[j]; ckk[4 * e + j] = cc[j]; cka[4 * e + j] = dd[j]; crk[4 * e + j] = ee[j]; } }
            float oa[8], orr[8], ob[8], ok[8];
#pragma unroll
            for (int e = 0; e < 8; ++e) {
                const int reg = 8 * q8 + e;
                const float xw = cw0[e] + lw[mt][reg];
                const float spn = fmaxf(-xw, 0.f) + LN2 * flog2(1.0f + fexp2(-fabsf(xw) * LOG2E));
                const float ld = -fexp2((-spn - 0.5f) * LOG2E);
                const float al = frcp(1.0f + fexp2(-(ca0[e] + la[mt][reg]) * LOG2E));
                const float kk = k8[e] * ckk[e] * kinv;
                const float kmod = k8[e] * (1.0f + (al - 1.0f) * cka[e]);
                const float bb = kk * al;
                bonus += r8[e] * kmod * crk[e];
                const float G = scan32(ld);
                const float eG = fexp2(G * LOG2E), eGm = fexp2((G - ld) * LOG2E), eiG = fexp2(-G * LOG2E);
                oa[e] = -kk * eGm; orr[e] = r8[e] * eG; ob[e] = bb * eiG; ok[e] = kmod * eiG;
                if (r32 == 31) gc[32 * h + 16 * mt + reg] = eG;
            }
            const int off = r32 * MSTR + (32 * h + 16 * mt + 8 * q8) * 2;
            *(LAS u32x4*)(mAT + off) = (u32x4){cvt_pk_bf16(oa[0], oa[1]), cvt_pk_bf16(oa[2], oa[3]), cvt_pk_bf16(oa[4], oa[5]), cvt_pk_bf16(oa[6], oa[7])};
            *(LAS u32x4*)(mRT + off) = (u32x4){cvt_pk_bf16(orr[0], orr[1]), cvt_pk_bf16(orr[2], orr[3]), cvt_pk_bf16(orr[4], orr[5]), cvt_pk_bf16(orr[6], orr[7])};
            *(LAS u32x4*)(mBT + off) = (u32x4){cvt_pk_bf16(ob[0], ob[1]), cvt_pk_bf16(ob[2], ob[3]), cvt_pk_bf16(ob[4], ob[5]), cvt_pk_bf16(ob[6], ob[7])};
            *(LAS u32x4*)(mKT + off) = (u32x4){cvt_pk_bf16(ok[0], ok[1]), cvt_pk_bf16(ok[2], ok[3]), cvt_pk_bf16(ok[4], ok[5]), cvt_pk_bf16(ok[6], ok[7])};
            asm volatile("" ::: "memory");
        }
    }
    bonus += swap32(bonus);
    u32x4 cv4[4], pv4[4];
#pragma unroll
    for (int q = 0; q < 4; ++q) { const bf16_t* cq = urow + URV + cb + 8 * q; cv4[q] = *(const u32x4*)cq; pv4[q] = (u32x4){0u, 0u, 0u, 0u}; if (hp) pv4[q] = *(const u32x4*)(cq - NIN); }
#pragma unroll
    for (int q = 0; q < 4; ++q) {
        float v8[8]; lerp8(cv4[q], pv4[q], cst + C_MUV + 32 * h + 8 * q, v8);
        *(u32x4*)(slot + SL_VR + q * 1024 + lane * 16) = (u32x4){cvt_pk_bf16(v8[0], v8[1]), cvt_pk_bf16(v8[2], v8[3]), cvt_pk_bf16(v8[4], v8[5]), cvt_pk_bf16(v8[6], v8[7])};
        const f32x4 b0 = *(const LAS f32x4*)(cst + C_LNB + 32 * h + 8 * q), b1 = *(const LAS f32x4*)(cst + C_LNB + 32 * h + 8 * q + 4);
        float gb[8];
#pragma unroll
        for (int e = 0; e < 8; ++e) gb[e] = (e < 4 ? b0[e] : b1[e - 4]) + bonus * v8[e];
        *(u32x4*)(slot + SL_GB + q * 1024 + lane * 16) = (u32x4){cvt_pk_bf16(gb[0], gb[1]), cvt_pk_bf16(gb[2], gb[3]), cvt_pk_bf16(gb[4], gb[5]), cvt_pk_bf16(gb[6], gb[7])};
    }
    LDS_WAIT();
    f32x16 nab = zero16(), nabT = zero16(), nakT = zero16(), mbr = zero16(), mkr = zero16();
#pragma unroll
    for (int s = 0; s < 4; ++s) {
        const int off = r32 * MSTR + (16 * s + 8 * h) * 2;
        const bf16x8 fa = *(const LAS bf16x8*)(mAT + off), fr = *(const LAS bf16x8*)(mRT + off), fb = *(const LAS bf16x8*)(mBT + off), fk = *(const LAS bf16x8*)(mKT + off);
        nab = mfma32(fb, fa, nab); nabT = mfma32(fa, fb, nabT); nakT = mfma32(fa, fk, nakT); mbr = mfma32(fb, fr, mbr); mkr = mfma32(fk, fr, mkr);
    }
#pragma unroll
    for (int reg = 0; reg < 16; ++reg) {
        const int row = (reg & 3) + 8 * (reg >> 2) + 4 * h;
        nab[reg] = row < r32 ? nab[reg] : 0.f;
        nabT[reg] = r32 < row ? nabT[reg] : 0.f;
        nakT[reg] = r32 < row ? nakT[reg] : 0.f;
        mbr[reg] = row <= r32 ? mbr[reg] : 0.f;
        mkr[reg] = row <= r32 ? mkr[reg] : 0.f;
    }
    f32x16 Y = nab;
#pragma unroll
    for (int reg = 0; reg < 16; ++reg) { const int row = (reg & 3) + 8 * (reg >> 2) + 4 * h; if (row == r32) Y[reg] += 1.0f; }
    {
        f32x16 M = nab, MT = nabT;
#pragma unroll
        for (int lvl = 0; lvl < 4; ++lvl) {
            const bf16x8 m0 = accfrag(M, 0), m1 = accfrag(M, 1), t0f = accfrag(MT, 0), t1f = accfrag(MT, 1);
            f32x16 M2T = mfma32(m0, t0f, zero16()); M2T = mfma32(m1, t1f, M2T);
            f32x16 M2 = zero16();
            if (lvl < 3) { M2 = mfma32(t0f, m0, M2); M2 = mfma32(t1f, m1, M2); }
            const bf16x8 y0 = accfrag(Y, 0), y1 = accfrag(Y, 1);
            Y = mfma32(accfrag(M2T, 0), y0, Y); Y = mfma32(accfrag(M2T, 1), y1, Y);
            M = M2; MT = M2T;
        }
    }
    int lane5 = lane; asm volatile("" : "+v"(lane5));
    const int r5 = lane5 & 31, h5 = lane5 >> 5;
    const bf16x8 ty0 = accfrag(Y, 0), ty1 = accfrag(Y, 1);
    f32x16 paT[2];
#pragma unroll
    for (int nt = 0; nt < 2; ++nt) { paT[nt] = mfma32(ty0, trfrag(mAT, 0, nt, lane5), zero16()); paT[nt] = mfma32(ty1, trfrag(mAT, 1, nt, lane5), paT[nt]); }
    f32x16 qakT = mfma32(ty0, accfrag(nakT, 0), zero16()); qakT = mfma32(ty1, accfrag(nakT, 1), qakT);
    const bf16x8 mb0 = accfrag(mbr, 0), mb1 = accfrag(mbr, 1);
#pragma unroll
    for (int mt = 0; mt < 2; ++mt) {
        f32x16 po;
#pragma unroll
        for (int g = 0; g < 4; ++g) { const u32x2 w = *(const LAS u32x2*)(mRT + r5 * MSTR + (32 * mt + 8 * g + 4 * h5) * 2);
            po[4 * g] = bf16_lo(w.x); po[4 * g + 1] = bf16_hi(w.x); po[4 * g + 2] = bf16_lo(w.y); po[4 * g + 3] = bf16_hi(w.y); }
        po = mfma32(accfrag(paT[mt], 0), mb0, po); po = mfma32(accfrag(paT[mt], 1), mb1, po);
#pragma unroll
        for (int sp = 0; sp < 2; ++sp)
            *(u32x4*)(slot + SL_PO + (2 * mt + sp) * 1024 + lane5 * 16) = (u32x4){cvt_pk_bf16(po[8 * sp], po[8 * sp + 1]), cvt_pk_bf16(po[8 * sp + 2], po[8 * sp + 3]), cvt_pk_bf16(po[8 * sp + 4], po[8 * sp + 5]), cvt_pk_bf16(po[8 * sp + 6], po[8 * sp + 7])};
    }
    {
        f32x16 qo = mfma32(accfrag(qakT, 0), mb0, mkr); qo = mfma32(accfrag(qakT, 1), mb1, qo);
#pragma unroll
        for (int sp = 0; sp < 2; ++sp) *(u32x4*)(slot + SL_QO + sp * 1024 + lane5 * 16) = (u32x4){cvt_pk_bf16(qo[8 * sp], qo[8 * sp + 1]), cvt_pk_bf16(qo[8 * sp + 2], qo[8 * sp + 3]), cvt_pk_bf16(qo[8 * sp + 4], qo[8 * sp + 5]), cvt_pk_bf16(qo[8 * sp + 6], qo[8 * sp + 7])};
    }
#pragma unroll
    for (int nt = 0; nt < 2; ++nt) {
        const bf16x8 bt0 = trfrag(mBT, 0, nt, lane5), bt1 = trfrag(mBT, 1, nt, lane5);
        const float gam = gc[32 * nt + r5];
#pragma unroll
        for (int mt = 0; mt < 2; ++mt) {
            f32x16 ps = zero16();
            if (mt == nt) {
#pragma unroll
                for (int reg = 0; reg < 16; ++reg) { const int row = (reg & 3) + 8 * (reg >> 2) + 4 * h5; ps[reg] = (row == r5) ? 1.0f : 0.f; }
            }
            ps = mfma32(accfrag(paT[mt], 0), bt0, ps); ps = mfma32(accfrag(paT[mt], 1), bt1, ps);
#pragma unroll
            for (int sp = 0; sp < 2; ++sp)
                *(u32x4*)(slot + SL_PS + ((nt * 2 + mt) * 2 + sp) * 1024 + lane5 * 16) = (u32x4){cvt_pk_bf16(ps[8 * sp] * gam, ps[8 * sp + 1] * gam), cvt_pk_bf16(ps[8 * sp + 2] * gam, ps[8 * sp + 3] * gam), cvt_pk_bf16(ps[8 * sp + 4] * gam, ps[8 * sp + 5] * gam), cvt_pk_bf16(ps[8 * sp + 6] * gam, ps[8 * sp + 7] * gam)};
        }
        f32x16 qs;
        { const bf16x8 k0 = trfrag(mKT, 0, nt, lane5), k1 = trfrag(mKT, 1, nt, lane5);
          const u32x4 w0 = __builtin_bit_cast(u32x4, k0), w1 = __builtin_bit_cast(u32x4, k1);
#pragma unroll
          for (int j = 0; j < 4; ++j) { qs[2 * j] = bf16_lo(w0[j]); qs[2 * j + 1] = bf16_hi(w0[j]); qs[8 + 2 * j] = bf16_lo(w1[j]); qs[8 + 2 * j + 1] = bf16_hi(w1[j]); } }
        qs = mfma32(accfrag(qakT, 0), bt0, qs); qs = mfma32(accfrag(qakT, 1), bt1, qs);
#pragma unroll
        for (int sp = 0; sp < 2; ++sp) *(u32x4*)(slot + SL_QS + (nt * 2 + sp) * 1024 + lane5 * 16) = (u32x4){cvt_pk_bf16(qs[8 * sp] * gam, qs[8 * sp + 1] * gam), cvt_pk_bf16(qs[8 * sp + 2] * gam, qs[8 * sp + 3] * gam), cvt_pk_bf16(qs[8 * sp + 4] * gam, qs[8 * sp + 5] * gam), cvt_pk_bf16(qs[8 * sp + 6] * gam, qs[8 * sp + 7] * gam)};
    }
    LDS_WAIT();
}

__device__ __forceinline__ u32x4 ntload16(const void* ptr) { return __builtin_nontemporal_load((const u32x4*)ptr); }
struct RkOps { u32x4 vr[4]; bf16x8 fps[2][2][2], fqs[2][2], fpo[2][2], fqo[2]; };
__device__ __forceinline__ void rk_load_ops_a(RkOps& o, const unsigned char* slot, int lane) {
    using namespace rk;
    const int r32 = lane & 31, h = lane >> 5;
#pragma unroll
    for (int k = 0; k < 4; ++k) o.vr[k] = ntload16(slot + SL_VR + k * 1024 + lane * 16);
#pragma unroll
    for (int jt = 0; jt < 2; ++jt)
#pragma unroll
        for (int s = 0; s < 2; ++s) o.fpo[jt][s] = __builtin_bit_cast(bf16x8, ntload16(slot + SL_PO + (2 * jt + s) * 1024 + lane * 16));
#pragma unroll
    for (int s = 0; s < 2; ++s) o.fqo[s] = __builtin_bit_cast(bf16x8, ntload16(slot + SL_QO + s * 1024 + lane * 16));
}
__device__ __forceinline__ void rk_load_ops_b(RkOps& o, const unsigned char* slot, int lane) {
    using namespace rk;
    const int r32 = lane & 31, h = lane >> 5;
#pragma unroll
    for (int mt = 0; mt < 2; ++mt) {
#pragma unroll
        for (int jt = 0; jt < 2; ++jt)
#pragma unroll
            for (int s = 0; s < 2; ++s) o.fps[mt][jt][s] = __builtin_bit_cast(bf16x8, ntload16(slot + SL_PS + ((mt * 2 + jt) * 2 + s) * 1024 + lane * 16));
#pragma unroll
        for (int s = 0; s < 2; ++s) o.fqs[mt][s] = __builtin_bit_cast(bf16x8, ntload16(slot + SL_QS + (mt * 2 + s) * 1024 + lane * 16));
    }
}
#define RK_SPIN(cond) do { unsigned _sp = 0; while (cond) { __builtin_amdgcn_s_sleep(1); if (++_sp > (1u << 24)) { err[0] = 1u; break; } } asm volatile("" ::: "memory"); } while (0)

__device__ __forceinline__ void rwkv_chain(const Params& p, LAS unsigned char* lds, int b, int hh) {
    using namespace rk;
    int tid = threadIdx.x; asm volatile("" : "+v"(tid));
    volatile LAS unsigned* ready = (volatile LAS unsigned*)(lds + L_FLAG); volatile LAS unsigned* freed = ready + NSLOT; volatile LAS unsigned* ofull = freed + NSLOT; volatile LAS unsigned* ofree = ofull + 2; volatile LAS unsigned* err = ofree + 2;
    if (tid < 2 * NSLOT + 5) ready[tid] = 0u;
    {
        const bf16_t* w2t = (const bf16_t*)(p.ws + WS_LT); const bf16_t* a2t = w2t + 512 * 64; const bf16_t* g2t = a2t + 512 * 64;
        for (int i = tid; i < 64 * 8; i += NTHREADS) { const int j = i >> 3, ch = i & 7, d = j * 128 + ((ch ^ (j & 7)) << 4);
            *(LAS u32x4*)(lds + L_W2 + d) = *(const u32x4*)(w2t + (hh * HD + j) * 64 + 8 * ch); *(LAS u32x4*)(lds + L_A2 + d) = *(const u32x4*)(a2t + (hh * HD + j) * 64 + 8 * ch); }
        for (int i = tid; i < 64 * 16; i += NTHREADS) { const int j = i >> 4, ch = i & 15; *(LAS u32x4*)(lds + L_G2 + j * 256 + ((ch ^ (j & 7)) << 4)) = *(const u32x4*)(g2t + (hh * HD + j) * 128 + 8 * ch); }
        LAS float* cst = (LAS float*)(lds + L_CST);
        for (int i = tid; i < C_END; i += NTHREADS) { float v;
            if (i < 256) v = p.shift_mu[(UXW - UR) + i];
            else if (i < 320) v = p.shift_mu[hh * HD + (i - 256)];
            else if (i < 384) v = p.shift_mu[(URK - UR) + hh * HD + (i - 320)];
            else if (i < 448) v = p.shift_mu[(URV - UR) + hh * HD + (i - 384)];
            else if (i < 512) v = p.rw_w0[hh * HD + (i - 448)];
            else if (i < 576) v = p.rw_a0[hh * HD + (i - 512)];
            else if (i < 640) v = p.rw_k_k[hh * HD + (i - 576)];
            else if (i < 704) v = p.rw_k_a[hh * HD + (i - 640)];
            else if (i < 768) v = p.rw_r_k[hh * HD + (i - 704)];
            else v = p.rw_ln_b[hh * HD + (i - 768)];
            cst[i] = v; }
    }
    __syncthreads();
    asm volatile("" : "+v"(tid));
    const int wave = __builtin_amdgcn_readfirstlane(tid >> 6);
    unsigned char* ring = (unsigned char*)p.out + (size_t)(b * NH + hh) * NSLOT * SLOT_BYTES;
    if (wave == 0) {
        int lane = tid & 63; asm volatile("" : "+v"(lane));
        const int r32 = lane & 31, h = lane >> 5;
        LAS unsigned char* vs = lds + L_CONS;
        f32x16 st[2][2];
#pragma unroll
        for (int a = 0; a < 2; ++a)
#pragma unroll
            for (int d = 0; d < 2; ++d) st[a][d] = zero16();
        RkOps ops;
        RK_SPIN(ready[0] != 1u);
        rk_load_ops_a(ops, ring, lane); rk_load_ops_b(ops, ring, lane);
        for (int c = 0; c < NCH; ++c) {
            bf16x8 sf[2][2][2];
#pragma unroll
            for (int jt = 0; jt < 2; ++jt)
#pragma unroll
                for (int it = 0; it < 2; ++it) { sf[jt][it][0] = accfrag(st[jt][it], 0); sf[jt][it][1] = accfrag(st[jt][it], 1); }
            { LAS unsigned char* d = vs + r32 * MSTR + h * 64;
              *(LAS u32x4*)d = ops.vr[0]; *(LAS u32x4*)(d + 16) = ops.vr[1]; *(LAS u32x4*)(d + 32) = ops.vr[2]; *(LAS u32x4*)(d + 48) = ops.vr[3]; }
            LDS_WAIT();
            bf16x8 vf[2][2];
            { const int g = lane >> 4, i16 = lane & 15, q = i16 >> 2, pp = i16 & 3;
#pragma unroll
              for (int it = 0; it < 2; ++it)
#pragma unroll
                  for (int s = 0; s < 2; ++s) { const LAS unsigned char* a = vs + (16 * s + 4 * h + q) * MSTR + (32 * it + 16 * (g & 1) + 4 * pp) * 2;
                      const s16x4 x = lds_tr16(a), y = lds_tr16(a + 8 * MSTR);
                      bf16x8 r; r[0] = x[0]; r[1] = x[1]; r[2] = x[2]; r[3] = x[3]; r[4] = y[0]; r[5] = y[1]; r[6] = y[2]; r[7] = y[3]; vf[it][s] = r; } }
            f32x16 o[2];
#pragma unroll
            for (int it = 0; it < 2; ++it) {
                o[it] = zero16();
#pragma unroll
                for (int jt = 0; jt < 2; ++jt)
#pragma unroll
                    for (int s = 0; s < 2; ++s) o[it] = mfma32(sf[jt][it][s], ops.fpo[jt][s], o[it]);
#pragma unroll
                for (int s = 0; s < 2; ++s) o[it] = mfma32(vf[it][s], ops.fqo[s], o[it]);
            }
            const unsigned char* nslot = ring + (size_t)((c + 1) % NSLOT) * SLOT_BYTES;
            if (c + 1 < NCH) { RK_SPIN(ready[(c + 1) % NSLOT] != (unsigned)(c + 2)); rk_load_ops_a(ops, nslot, lane); }
#pragma unroll
            for (int mt = 0; mt < 2; ++mt)
#pragma unroll
                for (int it = 0; it < 2; ++it) {
                    f32x16 a = zero16();
#pragma unroll
                    for (int jt = 0; jt < 2; ++jt)
#pragma unroll
                        for (int s = 0; s < 2; ++s) a = mfma32(ops.fps[mt][jt][s], sf[jt][it][s], a);
#pragma unroll
                    for (int s = 0; s < 2; ++s) a = mfma32(ops.fqs[mt][s], vf[it][s], a);
                    st[mt][it] = a;
                }
            if (c + 1 < NCH) rk_load_ops_b(ops, nslot, lane);
            if (c >= 1) RK_SPIN(ofree[0] != (unsigned)c);
            { LAS unsigned char* ob = lds + L_OBUF + r32 * OSTR;
#pragma unroll
              for (int it = 0; it < 2; ++it)
#pragma unroll
                  for (int g = 0; g < 4; ++g) *(LAS f32x4*)(ob + (32 * it + 8 * g + 4 * h) * 4) = (f32x4){o[it][4 * g], o[it][4 * g + 1], o[it][4 * g + 2], o[it][4 * g + 3]}; }
            LDS_WAIT();
            if (lane == 0) ofull[0] = (unsigned)(c + 1);
        }
    } else if (wave == 1) {
        int lane = tid & 63; asm volatile("" : "+v"(lane));
        const int r32 = lane & 31, h = lane >> 5;
        u32x4 gw[4], gb[4];
        RK_SPIN(ready[0] != 1u);
#pragma unroll
        for (int k = 0; k < 4; ++k) { gw[k] = ntload16(ring + SL_GW + k * 1024 + lane * 16); gb[k] = ntload16(ring + SL_GB + k * 1024 + lane * 16); }
        for (int c = 0; c < NCH; ++c) {
            const int sl = c % NSLOT;
            RK_SPIN(ofull[0] != (unsigned)(c + 1));
            float ov[32];
            { const LAS unsigned char* ob = lds + L_OBUF + r32 * OSTR + 128 * h;
#pragma unroll
              for (int k = 0; k < 8; ++k) { const f32x4 x = *(const LAS f32x4*)(ob + 16 * k); ov[4 * k] = x[0]; ov[4 * k + 1] = x[1]; ov[4 * k + 2] = x[2]; ov[4 * k + 3] = x[3]; } }
            LDS_WAIT();
            if (lane == 0) ofree[0] = (unsigned)(c + 1);
            float sm = 0.f;
#pragma unroll
            for (int k = 0; k < 32; ++k) sm += ov[k];
            sm += swap32(sm);
            const float mean = sm * (1.0f / 64.0f);
            float sv = 0.f;
#pragma unroll
            for (int k = 0; k < 32; ++k) { const float d = ov[k] - mean; sv += d * d; }
            sv += swap32(sv);
            const float rstd = 1.0f / sqrtf(sv * (1.0f / 64.0f) + 64e-5f);
            bf16_t* mrow = (bf16_t*)(p.ws + WS_B) + ((size_t)b * S + c * C + r32) * D + 512 + hh * HD + 32 * h;
#pragma unroll
            for (int k = 0; k < 4; ++k) {
                float w8[8], b8[8], r[8]; f8_from_bf16(gw[k], w8); f8_from_bf16(gb[k], b8);
                const f32x4 l0 = *(const f32x4*)(p.rw_ln_w + hh * HD + 32 * h + 8 * k), l1 = *(const f32x4*)(p.rw_ln_w + hh * HD + 32 * h + 8 * k + 4);
#pragma unroll
                for (int e = 0; e < 8; ++e) r[e] = ((ov[8 * k + e] - mean) * rstd * (e < 4 ? l0[e] : l1[e - 4]) + b8[e]) * w8[e];
                *(u32x4*)(mrow + 8 * k) = (u32x4){cvt_pk_bf16(r[0], r[1]), cvt_pk_bf16(r[2], r[3]), cvt_pk_bf16(r[4], r[5]), cvt_pk_bf16(r[6], r[7])};
            }
            if (lane == 0) freed[sl] = (unsigned)(c + 1);
            if (c + 1 < NCH) { const int sn = (c + 1) % NSLOT; const unsigned char* sp_ = ring + (size_t)sn * SLOT_BYTES; RK_SPIN(ready[sn] != (unsigned)(c + 2));
#pragma unroll
                for (int k = 0; k < 4; ++k) { gw[k] = ntload16(sp_ + SL_GW + k * 1024 + lane * 16); gb[k] = ntload16(sp_ + SL_GB + k * 1024 + lane * 16); } }
        }
    } else {
        int lane = tid & 63;
        if (wave - 2 < NPROD) for (int c = wave - 2; c < NCH; c += NPROD) {
            const int sl = c % NSLOT;
            if (c >= NSLOT) RK_SPIN(freed[sl] != (unsigned)(c - NSLOT + 1));
            rk_produce(p, lds, lds + (wave - 2) * PROD_LDS, ring + (size_t)sl * SLOT_BYTES, b, hh, c);
            asm volatile("s_waitcnt vmcnt(0)" ::: "memory");
            if (lane == 0) ready[sl] = (unsigned)(c + 1);
        }
    }
    __syncthreads();
}

#ifdef RWDEBUG
namespace rw {
constexpr int CH = 16;
constexpr int O_UM = 0;
constexpr int O_LW = O_UM + CH * 448 * 4;
constexpr int O_LA = O_LW + CH * 64 * 4;
constexpr int O_LG0 = O_LA + CH * 64 * 4;
constexpr int O_LG1 = O_LG0 + CH * 64 * 4;
constexpr int O_A1 = O_LG1 + CH * 64 * 4;
constexpr int O_R1 = O_A1 + CH * 64 * 4;
constexpr int O_B1 = O_R1 + CH * 64 * 4;
constexpr int O_K1 = O_B1 + CH * 64 * 4;
constexpr int O_O = O_K1 + CH * 64 * 4;
constexpr int O_WT = O_O + CH * 64 * 4;
constexpr int O_GC = O_WT + 8 * 64 * 4;
constexpr int O_SC = O_GC + 64 * 4;
constexpr int O_END = O_SC + 3 * 16 * 4;
}
__device__ __forceinline__ bf16x8 ldw_frag(const float* W, int ldw, int m0, int col) {
    unsigned w[4];
#pragma unroll
    for (int j = 0; j < 4; ++j) w[j] = cvt_pk_bf16(W[(size_t)(m0 + 2 * j) * ldw + col], W[(size_t)(m0 + 2 * j + 1) * ldw + col]);
    return __builtin_bit_cast(bf16x8, (u32x4){w[0], w[1], w[2], w[3]});
}
template <int ACT>
__device__ __forceinline__ bf16x8 act_frag(const LAS float* src) {
    const f32x4 a = *(const LAS f32x4*)src, b = *(const LAS f32x4*)(src + 4); float v[8] = {a[0], a[1], a[2], a[3], b[0], b[1], b[2], b[3]};
#pragma unroll
    for (int j = 0; j < 8; ++j) {
        if (ACT == 1) v[j] = 1.0f - 2.0f * frcp(1.0f + fexp2(v[j] * (2.0f * LOG2E)));
        if (ACT == 2) v[j] = frcp(1.0f + fexp2(-v[j] * LOG2E));
    }
    return __builtin_bit_cast(bf16x8, (u32x4){cvt_pk_bf16(v[0], v[1]), cvt_pk_bf16(v[2], v[3]), cvt_pk_bf16(v[4], v[5]), cvt_pk_bf16(v[6], v[7])});
}

__device__ __forceinline__ void rwkv_chain_seq(const Params& p, LAS unsigned char* lds, int b, int h, bf16_t* mix, int nchunks) {
    using namespace rw;
    const int tid = threadIdx.x, wave = __builtin_amdgcn_readfirstlane(tid >> 6), lane = tid & 63;
    const bf16_t* u = (const bf16_t*)(p.ws + WS_A);
    const size_t row0 = (size_t)b * S;
    LAS float* UM = (LAS float*)(lds + O_UM); LAS float* LW = (LAS float*)(lds + O_LW); LAS float* LA = (LAS float*)(lds + O_LA);
    LAS float* LG0 = (LAS float*)(lds + O_LG0); LAS float* LG1 = (LAS float*)(lds + O_LG1);
    LAS float* A1 = (LAS float*)(lds + O_A1); LAS float* R1 = (LAS float*)(lds + O_R1); LAS float* B1 = (LAS float*)(lds + O_B1); LAS float* K1 = (LAS float*)(lds + O_K1);
    LAS float* OO = (LAS float*)(lds + O_O); LAS float* WT = (LAS float*)(lds + O_WT); LAS float* GC = (LAS float*)(lds + O_GC); LAS float* SC = (LAS float*)(lds + O_SC);
    const int fc = lane & 15, fq = lane >> 4;
    bf16x8 bwa[2], bg[2];
    { const float* W = wave < 4 ? p.rw_w2 : p.rw_a2; const int col = h * HD + 16 * (wave & 3) + fc;
      bwa[0] = ldw_frag(W, 512, 8 * fq, col); bwa[1] = ldw_frag(W, 512, 32 + 8 * fq, col);
      const int ks = (wave >> 2) * 2; bg[0] = ldw_frag(p.rw_g2, 512, 32 * ks + 8 * fq, col); bg[1] = ldw_frag(p.rw_g2, 512, 32 * (ks + 1) + 8 * fq, col); }
    const int hj = h * HD + lane;
    const float c_w0 = p.rw_w0[hj], c_a0 = p.rw_a0[hj], c_kk = p.rw_k_k[hj], c_ka = p.rw_k_a[hj], c_rk = p.rw_r_k[hj], c_lnw = p.rw_ln_w[hj], c_lnb = p.rw_ln_b[hj];
    int ld_t[2], ld_c[2], ld_uc[2]; bool ld_ok[2];
#pragma unroll
    for (int r = 0; r < 2; ++r) { const int gid = tid + 512 * r; ld_ok[r] = gid < CH * 56; const int t = gid / 56, cg8 = gid % 56; ld_t[r] = t; ld_c[r] = cg8 * 8;
        ld_uc[r] = cg8 < 8 ? UR + h * HD + 8 * cg8 : cg8 < 16 ? URK + h * HD + 8 * (cg8 - 8) : cg8 < 24 ? URV + h * HD + 8 * (cg8 - 16) : UXW + 8 * (cg8 - 24); }
    const int si = 8 * wave + (lane >> 3), sj = 8 * (lane & 7);
    float st[8];
#pragma unroll
    for (int n = 0; n < 8; ++n) st[n] = 0.f;
    u32x4 cur[2], prv[2];
    auto issue_loads = [&](int t0) {
#pragma unroll
        for (int r = 0; r < 2; ++r) { cur[r] = (u32x4){0u, 0u, 0u, 0u}; prv[r] = (u32x4){0u, 0u, 0u, 0u};
            if (ld_ok[r]) { const int tt = t0 + ld_t[r]; const bf16_t* a = u + (row0 + tt) * NIN + ld_uc[r]; cur[r] = *(const u32x4*)a; if (tt > 0) prv[r] = *(const u32x4*)(a - NIN); } }
    };
    issue_loads(0);
    for (int c = 0; c < nchunks; ++c) {
        const int t0 = c * CH;
#pragma unroll
        for (int r = 0; r < 2; ++r) if (ld_ok[r]) {
            const float* mu = p.shift_mu + (ld_uc[r] - UR); const f32x4 m0 = *(const f32x4*)mu, m1 = *(const f32x4*)(mu + 4);
            float cv[8], pv[8];
#pragma unroll
            for (int j = 0; j < 4; ++j) { cv[2 * j] = bf16_lo(cur[r][j]); cv[2 * j + 1] = bf16_hi(cur[r][j]); pv[2 * j] = bf16_lo(prv[r][j]); pv[2 * j + 1] = bf16_hi(prv[r][j]); }
            f32x4 o0, o1;
#pragma unroll
            for (int j = 0; j < 4; ++j) { o0[j] = cv[j] + (pv[j] - cv[j]) * m0[j]; o1[j] = cv[4 + j] + (pv[4 + j] - cv[4 + j]) * m1[j]; }
            LAS float* d = UM + ld_t[r] * 448 + ld_c[r]; *(LAS f32x4*)d = o0; *(LAS f32x4*)(d + 4) = o1;
        }
        if (c + 1 < S / CH) issue_loads(t0 + CH);
        __syncthreads();
        {
            f32x4 acc = (f32x4){0.f, 0.f, 0.f, 0.f};
            const LAS float* src = UM + fc * 448 + (wave < 4 ? 192 : 256) + 8 * fq;
            if (wave < 4) { acc = __builtin_amdgcn_mfma_f32_16x16x32_bf16(act_frag<1>(src), bwa[0], acc, 0, 0, 0); acc = __builtin_amdgcn_mfma_f32_16x16x32_bf16(act_frag<1>(src + 32), bwa[1], acc, 0, 0, 0); }
            else          { acc = __builtin_amdgcn_mfma_f32_16x16x32_bf16(act_frag<0>(src), bwa[0], acc, 0, 0, 0); acc = __builtin_amdgcn_mfma_f32_16x16x32_bf16(act_frag<0>(src + 32), bwa[1], acc, 0, 0, 0); }
            LAS float* dst = (wave < 4 ? LW : LA) + 16 * (wave & 3) + fc;
#pragma unroll
            for (int r = 0; r < 4; ++r) dst[(4 * fq + r) * 64] = acc[r];
            f32x4 ag = (f32x4){0.f, 0.f, 0.f, 0.f};
            const LAS float* sg = UM + fc * 448 + 320 + 64 * (wave >> 2) + 8 * fq;
            ag = __builtin_amdgcn_mfma_f32_16x16x32_bf16(act_frag<2>(sg), bg[0], ag, 0, 0, 0); ag = __builtin_amdgcn_mfma_f32_16x16x32_bf16(act_frag<2>(sg + 32), bg[1], ag, 0, 0, 0);
            LAS float* dg = (wave < 4 ? LG0 : LG1) + 16 * (wave & 3) + fc;
#pragma unroll
            for (int r = 0; r < 4; ++r) dg[(4 * fq + r) * 64] = ag[r];
        }
        __syncthreads();
        float e_kk[2], e_b[2], e_k[2], e_r[2], e_ld[2];
#pragma unroll
        for (int tt = 0; tt < 2; ++tt) {
            const int t = 2 * wave + tt;
            const float xw = c_w0 + LW[t * 64 + lane];
            const float spn = (fmaxf(-xw, 0.f) + LN2 * flog2(1.0f + fexp2(-fabsf(xw) * LOG2E)));
            e_ld[tt] = -fexp2((-spn - 0.5f) * LOG2E);
            const float a = frcp(1.0f + fexp2(-(c_a0 + LA[t * 64 + lane]) * LOG2E));
            const float kraw = UM[t * 448 + 64 + lane], r = UM[t * 448 + lane];
            const float kkv = kraw * c_kk; const float ssq = wave_sum(kkv * kkv);
            const float kk = kkv * frsq(fmaxf(ssq, 1e-24f));
            const float kmod = kraw * (1.0f + (a - 1.0f) * c_ka);
            const float bb = kk * a;
            const float cbr = wave_sum(bb * r), ckr = wave_sum(kmod * r), bon = wave_sum(r * kmod * c_rk);
            if (lane == 0) { SC[t] = cbr; SC[16 + t] = ckr; SC[32 + t] = bon; }
            e_kk[tt] = kk; e_b[tt] = bb; e_k[tt] = kmod; e_r[tt] = r;
        }
        WT[wave * 64 + lane] = e_ld[0] + e_ld[1];
        __syncthreads();
        {
            float off = 0.f, tot = 0.f;
#pragma unroll
            for (int w = 0; w < 8; ++w) { const float x = WT[w * 64 + lane]; if (w < wave) off += x; tot += x; }
            const float c0 = off + e_ld[0], c1 = c0 + e_ld[1];
            const int t = 2 * wave;
            A1[t * 64 + lane] = -e_kk[0] * fexp2(off * LOG2E);       A1[(t + 1) * 64 + lane] = -e_kk[1] * fexp2(c0 * LOG2E);
            R1[t * 64 + lane] = e_r[0] * fexp2(c0 * LOG2E);          R1[(t + 1) * 64 + lane] = e_r[1] * fexp2(c1 * LOG2E);
            const float i0 = fexp2(-c0 * LOG2E), i1 = fexp2(-c1 * LOG2E);
            B1[t * 64 + lane] = e_b[0] * i0;                          B1[(t + 1) * 64 + lane] = e_b[1] * i1;
            K1[t * 64 + lane] = e_k[0] * i0;                          K1[(t + 1) * 64 + lane] = e_k[1] * i1;
            if (wave == 0) GC[lane] = fexp2(tot * LOG2E);
        }
        __syncthreads();
#pragma unroll 4
        for (int t = 0; t < CH; ++t) {
            const f32x4 a0 = *(const LAS f32x4*)(A1 + t * 64 + sj), a1 = *(const LAS f32x4*)(A1 + t * 64 + sj + 4);
            const f32x4 r0 = *(const LAS f32x4*)(R1 + t * 64 + sj), r1 = *(const LAS f32x4*)(R1 + t * 64 + sj + 4);
            const f32x4 b0 = *(const LAS f32x4*)(B1 + t * 64 + sj), b1 = *(const LAS f32x4*)(B1 + t * 64 + sj + 4);
            const f32x4 k0 = *(const LAS f32x4*)(K1 + t * 64 + sj), k1 = *(const LAS f32x4*)(K1 + t * 64 + sj + 4);
            const float v = UM[t * 448 + 128 + si], cbr = SC[t], ckr = SC[16 + t];
            float sa = (st[0] * a0[0] + st[1] * a0[1]) + (st[2] * a0[2] + st[3] * a0[3]) + ((st[4] * a1[0] + st[5] * a1[1]) + (st[6] * a1[2] + st[7] * a1[3]));
            float pp = (st[0] * r0[0] + st[1] * r0[1]) + (st[2] * r0[2] + st[3] * r0[3]) + ((st[4] * r1[0] + st[5] * r1[1]) + (st[6] * r1[2] + st[7] * r1[3]));
            sa = sum8(sa); pp = sum8(pp);
            if ((lane & 7) == 0) OO[t * 64 + si] = pp + sa * cbr + v * ckr;
#pragma unroll
            for (int n = 0; n < 4; ++n) { st[n] += sa * b0[n] + v * k0[n]; st[4 + n] += sa * b1[n] + v * k1[n]; }
        }
        {
            const f32x4 g0 = *(const LAS f32x4*)(GC + sj), g1 = *(const LAS f32x4*)(GC + sj + 4);
#pragma unroll
            for (int n = 0; n < 4; ++n) { st[n] *= g0[n]; st[4 + n] *= g1[n]; }
        }
        __syncthreads();
#pragma unroll
        for (int tt = 0; tt < 2; ++tt) {
            const int t = 2 * wave + tt;
            const float o = OO[t * 64 + lane];
            const float mean = wave_sum(o) * (1.0f / 64.0f); const float dlt = o - mean;
            const float var = wave_sum(dlt * dlt) * (1.0f / 64.0f);
            const float gn = dlt * (1.0f / sqrtf(var + 64e-5f)) * c_lnw + c_lnb;
            const float res = (gn + SC[32 + t] * UM[t * 448 + 128 + lane]) * (LG0[t * 64 + lane] + LG1[t * 64 + lane]);
            mix[(row0 + t0 + t) * D + 512 + h * HD + lane] = (bf16_t)(cvt_pk_bf16(res, 0.f) & 0xffffu);
        }
        __syncthreads();
    }
}

#endif

__device__ __forceinline__ void phase2a(const Params& p) {
    int tid = threadIdx.x; asm volatile("" : "+v"(tid));
    const int wave = tid >> 6, lane = tid & 63;
    const bf16_t* u = (const bf16_t*)(p.ws + WS_A);
    bf16_t* act = (bf16_t*)((unsigned char*)p.out + ACT_OFF);
    const f32x4 mu = *(const f32x4*)(p.shift_mu + (UXW - UR) + 4 * lane);
    const int stride = gridDim.x * NWAVES;
    int row = blockIdx.x * NWAVES + wave;
    u32x2 c = (u32x2){0u, 0u}, pv = (u32x2){0u, 0u};
    if (row < T) { const bf16_t* a = u + (size_t)row * NIN + UXW + 4 * lane; c = *(const u32x2*)a; if ((row & (S - 1)) != 0) pv = *(const u32x2*)(a - NIN); }
    for (; row < T; row += stride) {
        const float cv[4] = {bf16_lo(c.x), bf16_hi(c.x), bf16_lo(c.y), bf16_hi(c.y)}, pf[4] = {bf16_lo(pv.x), bf16_hi(pv.x), bf16_lo(pv.y), bf16_hi(pv.y)};
        const int nrow = row + stride;
        if (nrow < T) { const bf16_t* a = u + (size_t)nrow * NIN + UXW + 4 * lane; c = *(const u32x2*)a; pv = (u32x2){0u, 0u}; if ((nrow & (S - 1)) != 0) pv = *(const u32x2*)(a - NIN); }
        float x[4];
#pragma unroll
        for (int j = 0; j < 4; ++j) { x[j] = cv[j] + (pf[j] - cv[j]) * mu[j];
            if (lane < 16) x[j] = 1.0f - 2.0f * frcp(1.0f + fexp2(x[j] * (2.0f * LOG2E)));
            else if (lane >= 32) x[j] = frcp(1.0f + fexp2(-x[j] * LOG2E)); }
        *(u32x2*)(act + (size_t)row * 256 + 4 * lane) = (u32x2){cvt_pk_bf16(x[0], x[1]), cvt_pk_bf16(x[2], x[3])};
    }
}

__device__ __forceinline__ void phase2(const Params& p, LAS unsigned char* lds) {
    const int nchain = NB * NH, G = gridDim.x, wave = threadIdx.x >> 6;
    const int nscan = G >= 2 * nchain ? nchain : (G > 1 ? G / 2 : 0);
    if ((int)blockIdx.x < nscan || nscan == 0) {
        const int stride = nscan == 0 ? G : nscan;
        for (int it = blockIdx.x; it < nchain; it += stride) rwkv_chain(p, lds, it / NH, it % NH);
    }
    if ((int)blockIdx.x >= nscan) {
        const int nb = G - nscan, bi = blockIdx.x - nscan;
        for (int it = bi * 8 + wave; it < NB * NH * 64; it += nb * 8) attn_tile(p, lds + wave * 9216, it / (NH * 64), (it / 64) % NH, 63 - (it % 64));
        __syncthreads();
        p0_expert_weights(p, lds, bi * 8 + wave, nb * 8);
    }
}

struct EpiH {
    const float* x; bf16_t* hb; int row0, col0;
    __device__ __forceinline__ void operator()(const f32x4 (&acc)[2][2][4][2], const unsigned (&m0)[8], const unsigned (&m1)[8], int wr, int wc, int fr, int fq) const {
#pragma unroll
        for (int ai = 0; ai < 2; ++ai)
#pragma unroll
            for (int m = 0; m < 4; ++m) { const size_t off = (size_t)(row0 + ai * 128 + wr * 64 + m * 16 + fr) * D + col0 + wc * 32 + 8 * fq;
#pragma unroll
                for (int bj = 0; bj < 2; ++bj) { const f32x4 v0 = *(const f32x4*)(x + off + bj * 128) + acc[ai][bj][m][0], v1 = *(const f32x4*)(x + off + bj * 128 + 4) + acc[ai][bj][m][1];
                    *(u32x4*)(hb + off + bj * 128) = (u32x4){cvt_pk_bf16(v0[0], v0[1]), cvt_pk_bf16(v0[2], v0[3]), cvt_pk_bf16(v1[0], v1[1]), cvt_pk_bf16(v1[2], v1[3])}; }
                if (m & 1) asm volatile("" ::: "memory"); }
    }
};
__device__ __forceinline__ void phase3(const Params& p, LAS unsigned char* lds) {
    constexpr int nM = T / 256, nN = D / 256;
    unsigned aoff[2][2]; g8::aoff_rows(aoff, D);
    for (int L = blockIdx.x; L < nM * nN; L += gridDim.x) {
        int pm, pn; g8::tile_order(L, nM, nN, pm, pn);
        EpiH E{p.x, (bf16_t*)(p.ws + WS_A), pm * 256, pn * 256};
        g8::gemm_unit(lds, (const char*)(p.ws + WS_B) + (size_t)pm * 256 * D * 2, aoff, (const char*)(p.ws + WS_WOUT) + (size_t)pn * 256 * D * 2, D, E);
    }
}

__device__ __forceinline__ void phase4(const Params& p, LAS unsigned char* lds) {
    int tid = threadIdx.x; asm volatile("" : "+v"(tid));
    const int wave = tid >> 6, lane = tid & 63, fr = lane & 15, fq = lane >> 4;
    const float* hsrc = p.out; bf16_t* hb = (bf16_t*)(p.ws + WS_A); float* rstd2 = (float*)(p.ws + WS_RSTD2);
    const bf16_t* wr_hi = (const bf16_t*)(p.ws + WS_WR); const bf16_t* wr_lo = wr_hi + 48 * D;
    int* list = (int*)(p.ws + WS_LIST); float* listw = (float*)(p.ws + WS_LISTW); float* listr = (float*)(p.ws + WS_LISTR); unsigned* cnt = (unsigned*)(p.ws + WS_CTL);
    LAS float* lg = (LAS float*)(lds + wave * 3072);
    LAS unsigned* lcnt = (LAS unsigned*)(lds + 8 * 3072);
    LAS unsigned* gbase = lcnt + 32;
    for (int blk = blockIdx.x; blk < T / 128; blk += gridDim.x) {
        if (tid < 32) lcnt[tid] = 0u;
        __syncthreads();
        const int tok0 = blk * 128 + wave * 16;
        f32x4 acc[3];
#pragma unroll
        for (int n = 0; n < 3; ++n) acc[n] = (f32x4){0.f, 0.f, 0.f, 0.f};
        float ss = 0.f;
        const bf16_t* hbp = hb + (size_t)(tok0 + fr) * D + 8 * fq;
        LAS unsigned char* wl_ = lds + 32768;
#pragma unroll 1
        for (int half = 0; half < 2; ++half) {
            __syncthreads();
            for (int i = tid; i < 2 * 48 * 64; i += NTHREADS) { const int mat = i / 3072, r = (i % 3072) >> 6, ch = i & 63;
                *(LAS u32x4*)(wl_ + mat * 49152 + r * 1024 + ((ch ^ (r & 15)) << 4)) = *(const u32x4*)((mat ? wr_lo : wr_hi) + (size_t)r * D + half * 512 + ch * 8); }
            u32x4 av[16];
#pragma unroll
            for (int ks = 0; ks < 16; ++ks) av[ks] = *(const u32x4*)(hbp + half * 512 + 32 * ks);
            __syncthreads();
#pragma unroll
            for (int ks = 0; ks < 16; ++ks) {
                float f[8]; f8_from_bf16(av[ks], f);
                ss += (f[0] * f[0] + f[1] * f[1]) + (f[2] * f[2] + f[3] * f[3]) + ((f[4] * f[4] + f[5] * f[5]) + (f[6] * f[6] + f[7] * f[7]));
                const bf16x8 ah = __builtin_bit_cast(bf16x8, av[ks]);
#pragma unroll
                for (int n = 0; n < 3; ++n) {
                    const int r = 16 * n + fr, off = r * 1024 + (((4 * ks + fq) ^ (r & 15)) << 4);
                    const bf16x8 wh = *(const LAS bf16x8*)(wl_ + off), wl = *(const LAS bf16x8*)(wl_ + 49152 + off);
                    acc[n] = __builtin_amdgcn_mfma_f32_16x16x32_bf16(ah, wh, acc[n], 0, 0, 0);
                    acc[n] = __builtin_amdgcn_mfma_f32_16x16x32_bf16(ah, wl, acc[n], 0, 0, 0);
                }
            }
        }
        ss += __shfl_xor(ss, 16); ss += __shfl_xor(ss, 32);
        const float rs = 1.0f / sqrtf(ss * (1.0f / D) + 1e-6f);
        if (fq == 0) rstd2[tok0 + fr] = rs;
#pragma unroll
        for (int n = 0; n < 3; ++n)
#pragma unroll
            for (int r = 0; r < 4; ++r) lg[(4 * fq + r) * 48 + 16 * n + fr] = acc[n][r];
        LDS_WAIT();
        int e0 = 0, e1 = 0; float w0 = 0.f, w1 = 0.f; unsigned lp0 = 0, lp1 = 0;
        if (lane < 16) {
            const float rst = rs;
            const LAS float* L = lg + lane * 48;
            float gl[4]; int gi = 0; float gm;
#pragma unroll
            for (int g = 0; g < 4; ++g) gl[g] = L[g] * rst + p.r_grp_b[g];
            gm = gl[0];
#pragma unroll
            for (int g = 1; g < 4; ++g) if (gl[g] > gm) { gm = gl[g]; gi = g; }
            float gs = 0.f;
#pragma unroll
            for (int g = 0; g < 4; ++g) gs += __expf(gl[g] - gm);
            const float gval = 1.0f / gs;
            float el[8];
#pragma unroll
            for (int e = 0; e < 8; ++e) el[e] = L[4 + gi * 8 + e] * rst + p.r_exp_b[gi * 8 + e];
            int i0 = 0; float m0 = el[0];
#pragma unroll
            for (int e = 1; e < 8; ++e) if (el[e] > m0) { m0 = el[e]; i0 = e; }
            int i1 = i0 == 0 ? 1 : 0; float m1 = el[i1];
#pragma unroll
            for (int e = 0; e < 8; ++e) if (e != i0 && el[e] > m1) { m1 = el[e]; i1 = e; }
            const float x1 = __expf(m1 - m0); const float den = 1.0f / (1.0f + x1);
            e0 = gi * 8 + i0; e1 = gi * 8 + i1; w0 = gval * den; w1 = gval * x1 * den;
            lp0 = atomicAdd((unsigned*)&lcnt[e0], 1u); lp1 = atomicAdd((unsigned*)&lcnt[e1], 1u);
        }
        __syncthreads();
        if (tid < 32) gbase[tid] = atomicAdd(&cnt[tid], lcnt[tid]);
        __syncthreads();
        if (lane < 16) {
            const int tok = tok0 + lane;
            const unsigned q0 = gbase[e0] + lp0, q1 = gbase[e1] + lp1;
            list[(size_t)e0 * T + q0] = tok * 2;     listw[(size_t)e0 * T + q0] = w0; listr[(size_t)e0 * T + q0] = rs;
            list[(size_t)e1 * T + q1] = tok * 2 + 1; listw[(size_t)e1 * T + q1] = w1; listr[(size_t)e1 * T + q1] = rs;
        }
        __syncthreads();
    }
}

constexpr int LDS_MAP = 161792;
__device__ __forceinline__ void expert_map_build(const unsigned* cnt, LAS unsigned char* lds) {
    LAS int* pre = (LAS int*)(lds + LDS_MAP); LAS int* cn = pre + 40;
    if (threadIdx.x == 0) { int acc = 0; for (int i = 0; i < NE; ++i) { const int ci = (int)__hip_atomic_load(cnt + i, __ATOMIC_RELAXED, __HIP_MEMORY_SCOPE_AGENT); pre[i] = acc; cn[i] = ci; acc += (ci + 255) >> 8; } pre[NE] = acc; }
    __syncthreads();
}
__device__ __forceinline__ void expert_find(LAS unsigned char* lds, int mt, int& e, int& local, int& c) {
    const LAS int* pre = (const LAS int*)(lds + LDS_MAP); const LAS int* cn = pre + 40;
    int lo = 0;
#pragma unroll 1
    for (int i = 1; i < NE; ++i) if (pre[i] <= mt) lo = i;
    e = __builtin_amdgcn_readfirstlane(lo); local = mt - __builtin_amdgcn_readfirstlane(pre[e]); c = __builtin_amdgcn_readfirstlane(cn[e]);
}
__device__ __forceinline__ int expert_tiles(LAS unsigned char* lds) { return __builtin_amdgcn_readfirstlane(((const LAS int*)(lds + LDS_MAP))[NE]); }

struct EpiGU {
    bf16_t* hid; const float* rstd2; const int* lst; int cnt, p0, hrow0, ct;
    __device__ __forceinline__ void operator()(const f32x4 (&acc)[2][2][4][2], const unsigned (&m0)[8], const unsigned (&m1)[8], int wr, int wc, int fr, int fq) const {
#pragma unroll
        for (int ai = 0; ai < 2; ++ai)
#pragma unroll
            for (int m = 0; m < 4; ++m) { const int r = ai * 128 + wr * 64 + m * 16 + fr; const int pp = p0 + r;
                const float rs = pp < cnt ? __uint_as_float(m0[ai * 4 + m]) : 0.f;
                bf16_t* op = hid + (size_t)(hrow0 + r) * DE + ct * 128 + wc * 32 + 8 * fq;
                float o[8];
#pragma unroll
                for (int n = 0; n < 2; ++n) { const f32x4 g = acc[ai][0][m][n] * rs, uu = acc[ai][1][m][n] * rs;
#pragma unroll
                    for (int j = 0; j < 4; ++j) o[4 * n + j] = g[j] * frcp(1.0f + fexp2(-g[j] * LOG2E)) * uu[j]; }
                *(u32x4*)op = (u32x4){cvt_pk_bf16(o[0], o[1]), cvt_pk_bf16(o[2], o[3]), cvt_pk_bf16(o[4], o[5]), cvt_pk_bf16(o[6], o[7])}; }
    }
};
__device__ __forceinline__ void phase5(const Params& p, LAS unsigned char* lds) {
    expert_map_build((const unsigned*)(p.ws + WS_CTL), lds);
    const int MT = expert_tiles(lds);
    const int tid = threadIdx.x;
    for (int unit = blockIdx.x; unit < MT * 2; unit += gridDim.x) {
        const int mt = unit >> 1, ct = unit & 1; int e, local, c; expert_find(lds, mt, e, local, c);
        const int* lst = (const int*)(p.ws + WS_LIST) + (size_t)e * T; const int p0 = local * 256;
        unsigned aoff[2][2];
#pragma unroll
        for (int i = 0; i < 2; ++i) { int R, C; g8::stage_rc(tid * 16 + i * 8192, R, C);
#pragma unroll
            for (int hh = 0; hh < 2; ++hh) { const int pp = p0 + hh * 128 + R; const int tok = pp < c ? (lst[pp] >> 1) : 0; aoff[hh][i] = (unsigned)(tok * D + C) * 2u; } }
        EpiGU E{(bf16_t*)(p.ws + WS_B), (const float*)(p.ws + WS_RSTD2), lst, c, p0, mt * 256, ct};
        g8::gemm_unit(lds, (const char*)(p.ws + WS_A), aoff, (const char*)(p.ws + WS_WGU) + ((size_t)e * 512 + ct * 256) * D * 2, D, E, (const unsigned*)(p.ws + WS_LISTR) + (size_t)e * T + p0);
    }
}
struct EpiDN {
    bf16_t* y; bf16_t* dummy; const int* lst; const float* lw; int cnt, p0, col0;
    __device__ __forceinline__ void operator()(const f32x4 (&acc)[2][2][4][2], const unsigned (&m0)[8], const unsigned (&m1)[8], int wr, int wc, int fr, int fq) const {
#pragma unroll
        for (int ai = 0; ai < 2; ++ai)
#pragma unroll
            for (int m = 0; m < 4; ++m) { const int pp = p0 + ai * 128 + wr * 64 + m * 16 + fr;
                const bool ok = pp < cnt; const int rl = pp - p0; const int ent = (int)m0[ai * 4 + m]; const float w = __uint_as_float(m1[ai * 4 + m]);
                bf16_t* op = (ok ? y + ((size_t)(ent & 1) * T + (ent >> 1)) * D : dummy) + col0 + wc * 32 + 8 * fq;
#pragma unroll
                for (int bj = 0; bj < 2; ++bj) { const f32x4 v0 = acc[ai][bj][m][0] * w, v1 = acc[ai][bj][m][1] * w;
                    *(u32x4*)(op + bj * 128) = (u32x4){cvt_pk_bf16(v0[0], v0[1]), cvt_pk_bf16(v0[2], v0[3]), cvt_pk_bf16(v1[0], v1[1]), cvt_pk_bf16(v1[2], v1[3])}; }
                if (m & 1) asm volatile("" ::: "memory"); }
    }
};
__device__ __forceinline__ void phase6(const Params& p, LAS unsigned char* lds) {
    expert_map_build((const unsigned*)(p.ws + WS_CTL), lds);
    const int MT = expert_tiles(lds);
    constexpr int kdn = DE;
    unsigned aoff[2][2]; g8::aoff_rows(aoff, kdn);
    for (int unit = blockIdx.x; unit < MT * 4; unit += gridDim.x) {
        const int mt = unit >> 2, pn = unit & 3; int e, local, c; expert_find(lds, mt, e, local, c);
        EpiDN E{(bf16_t*)(p.ws + WS_A + (size_t)T * D * 2), (bf16_t*)(p.ws + WS_A + (size_t)3 * T * D * 2), (const int*)(p.ws + WS_LIST) + (size_t)e * T, (const float*)(p.ws + WS_LISTW) + (size_t)e * T, c, local * 256, pn * 256};
        g8::gemm_unit(lds, (const char*)(p.ws + WS_B) + (size_t)mt * 256 * DE * 2, aoff, (const char*)(p.ws + WS_WDN) + ((size_t)e * D + pn * 256) * DE * 2, kdn, E, (const unsigned*)(p.ws + WS_LIST) + (size_t)e * T + local * 256, (const unsigned*)(p.ws + WS_LISTW) + (size_t)e * T + local * 256);
    }
}

__device__ __forceinline__ void phase7(const Params& p) {
    int tid7 = threadIdx.x; asm volatile("" : "+v"(tid7));
    const int wave = tid7 >> 6, lane = tid7 & 63;
    const bf16_t* hb = (const bf16_t*)(p.ws + WS_A);
    const bf16_t* y0 = (const bf16_t*)(p.ws + WS_A + (size_t)T * D * 2); const bf16_t* y1 = y0 + (size_t)T * D;
    f32x4 g[4];
#pragma unroll
    for (int j = 0; j < 4; ++j) g[j] = *((const f32x4*)p.final_g + lane + 64 * j);
    const int stride = gridDim.x * NWAVES;
    int row = blockIdx.x * NWAVES + wave;
    u32x2 hv[4], ya[4], yb[4];
    if (row < T) {
#pragma unroll
        for (int j = 0; j < 4; ++j) { hv[j] = ((const u32x2*)(hb + (size_t)row * D) + lane)[64 * j]; ya[j] = ((const u32x2*)(y0 + (size_t)row * D) + lane)[64 * j]; yb[j] = ((const u32x2*)(y1 + (size_t)row * D) + lane)[64 * j]; }
    }
    for (; row < T; row += stride) {
        f32x4 v[4]; float s = 0.f;
#pragma unroll
        for (int j = 0; j < 4; ++j) {
            v[j][0] = bf16_lo(hv[j].x) + (bf16_lo(ya[j].x) + bf16_lo(yb[j].x)); v[j][1] = bf16_hi(hv[j].x) + (bf16_hi(ya[j].x) + bf16_hi(yb[j].x)); v[j][2] = bf16_lo(hv[j].y) + (bf16_lo(ya[j].y) + bf16_lo(yb[j].y)); v[j][3] = bf16_hi(hv[j].y) + (bf16_hi(ya[j].y) + bf16_hi(yb[j].y));
            s += (v[j][0] * v[j][0] + v[j][1] * v[j][1]) + (v[j][2] * v[j][2] + v[j][3] * v[j][3]); }
        const int nrow = row + stride;
        if (nrow < T) {
#pragma unroll
            for (int j = 0; j < 4; ++j) { hv[j] = ((const u32x2*)(hb + (size_t)nrow * D) + lane)[64 * j]; ya[j] = ((const u32x2*)(y0 + (size_t)nrow * D) + lane)[64 * j]; yb[j] = ((const u32x2*)(y1 + (size_t)nrow * D) + lane)[64 * j]; }
        }
        s = wave_sum(s);
        const float rs = 1.0f / sqrtf(s * (1.0f / D) + 1e-6f);
        f32x4* orow = (f32x4*)(p.out + (size_t)row * D) + lane;
#pragma unroll
        for (int j = 0; j < 4; ++j) orow[64 * j] = v[j] * rs * g[j];
    }
}

__global__ __launch_bounds__(512) void mega(Params p) {
    extern __shared__ __attribute__((aligned(16))) unsigned char lds_raw[];
    LAS unsigned char* lds = (LAS unsigned char*)lds_raw;
    volatile LAS unsigned* bst = (volatile LAS unsigned*)(lds + LDS_MAP + 512);
    if (threadIdx.x == 0) { bst[0] = 0u; bst[1] = 0u; bst[2] = 0u; bst[3] = 0u; }
    __syncthreads();
    const XcdBarrier gb = xcd_barrier_post((unsigned*)(p.ws + WS_BAR), bst);
#define GSYNC() xcd_barrier(gb)
#ifndef PHASE_MASK
#define PHASE_MASK 0xff
#endif
#ifdef TPROBE
    volatile LAS unsigned long long* tsl = (volatile LAS unsigned long long*)(lds + LDS_MAP + 640);
    if (threadIdx.x == 0) tsl[0] = __builtin_amdgcn_s_memrealtime();
#define TS(i) do { if (threadIdx.x == 0 && ((i) == TPROBE || (i) == TPROBE + 1)) tsl[i] = __builtin_amdgcn_s_memrealtime(); } while (0)
#else
#define TS(i)
#endif
    if (PHASE_MASK & 1) phase0(p, lds); GSYNC(); TS(1);
    if (PHASE_MASK & 2) phase1(p, lds); GSYNC(); TS(2);
    if (PHASE_MASK & 4) { phase2a(p); GSYNC(); phase2(p, lds); } GSYNC(); TS(3);
#ifdef RWDEBUG
    {
        bf16_t* dbg = (bf16_t*)(p.ws + WS_A + (size_t)3 * T * D * 2 + 4096);
        float* red = (float*)(p.ws + WS_CTL + 2048);
        if (blockIdx.x == 0) {
            rwkv_chain_seq(p, lds, RWDEBUG_B, RWDEBUG_H, dbg - (size_t)RWDEBUG_B * S * D, 2 * RWDEBUG_C1);
            __syncthreads();
            const bf16_t* mix = (const bf16_t*)(p.ws + WS_B);
            float md = 0.f, mr = 0.f; int bad = 0;
            for (int i = threadIdx.x; i < (RWDEBUG_C1 - RWDEBUG_C0) * 32 * 64; i += NTHREADS) {
                const int t = RWDEBUG_C0 * 32 + i / 64, col = 512 + RWDEBUG_H * 64 + (i % 64);
                const float a = __uint_as_float((unsigned)mix[((size_t)RWDEBUG_B * S + t) * D + col] << 16), r = __uint_as_float((unsigned)dbg[(size_t)t * D + col] << 16);
                if (!(fabsf(a) < 1e30f)) bad++;
                else { md = fmaxf(md, fabsf(a - r)); } mr = fmaxf(mr, fabsf(r));
            }
            LAS float* sh = (LAS float*)lds;
            sh[threadIdx.x] = md; sh[512 + threadIdx.x] = mr; sh[1024 + threadIdx.x] = (float)bad; __syncthreads();
            if (threadIdx.x == 0) { float a = 0.f, r = 0.f, nb = 0.f; for (int i = 0; i < NTHREADS; ++i) { a = fmaxf(a, sh[i]); r = fmaxf(r, sh[512 + i]); nb += sh[1024 + i]; }
                float rel = a / fmaxf(r, 1e-20f); float code = nb > 0.f ? 40.0f : (rel < 0.03f ? 5.0f : (rel < 0.3f ? 10.0f : 20.0f));
                red[0] = code; }
        }
        GSYNC();
        const float code = ((const float*)(p.ws + WS_CTL + 2048))[0];
        for (size_t i = (size_t)blockIdx.x * NTHREADS + threadIdx.x; i < (size_t)T * D; i += (size_t)gridDim.x * NTHREADS) p.out[i] = code;
        return;
    }
#endif
    if (PHASE_MASK & 8) phase3(p, lds); GSYNC(); TS(4);
    if (PHASE_MASK & 16) phase4(p, lds); GSYNC(); TS(5);
    if (PHASE_MASK & 32) phase5(p, lds); GSYNC(); TS(6);
    if (PHASE_MASK & 64) phase6(p, lds); GSYNC(); TS(7);
    if (PHASE_MASK & 128) phase7(p);
#ifdef TPROBE
    GSYNC(); TS(8);
    float* tw = (float*)(p.ws + WS_CTL + 1024);
    if (blockIdx.x == 0 && threadIdx.x == 0) { const float t1 = (float)(tsl[TPROBE + 1] - tsl[TPROBE]) * 0.01f; tw[0] = floorf(log2f(t1) * TPQ + 0.5f) / TPQ; }
    GSYNC();
    const float c1 = tw[0];
    int tq_ = threadIdx.x; asm volatile("" : "+v"(tq_));
    for (size_t i = (size_t)blockIdx.x * NTHREADS + tq_; i < (size_t)T * D; i += (size_t)gridDim.x * NTHREADS) p.out[i] = c1;
#endif
}

extern "C" void kernel_launch(void* const* d_in, const int* in_sizes, int n_in, void* d_out, int out_size, void* d_ws, size_t ws_size, hipStream_t stream) {
    static int grid = 0;
    if (grid == 0) {
        if (n_in != 25 || out_size != T * D || ws_size < WS_END) { fprintf(stderr, "kernel_launch: unexpected sizes n_in %d out %d ws %zu (need %zu)\n", n_in, out_size, ws_size, (size_t)WS_END); grid = -1; return; }
        int dev = 0, cus = 0, per_cu = 0;
        (void)hipGetDevice(&dev); (void)hipDeviceGetAttribute(&cus, hipDeviceAttributeMultiprocessorCount, dev);
        if (hipFuncSetAttribute((const void*)mega, hipFuncAttributeMaxDynamicSharedMemorySize, LDS_BYTES) != hipSuccess) { fprintf(stderr, "kernel_launch: hipFuncSetAttribute failed\n"); grid = -1; return; }
        if (hipOccupancyMaxActiveBlocksPerMultiprocessor(&per_cu, (const void*)mega, NTHREADS, LDS_BYTES) != hipSuccess || per_cu < 1) { fprintf(stderr, "kernel_launch: occupancy query failed (%d)\n", per_cu); (void)hipGetLastError(); per_cu = 1; }
        grid = cus * 1;
    }
    if (grid < 0) return;
    Params p{};
    const float** f = (const float**)&p;
    for (int i = 0; i < 25; ++i) f[i] = (const float*)d_in[i];
    p.out = (float*)d_out; p.ws = (unsigned char*)d_ws;
    if (hipMemsetAsync((char*)d_ws + WS_BAR, 0, XCD_BAR_WORDS * 4, stream) != hipSuccess) { fprintf(stderr, "kernel_launch: memset failed\n"); return; }
    hipLaunchKernelGGL(mega, dim3(grid), dim3(NTHREADS), LDS_BYTES, stream, p);
    hipError_t e = hipPeekAtLastError();
    if (e != hipSuccess) fprintf(stderr, "launch failed: %s (grid %d)\n", hipGetErrorString(e), grid);
}
```

```cpp
#include <hip/hip_runtime.h>
#include <cstdio>
#include <cstdint>
#define TPQ 8.0f

#define LAS __attribute__((address_space(3)))
typedef unsigned short bf16_t;
typedef short bf16x8 __attribute__((ext_vector_type(8)));
typedef short s16x4 __attribute__((ext_vector_type(4)));
typedef float f32x4 __attribute__((ext_vector_type(4)));
typedef float f32x2 __attribute__((ext_vector_type(2)));
typedef float f32x16 __attribute__((ext_vector_type(16)));
typedef unsigned u32x2 __attribute__((ext_vector_type(2)));
typedef unsigned u32x4 __attribute__((ext_vector_type(4)));

constexpr int NB = 16, S = 2048, T = NB * S, D = 1024, NIN = 3328, NH = 8, HD = 64;
constexpr int UQ = 0, UK = 512, UV = 1024, UR = 1536, URK = 2048, URV = 2560, UXW = 3072, UXA = 3136, UXG = 3200;
constexpr int NE = 32, DE = 256;
constexpr float LOG2E = 1.4426950408889634f, LN2 = 0.6931471805599453f;
constexpr float QSCALE = 0.125f * LOG2E;
constexpr int NTHREADS = 512, NWAVES = 8;
constexpr int LDS_BYTES = 161792 + 1024;

constexpr size_t WS_CTL   = 0;
constexpr size_t WS_BAR   = 8192;
constexpr size_t WS_WIN   = 65536;
constexpr size_t WS_WOUT  = WS_WIN  + (size_t)NIN * D * 2;
constexpr size_t WS_WGU   = WS_WOUT + (size_t)D * D * 2;
constexpr size_t WS_WDN   = WS_WGU  + (size_t)NE * 512 * D * 2;
constexpr size_t WS_RSTD1 = WS_WDN  + (size_t)NE * D * DE * 2;
constexpr size_t WS_RSTD2 = WS_RSTD1 + (size_t)T * 4;
constexpr size_t WS_LIST  = WS_RSTD2 + (size_t)T * 4;
constexpr size_t WS_LISTW = WS_LIST + (size_t)NE * T * 4;
constexpr size_t WS_LISTR = WS_LISTW + (size_t)NE * T * 4;
constexpr size_t WS_WR    = WS_LISTR + (size_t)NE * T * 4;
constexpr size_t WS_LT    = WS_WR + (size_t)2 * 48 * D * 2;
constexpr size_t WS_A     = WS_LT + (size_t)512 * 256 * 2;
constexpr size_t WS_B     = WS_A + (size_t)T * NIN * 2;
constexpr size_t WS_END   = WS_B + (size_t)T * D * 2;
constexpr int HID_ROWS = 2 * T + NE * 256;

struct Params {
    const float* x; const float* norm_mix_g; const float* w_in; const float* shift_mu; const float* sb_out_g;
    const float* rw_w0; const float* rw_w2; const float* rw_a0; const float* rw_a2; const float* rw_g2;
    const float* rw_k_k; const float* rw_k_a; const float* rw_r_k; const float* rw_ln_w; const float* rw_ln_b;
    const float* w_out; const float* norm_ffn_g; const float* r_grp_w; const float* r_grp_b; const float* r_exp_w; const float* r_exp_b;
    const float* w_gate; const float* w_up; const float* w_down; const float* final_g;
    float* out; unsigned char* ws;
};

typedef __bf16 bf16x2_t __attribute__((ext_vector_type(2)));
__device__ __forceinline__ unsigned cvt_pk_bf16(float lo, float hi) { const f32x2 v = {lo, hi}; return __builtin_bit_cast(unsigned, __builtin_convertvector(v, bf16x2_t)); }
__device__ __forceinline__ float bf16_lo(unsigned w) { return __uint_as_float(w << 16); }
__device__ __forceinline__ float bf16_hi(unsigned w) { return __uint_as_float(w & 0xffff0000u); }
__device__ __forceinline__ float fexp2(float x) { return __builtin_amdgcn_exp2f(x); }
__device__ __forceinline__ float flog2(float x) { return __builtin_amdgcn_logf(x); }
__device__ __forceinline__ float frcp(float x) { return __builtin_amdgcn_rcpf(x); }
__device__ __forceinline__ float frsq(float x) { return __builtin_amdgcn_rsqf(x); }
template <int CTRL> __device__ __forceinline__ float dppf(float v) { return __builtin_bit_cast(float, __builtin_amdgcn_update_dpp(0, __builtin_bit_cast(int, v), CTRL, 0xF, 0xF, true)); }
__device__ __forceinline__ float rlane(float v, int l) { return __builtin_bit_cast(float, __builtin_amdgcn_readlane(__builtin_bit_cast(int, v), l)); }
__device__ __forceinline__ float sum8(float v) { v += dppf<0xB1>(v); v += dppf<0x4E>(v); v += dppf<0x141>(v); return v; }
__device__ __forceinline__ float sum16(float v) { v = sum8(v); v += dppf<0x140>(v); return v; }
__device__ __forceinline__ float wave_sum(float v) { v = sum16(v); return (rlane(v, 0) + rlane(v, 16)) + (rlane(v, 32) + rlane(v, 48)); }
__device__ __forceinline__ float swap32(float v) { return __shfl_xor(v, 32); }
#define LDS_WAIT() asm volatile("s_waitcnt lgkmcnt(0)" ::: "memory")


#define XB_TMO      128
#define XB_XCNT(j)  (256  + 64 * (j))
#define XB_XSUB(j)  (1280 + 64 * (j))
#define XB_XGEN(j)  (2304 + 64 * (j))
#define XB_TOP      3328
#define XB_TOPGEN   3392
#define XCD_BAR_WORDS 3456
#define XB_SPIN_CAP (1u << 22)
__device__ __forceinline__ unsigned xb_ld(unsigned* p)              { return __hip_atomic_load(p, __ATOMIC_RELAXED, __HIP_MEMORY_SCOPE_AGENT); }
__device__ __forceinline__ unsigned xb_add(unsigned* p, unsigned v) { return __hip_atomic_fetch_add(p, v, __ATOMIC_RELAXED, __HIP_MEMORY_SCOPE_AGENT); }
__device__ __forceinline__ unsigned xb_xcc_id() { return (unsigned)__builtin_amdgcn_s_getreg((3 << 11) | 20) & 0xFu; }
#define XB_SPIN(cond, bar) do { unsigned _sp = 0; while (cond) { __builtin_amdgcn_s_sleep(1); \
    if ((++_sp & 255u) == 0u) { if (xb_ld(&(bar)[XB_TMO])) break; if (_sp > XB_SPIN_CAP) { atomicAdd(&(bar)[XB_TMO], 1u); break; } } } } while (0)
struct XcdBarrier { unsigned* bar; unsigned x; volatile LAS unsigned* st; };
__device__ __forceinline__ XcdBarrier xcd_barrier_post(unsigned* bar, volatile LAS unsigned* st) {
    XcdBarrier b; b.bar = bar; b.x = xb_xcc_id(); b.st = st;
    if (threadIdx.x == 0) (void)xb_add(&bar[XB_XCNT(b.x)], 1u);
    return b;
}
__device__ __forceinline__ void xcd_barrier_complete(unsigned* bar, unsigned x, unsigned& nloc, unsigned& nx) {
    const unsigned G = gridDim.x * gridDim.y * gridDim.z;
    unsigned sum, cnt, mine, sp = 0u;
    for (;;) {
        sum = 0u; cnt = 0u; mine = 0u;
#pragma unroll
        for (unsigned j = 0; j < 16; ++j) { const unsigned c = xb_ld(&bar[XB_XCNT(j)]); sum += c; cnt += (c > 0u) ? 1u : 0u; mine = (j == x) ? c : mine; }
        if (sum == G) break;
        __builtin_amdgcn_s_sleep(1);
        if ((++sp & 255u) == 0u) { if (xb_ld(&bar[XB_TMO])) break; if (sp > XB_SPIN_CAP) { atomicAdd(&bar[XB_TMO], 1u); break; } }
    }
    nloc = mine > 0u ? mine : 1u; nx = cnt > 0u ? cnt : 1u;
}
__device__ __forceinline__ void xcd_barrier(const XcdBarrier& b) {
    asm volatile("s_waitcnt vmcnt(0)" ::: "memory");
    __syncthreads();
    if (threadIdx.x == 0) {
        unsigned* bar = b.bar;
        __builtin_amdgcn_s_waitcnt(0);
        unsigned nloc = b.st[0], nx = b.st[1];
        if (nloc == 0u) { xcd_barrier_complete(bar, b.x, nloc, nx); b.st[0] = nloc; b.st[1] = nx; }
        const unsigned old = xb_add(&bar[XB_XSUB(b.x)], 1u);
        const unsigned gen = old / nloc;
        if (old + 1u == (gen + 1u) * nloc) {
            __builtin_amdgcn_fence(__ATOMIC_RELEASE, "agent");
            asm volatile("s_waitcnt vmcnt(0)" ::: "memory");
            const unsigned og = xb_add(&bar[XB_TOP], 1u);
            const unsigned tg = og / nx;
            if (og + 1u == (tg + 1u) * nx) xb_add(&bar[XB_TOPGEN], 1u);
            else XB_SPIN(xb_ld(&bar[XB_TOPGEN]) == tg, bar);
            __builtin_amdgcn_fence(__ATOMIC_ACQUIRE, "agent");
            xb_add(&bar[XB_XGEN(b.x)], 1u);
            asm volatile("s_waitcnt vmcnt(0)" ::: "memory");
        } else {
            XB_SPIN(xb_ld(&bar[XB_XGEN(b.x)]) == gen, bar);
            __builtin_amdgcn_fence(__ATOMIC_ACQUIRE, "agent");
            asm volatile("s_waitcnt vmcnt(0)" ::: "memory");
        }
    }
    __syncthreads();
}

namespace g8 {
constexpr int BK = 64, HALF = 128, HTB = HALF * BK * 2;
__device__ __forceinline__ int lds_byte(int r, int c) { const int st = (r >> 4) * 2 + (c >> 5), rr = r & 15, cc = c & 31, ob = rr * 64 + cc * 2; return st * 1024 + (ob ^ (((ob >> 9) & 1) << 5)); }
__device__ __forceinline__ void stage_rc(int b, int& R, int& C) { const int st = b / 1024, sb = b % 1024, swz = sb ^ (((sb >> 9) & 1) << 5); R = (st >> 1) * 16 + swz / 64; C = (st & 1) * 32 + (swz % 64) / 2; }

#define G8_SA(b, h) (((b) * 2 + (h)) * HTB)
#define G8_SB(b, h) ((4 + (b) * 2 + (h)) * HTB)
#define G8_STAGE_A(bufoff, h, kt) do { _Pragma("unroll") for (int _i = 0; _i < 2; ++_i) \
    __builtin_amdgcn_global_load_lds((const unsigned*)((Ab + (size_t)(kt) * (BK * 2)) + aoff[h][_i]), (LAS unsigned*)(lds + (bufoff) + ldsw + _i * 8192), 16, 0, 0); } while (0)
#define G8_STAGE_B(bufoff, h, kt) do { _Pragma("unroll") for (int _i = 0; _i < 2; ++_i) \
    __builtin_amdgcn_global_load_lds((const unsigned*)((Bb + (size_t)(h) * bhalf + (size_t)(kt) * (BK * 2)) + boff[_i]), (LAS unsigned*)(lds + (bufoff) + ldsw + _i * 8192), 16, 0, 0); } while (0)
#define G8_LDA(dst, b, h) do { _Pragma("unroll") for (int m = 0; m < 4; ++m) _Pragma("unroll") for (int k = 0; k < 2; ++k) dst[m][k] = *(const LAS bf16x8*)(lds + G8_SA(b, h) + la_off + m * 2048 + k * 1024); } while (0)
#define G8_LDB(dst, b, h) do { _Pragma("unroll") for (int n = 0; n < 2; ++n) _Pragma("unroll") for (int k = 0; k < 2; ++k) dst[n][k] = *(const LAS bf16x8*)(lds + G8_SB(b, h) + lb_off + n * 2048 + k * 1024); } while (0)
#define G8_MMA(ai, bj, At, Bt) do { __builtin_amdgcn_s_setprio(1); _Pragma("unroll") for (int m = 0; m < 4; ++m) _Pragma("unroll") for (int n = 0; n < 2; ++n) _Pragma("unroll") for (int k = 0; k < 2; ++k) \
    acc[ai][bj][m][n] = __builtin_amdgcn_mfma_f32_16x16x32_bf16(Bt[n][k], At[m][k], acc[ai][bj][m][n], 0, 0, 0); __builtin_amdgcn_s_setprio(0); } while (0)
#define G8_WAIT_V(n) asm volatile("s_waitcnt vmcnt(" #n ")" ::: "memory")
#define G8_WAIT_L(n) asm volatile("s_waitcnt lgkmcnt(" #n ")" ::: "memory")
#define G8_BAR __builtin_amdgcn_s_barrier()
#define G8_SCHED __builtin_amdgcn_sched_barrier(0)

template <class Epi>
__device__ __forceinline__ void gemm_unit(LAS unsigned char* lds, const char* Ab, const unsigned (&aoff)[2][2], const char* Bb, int K, const Epi& E, const unsigned* meta0 = nullptr, const unsigned* meta1 = nullptr) {
    int tid = threadIdx.x; asm volatile("" : "+v"(tid));
    const int wid = __builtin_amdgcn_readfirstlane(tid >> 6), lane = tid & 63, wr = wid >> 2, wc = wid & 3, fr = lane & 15, fq = lane >> 4;
    const int nt = K / BK;
    unsigned boff[2];
#pragma unroll
    for (int i = 0; i < 2; ++i) { int R, C; stage_rc(tid * 16 + i * 8192, R, C); const int rho = R & 31, Rb = (R & ~31) + 8 * ((rho & 15) >> 2) + 4 * (rho >> 4) + (rho & 3);
        boff[i] = (unsigned)(Rb * K + C) * 2u; }
    const size_t bhalf = (size_t)HALF * K * 2;
    const unsigned ldsw = (unsigned)wid * 1024u;
    const int la_off = lds_byte(wr * 64 + fr, fq * 8), lb_off = lds_byte(wc * 32 + fr, fq * 8);
    f32x4 acc[2][2][4][2];
#pragma unroll
    for (int a = 0; a < 2; ++a)
#pragma unroll
        for (int b = 0; b < 2; ++b)
#pragma unroll
            for (int m = 0; m < 4; ++m)
#pragma unroll
                for (int n = 0; n < 2; ++n) acc[a][b][m][n] = (f32x4){0.f, 0.f, 0.f, 0.f};
    bf16x8 At[4][2], B0[2][2], B1[2][2];
    if (meta0) { if (wid < 4) __builtin_amdgcn_global_load_lds(meta0 + wid * 64 + lane, (LAS unsigned*)(lds + 131072 + wid * 256), 4, 0, 0);
                 else if (meta1) __builtin_amdgcn_global_load_lds(meta1 + (wid - 4) * 64 + lane, (LAS unsigned*)(lds + 131072 + 1024 + (wid - 4) * 256), 4, 0, 0); }
    G8_STAGE_B(G8_SB(0, 0), 0, 0); G8_STAGE_A(G8_SA(0, 0), 0, 0);
    G8_STAGE_B(G8_SB(0, 1), 1, 0); G8_STAGE_A(G8_SA(0, 1), 1, 0);
    if (wr == 1) G8_BAR;
    G8_WAIT_V(4); G8_BAR;
    G8_STAGE_B(G8_SB(1, 0), 0, 1); G8_STAGE_A(G8_SA(1, 0), 0, 1); G8_STAGE_B(G8_SB(1, 1), 1, 1);
    G8_WAIT_V(6); G8_BAR;
    for (int t = 0; t < nt - 2; t += 2) {
        G8_LDB(B0, 0, 0); G8_SCHED; G8_LDA(At, 0, 0); G8_STAGE_A(G8_SA(1, 1), 1, t + 1);
        G8_WAIT_L(8); G8_BAR; G8_WAIT_L(0); G8_MMA(0, 0, At, B0); G8_BAR; G8_SCHED;
        G8_LDB(B1, 0, 1); G8_STAGE_B(G8_SB(0, 0), 0, t + 2);
        G8_BAR; G8_WAIT_L(0); G8_MMA(0, 1, At, B1); G8_BAR;
        G8_LDA(At, 0, 1); G8_STAGE_A(G8_SA(0, 0), 0, t + 2);
        G8_BAR; G8_WAIT_L(0); G8_MMA(1, 0, At, B0); G8_BAR; G8_SCHED;
        G8_STAGE_B(G8_SB(0, 1), 1, t + 2);
        G8_WAIT_V(6); G8_BAR; G8_MMA(1, 1, At, B1); G8_BAR;
        G8_LDB(B0, 1, 0); G8_SCHED; G8_LDA(At, 1, 0); G8_STAGE_A(G8_SA(0, 1), 1, t + 2);
        G8_WAIT_L(8); G8_BAR; G8_WAIT_L(0); G8_MMA(0, 0, At, B0); G8_BAR; G8_SCHED;
        G8_LDB(B1, 1, 1); G8_STAGE_B(G8_SB(1, 0), 0, t + 3);
        G8_BAR; G8_WAIT_L(0); G8_MMA(0, 1, At, B1); G8_BAR;
        G8_LDA(At, 1, 1); G8_STAGE_A(G8_SA(1, 0), 0, t + 3);
        G8_BAR; G8_WAIT_L(0); G8_MMA(1, 0, At, B0); G8_BAR; G8_SCHED;
        G8_STAGE_B(G8_SB(1, 1), 1, t + 3);
        G8_WAIT_V(6); G8_BAR; G8_MMA(1, 1, At, B1); G8_BAR;
    }
    { G8_LDB(B0, 0, 0); G8_LDA(At, 0, 0); G8_STAGE_A(G8_SA(1, 1), 1, nt - 1);
      G8_BAR; G8_WAIT_L(0); G8_MMA(0, 0, At, B0); G8_BAR;
      G8_LDB(B1, 0, 1); G8_BAR; G8_WAIT_L(0); G8_MMA(0, 1, At, B1); G8_BAR;
      G8_LDA(At, 0, 1); G8_WAIT_V(4); G8_BAR; G8_WAIT_L(0); G8_MMA(1, 0, At, B0); G8_MMA(1, 1, At, B1); G8_BAR; }
    { G8_LDB(B0, 1, 0); G8_LDA(At, 1, 0); G8_WAIT_V(2); G8_BAR; G8_WAIT_L(0); G8_MMA(0, 0, At, B0); G8_BAR;
      G8_LDB(B1, 1, 1); G8_WAIT_V(0); G8_BAR; G8_WAIT_L(0); G8_MMA(0, 1, At, B1); G8_BAR;
      G8_LDA(At, 1, 1); G8_BAR; G8_WAIT_L(0); G8_MMA(1, 0, At, B0); G8_MMA(1, 1, At, B1); G8_BAR; }
    if (wr == 0) G8_BAR;
    asm volatile("" ::: "memory");
    unsigned m0[8], m1[8];
#pragma unroll
    for (int ai = 0; ai < 2; ++ai)
#pragma unroll
        for (int m = 0; m < 4; ++m) { const int rl = ai * 128 + wr * 64 + m * 16 + fr; m0[ai * 4 + m] = ((const LAS unsigned*)(lds + 131072))[rl]; m1[ai * 4 + m] = ((const LAS unsigned*)(lds + 131072 + 1024))[rl]; }
    E(acc, m0, m1, wr, wc, fr, fq);
    __syncthreads();
}

struct UnitIO { const char* Ab; const char* Bb; const unsigned* meta0; const unsigned* meta1; unsigned aoff[2][2]; };
#define G8_STAGE_AX(bufoff, h, kt, AB, AOFF) do { _Pragma("unroll") for (int _i = 0; _i < 2; ++_i) \
    __builtin_amdgcn_global_load_lds((const unsigned*)(((AB) + (size_t)(kt) * (BK * 2)) + (AOFF)[h][_i]), (LAS unsigned*)(lds + (bufoff) + ldsw + _i * 8192), 16, 0, 0); } while (0)
#define G8_STAGE_BX(bufoff, h, kt, BB) do { _Pragma("unroll") for (int _i = 0; _i < 2; ++_i) \
    __builtin_amdgcn_global_load_lds((const unsigned*)(((BB) + (size_t)(h) * bhalf + (size_t)(kt) * (BK * 2)) + boff[_i]), (LAS unsigned*)(lds + (bufoff) + ldsw + _i * 8192), 16, 0, 0); } while (0)
template <int N> __device__ __forceinline__ void wait_v() { asm volatile("s_waitcnt vmcnt(%0)" :: "n"(N) : "memory"); }
template <int NEPI, class Epi>
__device__ __forceinline__ void gemm_unit_p(LAS unsigned char* lds, const UnitIO& io, int K, const Epi& E, int parity, bool primed, bool has_next, const UnitIO& nx) {
    int tid = threadIdx.x; asm volatile("" : "+v"(tid));
    const int wid = __builtin_amdgcn_readfirstlane(tid >> 6), lane = tid & 63, wr = wid >> 2, wc = wid & 3, fr = lane & 15, fq = lane >> 4;
    const int nt = K / BK;
    unsigned boff[2];
#pragma unroll
    for (int i = 0; i < 2; ++i) { int R, C; stage_rc(tid * 16 + i * 8192, R, C); const int rho = R & 31, Rb = (R & ~31) + 8 * ((rho & 15) >> 2) + 4 * (rho >> 4) + (rho & 3);
        boff[i] = (unsigned)(Rb * K + C) * 2u; }
    const size_t bhalf = (size_t)HALF * K * 2;
    const unsigned ldsw = (unsigned)wid * 1024u;
    const int la_off = lds_byte(wr * 64 + fr, fq * 8), lb_off = lds_byte(wc * 32 + fr, fq * 8);
    const char* Ab = io.Ab; const char* Bb = io.Bb; const unsigned (&aoff)[2][2] = io.aoff;
    f32x4 acc[2][2][4][2];
#pragma unroll
    for (int a = 0; a < 2; ++a)
#pragma unroll
        for (int b = 0; b < 2; ++b)
#pragma unroll
            for (int m = 0; m < 4; ++m)
#pragma unroll
                for (int n = 0; n < 2; ++n) acc[a][b][m][n] = (f32x4){0.f, 0.f, 0.f, 0.f};
    bf16x8 At[4][2], B0[2][2], B1[2][2];
    LAS unsigned char* mbuf = lds + 131072 + parity * 2048;
    if (!primed) {
        if (io.meta0) { if (wid < 4) __builtin_amdgcn_global_load_lds(io.meta0 + wid * 64 + lane, (LAS unsigned*)(mbuf + wid * 256), 4, 0, 0);
                        else if (io.meta1) __builtin_amdgcn_global_load_lds(io.meta1 + (wid - 4) * 64 + lane, (LAS unsigned*)(mbuf + 1024 + (wid - 4) * 256), 4, 0, 0); }
        G8_STAGE_B(G8_SB(0, 0), 0, 0); G8_STAGE_A(G8_SA(0, 0), 0, 0);
        G8_STAGE_B(G8_SB(0, 1), 1, 0); G8_STAGE_A(G8_SA(0, 1), 1, 0);
        if (wr == 1) G8_BAR;
        G8_WAIT_V(4); G8_BAR;
        G8_STAGE_B(G8_SB(1, 0), 0, 1); G8_STAGE_A(G8_SA(1, 0), 0, 1); G8_STAGE_B(G8_SB(1, 1), 1, 1);
        G8_WAIT_V(6); G8_BAR;
    } else {
        if (wr == 1) G8_BAR;
        wait_v<4 + NEPI>(); G8_BAR;
        G8_STAGE_B(G8_SB(1, 0), 0, 1); G8_STAGE_A(G8_SA(1, 0), 0, 1); G8_STAGE_B(G8_SB(1, 1), 1, 1);
        wait_v<6 + NEPI>(); G8_BAR;
    }
    for (int t = 0; t < nt - 2; t += 2) {
        G8_LDB(B0, 0, 0); G8_SCHED; G8_LDA(At, 0, 0); G8_STAGE_A(G8_SA(1, 1), 1, t + 1);
        G8_WAIT_L(8); G8_BAR; G8_WAIT_L(0); G8_MMA(0, 0, At, B0); G8_BAR; G8_SCHED;
        G8_LDB(B1, 0, 1); G8_STAGE_B(G8_SB(0, 0), 0, t + 2);
        G8_BAR; G8_WAIT_L(0); G8_MMA(0, 1, At, B1); G8_BAR;
        G8_LDA(At, 0, 1); G8_STAGE_A(G8_SA(0, 0), 0, t + 2);
        G8_BAR; G8_WAIT_L(0); G8_MMA(1, 0, At, B0); G8_BAR; G8_SCHED;
        G8_STAGE_B(G8_SB(0, 1), 1, t + 2);
        G8_WAIT_V(6); G8_BAR; G8_MMA(1, 1, At, B1); G8_BAR;
        G8_LDB(B0, 1, 0); G8_SCHED; G8_LDA(At, 1, 0); G8_STAGE_A(G8_SA(0, 1), 1, t + 2);
        G8_WAIT_L(8); G8_BAR; G8_WAIT_L(0); G8_MMA(0, 0, At, B0); G8_BAR; G8_SCHED;
        G8_LDB(B1, 1, 1); G8_STAGE_B(G8_SB(1, 0), 0, t + 3);
        G8_BAR; G8_WAIT_L(0); G8_MMA(0, 1, At, B1); G8_BAR;
        G8_LDA(At, 1, 1); G8_STAGE_A(G8_SA(1, 0), 0, t + 3);
        G8_BAR; G8_WAIT_L(0); G8_MMA(1, 0, At, B0); G8_BAR; G8_SCHED;
        G8_STAGE_B(G8_SB(1, 1), 1, t + 3);
        G8_WAIT_V(6); G8_BAR; G8_MMA(1, 1, At, B1); G8_BAR;
    }
    { G8_LDB(B0, 0, 0); G8_LDA(At, 0, 0); G8_STAGE_A(G8_SA(1, 1), 1, nt - 1);
      G8_BAR; G8_WAIT_L(0); G8_MMA(0, 0, At, B0); G8_BAR;
      G8_LDB(B1, 0, 1); G8_BAR; G8_WAIT_L(0); G8_MMA(0, 1, At, B1); G8_BAR;
      G8_LDA(At, 0, 1); G8_WAIT_V(4); G8_BAR; G8_WAIT_L(0); G8_MMA(1, 0, At, B0); G8_MMA(1, 1, At, B1); G8_BAR; }
    { G8_LDB(B0, 1, 0); G8_LDA(At, 1, 0); G8_WAIT_V(2); G8_BAR; G8_WAIT_L(0); G8_MMA(0, 0, At, B0); G8_BAR;
      G8_LDB(B1, 1, 1); G8_WAIT_V(0); G8_BAR; G8_WAIT_L(0); G8_MMA(0, 1, At, B1); G8_BAR;
      G8_LDA(At, 1, 1); G8_BAR; G8_WAIT_L(0); G8_MMA(1, 0, At, B0); G8_MMA(1, 1, At, B1); G8_BAR; }
    if (wr == 0) G8_BAR;
    asm volatile("" ::: "memory");
    unsigned m0[8], m1[8];
#pragma unroll
    for (int ai = 0; ai < 2; ++ai)
#pragma unroll
        for (int m = 0; m < 4; ++m) { const int rl = ai * 128 + wr * 64 + m * 16 + fr; m0[ai * 4 + m] = ((const LAS unsigned*)mbuf)[rl]; m1[ai * 4 + m] = ((const LAS unsigned*)(mbuf + 1024))[rl]; }
    G8_WAIT_L(0);
    if (has_next) {
        LAS unsigned char* nb = lds + 131072 + (parity ^ 1) * 2048;
        if (nx.meta0) { if (wid < 4) __builtin_amdgcn_global_load_lds(nx.meta0 + wid * 64 + lane, (LAS unsigned*)(nb + wid * 256), 4, 0, 0);
                        else if (nx.meta1) __builtin_amdgcn_global_load_lds(nx.meta1 + (wid - 4) * 64 + lane, (LAS unsigned*)(nb + 1024 + (wid - 4) * 256), 4, 0, 0); }
        G8_STAGE_BX(G8_SB(0, 0), 0, 0, nx.Bb); G8_STAGE_AX(G8_SA(0, 0), 0, 0, nx.Ab, nx.aoff);
        G8_STAGE_BX(G8_SB(0, 1), 1, 0, nx.Bb); G8_STAGE_AX(G8_SA(0, 1), 1, 0, nx.Ab, nx.aoff);
        asm volatile("" ::: "memory");
    }
    E(acc, m0, m1, wr, wc, fr, fq);
    if (!has_next) __syncthreads();
}
__device__ __forceinline__ void aoff_rows(unsigned (&aoff)[2][2], int K) {
    int tid = threadIdx.x; asm volatile("" : "+v"(tid));
#pragma unroll
    for (int i = 0; i < 2; ++i) { int R, C; stage_rc(tid * 16 + i * 8192, R, C);
#pragma unroll
        for (int h = 0; h < 2; ++h) aoff[h][i] = (unsigned)((h * HALF + R) * K + C) * 2u; }
}
__device__ __forceinline__ void tile_order(int L, int nM, int nN, int& pm, int& pn) {
    const int nwg = nM * nN; int wgid = L;
    { const int q = nwg / 8, r = nwg % 8, xcd = wgid % 8, off = wgid / 8; wgid = (xcd < r ? xcd * (q + 1) : r * (q + 1) + (xcd - r) * q) + off; }
    const int nig = 8 * nN, gid = wgid / nig, fm = gid * 8, gsz = (nM - fm) < 8 ? (nM - fm) : 8;
    pm = fm + ((wgid % nig) % gsz); pn = (wgid % nig) / gsz;
}
}

__device__ __forceinline__ void p0_transpose_item(const float* W, int K, int N, int k0, int n0, bf16_t* WTrow0  , const float* kscale, float mul, LAS float* scr, int lane) {
#pragma unroll 8
    for (int i = 0; i < 32; ++i) { const int kk = 2 * i + (lane >> 5); float v = W[(size_t)(k0 + kk) * N + n0 + (lane & 31)]; if (kscale) v *= kscale[k0 + kk]; scr[kk * 33 + (lane & 31)] = v * mul; }
    LDS_WAIT();
    const int c = lane & 7;
#pragma unroll
    for (int j = 0; j < 4; ++j) { const int n = (lane >> 3) + 8 * j; const LAS float* s = scr + (8 * c) * 33 + n;
        u32x4 o; o.x = cvt_pk_bf16(s[0 * 33], s[1 * 33]); o.y = cvt_pk_bf16(s[2 * 33], s[3 * 33]); o.z = cvt_pk_bf16(s[4 * 33], s[5 * 33]); o.w = cvt_pk_bf16(s[6 * 33], s[7 * 33]);
        *(u32x4*)(WTrow0 + (size_t)n * K + k0 + 8 * c) = o; }
    LDS_WAIT();
}

__device__ __forceinline__ void p0_transpose64(const float* W, int K, int N, int k0, int n0, bf16_t* WTrow0  , const float* kscale, LAS float* scr, int lane) {
    const int rq = lane >> 4, c4 = 4 * (lane & 15);
    f32x4 v[16];
#pragma unroll
    for (int i = 0; i < 16; ++i) v[i] = *(const f32x4*)(W + (size_t)(k0 + 4 * i + rq) * N + n0 + c4);
    if (kscale) {
#pragma unroll
        for (int i = 0; i < 16; ++i) v[i] = v[i] * kscale[k0 + 4 * i + rq];
    }
#pragma unroll
    for (int i = 0; i < 16; ++i) { LAS float* d = scr + (4 * i + rq) * 65 + c4; d[0] = v[i][0]; d[1] = v[i][1]; d[2] = v[i][2]; d[3] = v[i][3]; }
    LDS_WAIT();
#pragma unroll
    for (int c = 0; c < 8; ++c) { const LAS float* sp = scr + (8 * c) * 65 + lane;
        u32x4 o; o.x = cvt_pk_bf16(sp[0], sp[65]); o.y = cvt_pk_bf16(sp[2 * 65], sp[3 * 65]); o.z = cvt_pk_bf16(sp[4 * 65], sp[5 * 65]); o.w = cvt_pk_bf16(sp[6 * 65], sp[7 * 65]);
        *(u32x4*)(WTrow0 + (size_t)lane * K + k0 + 8 * c) = o; }
    LDS_WAIT();
}
__device__ __forceinline__ void p0_expert_weights(const Params& p, LAS unsigned char* lds, int gw, int NGW) {
    int tid = threadIdx.x; asm volatile("" : "+v"(tid));
    const int wave = tid >> 6, lane = tid & 63;
    LAS float* scr = (LAS float*)(lds + wave * 16640);
    bf16_t* wgu = (bf16_t*)(p.ws + WS_WGU); bf16_t* wdn = (bf16_t*)(p.ws + WS_WDN);
    constexpr int I_G = NE * 16 * 4, I_D = NE * 4 * 16;
    for (int it = gw; it < 2 * I_G + I_D; it += NGW) {
        int r = it;
        if (r < 2 * I_G) { const int up = r >= I_G; if (up) r -= I_G; const int e = r / 64, q = r % 64, kb = q / 4, nb = q % 4, n0 = nb * 64;
            const int drow = (n0 >> 7) * 256 + up * 128 + (n0 & 127);
            p0_transpose64((up ? p.w_up : p.w_gate) + (size_t)e * D * DE, D, DE, kb * 64, n0, wgu + ((size_t)e * 512 + drow) * D, p.norm_ffn_g, scr, lane); continue; } r -= 2 * I_G;
        { const int e = r / 64, q = r % 64, kb = q / 16, nb = q % 16, n0 = nb * 64;
            p0_transpose64(p.w_down + (size_t)e * DE * D, DE, D, kb * 64, n0, wdn + ((size_t)e * D + n0) * DE, nullptr, scr, lane); }
    }
}
__device__ __forceinline__ void phase0(const Params& p, LAS unsigned char* lds) {
    int tid = threadIdx.x; asm volatile("" : "+v"(tid));
    const int wave = tid >> 6, lane = tid & 63;
    const int gw = blockIdx.x * NWAVES + wave, NGW = gridDim.x * NWAVES;
    LAS float* scr = (LAS float*)(lds + wave * 8704);
    bf16_t* win = (bf16_t*)(p.ws + WS_WIN); bf16_t* wout = (bf16_t*)(p.ws + WS_WOUT);
    constexpr int I_IN = 16 * 104, I_OUT = 16 * 32;
    for (int it = gw; it < I_IN + I_OUT; it += NGW) {
        int r = it;
        if (r < I_IN) { const int kb = r / 104, nb = r % 104, n0 = nb * 32; p0_transpose_item(p.w_in, D, NIN, kb * 64, n0, win + (size_t)n0 * D, p.norm_mix_g, n0 < 512 ? QSCALE : 1.f, scr, lane); continue; } r -= I_IN;
        { const int kb = r / 32, nb = r % 32, n0 = nb * 32; p0_transpose_item(p.w_out, D, D, kb * 64, n0, wout + (size_t)n0 * D, nullptr, 1.f, scr, lane); }
    }
    bf16_t* xb = (bf16_t*)(p.ws + WS_B); float* rstd1 = (float*)(p.ws + WS_RSTD1);
    {
        f32x4 nv[4];
        if (gw < T) {
#pragma unroll
            for (int j = 0; j < 4; ++j) nv[j] = ((const f32x4*)(p.x + (size_t)gw * D) + lane)[64 * j];
        }
        for (int row = gw; row < T; row += NGW) {
            f32x4 v[4]; float s = 0.f;
#pragma unroll
            for (int j = 0; j < 4; ++j) { v[j] = nv[j]; s += (v[j].x * v[j].x + v[j].y * v[j].y) + (v[j].z * v[j].z + v[j].w * v[j].w); }
            if (row + NGW < T) {
#pragma unroll
                for (int j = 0; j < 4; ++j) nv[j] = ((const f32x4*)(p.x + (size_t)(row + NGW) * D) + lane)[64 * j];
            }
            s = wave_sum(s);
            u32x2* o = (u32x2*)(xb + (size_t)row * D) + lane;
#pragma unroll
            for (int j = 0; j < 4; ++j) { u32x2 w; w.x = cvt_pk_bf16(v[j].x, v[j].y); w.y = cvt_pk_bf16(v[j].z, v[j].w); o[64 * j] = w; }
            if (lane == 0) rstd1[row] = 1.0f / sqrtf(s * (1.0f / D) + 1e-6f);
        }
    }
    bf16_t* wr_hi = (bf16_t*)(p.ws + WS_WR); bf16_t* wr_lo = wr_hi + 48 * D;
    for (int i = blockIdx.x * NTHREADS + tid; i < 48 * D; i += gridDim.x * NTHREADS) {
        const int c = i / D, k = i % D; float w = 0.f;
        if (c < 4) w = p.r_grp_w[k * 4 + c]; else if (c < 36) w = p.r_exp_w[k * 32 + (c - 4)];
        w *= p.norm_ffn_g[k];
        const unsigned hi = cvt_pk_bf16(w, 0.f) & 0xffffu; const float rem = w - __uint_as_float(hi << 16);
        wr_hi[i] = (bf16_t)hi; wr_lo[i] = (bf16_t)(cvt_pk_bf16(rem, 0.f) & 0xffffu);
    }
    { bf16_t* w2t = (bf16_t*)(p.ws + WS_LT); bf16_t* a2t = w2t + 512 * 64; bf16_t* g2t = a2t + 512 * 64;
      for (int i = blockIdx.x * NTHREADS + tid; i < 512 * 256; i += gridDim.x * NTHREADS) {
          if (i < 512 * 64) { const int c = i >> 6, m = i & 63; w2t[i] = (bf16_t)(cvt_pk_bf16(p.rw_w2[m * 512 + c], 0.f) & 0xffffu); }
          else if (i < 2 * 512 * 64) { const int q = i - 512 * 64, c = q >> 6, m = q & 63; a2t[q] = (bf16_t)(cvt_pk_bf16(p.rw_a2[m * 512 + c], 0.f) & 0xffffu); }
          else { const int q = i - 2 * 512 * 64, c = q >> 7, m = q & 127; g2t[q] = (bf16_t)(cvt_pk_bf16(p.rw_g2[m * 512 + c], 0.f) & 0xffffu); } } }
    if (blockIdx.x == 0 && tid < 64) ((unsigned*)(p.ws + WS_CTL))[tid] = 0u;
}

struct EpiU {
    bf16_t* u; const float* rstd; int row0, col0;
    __device__ __forceinline__ void operator()(const f32x4 (&acc)[2][2][4][2], const unsigned (&m0)[8], const unsigned (&m1)[8], int wr, int wc, int fr, int fq) const {
#pragma unroll
        for (int ai = 0; ai < 2; ++ai)
#pragma unroll
            for (int m = 0; m < 4; ++m) { const int rl = ai * 128 + wr * 64 + m * 16 + fr, row = row0 + rl; const float rs = __uint_as_float(m0[ai * 4 + m]); bf16_t* rp = u + (size_t)row * NIN + col0 + wc * 32 + 8 * fq;
#pragma unroll
                for (int bj = 0; bj < 2; ++bj) { const f32x4 v0 = acc[ai][bj][m][0] * rs, v1 = acc[ai][bj][m][1] * rs;
                    *(u32x4*)(rp + bj * 128) = (u32x4){cvt_pk_bf16(v0[0], v0[1]), cvt_pk_bf16(v0[2], v0[3]), cvt_pk_bf16(v1[0], v1[1]), cvt_pk_bf16(v1[2], v1[3])}; } }
    }
};
__device__ __forceinline__ void phase1(const Params& p, LAS unsigned char* lds) {
    constexpr int nM = T / 256, nN = NIN / 256;
    g8::UnitIO cur, nxt; g8::aoff_rows(cur.aoff, D);
#pragma unroll
    for (int a = 0; a < 2; ++a)
#pragma unroll
        for (int b = 0; b < 2; ++b) nxt.aoff[a][b] = cur.aoff[a][b];
    cur.meta1 = nullptr; nxt.meta1 = nullptr;
    int pm, pn; int L = blockIdx.x;
    if (L < nM * nN) { g8::tile_order(L, nM, nN, pm, pn); cur.Ab = (const char*)(p.ws + WS_B) + (size_t)pm * 256 * D * 2; cur.Bb = (const char*)(p.ws + WS_WIN) + (size_t)pn * 256 * D * 2; cur.meta0 = (const unsigned*)(p.ws + WS_RSTD1) + pm * 256; }
    for (int i = 0; L < nM * nN; L += gridDim.x, ++i) {
        const bool hn = L + (int)gridDim.x < nM * nN; int pm2 = 0, pn2 = 0;
        if (hn) { g8::tile_order(L + gridDim.x, nM, nN, pm2, pn2); nxt.Ab = (const char*)(p.ws + WS_B) + (size_t)pm2 * 256 * D * 2; nxt.Bb = (const char*)(p.ws + WS_WIN) + (size_t)pn2 * 256 * D * 2; nxt.meta0 = (const unsigned*)(p.ws + WS_RSTD1) + pm2 * 256; }
        EpiU E{(bf16_t*)(p.ws + WS_A), (const float*)(p.ws + WS_RSTD1), pm * 256, pn * 256};
        g8::gemm_unit_p<16>(lds, cur, D, E, i & 1, i > 0, hn, nxt);
        cur.Ab = nxt.Ab; cur.Bb = nxt.Bb; cur.meta0 = nxt.meta0; pm = pm2; pn = pn2;
    }
}


typedef short v4i16_t __attribute__((ext_vector_type(4)));
__device__ __forceinline__ s16x4 lds_tr16(const LAS unsigned char* p) { return __builtin_bit_cast(s16x4, __builtin_amdgcn_ds_read_tr16_b64_v4i16((LAS v4i16_t*)p)); }

__device__ __forceinline__ void attn_tile(const Params& p, LAS unsigned char* vl  , int b, int h, int qt) {
    const int lane = threadIdx.x & 63, r32 = lane & 31, hi = lane >> 5;
    const bf16_t* u = (const bf16_t*)(p.ws + WS_A);
    const size_t row0 = (size_t)b * S; const int q0 = qt * 32;
    bf16x8 qf[4];
    { const bf16_t* qp = u + (row0 + q0 + r32) * NIN + UQ + h * HD + 8 * hi;
#pragma unroll
      for (int s = 0; s < 4; ++s) qf[s] = *(const bf16x8*)(qp + 16 * s); }
    f32x16 o0, o1;
#pragma unroll
    for (int i = 0; i < 16; ++i) { o0[i] = 0.f; o1[i] = 0.f; }
    float carry = 0.f;
    const int kperm = 16 * ((r32 >> 2) & 1) + (r32 & 3) + 4 * (r32 >> 3);
    const int g = lane >> 4, i16 = lane & 15, tq = i16 >> 2, tp = i16 & 3;
    const LAS unsigned char* vrd = vl + (16 * (g >> 1) + tq) * 144 + (16 * (g & 1) + 4 * tp) * 2;
    LAS unsigned char* kl = vl + 4608;
    const int lrow = lane >> 3, lchk = lane & 7;
    const bf16_t* kvp = u + (row0 + lrow) * NIN + h * HD + lchk * 8;
    u32x4 kreg[4], vreg[4];
#pragma unroll
    for (int i = 0; i < 4; ++i) { const bf16_t* a = kvp + (size_t)(qt * 32 + 8 * i) * NIN; kreg[i] = *(const u32x4*)(a + UK); vreg[i] = *(const u32x4*)(a + UV); }
    for (int kb = qt; kb >= 0; --kb) {
        const int key0 = kb * 32;
#pragma unroll
        for (int i = 0; i < 4; ++i) { *(LAS u32x4*)(kl + (8 * i + lrow) * 144 + lchk * 16) = kreg[i]; *(LAS u32x4*)(vl + (8 * i + lrow) * 144 + lchk * 16) = vreg[i]; }
        if (kb > 0) {
#pragma unroll
            for (int i = 0; i < 4; ++i) { const bf16_t* a = kvp + (size_t)(key0 - 32 + 8 * i) * NIN; kreg[i] = *(const u32x4*)(a + UK); vreg[i] = *(const u32x4*)(a + UV); }
        }
        LDS_WAIT();
        f32x16 st;
#pragma unroll
        for (int i = 0; i < 16; ++i) st[i] = 0.f;
        { const LAS unsigned char* kp = kl + kperm * 144 + 16 * hi;
          bf16x8 kf[4];
#pragma unroll
          for (int s = 0; s < 4; ++s) kf[s] = *(const LAS bf16x8*)(kp + 32 * s);
#pragma unroll
          for (int s = 0; s < 4; ++s) st = __builtin_amdgcn_mfma_f32_32x32x16_bf16(kf[s], qf[s], st, 0, 0, 0); }
        const bool diag = (kb == qt);
        float lw[16], suf[16];
        float run = 0.f;
#pragma unroll
        for (int reg = 15; reg >= 0; --reg) {
            const float z = st[reg];
            const float l = flog2(1.0f + fexp2(-fabsf(z)));
            const float sp = fmaxf(z, 0.f) + l;
            const bool valid = !diag || (16 * hi + reg < r32);
            lw[reg] = valid ? (z - sp) : -1.0e30f;
            suf[reg] = run;
            run += valid ? -sp : 0.f;
        }
        const float other = swap32(run);
        const float tot_hi = hi ? run : other, tot_lo = hi ? other : run;
        const float base = carry + (hi ? 0.f : tot_hi);
        carry += tot_lo + tot_hi;
        unsigned pk[8];
#pragma unroll
        for (int j = 0; j < 8; ++j) pk[j] = cvt_pk_bf16(fexp2(lw[2 * j] + suf[2 * j] + base), fexp2(lw[2 * j + 1] + suf[2 * j + 1] + base));
        LDS_WAIT();
#pragma unroll
        for (int s2 = 0; s2 < 2; ++s2) {
            bf16x8 pf = __builtin_bit_cast(bf16x8, (u32x4){pk[4 * s2], pk[4 * s2 + 1], pk[4 * s2 + 2], pk[4 * s2 + 3]});
#pragma unroll
            for (int dh = 0; dh < 2; ++dh) {
                const s16x4 a = lds_tr16(vrd + (8 * s2) * 144 + 64 * dh), c = lds_tr16(vrd + (8 * s2 + 4) * 144 + 64 * dh);
                bf16x8 vf; vf[0] = a[0]; vf[1] = a[1]; vf[2] = a[2]; vf[3] = a[3]; vf[4] = c[0]; vf[5] = c[1]; vf[6] = c[2]; vf[7] = c[3];
                if (dh == 0) o0 = __builtin_amdgcn_mfma_f32_32x32x16_bf16(vf, pf, o0, 0, 0, 0); else o1 = __builtin_amdgcn_mfma_f32_32x32x16_bf16(vf, pf, o1, 0, 0, 0);
            }
        }
        LDS_WAIT();
        if (__builtin_amdgcn_ballot_w64(carry > -150.0f) == 0ull) break;
    }
    float ss = 0.f;
#pragma unroll
    for (int i = 0; i < 16; ++i) ss += o0[i] * o0[i] + o1[i] * o1[i];
    ss += swap32(ss);
    const float rs = 1.0f / sqrtf(ss * (1.0f / HD) + 1e-6f);
    bf16_t* op = (bf16_t*)(p.ws + WS_B) + (row0 + q0 + r32) * D + h * HD + 4 * hi;
    const float* gp = p.sb_out_g + h * HD + 4 * hi;
#pragma unroll
    for (int dh = 0; dh < 2; ++dh)
#pragma unroll
        for (int gq = 0; gq < 4; ++gq) {
            const f32x4 gg = *(const f32x4*)(gp + 32 * dh + 8 * gq);
            const f32x16& o = dh ? o1 : o0;
            u32x2 w; w.x = cvt_pk_bf16(o[4 * gq] * rs * gg[0], o[4 * gq + 1] * rs * gg[1]); w.y = cvt_pk_bf16(o[4 * gq + 2] * rs * gg[2], o[4 * gq + 3] * rs * gg[3]);
            *(u32x2*)(op + 32 * dh + 8 * gq) = w;
        }
}

constexpr size_t ACT_OFF = (size_t)64 << 20;
namespace rk {
constexpr int C = 32, NCH = S / C, NSLOT = 16;
constexpr int SL_PS = 0, SL_QS = 8192, SL_PO = 12288, SL_QO = 16384, SL_VR = 18432, SL_GB = 22528, SL_GW = 26624, SLOT_BYTES = 30720;
constexpr int MSTR = 144;
constexpr int PM_AT = 0, PM_RT = 4608, PM_BT = 9216, PM_KT = 13824, PM_GC = 18432, PROD_LDS = 18688;
constexpr int NPROD = 6;
constexpr int L_CONS = NPROD * PROD_LDS;
constexpr int OSTR = 272;
constexpr int L_OBUF = L_CONS + 4608;
constexpr int L_FLAG = L_OBUF + 32 * OSTR;
constexpr int L_W2 = L_FLAG + 256;
constexpr int L_A2 = L_W2 + 8192;
constexpr int L_G2 = L_A2 + 8192;
constexpr int L_CST = L_G2 + 16384;
constexpr int C_MUL = 0, C_MUR = 256, C_MUK = 320, C_MUV = 384, C_W0 = 448, C_A0 = 512, C_KK = 576, C_KA = 640, C_RK = 704, C_LNB = 768, C_END = 832;
static_assert(L_CST + C_END * 4 <= 161792, "rwkv LDS layout overflows");
}
__device__ __forceinline__ bf16x8 accfrag(const f32x16& a, int s) {
    return __builtin_bit_cast(bf16x8, (u32x4){cvt_pk_bf16(a[8 * s], a[8 * s + 1]), cvt_pk_bf16(a[8 * s + 2], a[8 * s + 3]), cvt_pk_bf16(a[8 * s + 4], a[8 * s + 5]), cvt_pk_bf16(a[8 * s + 6], a[8 * s + 7])});
}
__device__ __forceinline__ bf16x8 trfrag(const LAS unsigned char* mat, int s, int nt, int lane) {
    const int g = lane >> 4, i16 = lane & 15, q = i16 >> 2, pp = i16 & 3, h = g >> 1;
    const LAS unsigned char* a = mat + (16 * s + 4 * h + q) * rk::MSTR + (32 * nt + 16 * (g & 1) + 4 * pp) * 2;
    const s16x4 x = lds_tr16(a), y = lds_tr16(a + 8 * rk::MSTR);
    bf16x8 r; r[0] = x[0]; r[1] = x[1]; r[2] = x[2]; r[3] = x[3]; r[4] = y[0]; r[5] = y[1]; r[6] = y[2]; r[7] = y[3]; return r;
}
__device__ __forceinline__ void f8_from_bf16(const u32x4 w, float (&o)[8]) {
#pragma unroll
    for (int j = 0; j < 4; ++j) { o[2 * j] = bf16_lo(w[j]); o[2 * j + 1] = bf16_hi(w[j]); }
}
__device__ __forceinline__ f32x16 mfma32(bf16x8 a, bf16x8 b, f32x16 c) { return __builtin_amdgcn_mfma_f32_32x32x16_bf16(a, b, c, 0, 0, 0); }
__device__ __forceinline__ f32x16 zero16() { f32x16 z; for (int i = 0; i < 16; ++i) z[i] = 0.f; return z; }
__device__ __forceinline__ void um8(const bf16_t* urow  , bool has_prev, const float* mu, float (&o)[8]) {
    const u32x4 c = *(const u32x4*)urow; u32x4 pv = (u32x4){0u, 0u, 0u, 0u}; if (has_prev) pv = *(const u32x4*)(urow - NIN);
    const f32x4 m0 = *(const f32x4*)mu, m1 = *(const f32x4*)(mu + 4);
    float cv[8], pf[8]; f8_from_bf16(c, cv); f8_from_bf16(pv, pf);
#pragma unroll
    for (int j = 0; j < 4; ++j) { o[j] = cv[j] + (pf[j] - cv[j]) * m0[j]; o[4 + j] = cv[4 + j] + (pf[4 + j] - cv[4 + j]) * m1[j]; }
}
__device__ __forceinline__ void lerp8(const u32x4 c, const u32x4 pv, const LAS float* mu, float (&o)[8]) {
    const f32x4 m0 = *(const LAS f32x4*)mu, m1 = *(const LAS f32x4*)(mu + 4);
    float cv[8], pf[8]; f8_from_bf16(c, cv); f8_from_bf16(pv, pf);
#pragma unroll
    for (int j = 0; j < 4; ++j) { o[j] = cv[j] + (pf[j] - cv[j]) * m0[j]; o[4 + j] = cv[4 + j] + (pf[4 + j] - cv[4 + j]) * m1[j]; }
}
__device__ __forceinline__ void lerp8(const u32x4 c, const u32x4 pv, const float* mu, float (&o)[8]) {
    const f32x4 m0 = *(const f32x4*)mu, m1 = *(const f32x4*)(mu + 4);
    float cv[8], pf[8]; f8_from_bf16(c, cv); f8_from_bf16(pv, pf);
#pragma unroll
    for (int j = 0; j < 4; ++j) { o[j] = cv[j] + (pf[j] - cv[j]) * m0[j]; o[4 + j] = cv[4 + j] + (pf[4 + j] - cv[4 + j]) * m1[j]; }
}
__device__ __forceinline__ float scan32(float x) {
    x += dppf<0x111>(x); x += dppf<0x112>(x); x += dppf<0x114>(x); x += dppf<0x118>(x);
    const float bc = __builtin_bit_cast(float, __builtin_amdgcn_update_dpp(0, __builtin_bit_cast(int, x), 0x142, 0xA, 0xF, false));
    return x + bc;
}

__device__ __forceinline__ void rk_produce(const Params& p, LAS unsigned char* lds, LAS unsigned char* pl  , unsigned char* slot, int b, int hh, int c) {
    using namespace rk;
    int lane = threadIdx.x & 63; asm volatile("" : "+v"(lane));
    const int r32 = lane & 31, h = lane >> 5;
    const bf16_t* u = (const bf16_t*)(p.ws + WS_A);
    const size_t row0 = (size_t)b * S; const int t0 = c * C; const int tt = t0 + r32; const bool hp = tt > 0;
    const bf16_t* urow = u + (row0 + tt) * NIN;
    const LAS float* cst = (const LAS float*)(lds + L_CST);
    const int jrow0 = 32 * ((r32 >> 2) & 1) + (r32 & 3) + 4 * (r32 >> 3);
    f32x16 lw[2], la[2], lg[2];
#pragma unroll
    for (int mt = 0; mt < 2; ++mt) { lw[mt] = zero16(); la[mt] = zero16(); lg[mt] = zero16(); }
    const int cb = hh * HD + 32 * h;
    u32x4 ck[4], pk4[4], cr[4], pr4[4];
    {
        const bf16_t* act = (const bf16_t*)((const unsigned char*)p.out + ACT_OFF) + (row0 + tt) * 256 + 8 * h;
        u32x4 bw[4], ba[4], bg[8];
#pragma unroll
        for (int s = 0; s < 4; ++s) { bw[s] = *(const u32x4*)(act + 16 * s); ba[s] = *(const u32x4*)(act + 64 + 16 * s); }
#pragma unroll
        for (int s = 0; s < 8; ++s) bg[s] = *(const u32x4*)(act + 128 + 16 * s);
        {
            bf16x8 fw[2][4];
#pragma unroll
            for (int mt = 0; mt < 2; ++mt)
#pragma unroll
                for (int s = 0; s < 4; ++s) { const int jl = jrow0 + 16 * mt; fw[mt][s] = *(const LAS bf16x8*)(lds + L_W2 + jl * 128 + (((2 * s + h) ^ (jl & 7)) << 4)); }
#pragma unroll
            for (int s = 0; s < 4; ++s)
#pragma unroll
                for (int mt = 0; mt < 2; ++mt) lw[mt] = mfma32(fw[mt][s], __builtin_bit_cast(bf16x8, bw[s]), lw[mt]);
        }
        {
            bf16x8 fa[2][4];
#pragma unroll
            for (int mt = 0; mt < 2; ++mt)
#pragma unroll
                for (int s = 0; s < 4; ++s) { const int jl = jrow0 + 16 * mt; fa[mt][s] = *(const LAS bf16x8*)(lds + L_A2 + jl * 128 + (((2 * s + h) ^ (jl & 7)) << 4)); }
#pragma unroll
            for (int s = 0; s < 4; ++s)
#pragma unroll
                for (int mt = 0; mt < 2; ++mt) la[mt] = mfma32(fa[mt][s], __builtin_bit_cast(bf16x8, ba[s]), la[mt]);
        }
        asm volatile("" ::: "memory");
#pragma unroll
        for (int half = 0; half < 2; ++half) {
            bf16x8 fg[2][4];
#pragma unroll
            for (int mt = 0; mt < 2; ++mt)
#pragma unroll
                for (int s4 = 0; s4 < 4; ++s4) { const int s = 4 * half + s4, jl = jrow0 + 16 * mt; fg[mt][s4] = *(const LAS bf16x8*)(lds + L_G2 + jl * 256 + (((2 * s + h) ^ (jl & 7)) << 4)); }
#pragma unroll
            for (int s4 = 0; s4 < 4; ++s4)
#pragma unroll
                for (int mt = 0; mt < 2; ++mt) lg[mt] = mfma32(fg[mt][s4], __builtin_bit_cast(bf16x8, bg[4 * half + s4]), lg[mt]);
        }
        asm volatile("" ::: "memory");
#pragma unroll
        for (int q = 0; q < 4; ++q) { const bf16_t* a = urow + URK + cb + 8 * q; const bf16_t* bq = urow + UR + cb + 8 * q;
            ck[q] = *(const u32x4*)a; cr[q] = *(const u32x4*)bq; pk4[q] = (u32x4){0u, 0u, 0u, 0u}; pr4[q] = pk4[q];
            if (hp) { pk4[q] = *(const u32x4*)(a - NIN); pr4[q] = *(const u32x4*)(bq - NIN); } }
    }
#pragma unroll
    for (int mt = 0; mt < 2; ++mt) {
        u32x4 w0, w1; w0.x = cvt_pk_bf16(lg[mt][0], lg[mt][1]); w0.y = cvt_pk_bf16(lg[mt][2], lg[mt][3]); w0.z = cvt_pk_bf16(lg[mt][4], lg[mt][5]); w0.w = cvt_pk_bf16(lg[mt][6], lg[mt][7]);
        w1.x = cvt_pk_bf16(lg[mt][8], lg[mt][9]); w1.y = cvt_pk_bf16(lg[mt][10], lg[mt][11]); w1.z = cvt_pk_bf16(lg[mt][12], lg[mt][13]); w1.w = cvt_pk_bf16(lg[mt][14], lg[mt][15]);
        *(u32x4*)(slot + SL_GW + (2 * mt) * 1024 + lane * 16) = w0; *(u32x4*)(slot + SL_GW + (2 * mt + 1) * 1024 + lane * 16) = w1;
    }
    asm volatile("" ::: "memory");
    float ssq = 0.f;
#pragma unroll
    for (int q = 0; q < 4; ++q) {
        float t8[8]; lerp8(ck[q], pk4[q], cst + C_MUK + 32 * h + 8 * q, t8);
        const f32x4 c0 = *(const LAS f32x4*)(cst + C_KK + 32 * h + 8 * q), c1 = *(const LAS f32x4*)(cst + C_KK + 32 * h + 8 * q + 4);
#pragma unroll
        for (int j = 0; j < 4; ++j) { const float x0 = t8[j] * c0[j], x1 = t8[4 + j] * c1[j]; ssq += x0 * x0 + x1 * x1; }
    }
    ssq += swap32(ssq);
    const float kinv = frsq(fmaxf(ssq, 1e-24f));
    float bonus = 0.f;
    LAS unsigned char* mAT = pl + PM_AT; LAS unsigned char* mRT = pl + PM_RT; LAS unsigned char* mBT = pl + PM_BT; LAS unsigned char* mKT = pl + PM_KT;
    LAS float* gc = (LAS float*)(pl + PM_GC);
#pragma unroll
    for (int mt = 0; mt < 2; ++mt) {
#pragma unroll
        for (int q8 = 0; q8 < 2; ++q8) {
            const int jl0 = 32 * h + 16 * mt + 8 * q8, q = 2 * mt + q8;
            float k8[8], r8[8];
            lerp8(ck[q], pk4[q], cst + C_MUK + jl0, k8);
            lerp8(cr[q], pr4[q], cst + C_MUR + jl0, r8);
            float cw0[8], ca0[8], ckk[8], cka[8], crk[8];
#pragma unroll
            for (int e = 0; e < 2; ++e) { const f32x4 a = *(const LAS f32x4*)(cst + C_W0 + jl0 + 4 * e), bq = *(const LAS f32x4*)(cst + C_A0 + jl0 + 4 * e), cc = *(const LAS f32x4*)(cst + C_KK + jl0 + 4 * e), dd = *(const LAS f32x4*)(cst + C_KA + jl0 + 4 * e), ee = *(const LAS f32x4*)(cst + C_RK + jl0 + 4 * e);
#pragma unroll
                for (int j = 0; j < 4; ++j) { cw0[4 * e + j] = a[j]; ca0[4 * e + j] = bq[j]; ckk[4 * e + j] = cc[j]; cka[4 * e + j] = dd[j]; crk[4 * e + j] = ee[j]; } }
            float oa[8], orr[8], ob[8], ok[8];
#pragma unroll
            for (int e = 0; e < 8; ++e) {
                const int reg = 8 * q8 + e;
                const float xw = cw0[e] + lw[mt][reg];
                const float spn = fmaxf(-xw, 0.f) + LN2 * flog2(1.0f + fexp2(-fabsf(xw) * LOG2E));
                const float ld = -fexp2((-spn - 0.5f) * LOG2E);
                const float al = frcp(1.0f + fexp2(-(ca0[e] + la[mt][reg]) * LOG2E));
                const float kk = k8[e] * ckk[e] * kinv;
                const float kmod = k8[e] * (1.0f + (al - 1.0f) * cka[e]);
                const float bb = kk * al;
                bonus += r8[e] * kmod * crk[e];
                const float G = scan32(ld);
                const float eG = fexp2(G * LOG2E), eGm = fexp2((G - ld) * LOG2E), eiG = fexp2(-G * LOG2E);
                oa[e] = -kk * eGm; orr[e] = r8[e] * eG; ob[e] = bb * eiG; ok[e] = kmod * eiG;
                if (r32 == 31) gc[32 * h + 16 * mt + reg] = eG;
            }
            const int off = r32 * MSTR + (32 * h + 16 * mt + 8 * q8) * 2;
            *(LAS u32x4*)(mAT + off) = (u32x4){cvt_pk_bf16(oa[0], oa[1]), cvt_pk_bf16(oa[2], oa[3]), cvt_pk_bf16(oa[4], oa[5]), cvt_pk_bf16(oa[6], oa[7])};
            *(LAS u32x4*)(mRT + off) = (u32x4){cvt_pk_bf16(orr[0], orr[1]), cvt_pk_bf16(orr[2], orr[3]), cvt_pk_bf16(orr[4], orr[5]), cvt_pk_bf16(orr[6], orr[7])};
            *(LAS u32x4*)(mBT + off) = (u32x4){cvt_pk_bf16(ob[0], ob[1]), cvt_pk_bf16(ob[2], ob[3]), cvt_pk_bf16(ob[4], ob[5]), cvt_pk_bf16(ob[6], ob[7])};
            *(LAS u32x4*)(mKT + off) = (u32x4){cvt_pk_bf16(ok[0], ok[1]), cvt_pk_bf16(ok[2], ok[3]), cvt_pk_bf16(ok[4], ok[5]), cvt_pk_bf16(ok[6], ok[7])};
            asm volatile("" ::: "memory");
        }
    }
    bonus += swap32(bonus);
    u32x4 cv4[4], pv4[4];
#pragma unroll
    for (int q = 0; q < 4; ++q) { const bf16_t* cq = urow + URV + cb + 8 * q; cv4[q] = *(const u32x4*)cq; pv4[q] = (u32x4){0u, 0u, 0u, 0u}; if (hp) pv4[q] = *(const u32x4*)(cq - NIN); }
#pragma unroll
    for (int q = 0; q < 4; ++q) {
        float v8[8]; lerp8(cv4[q], pv4[q], cst + C_MUV + 32 * h + 8 * q, v8);
        *(u32x4*)(slot + SL_VR + q * 1024 + lane * 16) = (u32x4){cvt_pk_bf16(v8[0], v8[1]), cvt_pk_bf16(v8[2], v8[3]), cvt_pk_bf16(v8[4], v8[5]), cvt_pk_bf16(v8[6], v8[7])};
        const f32x4 b0 = *(const LAS f32x4*)(cst + C_LNB + 32 * h + 8 * q), b1 = *(const LAS f32x4*)(cst + C_LNB + 32 * h + 8 * q + 4);
        float gb[8];
#pragma unroll
        for (int e = 0; e < 8; ++e) gb[e] = (e < 4 ? b0[e] : b1[e - 4]) + bonus * v8[e];
        *(u32x4*)(slot + SL_GB + q * 1024 + lane * 16) = (u32x4){cvt_pk_bf16(gb[0], gb[1]), cvt_pk_bf16(gb[2], gb[3]), cvt_pk_bf16(gb[4], gb[5]), cvt_pk_bf16(gb[6], gb[7])};
    }
    LDS_WAIT();
    f32x16 nab = zero16(), nabT = zero16(), nakT = zero16(), mbr = zero16(), mkr = zero16();
#pragma unroll
    for (int s = 0; s < 4; ++s) {
        const int off = r32 * MSTR + (16 * s + 8 * h) * 2;
        const bf16x8 fa = *(const LAS bf16x8*)(mAT + off), fr = *(const LAS bf16x8*)(mRT + off), fb = *(const LAS bf16x8*)(mBT + off), fk = *(const LAS bf16x8*)(mKT + off);
        nab = mfma32(fb, fa, nab); nabT = mfma32(fa, fb, nabT); nakT = mfma32(fa, fk, nakT); mbr = mfma32(fb, fr, mbr); mkr = mfma32(fk, fr, mkr);
    }
#pragma unroll
    for (int reg = 0; reg < 16; ++reg) {
        const int row = (reg & 3) + 8 * (reg >> 2) + 4 * h;
        nab[reg] = row < r32 ? nab[reg] : 0.f;
        nabT[reg] = r32 < row ? nabT[reg] : 0.f;
        nakT[reg] = r32 < row ? nakT[reg] : 0.f;
        mbr[reg] = row <= r32 ? mbr[reg] : 0.f;
        mkr[reg] = row <= r32 ? mkr[reg] : 0.f;
    }
    f32x16 Y = nab;
#pragma unroll
    for (int reg = 0; reg < 16; ++reg) { const int row = (reg & 3) + 8 * (reg >> 2) + 4 * h; if (row == r32) Y[reg] += 1.0f; }
    {
        f32x16 M = nab, MT = nabT;
#pragma unroll
        for (int lvl = 0; lvl < 4; ++lvl) {
            const bf16x8 m0 = accfrag(M, 0), m1 = accfrag(M, 1), t0f = accfrag(MT, 0), t1f = accfrag(MT, 1);
            f32x16 M2T = mfma32(m0, t0f, zero16()); M2T = mfma32(m1, t1f, M2T);
            f32x16 M2 = zero16();
            if (lvl < 3) { M2 = mfma32(t0f, m0, M2); M2 = mfma32(t1f, m1, M2); }
            const bf16x8 y0 = accfrag(Y, 0), y1 = accfrag(Y, 1);
            Y = mfma32(accfrag(M2T, 0), y0, Y); Y = mfma32(accfrag(M2T, 1), y1, Y);
            M = M2; MT = M2T;
        }
    }
    int lane5 = lane; asm volatile("" : "+v"(lane5));
    const int r5 = lane5 & 31, h5 = lane5 >> 5;
    const bf16x8 ty0 = accfrag(Y, 0), ty1 = accfrag(Y, 1);
    f32x16 paT[2];
#pragma unroll
    for (int nt = 0; nt < 2; ++nt) { paT[nt] = mfma32(ty0, trfrag(mAT, 0, nt, lane5), zero16()); paT[nt] = mfma32(ty1, trfrag(mAT, 1, nt, lane5), paT[nt]); }
    f32x16 qakT = mfma32(ty0, accfrag(nakT, 0), zero16()); qakT = mfma32(ty1, accfrag(nakT, 1), qakT);
    const bf16x8 mb0 = accfrag(mbr, 0), mb1 = accfrag(mbr, 1);
#pragma unroll
    for (int mt = 0; mt < 2; ++mt) {
        f32x16 po;
#pragma unroll
        for (int g = 0; g < 4; ++g) { const u32x2 w = *(const LAS u32x2*)(mRT + r5 * MSTR + (32 * mt + 8 * g + 4 * h5) * 2);
            po[4 * g] = bf16_lo(w.x); po[4 * g + 1] = bf16_hi(w.x); po[4 * g + 2] = bf16_lo(w.y); po[4 * g + 3] = bf16_hi(w.y); }
        po = mfma32(accfrag(paT[mt], 0), mb0, po); po = mfma32(accfrag(paT[mt], 1), mb1, po);
#pragma unroll
        for (int sp = 0; sp < 2; ++sp)
            *(u32x4*)(slot + SL_PO + (2 * mt + sp) * 1024 + lane5 * 16) = (u32x4){cvt_pk_bf16(po[8 * sp], po[8 * sp + 1]), cvt_pk_bf16(po[8 * sp + 2], po[8 * sp + 3]), cvt_pk_bf16(po[8 * sp + 4], po[8 * sp + 5]), cvt_pk_bf16(po[8 * sp + 6], po[8 * sp + 7])};
    }
    {
        f32x16 qo = mfma32(accfrag(qakT, 0), mb0, mkr); qo = mfma32(accfrag(qakT, 1), mb1, qo);
#pragma unroll
        for (int sp = 0; sp < 2; ++sp) *(u32x4*)(slot + SL_QO + sp * 1024 + lane5 * 16) = (u32x4){cvt_pk_bf16(qo[8 * sp], qo[8 * sp + 1]), cvt_pk_bf16(qo[8 * sp + 2], qo[8 * sp + 3]), cvt_pk_bf16(qo[8 * sp + 4], qo[8 * sp + 5]), cvt_pk_bf16(qo[8 * sp + 6], qo[8 * sp + 7])};
    }
#pragma unroll
    for (int nt = 0; nt < 2; ++nt) {
        const bf16x8 bt0 = trfrag(mBT, 0, nt, lane5), bt1 = trfrag(mBT, 1, nt, lane5);
        const float gam = gc[32 * nt + r5];
#pragma unroll
        for (int mt = 0; mt < 2; ++mt) {
            f32x16 ps = zero16();
            if (mt == nt) {
#pragma unroll
                for (int reg = 0; reg < 16; ++reg) { const int row = (reg & 3) + 8 * (reg >> 2) + 4 * h5; ps[reg] = (row == r5) ? 1.0f : 0.f; }
            }
            ps = mfma32(accfrag(paT[mt], 0), bt0, ps); ps = mfma32(accfrag(paT[mt], 1), bt1, ps);
#pragma unroll
            for (int sp = 0; sp < 2; ++sp)
                *(u32x4*)(slot + SL_PS + ((nt * 2 + mt) * 2 + sp) * 1024 + lane5 * 16) = (u32x4){cvt_pk_bf16(ps[8 * sp] * gam, ps[8 * sp + 1] * gam), cvt_pk_bf16(ps[8 * sp + 2] * gam, ps[8 * sp + 3] * gam), cvt_pk_bf16(ps[8 * sp + 4] * gam, ps[8 * sp + 5] * gam), cvt_pk_bf16(ps[8 * sp + 6] * gam, ps[8 * sp + 7] * gam)};
        }
        f32x16 qs;
        { const bf16x8 k0 = trfrag(mKT, 0, nt, lane5), k1 = trfrag(mKT, 1, nt, lane5);
          const u32x4 w0 = __builtin_bit_cast(u32x4, k0), w1 = __builtin_bit_cast(u32x4, k1);
#pragma unroll
          for (int j = 0; j < 4; ++j) { qs[2 * j] = bf16_lo(w0[j]); qs[2 * j + 1] = bf16_hi(w0[j]); qs[8 + 2 * j] = bf16_lo(w1[j]); qs[8 + 2 * j + 1] = bf16_hi(w1[j]); } }
        qs = mfma32(accfrag(qakT, 0), bt0, qs); qs = mfma32(accfrag(qakT, 1), bt1, qs);
#pragma unroll
        for (int sp = 0; sp < 2; ++sp) *(u32x4*)(slot + SL_QS + (nt * 2 + sp) * 1024 + lane5 * 16) = (u32x4){cvt_pk_bf16(qs[8 * sp] * gam, qs[8 * sp + 1] * gam), cvt_pk_bf16(qs[8 * sp + 2] * gam, qs[8 * sp + 3] * gam), cvt_pk_bf16(qs[8 * sp + 4] * gam, qs[8 * sp + 5] * gam), cvt_pk_bf16(qs[8 * sp + 6] * gam, qs[8 * sp + 7] * gam)};
    }
    LDS_WAIT();
}

__device__ __forceinline__ u32x4 ntload16(const void* ptr) { return __builtin_nontemporal_load((const u32x4*)ptr); }
struct RkOps { u32x4 vr[4]; bf16x8 fps[2][2][2], fqs[2][2], fpo[2][2], fqo[2]; };
__device__ __forceinline__ void rk_load_ops_a(RkOps& o, const unsigned char* slot, int lane) {
    using namespace rk;
    const int r32 = lane & 31, h = lane >> 5;
#pragma unroll
    for (int k = 0; k < 4; ++k) o.vr[k] = ntload16(slot + SL_VR + k * 1024 + lane * 16);
#pragma unroll
    for (int jt = 0; jt < 2; ++jt)
#pragma unroll
        for (int s = 0; s < 2; ++s) o.fpo[jt][s] = __builtin_bit_cast(bf16x8, ntload16(slot + SL_PO + (2 * jt + s) * 1024 + lane * 16));
#pragma unroll
    for (int s = 0; s < 2; ++s) o.fqo[s] = __builtin_bit_cast(bf16x8, ntload16(slot + SL_QO + s * 1024 + lane * 16));
}
__device__ __forceinline__ void rk_load_ops_b(RkOps& o, const unsigned char* slot, int lane) {
    using namespace rk;
    const int r32 = lane & 31, h = lane >> 5;
#pragma unroll
    for (int mt = 0; mt < 2; ++mt) {
#pragma unroll
        for (int jt = 0; jt < 2; ++jt)
#pragma unroll
            for (int s = 0; s < 2; ++s) o.fps[mt][jt][s] = __builtin_bit_cast(bf16x8, ntload16(slot + SL_PS + ((mt * 2 + jt) * 2 + s) * 1024 + lane * 16));
#pragma unroll
        for (int s = 0; s < 2; ++s) o.fqs[mt][s] = __builtin_bit_cast(bf16x8, ntload16(slot + SL_QS + (mt * 2 + s) * 1024 + lane * 16));
    }
}
#define RK_SPIN(cond) do { unsigned _sp = 0; while (cond) { __builtin_amdgcn_s_sleep(1); if (++_sp > (1u << 24)) { err[0] = 1u; break; } } asm volatile("" ::: "memory"); } while (0)

__device__ __forceinline__ void rwkv_chain(const Params& p, LAS unsigned char* lds, int b, int hh) {
    using namespace rk;
    int tid = threadIdx.x; asm volatile("" : "+v"(tid));
    volatile LAS unsigned* ready = (volatile LAS unsigned*)(lds + L_FLAG); volatile LAS unsigned* freed = ready + NSLOT; volatile LAS unsigned* ofull = freed + NSLOT; volatile LAS unsigned* ofree = ofull + 2; volatile LAS unsigned* err = ofree + 2;
    if (tid < 2 * NSLOT + 5) ready[tid] = 0u;
    {
        const bf16_t* w2t = (const bf16_t*)(p.ws + WS_LT); const bf16_t* a2t = w2t + 512 * 64; const bf16_t* g2t = a2t + 512 * 64;
        for (int i = tid; i < 64 * 8; i += NTHREADS) { const int j = i >> 3, ch = i & 7, d = j * 128 + ((ch ^ (j & 7)) << 4);
            *(LAS u32x4*)(lds + L_W2 + d) = *(const u32x4*)(w2t + (hh * HD + j) * 64 + 8 * ch); *(LAS u32x4*)(lds + L_A2 + d) = *(const u32x4*)(a2t + (hh * HD + j) * 64 + 8 * ch); }
        for (int i = tid; i < 64 * 16; i += NTHREADS) { const int j = i >> 4, ch = i & 15; *(LAS u32x4*)(lds + L_G2 + j * 256 + ((ch ^ (j & 7)) << 4)) = *(const u32x4*)(g2t + (hh * HD + j) * 128 + 8 * ch); }
        LAS float* cst = (LAS float*)(lds + L_CST);
        for (int i = tid; i < C_END; i += NTHREADS) { float v;
            if (i < 256) v = p.shift_mu[(UXW - UR) + i];
            else if (i < 320) v = p.shift_mu[hh * HD + (i - 256)];
            else if (i < 384) v = p.shift_mu[(URK - UR) + hh * HD + (i - 320)];
            else if (i < 448) v = p.shift_mu[(URV - UR) + hh * HD + (i - 384)];
            else if (i < 512) v = p.rw_w0[hh * HD + (i - 448)];
            else if (i < 576) v = p.rw_a0[hh * HD + (i - 512)];
            else if (i < 640) v = p.rw_k_k[hh * HD + (i - 576)];
            else if (i < 704) v = p.rw_k_a[hh * HD + (i - 640)];
            else if (i < 768) v = p.rw_r_k[hh * HD + (i - 704)];
            else v = p.rw_ln_b[hh * HD + (i - 768)];
            cst[i] = v; }
    }
    __syncthreads();
    asm volatile("" : "+v"(tid));
    const int wave = __builtin_amdgcn_readfirstlane(tid >> 6);
    unsigned char* ring = (unsigned char*)p.out + (size_t)(b * NH + hh) * NSLOT * SLOT_BYTES;
    if (wave == 0) {
        int lane = tid & 63; asm volatile("" : "+v"(lane));
        const int r32 = lane & 31, h = lane >> 5;
        LAS unsigned char* vs = lds + L_CONS;
        f32x16 st[2][2];
#pragma unroll
        for (int a = 0; a < 2; ++a)
#pragma unroll
            for (int d = 0; d < 2; ++d) st[a][d] = zero16();
        RkOps ops;
        RK_SPIN(ready[0] != 1u);
        rk_load_ops_a(ops, ring, lane); rk_load_ops_b(ops, ring, lane);
        for (int c = 0; c < NCH; ++c) {
            bf16x8 sf[2][2][2];
#pragma unroll
            for (int jt = 0; jt < 2; ++jt)
#pragma unroll
                for (int it = 0; it < 2; ++it) { sf[jt][it][0] = accfrag(st[jt][it], 0); sf[jt][it][1] = accfrag(st[jt][it], 1); }
            { LAS unsigned char* d = vs + r32 * MSTR + h * 64;
              *(LAS u32x4*)d = ops.vr[0]; *(LAS u32x4*)(d + 16) = ops.vr[1]; *(LAS u32x4*)(d + 32) = ops.vr[2]; *(LAS u32x4*)(d + 48) = ops.vr[3]; }
            LDS_WAIT();
            bf16x8 vf[2][2];
            { const int g = lane >> 4, i16 = lane & 15, q = i16 >> 2, pp = i16 & 3;
#pragma unroll
              for (int it = 0; it < 2; ++it)
#pragma unroll
                  for (int s = 0; s < 2; ++s) { const LAS unsigned char* a = vs + (16 * s + 4 * h + q) * MSTR + (32 * it + 16 * (g & 1) + 4 * pp) * 2;
                      const s16x4 x = lds_tr16(a), y = lds_tr16(a + 8 * MSTR);
                      bf16x8 r; r[0] = x[0]; r[1] = x[1]; r[2] = x[2]; r[3] = x[3]; r[4] = y[0]; r[5] = y[1]; r[6] = y[2]; r[7] = y[3]; vf[it][s] = r; } }
            f32x16 o[2];
#pragma unroll
            for (int it = 0; it < 2; ++it) {
                o[it] = zero16();
#pragma unroll
                for (int jt = 0; jt < 2; ++jt)
#pragma unroll
                    for (int s = 0; s < 2; ++s) o[it] = mfma32(sf[jt][it][s], ops.fpo[jt][s], o[it]);
#pragma unroll
                for (int s = 0; s < 2; ++s) o[it] = mfma32(vf[it][s], ops.fqo[s], o[it]);
            }
            const unsigned char* nslot = ring + (size_t)((c + 1) % NSLOT) * SLOT_BYTES;
            if (c + 1 < NCH) { RK_SPIN(ready[(c + 1) % NSLOT] != (unsigned)(c + 2)); rk_load_ops_a(ops, nslot, lane); }
#pragma unroll
            for (int mt = 0; mt < 2; ++mt)
#pragma unroll
                for (int it = 0; it < 2; ++it) {
                    f32x16 a = zero16();
#pragma unroll
                    for (int jt = 0; jt < 2; ++jt)
#pragma unroll
                        for (int s = 0; s < 2; ++s) a = mfma32(ops.fps[mt][jt][s], sf[jt][it][s], a);
#pragma unroll
                    for (int s = 0; s < 2; ++s) a = mfma32(ops.fqs[mt][s], vf[it][s], a);
                    st[mt][it] = a;
                }
            if (c + 1 < NCH) rk_load_ops_b(ops, nslot, lane);
            if (c >= 1) RK_SPIN(ofree[0] != (unsigned)c);
            { LAS unsigned char* ob = lds + L_OBUF + r32 * OSTR;
#pragma unroll
              for (int it = 0; it < 2; ++it)
#pragma unroll
                  for (int g = 0; g < 4; ++g) *(LAS f32x4*)(ob + (32 * it + 8 * g + 4 * h) * 4) = (f32x4){o[it][4 * g], o[it][4 * g + 1], o[it][4 * g + 2], o[it][4 * g + 3]}; }
            LDS_WAIT();
            if (lane == 0) ofull[0] = (unsigned)(c + 1);
        }
    } else if (wave == 1) {
        int lane = tid & 63; asm volatile("" : "+v"(lane));
        const int r32 = lane & 31, h = lane >> 5;
        u32x4 gw[4], gb[4];
        RK_SPIN(ready[0] != 1u);
#pragma unroll
        for (int k = 0; k < 4; ++k) { gw[k] = ntload16(ring + SL_GW + k * 1024 + lane * 16); gb[k] = ntload16(ring + SL_GB + k * 1024 + lane * 16); }
        for (int c = 0; c < NCH; ++c) {
            const int sl = c % NSLOT;
            RK_SPIN(ofull[0] != (unsigned)(c + 1));
            float ov[32];
            { const LAS unsigned char* ob = lds + L_OBUF + r32 * OSTR + 128 * h;
#pragma unroll
              for (int k = 0; k < 8; ++k) { const f32x4 x = *(const LAS f32x4*)(ob + 16 * k); ov[4 * k] = x[0]; ov[4 * k + 1] = x[1]; ov[4 * k + 2] = x[2]; ov[4 * k + 3] = x[3]; } }
            LDS_WAIT();
            if (lane == 0) ofree[0] = (unsigned)(c + 1);
            float sm = 0.f;
#pragma unroll
            for (int k = 0; k < 32; ++k) sm += ov[k];
            sm += swap32(sm);
            const float mean = sm * (1.0f / 64.0f);
            float sv = 0.f;
#pragma unroll
            for (int k = 0; k < 32; ++k) { const float d = ov[k] - mean; sv += d * d; }
            sv += swap32(sv);
            const float rstd = 1.0f / sqrtf(sv * (1.0f / 64.0f) + 64e-5f);
            bf16_t* mrow = (bf16_t*)(p.ws + WS_B) + ((size_t)b * S + c * C + r32) * D + 512 + hh * HD + 32 * h;
#pragma unroll
            for (int k = 0; k < 4; ++k) {
                float w8[8], b8[8], r[8]; f8_from_bf16(gw[k], w8); f8_from_bf16(gb[k], b8);
                const f32x4 l0 = *(const f32x4*)(p.rw_ln_w + hh * HD + 32 * h + 8 * k), l1 = *(const f32x4*)(p.rw_ln_w + hh * HD + 32 * h + 8 * k + 4);
#pragma unroll
                for (int e = 0; e < 8; ++e) r[e] = ((ov[8 * k + e] - mean) * rstd * (e < 4 ? l0[e] : l1[e - 4]) + b8[e]) * w8[e];
                *(u32x4*)(mrow + 8 * k) = (u32x4){cvt_pk_bf16(r[0], r[1]), cvt_pk_bf16(r[2], r[3]), cvt_pk_bf16(r[4], r[5]), cvt_pk_bf16(r[6], r[7])};
            }
            if (lane == 0) freed[sl] = (unsigned)(c + 1);
            if (c + 1 < NCH) { const int sn = (c + 1) % NSLOT; const unsigned char* sp_ = ring + (size_t)sn * SLOT_BYTES; RK_SPIN(ready[sn] != (unsigned)(c + 2));
#pragma unroll
                for (int k = 0; k < 4; ++k) { gw[k] = ntload16(sp_ + SL_GW + k * 1024 + lane * 16); gb[k] = ntload16(sp_ + SL_GB + k * 1024 + lane * 16); } }
        }
    } else {
        int lane = tid & 63;
        if (wave - 2 < NPROD) for (int c = wave - 2; c < NCH; c += NPROD) {
            const int sl = c % NSLOT;
            if (c >= NSLOT) RK_SPIN(freed[sl] != (unsigned)(c - NSLOT + 1));
            rk_produce(p, lds, lds + (wave - 2) * PROD_LDS, ring + (size_t)sl * SLOT_BYTES, b, hh, c);
            asm volatile("s_waitcnt vmcnt(0)" ::: "memory");
            if (lane == 0) ready[sl] = (unsigned)(c + 1);
        }
    }
    __syncthreads();
}

#ifdef RWDEBUG
namespace rw {
constexpr int CH = 16;
constexpr int O_UM = 0;
constexpr int O_LW = O_UM + CH * 448 * 4;
constexpr int O_LA = O_LW + CH * 64 * 4;
constexpr int O_LG0 = O_LA + CH * 64 * 4;
constexpr int O_LG1 = O_LG0 + CH * 64 * 4;
constexpr int O_A1 = O_LG1 + CH * 64 * 4;
constexpr int O_R1 = O_A1 + CH * 64 * 4;
constexpr int O_B1 = O_R1 + CH * 64 * 4;
constexpr int O_K1 = O_B1 + CH * 64 * 4;
constexpr int O_O = O_K1 + CH * 64 * 4;
constexpr int O_WT = O_O + CH * 64 * 4;
constexpr int O_GC = O_WT + 8 * 64 * 4;
constexpr int O_SC = O_GC + 64 * 4;
constexpr int O_END = O_SC + 3 * 16 * 4;
}
__device__ __forceinline__ bf16x8 ldw_frag(const float* W, int ldw, int m0, int col) {
    unsigned w[4];
#pragma unroll
    for (int j = 0; j < 4; ++j) w[j] = cvt_pk_bf16(W[(size_t)(m0 + 2 * j) * ldw + col], W[(size_t)(m0 + 2 * j + 1) * ldw + col]);
    return __builtin_bit_cast(bf16x8, (u32x4){w[0], w[1], w[2], w[3]});
}
template <int ACT>
__device__ __forceinline__ bf16x8 act_frag(const LAS float* src) {
    const f32x4 a = *(const LAS f32x4*)src, b = *(const LAS f32x4*)(src + 4); float v[8] = {a[0], a[1], a[2], a[3], b[0], b[1], b[2], b[3]};
#pragma unroll
    for (int j = 0; j < 8; ++j) {
        if (ACT == 1) v[j] = 1.0f - 2.0f * frcp(1.0f + fexp2(v[j] * (2.0f * LOG2E)));
        if (ACT == 2) v[j] = frcp(1.0f + fexp2(-v[j] * LOG2E));
    }
    return __builtin_bit_cast(bf16x8, (u32x4){cvt_pk_bf16(v[0], v[1]), cvt_pk_bf16(v[2], v[3]), cvt_pk_bf16(v[4], v[5]), cvt_pk_bf16(v[6], v[7])});
}

__device__ __forceinline__ void rwkv_chain_seq(const Params& p, LAS unsigned char* lds, int b, int h, bf16_t* mix, int nchunks) {
    using namespace rw;
    const int tid = threadIdx.x, wave = __builtin_amdgcn_readfirstlane(tid >> 6), lane = tid & 63;
    const bf16_t* u = (const bf16_t*)(p.ws + WS_A);
    const size_t row0 = (size_t)b * S;
    LAS float* UM = (LAS float*)(lds + O_UM); LAS float* LW = (LAS float*)(lds + O_LW); LAS float* LA = (LAS float*)(lds + O_LA);
    LAS float* LG0 = (LAS float*)(lds + O_LG0); LAS float* LG1 = (LAS float*)(lds + O_LG1);
    LAS float* A1 = (LAS float*)(lds + O_A1); LAS float* R1 = (LAS float*)(lds + O_R1); LAS float* B1 = (LAS float*)(lds + O_B1); LAS float* K1 = (LAS float*)(lds + O_K1);
    LAS float* OO = (LAS float*)(lds + O_O); LAS float* WT = (LAS float*)(lds + O_WT); LAS float* GC = (LAS float*)(lds + O_GC); LAS float* SC = (LAS float*)(lds + O_SC);
    const int fc = lane & 15, fq = lane >> 4;
    bf16x8 bwa[2], bg[2];
    { const float* W = wave < 4 ? p.rw_w2 : p.rw_a2; const int col = h * HD + 16 * (wave & 3) + fc;
      bwa[0] = ldw_frag(W, 512, 8 * fq, col); bwa[1] = ldw_frag(W, 512, 32 + 8 * fq, col);
      const int ks = (wave >> 2) * 2; bg[0] = ldw_frag(p.rw_g2, 512, 32 * ks + 8 * fq, col); bg[1] = ldw_frag(p.rw_g2, 512, 32 * (ks + 1) + 8 * fq, col); }
    const int hj = h * HD + lane;
    const float c_w0 = p.rw_w0[hj], c_a0 = p.rw_a0[hj], c_kk = p.rw_k_k[hj], c_ka = p.rw_k_a[hj], c_rk = p.rw_r_k[hj], c_lnw = p.rw_ln_w[hj], c_lnb = p.rw_ln_b[hj];
    int ld_t[2], ld_c[2], ld_uc[2]; bool ld_ok[2];
#pragma unroll
    for (int r = 0; r < 2; ++r) { const int gid = tid + 512 * r; ld_ok[r] = gid < CH * 56; const int t = gid / 56, cg8 = gid % 56; ld_t[r] = t; ld_c[r] = cg8 * 8;
        ld_uc[r] = cg8 < 8 ? UR + h * HD + 8 * cg8 : cg8 < 16 ? URK + h * HD + 8 * (cg8 - 8) : cg8 < 24 ? URV + h * HD + 8 * (cg8 - 16) : UXW + 8 * (cg8 - 24); }
    const int si = 8 * wave + (lane >> 3), sj = 8 * (lane & 7);
    float st[8];
#pragma unroll
    for (int n = 0; n < 8; ++n) st[n] = 0.f;
    u32x4 cur[2], prv[2];
    auto issue_loads = [&](int t0) {
#pragma unroll
        for (int r = 0; r < 2; ++r) { cur[r] = (u32x4){0u, 0u, 0u, 0u}; prv[r] = (u32x4){0u, 0u, 0u, 0u};
            if (ld_ok[r]) { const int tt = t0 + ld_t[r]; const bf16_t* a = u + (row0 + tt) * NIN + ld_uc[r]; cur[r] = *(const u32x4*)a; if (tt > 0) prv[r] = *(const u32x4*)(a - NIN); } }
    };
    issue_loads(0);
    for (int c = 0; c < nchunks; ++c) {
        const int t0 = c * CH;
#pragma unroll
        for (int r = 0; r < 2; ++r) if (ld_ok[r]) {
            const float* mu = p.shift_mu + (ld_uc[r] - UR); const f32x4 m0 = *(const f32x4*)mu, m1 = *(const f32x4*)(mu + 4);
            float cv[8], pv[8];
#pragma unroll
            for (int j = 0; j < 4; ++j) { cv[2 * j] = bf16_lo(cur[r][j]); cv[2 * j + 1] = bf16_hi(cur[r][j]); pv[2 * j] = bf16_lo(prv[r][j]); pv[2 * j + 1] = bf16_hi(prv[r][j]); }
            f32x4 o0, o1;
#pragma unroll
            for (int j = 0; j < 4; ++j) { o0[j] = cv[j] + (pv[j] - cv[j]) * m0[j]; o1[j] = cv[4 + j] + (pv[4 + j] - cv[4 + j]) * m1[j]; }
            LAS float* d = UM + ld_t[r] * 448 + ld_c[r]; *(LAS f32x4*)d = o0; *(LAS f32x4*)(d + 4) = o1;
        }
        if (c + 1 < S / CH) issue_loads(t0 + CH);
        __syncthreads();
        {
            f32x4 acc = (f32x4){0.f, 0.f, 0.f, 0.f};
            const LAS float* src = UM + fc * 448 + (wave < 4 ? 192 : 256) + 8 * fq;
            if (wave < 4) { acc = __builtin_amdgcn_mfma_f32_16x16x32_bf16(act_frag<1>(src), bwa[0], acc, 0, 0, 0); acc = __builtin_amdgcn_mfma_f32_16x16x32_bf16(act_frag<1>(src + 32), bwa[1], acc, 0, 0, 0); }
            else          { acc = __builtin_amdgcn_mfma_f32_16x16x32_bf16(act_frag<0>(src), bwa[0], acc, 0, 0, 0); acc = __builtin_amdgcn_mfma_f32_16x16x32_bf16(act_frag<0>(src + 32), bwa[1], acc, 0, 0, 0); }
            LAS float* dst = (wave < 4 ? LW : LA) + 16 * (wave & 3) + fc;
#pragma unroll
            for (int r = 0; r < 4; ++r) dst[(4 * fq + r) * 64] = acc[r];
            f32x4 ag = (f32x4){0.f, 0.f, 0.f, 0.f};
            const LAS float* sg = UM + fc * 448 + 320 + 64 * (wave >> 2) + 8 * fq;
            ag = __builtin_amdgcn_mfma_f32_16x16x32_bf16(act_frag<2>(sg), bg[0], ag, 0, 0, 0); ag = __builtin_amdgcn_mfma_f32_16x16x32_bf16(act_frag<2>(sg + 32), bg[1], ag, 0, 0, 0);
            LAS float* dg = (wave < 4 ? LG0 : LG1) + 16 * (wave & 3) + fc;
#pragma unroll
            for (int r = 0; r < 4; ++r) dg[(4 * fq + r) * 64] = ag[r];
        }
        __syncthreads();
        float e_kk[2], e_b[2], e_k[2], e_r[2], e_ld[2];
#pragma unroll
        for (int tt = 0; tt < 2; ++tt) {
            const int t = 2 * wave + tt;
            const float xw = c_w0 + LW[t * 64 + lane];
            const float spn = (fmaxf(-xw, 0.f) + LN2 * flog2(1.0f + fexp2(-fabsf(xw) * LOG2E)));
            e_ld[tt] = -fexp2((-spn - 0.5f) * LOG2E);
            const float a = frcp(1.0f + fexp2(-(c_a0 + LA[t * 64 + lane]) * LOG2E));
            const float kraw = UM[t * 448 + 64 + lane], r = UM[t * 448 + lane];
            const float kkv = kraw * c_kk; const float ssq = wave_sum(kkv * kkv);
            const float kk = kkv * frsq(fmaxf(ssq, 1e-24f));
            const float kmod = kraw * (1.0f + (a - 1.0f) * c_ka);
            const float bb = kk * a;
            const float cbr = wave_sum(bb * r), ckr = wave_sum(kmod * r), bon = wave_sum(r * kmod * c_rk);
            if (lane == 0) { SC[t] = cbr; SC[16 + t] = ckr; SC[32 + t] = bon; }
            e_kk[tt] = kk; e_b[tt] = bb; e_k[tt] = kmod; e_r[tt] = r;
        }
        WT[wave * 64 + lane] = e_ld[0] + e_ld[1];
        __syncthreads();
        {
            float off = 0.f, tot = 0.f;
#pragma unroll
            for (int w = 0; w < 8; ++w) { const float x = WT[w * 64 + lane]; if (w < wave) off += x; tot += x; }
            const float c0 = off + e_ld[0], c1 = c0 + e_ld[1];
            const int t = 2 * wave;
            A1[t * 64 + lane] = -e_kk[0] * fexp2(off * LOG2E);       A1[(t + 1) * 64 + lane] = -e_kk[1] * fexp2(c0 * LOG2E);
            R1[t * 64 + lane] = e_r[0] * fexp2(c0 * LOG2E);          R1[(t + 1) * 64 + lane] = e_r[1] * fexp2(c1 * LOG2E);
            const float i0 = fexp2(-c0 * LOG2E), i1 = fexp2(-c1 * LOG2E);
            B1[t * 64 + lane] = e_b[0] * i0;                          B1[(t + 1) * 64 + lane] = e_b[1] * i1;
            K1[t * 64 + lane] = e_k[0] * i0;                          K1[(t + 1) * 64 + lane] = e_k[1] * i1;
            if (wave == 0) GC[lane] = fexp2(tot * LOG2E);
        }
        __syncthreads();
#pragma unroll 4
        for (int t = 0; t < CH; ++t) {
            const f32x4 a0 = *(const LAS f32x4*)(A1 + t * 64 + sj), a1 = *(const LAS f32x4*)(A1 + t * 64 + sj + 4);
            const f32x4 r0 = *(const LAS f32x4*)(R1 + t * 64 + sj), r1 = *(const LAS f32x4*)(R1 + t * 64 + sj + 4);
            const f32x4 b0 = *(const LAS f32x4*)(B1 + t * 64 + sj), b1 = *(const LAS f32x4*)(B1 + t * 64 + sj + 4);
            const f32x4 k0 = *(const LAS f32x4*)(K1 + t * 64 + sj), k1 = *(const LAS f32x4*)(K1 + t * 64 + sj + 4);
            const float v = UM[t * 448 + 128 + si], cbr = SC[t], ckr = SC[16 + t];
            float sa = (st[0] * a0[0] + st[1] * a0[1]) + (st[2] * a0[2] + st[3] * a0[3]) + ((st[4] * a1[0] + st[5] * a1[1]) + (st[6] * a1[2] + st[7] * a1[3]));
            float pp = (st[0] * r0[0] + st[1] * r0[1]) + (st[2] * r0[2] + st[3] * r0[3]) + ((st[4] * r1[0] + st[5] * r1[1]) + (st[6] * r1[2] + st[7] * r1[3]));
            sa = sum8(sa); pp = sum8(pp);
            if ((lane & 7) == 0) OO[t * 64 + si] = pp + sa * cbr + v * ckr;
#pragma unroll
            for (int n = 0; n < 4; ++n) { st[n] += sa * b0[n] + v * k0[n]; st[4 + n] += sa * b1[n] + v * k1[n]; }
        }
        {
            const f32x4 g0 = *(const LAS f32x4*)(GC + sj), g1 = *(const LAS f32x4*)(GC + sj + 4);
#pragma unroll
            for (int n = 0; n < 4; ++n) { st[n] *= g0[n]; st[4 + n] *= g1[n]; }
        }
        __syncthreads();
#pragma unroll
        for (int tt = 0; tt < 2; ++tt) {
            const int t = 2 * wave + tt;
            const float o = OO[t * 64 + lane];
            const float mean = wave_sum(o) * (1.0f / 64.0f); const float dlt = o - mean;
            const float var = wave_sum(dlt * dlt) * (1.0f / 64.0f);
            const float gn = dlt * (1.0f / sqrtf(var + 64e-5f)) * c_lnw + c_lnb;
            const float res = (gn + SC[32 + t] * UM[t * 448 + 128 + lane]) * (LG0[t * 64 + lane] + LG1[t * 64 + lane]);
            mix[(row0 + t0 + t) * D + 512 + h * HD + lane] = (bf16_t)(cvt_pk_bf16(res, 0.f) & 0xffffu);
        }
        __syncthreads();
    }
}

#endif

__device__ __forceinline__ void phase2a(const Params& p) {
    int tid = threadIdx.x; asm volatile("" : "+v"(tid));
    const int wave = tid >> 6, lane = tid & 63;
    const bf16_t* u = (const bf16_t*)(p.ws + WS_A);
    bf16_t* act = (bf16_t*)((unsigned char*)p.out + ACT_OFF);
    const f32x4 mu = *(const f32x4*)(p.shift_mu + (UXW - UR) + 4 * lane);
    const int stride = gridDim.x * NWAVES;
    int row = blockIdx.x * NWAVES + wave;
    u32x2 c = (u32x2){0u, 0u}, pv = (u32x2){0u, 0u};
    if (row < T) { const bf16_t* a = u + (size_t)row * NIN + UXW + 4 * lane; c = *(const u32x2*)a; if ((row & (S - 1)) != 0) pv = *(const u32x2*)(a - NIN); }
    for (; row < T; row += stride) {
        const float cv[4] = {bf16_lo(c.x), bf16_hi(c.x), bf16_lo(c.y), bf16_hi(c.y)}, pf[4] = {bf16_lo(pv.x), bf16_hi(pv.x), bf16_lo(pv.y), bf16_hi(pv.y)};
        const int nrow = row + stride;
        if (nrow < T) { const bf16_t* a = u + (size_t)nrow * NIN + UXW + 4 * lane; c = *(const u32x2*)a; pv = (u32x2){0u, 0u}; if ((nrow & (S - 1)) != 0) pv = *(const u32x2*)(a - NIN); }
        float x[4];
#pragma unroll
        for (int j = 0; j < 4; ++j) { x[j] = cv[j] + (pf[j] - cv[j]) * mu[j];
            if (lane < 16) x[j] = 1.0f - 2.0f * frcp(1.0f + fexp2(x[j] * (2.0f * LOG2E)));
            else if (lane >= 32) x[j] = frcp(1.0f + fexp2(-x[j] * LOG2E)); }
        *(u32x2*)(act + (size_t)row * 256 + 4 * lane) = (u32x2){cvt_pk_bf16(x[0], x[1]), cvt_pk_bf16(x[2], x[3])};
    }
}

__device__ __forceinline__ void phase2(const Params& p, LAS unsigned char* lds) {
    const int nchain = NB * NH, G = gridDim.x, wave = threadIdx.x >> 6;
    const int nscan = G >= 2 * nchain ? nchain : (G > 1 ? G / 2 : 0);
    if ((int)blockIdx.x < nscan || nscan == 0) {
        const int stride = nscan == 0 ? G : nscan;
        for (int it = blockIdx.x; it < nchain; it += stride) rwkv_chain(p, lds, it / NH, it % NH);
    }
    if ((int)blockIdx.x >= nscan) {
        const int nb = G - nscan, bi = blockIdx.x - nscan;
        for (int it = bi * 8 + wave; it < NB * NH * 64; it += nb * 8) attn_tile(p, lds + wave * 9216, it / (NH * 64), (it / 64) % NH, 63 - (it % 64));
        __syncthreads();
        p0_expert_weights(p, lds, bi * 8 + wave, nb * 8);
    }
}

struct EpiH {
    const float* x; bf16_t* hb; int row0, col0;
    __device__ __forceinline__ void operator()(const f32x4 (&acc)[2][2][4][2], const unsigned (&m0)[8], const unsigned (&m1)[8], int wr, int wc, int fr, int fq) const {
#pragma unroll
        for (int ai = 0; ai < 2; ++ai)
#pragma unroll
            for (int m = 0; m < 4; ++m) { const size_t off = (size_t)(row0 + ai * 128 + wr * 64 + m * 16 + fr) * D + col0 + wc * 32 + 8 * fq;
#pragma unroll
                for (int bj = 0; bj < 2; ++bj) { const f32x4 v0 = *(const f32x4*)(x + off + bj * 128) + acc[ai][bj][m][0], v1 = *(const f32x4*)(x + off + bj * 128 + 4) + acc[ai][bj][m][1];
                    *(u32x4*)(hb + off + bj * 128) = (u32x4){cvt_pk_bf16(v0[0], v0[1]), cvt_pk_bf16(v0[2], v0[3]), cvt_pk_bf16(v1[0], v1[1]), cvt_pk_bf16(v1[2], v1[3])}; }
                if (m & 1) asm volatile("" ::: "memory"); }
    }
};
__device__ __forceinline__ void phase3(const Params& p, LAS unsigned char* lds) {
    constexpr int nM = T / 256, nN = D / 256;
    g8::UnitIO cur, nxt; g8::aoff_rows(cur.aoff, D);
#pragma unroll
    for (int a = 0; a < 2; ++a)
#pragma unroll
        for (int b = 0; b < 2; ++b) nxt.aoff[a][b] = cur.aoff[a][b];
    cur.meta0 = nullptr; cur.meta1 = nullptr; nxt.meta0 = nullptr; nxt.meta1 = nullptr;
    int pm = 0, pn = 0; int L = blockIdx.x;
    if (L < nM * nN) { g8::tile_order(L, nM, nN, pm, pn); cur.Ab = (const char*)(p.ws + WS_B) + (size_t)pm * 256 * D * 2; cur.Bb = (const char*)(p.ws + WS_WOUT) + (size_t)pn * 256 * D * 2; }
    for (int i = 0; L < nM * nN; L += gridDim.x, ++i) {
        const bool hn = L + (int)gridDim.x < nM * nN; int pm2 = 0, pn2 = 0;
        if (hn) { g8::tile_order(L + gridDim.x, nM, nN, pm2, pn2); nxt.Ab = (const char*)(p.ws + WS_B) + (size_t)pm2 * 256 * D * 2; nxt.Bb = (const char*)(p.ws + WS_WOUT) + (size_t)pn2 * 256 * D * 2; }
        EpiH E{p.x, (bf16_t*)(p.ws + WS_A), pm * 256, pn * 256};
        g8::gemm_unit_p<16>(lds, cur, D, E, i & 1, i > 0, hn, nxt);
        cur.Ab = nxt.Ab; cur.Bb = nxt.Bb; pm = pm2; pn = pn2;
    }
}

__device__ __forceinline__ void phase4(const Params& p, LAS unsigned char* lds) {
    int tid = threadIdx.x; asm volatile("" : "+v"(tid));
    const int wave = tid >> 6, lane = tid & 63, fr = lane & 15, fq = lane >> 4;
    const float* hsrc = p.out; bf16_t* hb = (bf16_t*)(p.ws + WS_A); float* rstd2 = (float*)(p.ws + WS_RSTD2);
    const bf16_t* wr_hi = (const bf16_t*)(p.ws + WS_WR); const bf16_t* wr_lo = wr_hi + 48 * D;
    int* list = (int*)(p.ws + WS_LIST); float* listw = (float*)(p.ws + WS_LISTW); float* listr = (float*)(p.ws + WS_LISTR); unsigned* cnt = (unsigned*)(p.ws + WS_CTL);
    LAS float* lg = (LAS float*)(lds + wave * 3072);
    LAS unsigned* lcnt = (LAS unsigned*)(lds + 8 * 3072);
    LAS unsigned* gbase = lcnt + 32;
    for (int blk = blockIdx.x; blk < T / 128; blk += gridDim.x) {
        if (tid < 32) lcnt[tid] = 0u;
        __syncthreads();
        const int tok0 = blk * 128 + wave * 16;
        f32x4 acc[3];
#pragma unroll
        for (int n = 0; n < 3; ++n) acc[n] = (f32x4){0.f, 0.f, 0.f, 0.f};
        float ss = 0.f;
        const bf16_t* hbp = hb + (size_t)(tok0 + fr) * D + 8 * fq;
        LAS unsigned char* wl_ = lds + 32768;
#pragma unroll 1
        for (int half = 0; half < 2; ++half) {
            __syncthreads();
            for (int i = tid; i < 2 * 48 * 64; i += NTHREADS) { const int mat = i / 3072, r = (i % 3072) >> 6, ch = i & 63;
                *(LAS u32x4*)(wl_ + mat * 49152 + r * 1024 + ((ch ^ (r & 15)) << 4)) = *(const u32x4*)((mat ? wr_lo : wr_hi) + (size_t)r * D + half * 512 + ch * 8); }
            u32x4 av[16];
#pragma unroll
            for (int ks = 0; ks < 16; ++ks) av[ks] = *(const u32x4*)(hbp + half * 512 + 32 * ks);
            __syncthreads();
#pragma unroll
            for (int ks = 0; ks < 16; ++ks) {
                float f[8]; f8_from_bf16(av[ks], f);
                ss += (f[0] * f[0] + f[1] * f[1]) + (f[2] * f[2] + f[3] * f[3]) + ((f[4] * f[4] + f[5] * f[5]) + (f[6] * f[6] + f[7] * f[7]));
                const bf16x8 ah = __builtin_bit_cast(bf16x8, av[ks]);
#pragma unroll
                for (int n = 0; n < 3; ++n) {
                    const int r = 16 * n + fr, off = r * 1024 + (((4 * ks + fq) ^ (r & 15)) << 4);
                    const bf16x8 wh = *(const LAS bf16x8*)(wl_ + off), wl = *(const LAS bf16x8*)(wl_ + 49152 + off);
                    acc[n] = __builtin_amdgcn_mfma_f32_16x16x32_bf16(ah, wh, acc[n], 0, 0, 0);
                    acc[n] = __builtin_amdgcn_mfma_f32_16x16x32_bf16(ah, wl, acc[n], 0, 0, 0);
                }
            }
        }
        ss += __shfl_xor(ss, 16); ss += __shfl_xor(ss, 32);
        const float rs = 1.0f / sqrtf(ss * (1.0f / D) + 1e-6f);
        if (fq == 0) rstd2[tok0 + fr] = rs;
#pragma unroll
        for (int n = 0; n < 3; ++n)
#pragma unroll
            for (int r = 0; r < 4; ++r) lg[(4 * fq + r) * 48 + 16 * n + fr] = acc[n][r];
        LDS_WAIT();
        int e0 = 0, e1 = 0; float w0 = 0.f, w1 = 0.f; unsigned lp0 = 0, lp1 = 0;
        if (lane < 16) {
            const float rst = rs;
            const LAS float* L = lg + lane * 48;
            float gl[4]; int gi = 0; float gm;
#pragma unroll
            for (int g = 0; g < 4; ++g) gl[g] = L[g] * rst + p.r_grp_b[g];
            gm = gl[0];
#pragma unroll
            for (int g = 1; g < 4; ++g) if (gl[g] > gm) { gm = gl[g]; gi = g; }
            float gs = 0.f;
#pragma unroll
            for (int g = 0; g < 4; ++g) gs += __expf(gl[g] - gm);
            const float gval = 1.0f / gs;
            float el[8];
#pragma unroll
            for (int e = 0; e < 8; ++e) el[e] = L[4 + gi * 8 + e] * rst + p.r_exp_b[gi * 8 + e];
            int i0 = 0; float m0 = el[0];
#pragma unroll
            for (int e = 1; e < 8; ++e) if (el[e] > m0) { m0 = el[e]; i0 = e; }
            int i1 = i0 == 0 ? 1 : 0; float m1 = el[i1];
#pragma unroll
            for (int e = 0; e < 8; ++e) if (e != i0 && el[e] > m1) { m1 = el[e]; i1 = e; }
            const float x1 = __expf(m1 - m0); const float den = 1.0f / (1.0f + x1);
            e0 = gi * 8 + i0; e1 = gi * 8 + i1; w0 = gval * den; w1 = gval * x1 * den;
            lp0 = atomicAdd((unsigned*)&lcnt[e0], 1u); lp1 = atomicAdd((unsigned*)&lcnt[e1], 1u);
        }
        __syncthreads();
        if (tid < 32) gbase[tid] = atomicAdd(&cnt[tid], lcnt[tid]);
        __syncthreads();
        if (lane < 16) {
            const int tok = tok0 + lane;
            const unsigned q0 = gbase[e0] + lp0, q1 = gbase[e1] + lp1;
            list[(size_t)e0 * T + q0] = tok * 2;     listw[(size_t)e0 * T + q0] = w0; listr[(size_t)e0 * T + q0] = rs;
            list[(size_t)e1 * T + q1] = tok * 2 + 1; listw[(size_t)e1 * T + q1] = w1; listr[(size_t)e1 * T + q1] = rs;
        }
        __syncthreads();
    }
}

constexpr int LDS_MAP = 161792;
__device__ __forceinline__ void expert_map_build(const unsigned* cnt, LAS unsigned char* lds) {
    LAS int* pre = (LAS int*)(lds + LDS_MAP); LAS int* cn = pre + 40;
    if (threadIdx.x == 0) { int acc = 0; for (int i = 0; i < NE; ++i) { const int ci = (int)__hip_atomic_load(cnt + i, __ATOMIC_RELAXED, __HIP_MEMORY_SCOPE_AGENT); pre[i] = acc; cn[i] = ci; acc += (ci + 255) >> 8; } pre[NE] = acc; }
    __syncthreads();
}
__device__ __forceinline__ void expert_find(LAS unsigned char* lds, int mt, int& e, int& local, int& c) {
    const LAS int* pre = (const LAS int*)(lds + LDS_MAP); const LAS int* cn = pre + 40;
    int lo = 0;
#pragma unroll 1
    for (int i = 1; i < NE; ++i) if (pre[i] <= mt) lo = i;
    e = __builtin_amdgcn_readfirstlane(lo); local = mt - __builtin_amdgcn_readfirstlane(pre[e]); c = __builtin_amdgcn_readfirstlane(cn[e]);
}
__device__ __forceinline__ int expert_tiles(LAS unsigned char* lds) { return __builtin_amdgcn_readfirstlane(((const LAS int*)(lds + LDS_MAP))[NE]); }

struct EpiGU {
    bf16_t* hid; const float* rstd2; const int* lst; int cnt, p0, hrow0, ct;
    __device__ __forceinline__ void operator()(const f32x4 (&acc)[2][2][4][2], const unsigned (&m0)[8], const unsigned (&m1)[8], int wr, int wc, int fr, int fq) const {
#pragma unroll
        for (int ai = 0; ai < 2; ++ai)
#pragma unroll
            for (int m = 0; m < 4; ++m) { const int r = ai * 128 + wr * 64 + m * 16 + fr; const int pp = p0 + r;
                const float rs = pp < cnt ? __uint_as_float(m0[ai * 4 + m]) : 0.f;
                bf16_t* op = hid + (size_t)(hrow0 + r) * DE + ct * 128 + wc * 32 + 8 * fq;
                float o[8];
#pragma unroll
                for (int n = 0; n < 2; ++n) { const f32x4 g = acc[ai][0][m][n] * rs, uu = acc[ai][1][m][n] * rs;
#pragma unroll
                    for (int j = 0; j < 4; ++j) o[4 * n + j] = g[j] * frcp(1.0f + fexp2(-g[j] * LOG2E)) * uu[j]; }
                *(u32x4*)op = (u32x4){cvt_pk_bf16(o[0], o[1]), cvt_pk_bf16(o[2], o[3]), cvt_pk_bf16(o[4], o[5]), cvt_pk_bf16(o[6], o[7])}; }
    }
};
__device__ __forceinline__ void phase5(const Params& p, LAS unsigned char* lds) {
    expert_map_build((const unsigned*)(p.ws + WS_CTL), lds);
    const int MT = expert_tiles(lds);
    int tid = threadIdx.x; asm volatile("" : "+v"(tid));
    int Rr[2], Cc[2];
#pragma unroll
    for (int i = 0; i < 2; ++i) g8::stage_rc(tid * 16 + i * 8192, Rr[i], Cc[i]);
    g8::UnitIO cur, nxt; cur.meta1 = nullptr; nxt.meta1 = nullptr;
    auto fill = [&](g8::UnitIO& io, int unit, int& e, int& c, int& p0, int& mt, int& ct) {
        mt = unit >> 1; ct = unit & 1; int local; expert_find(lds, mt, e, local, c); p0 = local * 256;
        const int* lst = (const int*)(p.ws + WS_LIST) + (size_t)e * T;
#pragma unroll
        for (int i = 0; i < 2; ++i)
#pragma unroll
            for (int hh = 0; hh < 2; ++hh) { const int pp = p0 + hh * 128 + Rr[i]; const int tok = pp < c ? (lst[pp] >> 1) : 0; io.aoff[hh][i] = (unsigned)(tok * D + Cc[i]) * 2u; }
        io.Ab = (const char*)(p.ws + WS_A); io.Bb = (const char*)(p.ws + WS_WGU) + ((size_t)e * 512 + ct * 256) * D * 2; io.meta0 = (const unsigned*)(p.ws + WS_LISTR) + (size_t)e * T + p0;
    };
    int e = 0, c = 0, p0 = 0, mt = 0, ct = 0; int unit = blockIdx.x;
    if (unit < MT * 2) fill(cur, unit, e, c, p0, mt, ct);
    for (int i = 0; unit < MT * 2; unit += gridDim.x, ++i) {
        const bool hn = unit + (int)gridDim.x < MT * 2; int e2 = 0, c2 = 0, p02 = 0, mt2 = 0, ct2 = 0;
        if (hn) fill(nxt, unit + gridDim.x, e2, c2, p02, mt2, ct2);
        EpiGU E{(bf16_t*)(p.ws + WS_B), (const float*)(p.ws + WS_RSTD2), nullptr, c, p0, mt * 256, ct};
        g8::gemm_unit_p<8>(lds, cur, D, E, i & 1, i > 0, hn, nxt);
        cur = nxt; e = e2; c = c2; p0 = p02; mt = mt2; ct = ct2;
    }
}
struct EpiDN {
    bf16_t* y; bf16_t* dummy; const int* lst; const float* lw; int cnt, p0, col0;
    __device__ __forceinline__ void operator()(const f32x4 (&acc)[2][2][4][2], const unsigned (&m0)[8], const unsigned (&m1)[8], int wr, int wc, int fr, int fq) const {
#pragma unroll
        for (int ai = 0; ai < 2; ++ai)
#pragma unroll
            for (int m = 0; m < 4; ++m) { const int pp = p0 + ai * 128 + wr * 64 + m * 16 + fr;
                const bool ok = pp < cnt; const int rl = pp - p0; const int ent = (int)m0[ai * 4 + m]; const float w = __uint_as_float(m1[ai * 4 + m]);
                bf16_t* op = (ok ? y + ((size_t)(ent & 1) * T + (ent >> 1)) * D : dummy) + col0 + wc * 32 + 8 * fq;
#pragma unroll
                for (int bj = 0; bj < 2; ++bj) { const f32x4 v0 = acc[ai][bj][m][0] * w, v1 = acc[ai][bj][m][1] * w;
                    *(u32x4*)(op + bj * 128) = (u32x4){cvt_pk_bf16(v0[0], v0[1]), cvt_pk_bf16(v0[2], v0[3]), cvt_pk_bf16(v1[0], v1[1]), cvt_pk_bf16(v1[2], v1[3])}; }
                if (m & 1) asm volatile("" ::: "memory"); }
    }
};
__device__ __forceinline__ void phase6(const Params& p, LAS unsigned char* lds) {
    expert_map_build((const unsigned*)(p.ws + WS_CTL), lds);
    const int MT = expert_tiles(lds);
    constexpr int kdn = DE;
    g8::UnitIO cur, nxt; g8::aoff_rows(cur.aoff, kdn);
#pragma unroll
    for (int a = 0; a < 2; ++a)
#pragma unroll
        for (int b = 0; b < 2; ++b) nxt.aoff[a][b] = cur.aoff[a][b];
    auto fill = [&](g8::UnitIO& io, int unit, int& c, int& p0, int& pn) {
        const int mt = unit >> 2; pn = unit & 3; int e, local; expert_find(lds, mt, e, local, c); p0 = local * 256;
        io.Ab = (const char*)(p.ws + WS_B) + (size_t)mt * 256 * DE * 2; io.Bb = (const char*)(p.ws + WS_WDN) + ((size_t)e * D + pn * 256) * DE * 2;
        io.meta0 = (const unsigned*)(p.ws + WS_LIST) + (size_t)e * T + p0; io.meta1 = (const unsigned*)(p.ws + WS_LISTW) + (size_t)e * T + p0;
    };
    int c = 0, p0 = 0, pn = 0; int unit = blockIdx.x;
    if (unit < MT * 4) fill(cur, unit, c, p0, pn);
    for (int i = 0; unit < MT * 4; unit += gridDim.x, ++i) {
        const bool hn = unit + (int)gridDim.x < MT * 4; int c2 = 0, p02 = 0, pn2 = 0;
        if (hn) fill(nxt, unit + gridDim.x, c2, p02, pn2);
        EpiDN E{(bf16_t*)(p.ws + WS_A + (size_t)T * D * 2), (bf16_t*)(p.ws + WS_A + (size_t)3 * T * D * 2), nullptr, nullptr, c, p0, pn * 256};
        g8::gemm_unit_p<16>(lds, cur, kdn, E, i & 1, i > 0, hn, nxt);
        cur.Ab = nxt.Ab; cur.Bb = nxt.Bb; cur.meta0 = nxt.meta0; cur.meta1 = nxt.meta1; c = c2; p0 = p02; pn = pn2;
    }
}

__device__ __forceinline__ void phase7(const Params& p) {
    int tid7 = threadIdx.x; asm volatile("" : "+v"(tid7));
    const int wave = tid7 >> 6, lane = tid7 & 63;
    const bf16_t* hb = (const bf16_t*)(p.ws + WS_A);
    const bf16_t* y0 = (const bf16_t*)(p.ws + WS_A + (size_t)T * D * 2); const bf16_t* y1 = y0 + (size_t)T * D;
    f32x4 g[4];
#pragma unroll
    for (int j = 0; j < 4; ++j) g[j] = *((const f32x4*)p.final_g + lane + 64 * j);
    const int stride = gridDim.x * NWAVES;
    int row = blockIdx.x * NWAVES + wave;
    u32x2 hv[4], ya[4], yb[4];
    if (row < T) {
#pragma unroll
        for (int j = 0; j < 4; ++j) { hv[j] = ((const u32x2*)(hb + (size_t)row * D) + lane)[64 * j]; ya[j] = ((const u32x2*)(y0 + (size_t)row * D) + lane)[64 * j]; yb[j] = ((const u32x2*)(y1 + (size_t)row * D) + lane)[64 * j]; }
    }
    for (; row < T; row += stride) {
        f32x4 v[4]; float s = 0.f;
#pragma unroll
        for (int j = 0; j < 4; ++j) {
            v[j][0] = bf16_lo(hv[j].x) + (bf16_lo(ya[j].x) + bf16_lo(yb[j].x)); v[j][1] = bf16_hi(hv[j].x) + (bf16_hi(ya[j].x) + bf16_hi(yb[j].x)); v[j][2] = bf16_lo(hv[j].y) + (bf16_lo(ya[j].y) + bf16_lo(yb[j].y)); v[j][3] = bf16_hi(hv[j].y) + (bf16_hi(ya[j].y) + bf16_hi(yb[j].y));
            s += (v[j][0] * v[j][0] + v[j][1] * v[j][1]) + (v[j][2] * v[j][2] + v[j][3] * v[j][3]); }
        const int nrow = row + stride;
        if (nrow < T) {
#pragma unroll
            for (int j = 0; j < 4; ++j) { hv[j] = ((const u32x2*)(hb + (size_t)nrow * D) + lane)[64 * j]; ya[j] = ((const u32x2*)(y0 + (size_t)nrow * D) + lane)[64 * j]; yb[j] = ((const u32x2*)(y1 + (size_t)nrow * D) + lane)[64 * j]; }
        }
        s = wave_sum(s);
        const float rs = 1.0f / sqrtf(s * (1.0f / D) + 1e-6f);
        f32x4* orow = (f32x4*)(p.out + (size_t)row * D) + lane;
#pragma unroll
        for (int j = 0; j < 4; ++j) orow[64 * j] = v[j] * rs * g[j];
    }
}

__global__ __launch_bounds__(512) void mega(Params p) {
    extern __shared__ __attribute__((aligned(16))) unsigned char lds_raw[];
    LAS unsigned char* lds = (LAS unsigned char*)lds_raw;
    volatile LAS unsigned* bst = (volatile LAS unsigned*)(lds + LDS_MAP + 512);
    if (threadIdx.x == 0) { bst[0] = 0u; bst[1] = 0u; bst[2] = 0u; bst[3] = 0u; }
    __syncthreads();
    const XcdBarrier gb = xcd_barrier_post((unsigned*)(p.ws + WS_BAR), bst);
#define GSYNC() xcd_barrier(gb)
#ifndef PHASE_MASK
#define PHASE_MASK 0xff
#endif
#ifdef TPROBE
    volatile LAS unsigned long long* tsl = (volatile LAS unsigned long long*)(lds + LDS_MAP + 640);
    if (threadIdx.x == 0) tsl[0] = __builtin_amdgcn_s_memrealtime();
#define TS(i) do { if (threadIdx.x == 0 && ((i) == TPROBE || (i) == TPROBE + 1)) tsl[i] = __builtin_amdgcn_s_memrealtime(); } while (0)
#else
#define TS(i)
#endif
    if (PHASE_MASK & 1) phase0(p, lds); GSYNC(); TS(1);
    if (PHASE_MASK & 2) phase1(p, lds); GSYNC(); TS(2);
    if (PHASE_MASK & 4) { phase2a(p); GSYNC(); phase2(p, lds); } GSYNC(); TS(3);
#ifdef RWDEBUG
    {
        bf16_t* dbg = (bf16_t*)(p.ws + WS_A + (size_t)3 * T * D * 2 + 4096);
        float* red = (float*)(p.ws + WS_CTL + 2048);
        if (blockIdx.x == 0) {
            rwkv_chain_seq(p, lds, RWDEBUG_B, RWDEBUG_H, dbg - (size_t)RWDEBUG_B * S * D, 2 * RWDEBUG_C1);
            __syncthreads();
            const bf16_t* mix = (const bf16_t*)(p.ws + WS_B);
            float md = 0.f, mr = 0.f; int bad = 0;
            for (int i = threadIdx.x; i < (RWDEBUG_C1 - RWDEBUG_C0) * 32 * 64; i += NTHREADS) {
                const int t = RWDEBUG_C0 * 32 + i / 64, col = 512 + RWDEBUG_H * 64 + (i % 64);
                const float a = __uint_as_float((unsigned)mix[((size_t)RWDEBUG_B * S + t) * D + col] << 16), r = __uint_as_float((unsigned)dbg[(size_t)t * D + col] << 16);
                if (!(fabsf(a) < 1e30f)) bad++;
                else { md = fmaxf(md, fabsf(a - r)); } mr = fmaxf(mr, fabsf(r));
            }
            LAS float* sh = (LAS float*)lds;
            sh[threadIdx.x] = md; sh[512 + threadIdx.x] = mr; sh[1024 + threadIdx.x] = (float)bad; __syncthreads();
            if (threadIdx.x == 0) { float a = 0.f, r = 0.f, nb = 0.f; for (int i = 0; i < NTHREADS; ++i) { a = fmaxf(a, sh[i]); r = fmaxf(r, sh[512 + i]); nb += sh[1024 + i]; }
                float rel = a / fmaxf(r, 1e-20f); float code = nb > 0.f ? 40.0f : (rel < 0.03f ? 5.0f : (rel < 0.3f ? 10.0f : 20.0f));
                red[0] = code; }
        }
        GSYNC();
        const float code = ((const float*)(p.ws + WS_CTL + 2048))[0];
        for (size_t i = (size_t)blockIdx.x * NTHREADS + threadIdx.x; i < (size_t)T * D; i += (size_t)gridDim.x * NTHREADS) p.out[i] = code;
        return;
    }
#endif
    if (PHASE_MASK & 8) phase3(p, lds); GSYNC(); TS(4);
    if (PHASE_MASK & 16) phase4(p, lds); GSYNC(); TS(5);
    if (PHASE_MASK & 32) phase5(p, lds); GSYNC(); TS(6);
    if (PHASE_MASK & 64) phase6(p, lds); GSYNC(); TS(7);
    if (PHASE_MASK & 128) phase7(p);
#ifdef TPROBE
    GSYNC(); TS(8);
    float* tw = (float*)(p.ws + WS_CTL + 1024);
    if (blockIdx.x == 0 && threadIdx.x == 0) { const float t1 = (float)(tsl[TPROBE + 1] - tsl[TPROBE]) * 0.01f; tw[0] = floorf(log2f(t1) * TPQ + 0.5f) / TPQ; }
    GSYNC();
    const float c1 = tw[0];
    int tq_ = threadIdx.x; asm volatile("" : "+v"(tq_));
    for (size_t i = (size_t)blockIdx.x * NTHREADS + tq_; i < (size_t)T * D; i += (size_t)gridDim.x * NTHREADS) p.out[i] = c1;
#endif
}

extern "C" void kernel_launch(void* const* d_in, const int* in_sizes, int n_in, void* d_out, int out_size, void* d_ws, size_t ws_size, hipStream_t stream) {
    static int grid = 0;
    if (grid == 0) {
        if (n_in != 25 || out_size != T * D || ws_size < WS_END) { fprintf(stderr, "kernel_launch: unexpected sizes n_in %d out %d ws %zu (need %zu)\n", n_in, out_size, ws_size, (size_t)WS_END); grid = -1; return; }
        int dev = 0, cus = 0, per_cu = 0;
        (void)hipGetDevice(&dev); (void)hipDeviceGetAttribute(&cus, hipDeviceAttributeMultiprocessorCount, dev);
        if (hipFuncSetAttribute((const void*)mega, hipFuncAttributeMaxDynamicSharedMemorySize, LDS_BYTES) != hipSuccess) { fprintf(stderr, "kernel_launch: hipFuncSetAttribute failed\n"); grid = -1; return; }
        if (hipOccupancyMaxActiveBlocksPerMultiprocessor(&per_cu, (const void*)mega, NTHREADS, LDS_BYTES) != hipSuccess || per_cu < 1) { fprintf(stderr, "kernel_launch: occupancy query failed (%d)\n", per_cu); (void)hipGetLastError(); per_cu = 1; }
        grid = cus * 1;
    }
    if (grid < 0) return;
    Params p{};
    const float** f = (const float**)&p;
    for (int i = 0; i < 25; ++i) f[i] = (const float*)d_in[i];
    p.out = (float*)d_out; p.ws = (unsigned char*)d_ws;
    if (hipMemsetAsync((char*)d_ws + WS_BAR, 0, XCD_BAR_WORDS * 4, stream) != hipSuccess) { fprintf(stderr, "kernel_launch: memset failed\n"); return; }
    hipLaunchKernelGGL(mega, dim3(grid), dim3(NTHREADS), LDS_BYTES, stream, p);
    hipError_t e = hipPeekAtLastError();
    if (e != hipSuccess) fprintf(stderr, "launch failed: %s (grid %d)\n", hipGetErrorString(e), grid);
}
```

```cpp
#include <hip/hip_runtime.h>
#include <cstdio>
#include <cstdint>

#define LAS __attribute__((address_space(3)))
typedef unsigned short bf16_t;
typedef short bf16x8 __attribute__((ext_vector_type(8)));
typedef short s16x4 __attribute__((ext_vector_type(4)));
typedef float f32x4 __attribute__((ext_vector_type(4)));
typedef float f32x2 __attribute__((ext_vector_type(2)));
typedef float f32x16 __attribute__((ext_vector_type(16)));
typedef unsigned u32x2 __attribute__((ext_vector_type(2)));
typedef unsigned u32x4 __attribute__((ext_vector_type(4)));

constexpr int NB = 16, S = 2048, T = NB * S, D = 1024, NIN = 3328, NH = 8, HD = 64;
constexpr int UQ = 0, UK = 512, UV = 1024, UR = 1536, URK = 2048, URV = 2560, UXW = 3072, UXA = 3136, UXG = 3200;
constexpr int NE = 32, DE = 256;
constexpr float LOG2E = 1.4426950408889634f, LN2 = 0.6931471805599453f;
constexpr float QSCALE = 0.125f * LOG2E;
constexpr int NTHREADS = 512, NWAVES = 8;
constexpr int LDS_BYTES = 161792 + 1024;

constexpr size_t WS_CTL   = 0;
constexpr size_t WS_BAR   = 8192;
constexpr size_t WS_WIN   = 65536;
constexpr size_t WS_WOUT  = WS_WIN  + (size_t)NIN * D * 2;
constexpr size_t WS_WGU   = WS_WOUT + (size_t)D * D * 2;
constexpr size_t WS_WDN   = WS_WGU  + (size_t)NE * 512 * D * 2;
constexpr size_t WS_RSTD1 = WS_WDN  + (size_t)NE * D * DE * 2;
constexpr size_t WS_RSTD2 = WS_RSTD1 + (size_t)T * 4;
constexpr size_t WS_LIST  = WS_RSTD2 + (size_t)T * 4;
constexpr size_t WS_LISTW = WS_LIST + (size_t)NE * T * 4;
constexpr size_t WS_LISTR = WS_LISTW + (size_t)NE * T * 4;
constexpr size_t WS_WR    = WS_LISTR + (size_t)NE * T * 4;
constexpr size_t WS_LT    = WS_WR + (size_t)2 * 48 * D * 2;
constexpr size_t WS_A     = WS_LT + (size_t)512 * 256 * 2;
constexpr size_t WS_B     = WS_A + (size_t)T * NIN * 2;
constexpr size_t WS_END   = WS_B + (size_t)T * D * 2;
constexpr int HID_ROWS = 2 * T + NE * 256;

struct Params {
    const float* x; const float* norm_mix_g; const float* w_in; const float* shift_mu; const float* sb_out_g;
    const float* rw_w0; const float* rw_w2; const float* rw_a0; const float* rw_a2; const float* rw_g2;
    const float* rw_k_k; const float* rw_k_a; const float* rw_r_k; const float* rw_ln_w; const float* rw_ln_b;
    const float* w_out; const float* norm_ffn_g; const float* r_grp_w; const float* r_grp_b; const float* r_exp_w; const float* r_exp_b;
    const float* w_gate; const float* w_up; const float* w_down; const float* final_g;
    float* out; unsigned char* ws;
};

typedef __bf16 bf16x2_t __attribute__((ext_vector_type(2)));
__device__ __forceinline__ unsigned cvt_pk_bf16(float lo, float hi) { const f32x2 v = {lo, hi}; return __builtin_bit_cast(unsigned, __builtin_convertvector(v, bf16x2_t)); }
__device__ __forceinline__ float bf16_lo(unsigned w) { return __uint_as_float(w << 16); }
__device__ __forceinline__ float bf16_hi(unsigned w) { return __uint_as_float(w & 0xffff0000u); }
__device__ __forceinline__ float fexp2(float x) { return __builtin_amdgcn_exp2f(x); }
__device__ __forceinline__ float flog2(float x) { return __builtin_amdgcn_logf(x); }
__device__ __forceinline__ float frcp(float x) { return __builtin_amdgcn_rcpf(x); }
__device__ __forceinline__ float frsq(float x) { return __builtin_amdgcn_rsqf(x); }
template <int CTRL> __device__ __forceinline__ float dppf(float v) { return __builtin_bit_cast(float, __builtin_amdgcn_update_dpp(0, __builtin_bit_cast(int, v), CTRL, 0xF, 0xF, true)); }
__device__ __forceinline__ float rlane(float v, int l) { return __builtin_bit_cast(float, __builtin_amdgcn_readlane(__builtin_bit_cast(int, v), l)); }
__device__ __forceinline__ float sum8(float v) { v += dppf<0xB1>(v); v += dppf<0x4E>(v); v += dppf<0x141>(v); return v; }
__device__ __forceinline__ float sum16(float v) { v = sum8(v); v += dppf<0x140>(v); return v; }
__device__ __forceinline__ float wave_sum(float v) { v = sum16(v); return (rlane(v, 0) + rlane(v, 16)) + (rlane(v, 32) + rlane(v, 48)); }
__device__ __forceinline__ float swap32(float v) { return __shfl_xor(v, 32); }
#define LDS_WAIT() asm volatile("s_waitcnt lgkmcnt(0)" ::: "memory")


#define XB_TMO      128
#define XB_XCNT(j)  (256  + 64 * (j))
#define XB_XSUB(j)  (1280 + 64 * (j))
#define XB_XGEN(j)  (2304 + 64 * (j))
#define XB_TOP      3328
#define XB_TOPGEN   3392
#define XCD_BAR_WORDS 3456
#define XB_SPIN_CAP (1u << 22)
__device__ __forceinline__ unsigned xb_ld(unsigned* p)              { return __hip_atomic_load(p, __ATOMIC_RELAXED, __HIP_MEMORY_SCOPE_AGENT); }
__device__ __forceinline__ unsigned xb_add(unsigned* p, unsigned v) { return __hip_atomic_fetch_add(p, v, __ATOMIC_RELAXED, __HIP_MEMORY_SCOPE_AGENT); }
__device__ __forceinline__ unsigned xb_xcc_id() { return (unsigned)__builtin_amdgcn_s_getreg((3 << 11) | 20) & 0xFu; }
#define XB_SPIN(cond, bar) do { unsigned _sp = 0; while (cond) { __builtin_amdgcn_s_sleep(1); \
    if ((++_sp & 255u) == 0u) { if (xb_ld(&(bar)[XB_TMO])) break; if (_sp > XB_SPIN_CAP) { atomicAdd(&(bar)[XB_TMO], 1u); break; } } } } while (0)
struct XcdBarrier { unsigned* bar; unsigned x; volatile LAS unsigned* st; };
__device__ __forceinline__ XcdBarrier xcd_barrier_post(unsigned* bar, volatile LAS unsigned* st) {
    XcdBarrier b; b.bar = bar; b.x = xb_xcc_id(); b.st = st;
    if (threadIdx.x == 0) (void)xb_add(&bar[XB_XCNT(b.x)], 1u);
    return b;
}
__device__ __forceinline__ void xcd_barrier_complete(unsigned* bar, unsigned x, unsigned& nloc, unsigned& nx) {
    const unsigned G = gridDim.x * gridDim.y * gridDim.z;
    unsigned sum, cnt, mine, sp = 0u;
    for (;;) {
        sum = 0u; cnt = 0u; mine = 0u;
#pragma unroll
        for (unsigned j = 0; j < 16; ++j) { const unsigned c = xb_ld(&bar[XB_XCNT(j)]); sum += c; cnt += (c > 0u) ? 1u : 0u; mine = (j == x) ? c : mine; }
        if (sum == G) break;
        __builtin_amdgcn_s_sleep(1);
        if ((++sp & 255u) == 0u) { if (xb_ld(&bar[XB_TMO])) break; if (sp > XB_SPIN_CAP) { atomicAdd(&bar[XB_TMO], 1u); break; } }
    }
    nloc = mine > 0u ? mine : 1u; nx = cnt > 0u ? cnt : 1u;
}
__device__ __forceinline__ void xcd_barrier(const XcdBarrier& b) {
    asm volatile("s_waitcnt vmcnt(0)" ::: "memory");
    __syncthreads();
    if (threadIdx.x == 0) {
        unsigned* bar = b.bar;
        __builtin_amdgcn_s_waitcnt(0);
        unsigned nloc = b.st[0], nx = b.st[1];
        if (nloc == 0u) { xcd_barrier_complete(bar, b.x, nloc, nx); b.st[0] = nloc; b.st[1] = nx; }
        const unsigned old = xb_add(&bar[XB_XSUB(b.x)], 1u);
        const unsigned gen = old / nloc;
        if (old + 1u == (gen + 1u) * nloc) {
            __builtin_amdgcn_fence(__ATOMIC_RELEASE, "agent");
            asm volatile("s_waitcnt vmcnt(0)" ::: "memory");
            const unsigned og = xb_add(&bar[XB_TOP], 1u);
            const unsigned tg = og / nx;
            if (og + 1u == (tg + 1u) * nx) xb_add(&bar[XB_TOPGEN], 1u);
            else XB_SPIN(xb_ld(&bar[XB_TOPGEN]) == tg, bar);
            __builtin_amdgcn_fence(__ATOMIC_ACQUIRE, "agent");
            xb_add(&bar[XB_XGEN(b.x)], 1u);
            asm volatile("s_waitcnt vmcnt(0)" ::: "memory");
        } else {
            XB_SPIN(xb_ld(&bar[XB_XGEN(b.x)]) == gen, bar);
            __builtin_amdgcn_fence(__ATOMIC_ACQUIRE, "agent");
            asm volatile("s_waitcnt vmcnt(0)" ::: "memory");
        }
    }
    __syncthreads();
}

namespace g8 {
constexpr int BK = 64, HALF = 128, HTB = HALF * BK * 2;
__device__ __forceinline__ int lds_byte(int r, int c) { const int st = (r >> 4) * 2 + (c >> 5), rr = r & 15, cc = c & 31, ob = rr * 64 + cc * 2; return st * 1024 + (ob ^ (((ob >> 9) & 1) << 5)); }
__device__ __forceinline__ void stage_rc(int b, int& R, int& C) { const int st = b / 1024, sb = b % 1024, swz = sb ^ (((sb >> 9) & 1) << 5); R = (st >> 1) * 16 + swz / 64; C = (st & 1) * 32 + (swz % 64) / 2; }

#define G8_SA(b, h) (((b) * 2 + (h)) * HTB)
#define G8_SB(b, h) ((4 + (b) * 2 + (h)) * HTB)
#define G8_STAGE_A(bufoff, h, kt) do { _Pragma("unroll") for (int _i = 0; _i < 2; ++_i) \
    __builtin_amdgcn_global_load_lds((const unsigned*)((Ab + (size_t)(kt) * (BK * 2)) + aoff[h][_i]), (LAS unsigned*)(lds + (bufoff) + ldsw + _i * 8192), 16, 0, 0); } while (0)
#define G8_STAGE_B(bufoff, h, kt) do { _Pragma("unroll") for (int _i = 0; _i < 2; ++_i) \
    __builtin_amdgcn_global_load_lds((const unsigned*)((Bb + (size_t)(h) * bhalf + (size_t)(kt) * (BK * 2)) + boff[_i]), (LAS unsigned*)(lds + (bufoff) + ldsw + _i * 8192), 16, 0, 0); } while (0)
#define G8_LDA(dst, b, h) do { _Pragma("unroll") for (int m = 0; m < 4; ++m) _Pragma("unroll") for (int k = 0; k < 2; ++k) dst[m][k] = *(const LAS bf16x8*)(lds + G8_SA(b, h) + la_off + m * 2048 + k * 1024); } while (0)
#define G8_LDB(dst, b, h) do { _Pragma("unroll") for (int n = 0; n < 2; ++n) _Pragma("unroll") for (int k = 0; k < 2; ++k) dst[n][k] = *(const LAS bf16x8*)(lds + G8_SB(b, h) + lb_off + n * 2048 + k * 1024); } while (0)
#define G8_MMA(ai, bj, At, Bt) do { __builtin_amdgcn_s_setprio(1); _Pragma("unroll") for (int m = 0; m < 4; ++m) _Pragma("unroll") for (int n = 0; n < 2; ++n) _Pragma("unroll") for (int k = 0; k < 2; ++k) \
    acc[ai][bj][m][n] = __builtin_amdgcn_mfma_f32_16x16x32_bf16(Bt[n][k], At[m][k], acc[ai][bj][m][n], 0, 0, 0); __builtin_amdgcn_s_setprio(0); } while (0)
#define G8_WAIT_V(n) asm volatile("s_waitcnt vmcnt(" #n ")" ::: "memory")
#define G8_WAIT_L(n) asm volatile("s_waitcnt lgkmcnt(" #n ")" ::: "memory")
#define G8_BAR __builtin_amdgcn_s_barrier()
#define G8_SCHED __builtin_amdgcn_sched_barrier(0)

struct UnitIO { const char* Ab; const char* Bb; const unsigned* meta0; const unsigned* meta1; unsigned aoff[2][2]; };
#define G8_STAGE_AX(bufoff, h, kt, AB, AOFF) do { _Pragma("unroll") for (int _i = 0; _i < 2; ++_i) \
    __builtin_amdgcn_global_load_lds((const unsigned*)(((AB) + (size_t)(kt) * (BK * 2)) + (AOFF)[h][_i]), (LAS unsigned*)(lds + (bufoff) + ldsw + _i * 8192), 16, 0, 0); } while (0)
#define G8_STAGE_BX(bufoff, h, kt, BB) do { _Pragma("unroll") for (int _i = 0; _i < 2; ++_i) \
    __builtin_amdgcn_global_load_lds((const unsigned*)(((BB) + (size_t)(h) * bhalf + (size_t)(kt) * (BK * 2)) + boff[_i]), (LAS unsigned*)(lds + (bufoff) + ldsw + _i * 8192), 16, 0, 0); } while (0)
template <int N> __device__ __forceinline__ void wait_v() { asm volatile("s_waitcnt vmcnt(%0)" :: "n"(N) : "memory"); }
template <int NEPI, class Epi>
__device__ __forceinline__ void gemm_unit_p(LAS unsigned char* lds, const UnitIO& io, int K, const Epi& E, int parity, bool primed, bool has_next, const UnitIO& nx) {
    int tid = threadIdx.x; asm volatile("" : "+v"(tid));
    const int wid = __builtin_amdgcn_readfirstlane(tid >> 6), lane = tid & 63, wr = wid >> 2, wc = wid & 3, fr = lane & 15, fq = lane >> 4;
    const int nt = K / BK;
    unsigned boff[2];
#pragma unroll
    for (int i = 0; i < 2; ++i) { int R, C; stage_rc(tid * 16 + i * 8192, R, C); const int rho = R & 31, Rb = (R & ~31) + 8 * ((rho & 15) >> 2) + 4 * (rho >> 4) + (rho & 3);
        boff[i] = (unsigned)(Rb * K + C) * 2u; }
    const size_t bhalf = (size_t)HALF * K * 2;
    const unsigned ldsw = (unsigned)wid * 1024u;
    const int la_off = lds_byte(wr * 64 + fr, fq * 8), lb_off = lds_byte(wc * 32 + fr, fq * 8);
    const char* Ab = io.Ab; const char* Bb = io.Bb; const unsigned (&aoff)[2][2] = io.aoff;
    f32x4 acc[2][2][4][2];
#pragma unroll
    for (int a = 0; a < 2; ++a)
#pragma unroll
        for (int b = 0; b < 2; ++b)
#pragma unroll
            for (int m = 0; m < 4; ++m)
#pragma unroll
                for (int n = 0; n < 2; ++n) acc[a][b][m][n] = (f32x4){0.f, 0.f, 0.f, 0.f};
    bf16x8 At[4][2], B0[2][2], B1[2][2];
    LAS unsigned char* mbuf = lds + 131072 + parity * 2048;
    if (!primed) {
        if (io.meta0) { if (wid < 4) __builtin_amdgcn_global_load_lds(io.meta0 + wid * 64 + lane, (LAS unsigned*)(mbuf + wid * 256), 4, 0, 0);
                        else if (io.meta1) __builtin_amdgcn_global_load_lds(io.meta1 + (wid - 4) * 64 + lane, (LAS unsigned*)(mbuf + 1024 + (wid - 4) * 256), 4, 0, 0); }
        G8_STAGE_B(G8_SB(0, 0), 0, 0); G8_STAGE_A(G8_SA(0, 0), 0, 0);
        G8_STAGE_B(G8_SB(0, 1), 1, 0); G8_STAGE_A(G8_SA(0, 1), 1, 0);
        if (wr == 1) G8_BAR;
        G8_WAIT_V(4); G8_BAR;
        G8_STAGE_B(G8_SB(1, 0), 0, 1); G8_STAGE_A(G8_SA(1, 0), 0, 1); G8_STAGE_B(G8_SB(1, 1), 1, 1);
        G8_WAIT_V(6); G8_BAR;
    } else {
        if (wr == 1) G8_BAR;
        wait_v<4 + NEPI>(); G8_BAR;
        G8_STAGE_B(G8_SB(1, 0), 0, 1); G8_STAGE_A(G8_SA(1, 0), 0, 1); G8_STAGE_B(G8_SB(1, 1), 1, 1);
        wait_v<6 + NEPI>(); G8_BAR;
    }
    for (int t = 0; t < nt - 2; t += 2) {
        G8_LDB(B0, 0, 0); G8_SCHED; G8_LDA(At, 0, 0); G8_STAGE_A(G8_SA(1, 1), 1, t + 1);
        G8_WAIT_L(8); G8_BAR; G8_WAIT_L(0); G8_MMA(0, 0, At, B0); G8_BAR; G8_SCHED;
        G8_LDB(B1, 0, 1); G8_STAGE_B(G8_SB(0, 0), 0, t + 2);
        G8_BAR; G8_WAIT_L(0); G8_MMA(0, 1, At, B1); G8_BAR;
        G8_LDA(At, 0, 1); G8_STAGE_A(G8_SA(0, 0), 0, t + 2);
        G8_BAR; G8_WAIT_L(0); G8_MMA(1, 0, At, B0); G8_BAR; G8_SCHED;
        G8_STAGE_B(G8_SB(0, 1), 1, t + 2);
        G8_WAIT_V(6); G8_BAR; G8_MMA(1, 1, At, B1); G8_BAR;
        G8_LDB(B0, 1, 0); G8_SCHED; G8_LDA(At, 1, 0); G8_STAGE_A(G8_SA(0, 1), 1, t + 2);
        G8_WAIT_L(8); G8_BAR; G8_WAIT_L(0); G8_MMA(0, 0, At, B0); G8_BAR; G8_SCHED;
        G8_LDB(B1, 1, 1); G8_STAGE_B(G8_SB(1, 0), 0, t + 3);
        G8_BAR; G8_WAIT_L(0); G8_MMA(0, 1, At, B1); G8_BAR;
        G8_LDA(At, 1, 1); G8_STAGE_A(G8_SA(1, 0), 0, t + 3);
        G8_BAR; G8_WAIT_L(0); G8_MMA(1, 0, At, B0); G8_BAR; G8_SCHED;
        G8_STAGE_B(G8_SB(1, 1), 1, t + 3);
        G8_WAIT_V(6); G8_BAR; G8_MMA(1, 1, At, B1); G8_BAR;
    }
    { G8_LDB(B0, 0, 0); G8_LDA(At, 0, 0); G8_STAGE_A(G8_SA(1, 1), 1, nt - 1);
      G8_BAR; G8_WAIT_L(0); G8_MMA(0, 0, At, B0); G8_BAR;
      G8_LDB(B1, 0, 1); G8_BAR; G8_WAIT_L(0); G8_MMA(0, 1, At, B1); G8_BAR;
      G8_LDA(At, 0, 1); G8_WAIT_V(4); G8_BAR; G8_WAIT_L(0); G8_MMA(1, 0, At, B0); G8_MMA(1, 1, At, B1); G8_BAR; }
    { G8_LDB(B0, 1, 0); G8_LDA(At, 1, 0); G8_WAIT_V(2); G8_BAR; G8_WAIT_L(0); G8_MMA(0, 0, At, B0); G8_BAR;
      G8_LDB(B1, 1, 1); G8_WAIT_V(0); G8_BAR; G8_WAIT_L(0); G8_MMA(0, 1, At, B1); G8_BAR;
      G8_LDA(At, 1, 1); G8_BAR; G8_WAIT_L(0); G8_MMA(1, 0, At, B0); G8_MMA(1, 1, At, B1); G8_BAR; }
    if (wr == 0) G8_BAR;
    asm volatile("" ::: "memory");
    unsigned m0[8], m1[8];
#pragma unroll
    for (int ai = 0; ai < 2; ++ai)
#pragma unroll
        for (int m = 0; m < 4; ++m) { const int rl = ai * 128 + wr * 64 + m * 16 + fr; m0[ai * 4 + m] = ((const LAS unsigned*)mbuf)[rl]; m1[ai * 4 + m] = ((const LAS unsigned*)(mbuf + 1024))[rl]; }
    G8_WAIT_L(0);
    if (has_next) {
        LAS unsigned char* nb = lds + 131072 + (parity ^ 1) * 2048;
        if (nx.meta0) { if (wid < 4) __builtin_amdgcn_global_load_lds(nx.meta0 + wid * 64 + lane, (LAS unsigned*)(nb + wid * 256), 4, 0, 0);
                        else if (nx.meta1) __builtin_amdgcn_global_load_lds(nx.meta1 + (wid - 4) * 64 + lane, (LAS unsigned*)(nb + 1024 + (wid - 4) * 256), 4, 0, 0); }
        G8_STAGE_BX(G8_SB(0, 0), 0, 0, nx.Bb); G8_STAGE_AX(G8_SA(0, 0), 0, 0, nx.Ab, nx.aoff);
        G8_STAGE_BX(G8_SB(0, 1), 1, 0, nx.Bb); G8_STAGE_AX(G8_SA(0, 1), 1, 0, nx.Ab, nx.aoff);
        asm volatile("" ::: "memory");
    }
    E(acc, m0, m1, wr, wc, fr, fq);
    if (!has_next) __syncthreads();
}
__device__ __forceinline__ void aoff_rows(unsigned (&aoff)[2][2], int K) {
    int tid = threadIdx.x; asm volatile("" : "+v"(tid));
#pragma unroll
    for (int i = 0; i < 2; ++i) { int R, C; stage_rc(tid * 16 + i * 8192, R, C);
#pragma unroll
        for (int h = 0; h < 2; ++h) aoff[h][i] = (unsigned)((h * HALF + R) * K + C) * 2u; }
}
__device__ __forceinline__ void tile_order(int L, int nM, int nN, int& pm, int& pn) {
    const int nwg = nM * nN; int wgid = L;
    { const int q = nwg / 8, r = nwg % 8, xcd = wgid % 8, off = wgid / 8; wgid = (xcd < r ? xcd * (q + 1) : r * (q + 1) + (xcd - r) * q) + off; }
    const int nig = 8 * nN, gid = wgid / nig, fm = gid * 8, gsz = (nM - fm) < 8 ? (nM - fm) : 8;
    pm = fm + ((wgid % nig) % gsz); pn = (wgid % nig) / gsz;
}
}

__device__ __forceinline__ void p0_transpose_item(const float* W, int K, int N, int k0, int n0, bf16_t* WTrow0  , const float* kscale, float mul, LAS float* scr, int lane) {
#pragma unroll 8
    for (int i = 0; i < 32; ++i) { const int kk = 2 * i + (lane >> 5); float v = W[(size_t)(k0 + kk) * N + n0 + (lane & 31)]; if (kscale) v *= kscale[k0 + kk]; scr[kk * 33 + (lane & 31)] = v * mul; }
    LDS_WAIT();
    const int c = lane & 7;
#pragma unroll
    for (int j = 0; j < 4; ++j) { const int n = (lane >> 3) + 8 * j; const LAS float* s = scr + (8 * c) * 33 + n;
        u32x4 o; o.x = cvt_pk_bf16(s[0 * 33], s[1 * 33]); o.y = cvt_pk_bf16(s[2 * 33], s[3 * 33]); o.z = cvt_pk_bf16(s[4 * 33], s[5 * 33]); o.w = cvt_pk_bf16(s[6 * 33], s[7 * 33]);
        *(u32x4*)(WTrow0 + (size_t)n * K + k0 + 8 * c) = o; }
    LDS_WAIT();
}

__device__ __forceinline__ void p0_transpose64(const float* W, int K, int N, int k0, int n0, bf16_t* WTrow0  , const float* kscale, LAS float* scr, int lane) {
    const int rq = lane >> 4, c4 = 4 * (lane & 15);
    f32x4 v[16];
#pragma unroll
    for (int i = 0; i < 16; ++i) v[i] = *(const f32x4*)(W + (size_t)(k0 + 4 * i + rq) * N + n0 + c4);
    if (kscale) {
#pragma unroll
        for (int i = 0; i < 16; ++i) v[i] = v[i] * kscale[k0 + 4 * i + rq];
    }
#pragma unroll
    for (int i = 0; i < 16; ++i) { LAS float* d = scr + (4 * i + rq) * 65 + c4; d[0] = v[i][0]; d[1] = v[i][1]; d[2] = v[i][2]; d[3] = v[i][3]; }
    LDS_WAIT();
#pragma unroll
    for (int c = 0; c < 8; ++c) { const LAS float* sp = scr + (8 * c) * 65 + lane;
        u32x4 o; o.x = cvt_pk_bf16(sp[0], sp[65]); o.y = cvt_pk_bf16(sp[2 * 65], sp[3 * 65]); o.z = cvt_pk_bf16(sp[4 * 65], sp[5 * 65]); o.w = cvt_pk_bf16(sp[6 * 65], sp[7 * 65]);
        *(u32x4*)(WTrow0 + (size_t)lane * K + k0 + 8 * c) = o; }
    LDS_WAIT();
}
__device__ __forceinline__ void p0_expert_weights(const Params& p, LAS unsigned char* lds, int gw, int NGW) {
    int tid = threadIdx.x; asm volatile("" : "+v"(tid));
    const int wave = tid >> 6, lane = tid & 63;
    LAS float* scr = (LAS float*)(lds + wave * 16640);
    bf16_t* wgu = (bf16_t*)(p.ws + WS_WGU); bf16_t* wdn = (bf16_t*)(p.ws + WS_WDN);
    constexpr int I_G = NE * 16 * 4, I_D = NE * 4 * 16;
    for (int it = gw; it < 2 * I_G + I_D; it += NGW) {
        int r = it;
        if (r < 2 * I_G) { const int up = r >= I_G; if (up) r -= I_G; const int e = r / 64, q = r % 64, kb = q / 4, nb = q % 4, n0 = nb * 64;
            const int drow = (n0 >> 7) * 256 + up * 128 + (n0 & 127);
            p0_transpose64((up ? p.w_up : p.w_gate) + (size_t)e * D * DE, D, DE, kb * 64, n0, wgu + ((size_t)e * 512 + drow) * D, p.norm_ffn_g, scr, lane); continue; } r -= 2 * I_G;
        { const int e = r / 64, q = r % 64, kb = q / 16, nb = q % 16, n0 = nb * 64;
            p0_transpose64(p.w_down + (size_t)e * DE * D, DE, D, kb * 64, n0, wdn + ((size_t)e * D + n0) * DE, nullptr, scr, lane); }
    }
}
__device__ __forceinline__ void phase0(const Params& p, LAS unsigned char* lds) {
    int tid = threadIdx.x; asm volatile("" : "+v"(tid));
    const int wave = tid >> 6, lane = tid & 63;
    const int gw = blockIdx.x * NWAVES + wave, NGW = gridDim.x * NWAVES;
    LAS float* scr = (LAS float*)(lds + wave * 8704);
    bf16_t* win = (bf16_t*)(p.ws + WS_WIN); bf16_t* wout = (bf16_t*)(p.ws + WS_WOUT);
    constexpr int I_IN = 16 * 104, I_OUT = 16 * 32;
    for (int it = gw; it < I_IN + I_OUT; it += NGW) {
        int r = it;
        if (r < I_IN) { const int kb = r / 104, nb = r % 104, n0 = nb * 32; p0_transpose_item(p.w_in, D, NIN, kb * 64, n0, win + (size_t)n0 * D, p.norm_mix_g, n0 < 512 ? QSCALE : 1.f, scr, lane); continue; } r -= I_IN;
        { const int kb = r / 32, nb = r % 32, n0 = nb * 32; p0_transpose_item(p.w_out, D, D, kb * 64, n0, wout + (size_t)n0 * D, nullptr, 1.f, scr, lane); }
    }
    bf16_t* xb = (bf16_t*)(p.ws + WS_B); float* rstd1 = (float*)(p.ws + WS_RSTD1);
    {
        f32x4 nv[4];
        if (gw < T) {
#pragma unroll
            for (int j = 0; j < 4; ++j) nv[j] = ((const f32x4*)(p.x + (size_t)gw * D) + lane)[64 * j];
        }
        for (int row = gw; row < T; row += NGW) {
            f32x4 v[4]; float s = 0.f;
#pragma unroll
            for (int j = 0; j < 4; ++j) { v[j] = nv[j]; s += (v[j].x * v[j].x + v[j].y * v[j].y) + (v[j].z * v[j].z + v[j].w * v[j].w); }
            if (row + NGW < T) {
#pragma unroll
                for (int j = 0; j < 4; ++j) nv[j] = ((const f32x4*)(p.x + (size_t)(row + NGW) * D) + lane)[64 * j];
            }
            s = wave_sum(s);
            u32x2* o = (u32x2*)(xb + (size_t)row * D) + lane;
#pragma unroll
            for (int j = 0; j < 4; ++j) { u32x2 w; w.x = cvt_pk_bf16(v[j].x, v[j].y); w.y = cvt_pk_bf16(v[j].z, v[j].w); o[64 * j] = w; }
            if (lane == 0) rstd1[row] = 1.0f / sqrtf(s * (1.0f / D) + 1e-6f);
        }
    }
    bf16_t* wr_hi = (bf16_t*)(p.ws + WS_WR); bf16_t* wr_lo = wr_hi + 48 * D;
    for (int i = blockIdx.x * NTHREADS + tid; i < 48 * D; i += gridDim.x * NTHREADS) {
        const int c = i / D, k = i % D; float w = 0.f;
        if (c < 4) w = p.r_grp_w[k * 4 + c]; else if (c < 36) w = p.r_exp_w[k * 32 + (c - 4)];
        w *= p.norm_ffn_g[k];
        const unsigned hi = cvt_pk_bf16(w, 0.f) & 0xffffu; const float rem = w - __uint_as_float(hi << 16);
        wr_hi[i] = (bf16_t)hi; wr_lo[i] = (bf16_t)(cvt_pk_bf16(rem, 0.f) & 0xffffu);
    }
    { bf16_t* w2t = (bf16_t*)(p.ws + WS_LT); bf16_t* a2t = w2t + 512 * 64; bf16_t* g2t = a2t + 512 * 64;
      for (int i = blockIdx.x * NTHREADS + tid; i < 512 * 256; i += gridDim.x * NTHREADS) {
          if (i < 512 * 64) { const int c = i >> 6, m = i & 63; w2t[i] = (bf16_t)(cvt_pk_bf16(p.rw_w2[m * 512 + c], 0.f) & 0xffffu); }
          else if (i < 2 * 512 * 64) { const int q = i - 512 * 64, c = q >> 6, m = q & 63; a2t[q] = (bf16_t)(cvt_pk_bf16(p.rw_a2[m * 512 + c], 0.f) & 0xffffu); }
          else { const int q = i - 2 * 512 * 64, c = q >> 7, m = q & 127; g2t[q] = (bf16_t)(cvt_pk_bf16(p.rw_g2[m * 512 + c], 0.f) & 0xffffu); } } }
    if (blockIdx.x == 0 && tid < 64) ((unsigned*)(p.ws + WS_CTL))[tid] = 0u;
}

struct EpiU {
    bf16_t* u; const float* rstd; int row0, col0;
    __device__ __forceinline__ void operator()(const f32x4 (&acc)[2][2][4][2], const unsigned (&m0)[8], const unsigned (&m1)[8], int wr, int wc, int fr, int fq) const {
#pragma unroll
        for (int ai = 0; ai < 2; ++ai)
#pragma unroll
            for (int m = 0; m < 4; ++m) { const int rl = ai * 128 + wr * 64 + m * 16 + fr, row = row0 + rl; const float rs = __uint_as_float(m0[ai * 4 + m]); bf16_t* rp = u + (size_t)row * NIN + col0 + wc * 32 + 8 * fq;
#pragma unroll
                for (int bj = 0; bj < 2; ++bj) { const f32x4 v0 = acc[ai][bj][m][0] * rs, v1 = acc[ai][bj][m][1] * rs;
                    *(u32x4*)(rp + bj * 128) = (u32x4){cvt_pk_bf16(v0[0], v0[1]), cvt_pk_bf16(v0[2], v0[3]), cvt_pk_bf16(v1[0], v1[1]), cvt_pk_bf16(v1[2], v1[3])}; } }
    }
};
__device__ __forceinline__ void phase1(const Params& p, LAS unsigned char* lds) {
    constexpr int nM = T / 256, nN = NIN / 256;
    g8::UnitIO cur, nxt; g8::aoff_rows(cur.aoff, D);
#pragma unroll
    for (int a = 0; a < 2; ++a)
#pragma unroll
        for (int b = 0; b < 2; ++b) nxt.aoff[a][b] = cur.aoff[a][b];
    cur.meta1 = nullptr; nxt.meta1 = nullptr;
    int pm, pn; int L = blockIdx.x;
    if (L < nM * nN) { g8::tile_order(L, nM, nN, pm, pn); cur.Ab = (const char*)(p.ws + WS_B) + (size_t)pm * 256 * D * 2; cur.Bb = (const char*)(p.ws + WS_WIN) + (size_t)pn * 256 * D * 2; cur.meta0 = (const unsigned*)(p.ws + WS_RSTD1) + pm * 256; }
    for (int i = 0; L < nM * nN; L += gridDim.x, ++i) {
        const bool hn = L + (int)gridDim.x < nM * nN; int pm2 = 0, pn2 = 0;
        if (hn) { g8::tile_order(L + gridDim.x, nM, nN, pm2, pn2); nxt.Ab = (const char*)(p.ws + WS_B) + (size_t)pm2 * 256 * D * 2; nxt.Bb = (const char*)(p.ws + WS_WIN) + (size_t)pn2 * 256 * D * 2; nxt.meta0 = (const unsigned*)(p.ws + WS_RSTD1) + pm2 * 256; }
        EpiU E{(bf16_t*)(p.ws + WS_A), (const float*)(p.ws + WS_RSTD1), pm * 256, pn * 256};
        g8::gemm_unit_p<16>(lds, cur, D, E, i & 1, i > 0, hn, nxt);
        cur.Ab = nxt.Ab; cur.Bb = nxt.Bb; cur.meta0 = nxt.meta0; pm = pm2; pn = pn2;
    }
}


typedef short v4i16_t __attribute__((ext_vector_type(4)));
__device__ __forceinline__ s16x4 lds_tr16(const LAS unsigned char* p) { return __builtin_bit_cast(s16x4, __builtin_amdgcn_ds_read_tr16_b64_v4i16((LAS v4i16_t*)p)); }

__device__ __forceinline__ void attn_tile(const Params& p, LAS unsigned char* vl  , int b, int h, int qt) {
    const int lane = threadIdx.x & 63, r32 = lane & 31, hi = lane >> 5;
    const bf16_t* u = (const bf16_t*)(p.ws + WS_A);
    const size_t row0 = (size_t)b * S; const int q0 = qt * 32;
    bf16x8 qf[4];
    { const bf16_t* qp = u + (row0 + q0 + r32) * NIN + UQ + h * HD + 8 * hi;
#pragma unroll
      for (int s = 0; s < 4; ++s) qf[s] = *(const bf16x8*)(qp + 16 * s); }
    f32x16 o0, o1;
#pragma unroll
    for (int i = 0; i < 16; ++i) { o0[i] = 0.f; o1[i] = 0.f; }
    float carry = 0.f;
    const int kperm = 16 * ((r32 >> 2) & 1) + (r32 & 3) + 4 * (r32 >> 3);
    const int g = lane >> 4, i16 = lane & 15, tq = i16 >> 2, tp = i16 & 3;
    const LAS unsigned char* vrd = vl + (16 * (g >> 1) + tq) * 144 + (16 * (g & 1) + 4 * tp) * 2;
    LAS unsigned char* kl = vl + 4608;
    const int lrow = lane >> 3, lchk = lane & 7;
    const bf16_t* kvp = u + (row0 + lrow) * NIN + h * HD + lchk * 8;
    u32x4 kreg[4], vreg[4];
#pragma unroll
    for (int i = 0; i < 4; ++i) { const bf16_t* a = kvp + (size_t)(qt * 32 + 8 * i) * NIN; kreg[i] = *(const u32x4*)(a + UK); vreg[i] = *(const u32x4*)(a + UV); }
    for (int kb = qt; kb >= 0; --kb) {
        const int key0 = kb * 32;
#pragma unroll
        for (int i = 0; i < 4; ++i) { *(LAS u32x4*)(kl + (8 * i + lrow) * 144 + lchk * 16) = kreg[i]; *(LAS u32x4*)(vl + (8 * i + lrow) * 144 + lchk * 16) = vreg[i]; }
        if (kb > 0) {
#pragma unroll
            for (int i = 0; i < 4; ++i) { const bf16_t* a = kvp + (size_t)(key0 - 32 + 8 * i) * NIN; kreg[i] = *(const u32x4*)(a + UK); vreg[i] = *(const u32x4*)(a + UV); }
        }
        LDS_WAIT();
        f32x16 st;
#pragma unroll
        for (int i = 0; i < 16; ++i) st[i] = 0.f;
        { const LAS unsigned char* kp = kl + kperm * 144 + 16 * hi;
          bf16x8 kf[4];
#pragma unroll
          for (int s = 0; s < 4; ++s) kf[s] = *(const LAS bf16x8*)(kp + 32 * s);
#pragma unroll
          for (int s = 0; s < 4; ++s) st = __builtin_amdgcn_mfma_f32_32x32x16_bf16(kf[s], qf[s], st, 0, 0, 0); }
        const bool diag = (kb == qt);
        float lw[16], suf[16];
        float run = 0.f;
#pragma unroll
        for (int reg = 15; reg >= 0; --reg) {
            const float z = st[reg];
            const float l = flog2(1.0f + fexp2(-fabsf(z)));
            const float sp = fmaxf(z, 0.f) + l;
            const bool valid = !diag || (16 * hi + reg < r32);
            lw[reg] = valid ? (z - sp) : -1.0e30f;
            suf[reg] = run;
            run += valid ? -sp : 0.f;
        }
        const float other = swap32(run);
        const float tot_hi = hi ? run : other, tot_lo = hi ? other : run;
        const float base = carry + (hi ? 0.f : tot_hi);
        carry += tot_lo + tot_hi;
        unsigned pk[8];
#pragma unroll
        for (int j = 0; j < 8; ++j) pk[j] = cvt_pk_bf16(fexp2(lw[2 * j] + suf[2 * j] + base), fexp2(lw[2 * j + 1] + suf[2 * j + 1] + base));
        LDS_WAIT();
#pragma unroll
        for (int s2 = 0; s2 < 2; ++s2) {
            bf16x8 pf = __builtin_bit_cast(bf16x8, (u32x4){pk[4 * s2], pk[4 * s2 + 1], pk[4 * s2 + 2], pk[4 * s2 + 3]});
#pragma unroll
            for (int dh = 0; dh < 2; ++dh) {
                const s16x4 a = lds_tr16(vrd + (8 * s2) * 144 + 64 * dh), c = lds_tr16(vrd + (8 * s2 + 4) * 144 + 64 * dh);
                bf16x8 vf; vf[0] = a[0]; vf[1] = a[1]; vf[2] = a[2]; vf[3] = a[3]; vf[4] = c[0]; vf[5] = c[1]; vf[6] = c[2]; vf[7] = c[3];
                if (dh == 0) o0 = __builtin_amdgcn_mfma_f32_32x32x16_bf16(vf, pf, o0, 0, 0, 0); else o1 = __builtin_amdgcn_mfma_f32_32x32x16_bf16(vf, pf, o1, 0, 0, 0);
            }
        }
        LDS_WAIT();
        if (__builtin_amdgcn_ballot_w64(carry > -150.0f) == 0ull) break;
    }
    float ss = 0.f;
#pragma unroll
    for (int i = 0; i < 16; ++i) ss += o0[i] * o0[i] + o1[i] * o1[i];
    ss += swap32(ss);
    const float rs = 1.0f / sqrtf(ss * (1.0f / HD) + 1e-6f);
    bf16_t* op = (bf16_t*)(p.ws + WS_B) + (row0 + q0 + r32) * D + h * HD + 4 * hi;
    const float* gp = p.sb_out_g + h * HD + 4 * hi;
#pragma unroll
    for (int dh = 0; dh < 2; ++dh)
#pragma unroll
        for (int gq = 0; gq < 4; ++gq) {
            const f32x4 gg = *(const f32x4*)(gp + 32 * dh + 8 * gq);
            const f32x16& o = dh ? o1 : o0;
            u32x2 w; w.x = cvt_pk_bf16(o[4 * gq] * rs * gg[0], o[4 * gq + 1] * rs * gg[1]); w.y = cvt_pk_bf16(o[4 * gq + 2] * rs * gg[2], o[4 * gq + 3] * rs * gg[3]);
            *(u32x2*)(op + 32 * dh + 8 * gq) = w;
        }
}

constexpr size_t ACT_OFF = (size_t)64 << 20;
namespace rk {
constexpr int C = 32, NCH = S / C, NSLOT = 16;
constexpr int SL_PS = 0, SL_QS = 8192, SL_PO = 12288, SL_QO = 16384, SL_VR = 18432, SL_GB = 22528, SL_GW = 26624, SLOT_BYTES = 30720;
constexpr int MSTR = 144;
constexpr int PM_AT = 0, PM_RT = 4608, PM_BT = 9216, PM_KT = 13824, PM_GC = 18432, PROD_LDS = 18688;
constexpr int NPROD = 6;
constexpr int L_CONS = NPROD * PROD_LDS;
constexpr int OSTR = 272;
constexpr int L_OBUF = L_CONS + 4608;
constexpr int L_FLAG = L_OBUF + 32 * OSTR;
constexpr int L_W2 = L_FLAG + 256;
constexpr int L_A2 = L_W2 + 8192;
constexpr int L_G2 = L_A2 + 8192;
constexpr int L_CST = L_G2 + 16384;
constexpr int C_MUL = 0, C_MUR = 256, C_MUK = 320, C_MUV = 384, C_W0 = 448, C_A0 = 512, C_KK = 576, C_KA = 640, C_RK = 704, C_LNB = 768, C_END = 832;
static_assert(L_CST + C_END * 4 <= 161792, "rwkv LDS layout overflows");
}
__device__ __forceinline__ bf16x8 accfrag(const f32x16& a, int s) {
    return __builtin_bit_cast(bf16x8, (u32x4){cvt_pk_bf16(a[8 * s], a[8 * s + 1]), cvt_pk_bf16(a[8 * s + 2], a[8 * s + 3]), cvt_pk_bf16(a[8 * s + 4], a[8 * s + 5]), cvt_pk_bf16(a[8 * s + 6], a[8 * s + 7])});
}
__device__ __forceinline__ bf16x8 trfrag(const LAS unsigned char* mat, int s, int nt, int lane) {
    const int g = lane >> 4, i16 = lane & 15, q = i16 >> 2, pp = i16 & 3, h = g >> 1;
    const LAS unsigned char* a = mat + (16 * s + 4 * h + q) * rk::MSTR + (32 * nt + 16 * (g & 1) + 4 * pp) * 2;
    const s16x4 x = lds_tr16(a), y = lds_tr16(a + 8 * rk::MSTR);
    bf16x8 r; r[0] = x[0]; r[1] = x[1]; r[2] = x[2]; r[3] = x[3]; r[4] = y[0]; r[5] = y[1]; r[6] = y[2]; r[7] = y[3]; return r;
}
__device__ __forceinline__ void f8_from_bf16(const u32x4 w, float (&o)[8]) {
#pragma unroll
    for (int j = 0; j < 4; ++j) { o[2 * j] = bf16_lo(w[j]); o[2 * j + 1] = bf16_hi(w[j]); }
}
__device__ __forceinline__ f32x16 mfma32(bf16x8 a, bf16x8 b, f32x16 c) { return __builtin_amdgcn_mfma_f32_32x32x16_bf16(a, b, c, 0, 0, 0); }
__device__ __forceinline__ f32x16 zero16() { f32x16 z; for (int i = 0; i < 16; ++i) z[i] = 0.f; return z; }
__device__ __forceinline__ void um8(const bf16_t* urow  , bool has_prev, const float* mu, float (&o)[8]) {
    const u32x4 c = *(const u32x4*)urow; u32x4 pv = (u32x4){0u, 0u, 0u, 0u}; if (has_prev) pv = *(const u32x4*)(urow - NIN);
    const f32x4 m0 = *(const f32x4*)mu, m1 = *(const f32x4*)(mu + 4);
    float cv[8], pf[8]; f8_from_bf16(c, cv); f8_from_bf16(pv, pf);
#pragma unroll
    for (int j = 0; j < 4; ++j) { o[j] = cv[j] + (pf[j] - cv[j]) * m0[j]; o[4 + j] = cv[4 + j] + (pf[4 + j] - cv[4 + j]) * m1[j]; }
}
__device__ __forceinline__ void lerp8(const u32x4 c, const u32x4 pv, const LAS float* mu, float (&o)[8]) {
    const f32x4 m0 = *(const LAS f32x4*)mu, m1 = *(const LAS f32x4*)(mu + 4);
    float cv[8], pf[8]; f8_from_bf16(c, cv); f8_from_bf16(pv, pf);
#pragma unroll
    for (int j = 0; j < 4; ++j) { o[j] = cv[j] + (pf[j] - cv[j]) * m0[j]; o[4 + j] = cv[4 + j] + (pf[4 + j] - cv[4 + j]) * m1[j]; }
}
__device__ __forceinline__ void lerp8(const u32x4 c, const u32x4 pv, const float* mu, float (&o)[8]) {
    const f32x4 m0 = *(const f32x4*)mu, m1 = *(const f32x4*)(mu + 4);
    float cv[8], pf[8]; f8_from_bf16(c, cv); f8_from_bf16(pv, pf);
#pragma unroll
    for (int j = 0; j < 4; ++j) { o[j] = cv[j] + (pf[j] - cv[j]) * m0[j]; o[4 + j] = cv[4 + j] + (pf[4 + j] - cv[4 + j]) * m1[j]; }
}
__device__ __forceinline__ float scan32(float x) {
    x += dppf<0x111>(x); x += dppf<0x112>(x); x += dppf<0x114>(x); x += dppf<0x118>(x);
    const float bc = __builtin_bit_cast(float, __builtin_amdgcn_update_dpp(0, __builtin_bit_cast(int, x), 0x142, 0xA, 0xF, false));
    return x + bc;
}

__device__ __forceinline__ void rk_produce(const Params& p, LAS unsigned char* lds, LAS unsigned char* pl  , unsigned char* slot, int b, int hh, int c) {
    using namespace rk;
    int lane = threadIdx.x & 63; asm volatile("" : "+v"(lane));
    const int r32 = lane & 31, h = lane >> 5;
    const bf16_t* u = (const bf16_t*)(p.ws + WS_A);
    const size_t row0 = (size_t)b * S; const int t0 = c * C; const int tt = t0 + r32; const bool hp = tt > 0;
    const bf16_t* urow = u + (row0 + tt) * NIN;
    const LAS float* cst = (const LAS float*)(lds + L_CST);
    const int jrow0 = 32 * ((r32 >> 2) & 1) + (r32 & 3) + 4 * (r32 >> 3);
    f32x16 lw[2], la[2], lg[2];
#pragma unroll
    for (int mt = 0; mt < 2; ++mt) { lw[mt] = zero16(); la[mt] = zero16(); lg[mt] = zero16(); }
    const int cb = hh * HD + 32 * h;
    u32x4 ck[4], pk4[4], cr[4], pr4[4];
    {
        const bf16_t* act = (const bf16_t*)((const unsigned char*)p.out + ACT_OFF) + (row0 + tt) * 256 + 8 * h;
        u32x4 bw[4], ba[4], bg[8];
#pragma unroll
        for (int s = 0; s < 4; ++s) { bw[s] = *(const u32x4*)(act + 16 * s); ba[s] = *(const u32x4*)(act + 64 + 16 * s); }
#pragma unroll
        for (int s = 0; s < 8; ++s) bg[s] = *(const u32x4*)(act + 128 + 16 * s);
        {
            bf16x8 fw[2][4];
#pragma unroll
            for (int mt = 0; mt < 2; ++mt)
#pragma unroll
                for (int s = 0; s < 4; ++s) { const int jl = jrow0 + 16 * mt; fw[mt][s] = *(const LAS bf16x8*)(lds + L_W2 + jl * 128 + (((2 * s + h) ^ (jl & 7)) << 4)); }
#pragma unroll
            for (int s = 0; s < 4; ++s)
#pragma unroll
                for (int mt = 0; mt < 2; ++mt) lw[mt] = mfma32(fw[mt][s], __builtin_bit_cast(bf16x8, bw[s]), lw[mt]);
        }
        {
            bf16x8 fa[2][4];
#pragma unroll
            for (int mt = 0; mt < 2; ++mt)
#pragma unroll
                for (int s = 0; s < 4; ++s) { const int jl = jrow0 + 16 * mt; fa[mt][s] = *(const LAS bf16x8*)(lds + L_A2 + jl * 128 + (((2 * s + h) ^ (jl & 7)) << 4)); }
#pragma unroll
            for (int s = 0; s < 4; ++s)
#pragma unroll
                for (int mt = 0; mt < 2; ++mt) la[mt] = mfma32(fa[mt][s], __builtin_bit_cast(bf16x8, ba[s]), la[mt]);
        }
        asm volatile("" ::: "memory");
#pragma unroll
        for (int half = 0; half < 2; ++half) {
            bf16x8 fg[2][4];
#pragma unroll
            for (int mt = 0; mt < 2; ++mt)
#pragma unroll
                for (int s4 = 0; s4 < 4; ++s4) { const int s = 4 * half + s4, jl = jrow0 + 16 * mt; fg[mt][s4] = *(const LAS bf16x8*)(lds + L_G2 + jl * 256 + (((2 * s + h) ^ (jl & 7)) << 4)); }
#pragma unroll
            for (int s4 = 0; s4 < 4; ++s4)
#pragma unroll
                for (int mt = 0; mt < 2; ++mt) lg[mt] = mfma32(fg[mt][s4], __builtin_bit_cast(bf16x8, bg[4 * half + s4]), lg[mt]);
        }
        asm volatile("" ::: "memory");
#pragma unroll
        for (int q = 0; q < 4; ++q) { const bf16_t* a = urow + URK + cb + 8 * q; const bf16_t* bq = urow + UR + cb + 8 * q;
            ck[q] = *(const u32x4*)a; cr[q] = *(const u32x4*)bq; pk4[q] = (u32x4){0u, 0u, 0u, 0u}; pr4[q] = pk4[q];
            if (hp) { pk4[q] = *(const u32x4*)(a - NIN); pr4[q] = *(const u32x4*)(bq - NIN); } }
    }
#pragma unroll
    for (int mt = 0; mt < 2; ++mt) {
        u32x4 w0, w1; w0.x = cvt_pk_bf16(lg[mt][0], lg[mt][1]); w0.y = cvt_pk_bf16(lg[mt][2], lg[mt][3]); w0.z = cvt_pk_bf16(lg[mt][4], lg[mt][5]); w0.w = cvt_pk_bf16(lg[mt][6], lg[mt][7]);
        w1.x = cvt_pk_bf16(lg[mt][8], lg[mt][9]); w1.y = cvt_pk_bf16(lg[mt][10], lg[mt][11]); w1.z = cvt_pk_bf16(lg[mt][12], lg[mt][13]); w1.w = cvt_pk_bf16(lg[mt][14], lg[mt][15]);
        *(u32x4*)(slot + SL_GW + (2 * mt) * 1024 + lane * 16) = w0; *(u32x4*)(slot + SL_GW + (2 * mt + 1) * 1024 + lane * 16) = w1;
    }
    asm volatile("" ::: "memory");
    float ssq = 0.f;
#pragma unroll
    for (int q = 0; q < 4; ++q) {
        float t8[8]; lerp8(ck[q], pk4[q], cst + C_MUK + 32 * h + 8 * q, t8);
        const f32x4 c0 = *(const LAS f32x4*)(cst + C_KK + 32 * h + 8 * q), c1 = *(const LAS f32x4*)(cst + C_KK + 32 * h + 8 * q + 4);
#pragma unroll
        for (int j = 0; j < 4; ++j) { const float x0 = t8[j] * c0[j], x1 = t8[4 + j] * c1[j]; ssq += x0 * x0 + x1 * x1; }
    }
    ssq += swap32(ssq);
    const float kinv = frsq(fmaxf(ssq, 1e-24f));
    float bonus = 0.f;
    LAS unsigned char* mAT = pl + PM_AT; LAS unsigned char* mRT = pl + PM_RT; LAS unsigned char* mBT = pl + PM_BT; LAS unsigned char* mKT = pl + PM_KT;
    LAS float* gc = (LAS float*)(pl + PM_GC);
#pragma unroll
    for (int mt = 0; mt < 2; ++mt) {
#pragma unroll
        for (int q8 = 0; q8 < 2; ++q8) {
            const int jl0 = 32 * h + 16 * mt + 8 * q8, q = 2 * mt + q8;
            float k8[8], r8[8];
            lerp8(ck[q], pk4[q], cst + C_MUK + jl0, k8);
            lerp8(cr[q], pr4[q], cst + C_MUR + jl0, r8);
            float cw0[8], ca0[8], ckk[8], cka[8], crk[8];
#pragma unroll
            for (int e = 0; e < 2; ++e) { const f32x4 a = *(const LAS f32x4*)(cst + C_W0 + jl0 + 4 * e), bq = *(const LAS f32x4*)(cst + C_A0 + jl0 + 4 * e), cc = *(const LAS f32x4*)(cst + C_KK + jl0 + 4 * e), dd = *(const LAS f32x4*)(cst + C_KA + jl0 + 4 * e), ee = *(const LAS f32x4*)(cst + C_RK + jl0 + 4 * e);
#pragma unroll
                for (int j = 0; j < 4; ++j) { cw0[4 * e + j] = a[j]; ca0[4 * e + j] = bq[j]; ckk[4 * e + j] = cc[j]; cka[4 * e + j] = dd[j]; crk[4 * e + j] = ee[j]; } }
            float oa[8], orr[8], ob[8], ok[8];
#pragma unroll
            for (int e = 0; e < 8; ++e) {
                const int reg = 8 * q8 + e;
                const float xw = cw0[e] + lw[mt][reg];
                const float spn = fmaxf(-xw, 0.f) + LN2 * flog2(1.0f + fexp2(-fabsf(xw) * LOG2E));
                const float ld = -fexp2((-spn - 0.5f) * LOG2E);
                const float al = frcp(1.0f + fexp2(-(ca0[e] + la[mt][reg]) * LOG2E));
                const float kk = k8[e] * ckk[e] * kinv;
                const float kmod = k8[e] * (1.0f + (al - 1.0f) * cka[e]);
                const float bb = kk * al;
                bonus += r8[e] * kmod * crk[e];
                const float G = scan32(ld);
                const float eG = fexp2(G * LOG2E), eGm = fexp2((G - ld) * LOG2E), eiG = fexp2(-G * LOG2E);
                oa[e] = -kk * eGm; orr[e] = r8[e] * eG; ob[e] = bb * eiG; ok[e] = kmod * eiG;
                if (r32 == 31) gc[32 * h + 16 * mt + reg] = eG;
            }
            const int off = r32 * MSTR + (32 * h + 16 * mt + 8 * q8) * 2;
            *(LAS u32x4*)(mAT + off) = (u32x4){cvt_pk_bf16(oa[0], oa[1]), cvt_pk_bf16(oa[2], oa[3]), cvt_pk_bf16(oa[4], oa[5]), cvt_pk_bf16(oa[6], oa[7])};
            *(LAS u32x4*)(mRT + off) = (u32x4){cvt_pk_bf16(orr[0], orr[1]), cvt_pk_bf16(orr[2], orr[3]), cvt_pk_bf16(orr[4], orr[5]), cvt_pk_bf16(orr[6], orr[7])};
            *(LAS u32x4*)(mBT + off) = (u32x4){cvt_pk_bf16(ob[0], ob[1]), cvt_pk_bf16(ob[2], ob[3]), cvt_pk_bf16(ob[4], ob[5]), cvt_pk_bf16(ob[6], ob[7])};
            *(LAS u32x4*)(mKT + off) = (u32x4){cvt_pk_bf16(ok[0], ok[1]), cvt_pk_bf16(ok[2], ok[3]), cvt_pk_bf16(ok[4], ok[5]), cvt_pk_bf16(ok[6], ok[7])};
            asm volatile("" ::: "memory");
        }
    }
    bonus += swap32(bonus);
    u32x4 cv4[4], pv4[4];
#pragma unroll
    for (int q = 0; q < 4; ++q) { const bf16_t* cq = urow + URV + cb + 8 * q; cv4[q] = *(const u32x4*)cq; pv4[q] = (u32x4){0u, 0u, 0u, 0u}; if (hp) pv4[q] = *(const u32x4*)(cq - NIN); }
#pragma unroll
    for (int q = 0; q < 4; ++q) {
        float v8[8]; lerp8(cv4[q], pv4[q], cst + C_MUV + 32 * h + 8 * q, v8);
        *(u32x4*)(slot + SL_VR + q * 1024 + lane * 16) = (u32x4){cvt_pk_bf16(v8[0], v8[1]), cvt_pk_bf16(v8[2], v8[3]), cvt_pk_bf16(v8[4], v8[5]), cvt_pk_bf16(v8[6], v8[7])};
        const f32x4 b0 = *(const LAS f32x4*)(cst + C_LNB + 32 * h + 8 * q), b1 = *(const LAS f32x4*)(cst + C_LNB + 32 * h + 8 * q + 4);
        float gb[8];
#pragma unroll
        for (int e = 0; e < 8; ++e) gb[e] = (e < 4 ? b0[e] : b1[e - 4]) + bonus * v8[e];
        *(u32x4*)(slot + SL_GB + q * 1024 + lane * 16) = (u32x4){cvt_pk_bf16(gb[0], gb[1]), cvt_pk_bf16(gb[2], gb[3]), cvt_pk_bf16(gb[4], gb[5]), cvt_pk_bf16(gb[6], gb[7])};
    }
    LDS_WAIT();
    f32x16 nab = zero16(), nabT = zero16(), nakT = zero16(), mbr = zero16(), mkr = zero16();
#pragma unroll
    for (int s = 0; s < 4; ++s) {
        const int off = r32 * MSTR + (16 * s + 8 * h) * 2;
        const bf16x8 fa = *(const LAS bf16x8*)(mAT + off), fr = *(const LAS bf16x8*)(mRT + off), fb = *(const LAS bf16x8*)(mBT + off), fk = *(const LAS bf16x8*)(mKT + off);
        nab = mfma32(fb, fa, nab); nabT = mfma32(fa, fb, nabT); nakT = mfma32(fa, fk, nakT); mbr = mfma32(fb, fr, mbr); mkr = mfma32(fk, fr, mkr);
    }
#pragma unroll
    for (int reg = 0; reg < 16; ++reg) {
        const int row = (reg & 3) + 8 * (reg >> 2) + 4 * h;
        nab[reg] = row < r32 ? nab[reg] : 0.f;
        nabT[reg] = r32 < row ? nabT[reg] : 0.f;
        nakT[reg] = r32 < row ? nakT[reg] : 0.f;
        mbr[reg] = row <= r32 ? mbr[reg] : 0.f;
        mkr[reg] = row <= r32 ? mkr[reg] : 0.f;
    }
    f32x16 Y = nab;
#pragma unroll
    for (int reg = 0; reg < 16; ++reg) { const int row = (reg & 3) + 8 * (reg >> 2) + 4 * h; if (row == r32) Y[reg] += 1.0f; }
    {
        f32x16 M = nab, MT = nabT;
#pragma unroll
        for (int lvl = 0; lvl < 4; ++lvl) {
            const bf16x8 m0 = accfrag(M, 0), m1 = accfrag(M, 1), t0f = accfrag(MT, 0), t1f = accfrag(MT, 1);
            f32x16 M2T = mfma32(m0, t0f, zero16()); M2T = mfma32(m1, t1f, M2T);
            f32x16 M2 = zero16();
            if (lvl < 3) { M2 = mfma32(t0f, m0, M2); M2 = mfma32(t1f, m1, M2); }
            const bf16x8 y0 = accfrag(Y, 0), y1 = accfrag(Y, 1);
            Y = mfma32(accfrag(M2T, 0), y0, Y); Y = mfma32(accfrag(M2T, 1), y1, Y);
            M = M2; MT = M2T;
        }
    }
    int lane5 = lane; asm volatile("" : "+v"(lane5));
    const int r5 = lane5 & 31, h5 = lane5 >> 5;
    const bf16x8 ty0 = accfrag(Y, 0), ty1 = accfrag(Y, 1);
    f32x16 paT[2];
#pragma unroll
    for (int nt = 0; nt < 2; ++nt) { paT[nt] = mfma32(ty0, trfrag(mAT, 0, nt, lane5), zero16()); paT[nt] = mfma32(ty1, trfrag(mAT, 1, nt, lane5), paT[nt]); }
    f32x16 qakT = mfma32(ty0, accfrag(nakT, 0), zero16()); qakT = mfma32(ty1, accfrag(nakT, 1), qakT);
    const bf16x8 mb0 = accfrag(mbr, 0), mb1 = accfrag(mbr, 1);
#pragma unroll
    for (int mt = 0; mt < 2; ++mt) {
        f32x16 po;
#pragma unroll
        for (int g = 0; g < 4; ++g) { const u32x2 w = *(const LAS u32x2*)(mRT + r5 * MSTR + (32 * mt + 8 * g + 4 * h5) * 2);
            po[4 * g] = bf16_lo(w.x); po[4 * g + 1] = bf16_hi(w.x); po[4 * g + 2] = bf16_lo(w.y); po[4 * g + 3] = bf16_hi(w.y); }
        po = mfma32(accfrag(paT[mt], 0), mb0, po); po = mfma32(accfrag(paT[mt], 1), mb1, po);
#pragma unroll
        for (int sp = 0; sp < 2; ++sp)
            *(u32x4*)(slot + SL_PO + (2 * mt + sp) * 1024 + lane5 * 16) = (u32x4){cvt_pk_bf16(po[8 * sp], po[8 * sp + 1]), cvt_pk_bf16(po[8 * sp + 2], po[8 * sp + 3]), cvt_pk_bf16(po[8 * sp + 4], po[8 * sp + 5]), cvt_pk_bf16(po[8 * sp + 6], po[8 * sp + 7])};
    }
    {
        f32x16 qo = mfma32(accfrag(qakT, 0), mb0, mkr); qo = mfma32(accfrag(qakT, 1), mb1, qo);
#pragma unroll
        for (int sp = 0; sp < 2; ++sp) *(u32x4*)(slot + SL_QO + sp * 1024 + lane5 * 16) = (u32x4){cvt_pk_bf16(qo[8 * sp], qo[8 * sp + 1]), cvt_pk_bf16(qo[8 * sp + 2], qo[8 * sp + 3]), cvt_pk_bf16(qo[8 * sp + 4], qo[8 * sp + 5]), cvt_pk_bf16(qo[8 * sp + 6], qo[8 * sp + 7])};
    }
#pragma unroll
    for (int nt = 0; nt < 2; ++nt) {
        const bf16x8 bt0 = trfrag(mBT, 0, nt, lane5), bt1 = trfrag(mBT, 1, nt, lane5);
        const float gam = gc[32 * nt + r5];
#pragma unroll
        for (int mt = 0; mt < 2; ++mt) {
            f32x16 ps = zero16();
            if (mt == nt) {
#pragma unroll
                for (int reg = 0; reg < 16; ++reg) { const int row = (reg & 3) + 8 * (reg >> 2) + 4 * h5; ps[reg] = (row == r5) ? 1.0f : 0.f; }
            }
            ps = mfma32(accfrag(paT[mt], 0), bt0, ps); ps = mfma32(accfrag(paT[mt], 1), bt1, ps);
#pragma unroll
            for (int sp = 0; sp < 2; ++sp)
                *(u32x4*)(slot + SL_PS + ((nt * 2 + mt) * 2 + sp) * 1024 + lane5 * 16) = (u32x4){cvt_pk_bf16(ps[8 * sp] * gam, ps[8 * sp + 1] * gam), cvt_pk_bf16(ps[8 * sp + 2] * gam, ps[8 * sp + 3] * gam), cvt_pk_bf16(ps[8 * sp + 4] * gam, ps[8 * sp + 5] * gam), cvt_pk_bf16(ps[8 * sp + 6] * gam, ps[8 * sp + 7] * gam)};
        }
        f32x16 qs;
        { const bf16x8 k0 = trfrag(mKT, 0, nt, lane5), k1 = trfrag(mKT, 1, nt, lane5);
          const u32x4 w0 = __builtin_bit_cast(u32x4, k0), w1 = __builtin_bit_cast(u32x4, k1);
#pragma unroll
          for (int j = 0; j < 4; ++j) { qs[2 * j] = bf16_lo(w0[j]); qs[2 * j + 1] = bf16_hi(w0[j]); qs[8 + 2 * j] = bf16_lo(w1[j]); qs[8 + 2 * j + 1] = bf16_hi(w1[j]); } }
        qs = mfma32(accfrag(qakT, 0), bt0, qs); qs = mfma32(accfrag(qakT, 1), bt1, qs);
#pragma unroll
        for (int sp = 0; sp < 2; ++sp) *(u32x4*)(slot + SL_QS + (nt * 2 + sp) * 1024 + lane5 * 16) = (u32x4){cvt_pk_bf16(qs[8 * sp] * gam, qs[8 * sp + 1] * gam), cvt_pk_bf16(qs[8 * sp + 2] * gam, qs[8 * sp + 3] * gam), cvt_pk_bf16(qs[8 * sp + 4] * gam, qs[8 * sp + 5] * gam), cvt_pk_bf16(qs[8 * sp + 6] * gam, qs[8 * sp + 7] * gam)};
    }
    LDS_WAIT();
}

__device__ __forceinline__ u32x4 ntload16(const void* ptr) { return __builtin_nontemporal_load((const u32x4*)ptr); }
struct RkOps { u32x4 vr[4]; bf16x8 fps[2][2][2], fqs[2][2], fpo[2][2], fqo[2]; };
__device__ __forceinline__ void rk_load_ops_a(RkOps& o, const unsigned char* slot, int lane) {
    using namespace rk;
    const int r32 = lane & 31, h = lane >> 5;
#pragma unroll
    for (int k = 0; k < 4; ++k) o.vr[k] = ntload16(slot + SL_VR + k * 1024 + lane * 16);
#pragma unroll
    for (int jt = 0; jt < 2; ++jt)
#pragma unroll
        for (int s = 0; s < 2; ++s) o.fpo[jt][s] = __builtin_bit_cast(bf16x8, ntload16(slot + SL_PO + (2 * jt + s) * 1024 + lane * 16));
#pragma unroll
    for (int s = 0; s < 2; ++s) o.fqo[s] = __builtin_bit_cast(bf16x8, ntload16(slot + SL_QO + s * 1024 + lane * 16));
}
__device__ __forceinline__ void rk_load_ops_b(RkOps& o, const unsigned char* slot, int lane) {
    using namespace rk;
    const int r32 = lane & 31, h = lane >> 5;
#pragma unroll
    for (int mt = 0; mt < 2; ++mt) {
#pragma unroll
        for (int jt = 0; jt < 2; ++jt)
#pragma unroll
            for (int s = 0; s < 2; ++s) o.fps[mt][jt][s] = __builtin_bit_cast(bf16x8, ntload16(slot + SL_PS + ((mt * 2 + jt) * 2 + s) * 1024 + lane * 16));
#pragma unroll
        for (int s = 0; s < 2; ++s) o.fqs[mt][s] = __builtin_bit_cast(bf16x8, ntload16(slot + SL_QS + (mt * 2 + s) * 1024 + lane * 16));
    }
}
#define RK_SPIN(cond) do { unsigned _sp = 0; while (cond) { __builtin_amdgcn_s_sleep(1); if (++_sp > (1u << 24)) { err[0] = 1u; break; } } asm volatile("" ::: "memory"); } while (0)

__device__ __forceinline__ void rwkv_chain(const Params& p, LAS unsigned char* lds, int b, int hh) {
    using namespace rk;
    int tid = threadIdx.x; asm volatile("" : "+v"(tid));
    volatile LAS unsigned* ready = (volatile LAS unsigned*)(lds + L_FLAG); volatile LAS unsigned* freed = ready + NSLOT; volatile LAS unsigned* ofull = freed + NSLOT; volatile LAS unsigned* ofree = ofull + 2; volatile LAS unsigned* err = ofree + 2;
    if (tid < 2 * NSLOT + 5) ready[tid] = 0u;
    {
        const bf16_t* w2t = (const bf16_t*)(p.ws + WS_LT); const bf16_t* a2t = w2t + 512 * 64; const bf16_t* g2t = a2t + 512 * 64;
        for (int i = tid; i < 64 * 8; i += NTHREADS) { const int j = i >> 3, ch = i & 7, d = j * 128 + ((ch ^ (j & 7)) << 4);
            *(LAS u32x4*)(lds + L_W2 + d) = *(const u32x4*)(w2t + (hh * HD + j) * 64 + 8 * ch); *(LAS u32x4*)(lds + L_A2 + d) = *(const u32x4*)(a2t + (hh * HD + j) * 64 + 8 * ch); }
        for (int i = tid; i < 64 * 16; i += NTHREADS) { const int j = i >> 4, ch = i & 15; *(LAS u32x4*)(lds + L_G2 + j * 256 + ((ch ^ (j & 7)) << 4)) = *(const u32x4*)(g2t + (hh * HD + j) * 128 + 8 * ch); }
        LAS float* cst = (LAS float*)(lds + L_CST);
        for (int i = tid; i < C_END; i += NTHREADS) { float v;
            if (i < 256) v = p.shift_mu[(UXW - UR) + i];
            else if (i < 320) v = p.shift_mu[hh * HD + (i - 256)];
            else if (i < 384) v = p.shift_mu[(URK - UR) + hh * HD + (i - 320)];
            else if (i < 448) v = p.shift_mu[(URV - UR) + hh * HD + (i - 384)];
            else if (i < 512) v = p.rw_w0[hh * HD + (i - 448)];
            else if (i < 576) v = p.rw_a0[hh * HD + (i - 512)];
            else if (i < 640) v = p.rw_k_k[hh * HD + (i - 576)];
            else if (i < 704) v = p.rw_k_a[hh * HD + (i - 640)];
            else if (i < 768) v = p.rw_r_k[hh * HD + (i - 704)];
            else v = p.rw_ln_b[hh * HD + (i - 768)];
            cst[i] = v; }
    }
    __syncthreads();
    asm volatile("" : "+v"(tid));
    const int wave = __builtin_amdgcn_readfirstlane(tid >> 6);
    unsigned char* ring = (unsigned char*)p.out + (size_t)(b * NH + hh) * NSLOT * SLOT_BYTES;
    if (wave == 0) {
        int lane = tid & 63; asm volatile("" : "+v"(lane));
        const int r32 = lane & 31, h = lane >> 5;
        LAS unsigned char* vs = lds + L_CONS;
        f32x16 st[2][2];
#pragma unroll
        for (int a = 0; a < 2; ++a)
#pragma unroll
            for (int d = 0; d < 2; ++d) st[a][d] = zero16();
        RkOps ops;
        RK_SPIN(ready[0] != 1u);
        rk_load_ops_a(ops, ring, lane); rk_load_ops_b(ops, ring, lane);
        for (int c = 0; c < NCH; ++c) {
            bf16x8 sf[2][2][2];
#pragma unroll
            for (int jt = 0; jt < 2; ++jt)
#pragma unroll
                for (int it = 0; it < 2; ++it) { sf[jt][it][0] = accfrag(st[jt][it], 0); sf[jt][it][1] = accfrag(st[jt][it], 1); }
            { LAS unsigned char* d = vs + r32 * MSTR + h * 64;
              *(LAS u32x4*)d = ops.vr[0]; *(LAS u32x4*)(d + 16) = ops.vr[1]; *(LAS u32x4*)(d + 32) = ops.vr[2]; *(LAS u32x4*)(d + 48) = ops.vr[3]; }
            LDS_WAIT();
            bf16x8 vf[2][2];
            { const int g = lane >> 4, i16 = lane & 15, q = i16 >> 2, pp = i16 & 3;
#pragma unroll
              for (int it = 0; it < 2; ++it)
#pragma unroll
                  for (int s = 0; s < 2; ++s) { const LAS unsigned char* a = vs + (16 * s + 4 * h + q) * MSTR + (32 * it + 16 * (g & 1) + 4 * pp) * 2;
                      const s16x4 x = lds_tr16(a), y = lds_tr16(a + 8 * MSTR);
                      bf16x8 r; r[0] = x[0]; r[1] = x[1]; r[2] = x[2]; r[3] = x[3]; r[4] = y[0]; r[5] = y[1]; r[6] = y[2]; r[7] = y[3]; vf[it][s] = r; } }
            f32x16 o[2];
#pragma unroll
            for (int it = 0; it < 2; ++it) {
                o[it] = zero16();
#pragma unroll
                for (int jt = 0; jt < 2; ++jt)
#pragma unroll
                    for (int s = 0; s < 2; ++s) o[it] = mfma32(sf[jt][it][s], ops.fpo[jt][s], o[it]);
#pragma unroll
                for (int s = 0; s < 2; ++s) o[it] = mfma32(vf[it][s], ops.fqo[s], o[it]);
            }
            const unsigned char* nslot = ring + (size_t)((c + 1) % NSLOT) * SLOT_BYTES;
            if (c + 1 < NCH) { RK_SPIN(ready[(c + 1) % NSLOT] != (unsigned)(c + 2)); rk_load_ops_a(ops, nslot, lane); }
#pragma unroll
            for (int mt = 0; mt < 2; ++mt)
#pragma unroll
                for (int it = 0; it < 2; ++it) {
                    f32x16 a = zero16();
#pragma unroll
                    for (int jt = 0; jt < 2; ++jt)
#pragma unroll
                        for (int s = 0; s < 2; ++s) a = mfma32(ops.fps[mt][jt][s], sf[jt][it][s], a);
#pragma unroll
                    for (int s = 0; s < 2; ++s) a = mfma32(ops.fqs[mt][s], vf[it][s], a);
                    st[mt][it] = a;
                }
            if (c + 1 < NCH) rk_load_ops_b(ops, nslot, lane);
            if (c >= 1) RK_SPIN(ofree[0] != (unsigned)c);
            { LAS unsigned char* ob = lds + L_OBUF + r32 * OSTR;
#pragma unroll
              for (int it = 0; it < 2; ++it)
#pragma unroll
                  for (int g = 0; g < 4; ++g) *(LAS f32x4*)(ob + (32 * it + 8 * g + 4 * h) * 4) = (f32x4){o[it][4 * g], o[it][4 * g + 1], o[it][4 * g + 2], o[it][4 * g + 3]}; }
            LDS_WAIT();
            if (lane == 0) ofull[0] = (unsigned)(c + 1);
        }
    } else if (wave == 1) {
        int lane = tid & 63; asm volatile("" : "+v"(lane));
        const int r32 = lane & 31, h = lane >> 5;
        u32x4 gw[4], gb[4];
        RK_SPIN(ready[0] != 1u);
#pragma unroll
        for (int k = 0; k < 4; ++k) { gw[k] = ntload16(ring + SL_GW + k * 1024 + lane * 16); gb[k] = ntload16(ring + SL_GB + k * 1024 + lane * 16); }
        for (int c = 0; c < NCH; ++c) {
            const int sl = c % NSLOT;
            RK_SPIN(ofull[0] != (unsigned)(c + 1));
            float ov[32];
            { const LAS unsigned char* ob = lds + L_OBUF + r32 * OSTR + 128 * h;
#pragma unroll
              for (int k = 0; k < 8; ++k) { const f32x4 x = *(const LAS f32x4*)(ob + 16 * k); ov[4 * k] = x[0]; ov[4 * k + 1] = x[1]; ov[4 * k + 2] = x[2]; ov[4 * k + 3] = x[3]; } }
            LDS_WAIT();
            if (lane == 0) ofree[0] = (unsigned)(c + 1);
            float sm = 0.f;
#pragma unroll
            for (int k = 0; k < 32; ++k) sm += ov[k];
            sm += swap32(sm);
            const float mean = sm * (1.0f / 64.0f);
            float sv = 0.f;
#pragma unroll
            for (int k = 0; k < 32; ++k) { const float d = ov[k] - mean; sv += d * d; }
            sv += swap32(sv);
            const float rstd = 1.0f / sqrtf(sv * (1.0f / 64.0f) + 64e-5f);
            bf16_t* mrow = (bf16_t*)(p.ws + WS_B) + ((size_t)b * S + c * C + r32) * D + 512 + hh * HD + 32 * h;
#pragma unroll
            for (int k = 0; k < 4; ++k) {
                float w8[8], b8[8], r[8]; f8_from_bf16(gw[k], w8); f8_from_bf16(gb[k], b8);
                const f32x4 l0 = *(const f32x4*)(p.rw_ln_w + hh * HD + 32 * h + 8 * k), l1 = *(const f32x4*)(p.rw_ln_w + hh * HD + 32 * h + 8 * k + 4);
#pragma unroll
                for (int e = 0; e < 8; ++e) r[e] = ((ov[8 * k + e] - mean) * rstd * (e < 4 ? l0[e] : l1[e - 4]) + b8[e]) * w8[e];
                *(u32x4*)(mrow + 8 * k) = (u32x4){cvt_pk_bf16(r[0], r[1]), cvt_pk_bf16(r[2], r[3]), cvt_pk_bf16(r[4], r[5]), cvt_pk_bf16(r[6], r[7])};
            }
            if (lane == 0) freed[sl] = (unsigned)(c + 1);
            if (c + 1 < NCH) { const int sn = (c + 1) % NSLOT; const unsigned char* sp_ = ring + (size_t)sn * SLOT_BYTES; RK_SPIN(ready[sn] != (unsigned)(c + 2));
#pragma unroll
                for (int k = 0; k < 4; ++k) { gw[k] = ntload16(sp_ + SL_GW + k * 1024 + lane * 16); gb[k] = ntload16(sp_ + SL_GB + k * 1024 + lane * 16); } }
        }
    } else {
        int lane = tid & 63;
        if (wave - 2 < NPROD) for (int c = wave - 2; c < NCH; c += NPROD) {
            const int sl = c % NSLOT;
            if (c >= NSLOT) RK_SPIN(freed[sl] != (unsigned)(c - NSLOT + 1));
            rk_produce(p, lds, lds + (wave - 2) * PROD_LDS, ring + (size_t)sl * SLOT_BYTES, b, hh, c);
            asm volatile("s_waitcnt vmcnt(0)" ::: "memory");
            if (lane == 0) ready[sl] = (unsigned)(c + 1);
        }
    }
    __syncthreads();
}


__device__ __forceinline__ void phase2a(const Params& p) {
    int tid = threadIdx.x; asm volatile("" : "+v"(tid));
    const int wave = tid >> 6, lane = tid & 63;
    const bf16_t* u = (const bf16_t*)(p.ws + WS_A);
    bf16_t* act = (bf16_t*)((unsigned char*)p.out + ACT_OFF);
    const f32x4 mu = *(const f32x4*)(p.shift_mu + (UXW - UR) + 4 * lane);
    const int stride = gridDim.x * NWAVES;
    int row = blockIdx.x * NWAVES + wave;
    u32x2 c = (u32x2){0u, 0u}, pv = (u32x2){0u, 0u};
    if (row < T) { const bf16_t* a = u + (size_t)row * NIN + UXW + 4 * lane; c = *(const u32x2*)a; if ((row & (S - 1)) != 0) pv = *(const u32x2*)(a - NIN); }
    for (; row < T; row += stride) {
        const float cv[4] = {bf16_lo(c.x), bf16_hi(c.x), bf16_lo(c.y), bf16_hi(c.y)}, pf[4] = {bf16_lo(pv.x), bf16_hi(pv.x), bf16_lo(pv.y), bf16_hi(pv.y)};
        const int nrow = row + stride;
        if (nrow < T) { const bf16_t* a = u + (size_t)nrow * NIN + UXW + 4 * lane; c = *(const u32x2*)a; pv = (u32x2){0u, 0u}; if ((nrow & (S - 1)) != 0) pv = *(const u32x2*)(a - NIN); }
        float x[4];
#pragma unroll
        for (int j = 0; j < 4; ++j) { x[j] = cv[j] + (pf[j] - cv[j]) * mu[j];
            if (lane < 16) x[j] = 1.0f - 2.0f * frcp(1.0f + fexp2(x[j] * (2.0f * LOG2E)));
            else if (lane >= 32) x[j] = frcp(1.0f + fexp2(-x[j] * LOG2E)); }
        *(u32x2*)(act + (size_t)row * 256 + 4 * lane) = (u32x2){cvt_pk_bf16(x[0], x[1]), cvt_pk_bf16(x[2], x[3])};
    }
}

__device__ __forceinline__ void phase2(const Params& p, LAS unsigned char* lds) {
    const int nchain = NB * NH, G = gridDim.x, wave = threadIdx.x >> 6;
    const int nscan = G >= 2 * nchain ? nchain : (G > 1 ? G / 2 : 0);
    if ((int)blockIdx.x < nscan || nscan == 0) {
        const int stride = nscan == 0 ? G : nscan;
        for (int it = blockIdx.x; it < nchain; it += stride) rwkv_chain(p, lds, it / NH, it % NH);
    }
    if ((int)blockIdx.x >= nscan) {
        const int nb = G - nscan, bi = blockIdx.x - nscan;
        for (int it = bi * 8 + wave; it < NB * NH * 64; it += nb * 8) attn_tile(p, lds + wave * 9216, it / (NH * 64), (it / 64) % NH, 63 - (it % 64));
        __syncthreads();
        p0_expert_weights(p, lds, bi * 8 + wave, nb * 8);
    }
}

struct EpiH {
    const float* x; bf16_t* hb; int row0, col0;
    __device__ __forceinline__ void operator()(const f32x4 (&acc)[2][2][4][2], const unsigned (&m0)[8], const unsigned (&m1)[8], int wr, int wc, int fr, int fq) const {
#pragma unroll
        for (int ai = 0; ai < 2; ++ai)
#pragma unroll
            for (int m = 0; m < 4; ++m) { const size_t off = (size_t)(row0 + ai * 128 + wr * 64 + m * 16 + fr) * D + col0 + wc * 32 + 8 * fq;
#pragma unroll
                for (int bj = 0; bj < 2; ++bj) { const f32x4 v0 = *(const f32x4*)(x + off + bj * 128) + acc[ai][bj][m][0], v1 = *(const f32x4*)(x + off + bj * 128 + 4) + acc[ai][bj][m][1];
                    *(u32x4*)(hb + off + bj * 128) = (u32x4){cvt_pk_bf16(v0[0], v0[1]), cvt_pk_bf16(v0[2], v0[3]), cvt_pk_bf16(v1[0], v1[1]), cvt_pk_bf16(v1[2], v1[3])}; }
                if (m & 1) asm volatile("" ::: "memory"); }
    }
};
__device__ __forceinline__ void phase3(const Params& p, LAS unsigned char* lds) {
    constexpr int nM = T / 256, nN = D / 256;
    g8::UnitIO cur, nxt; g8::aoff_rows(cur.aoff, D);
#pragma unroll
    for (int a = 0; a < 2; ++a)
#pragma unroll
        for (int b = 0; b < 2; ++b) nxt.aoff[a][b] = cur.aoff[a][b];
    cur.meta0 = nullptr; cur.meta1 = nullptr; nxt.meta0 = nullptr; nxt.meta1 = nullptr;
    int pm = 0, pn = 0; int L = blockIdx.x;
    if (L < nM * nN) { g8::tile_order(L, nM, nN, pm, pn); cur.Ab = (const char*)(p.ws + WS_B) + (size_t)pm * 256 * D * 2; cur.Bb = (const char*)(p.ws + WS_WOUT) + (size_t)pn * 256 * D * 2; }
    for (int i = 0; L < nM * nN; L += gridDim.x, ++i) {
        const bool hn = L + (int)gridDim.x < nM * nN; int pm2 = 0, pn2 = 0;
        if (hn) { g8::tile_order(L + gridDim.x, nM, nN, pm2, pn2); nxt.Ab = (const char*)(p.ws + WS_B) + (size_t)pm2 * 256 * D * 2; nxt.Bb = (const char*)(p.ws + WS_WOUT) + (size_t)pn2 * 256 * D * 2; }
        EpiH E{p.x, (bf16_t*)(p.ws + WS_A), pm * 256, pn * 256};
        g8::gemm_unit_p<16>(lds, cur, D, E, i & 1, i > 0, hn, nxt);
        cur.Ab = nxt.Ab; cur.Bb = nxt.Bb; pm = pm2; pn = pn2;
    }
}

__device__ __forceinline__ void phase4(const Params& p, LAS unsigned char* lds) {
    int tid = threadIdx.x; asm volatile("" : "+v"(tid));
    const int wave = tid >> 6, lane = tid & 63, fr = lane & 15, fq = lane >> 4;
    const float* hsrc = p.out; bf16_t* hb = (bf16_t*)(p.ws + WS_A); float* rstd2 = (float*)(p.ws + WS_RSTD2);
    const bf16_t* wr_hi = (const bf16_t*)(p.ws + WS_WR); const bf16_t* wr_lo = wr_hi + 48 * D;
    int* list = (int*)(p.ws + WS_LIST); float* listw = (float*)(p.ws + WS_LISTW); float* listr = (float*)(p.ws + WS_LISTR); unsigned* cnt = (unsigned*)(p.ws + WS_CTL);
    LAS float* lg = (LAS float*)(lds + wave * 3072);
    LAS unsigned* lcnt = (LAS unsigned*)(lds + 8 * 3072);
    LAS unsigned* gbase = lcnt + 32;
    for (int blk = blockIdx.x; blk < T / 128; blk += gridDim.x) {
        if (tid < 32) lcnt[tid] = 0u;
        __syncthreads();
        const int tok0 = blk * 128 + wave * 16;
        f32x4 acc[3];
#pragma unroll
        for (int n = 0; n < 3; ++n) acc[n] = (f32x4){0.f, 0.f, 0.f, 0.f};
        float ss = 0.f;
        const bf16_t* hbp = hb + (size_t)(tok0 + fr) * D + 8 * fq;
        LAS unsigned char* wl_ = lds + 32768;
#pragma unroll 1
        for (int half = 0; half < 2; ++half) {
            __syncthreads();
            for (int i = tid; i < 2 * 48 * 64; i += NTHREADS) { const int mat = i / 3072, r = (i % 3072) >> 6, ch = i & 63;
                *(LAS u32x4*)(wl_ + mat * 49152 + r * 1024 + ((ch ^ (r & 15)) << 4)) = *(const u32x4*)((mat ? wr_lo : wr_hi) + (size_t)r * D + half * 512 + ch * 8); }
            u32x4 av[16];
#pragma unroll
            for (int ks = 0; ks < 16; ++ks) av[ks] = *(const u32x4*)(hbp + half * 512 + 32 * ks);
            __syncthreads();
#pragma unroll
            for (int ks = 0; ks < 16; ++ks) {
                float f[8]; f8_from_bf16(av[ks], f);
                ss += (f[0] * f[0] + f[1] * f[1]) + (f[2] * f[2] + f[3] * f[3]) + ((f[4] * f[4] + f[5] * f[5]) + (f[6] * f[6] + f[7] * f[7]));
                const bf16x8 ah = __builtin_bit_cast(bf16x8, av[ks]);
#pragma unroll
                for (int n = 0; n < 3; ++n) {
                    const int r = 16 * n + fr, off = r * 1024 + (((4 * ks + fq) ^ (r & 15)) << 4);
                    const bf16x8 wh = *(const LAS bf16x8*)(wl_ + off), wl = *(const LAS bf16x8*)(wl_ + 49152 + off);
                    acc[n] = __builtin_amdgcn_mfma_f32_16x16x32_bf16(ah, wh, acc[n], 0, 0, 0);
                    acc[n] = __builtin_amdgcn_mfma_f32_16x16x32_bf16(ah, wl, acc[n], 0, 0, 0);
                }
            }
        }
        ss += __shfl_xor(ss, 16); ss += __shfl_xor(ss, 32);
        const float rs = 1.0f / sqrtf(ss * (1.0f / D) + 1e-6f);
        if (fq == 0) rstd2[tok0 + fr] = rs;
#pragma unroll
        for (int n = 0; n < 3; ++n)
#pragma unroll
            for (int r = 0; r < 4; ++r) lg[(4 * fq + r) * 48 + 16 * n + fr] = acc[n][r];
        LDS_WAIT();
        int e0 = 0, e1 = 0; float w0 = 0.f, w1 = 0.f; unsigned lp0 = 0, lp1 = 0;
        if (lane < 16) {
            const float rst = rs;
            const LAS float* L = lg + lane * 48;
            float gl[4]; int gi = 0; float gm;
#pragma unroll
            for (int g = 0; g < 4; ++g) gl[g] = L[g] * rst + p.r_grp_b[g];
            gm = gl[0];
#pragma unroll
            for (int g = 1; g < 4; ++g) if (gl[g] > gm) { gm = gl[g]; gi = g; }
            float gs = 0.f;
#pragma unroll
            for (int g = 0; g < 4; ++g) gs += __expf(gl[g] - gm);
            const float gval = 1.0f / gs;
            float el[8];
#pragma unroll
            for (int e = 0; e < 8; ++e) el[e] = L[4 + gi * 8 + e] * rst + p.r_exp_b[gi * 8 + e];
            int i0 = 0; float m0 = el[0];
#pragma unroll
            for (int e = 1; e < 8; ++e) if (el[e] > m0) { m0 = el[e]; i0 = e; }
            int i1 = i0 == 0 ? 1 : 0; float m1 = el[i1];
#pragma unroll
            for (int e = 0; e < 8; ++e) if (e != i0 && el[e] > m1) { m1 = el[e]; i1 = e; }
            const float x1 = __expf(m1 - m0); const float den = 1.0f / (1.0f + x1);
            e0 = gi * 8 + i0; e1 = gi * 8 + i1; w0 = gval * den; w1 = gval * x1 * den;
            lp0 = atomicAdd((unsigned*)&lcnt[e0], 1u); lp1 = atomicAdd((unsigned*)&lcnt[e1], 1u);
        }
        __syncthreads();
        if (tid < 32) gbase[tid] = atomicAdd(&cnt[tid], lcnt[tid]);
        __syncthreads();
        if (lane < 16) {
            const int tok = tok0 + lane;
            const unsigned q0 = gbase[e0] + lp0, q1 = gbase[e1] + lp1;
            list[(size_t)e0 * T + q0] = tok * 2;     listw[(size_t)e0 * T + q0] = w0; listr[(size_t)e0 * T + q0] = rs;
            list[(size_t)e1 * T + q1] = tok * 2 + 1; listw[(size_t)e1 * T + q1] = w1; listr[(size_t)e1 * T + q1] = rs;
        }
        __syncthreads();
    }
}

constexpr int LDS_MAP = 161792;
__device__ __forceinline__ void expert_map_build(const unsigned* cnt, LAS unsigned char* lds) {
    LAS int* pre = (LAS int*)(lds + LDS_MAP); LAS int* cn = pre + 40;
    if (threadIdx.x == 0) { int acc = 0; for (int i = 0; i < NE; ++i) { const int ci = (int)__hip_atomic_load(cnt + i, __ATOMIC_RELAXED, __HIP_MEMORY_SCOPE_AGENT); pre[i] = acc; cn[i] = ci; acc += (ci + 255) >> 8; } pre[NE] = acc; }
    __syncthreads();
}
__device__ __forceinline__ void expert_find(LAS unsigned char* lds, int mt, int& e, int& local, int& c) {
    const LAS int* pre = (const LAS int*)(lds + LDS_MAP); const LAS int* cn = pre + 40;
    int lo = 0;
#pragma unroll 1
    for (int i = 1; i < NE; ++i) if (pre[i] <= mt) lo = i;
    e = __builtin_amdgcn_readfirstlane(lo); local = mt - __builtin_amdgcn_readfirstlane(pre[e]); c = __builtin_amdgcn_readfirstlane(cn[e]);
}
__device__ __forceinline__ int expert_tiles(LAS unsigned char* lds) { return __builtin_amdgcn_readfirstlane(((const LAS int*)(lds + LDS_MAP))[NE]); }

struct EpiGU {
    bf16_t* hid; const float* rstd2; const int* lst; int cnt, p0, hrow0, ct;
    __device__ __forceinline__ void operator()(const f32x4 (&acc)[2][2][4][2], const unsigned (&m0)[8], const unsigned (&m1)[8], int wr, int wc, int fr, int fq) const {
#pragma unroll
        for (int ai = 0; ai < 2; ++ai)
#pragma unroll
            for (int m = 0; m < 4; ++m) { const int r = ai * 128 + wr * 64 + m * 16 + fr; const int pp = p0 + r;
                const float rs = pp < cnt ? __uint_as_float(m0[ai * 4 + m]) : 0.f;
                bf16_t* op = hid + (size_t)(hrow0 + r) * DE + ct * 128 + wc * 32 + 8 * fq;
                float o[8];
#pragma unroll
                for (int n = 0; n < 2; ++n) { const f32x4 g = acc[ai][0][m][n] * rs, uu = acc[ai][1][m][n] * rs;
#pragma unroll
                    for (int j = 0; j < 4; ++j) o[4 * n + j] = g[j] * frcp(1.0f + fexp2(-g[j] * LOG2E)) * uu[j]; }
                *(u32x4*)op = (u32x4){cvt_pk_bf16(o[0], o[1]), cvt_pk_bf16(o[2], o[3]), cvt_pk_bf16(o[4], o[5]), cvt_pk_bf16(o[6], o[7])}; }
    }
};
__device__ __forceinline__ void phase5(const Params& p, LAS unsigned char* lds) {
    expert_map_build((const unsigned*)(p.ws + WS_CTL), lds);
    const int MT = expert_tiles(lds);
    int tid = threadIdx.x; asm volatile("" : "+v"(tid));
    int Rr[2], Cc[2];
#pragma unroll
    for (int i = 0; i < 2; ++i) g8::stage_rc(tid * 16 + i * 8192, Rr[i], Cc[i]);
    g8::UnitIO cur, nxt; cur.meta1 = nullptr; nxt.meta1 = nullptr;
    auto fill = [&](g8::UnitIO& io, int unit, int& e, int& c, int& p0, int& mt, int& ct) {
        mt = unit >> 1; ct = unit & 1; int local; expert_find(lds, mt, e, local, c); p0 = local * 256;
        const int* lst = (const int*)(p.ws + WS_LIST) + (size_t)e * T;
#pragma unroll
        for (int i = 0; i < 2; ++i)
#pragma unroll
            for (int hh = 0; hh < 2; ++hh) { const int pp = p0 + hh * 128 + Rr[i]; const int tok = pp < c ? (lst[pp] >> 1) : 0; io.aoff[hh][i] = (unsigned)(tok * D + Cc[i]) * 2u; }
        io.Ab = (const char*)(p.ws + WS_A); io.Bb = (const char*)(p.ws + WS_WGU) + ((size_t)e * 512 + ct * 256) * D * 2; io.meta0 = (const unsigned*)(p.ws + WS_LISTR) + (size_t)e * T + p0;
    };
    int e = 0, c = 0, p0 = 0, mt = 0, ct = 0; int unit = blockIdx.x;
    if (unit < MT * 2) fill(cur, unit, e, c, p0, mt, ct);
    for (int i = 0; unit < MT * 2; unit += gridDim.x, ++i) {
        const bool hn = unit + (int)gridDim.x < MT * 2; int e2 = 0, c2 = 0, p02 = 0, mt2 = 0, ct2 = 0;
        if (hn) fill(nxt, unit + gridDim.x, e2, c2, p02, mt2, ct2);
        EpiGU E{(bf16_t*)(p.ws + WS_B), (const float*)(p.ws + WS_RSTD2), nullptr, c, p0, mt * 256, ct};
        g8::gemm_unit_p<8>(lds, cur, D, E, i & 1, i > 0, hn, nxt);
        cur = nxt; e = e2; c = c2; p0 = p02; mt = mt2; ct = ct2;
    }
}
struct EpiDN {
    bf16_t* y; bf16_t* dummy; const int* lst; const float* lw; int cnt, p0, col0;
    __device__ __forceinline__ void operator()(const f32x4 (&acc)[2][2][4][2], const unsigned (&m0)[8], const unsigned (&m1)[8], int wr, int wc, int fr, int fq) const {
#pragma unroll
        for (int ai = 0; ai < 2; ++ai)
#pragma unroll
            for (int m = 0; m < 4; ++m) { const int pp = p0 + ai * 128 + wr * 64 + m * 16 + fr;
                const bool ok = pp < cnt; const int rl = pp - p0; const int ent = (int)m0[ai * 4 + m]; const float w = __uint_as_float(m1[ai * 4 + m]);
                bf16_t* op = (ok ? y + ((size_t)(ent & 1) * T + (ent >> 1)) * D : dummy) + col0 + wc * 32 + 8 * fq;
#pragma unroll
                for (int bj = 0; bj < 2; ++bj) { const f32x4 v0 = acc[ai][bj][m][0] * w, v1 = acc[ai][bj][m][1] * w;
                    *(u32x4*)(op + bj * 128) = (u32x4){cvt_pk_bf16(v0[0], v0[1]), cvt_pk_bf16(v0[2], v0[3]), cvt_pk_bf16(v1[0], v1[1]), cvt_pk_bf16(v1[2], v1[3])}; }
                if (m & 1) asm volatile("" ::: "memory"); }
    }
};
__device__ __forceinline__ void phase6(const Params& p, LAS unsigned char* lds) {
    expert_map_build((const unsigned*)(p.ws + WS_CTL), lds);
    const int MT = expert_tiles(lds);
    constexpr int kdn = DE;
    g8::UnitIO cur, nxt; g8::aoff_rows(cur.aoff, kdn);
#pragma unroll
    for (int a = 0; a < 2; ++a)
#pragma unroll
        for (int b = 0; b < 2; ++b) nxt.aoff[a][b] = cur.aoff[a][b];
    auto fill = [&](g8::UnitIO& io, int unit, int& c, int& p0, int& pn) {
        const int mt = unit >> 2; pn = unit & 3; int e, local; expert_find(lds, mt, e, local, c); p0 = local * 256;
        io.Ab = (const char*)(p.ws + WS_B) + (size_t)mt * 256 * DE * 2; io.Bb = (const char*)(p.ws + WS_WDN) + ((size_t)e * D + pn * 256) * DE * 2;
        io.meta0 = (const unsigned*)(p.ws + WS_LIST) + (size_t)e * T + p0; io.meta1 = (const unsigned*)(p.ws + WS_LISTW) + (size_t)e * T + p0;
    };
    int c = 0, p0 = 0, pn = 0; int unit = blockIdx.x;
    if (unit < MT * 4) fill(cur, unit, c, p0, pn);
    for (int i = 0; unit < MT * 4; unit += gridDim.x, ++i) {
        const bool hn = unit + (int)gridDim.x < MT * 4; int c2 = 0, p02 = 0, pn2 = 0;
        if (hn) fill(nxt, unit + gridDim.x, c2, p02, pn2);
        EpiDN E{(bf16_t*)(p.ws + WS_A + (size_t)T * D * 2), (bf16_t*)(p.ws + WS_A + (size_t)3 * T * D * 2), nullptr, nullptr, c, p0, pn * 256};
        g8::gemm_unit_p<16>(lds, cur, kdn, E, i & 1, i > 0, hn, nxt);
        cur.Ab = nxt.Ab; cur.Bb = nxt.Bb; cur.meta0 = nxt.meta0; cur.meta1 = nxt.meta1; c = c2; p0 = p02; pn = pn2;
    }
}

__device__ __forceinline__ void phase7(const Params& p) {
    int tid7 = threadIdx.x; asm volatile("" : "+v"(tid7));
    const int wave = tid7 >> 6, lane = tid7 & 63;
    const bf16_t* hb = (const bf16_t*)(p.ws + WS_A);
    const bf16_t* y0 = (const bf16_t*)(p.ws + WS_A + (size_t)T * D * 2); const bf16_t* y1 = y0 + (size_t)T * D;
    f32x4 g[4];
#pragma unroll
    for (int j = 0; j < 4; ++j) g[j] = *((const f32x4*)p.final_g + lane + 64 * j);
    const int stride = gridDim.x * NWAVES;
    int row = blockIdx.x * NWAVES + wave;
    u32x2 hv[4], ya[4], yb[4];
    if (row < T) {
#pragma unroll
        for (int j = 0; j < 4; ++j) { hv[j] = ((const u32x2*)(hb + (size_t)row * D) + lane)[64 * j]; ya[j] = ((const u32x2*)(y0 + (size_t)row * D) + lane)[64 * j]; yb[j] = ((const u32x2*)(y1 + (size_t)row * D) + lane)[64 * j]; }
    }
    for (; row < T; row += stride) {
        f32x4 v[4]; float s = 0.f;
#pragma unroll
        for (int j = 0; j < 4; ++j) {
            v[j][0] = bf16_lo(hv[j].x) + (bf16_lo(ya[j].x) + bf16_lo(yb[j].x)); v[j][1] = bf16_hi(hv[j].x) + (bf16_hi(ya[j].x) + bf16_hi(yb[j].x)); v[j][2] = bf16_lo(hv[j].y) + (bf16_lo(ya[j].y) + bf16_lo(yb[j].y)); v[j][3] = bf16_hi(hv[j].y) + (bf16_hi(ya[j].y) + bf16_hi(yb[j].y));
            s += (v[j][0] * v[j][0] + v[j][1] * v[j][1]) + (v[j][2] * v[j][2] + v[j][3] * v[j][3]); }
        const int nrow = row + stride;
        if (nrow < T) {
#pragma unroll
            for (int j = 0; j < 4; ++j) { hv[j] = ((const u32x2*)(hb + (size_t)nrow * D) + lane)[64 * j]; ya[j] = ((const u32x2*)(y0 + (size_t)nrow * D) + lane)[64 * j]; yb[j] = ((const u32x2*)(y1 + (size_t)nrow * D) + lane)[64 * j]; }
        }
        s = wave_sum(s);
        const float rs = 1.0f / sqrtf(s * (1.0f / D) + 1e-6f);
        f32x4* orow = (f32x4*)(p.out + (size_t)row * D) + lane;
#pragma unroll
        for (int j = 0; j < 4; ++j) orow[64 * j] = v[j] * rs * g[j];
    }
}

__global__ __launch_bounds__(512) void mega(Params p) {
    extern __shared__ __attribute__((aligned(16))) unsigned char lds_raw[];
    LAS unsigned char* lds = (LAS unsigned char*)lds_raw;
    volatile LAS unsigned* bst = (volatile LAS unsigned*)(lds + LDS_MAP + 512);
    if (threadIdx.x == 0) { bst[0] = 0u; bst[1] = 0u; bst[2] = 0u; bst[3] = 0u; }
    __syncthreads();
    const XcdBarrier gb = xcd_barrier_post((unsigned*)(p.ws + WS_BAR), bst);
#define GSYNC() xcd_barrier(gb)
    phase0(p, lds); GSYNC();
    phase1(p, lds); GSYNC();
    { phase2a(p); GSYNC(); phase2(p, lds); } GSYNC();
    phase3(p, lds); GSYNC();
    phase4(p, lds); GSYNC();
    phase5(p, lds); GSYNC();
    phase6(p, lds); GSYNC();
    phase7(p);
}

extern "C" void kernel_launch(void* const* d_in, const int* in_sizes, int n_in, void* d_out, int out_size, void* d_ws, size_t ws_size, hipStream_t stream) {
    static int grid = 0;
    if (grid == 0) {
        if (n_in != 25 || out_size != T * D || ws_size < WS_END) { fprintf(stderr, "kernel_launch: unexpected sizes n_in %d out %d ws %zu (need %zu)\n", n_in, out_size, ws_size, (size_t)WS_END); grid = -1; return; }
        int dev = 0, cus = 0, per_cu = 0;
        (void)hipGetDevice(&dev); (void)hipDeviceGetAttribute(&cus, hipDeviceAttributeMultiprocessorCount, dev);
        if (hipFuncSetAttribute((const void*)mega, hipFuncAttributeMaxDynamicSharedMemorySize, LDS_BYTES) != hipSuccess) { fprintf(stderr, "kernel_launch: hipFuncSetAttribute failed\n"); grid = -1; return; }
        if (hipOccupancyMaxActiveBlocksPerMultiprocessor(&per_cu, (const void*)mega, NTHREADS, LDS_BYTES) != hipSuccess || per_cu < 1) { fprintf(stderr, "kernel_launch: occupancy query failed (%d)\n", per_cu); (void)hipGetLastError(); per_cu = 1; }
        grid = cus * 1;
    }
    if (grid < 0) return;
    Params p{};
    const float** f = (const float**)&p;
    for (int i = 0; i < 25; ++i) f[i] = (const float*)d_in[i];
    p.out = (float*)d_out; p.ws = (unsigned char*)d_ws;
    if (hipMemsetAsync((char*)d_ws + WS_BAR, 0, XCD_BAR_WORDS * 4, stream) != hipSuccess) { fprintf(stderr, "kernel_launch: memset failed\n"); return; }
    hipLaunchKernelGGL(mega, dim3(grid), dim3(NTHREADS), LDS_BYTES, stream, p);
    hipError_t e = hipPeekAtLastError();
    if (e != hipSuccess) fprintf(stderr, "launch failed: %s (grid %d)\n", hipGetErrorString(e), grid);
}
```

```cpp
#include <hip/hip_runtime.h>
#include <cstdio>
#include <cstdint>

#define LAS __attribute__((address_space(3)))
typedef unsigned short bf16_t;
typedef short bf16x8 __attribute__((ext_vector_type(8)));
typedef short s16x4 __attribute__((ext_vector_type(4)));
typedef float f32x4 __attribute__((ext_vector_type(4)));
typedef float f32x2 __attribute__((ext_vector_type(2)));
typedef float f32x16 __attribute__((ext_vector_type(16)));
typedef unsigned u32x2 __attribute__((ext_vector_type(2)));
typedef unsigned u32x4 __attribute__((ext_vector_type(4)));

constexpr int NB = 16, S = 2048, T = NB * S, D = 1024, NIN = 3328, NH = 8, HD = 64;
constexpr int UQ = 0, UK = 512, UV = 1024, UR = 1536, URK = 2048, URV = 2560, UXW = 3072, UXA = 3136, UXG = 3200;
constexpr int NE = 32, DE = 256;
constexpr float LOG2E = 1.4426950408889634f, LN2 = 0.6931471805599453f;
constexpr float QSCALE = 0.125f * LOG2E;
constexpr int NTHREADS = 512, NWAVES = 8;
constexpr int LDS_BYTES = 161792 + 1024;

constexpr size_t WS_CTL   = 0;
constexpr size_t WS_BAR   = 8192;
constexpr size_t WS_WIN   = 65536;
constexpr size_t WS_WOUT  = WS_WIN  + (size_t)NIN * D * 2;
constexpr size_t WS_WGU   = WS_WOUT + (size_t)D * D * 2;
constexpr size_t WS_WDN   = WS_WGU  + (size_t)NE * 512 * D * 2;
constexpr size_t WS_RSTD1 = WS_WDN  + (size_t)NE * D * DE * 2;
constexpr size_t WS_RSTD2 = WS_RSTD1 + (size_t)T * 4;
constexpr size_t WS_LIST  = WS_RSTD2 + (size_t)T * 4;
constexpr size_t WS_LISTW = WS_LIST + (size_t)NE * T * 4;
constexpr size_t WS_LISTR = WS_LISTW + (size_t)NE * T * 4;
constexpr size_t WS_WR    = WS_LISTR + (size_t)NE * T * 4;
constexpr size_t WS_LT    = WS_WR + (size_t)2 * 48 * D * 2;
constexpr size_t WS_A     = WS_LT + (size_t)512 * 256 * 2;
constexpr size_t WS_B     = WS_A + (size_t)T * NIN * 2;
constexpr size_t WS_C     = WS_B + (size_t)T * D * 2;
constexpr size_t WS_D     = WS_C + (size_t)T * D * 2;
constexpr size_t WS_END   = WS_D + (size_t)T * 1536 * 2;
constexpr int HID_ROWS = 2 * T + NE * 256;

struct Params {
    const float* x; const float* norm_mix_g; const float* w_in; const float* shift_mu; const float* sb_out_g;
    const float* rw_w0; const float* rw_w2; const float* rw_a0; const float* rw_a2; const float* rw_g2;
    const float* rw_k_k; const float* rw_k_a; const float* rw_r_k; const float* rw_ln_w; const float* rw_ln_b;
    const float* w_out; const float* norm_ffn_g; const float* r_grp_w; const float* r_grp_b; const float* r_exp_w; const float* r_exp_b;
    const float* w_gate; const float* w_up; const float* w_down; const float* final_g;
    float* out; unsigned char* ws;
};

typedef __bf16 bf16x2_t __attribute__((ext_vector_type(2)));
__device__ __forceinline__ unsigned cvt_pk_bf16(float lo, float hi) { const f32x2 v = {lo, hi}; return __builtin_bit_cast(unsigned, __builtin_convertvector(v, bf16x2_t)); }
__device__ __forceinline__ float bf16_lo(unsigned w) { return __uint_as_float(w << 16); }
__device__ __forceinline__ float bf16_hi(unsigned w) { return __uint_as_float(w & 0xffff0000u); }
__device__ __forceinline__ float fexp2(float x) { return __builtin_amdgcn_exp2f(x); }
__device__ __forceinline__ float flog2(float x) { return __builtin_amdgcn_logf(x); }
__device__ __forceinline__ float frcp(float x) { return __builtin_amdgcn_rcpf(x); }
__device__ __forceinline__ float frsq(float x) { return __builtin_amdgcn_rsqf(x); }
template <int CTRL> __device__ __forceinline__ float dppf(float v) { return __builtin_bit_cast(float, __builtin_amdgcn_update_dpp(0, __builtin_bit_cast(int, v), CTRL, 0xF, 0xF, true)); }
__device__ __forceinline__ float rlane(float v, int l) { return __builtin_bit_cast(float, __builtin_amdgcn_readlane(__builtin_bit_cast(int, v), l)); }
__device__ __forceinline__ float sum8(float v) { v += dppf<0xB1>(v); v += dppf<0x4E>(v); v += dppf<0x141>(v); return v; }
__device__ __forceinline__ float sum16(float v) { v = sum8(v); v += dppf<0x140>(v); return v; }
__device__ __forceinline__ float wave_sum(float v) { v = sum16(v); return (rlane(v, 0) + rlane(v, 16)) + (rlane(v, 32) + rlane(v, 48)); }
__device__ __forceinline__ float swap32(float v) { return __shfl_xor(v, 32); }
#define LDS_WAIT() asm volatile("s_waitcnt lgkmcnt(0)" ::: "memory")


#define XB_TMO      128
#define XB_XCNT(j)  (256  + 64 * (j))
#define XB_XSUB(j)  (1280 + 64 * (j))
#define XB_XGEN(j)  (2304 + 64 * (j))
#define XB_TOP      3328
#define XB_TOPGEN   3392
#define XCD_BAR_WORDS 3456
#define XB_SPIN_CAP (1u << 22)
__device__ __forceinline__ unsigned xb_ld(unsigned* p)              { return __hip_atomic_load(p, __ATOMIC_RELAXED, __HIP_MEMORY_SCOPE_AGENT); }
__device__ __forceinline__ unsigned xb_add(unsigned* p, unsigned v) { return __hip_atomic_fetch_add(p, v, __ATOMIC_RELAXED, __HIP_MEMORY_SCOPE_AGENT); }
__device__ __forceinline__ unsigned xb_xcc_id() { return (unsigned)__builtin_amdgcn_s_getreg((3 << 11) | 20) & 0xFu; }
#define XB_SPIN(cond, bar) do { unsigned _sp = 0; while (cond) { __builtin_amdgcn_s_sleep(1); \
    if ((++_sp & 255u) == 0u) { if (xb_ld(&(bar)[XB_TMO])) break; if (_sp > XB_SPIN_CAP) { atomicAdd(&(bar)[XB_TMO], 1u); break; } } } } while (0)
struct XcdBarrier { unsigned* bar; unsigned x; volatile LAS unsigned* st; };
__device__ __forceinline__ XcdBarrier xcd_barrier_post(unsigned* bar, volatile LAS unsigned* st) {
    XcdBarrier b; b.bar = bar; b.x = xb_xcc_id(); b.st = st;
    if (threadIdx.x == 0) (void)xb_add(&bar[XB_XCNT(b.x)], 1u);
    return b;
}
__device__ __forceinline__ void xcd_barrier_complete(unsigned* bar, unsigned x, unsigned& nloc, unsigned& nx) {
    const unsigned G = gridDim.x * gridDim.y * gridDim.z;
    unsigned sum, cnt, mine, sp = 0u;
    for (;;) {
        sum = 0u; cnt = 0u; mine = 0u;
#pragma unroll
        for (unsigned j = 0; j < 16; ++j) { const unsigned c = xb_ld(&bar[XB_XCNT(j)]); sum += c; cnt += (c > 0u) ? 1u : 0u; mine = (j == x) ? c : mine; }
        if (sum == G) break;
        __builtin_amdgcn_s_sleep(1);
        if ((++sp & 255u) == 0u) { if (xb_ld(&bar[XB_TMO])) break; if (sp > XB_SPIN_CAP) { atomicAdd(&bar[XB_TMO], 1u); break; } }
    }
    nloc = mine > 0u ? mine : 1u; nx = cnt > 0u ? cnt : 1u;
}
__device__ __forceinline__ void xcd_barrier(const XcdBarrier& b) {
    asm volatile("s_waitcnt vmcnt(0)" ::: "memory");
    __syncthreads();
    if (threadIdx.x == 0) {
        unsigned* bar = b.bar;
        __builtin_amdgcn_s_waitcnt(0);
        unsigned nloc = b.st[0], nx = b.st[1];
        if (nloc == 0u) { xcd_barrier_complete(bar, b.x, nloc, nx); b.st[0] = nloc; b.st[1] = nx; }
        const unsigned old = xb_add(&bar[XB_XSUB(b.x)], 1u);
        const unsigned gen = old / nloc;
        if (old + 1u == (gen + 1u) * nloc) {
            __builtin_amdgcn_fence(__ATOMIC_RELEASE, "agent");
            asm volatile("s_waitcnt vmcnt(0)" ::: "memory");
            const unsigned og = xb_add(&bar[XB_TOP], 1u);
            const unsigned tg = og / nx;
            if (og + 1u == (tg + 1u) * nx) xb_add(&bar[XB_TOPGEN], 1u);
            else XB_SPIN(xb_ld(&bar[XB_TOPGEN]) == tg, bar);
            __builtin_amdgcn_fence(__ATOMIC_ACQUIRE, "agent");
            xb_add(&bar[XB_XGEN(b.x)], 1u);
            asm volatile("s_waitcnt vmcnt(0)" ::: "memory");
        } else {
            XB_SPIN(xb_ld(&bar[XB_XGEN(b.x)]) == gen, bar);
            __builtin_amdgcn_fence(__ATOMIC_ACQUIRE, "agent");
            asm volatile("s_waitcnt vmcnt(0)" ::: "memory");
        }
    }
    __syncthreads();
}

namespace g8 {
constexpr int BK = 64, HALF = 128, HTB = HALF * BK * 2;
__device__ __forceinline__ int lds_byte(int r, int c) { const int st = (r >> 4) * 2 + (c >> 5), rr = r & 15, cc = c & 31, ob = rr * 64 + cc * 2; return st * 1024 + (ob ^ (((ob >> 9) & 1) << 5)); }
__device__ __forceinline__ void stage_rc(int b, int& R, int& C) { const int st = b / 1024, sb = b % 1024, swz = sb ^ (((sb >> 9) & 1) << 5); R = (st >> 1) * 16 + swz / 64; C = (st & 1) * 32 + (swz % 64) / 2; }

#define G8_SA(b, h) (((b) * 2 + (h)) * HTB)
#define G8_SB(b, h) ((4 + (b) * 2 + (h)) * HTB)
#define G8_STAGE_A(bufoff, h, kt) do { _Pragma("unroll") for (int _i = 0; _i < 2; ++_i) \
    __builtin_amdgcn_global_load_lds((const unsigned*)((Ab + (size_t)(kt) * (BK * 2)) + aoff[h][_i]), (LAS unsigned*)(lds + (bufoff) + ldsw + _i * 8192), 16, 0, 0); } while (0)
#define G8_STAGE_B(bufoff, h, kt) do { _Pragma("unroll") for (int _i = 0; _i < 2; ++_i) \
    __builtin_amdgcn_global_load_lds((const unsigned*)((Bb + (size_t)(h) * bhalf + (size_t)(kt) * (BK * 2)) + boff[_i]), (LAS unsigned*)(lds + (bufoff) + ldsw + _i * 8192), 16, 0, 0); } while (0)
#define G8_LDA(dst, b, h) do { _Pragma("unroll") for (int m = 0; m < 4; ++m) _Pragma("unroll") for (int k = 0; k < 2; ++k) dst[m][k] = *(const LAS bf16x8*)(lds + G8_SA(b, h) + la_off + m * 2048 + k * 1024); } while (0)
#define G8_LDB(dst, b, h) do { _Pragma("unroll") for (int n = 0; n < 2; ++n) _Pragma("unroll") for (int k = 0; k < 2; ++k) dst[n][k] = *(const LAS bf16x8*)(lds + G8_SB(b, h) + lb_off + n * 2048 + k * 1024); } while (0)
#define G8_MMA(ai, bj, At, Bt) do { __builtin_amdgcn_s_setprio(1); _Pragma("unroll") for (int m = 0; m < 4; ++m) _Pragma("unroll") for (int n = 0; n < 2; ++n) _Pragma("unroll") for (int k = 0; k < 2; ++k) \
    acc[ai][bj][m][n] = __builtin_amdgcn_mfma_f32_16x16x32_bf16(Bt[n][k], At[m][k], acc[ai][bj][m][n], 0, 0, 0); __builtin_amdgcn_s_setprio(0); } while (0)
#define G8_WAIT_V(n) asm volatile("s_waitcnt vmcnt(" #n ")" ::: "memory")
#define G8_WAIT_L(n) asm volatile("s_waitcnt lgkmcnt(" #n ")" ::: "memory")
#define G8_BAR __builtin_amdgcn_s_barrier()
#define G8_SCHED __builtin_amdgcn_sched_barrier(0)

struct UnitIO { const char* Ab; const char* Bb; const unsigned* meta0; const unsigned* meta1; unsigned aoff[2][2]; };
#define G8_STAGE_AX(bufoff, h, kt, AB, AOFF) do { _Pragma("unroll") for (int _i = 0; _i < 2; ++_i) \
    __builtin_amdgcn_global_load_lds((const unsigned*)(((AB) + (size_t)(kt) * (BK * 2)) + (AOFF)[h][_i]), (LAS unsigned*)(lds + (bufoff) + ldsw + _i * 8192), 16, 0, 0); } while (0)
#define G8_STAGE_BX(bufoff, h, kt, BB) do { _Pragma("unroll") for (int _i = 0; _i < 2; ++_i) \
    __builtin_amdgcn_global_load_lds((const unsigned*)(((BB) + (size_t)(h) * bhalf + (size_t)(kt) * (BK * 2)) + boff[_i]), (LAS unsigned*)(lds + (bufoff) + ldsw + _i * 8192), 16, 0, 0); } while (0)
template <int N> __device__ __forceinline__ void wait_v() { asm volatile("s_waitcnt vmcnt(%0)" :: "n"(N) : "memory"); }
template <int NEPI, class Epi>
__device__ __forceinline__ void gemm_unit_p(LAS unsigned char* lds, const UnitIO& io, int K, const Epi& E, int parity, bool primed, bool has_next, const UnitIO& nx, int mh = -1) {
    const bool do0 = mh != 1, do1 = mh != 0;
    int tid = threadIdx.x; asm volatile("" : "+v"(tid));
    const int wid = __builtin_amdgcn_readfirstlane(tid >> 6), lane = tid & 63, wr = wid >> 2, wc = wid & 3, fr = lane & 15, fq = lane >> 4;
    const int nt = K / BK;
    unsigned boff[2];
#pragma unroll
    for (int i = 0; i < 2; ++i) { int R, C; stage_rc(tid * 16 + i * 8192, R, C); const int rho = R & 31, Rb = (R & ~31) + 8 * ((rho & 15) >> 2) + 4 * (rho >> 4) + (rho & 3);
        boff[i] = (unsigned)(Rb * K + C) * 2u; }
    const size_t bhalf = (size_t)HALF * K * 2;
    const unsigned ldsw = (unsigned)wid * 1024u;
    const int la_off = lds_byte(wr * 64 + fr, fq * 8), lb_off = lds_byte(wc * 32 + fr, fq * 8);
    const char* Ab = io.Ab; const char* Bb = io.Bb; const unsigned (&aoff)[2][2] = io.aoff;
    f32x4 acc[2][2][4][2];
#pragma unroll
    for (int a = 0; a < 2; ++a)
#pragma unroll
        for (int b = 0; b < 2; ++b)
#pragma unroll
            for (int m = 0; m < 4; ++m)
#pragma unroll
                for (int n = 0; n < 2; ++n) acc[a][b][m][n] = (f32x4){0.f, 0.f, 0.f, 0.f};
    bf16x8 At[4][2], B0[2][2], B1[2][2];
    LAS unsigned char* mbuf = lds + 131072 + parity * 2048;
    if (!primed) {
        if (io.meta0) { if (wid < 4) __builtin_amdgcn_global_load_lds(io.meta0 + wid * 64 + lane, (LAS unsigned*)(mbuf + wid * 256), 4, 0, 0);
                        else if (io.meta1) __builtin_amdgcn_global_load_lds(io.meta1 + (wid - 4) * 64 + lane, (LAS unsigned*)(mbuf + 1024 + (wid - 4) * 256), 4, 0, 0); }
        G8_STAGE_B(G8_SB(0, 0), 0, 0); G8_STAGE_A(G8_SA(0, 0), 0, 0);
        G8_STAGE_B(G8_SB(0, 1), 1, 0); G8_STAGE_A(G8_SA(0, 1), 1, 0);
        if (wr == 1) G8_BAR;
        G8_WAIT_V(4); G8_BAR;
        G8_STAGE_B(G8_SB(1, 0), 0, 1); G8_STAGE_A(G8_SA(1, 0), 0, 1); G8_STAGE_B(G8_SB(1, 1), 1, 1);
        G8_WAIT_V(6); G8_BAR;
    } else {
        if (wr == 1) G8_BAR;
        wait_v<4 + NEPI>(); G8_BAR;
        G8_STAGE_B(G8_SB(1, 0), 0, 1); G8_STAGE_A(G8_SA(1, 0), 0, 1); G8_STAGE_B(G8_SB(1, 1), 1, 1);
        wait_v<6 + NEPI>(); G8_BAR;
    }
    for (int t = 0; t < nt - 2; t += 2) {
        G8_LDB(B0, 0, 0); G8_SCHED; G8_LDA(At, 0, 0); G8_STAGE_A(G8_SA(1, 1), 1, t + 1);
        G8_WAIT_L(8); G8_BAR; G8_WAIT_L(0); if (do0) G8_MMA(0, 0, At, B0); G8_BAR; G8_SCHED;
        G8_LDB(B1, 0, 1); G8_STAGE_B(G8_SB(0, 0), 0, t + 2);
        G8_BAR; G8_WAIT_L(0); if (do0) G8_MMA(0, 1, At, B1); G8_BAR;
        G8_LDA(At, 0, 1); G8_STAGE_A(G8_SA(0, 0), 0, t + 2);
        G8_BAR; G8_WAIT_L(0); if (do1) G8_MMA(1, 0, At, B0); G8_BAR; G8_SCHED;
        G8_STAGE_B(G8_SB(0, 1), 1, t + 2);
        G8_WAIT_V(6); G8_BAR; if (do1) G8_MMA(1, 1, At, B1); G8_BAR;
        G8_LDB(B0, 1, 0); G8_SCHED; G8_LDA(At, 1, 0); G8_STAGE_A(G8_SA(0, 1), 1, t + 2);
        G8_WAIT_L(8); G8_BAR; G8_WAIT_L(0); if (do0) G8_MMA(0, 0, At, B0); G8_BAR; G8_SCHED;
        G8_LDB(B1, 1, 1); G8_STAGE_B(G8_SB(1, 0), 0, t + 3);
        G8_BAR; G8_WAIT_L(0); if (do0) G8_MMA(0, 1, At, B1); G8_BAR;
        G8_LDA(At, 1, 1); G8_STAGE_A(G8_SA(1, 0), 0, t + 3);
        G8_BAR; G8_WAIT_L(0); if (do1) G8_MMA(1, 0, At, B0); G8_BAR; G8_SCHED;
        G8_STAGE_B(G8_SB(1, 1), 1, t + 3);
        G8_WAIT_V(6); G8_BAR; if (do1) G8_MMA(1, 1, At, B1); G8_BAR;
    }
    { G8_LDB(B0, 0, 0); G8_LDA(At, 0, 0); G8_STAGE_A(G8_SA(1, 1), 1, nt - 1);
      G8_BAR; G8_WAIT_L(0); if (do0) G8_MMA(0, 0, At, B0); G8_BAR;
      G8_LDB(B1, 0, 1); G8_BAR; G8_WAIT_L(0); if (do0) G8_MMA(0, 1, At, B1); G8_BAR;
      G8_LDA(At, 0, 1); G8_WAIT_V(4); G8_BAR; G8_WAIT_L(0); if (do1) { G8_MMA(1, 0, At, B0); G8_MMA(1, 1, At, B1); }; G8_BAR; }
    { G8_LDB(B0, 1, 0); G8_LDA(At, 1, 0); G8_WAIT_V(2); G8_BAR; G8_WAIT_L(0); if (do0) G8_MMA(0, 0, At, B0); G8_BAR;
      G8_LDB(B1, 1, 1); G8_WAIT_V(0); G8_BAR; G8_WAIT_L(0); if (do0) G8_MMA(0, 1, At, B1); G8_BAR;
      G8_LDA(At, 1, 1); G8_BAR; G8_WAIT_L(0); if (do1) { G8_MMA(1, 0, At, B0); G8_MMA(1, 1, At, B1); }; G8_BAR; }
    if (wr == 0) G8_BAR;
    asm volatile("" ::: "memory");
    unsigned m0[8], m1[8];
#pragma unroll
    for (int ai = 0; ai < 2; ++ai)
#pragma unroll
        for (int m = 0; m < 4; ++m) { const int rl = ai * 128 + wr * 64 + m * 16 + fr; m0[ai * 4 + m] = ((const LAS unsigned*)mbuf)[rl]; m1[ai * 4 + m] = ((const LAS unsigned*)(mbuf + 1024))[rl]; }
    G8_WAIT_L(0);
    if (has_next) {
        LAS unsigned char* nb = lds + 131072 + (parity ^ 1) * 2048;
        if (nx.meta0) { if (wid < 4) __builtin_amdgcn_global_load_lds(nx.meta0 + wid * 64 + lane, (LAS unsigned*)(nb + wid * 256), 4, 0, 0);
                        else if (nx.meta1) __builtin_amdgcn_global_load_lds(nx.meta1 + (wid - 4) * 64 + lane, (LAS unsigned*)(nb + 1024 + (wid - 4) * 256), 4, 0, 0); }
        G8_STAGE_BX(G8_SB(0, 0), 0, 0, nx.Bb); G8_STAGE_AX(G8_SA(0, 0), 0, 0, nx.Ab, nx.aoff);
        G8_STAGE_BX(G8_SB(0, 1), 1, 0, nx.Bb); G8_STAGE_AX(G8_SA(0, 1), 1, 0, nx.Ab, nx.aoff);
        asm volatile("" ::: "memory");
    }
    E(acc, m0, m1, wr, wc, fr, fq, mh);
    if (!has_next) __syncthreads();
}
__device__ __forceinline__ bool sched_get(int nU, int i, int& unit, int& mh) {
    const int G = gridDim.x, full = (nU / G) * G, rem = nU - full;
    const int L = blockIdx.x + i * G; mh = -1; unit = L;
    if (L < full) return true;
    const int j = L - full; if (j >= G) return false;
    if (rem > 0 && 2 * rem <= G) { if (j < 2 * rem) { unit = full + (j >> 1); mh = j & 1; return true; } return false; }
    return j < rem;
}
__device__ __forceinline__ void aoff_rows(unsigned (&aoff)[2][2], int K) {
    int tid = threadIdx.x; asm volatile("" : "+v"(tid));
#pragma unroll
    for (int i = 0; i < 2; ++i) { int R, C; stage_rc(tid * 16 + i * 8192, R, C);
#pragma unroll
        for (int h = 0; h < 2; ++h) aoff[h][i] = (unsigned)((h * HALF + R) * K + C) * 2u; }
}
__device__ __forceinline__ void tile_order(int L, int nM, int nN, int& pm, int& pn) {
    const int nwg = nM * nN; int wgid = L;
    { const int q = nwg / 8, r = nwg % 8, xcd = wgid % 8, off = wgid / 8; wgid = (xcd < r ? xcd * (q + 1) : r * (q + 1) + (xcd - r) * q) + off; }
    const int nig = 8 * nN, gid = wgid / nig, fm = gid * 8, gsz = (nM - fm) < 8 ? (nM - fm) : 8;
    pm = fm + ((wgid % nig) % gsz); pn = (wgid % nig) / gsz;
}
}

__device__ __forceinline__ void p0_transpose_item(const float* W, int K, int N, int k0, int n0, bf16_t* WTrow0  , const float* kscale, float mul, LAS float* scr, int lane) {
    float v[32];
#pragma unroll
    for (int i = 0; i < 32; ++i) v[i] = W[(size_t)(k0 + 2 * i + (lane >> 5)) * N + n0 + (lane & 31)];
    if (kscale) {
#pragma unroll
        for (int i = 0; i < 32; ++i) v[i] *= kscale[k0 + 2 * i + (lane >> 5)];
    }
#pragma unroll
    for (int i = 0; i < 32; ++i) scr[(2 * i + (lane >> 5)) * 33 + (lane & 31)] = v[i] * mul;
    LDS_WAIT();
    const int c = lane & 7;
#pragma unroll
    for (int j = 0; j < 4; ++j) { const int n = (lane >> 3) + 8 * j; const LAS float* s = scr + (8 * c) * 33 + n;
        u32x4 o; o.x = cvt_pk_bf16(s[0 * 33], s[1 * 33]); o.y = cvt_pk_bf16(s[2 * 33], s[3 * 33]); o.z = cvt_pk_bf16(s[4 * 33], s[5 * 33]); o.w = cvt_pk_bf16(s[6 * 33], s[7 * 33]);
        *(u32x4*)(WTrow0 + (size_t)n * K + k0 + 8 * c) = o; }
    LDS_WAIT();
}

__device__ __forceinline__ void p0_transpose64(const float* W, int K, int N, int k0, int n0, bf16_t* WTrow0  , const float* kscale, LAS float* scr, int lane) {
    const int rq = lane >> 4, c4 = 4 * (lane & 15);
    f32x4 v[16];
#pragma unroll
    for (int i = 0; i < 16; ++i) v[i] = *(const f32x4*)(W + (size_t)(k0 + 4 * i + rq) * N + n0 + c4);
    if (kscale) {
#pragma unroll
        for (int i = 0; i < 16; ++i) v[i] = v[i] * kscale[k0 + 4 * i + rq];
    }
#pragma unroll
    for (int i = 0; i < 16; ++i) { LAS float* d = scr + (4 * i + rq) * 65 + c4; d[0] = v[i][0]; d[1] = v[i][1]; d[2] = v[i][2]; d[3] = v[i][3]; }
    LDS_WAIT();
#pragma unroll
    for (int j = 0; j < 8; ++j) { const int c = lane & 7, n = (lane >> 3) + 8 * j; const LAS float* sp = scr + (8 * c) * 65 + n;
        u32x4 o; o.x = cvt_pk_bf16(sp[0], sp[65]); o.y = cvt_pk_bf16(sp[2 * 65], sp[3 * 65]); o.z = cvt_pk_bf16(sp[4 * 65], sp[5 * 65]); o.w = cvt_pk_bf16(sp[6 * 65], sp[7 * 65]);
        *(u32x4*)(WTrow0 + (size_t)n * K + k0 + 8 * c) = o; }
    LDS_WAIT();
}
__device__ __forceinline__ void p0_expert_weights(const Params& p, LAS unsigned char* lds, int gw, int NGW) {
    int tid = threadIdx.x; asm volatile("" : "+v"(tid));
    const int wave = tid >> 6, lane = tid & 63;
    LAS float* scr = (LAS float*)(lds + wave * 16640);
    bf16_t* wgu = (bf16_t*)(p.ws + WS_WGU); bf16_t* wdn = (bf16_t*)(p.ws + WS_WDN);
    constexpr int I_G = NE * 16 * 4, I_D = NE * 4 * 16;
    for (int it = gw; it < 2 * I_G + I_D; it += NGW) {
        int r = it;
        if (r < 2 * I_G) { const int up = r >= I_G; if (up) r -= I_G; const int e = r / 64, q = r % 64, kb = q / 4, nb = q % 4, n0 = nb * 64;
            const int drow = (n0 >> 7) * 256 + up * 128 + (n0 & 127);
            p0_transpose64((up ? p.w_up : p.w_gate) + (size_t)e * D * DE, D, DE, kb * 64, n0, wgu + ((size_t)e * 512 + drow) * D, p.norm_ffn_g, scr, lane); continue; } r -= 2 * I_G;
        { const int e = r / 64, q = r % 64, kb = q / 16, nb = q % 16, n0 = nb * 64;
            p0_transpose64(p.w_down + (size_t)e * DE * D, DE, D, kb * 64, n0, wdn + ((size_t)e * D + n0) * DE, nullptr, scr, lane); }
    }
}
__device__ __forceinline__ void phase0(const Params& p, LAS unsigned char* lds) {
    int tid = threadIdx.x; asm volatile("" : "+v"(tid));
    const int wave = tid >> 6, lane = tid & 63;
    const int gw = blockIdx.x * NWAVES + wave, NGW = gridDim.x * NWAVES;
    LAS float* scr = (LAS float*)(lds + wave * 8704);
    bf16_t* win = (bf16_t*)(p.ws + WS_WIN); bf16_t* wout = (bf16_t*)(p.ws + WS_WOUT);
    bf16_t* xb = (bf16_t*)(p.ws + WS_B); float* rstd1 = (float*)(p.ws + WS_RSTD1);
    f32x4 na[4], nb[4];
    if (gw < T) {
#pragma unroll
        for (int j = 0; j < 4; ++j) na[j] = ((const f32x4*)(p.x + (size_t)gw * D) + lane)[64 * j];
    }
    if (gw + NGW < T) {
#pragma unroll
        for (int j = 0; j < 4; ++j) nb[j] = ((const f32x4*)(p.x + (size_t)(gw + NGW) * D) + lane)[64 * j];
    }
    constexpr int I_IN = 16 * 104, I_OUT = 16 * 32;
    for (int it = gw; it < I_IN + I_OUT; it += NGW) {
        int r = it;
        if (r < I_IN) { const int kb = r / 104, nb = r % 104, n0 = nb * 32; p0_transpose_item(p.w_in, D, NIN, kb * 64, n0, win + (size_t)n0 * D, p.norm_mix_g, n0 < 512 ? QSCALE : 1.f, scr, lane); continue; } r -= I_IN;
        { const int kb = r / 32, nb = r % 32, n0 = nb * 32; p0_transpose_item(p.w_out, D, D, kb * 64, n0, wout + (size_t)n0 * D, nullptr, 1.f, scr, lane); }
    }
    bf16_t* wr_hi = (bf16_t*)(p.ws + WS_WR); bf16_t* wr_lo = wr_hi + 48 * D;
    for (int i = blockIdx.x * NTHREADS + tid; i < 48 * D; i += gridDim.x * NTHREADS) {
        const int c = i / D, k = i % D; float w = 0.f;
        if (c < 4) w = p.r_grp_w[k * 4 + c]; else if (c < 36) w = p.r_exp_w[k * 32 + (c - 4)];
        w *= p.norm_ffn_g[k];
        const unsigned hi = cvt_pk_bf16(w, 0.f) & 0xffffu; const float rem = w - __uint_as_float(hi << 16);
        wr_hi[i] = (bf16_t)hi; wr_lo[i] = (bf16_t)(cvt_pk_bf16(rem, 0.f) & 0xffffu);
    }
    { bf16_t* w2t = (bf16_t*)(p.ws + WS_LT); bf16_t* a2t = w2t + 512 * 64; bf16_t* g2t = a2t + 512 * 64;
      for (int i = blockIdx.x * NTHREADS + tid; i < 512 * 256; i += gridDim.x * NTHREADS) {
          if (i < 512 * 64) { const int c = i >> 6, m = i & 63; w2t[i] = (bf16_t)(cvt_pk_bf16(p.rw_w2[m * 512 + c], 0.f) & 0xffffu); }
          else if (i < 2 * 512 * 64) { const int q = i - 512 * 64, c = q >> 6, m = q & 63; a2t[q] = (bf16_t)(cvt_pk_bf16(p.rw_a2[m * 512 + c], 0.f) & 0xffffu); }
          else { const int q = i - 2 * 512 * 64, c = q >> 7, m = q & 127; g2t[q] = (bf16_t)(cvt_pk_bf16(p.rw_g2[m * 512 + c], 0.f) & 0xffffu); } } }
    {
        auto xrow = [&](int row, const f32x4 (&v)[4]) __attribute__((always_inline)) {
            float s = 0.f;
#pragma unroll
            for (int j = 0; j < 4; ++j) s += (v[j].x * v[j].x + v[j].y * v[j].y) + (v[j].z * v[j].z + v[j].w * v[j].w);
            s = wave_sum(s);
            u32x2* o = (u32x2*)(xb + (size_t)row * D) + lane;
#pragma unroll
            for (int j = 0; j < 4; ++j) { u32x2 w; w.x = cvt_pk_bf16(v[j].x, v[j].y); w.y = cvt_pk_bf16(v[j].z, v[j].w); o[64 * j] = w; }
            if (lane == 0) rstd1[row] = 1.0f / sqrtf(s * (1.0f / D) + 1e-6f);
        };
        for (int row = gw; row < T; row += 2 * NGW) {
            f32x4 v[4];
#pragma unroll
            for (int j = 0; j < 4; ++j) v[j] = na[j];
            if (row + 2 * NGW < T) {
#pragma unroll
                for (int j = 0; j < 4; ++j) na[j] = ((const f32x4*)(p.x + (size_t)(row + 2 * NGW) * D) + lane)[64 * j];
            }
            xrow(row, v);
            if (row + NGW < T) {
#pragma unroll
                for (int j = 0; j < 4; ++j) v[j] = nb[j];
                if (row + 3 * NGW < T) {
#pragma unroll
                    for (int j = 0; j < 4; ++j) nb[j] = ((const f32x4*)(p.x + (size_t)(row + 3 * NGW) * D) + lane)[64 * j];
                }
                xrow(row + NGW, v);
            }
        }
    }
    if (blockIdx.x == 0 && tid < 64) ((unsigned*)(p.ws + WS_CTL))[tid] = 0u;
}

struct EpiU {
    bf16_t* u; const float* rstd; int row0, col0; unsigned char* rkv;
    __device__ __forceinline__ void operator()(const f32x4 (&acc)[2][2][4][2], const unsigned (&m0)[8], const unsigned (&m1)[8], int wr, int wc, int fr, int fq, int mh) const {
        const bool isrkv = col0 >= UR && col0 < UXW;
        const int cbase = col0 - UR, mat = cbase >> 9, head0 = (cbase & 511) >> 6;
#pragma unroll
        for (int ai = 0; ai < 2; ++ai) if (mh < 0 || ai == mh)
#pragma unroll
            for (int m = 0; m < 4; ++m) { const int rl = ai * 128 + wr * 64 + m * 16 + fr, row = row0 + rl; const float rs = __uint_as_float(m0[ai * 4 + m]); bf16_t* rp = u + (size_t)row * NIN + col0 + wc * 32 + 8 * fq;
#pragma unroll
                for (int bj = 0; bj < 2; ++bj) { const f32x4 v0 = acc[ai][bj][m][0] * rs, v1 = acc[ai][bj][m][1] * rs;
                    const u32x4 o = (u32x4){cvt_pk_bf16(v0[0], v0[1]), cvt_pk_bf16(v0[2], v0[3]), cvt_pk_bf16(v1[0], v1[1]), cvt_pk_bf16(v1[2], v1[3])};
                    if (isrkv) *(u32x4*)(rkv + (((size_t)(row >> 5) * 3 + mat) * 8 + (head0 + 2 * bj + (wc >> 1))) * 4096 + fq * 1024 + ((wc & 1) * 32 + (row & 31)) * 16) = o;
                    else *(u32x4*)(rp + bj * 128) = o; } }
    }
};
__device__ __forceinline__ void phase1(const Params& p, LAS unsigned char* lds) {
    constexpr int nM = T / 256, nN = NIN / 256;
    g8::UnitIO cur, nxt; g8::aoff_rows(cur.aoff, D);
#pragma unroll
    for (int a = 0; a < 2; ++a)
#pragma unroll
        for (int b = 0; b < 2; ++b) nxt.aoff[a][b] = cur.aoff[a][b];
    cur.meta1 = nullptr; nxt.meta1 = nullptr;
    int pm = 0, pn = 0, L = 0, mh = -1;
    bool have = g8::sched_get(nM * nN, 0, L, mh);
    if (have) { g8::tile_order(L, nM, nN, pm, pn); cur.Ab = (const char*)(p.ws + WS_B) + (size_t)pm * 256 * D * 2; cur.Bb = (const char*)(p.ws + WS_WIN) + (size_t)pn * 256 * D * 2; cur.meta0 = (const unsigned*)(p.ws + WS_RSTD1) + pm * 256; }
    for (int i = 0; have; ++i) {
        int L2 = 0, mh2 = -1, pm2 = 0, pn2 = 0; const bool hn = g8::sched_get(nM * nN, i + 1, L2, mh2);
        if (hn) { g8::tile_order(L2, nM, nN, pm2, pn2); nxt.Ab = (const char*)(p.ws + WS_B) + (size_t)pm2 * 256 * D * 2; nxt.Bb = (const char*)(p.ws + WS_WIN) + (size_t)pn2 * 256 * D * 2; nxt.meta0 = (const unsigned*)(p.ws + WS_RSTD1) + pm2 * 256; }
        EpiU E{(bf16_t*)(p.ws + WS_A), (const float*)(p.ws + WS_RSTD1), pm * 256, pn * 256, (unsigned char*)(p.ws + WS_D)};
        g8::gemm_unit_p<16>(lds, cur, D, E, i & 1, i > 0, hn, nxt, mh);
        cur.Ab = nxt.Ab; cur.Bb = nxt.Bb; cur.meta0 = nxt.meta0; pm = pm2; pn = pn2; mh = mh2; have = hn;
    }
}


typedef short v4i16_t __attribute__((ext_vector_type(4)));
__device__ __forceinline__ s16x4 lds_tr16(const LAS unsigned char* p) { return __builtin_bit_cast(s16x4, __builtin_amdgcn_ds_read_tr16_b64_v4i16((LAS v4i16_t*)p)); }

__device__ __forceinline__ void attn_tile(const Params& p, LAS unsigned char* vl  , int b, int h, int qt) {
    const int lane = threadIdx.x & 63, r32 = lane & 31, hi = lane >> 5;
    const bf16_t* u = (const bf16_t*)(p.ws + WS_A);
    const size_t row0 = (size_t)b * S; const int q0 = qt * 32;
    bf16x8 qf[4];
    { const bf16_t* qp = u + (row0 + q0 + r32) * NIN + UQ + h * HD + 8 * hi;
#pragma unroll
      for (int s = 0; s < 4; ++s) qf[s] = *(const bf16x8*)(qp + 16 * s); }
    f32x16 o0, o1;
#pragma unroll
    for (int i = 0; i < 16; ++i) { o0[i] = 0.f; o1[i] = 0.f; }
    float carry = 0.f;
    const int kperm = 16 * ((r32 >> 2) & 1) + (r32 & 3) + 4 * (r32 >> 3);
    const int g = lane >> 4, i16 = lane & 15, tq = i16 >> 2, tp = i16 & 3;
    const LAS unsigned char* vrd = vl + (16 * (g >> 1) + tq) * 144 + (16 * (g & 1) + 4 * tp) * 2;
    LAS unsigned char* kl = vl + 4608;
    const int lrow = lane >> 3, lchk = lane & 7;
    const bf16_t* kvp = u + (row0 + lrow) * NIN + h * HD + lchk * 8;
    u32x4 kreg[4], vreg[4];
#pragma unroll
    for (int i = 0; i < 4; ++i) { const bf16_t* a = kvp + (size_t)(qt * 32 + 8 * i) * NIN; kreg[i] = *(const u32x4*)(a + UK); vreg[i] = *(const u32x4*)(a + UV); }
    for (int kb = qt; kb >= 0; --kb) {
        const int key0 = kb * 32;
#pragma unroll
        for (int i = 0; i < 4; ++i) { *(LAS u32x4*)(kl + (8 * i + lrow) * 144 + lchk * 16) = kreg[i]; *(LAS u32x4*)(vl + (8 * i + lrow) * 144 + lchk * 16) = vreg[i]; }
        if (kb > 0) {
#pragma unroll
            for (int i = 0; i < 4; ++i) { const bf16_t* a = kvp + (size_t)(key0 - 32 + 8 * i) * NIN; kreg[i] = *(const u32x4*)(a + UK); vreg[i] = *(const u32x4*)(a + UV); }
        }
        LDS_WAIT();
        f32x16 st;
#pragma unroll
        for (int i = 0; i < 16; ++i) st[i] = 0.f;
        { const LAS unsigned char* kp = kl + kperm * 144 + 16 * hi;
          bf16x8 kf[4];
#pragma unroll
          for (int s = 0; s < 4; ++s) kf[s] = *(const LAS bf16x8*)(kp + 32 * s);
#pragma unroll
          for (int s = 0; s < 4; ++s) st = __builtin_amdgcn_mfma_f32_32x32x16_bf16(kf[s], qf[s], st, 0, 0, 0); }
        const bool diag = (kb == qt);
        float lw[16], suf[16];
        float run = 0.f;
#pragma unroll
        for (int reg = 15; reg >= 0; --reg) {
            const float z = st[reg];
            const float l = flog2(1.0f + fexp2(-fabsf(z)));
            const float sp = fmaxf(z, 0.f) + l;
            const bool valid = !diag || (16 * hi + reg < r32);
            lw[reg] = valid ? (z - sp) : -1.0e30f;
            suf[reg] = run;
            run += valid ? -sp : 0.f;
        }
        const float other = swap32(run);
        const float tot_hi = hi ? run : other, tot_lo = hi ? other : run;
        const float base = carry + (hi ? 0.f : tot_hi);
        carry += tot_lo + tot_hi;
        unsigned pk[8];
#pragma unroll
        for (int j = 0; j < 8; ++j) pk[j] = cvt_pk_bf16(fexp2(lw[2 * j] + suf[2 * j] + base), fexp2(lw[2 * j + 1] + suf[2 * j + 1] + base));
        LDS_WAIT();
#pragma unroll
        for (int s2 = 0; s2 < 2; ++s2) {
            bf16x8 pf = __builtin_bit_cast(bf16x8, (u32x4){pk[4 * s2], pk[4 * s2 + 1], pk[4 * s2 + 2], pk[4 * s2 + 3]});
#pragma unroll
            for (int dh = 0; dh < 2; ++dh) {
                const s16x4 a = lds_tr16(vrd + (8 * s2) * 144 + 64 * dh), c = lds_tr16(vrd + (8 * s2 + 4) * 144 + 64 * dh);
                bf16x8 vf; vf[0] = a[0]; vf[1] = a[1]; vf[2] = a[2]; vf[3] = a[3]; vf[4] = c[0]; vf[5] = c[1]; vf[6] = c[2]; vf[7] = c[3];
                if (dh == 0) o0 = __builtin_amdgcn_mfma_f32_32x32x16_bf16(vf, pf, o0, 0, 0, 0); else o1 = __builtin_amdgcn_mfma_f32_32x32x16_bf16(vf, pf, o1, 0, 0, 0);
            }
        }
        LDS_WAIT();
        if (__builtin_amdgcn_ballot_w64(carry > -150.0f) == 0ull) break;
    }
    float ss = 0.f;
#pragma unroll
    for (int i = 0; i < 16; ++i) ss += o0[i] * o0[i] + o1[i] * o1[i];
    ss += swap32(ss);
    const float rs = 1.0f / sqrtf(ss * (1.0f / HD) + 1e-6f);
    bf16_t* op = (bf16_t*)(p.ws + WS_C) + (row0 + q0 + r32) * D + h * HD + 4 * hi;
    const float* gp = p.sb_out_g + h * HD + 4 * hi;
#pragma unroll
    for (int dh = 0; dh < 2; ++dh)
#pragma unroll
        for (int gq = 0; gq < 4; ++gq) {
            const f32x4 gg = *(const f32x4*)(gp + 32 * dh + 8 * gq);
            const f32x16& o = dh ? o1 : o0;
            u32x2 w; w.x = cvt_pk_bf16(o[4 * gq] * rs * gg[0], o[4 * gq + 1] * rs * gg[1]); w.y = cvt_pk_bf16(o[4 * gq + 2] * rs * gg[2], o[4 * gq + 3] * rs * gg[3]);
            *(u32x2*)(op + 32 * dh + 8 * gq) = w;
        }
}

constexpr size_t ACT_OFF = (size_t)64 << 20;
namespace rk {
constexpr int C = 32, NCH = S / C, NSLOT = 8;
constexpr int SL_PS = 0, SL_QS = 8192, SL_PO = 12288, SL_QO = 16384, SL_VR = 18432, SL_BON = 22528, SL_GW = 22784, SLOT_BYTES = 26880;
constexpr int MSTR = 144;
constexpr int PM_AT = 0, PM_RT = 4608, PM_BT = 9216, PM_KT = 13824, PM_GC = 18432, PROD_LDS = 18688;
constexpr int NPROD = 6;
constexpr int L_CONS = NPROD * PROD_LDS;
constexpr int OSTR = 272;
constexpr int L_OBUF = L_CONS + 4608;
constexpr int L_FLAG = L_OBUF + 32 * OSTR;
constexpr int L_W2 = L_FLAG + 256;
constexpr int L_A2 = L_W2 + 8192;
constexpr int L_G2 = L_A2 + 8192;
constexpr int L_CST = L_G2 + 16384;
constexpr int C_MUL = 0, C_MUR = 256, C_MUK = 320, C_MUV = 384, C_W0 = 448, C_A0 = 512, C_KK = 576, C_KA = 640, C_RK = 704, C_LNB = 768, C_END = 832;
static_assert(L_CST + C_END * 4 <= 161792, "rwkv LDS layout overflows");
}
__device__ __forceinline__ bf16x8 accfrag(const f32x16& a, int s) {
    return __builtin_bit_cast(bf16x8, (u32x4){cvt_pk_bf16(a[8 * s], a[8 * s + 1]), cvt_pk_bf16(a[8 * s + 2], a[8 * s + 3]), cvt_pk_bf16(a[8 * s + 4], a[8 * s + 5]), cvt_pk_bf16(a[8 * s + 6], a[8 * s + 7])});
}
__device__ __forceinline__ bf16x8 trfrag(const LAS unsigned char* mat, int s, int nt, int lane) {
    const int g = lane >> 4, i16 = lane & 15, q = i16 >> 2, pp = i16 & 3, h = g >> 1;
    const LAS unsigned char* a = mat + (16 * s + 4 * h + q) * rk::MSTR + (32 * nt + 16 * (g & 1) + 4 * pp) * 2;
    const s16x4 x = lds_tr16(a), y = lds_tr16(a + 8 * rk::MSTR);
    bf16x8 r; r[0] = x[0]; r[1] = x[1]; r[2] = x[2]; r[3] = x[3]; r[4] = y[0]; r[5] = y[1]; r[6] = y[2]; r[7] = y[3]; return r;
}
__device__ __forceinline__ void f8_from_bf16(const u32x4 w, float (&o)[8]) {
#pragma unroll
    for (int j = 0; j < 4; ++j) { o[2 * j] = bf16_lo(w[j]); o[2 * j + 1] = bf16_hi(w[j]); }
}
__device__ __forceinline__ f32x16 mfma32(bf16x8 a, bf16x8 b, f32x16 c) { return __builtin_amdgcn_mfma_f32_32x32x16_bf16(a, b, c, 0, 0, 0); }
__device__ __forceinline__ f32x16 zero16() { f32x16 z; for (int i = 0; i < 16; ++i) z[i] = 0.f; return z; }
__device__ __forceinline__ void um8(const bf16_t* urow  , bool has_prev, const float* mu, float (&o)[8]) {
    const u32x4 c = *(const u32x4*)urow; u32x4 pv = (u32x4){0u, 0u, 0u, 0u}; if (has_prev) pv = *(const u32x4*)(urow - NIN);
    const f32x4 m0 = *(const f32x4*)mu, m1 = *(const f32x4*)(mu + 4);
    float cv[8], pf[8]; f8_from_bf16(c, cv); f8_from_bf16(pv, pf);
#pragma unroll
    for (int j = 0; j < 4; ++j) { o[j] = cv[j] + (pf[j] - cv[j]) * m0[j]; o[4 + j] = cv[4 + j] + (pf[4 + j] - cv[4 + j]) * m1[j]; }
}
__device__ __forceinline__ void lerp8(const u32x4 c, const u32x4 pv, const LAS float* mu, float (&o)[8]) {
    const f32x4 m0 = *(const LAS f32x4*)mu, m1 = *(const LAS f32x4*)(mu + 4);
    float cv[8], pf[8]; f8_from_bf16(c, cv); f8_from_bf16(pv, pf);
#pragma unroll
    for (int j = 0; j < 4; ++j) { o[j] = cv[j] + (pf[j] - cv[j]) * m0[j]; o[4 + j] = cv[4 + j] + (pf[4 + j] - cv[4 + j]) * m1[j]; }
}
__device__ __forceinline__ void lerp8(const u32x4 c, const u32x4 pv, const float* mu, float (&o)[8]) {
    const f32x4 m0 = *(const f32x4*)mu, m1 = *(const f32x4*)(mu + 4);
    float cv[8], pf[8]; f8_from_bf16(c, cv); f8_from_bf16(pv, pf);
#pragma unroll
    for (int j = 0; j < 4; ++j) { o[j] = cv[j] + (pf[j] - cv[j]) * m0[j]; o[4 + j] = cv[4 + j] + (pf[4 + j] - cv[4 + j]) * m1[j]; }
}
__device__ __forceinline__ float shr1(float v) { return __builtin_bit_cast(float, __builtin_amdgcn_update_dpp(0, __builtin_bit_cast(int, v), 0x138, 0xF, 0xF, false)); }
__device__ __forceinline__ u32x4 prev4(const u32x4 c, const u32x4 p, bool first) {
    u32x4 r;
#pragma unroll
    for (int j = 0; j < 4; ++j) { const unsigned sh = (unsigned)__builtin_amdgcn_update_dpp(0, (int)c[j], 0x138, 0xF, 0xF, false); r[j] = first ? p[j] : sh; }
    return r;
}
__device__ __forceinline__ float scan32(float x) {
    x += dppf<0x111>(x); x += dppf<0x112>(x); x += dppf<0x114>(x); x += dppf<0x118>(x);
    const float bc = __builtin_bit_cast(float, __builtin_amdgcn_update_dpp(0, __builtin_bit_cast(int, x), 0x142, 0xA, 0xF, false));
    return x + bc;
}

__device__ __forceinline__ void rk_produce(const Params& p, LAS unsigned char* lds, LAS unsigned char* pl  , unsigned char* slot, int b, int hh, int c, volatile LAS unsigned* rdy_prev, unsigned rdy_val) {
    using namespace rk;
    int lane = threadIdx.x & 63; asm volatile("" : "+v"(lane));
    const int r32 = lane & 31, h = lane >> 5;
    const bf16_t* u = (const bf16_t*)(p.ws + WS_A);
    const size_t row0 = (size_t)b * S; const int t0 = c * C; const int tt = t0 + r32; const bool hp = tt > 0;
    const bf16_t* urow = u + (row0 + tt) * NIN; (void)urow;
    constexpr size_t RKV_CHUNK = (size_t)3 * 8 * 4096;
    const unsigned char* rkvb = (const unsigned char*)(p.ws + WS_D) + (size_t)(b * NCH + c) * RKV_CHUNK + (size_t)hh * 4096;
    const LAS float* cst = (const LAS float*)(lds + L_CST);
    const int jrow0 = 32 * ((r32 >> 2) & 1) + (r32 & 3) + 4 * (r32 >> 3);
    f32x16 lw[2], la[2], lg[2];
#pragma unroll
    for (int mt = 0; mt < 2; ++mt) { lw[mt] = zero16(); la[mt] = zero16(); lg[mt] = zero16(); }
    const int cb = hh * HD + 32 * h;
    u32x4 ck[4], pk4[4], cr[4], pr4[4];
    {
        const unsigned char* act = (const unsigned char*)p.out + ACT_OFF + ((size_t)b * NCH + c) * 16384 + lane * 16;
        u32x4 bw[4], ba[4], bg[8];
#pragma unroll
        for (int s = 0; s < 4; ++s) { bw[s] = *(const u32x4*)(act + s * 1024); ba[s] = *(const u32x4*)(act + (4 + s) * 1024); }
#pragma unroll
        for (int s = 0; s < 8; ++s) bg[s] = *(const u32x4*)(act + (8 + s) * 1024);
#pragma unroll
        for (int q = 0; q < 4; ++q) { ck[q] = *(const u32x4*)(rkvb + (size_t)8 * 4096 + q * 1024 + lane * 16); cr[q] = *(const u32x4*)(rkvb + q * 1024 + lane * 16); }
        asm volatile("s_waitcnt vmcnt(16)" ::: "memory");
        if (rdy_prev && (threadIdx.x & 63) == 0) *rdy_prev = rdy_val;
        {
            bf16x8 fw[2][4];
#pragma unroll
            for (int mt = 0; mt < 2; ++mt)
#pragma unroll
                for (int s = 0; s < 4; ++s) { const int jl = jrow0 + 16 * mt; fw[mt][s] = *(const LAS bf16x8*)(lds + L_W2 + jl * 128 + (((2 * s + h) ^ (jl & 7)) << 4)); }
#pragma unroll
            for (int s = 0; s < 4; ++s)
#pragma unroll
                for (int mt = 0; mt < 2; ++mt) lw[mt] = mfma32(fw[mt][s], __builtin_bit_cast(bf16x8, bw[s]), lw[mt]);
        }
        {
            bf16x8 fa[2][4];
#pragma unroll
            for (int mt = 0; mt < 2; ++mt)
#pragma unroll
                for (int s = 0; s < 4; ++s) { const int jl = jrow0 + 16 * mt; fa[mt][s] = *(const LAS bf16x8*)(lds + L_A2 + jl * 128 + (((2 * s + h) ^ (jl & 7)) << 4)); }
#pragma unroll
            for (int s = 0; s < 4; ++s)
#pragma unroll
                for (int mt = 0; mt < 2; ++mt) la[mt] = mfma32(fa[mt][s], __builtin_bit_cast(bf16x8, ba[s]), la[mt]);
        }
        asm volatile("" ::: "memory");
#pragma unroll
        for (int half = 0; half < 2; ++half) {
            bf16x8 fg[2][4];
#pragma unroll
            for (int mt = 0; mt < 2; ++mt)
#pragma unroll
                for (int s4 = 0; s4 < 4; ++s4) { const int s = 4 * half + s4, jl = jrow0 + 16 * mt; fg[mt][s4] = *(const LAS bf16x8*)(lds + L_G2 + jl * 256 + (((2 * s + h) ^ (jl & 7)) << 4)); }
#pragma unroll
            for (int s4 = 0; s4 < 4; ++s4)
#pragma unroll
                for (int mt = 0; mt < 2; ++mt) lg[mt] = mfma32(fg[mt][s4], __builtin_bit_cast(bf16x8, bg[4 * half + s4]), lg[mt]);
        }
        asm volatile("" ::: "memory");
#pragma unroll
        for (int q = 0; q < 4; ++q) { const unsigned char* a = rkvb + (size_t)8 * 4096 + q * 1024; const unsigned char* bq = rkvb + q * 1024;
            pk4[q] = (u32x4){0u, 0u, 0u, 0u}; pr4[q] = pk4[q];
            if (hp && r32 == 0) { pk4[q] = *(const u32x4*)(a - RKV_CHUNK + (h * 32 + 31) * 16); pr4[q] = *(const u32x4*)(bq - RKV_CHUNK + (h * 32 + 31) * 16); } }
    }
#pragma unroll
    for (int mt = 0; mt < 2; ++mt) {
        u32x4 w0, w1; w0.x = cvt_pk_bf16(lg[mt][0], lg[mt][1]); w0.y = cvt_pk_bf16(lg[mt][2], lg[mt][3]); w0.z = cvt_pk_bf16(lg[mt][4], lg[mt][5]); w0.w = cvt_pk_bf16(lg[mt][6], lg[mt][7]);
        w1.x = cvt_pk_bf16(lg[mt][8], lg[mt][9]); w1.y = cvt_pk_bf16(lg[mt][10], lg[mt][11]); w1.z = cvt_pk_bf16(lg[mt][12], lg[mt][13]); w1.w = cvt_pk_bf16(lg[mt][14], lg[mt][15]);
        *(u32x4*)(slot + SL_GW + (2 * mt) * 1024 + lane * 16) = w0; *(u32x4*)(slot + SL_GW + (2 * mt + 1) * 1024 + lane * 16) = w1;
    }
    asm volatile("" ::: "memory");
    float kl[32];
    float ssq = 0.f;
#pragma unroll
    for (int q = 0; q < 4; ++q) {
        float t8[8]; lerp8(ck[q], prev4(ck[q], pk4[q], r32 == 0), cst + C_MUK + 32 * h + 8 * q, t8);
        const f32x4 c0 = *(const LAS f32x4*)(cst + C_KK + 32 * h + 8 * q), c1 = *(const LAS f32x4*)(cst + C_KK + 32 * h + 8 * q + 4);
#pragma unroll
        for (int j = 0; j < 4; ++j) { const float x0 = t8[j] * c0[j], x1 = t8[4 + j] * c1[j]; ssq += x0 * x0 + x1 * x1; kl[8 * q + j] = t8[j]; kl[8 * q + 4 + j] = t8[4 + j]; }
    }
    ssq += swap32(ssq);
    const float kinv = frsq(fmaxf(ssq, 1e-24f));
    u32x4 cv4[4], pv4[4];
#pragma unroll
    for (int q = 0; q < 4; ++q) { const unsigned char* cq = rkvb + (size_t)2 * 8 * 4096 + q * 1024; cv4[q] = *(const u32x4*)(cq + lane * 16); pv4[q] = (u32x4){0u, 0u, 0u, 0u}; if (hp && r32 == 0) pv4[q] = *(const u32x4*)(cq - RKV_CHUNK + (h * 32 + 31) * 16); }
    f32x2 bonus2 = (f32x2){0.f, 0.f};
    LAS unsigned char* mAT = pl + PM_AT; LAS unsigned char* mRT = pl + PM_RT; LAS unsigned char* mBT = pl + PM_BT; LAS unsigned char* mKT = pl + PM_KT;
    LAS float* gc = (LAS float*)(pl + PM_GC);
#pragma unroll
    for (int mt = 0; mt < 2; ++mt) {
#pragma unroll
        for (int q8 = 0; q8 < 2; ++q8) {
            const int jl0 = 32 * h + 16 * mt + 8 * q8, q = 2 * mt + q8;
            float r8[8];
            lerp8(cr[q], prev4(cr[q], pr4[q], r32 == 0), cst + C_MUR + jl0, r8);
            float cw0[8], ca0[8], ckk[8], cka[8], crk[8];
#pragma unroll
            for (int e = 0; e < 2; ++e) { const f32x4 a = *(const LAS f32x4*)(cst + C_W0 + jl0 + 4 * e), bq = *(const LAS f32x4*)(cst + C_A0 + jl0 + 4 * e), cc = *(const LAS f32x4*)(cst + C_KK + jl0 + 4 * e), dd = *(const LAS f32x4*)(cst + C_KA + jl0 + 4 * e), ee = *(const LAS f32x4*)(cst + C_RK + jl0 + 4 * e);
#pragma unroll
                for (int j = 0; j < 4; ++j) { cw0[4 * e + j] = a[j]; ca0[4 * e + j] = bq[j]; ckk[4 * e + j] = cc[j]; cka[4 * e + j] = dd[j]; crk[4 * e + j] = ee[j]; } }
            float oa[8], orr[8], ob[8], ok[8], eg8[8];
#pragma unroll
            for (int e2 = 0; e2 < 4; ++e2) {
                const int e = 2 * e2, reg = 8 * q8 + e;
                const f32x2 tw = ((f32x2){cw0[e], cw0[e + 1]} + (f32x2){lw[mt][reg], lw[mt][reg + 1]}) * (-LOG2E);
                const f32x2 dw = (f32x2){fexp2(tw.x), fexp2(tw.y)} + 1.0f;
                const f32x2 ld = (f32x2){frcp(dw.x), frcp(dw.y)} * (-0.60653065971263342f);
                const f32x2 ta = ((f32x2){ca0[e], ca0[e + 1]} + (f32x2){la[mt][reg], la[mt][reg + 1]}) * (-LOG2E);
                const f32x2 da = (f32x2){fexp2(ta.x), fexp2(ta.y)} + 1.0f;
                const f32x2 al = (f32x2){frcp(da.x), frcp(da.y)};
                const f32x2 k2 = (f32x2){kl[8 * q + e], kl[8 * q + e + 1]}, r2 = (f32x2){r8[e], r8[e + 1]};
                const f32x2 kk = k2 * (f32x2){ckk[e], ckk[e + 1]} * kinv;
                const f32x2 kmod = k2 * (1.0f + (al - 1.0f) * (f32x2){cka[e], cka[e + 1]});
                const f32x2 bb = kk * al;
                bonus2 += r2 * kmod * (f32x2){crk[e], crk[e + 1]};
                const f32x2 Gl = (f32x2){scan32(ld.x), scan32(ld.y)} * LOG2E;
                const f32x2 eG = (f32x2){fexp2(Gl.x), fexp2(Gl.y)}, eiG = (f32x2){fexp2(-Gl.x), fexp2(-Gl.y)};
                f32x2 eGm = (f32x2){shr1(eG.x), shr1(eG.y)};
                if (r32 == 0) eGm = (f32x2){1.0f, 1.0f};
                const f32x2 va = -kk * eGm, vr = r2 * eG, vb = bb * eiG, vk = kmod * eiG;
                oa[e] = va.x; oa[e + 1] = va.y; orr[e] = vr.x; orr[e + 1] = vr.y; ob[e] = vb.x; ob[e + 1] = vb.y; ok[e] = vk.x; ok[e + 1] = vk.y; eg8[e] = eG.x; eg8[e + 1] = eG.y;
            }
            if (r32 == 31) { *(LAS f32x4*)(gc + jl0) = (f32x4){eg8[0], eg8[1], eg8[2], eg8[3]}; *(LAS f32x4*)(gc + jl0 + 4) = (f32x4){eg8[4], eg8[5], eg8[6], eg8[7]}; }
            const int off = r32 * MSTR + (32 * h + 16 * mt + 8 * q8) * 2;
            *(LAS u32x4*)(mAT + off) = (u32x4){cvt_pk_bf16(oa[0], oa[1]), cvt_pk_bf16(oa[2], oa[3]), cvt_pk_bf16(oa[4], oa[5]), cvt_pk_bf16(oa[6], oa[7])};
            *(LAS u32x4*)(mRT + off) = (u32x4){cvt_pk_bf16(orr[0], orr[1]), cvt_pk_bf16(orr[2], orr[3]), cvt_pk_bf16(orr[4], orr[5]), cvt_pk_bf16(orr[6], orr[7])};
            *(LAS u32x4*)(mBT + off) = (u32x4){cvt_pk_bf16(ob[0], ob[1]), cvt_pk_bf16(ob[2], ob[3]), cvt_pk_bf16(ob[4], ob[5]), cvt_pk_bf16(ob[6], ob[7])};
            *(LAS u32x4*)(mKT + off) = (u32x4){cvt_pk_bf16(ok[0], ok[1]), cvt_pk_bf16(ok[2], ok[3]), cvt_pk_bf16(ok[4], ok[5]), cvt_pk_bf16(ok[6], ok[7])};
            asm volatile("" ::: "memory");
        }
    }
    float bonus = bonus2.x + bonus2.y;
    bonus += swap32(bonus);
#pragma unroll
    for (int q = 0; q < 4; ++q) {
        float v8[8]; lerp8(cv4[q], prev4(cv4[q], pv4[q], r32 == 0), cst + C_MUV + 32 * h + 8 * q, v8);
        *(u32x4*)(slot + SL_VR + q * 1024 + lane * 16) = (u32x4){cvt_pk_bf16(v8[0], v8[1]), cvt_pk_bf16(v8[2], v8[3]), cvt_pk_bf16(v8[4], v8[5]), cvt_pk_bf16(v8[6], v8[7])};
    }
    *(float*)(slot + SL_BON + lane * 4) = bonus;
    LDS_WAIT();
    f32x16 nab = zero16(), nabT = zero16(), nakT = zero16(), mbr = zero16(), mkr = zero16();
#pragma unroll
    for (int s = 0; s < 4; ++s) {
        const int off = r32 * MSTR + (16 * s + 8 * h) * 2;
        const bf16x8 fa = *(const LAS bf16x8*)(mAT + off), fr = *(const LAS bf16x8*)(mRT + off), fb = *(const LAS bf16x8*)(mBT + off), fk = *(const LAS bf16x8*)(mKT + off);
        nab = mfma32(fb, fa, nab); nabT = mfma32(fa, fb, nabT); nakT = mfma32(fa, fk, nakT); mbr = mfma32(fb, fr, mbr); mkr = mfma32(fk, fr, mkr);
    }
#pragma unroll
    for (int reg = 0; reg < 16; ++reg) {
        const int row = (reg & 3) + 8 * (reg >> 2) + 4 * h;
        nab[reg] = row < r32 ? nab[reg] : 0.f;
        nabT[reg] = r32 < row ? nabT[reg] : 0.f;
        nakT[reg] = r32 < row ? nakT[reg] : 0.f;
        mbr[reg] = row <= r32 ? mbr[reg] : 0.f;
        mkr[reg] = row <= r32 ? mkr[reg] : 0.f;
    }
    f32x16 Y = nab;
#pragma unroll
    for (int reg = 0; reg < 16; ++reg) { const int row = (reg & 3) + 8 * (reg >> 2) + 4 * h; if (row == r32) Y[reg] += 1.0f; }
    {
        f32x16 M = nab, MT = nabT;
#pragma unroll
        for (int lvl = 0; lvl < 4; ++lvl) {
            const bf16x8 m0 = accfrag(M, 0), m1 = accfrag(M, 1), t0f = accfrag(MT, 0), t1f = accfrag(MT, 1);
            f32x16 M2T = mfma32(m0, t0f, zero16()); M2T = mfma32(m1, t1f, M2T);
            f32x16 M2 = zero16();
            if (lvl < 3) { M2 = mfma32(t0f, m0, M2); M2 = mfma32(t1f, m1, M2); }
            const bf16x8 y0 = accfrag(Y, 0), y1 = accfrag(Y, 1);
            Y = mfma32(accfrag(M2T, 0), y0, Y); Y = mfma32(accfrag(M2T, 1), y1, Y);
            M = M2; MT = M2T;
        }
    }
    int lane5 = lane; asm volatile("" : "+v"(lane5));
    const int r5 = lane5 & 31, h5 = lane5 >> 5;
    const bf16x8 ty0 = accfrag(Y, 0), ty1 = accfrag(Y, 1);
    f32x16 paT[2];
#pragma unroll
    for (int nt = 0; nt < 2; ++nt) { paT[nt] = mfma32(ty0, trfrag(mAT, 0, nt, lane5), zero16()); paT[nt] = mfma32(ty1, trfrag(mAT, 1, nt, lane5), paT[nt]); }
    f32x16 qakT = mfma32(ty0, accfrag(nakT, 0), zero16()); qakT = mfma32(ty1, accfrag(nakT, 1), qakT);
    const bf16x8 mb0 = accfrag(mbr, 0), mb1 = accfrag(mbr, 1);
#pragma unroll
    for (int mt = 0; mt < 2; ++mt) {
        f32x16 po;
#pragma unroll
        for (int g = 0; g < 4; ++g) { const u32x2 w = *(const LAS u32x2*)(mRT + r5 * MSTR + (32 * mt + 8 * g + 4 * h5) * 2);
            po[4 * g] = bf16_lo(w.x); po[4 * g + 1] = bf16_hi(w.x); po[4 * g + 2] = bf16_lo(w.y); po[4 * g + 3] = bf16_hi(w.y); }
        po = mfma32(accfrag(paT[mt], 0), mb0, po); po = mfma32(accfrag(paT[mt], 1), mb1, po);
#pragma unroll
        for (int sp = 0; sp < 2; ++sp)
            *(u32x4*)(slot + SL_PO + (2 * mt + sp) * 1024 + lane5 * 16) = (u32x4){cvt_pk_bf16(po[8 * sp], po[8 * sp + 1]), cvt_pk_bf16(po[8 * sp + 2], po[8 * sp + 3]), cvt_pk_bf16(po[8 * sp + 4], po[8 * sp + 5]), cvt_pk_bf16(po[8 * sp + 6], po[8 * sp + 7])};
    }
    {
        f32x16 qo = mfma32(accfrag(qakT, 0), mb0, mkr); qo = mfma32(accfrag(qakT, 1), mb1, qo);
#pragma unroll
        for (int sp = 0; sp < 2; ++sp) *(u32x4*)(slot + SL_QO + sp * 1024 + lane5 * 16) = (u32x4){cvt_pk_bf16(qo[8 * sp], qo[8 * sp + 1]), cvt_pk_bf16(qo[8 * sp + 2], qo[8 * sp + 3]), cvt_pk_bf16(qo[8 * sp + 4], qo[8 * sp + 5]), cvt_pk_bf16(qo[8 * sp + 6], qo[8 * sp + 7])};
    }
#pragma unroll
    for (int nt = 0; nt < 2; ++nt) {
        const bf16x8 bt0 = trfrag(mBT, 0, nt, lane5), bt1 = trfrag(mBT, 1, nt, lane5);
        const float gam = gc[32 * nt + r5];
#pragma unroll
        for (int mt = 0; mt < 2; ++mt) {
            f32x16 ps = zero16();
            if (mt == nt) {
#pragma unroll
                for (int reg = 0; reg < 16; ++reg) { const int row = (reg & 3) + 8 * (reg >> 2) + 4 * h5; ps[reg] = (row == r5) ? 1.0f : 0.f; }
            }
            ps = mfma32(accfrag(paT[mt], 0), bt0, ps); ps = mfma32(accfrag(paT[mt], 1), bt1, ps);
#pragma unroll
            for (int sp = 0; sp < 2; ++sp)
                *(u32x4*)(slot + SL_PS + ((nt * 2 + mt) * 2 + sp) * 1024 + lane5 * 16) = (u32x4){cvt_pk_bf16(ps[8 * sp] * gam, ps[8 * sp + 1] * gam), cvt_pk_bf16(ps[8 * sp + 2] * gam, ps[8 * sp + 3] * gam), cvt_pk_bf16(ps[8 * sp + 4] * gam, ps[8 * sp + 5] * gam), cvt_pk_bf16(ps[8 * sp + 6] * gam, ps[8 * sp + 7] * gam)};
        }
        f32x16 qs;
        { const bf16x8 k0 = trfrag(mKT, 0, nt, lane5), k1 = trfrag(mKT, 1, nt, lane5);
          const u32x4 w0 = __builtin_bit_cast(u32x4, k0), w1 = __builtin_bit_cast(u32x4, k1);
#pragma unroll
          for (int j = 0; j < 4; ++j) { qs[2 * j] = bf16_lo(w0[j]); qs[2 * j + 1] = bf16_hi(w0[j]); qs[8 + 2 * j] = bf16_lo(w1[j]); qs[8 + 2 * j + 1] = bf16_hi(w1[j]); } }
        qs = mfma32(accfrag(qakT, 0), bt0, qs); qs = mfma32(accfrag(qakT, 1), bt1, qs);
#pragma unroll
        for (int sp = 0; sp < 2; ++sp) *(u32x4*)(slot + SL_QS + (nt * 2 + sp) * 1024 + lane5 * 16) = (u32x4){cvt_pk_bf16(qs[8 * sp] * gam, qs[8 * sp + 1] * gam), cvt_pk_bf16(qs[8 * sp + 2] * gam, qs[8 * sp + 3] * gam), cvt_pk_bf16(qs[8 * sp + 4] * gam, qs[8 * sp + 5] * gam), cvt_pk_bf16(qs[8 * sp + 6] * gam, qs[8 * sp + 7] * gam)};
    }
    LDS_WAIT();
}

__device__ __forceinline__ u32x4 ntload16(const void* ptr) { return __builtin_nontemporal_load((const u32x4*)ptr); }
struct RkOps { u32x4 vr[4]; bf16x8 fps[2][2][2], fqs[2][2], fpo[2][2], fqo[2]; };
__device__ __forceinline__ void rk_load_ops_a(RkOps& o, const unsigned char* slot, int lane) {
    using namespace rk;
    const int r32 = lane & 31, h = lane >> 5;
#pragma unroll
    for (int k = 0; k < 4; ++k) o.vr[k] = ntload16(slot + SL_VR + k * 1024 + lane * 16);
#pragma unroll
    for (int jt = 0; jt < 2; ++jt)
#pragma unroll
        for (int s = 0; s < 2; ++s) o.fpo[jt][s] = __builtin_bit_cast(bf16x8, ntload16(slot + SL_PO + (2 * jt + s) * 1024 + lane * 16));
#pragma unroll
    for (int s = 0; s < 2; ++s) o.fqo[s] = __builtin_bit_cast(bf16x8, ntload16(slot + SL_QO + s * 1024 + lane * 16));
}
__device__ __forceinline__ void rk_load_ops_b(RkOps& o, const unsigned char* slot, int lane) {
    using namespace rk;
    const int r32 = lane & 31, h = lane >> 5;
#pragma unroll
    for (int mt = 0; mt < 2; ++mt) {
#pragma unroll
        for (int jt = 0; jt < 2; ++jt)
#pragma unroll
            for (int s = 0; s < 2; ++s) o.fps[mt][jt][s] = __builtin_bit_cast(bf16x8, ntload16(slot + SL_PS + ((mt * 2 + jt) * 2 + s) * 1024 + lane * 16));
#pragma unroll
        for (int s = 0; s < 2; ++s) o.fqs[mt][s] = __builtin_bit_cast(bf16x8, ntload16(slot + SL_QS + (mt * 2 + s) * 1024 + lane * 16));
    }
}
#define RK_SPIN(cond) do { unsigned _sp = 0; while (cond) { __builtin_amdgcn_s_sleep(1); if (++_sp > (1u << 24)) { err[0] = 1u; break; } } asm volatile("" ::: "memory"); } while (0)

__device__ __forceinline__ void rwkv_chain(const Params& p, LAS unsigned char* lds, int b, int hh) {
    using namespace rk;
    int tid = threadIdx.x; asm volatile("" : "+v"(tid));
    volatile LAS unsigned* ready = (volatile LAS unsigned*)(lds + L_FLAG); volatile LAS unsigned* freed = ready + NSLOT; volatile LAS unsigned* ofull = freed + NSLOT; volatile LAS unsigned* ofree = ofull + 2; volatile LAS unsigned* err = ofree + 2; LAS unsigned* nextc = (LAS unsigned*)(err + 1);
    if (tid < 2 * NSLOT + 6) ready[tid] = 0u;
    {
        const bf16_t* w2t = (const bf16_t*)(p.ws + WS_LT); const bf16_t* a2t = w2t + 512 * 64; const bf16_t* g2t = a2t + 512 * 64;
        for (int i = tid; i < 64 * 8; i += NTHREADS) { const int j = i >> 3, ch = i & 7, d = j * 128 + ((ch ^ (j & 7)) << 4);
            *(LAS u32x4*)(lds + L_W2 + d) = *(const u32x4*)(w2t + (hh * HD + j) * 64 + 8 * ch); *(LAS u32x4*)(lds + L_A2 + d) = *(const u32x4*)(a2t + (hh * HD + j) * 64 + 8 * ch); }
        for (int i = tid; i < 64 * 16; i += NTHREADS) { const int j = i >> 4, ch = i & 15; *(LAS u32x4*)(lds + L_G2 + j * 256 + ((ch ^ (j & 7)) << 4)) = *(const u32x4*)(g2t + (hh * HD + j) * 128 + 8 * ch); }
        LAS float* cst = (LAS float*)(lds + L_CST);
        for (int i = tid; i < C_END; i += NTHREADS) { float v;
            if (i < 256) v = p.shift_mu[(UXW - UR) + i];
            else if (i < 320) v = p.shift_mu[hh * HD + (i - 256)];
            else if (i < 384) v = p.shift_mu[(URK - UR) + hh * HD + (i - 320)];
            else if (i < 448) v = p.shift_mu[(URV - UR) + hh * HD + (i - 384)];
            else if (i < 512) v = p.rw_w0[hh * HD + (i - 448)];
            else if (i < 576) v = p.rw_a0[hh * HD + (i - 512)];
            else if (i < 640) v = p.rw_k_k[hh * HD + (i - 576)];
            else if (i < 704) v = p.rw_k_a[hh * HD + (i - 640)];
            else if (i < 768) v = p.rw_r_k[hh * HD + (i - 704)];
            else v = p.rw_ln_b[hh * HD + (i - 768)];
            cst[i] = v; }
    }
    __syncthreads();
    asm volatile("" : "+v"(tid));
    const int wave = __builtin_amdgcn_readfirstlane(tid >> 6);
    unsigned char* ring = (unsigned char*)p.out + (size_t)(b * NH + hh) * NSLOT * SLOT_BYTES;
    if (wave == 0) {
        int lane = tid & 63; asm volatile("" : "+v"(lane));
        const int r32 = lane & 31, h = lane >> 5;
        LAS unsigned char* vs = lds + L_CONS;
        f32x16 st[2][2];
#pragma unroll
        for (int a = 0; a < 2; ++a)
#pragma unroll
            for (int d = 0; d < 2; ++d) st[a][d] = zero16();
        RkOps ops;
        RK_SPIN(ready[0] != 1u);
        rk_load_ops_a(ops, ring, lane); rk_load_ops_b(ops, ring, lane);
        for (int c = 0; c < NCH; ++c) {
            bf16x8 sf[2][2][2];
#pragma unroll
            for (int jt = 0; jt < 2; ++jt)
#pragma unroll
                for (int it = 0; it < 2; ++it) { sf[jt][it][0] = accfrag(st[jt][it], 0); sf[jt][it][1] = accfrag(st[jt][it], 1); }
            { LAS unsigned char* d = vs + r32 * MSTR + h * 64;
              *(LAS u32x4*)d = ops.vr[0]; *(LAS u32x4*)(d + 16) = ops.vr[1]; *(LAS u32x4*)(d + 32) = ops.vr[2]; *(LAS u32x4*)(d + 48) = ops.vr[3]; }
            LDS_WAIT();
            bf16x8 vf[2][2];
            { const int g = lane >> 4, i16 = lane & 15, q = i16 >> 2, pp = i16 & 3;
#pragma unroll
              for (int it = 0; it < 2; ++it)
#pragma unroll
                  for (int s = 0; s < 2; ++s) { const LAS unsigned char* a = vs + (16 * s + 4 * h + q) * MSTR + (32 * it + 16 * (g & 1) + 4 * pp) * 2;
                      const s16x4 x = lds_tr16(a), y = lds_tr16(a + 8 * MSTR);
                      bf16x8 r; r[0] = x[0]; r[1] = x[1]; r[2] = x[2]; r[3] = x[3]; r[4] = y[0]; r[5] = y[1]; r[6] = y[2]; r[7] = y[3]; vf[it][s] = r; } }
            f32x16 o[2];
#pragma unroll
            for (int it = 0; it < 2; ++it) {
                o[it] = zero16();
#pragma unroll
                for (int jt = 0; jt < 2; ++jt)
#pragma unroll
                    for (int s = 0; s < 2; ++s) o[it] = mfma32(sf[jt][it][s], ops.fpo[jt][s], o[it]);
#pragma unroll
                for (int s = 0; s < 2; ++s) o[it] = mfma32(vf[it][s], ops.fqo[s], o[it]);
            }
            const unsigned char* nslot = ring + (size_t)((c + 1) % NSLOT) * SLOT_BYTES;
            if (c + 1 < NCH) { RK_SPIN(ready[(c + 1) % NSLOT] != (unsigned)(c + 2)); rk_load_ops_a(ops, nslot, lane); }
#pragma unroll
            for (int mt = 0; mt < 2; ++mt)
#pragma unroll
                for (int it = 0; it < 2; ++it) {
                    f32x16 a = zero16();
#pragma unroll
                    for (int jt = 0; jt < 2; ++jt)
#pragma unroll
                        for (int s = 0; s < 2; ++s) a = mfma32(ops.fps[mt][jt][s], sf[jt][it][s], a);
#pragma unroll
                    for (int s = 0; s < 2; ++s) a = mfma32(ops.fqs[mt][s], vf[it][s], a);
                    st[mt][it] = a;
                }
            if (c + 1 < NCH) rk_load_ops_b(ops, nslot, lane);
            if (c >= 1) RK_SPIN(ofree[0] != (unsigned)c);
            { LAS unsigned char* ob = lds + L_OBUF + r32 * OSTR;
#pragma unroll
              for (int it = 0; it < 2; ++it)
#pragma unroll
                  for (int g = 0; g < 4; ++g) *(LAS f32x4*)(ob + (32 * it + 8 * g + 4 * h) * 4) = (f32x4){o[it][4 * g], o[it][4 * g + 1], o[it][4 * g + 2], o[it][4 * g + 3]}; }
            LDS_WAIT();
            if (lane == 0) ofull[0] = (unsigned)(c + 1);
        }
    } else if (wave == 1) {
        int lane = tid & 63; asm volatile("" : "+v"(lane));
        const int r32 = lane & 31, h = lane >> 5;
        u32x4 gw[4], gb[4]; float bon;
        float lnw[32], lnb[32];
#pragma unroll
        for (int k = 0; k < 8; ++k) { const f32x4 l = *(const f32x4*)(p.rw_ln_w + hh * HD + 32 * h + 4 * k); lnw[4 * k] = l[0]; lnw[4 * k + 1] = l[1]; lnw[4 * k + 2] = l[2]; lnw[4 * k + 3] = l[3];
            const f32x4 lb = *(const f32x4*)(p.rw_ln_b + hh * HD + 32 * h + 4 * k); lnb[4 * k] = lb[0]; lnb[4 * k + 1] = lb[1]; lnb[4 * k + 2] = lb[2]; lnb[4 * k + 3] = lb[3]; }
        RK_SPIN(ready[0] != 1u);
#pragma unroll
        for (int k = 0; k < 4; ++k) { gw[k] = ntload16(ring + SL_GW + k * 1024 + lane * 16); gb[k] = ntload16(ring + SL_VR + k * 1024 + lane * 16); }
        bon = __builtin_nontemporal_load((const float*)(ring + SL_BON + lane * 4));
        for (int c = 0; c < NCH; ++c) {
            const int sl = c % NSLOT;
            RK_SPIN(ofull[0] != (unsigned)(c + 1));
            float ov[32];
            { const LAS unsigned char* ob = lds + L_OBUF + r32 * OSTR + 128 * h;
#pragma unroll
              for (int k = 0; k < 8; ++k) { const f32x4 x = *(const LAS f32x4*)(ob + 16 * k); ov[4 * k] = x[0]; ov[4 * k + 1] = x[1]; ov[4 * k + 2] = x[2]; ov[4 * k + 3] = x[3]; } }
            LDS_WAIT();
            if (lane == 0) ofree[0] = (unsigned)(c + 1);
            float sm = 0.f;
#pragma unroll
            for (int k = 0; k < 32; ++k) sm += ov[k];
            sm += swap32(sm);
            const float mean = sm * (1.0f / 64.0f);
            float sv = 0.f;
#pragma unroll
            for (int k = 0; k < 32; ++k) { const float d = ov[k] - mean; sv += d * d; }
            sv += swap32(sv);
            const float rstd = 1.0f / sqrtf(sv * (1.0f / 64.0f) + 64e-5f);
            bf16_t* mrow = (bf16_t*)(p.ws + WS_C) + ((size_t)b * S + c * C + r32) * D + 512 + hh * HD + 32 * h;
#pragma unroll
            for (int k = 0; k < 4; ++k) {
                float w8[8], b8[8], r[8]; f8_from_bf16(gw[k], w8); f8_from_bf16(gb[k], b8);
#pragma unroll
                for (int e = 0; e < 8; ++e) r[e] = ((ov[8 * k + e] - mean) * rstd * lnw[8 * k + e] + (lnb[8 * k + e] + bon * b8[e])) * w8[e];
                *(u32x4*)(mrow + 8 * k) = (u32x4){cvt_pk_bf16(r[0], r[1]), cvt_pk_bf16(r[2], r[3]), cvt_pk_bf16(r[4], r[5]), cvt_pk_bf16(r[6], r[7])};
            }
            if (lane == 0) freed[sl] = (unsigned)(c + 1);
            if (c + 1 < NCH) { const int sn = (c + 1) % NSLOT; const unsigned char* sp_ = ring + (size_t)sn * SLOT_BYTES; RK_SPIN(ready[sn] != (unsigned)(c + 2));
#pragma unroll
                for (int k = 0; k < 4; ++k) { gw[k] = ntload16(sp_ + SL_GW + k * 1024 + lane * 16); gb[k] = ntload16(sp_ + SL_VR + k * 1024 + lane * 16); }
                bon = __builtin_nontemporal_load((const float*)(sp_ + SL_BON + lane * 4)); }
        }
    } else {
        int lane = tid & 63;
        if (wave - 2 < NPROD) {
            int pc = -1;
            for (;;) {
                int c = 0; if (lane == 0) c = (int)atomicAdd((unsigned*)nextc, 1u);
                c = __builtin_amdgcn_readfirstlane(c);
                if (c >= NCH) break;
                const int sl = c % NSLOT;
                if (c >= NSLOT && freed[sl] != (unsigned)(c - NSLOT + 1)) {
                    if (pc >= 0) { asm volatile("s_waitcnt vmcnt(0)" ::: "memory"); if (lane == 0) ready[pc % NSLOT] = (unsigned)(pc + 1); pc = -1; }
                    RK_SPIN(freed[sl] != (unsigned)(c - NSLOT + 1));
                }
                rk_produce(p, lds, lds + (wave - 2) * PROD_LDS, ring + (size_t)sl * SLOT_BYTES, b, hh, c, pc >= 0 ? ready + (pc % NSLOT) : nullptr, (unsigned)(pc + 1));
                pc = c;
            }
            asm volatile("s_waitcnt vmcnt(0)" ::: "memory");
            if (pc >= 0 && lane == 0) ready[pc % NSLOT] = (unsigned)(pc + 1);
        }
    }
    __syncthreads();
}


__device__ __forceinline__ void phase2a(const Params& p) {
    int tid = threadIdx.x; asm volatile("" : "+v"(tid));
    const int wave = tid >> 6, lane = tid & 63, t8 = lane & 7, pl = lane >> 3;
    const bf16_t* u = (const bf16_t*)(p.ws + WS_A);
    unsigned char* act = (unsigned char*)p.out + ACT_OFF;
    const int ngrp = T / 8, stride = gridDim.x * NWAVES;
    for (int grp = blockIdx.x * NWAVES + wave; grp < ngrp; grp += stride) {
        const int row = grp * 8 + t8; const bool hp = (row & (S - 1)) != 0;
        const bf16_t* a = u + (size_t)row * NIN + UXW + 8 * pl;
        u32x4 c[4], pv[4];
#pragma unroll
        for (int it = 0; it < 4; ++it) { c[it] = *(const u32x4*)(a + 64 * it); pv[it] = (u32x4){0u, 0u, 0u, 0u}; if (hp) pv[it] = *(const u32x4*)(a + 64 * it - NIN); }
#pragma unroll
        for (int it = 0; it < 4; ++it) {
            const int pc = 8 * it + pl;
            float x[8]; lerp8(c[it], pv[it], p.shift_mu + (UXW - UR) + 8 * pc, x);
#pragma unroll
            for (int j = 0; j < 8; ++j) {
                if (it == 0) x[j] = 1.0f - 2.0f * frcp(1.0f + fexp2(x[j] * (2.0f * LOG2E)));
                else if (it >= 2) x[j] = frcp(1.0f + fexp2(-x[j] * LOG2E)); }
            *(u32x4*)(act + (size_t)(row >> 5) * 16384 + (pc >> 1) * 1024 + ((pc & 1) * 32 + (row & 31)) * 16) = (u32x4){cvt_pk_bf16(x[0], x[1]), cvt_pk_bf16(x[2], x[3]), cvt_pk_bf16(x[4], x[5]), cvt_pk_bf16(x[6], x[7])};
        }
    }
}

__device__ __forceinline__ void phase2(const Params& p, LAS unsigned char* lds) {
    const int nchain = NB * NH, G = gridDim.x, wave = threadIdx.x >> 6;
    const int nscan = G >= 2 * nchain ? nchain : (G > 1 ? G / 2 : 0);
    const bool ilv = (G == 256 && nscan == 128);
    const int slot_ = blockIdx.x >> 3, vidx = ilv ? ((slot_ >> 1) * 8 + (blockIdx.x & 7)) + ((slot_ & 1) ? nscan : 0) : (int)blockIdx.x;
    if (vidx < nscan || nscan == 0) {
        const int stride = nscan == 0 ? G : nscan;
        for (int it = vidx; it < nchain; it += stride) {
            int cb = it / NH, ch = it % NH;
            rwkv_chain(p, lds, cb, ch);
        }
    }
    if (vidx >= nscan) {
        const int nb = G - nscan, bi = vidx - nscan;
        if (nb * 8 == 1024 && NB * NH * 64 == 8192) {
            const int li = (bi & 7) * (nb >> 3) + (bi >> 3), w = li * 8 + wave;
            for (int k = 0; k < 8; ++k) { const int bh = (w >> 6) * 8 + k, pos = ((w & 63) + 8 * k) & 63; attn_tile(p, lds + wave * 9216, bh / NH, bh % NH, pos); }
        } else
            for (int it = bi * 8 + wave; it < NB * NH * 64; it += nb * 8) attn_tile(p, lds + wave * 9216, it / (NH * 64), (it / 64) % NH, 63 - (it % 64));
        __syncthreads();
        p0_expert_weights(p, lds, bi * 8 + wave, nb * 8);
    }
}

struct EpiH {
    const bf16_t* xb; bf16_t* hb; int row0, col0;
    __device__ __forceinline__ void operator()(const f32x4 (&acc)[2][2][4][2], const unsigned (&m0)[8], const unsigned (&m1)[8], int wr, int wc, int fr, int fq, int mh) const {
#pragma unroll
        for (int ai = 0; ai < 2; ++ai) if (mh < 0 || ai == mh) {
            u32x4 xv[4][2];
#pragma unroll
            for (int m = 0; m < 4; ++m) { const size_t off = (size_t)(row0 + ai * 128 + wr * 64 + m * 16 + fr) * D + col0 + wc * 32 + 8 * fq;
#pragma unroll
                for (int bj = 0; bj < 2; ++bj) xv[m][bj] = *(const u32x4*)(xb + off + bj * 128); }
#pragma unroll
            for (int m = 0; m < 4; ++m) { const size_t off = (size_t)(row0 + ai * 128 + wr * 64 + m * 16 + fr) * D + col0 + wc * 32 + 8 * fq;
#pragma unroll
                for (int bj = 0; bj < 2; ++bj) { const u32x4 w = xv[m][bj];
                    const f32x4 v0 = (f32x4){bf16_lo(w.x), bf16_hi(w.x), bf16_lo(w.y), bf16_hi(w.y)} + acc[ai][bj][m][0], v1 = (f32x4){bf16_lo(w.z), bf16_hi(w.z), bf16_lo(w.w), bf16_hi(w.w)} + acc[ai][bj][m][1];
                    *(u32x4*)(hb + off + bj * 128) = (u32x4){cvt_pk_bf16(v0[0], v0[1]), cvt_pk_bf16(v0[2], v0[3]), cvt_pk_bf16(v1[0], v1[1]), cvt_pk_bf16(v1[2], v1[3])}; } }
            asm volatile("" ::: "memory");
        }
    }
};
__device__ __forceinline__ void phase3(const Params& p, LAS unsigned char* lds) {
    constexpr int nM = T / 256, nN = D / 256;
    g8::UnitIO cur, nxt; g8::aoff_rows(cur.aoff, D);
#pragma unroll
    for (int a = 0; a < 2; ++a)
#pragma unroll
        for (int b = 0; b < 2; ++b) nxt.aoff[a][b] = cur.aoff[a][b];
    cur.meta0 = nullptr; cur.meta1 = nullptr; nxt.meta0 = nullptr; nxt.meta1 = nullptr;
    int pm = 0, pn = 0; int L = blockIdx.x;
    if (L < nM * nN) { g8::tile_order(L, nM, nN, pm, pn); cur.Ab = (const char*)(p.ws + WS_C) + (size_t)pm * 256 * D * 2; cur.Bb = (const char*)(p.ws + WS_WOUT) + (size_t)pn * 256 * D * 2; }
    for (int i = 0; L < nM * nN; L += gridDim.x, ++i) {
        const bool hn = L + (int)gridDim.x < nM * nN; int pm2 = 0, pn2 = 0;
        if (hn) { g8::tile_order(L + gridDim.x, nM, nN, pm2, pn2); nxt.Ab = (const char*)(p.ws + WS_C) + (size_t)pm2 * 256 * D * 2; nxt.Bb = (const char*)(p.ws + WS_WOUT) + (size_t)pn2 * 256 * D * 2; }
        EpiH E{(const bf16_t*)(p.ws + WS_B), (bf16_t*)(p.ws + WS_A), pm * 256, pn * 256};
        g8::gemm_unit_p<16>(lds, cur, D, E, i & 1, i > 0, hn, nxt);
        cur.Ab = nxt.Ab; cur.Bb = nxt.Bb; pm = pm2; pn = pn2;
    }
}

__device__ __forceinline__ void phase4(const Params& p, LAS unsigned char* lds) {
    int tid = threadIdx.x; asm volatile("" : "+v"(tid));
    const int wave = tid >> 6, lane = tid & 63, fr = lane & 15, fq = lane >> 4;
    const float* hsrc = p.out; bf16_t* hb = (bf16_t*)(p.ws + WS_A); float* rstd2 = (float*)(p.ws + WS_RSTD2);
    const bf16_t* wr_hi = (const bf16_t*)(p.ws + WS_WR); const bf16_t* wr_lo = wr_hi + 48 * D;
    int* list = (int*)(p.ws + WS_LIST); float* listw = (float*)(p.ws + WS_LISTW); float* listr = (float*)(p.ws + WS_LISTR); unsigned* cnt = (unsigned*)(p.ws + WS_CTL);
    LAS float* lg = (LAS float*)(lds + wave * 3072);
    LAS unsigned* lcnt = (LAS unsigned*)(lds + 8 * 3072);
    LAS unsigned* gbase = lcnt + 32;
    for (int blk = blockIdx.x; blk < T / 128; blk += gridDim.x) {
        if (tid < 32) lcnt[tid] = 0u;
        __syncthreads();
        const int tok0 = blk * 128 + wave * 16;
        f32x4 acc[3];
#pragma unroll
        for (int n = 0; n < 3; ++n) acc[n] = (f32x4){0.f, 0.f, 0.f, 0.f};
        float ss = 0.f;
        const bf16_t* hbp = hb + (size_t)(tok0 + fr) * D + 8 * fq;
        LAS unsigned char* wl_ = lds + 32768;
#pragma unroll 1
        for (int half = 0; half < 2; ++half) {
            __syncthreads();
            for (int i = tid; i < 2 * 48 * 64; i += NTHREADS) { const int mat = i / 3072, r = (i % 3072) >> 6, ch = i & 63;
                *(LAS u32x4*)(wl_ + mat * 49152 + r * 1024 + ((ch ^ (r & 15)) << 4)) = *(const u32x4*)((mat ? wr_lo : wr_hi) + (size_t)r * D + half * 512 + ch * 8); }
            u32x4 av[16];
#pragma unroll
            for (int ks = 0; ks < 16; ++ks) av[ks] = *(const u32x4*)(hbp + half * 512 + 32 * ks);
            __syncthreads();
#pragma unroll
            for (int ks = 0; ks < 16; ++ks) {
                float f[8]; f8_from_bf16(av[ks], f);
                ss += (f[0] * f[0] + f[1] * f[1]) + (f[2] * f[2] + f[3] * f[3]) + ((f[4] * f[4] + f[5] * f[5]) + (f[6] * f[6] + f[7] * f[7]));
                const bf16x8 ah = __builtin_bit_cast(bf16x8, av[ks]);
#pragma unroll
                for (int n = 0; n < 3; ++n) {
                    const int r = 16 * n + fr, off = r * 1024 + (((4 * ks + fq) ^ (r & 15)) << 4);
                    const bf16x8 wh = *(const LAS bf16x8*)(wl_ + off), wl = *(const LAS bf16x8*)(wl_ + 49152 + off);
                    acc[n] = __builtin_amdgcn_mfma_f32_16x16x32_bf16(ah, wh, acc[n], 0, 0, 0);
                    acc[n] = __builtin_amdgcn_mfma_f32_16x16x32_bf16(ah, wl, acc[n], 0, 0, 0);
                }
            }
        }
        ss += __shfl_xor(ss, 16); ss += __shfl_xor(ss, 32);
        const float rs = 1.0f / sqrtf(ss * (1.0f / D) + 1e-6f);
        if (fq == 0) rstd2[tok0 + fr] = rs;
#pragma unroll
        for (int n = 0; n < 3; ++n)
#pragma unroll
            for (int r = 0; r < 4; ++r) lg[(4 * fq + r) * 48 + 16 * n + fr] = acc[n][r];
        LDS_WAIT();
        int e0 = 0, e1 = 0; float w0 = 0.f, w1 = 0.f; unsigned lp0 = 0, lp1 = 0;
        if (lane < 16) {
            const float rst = rs;
            const LAS float* L = lg + lane * 48;
            float gl[4]; int gi = 0; float gm;
#pragma unroll
            for (int g = 0; g < 4; ++g) gl[g] = L[g] * rst + p.r_grp_b[g];
            gm = gl[0];
#pragma unroll
            for (int g = 1; g < 4; ++g) if (gl[g] > gm) { gm = gl[g]; gi = g; }
            float gs = 0.f;
#pragma unroll
            for (int g = 0; g < 4; ++g) gs += __expf(gl[g] - gm);
            const float gval = 1.0f / gs;
            float el[8];
#pragma unroll
            for (int e = 0; e < 8; ++e) el[e] = L[4 + gi * 8 + e] * rst + p.r_exp_b[gi * 8 + e];
            int i0 = 0; float m0 = el[0];
#pragma unroll
            for (int e = 1; e < 8; ++e) if (el[e] > m0) { m0 = el[e]; i0 = e; }
            int i1 = i0 == 0 ? 1 : 0; float m1 = el[i1];
#pragma unroll
            for (int e = 0; e < 8; ++e) if (e != i0 && el[e] > m1) { m1 = el[e]; i1 = e; }
            const float x1 = __expf(m1 - m0); const float den = 1.0f / (1.0f + x1);
            e0 = gi * 8 + i0; e1 = gi * 8 + i1; w0 = gval * den; w1 = gval * x1 * den;
            lp0 = atomicAdd((unsigned*)&lcnt[e0], 1u); lp1 = atomicAdd((unsigned*)&lcnt[e1], 1u);
        }
        __syncthreads();
        if (tid < 32) gbase[tid] = atomicAdd(&cnt[tid], lcnt[tid]);
        __syncthreads();
        if (lane < 16) {
            const int tok = tok0 + lane;
            const unsigned q0 = gbase[e0] + lp0, q1 = gbase[e1] + lp1;
            list[(size_t)e0 * T + q0] = tok * 2;     listw[(size_t)e0 * T + q0] = w0; listr[(size_t)e0 * T + q0] = rs;
            list[(size_t)e1 * T + q1] = tok * 2 + 1; listw[(size_t)e1 * T + q1] = w1; listr[(size_t)e1 * T + q1] = rs;
        }
        __syncthreads();
    }
}

constexpr int LDS_MAP = 161792;
__device__ __forceinline__ void expert_map_build(const unsigned* cnt, LAS unsigned char* lds) {
    LAS int* pre = (LAS int*)(lds + LDS_MAP); LAS int* cn = pre + 40;
    if (threadIdx.x == 0) { int acc = 0; for (int i = 0; i < NE; ++i) { const int ci = (int)__hip_atomic_load(cnt + i, __ATOMIC_RELAXED, __HIP_MEMORY_SCOPE_AGENT); pre[i] = acc; cn[i] = ci; acc += (ci + 255) >> 8; } pre[NE] = acc; }
    __syncthreads();
}
__device__ __forceinline__ void expert_find(LAS unsigned char* lds, int mt, int& e, int& local, int& c) {
    const LAS int* pre = (const LAS int*)(lds + LDS_MAP); const LAS int* cn = pre + 40;
    int lo = 0;
#pragma unroll 1
    for (int i = 1; i < NE; ++i) if (pre[i] <= mt) lo = i;
    e = __builtin_amdgcn_readfirstlane(lo); local = mt - __builtin_amdgcn_readfirstlane(pre[e]); c = __builtin_amdgcn_readfirstlane(cn[e]);
}
__device__ __forceinline__ int expert_tiles(LAS unsigned char* lds) { return __builtin_amdgcn_readfirstlane(((const LAS int*)(lds + LDS_MAP))[NE]); }

struct EpiGU {
    bf16_t* hid; const float* rstd2; const int* lst; int cnt, p0, hrow0, ct;
    __device__ __forceinline__ void operator()(const f32x4 (&acc)[2][2][4][2], const unsigned (&m0)[8], const unsigned (&m1)[8], int wr, int wc, int fr, int fq, int mh) const {
#pragma unroll
        for (int ai = 0; ai < 2; ++ai) if (mh < 0 || ai == mh)
#pragma unroll
            for (int m = 0; m < 4; ++m) { const int r = ai * 128 + wr * 64 + m * 16 + fr; const int pp = p0 + r;
                const float rs = pp < cnt ? __uint_as_float(m0[ai * 4 + m]) : 0.f;
                bf16_t* op = hid + (size_t)(hrow0 + r) * DE + ct * 128 + wc * 32 + 8 * fq;
                float o[8];
#pragma unroll
                for (int n = 0; n < 2; ++n) { const f32x4 g = acc[ai][0][m][n] * rs, uu = acc[ai][1][m][n] * rs;
#pragma unroll
                    for (int j = 0; j < 4; ++j) o[4 * n + j] = g[j] * frcp(1.0f + fexp2(-g[j] * LOG2E)) * uu[j]; }
                *(u32x4*)op = (u32x4){cvt_pk_bf16(o[0], o[1]), cvt_pk_bf16(o[2], o[3]), cvt_pk_bf16(o[4], o[5]), cvt_pk_bf16(o[6], o[7])}; }
    }
};
__device__ __forceinline__ void phase5(const Params& p, LAS unsigned char* lds) {
    expert_map_build((const unsigned*)(p.ws + WS_CTL), lds);
    const int MT = expert_tiles(lds);
    int tid = threadIdx.x; asm volatile("" : "+v"(tid));
    int Rr[2], Cc[2];
#pragma unroll
    for (int i = 0; i < 2; ++i) g8::stage_rc(tid * 16 + i * 8192, Rr[i], Cc[i]);
    g8::UnitIO cur, nxt; cur.meta1 = nullptr; nxt.meta1 = nullptr;
    auto fill = [&](g8::UnitIO& io, int unit, int& e, int& c, int& p0, int& mt, int& ct) {
        mt = unit >> 1; ct = unit & 1; int local; expert_find(lds, mt, e, local, c); p0 = local * 256;
        const int* lst = (const int*)(p.ws + WS_LIST) + (size_t)e * T;
#pragma unroll
        for (int i = 0; i < 2; ++i)
#pragma unroll
            for (int hh = 0; hh < 2; ++hh) { const int pp = p0 + hh * 128 + Rr[i]; const int tok = pp < c ? (lst[pp] >> 1) : 0; io.aoff[hh][i] = (unsigned)(tok * D + Cc[i]) * 2u; }
        io.Ab = (const char*)(p.ws + WS_A); io.Bb = (const char*)(p.ws + WS_WGU) + ((size_t)e * 512 + ct * 256) * D * 2; io.meta0 = (const unsigned*)(p.ws + WS_LISTR) + (size_t)e * T + p0;
    };
    int e = 0, c = 0, p0 = 0, mt = 0, ct = 0, unit = 0, mh = -1;
    bool have = g8::sched_get(MT * 2, 0, unit, mh);
    if (have) fill(cur, unit, e, c, p0, mt, ct);
    for (int i = 0; have; ++i) {
        int unit2 = 0, mh2 = -1, e2 = 0, c2 = 0, p02 = 0, mt2 = 0, ct2 = 0; const bool hn = g8::sched_get(MT * 2, i + 1, unit2, mh2);
        if (hn) fill(nxt, unit2, e2, c2, p02, mt2, ct2);
        EpiGU E{(bf16_t*)(p.ws + WS_B), (const float*)(p.ws + WS_RSTD2), nullptr, c, p0, mt * 256, ct};
        g8::gemm_unit_p<8>(lds, cur, D, E, i & 1, i > 0, hn, nxt, mh);
        cur = nxt; e = e2; c = c2; p0 = p02; mt = mt2; ct = ct2; mh = mh2; have = hn;
    }
}
struct EpiDN {
    bf16_t* y; bf16_t* dummy; const int* lst; const float* lw; int cnt, p0, col0;
    __device__ __forceinline__ void operator()(const f32x4 (&acc)[2][2][4][2], const unsigned (&m0)[8], const unsigned (&m1)[8], int wr, int wc, int fr, int fq, int mh) const {
#pragma unroll
        for (int ai = 0; ai < 2; ++ai) if (mh < 0 || ai == mh)
#pragma unroll
            for (int m = 0; m < 4; ++m) { const int pp = p0 + ai * 128 + wr * 64 + m * 16 + fr;
                const bool ok = pp < cnt; const int rl = pp - p0; const int ent = (int)m0[ai * 4 + m]; const float w = __uint_as_float(m1[ai * 4 + m]);
                bf16_t* op = (ok ? y + ((size_t)(ent & 1) * T + (ent >> 1)) * D : dummy) + col0 + wc * 32 + 8 * fq;
#pragma unroll
                for (int bj = 0; bj < 2; ++bj) { const f32x4 v0 = acc[ai][bj][m][0] * w, v1 = acc[ai][bj][m][1] * w;
                    *(u32x4*)(op + bj * 128) = (u32x4){cvt_pk_bf16(v0[0], v0[1]), cvt_pk_bf16(v0[2], v0[3]), cvt_pk_bf16(v1[0], v1[1]), cvt_pk_bf16(v1[2], v1[3])}; }
                if (m & 1) asm volatile("" ::: "memory"); }
    }
};
__device__ __forceinline__ void phase6(const Params& p, LAS unsigned char* lds) {
    expert_map_build((const unsigned*)(p.ws + WS_CTL), lds);
    const int MT = expert_tiles(lds);
    constexpr int kdn = DE;
    g8::UnitIO cur, nxt; g8::aoff_rows(cur.aoff, kdn);
#pragma unroll
    for (int a = 0; a < 2; ++a)
#pragma unroll
        for (int b = 0; b < 2; ++b) nxt.aoff[a][b] = cur.aoff[a][b];
    auto fill = [&](g8::UnitIO& io, int unit, int& c, int& p0, int& pn) {
        const int mt = unit >> 2; pn = unit & 3; int e, local; expert_find(lds, mt, e, local, c); p0 = local * 256;
        io.Ab = (const char*)(p.ws + WS_B) + (size_t)mt * 256 * DE * 2; io.Bb = (const char*)(p.ws + WS_WDN) + ((size_t)e * D + pn * 256) * DE * 2;
        io.meta0 = (const unsigned*)(p.ws + WS_LIST) + (size_t)e * T + p0; io.meta1 = (const unsigned*)(p.ws + WS_LISTW) + (size_t)e * T + p0;
    };
    int c = 0, p0 = 0, pn = 0, unit = 0, mh = -1;
    bool have = g8::sched_get(MT * 4, 0, unit, mh);
    if (have) fill(cur, unit, c, p0, pn);
    for (int i = 0; have; ++i) {
        int unit2 = 0, mh2 = -1, c2 = 0, p02 = 0, pn2 = 0; const bool hn = g8::sched_get(MT * 4, i + 1, unit2, mh2);
        if (hn) fill(nxt, unit2, c2, p02, pn2);
        EpiDN E{(bf16_t*)(p.ws + WS_A + (size_t)T * D * 2), (bf16_t*)(p.ws + WS_A + (size_t)3 * T * D * 2), nullptr, nullptr, c, p0, pn * 256};
        g8::gemm_unit_p<16>(lds, cur, kdn, E, i & 1, i > 0, hn, nxt, mh);
        cur.Ab = nxt.Ab; cur.Bb = nxt.Bb; cur.meta0 = nxt.meta0; cur.meta1 = nxt.meta1; c = c2; p0 = p02; pn = pn2; mh = mh2; have = hn;
    }
}

__device__ __forceinline__ void phase7(const Params& p) {
    int tid7 = threadIdx.x; asm volatile("" : "+v"(tid7));
    const int wave = tid7 >> 6, lane = tid7 & 63;
    const bf16_t* hb = (const bf16_t*)(p.ws + WS_A);
    const bf16_t* y0 = (const bf16_t*)(p.ws + WS_A + (size_t)T * D * 2); const bf16_t* y1 = y0 + (size_t)T * D;
    f32x4 g[4];
#pragma unroll
    for (int j = 0; j < 4; ++j) g[j] = *((const f32x4*)p.final_g + lane + 64 * j);
    const int stride = gridDim.x * NWAVES;
    int row = blockIdx.x * NWAVES + wave;
    struct Row { u32x2 hv[4], ya[4], yb[4]; };
    auto ld = [&](Row& r, int rw) __attribute__((always_inline)) {
#pragma unroll
        for (int j = 0; j < 4; ++j) { r.hv[j] = ((const u32x2*)(hb + (size_t)rw * D) + lane)[64 * j]; r.ya[j] = ((const u32x2*)(y0 + (size_t)rw * D) + lane)[64 * j]; r.yb[j] = ((const u32x2*)(y1 + (size_t)rw * D) + lane)[64 * j]; }
    };
    Row ra, rb;
    if (row < T) ld(ra, row);
    if (row + stride < T) ld(rb, row + stride);
    auto one = [&](Row& r, int rw, int nrow) __attribute__((always_inline)) {
        f32x4 v[4]; float s = 0.f;
#pragma unroll
        for (int j = 0; j < 4; ++j) {
            v[j][0] = bf16_lo(r.hv[j].x) + (bf16_lo(r.ya[j].x) + bf16_lo(r.yb[j].x)); v[j][1] = bf16_hi(r.hv[j].x) + (bf16_hi(r.ya[j].x) + bf16_hi(r.yb[j].x));
            v[j][2] = bf16_lo(r.hv[j].y) + (bf16_lo(r.ya[j].y) + bf16_lo(r.yb[j].y)); v[j][3] = bf16_hi(r.hv[j].y) + (bf16_hi(r.ya[j].y) + bf16_hi(r.yb[j].y));
            s += (v[j][0] * v[j][0] + v[j][1] * v[j][1]) + (v[j][2] * v[j][2] + v[j][3] * v[j][3]); }
        if (nrow < T) ld(r, nrow);
        s = wave_sum(s);
        const float rs = 1.0f / sqrtf(s * (1.0f / D) + 1e-6f);
        f32x4* orow = (f32x4*)(p.out + (size_t)rw * D) + lane;
#pragma unroll
        for (int j = 0; j < 4; ++j) orow[64 * j] = v[j] * rs * g[j];
    };
    for (; row < T; row += 2 * stride) {
        one(ra, row, row + 2 * stride);
        if (row + stride < T) one(rb, row + stride, row + 3 * stride);
    }
}

__global__ __launch_bounds__(512) void mega(Params p) {
    extern __shared__ __attribute__((aligned(16))) unsigned char lds_raw[];
    LAS unsigned char* lds = (LAS unsigned char*)lds_raw;
    volatile LAS unsigned* bst = (volatile LAS unsigned*)(lds + LDS_MAP + 512);
    if (threadIdx.x == 0) { bst[0] = 0u; bst[1] = 0u; bst[2] = 0u; bst[3] = 0u; }
    __syncthreads();
    const XcdBarrier gb = xcd_barrier_post((unsigned*)(p.ws + WS_BAR), bst);
#define GSYNC() xcd_barrier(gb)
    phase0(p, lds); GSYNC();
    phase1(p, lds); GSYNC();
    { phase2a(p); GSYNC(); phase2(p, lds); } GSYNC();
    phase3(p, lds); GSYNC();
    phase4(p, lds); GSYNC();
    phase5(p, lds); GSYNC();
    phase6(p, lds); GSYNC();
    phase7(p);
}

extern "C" void kernel_launch(void* const* d_in, const int* in_sizes, int n_in, void* d_out, int out_size, void* d_ws, size_t ws_size, hipStream_t stream) {
    static int grid = 0;
    if (grid == 0) {
        if (n_in != 25 || out_size != T * D || ws_size < WS_END) { fprintf(stderr, "kernel_launch: unexpected sizes n_in %d out %d ws %zu (need %zu)\n", n_in, out_size, ws_size, (size_t)WS_END); grid = -1; return; }
        int dev = 0, cus = 0, per_cu = 0;
        (void)hipGetDevice(&dev); (void)hipDeviceGetAttribute(&cus, hipDeviceAttributeMultiprocessorCount, dev);
        if (hipFuncSetAttribute((const void*)mega, hipFuncAttributeMaxDynamicSharedMemorySize, LDS_BYTES) != hipSuccess) { fprintf(stderr, "kernel_launch: hipFuncSetAttribute failed\n"); grid = -1; return; }
        if (hipOccupancyMaxActiveBlocksPerMultiprocessor(&per_cu, (const void*)mega, NTHREADS, LDS_BYTES) != hipSuccess || per_cu < 1) { fprintf(stderr, "kernel_launch: occupancy query failed (%d)\n", per_cu); (void)hipGetLastError(); per_cu = 1; }
        grid = cus * 1;
    }
    if (grid < 0) return;
    Params p{};
    const float** f = (const float**)&p;
    for (int i = 0; i < 25; ++i) f[i] = (const float*)d_in[i];
    p.out = (float*)d_out; p.ws = (unsigned char*)d_ws;
    if (hipMemsetAsync((char*)d_ws + WS_BAR, 0, XCD_BAR_WORDS * 4, stream) != hipSuccess) { fprintf(stderr, "kernel_launch: memset failed\n"); return; }
    hipLaunchKernelGGL(mega, dim3(grid), dim3(NTHREADS), LDS_BYTES, stream, p);
    hipError_t e = hipPeekAtLastError();
    if (e != hipSuccess) fprintf(stderr, "launch failed: %s (grid %d)\n", hipGetErrorString(e), grid);
}
```

```cpp
#include <hip/hip_runtime.h>
#include <cstdio>
#include <cstdint>

#define LAS __attribute__((address_space(3)))
typedef unsigned short bf16_t;
typedef short bf16x8 __attribute__((ext_vector_type(8)));
typedef short s16x4 __attribute__((ext_vector_type(4)));
typedef float f32x4 __attribute__((ext_vector_type(4)));
typedef float f32x2 __attribute__((ext_vector_type(2)));
typedef float f32x16 __attribute__((ext_vector_type(16)));
typedef unsigned u32x2 __attribute__((ext_vector_type(2)));
typedef unsigned u32x4 __attribute__((ext_vector_type(4)));

constexpr int NB = 16, S = 2048, T = NB * S, D = 1024, NIN = 3328, NH = 8, HD = 64;
constexpr int UQ = 0, UK = 512, UV = 1024, UR = 1536, URK = 2048, URV = 2560, UXW = 3072, UXA = 3136, UXG = 3200;
constexpr int NE = 32, DE = 256;
constexpr float LOG2E = 1.4426950408889634f, LN2 = 0.6931471805599453f;
constexpr float QSCALE = 0.125f * LOG2E;
constexpr int NTHREADS = 512, NWAVES = 8;
constexpr int LDS_BYTES = 161792 + 1024;

constexpr size_t WS_CTL   = 0;
constexpr size_t WS_BAR   = 8192;
constexpr size_t WS_WIN   = 65536;
constexpr size_t WS_WOUT  = WS_WIN  + (size_t)NIN * D * 2;
constexpr size_t WS_WGU   = WS_WOUT + (size_t)D * D * 2;
constexpr size_t WS_WDN   = WS_WGU  + (size_t)NE * 512 * D * 2;
constexpr size_t WS_RSTD1 = WS_WDN  + (size_t)NE * D * DE * 2;
constexpr size_t WS_RSTD2 = WS_RSTD1 + (size_t)T * 4;
constexpr size_t WS_LIST  = WS_RSTD2 + (size_t)T * 4;
constexpr size_t WS_LISTW = WS_LIST + (size_t)NE * T * 4;
constexpr size_t WS_LISTR = WS_LISTW + (size_t)NE * T * 4;
constexpr size_t WS_WR    = WS_LISTR + (size_t)NE * T * 4;
constexpr size_t WS_LT    = WS_WR + (size_t)2 * 48 * D * 2;
constexpr size_t WS_A     = WS_LT + (size_t)512 * 256 * 2;
constexpr size_t WS_B     = WS_A + (size_t)T * NIN * 2;
constexpr size_t WS_C     = WS_B + (size_t)T * D * 2;
constexpr size_t WS_D     = WS_C + (size_t)T * D * 2;
constexpr size_t WS_END   = WS_D + (size_t)T * 1536 * 2;
constexpr int HID_ROWS = 2 * T + NE * 256;

struct Params {
    const float* x; const float* norm_mix_g; const float* w_in; const float* shift_mu; const float* sb_out_g;
    const float* rw_w0; const float* rw_w2; const float* rw_a0; const float* rw_a2; const float* rw_g2;
    const float* rw_k_k; const float* rw_k_a; const float* rw_r_k; const float* rw_ln_w; const float* rw_ln_b;
    const float* w_out; const float* norm_ffn_g; const float* r_grp_w; const float* r_grp_b; const float* r_exp_w; const float* r_exp_b;
    const float* w_gate; const float* w_up; const float* w_down; const float* final_g;
    float* out; unsigned char* ws;
};

typedef __bf16 bf16x2_t __attribute__((ext_vector_type(2)));
__device__ __forceinline__ unsigned cvt_pk_bf16(float lo, float hi) { const f32x2 v = {lo, hi}; return __builtin_bit_cast(unsigned, __builtin_convertvector(v, bf16x2_t)); }
__device__ __forceinline__ float bf16_lo(unsigned w) { return __uint_as_float(w << 16); }
__device__ __forceinline__ float bf16_hi(unsigned w) { return __uint_as_float(w & 0xffff0000u); }
__device__ __forceinline__ float fexp2(float x) { return __builtin_amdgcn_exp2f(x); }
__device__ __forceinline__ float flog2(float x) { return __builtin_amdgcn_logf(x); }
__device__ __forceinline__ float frcp(float x) { return __builtin_amdgcn_rcpf(x); }
__device__ __forceinline__ float frsq(float x) { return __builtin_amdgcn_rsqf(x); }
template <int CTRL> __device__ __forceinline__ float dppf(float v) { return __builtin_bit_cast(float, __builtin_amdgcn_update_dpp(0, __builtin_bit_cast(int, v), CTRL, 0xF, 0xF, true)); }
__device__ __forceinline__ float rlane(float v, int l) { return __builtin_bit_cast(float, __builtin_amdgcn_readlane(__builtin_bit_cast(int, v), l)); }
__device__ __forceinline__ float sum8(float v) { v += dppf<0xB1>(v); v += dppf<0x4E>(v); v += dppf<0x141>(v); return v; }
__device__ __forceinline__ float sum16(float v) { v = sum8(v); v += dppf<0x140>(v); return v; }
__device__ __forceinline__ float wave_sum(float v) { v = sum16(v); return (rlane(v, 0) + rlane(v, 16)) + (rlane(v, 32) + rlane(v, 48)); }
__device__ __forceinline__ float swap32(float v) { return __shfl_xor(v, 32); }
#define LDS_WAIT() asm volatile("s_waitcnt lgkmcnt(0)" ::: "memory")


#define XB_TMO      128
#define XB_XCNT(j)  (256  + 64 * (j))
#define XB_XSUB(j)  (1280 + 64 * (j))
#define XB_XGEN(j)  (2304 + 64 * (j))
#define XB_TOP      3328
#define XB_TOPGEN   3392
#define XCD_BAR_WORDS 3456
#define XB_SPIN_CAP (1u << 22)
__device__ __forceinline__ unsigned xb_ld(unsigned* p)              { return __hip_atomic_load(p, __ATOMIC_RELAXED, __HIP_MEMORY_SCOPE_AGENT); }
__device__ __forceinline__ unsigned xb_add(unsigned* p, unsigned v) { return __hip_atomic_fetch_add(p, v, __ATOMIC_RELAXED, __HIP_MEMORY_SCOPE_AGENT); }
__device__ __forceinline__ unsigned xb_xcc_id() { return (unsigned)__builtin_amdgcn_s_getreg((3 << 11) | 20) & 0xFu; }
#define XB_SPIN(cond, bar) do { unsigned _sp = 0; while (cond) { __builtin_amdgcn_s_sleep(1); \
    if ((++_sp & 255u) == 0u) { if (xb_ld(&(bar)[XB_TMO])) break; if (_sp > XB_SPIN_CAP) { atomicAdd(&(bar)[XB_TMO], 1u); break; } } } } while (0)
struct XcdBarrier { unsigned* bar; unsigned x; volatile LAS unsigned* st; };
__device__ __forceinline__ XcdBarrier xcd_barrier_post(unsigned* bar, volatile LAS unsigned* st) {
    XcdBarrier b; b.bar = bar; b.x = xb_xcc_id(); b.st = st;
    if (threadIdx.x == 0) (void)xb_add(&bar[XB_XCNT(b.x)], 1u);
    return b;
}
__device__ __forceinline__ void xcd_barrier_complete(unsigned* bar, unsigned x, unsigned& nloc, unsigned& nx) {
    const unsigned G = gridDim.x * gridDim.y * gridDim.z;
    unsigned sum, cnt, mine, sp = 0u;
    for (;;) {
        sum = 0u; cnt = 0u; mine = 0u;
#pragma unroll
        for (unsigned j = 0; j < 16; ++j) { const unsigned c = xb_ld(&bar[XB_XCNT(j)]); sum += c; cnt += (c > 0u) ? 1u : 0u; mine = (j == x) ? c : mine; }
        if (sum == G) break;
        __builtin_amdgcn_s_sleep(1);
        if ((++sp & 255u) == 0u) { if (xb_ld(&bar[XB_TMO])) break; if (sp > XB_SPIN_CAP) { atomicAdd(&bar[XB_TMO], 1u); break; } }
    }
    nloc = mine > 0u ? mine : 1u; nx = cnt > 0u ? cnt : 1u;
}
__device__ __forceinline__ void xcd_barrier(const XcdBarrier& b) {
    asm volatile("s_waitcnt vmcnt(0)" ::: "memory");
    __syncthreads();
    if (threadIdx.x == 0) {
        unsigned* bar = b.bar;
        __builtin_amdgcn_s_waitcnt(0);
        unsigned nloc = b.st[0], nx = b.st[1];
        if (nloc == 0u) { xcd_barrier_complete(bar, b.x, nloc, nx); b.st[0] = nloc; b.st[1] = nx; }
        const unsigned old = xb_add(&bar[XB_XSUB(b.x)], 1u);
        const unsigned gen = old / nloc;
        if (old + 1u == (gen + 1u) * nloc) {
            __builtin_amdgcn_fence(__ATOMIC_RELEASE, "agent");
            asm volatile("s_waitcnt vmcnt(0)" ::: "memory");
            const unsigned og = xb_add(&bar[XB_TOP], 1u);
            const unsigned tg = og / nx;
            if (og + 1u == (tg + 1u) * nx) xb_add(&bar[XB_TOPGEN], 1u);
            else XB_SPIN(xb_ld(&bar[XB_TOPGEN]) == tg, bar);
            __builtin_amdgcn_fence(__ATOMIC_ACQUIRE, "agent");
            xb_add(&bar[XB_XGEN(b.x)], 1u);
            asm volatile("s_waitcnt vmcnt(0)" ::: "memory");
        } else {
            XB_SPIN(xb_ld(&bar[XB_XGEN(b.x)]) == gen, bar);
            __builtin_amdgcn_fence(__ATOMIC_ACQUIRE, "agent");
            asm volatile("s_waitcnt vmcnt(0)" ::: "memory");
        }
    }
    __syncthreads();
}

namespace g8 {
constexpr int BK = 64, HALF = 128, HTB = HALF * BK * 2;
__device__ __forceinline__ int lds_byte(int r, int c) { const int st = (r >> 4) * 2 + (c >> 5), rr = r & 15, cc = c & 31, ob = rr * 64 + cc * 2; return st * 1024 + (ob ^ (((ob >> 9) & 1) << 5)); }
__device__ __forceinline__ void stage_rc(int b, int& R, int& C) { const int st = b / 1024, sb = b % 1024, swz = sb ^ (((sb >> 9) & 1) << 5); R = (st >> 1) * 16 + swz / 64; C = (st & 1) * 32 + (swz % 64) / 2; }

#define G8_SA(b, h) (((b) * 2 + (h)) * HTB)
#define G8_SB(b, h) ((4 + (b) * 2 + (h)) * HTB)
#define G8_STAGE_A(bufoff, h, kt) do { _Pragma("unroll") for (int _i = 0; _i < 2; ++_i) \
    __builtin_amdgcn_global_load_lds((const unsigned*)((Ab + (size_t)(kt) * (BK * 2)) + aoff[h][_i]), (LAS unsigned*)(lds + (bufoff) + ldsw + _i * 8192), 16, 0, 0); } while (0)
#define G8_STAGE_B(bufoff, h, kt) do { _Pragma("unroll") for (int _i = 0; _i < 2; ++_i) \
    __builtin_amdgcn_global_load_lds((const unsigned*)((Bb + (size_t)(h) * bhalf + (size_t)(kt) * (BK * 2)) + boff[_i]), (LAS unsigned*)(lds + (bufoff) + ldsw + _i * 8192), 16, 0, 0); } while (0)
#define G8_LDA(dst, b, h) do { _Pragma("unroll") for (int m = 0; m < 4; ++m) _Pragma("unroll") for (int k = 0; k < 2; ++k) dst[m][k] = *(const LAS bf16x8*)(lds + G8_SA(b, h) + la_off + m * 2048 + k * 1024); } while (0)
#define G8_LDB(dst, b, h) do { _Pragma("unroll") for (int n = 0; n < 2; ++n) _Pragma("unroll") for (int k = 0; k < 2; ++k) dst[n][k] = *(const LAS bf16x8*)(lds + G8_SB(b, h) + lb_off + n * 2048 + k * 1024); } while (0)
#define G8_MMA(ai, bj, At, Bt) do { __builtin_amdgcn_s_setprio(1); _Pragma("unroll") for (int m = 0; m < 4; ++m) _Pragma("unroll") for (int n = 0; n < 2; ++n) _Pragma("unroll") for (int k = 0; k < 2; ++k) \
    acc[ai][bj][m][n] = __builtin_amdgcn_mfma_f32_16x16x32_bf16(Bt[n][k], At[m][k], acc[ai][bj][m][n], 0, 0, 0); __builtin_amdgcn_s_setprio(0); } while (0)
#define G8_WAIT_V(n) asm volatile("s_waitcnt vmcnt(" #n ")" ::: "memory")
#define G8_WAIT_L(n) asm volatile("s_waitcnt lgkmcnt(" #n ")" ::: "memory")
#define G8_BAR __builtin_amdgcn_s_barrier()
#define G8_SCHED __builtin_amdgcn_sched_barrier(0)

struct UnitIO { const char* Ab; const char* Bb; const unsigned* meta0; const unsigned* meta1; unsigned aoff[2][2]; };
#define G8_STAGE_AX(bufoff, h, kt, AB, AOFF) do { _Pragma("unroll") for (int _i = 0; _i < 2; ++_i) \
    __builtin_amdgcn_global_load_lds((const unsigned*)(((AB) + (size_t)(kt) * (BK * 2)) + (AOFF)[h][_i]), (LAS unsigned*)(lds + (bufoff) + ldsw + _i * 8192), 16, 0, 0); } while (0)
#define G8_STAGE_BX(bufoff, h, kt, BB) do { _Pragma("unroll") for (int _i = 0; _i < 2; ++_i) \
    __builtin_amdgcn_global_load_lds((const unsigned*)(((BB) + (size_t)(h) * bhalf + (size_t)(kt) * (BK * 2)) + boff[_i]), (LAS unsigned*)(lds + (bufoff) + ldsw + _i * 8192), 16, 0, 0); } while (0)
template <int N> __device__ __forceinline__ void wait_v() { asm volatile("s_waitcnt vmcnt(%0)" :: "n"(N) : "memory"); }
template <int NEPI, class Epi>
__device__ __forceinline__ void gemm_unit_p(LAS unsigned char* lds, const UnitIO& io, int K, const Epi& E, int parity, bool primed, bool has_next, const UnitIO& nx, int mh = -1) {
    const bool do0 = mh != 1, do1 = mh != 0;
    int tid = threadIdx.x; asm volatile("" : "+v"(tid));
    const int wid = __builtin_amdgcn_readfirstlane(tid >> 6), lane = tid & 63, wr = wid >> 2, wc = wid & 3, fr = lane & 15, fq = lane >> 4;
    const int nt = K / BK;
    unsigned boff[2];
#pragma unroll
    for (int i = 0; i < 2; ++i) { int R, C; stage_rc(tid * 16 + i * 8192, R, C); const int rho = R & 31, Rb = (R & ~31) + 8 * ((rho & 15) >> 2) + 4 * (rho >> 4) + (rho & 3);
        boff[i] = (unsigned)(Rb * K + C) * 2u; }
    const size_t bhalf = (size_t)HALF * K * 2;
    const unsigned ldsw = (unsigned)wid * 1024u;
    const int la_off = lds_byte(wr * 64 + fr, fq * 8), lb_off = lds_byte(wc * 32 + fr, fq * 8);
    const char* Ab = io.Ab; const char* Bb = io.Bb; const unsigned (&aoff)[2][2] = io.aoff;
    f32x4 acc[2][2][4][2];
#pragma unroll
    for (int a = 0; a < 2; ++a)
#pragma unroll
        for (int b = 0; b < 2; ++b)
#pragma unroll
            for (int m = 0; m < 4; ++m)
#pragma unroll
                for (int n = 0; n < 2; ++n) acc[a][b][m][n] = (f32x4){0.f, 0.f, 0.f, 0.f};
    bf16x8 At[4][2], B0[2][2], B1[2][2];
    LAS unsigned char* mbuf = lds + 131072 + parity * 2048;
    if (!primed) {
        if (io.meta0) { if (wid < 4) __builtin_amdgcn_global_load_lds(io.meta0 + wid * 64 + lane, (LAS unsigned*)(mbuf + wid * 256), 4, 0, 0);
                        else if (io.meta1) __builtin_amdgcn_global_load_lds(io.meta1 + (wid - 4) * 64 + lane, (LAS unsigned*)(mbuf + 1024 + (wid - 4) * 256), 4, 0, 0); }
        G8_STAGE_B(G8_SB(0, 0), 0, 0); G8_STAGE_A(G8_SA(0, 0), 0, 0);
        G8_STAGE_B(G8_SB(0, 1), 1, 0); G8_STAGE_A(G8_SA(0, 1), 1, 0);
        if (wr == 1) G8_BAR;
        G8_WAIT_V(4); G8_BAR;
        G8_STAGE_B(G8_SB(1, 0), 0, 1); G8_STAGE_A(G8_SA(1, 0), 0, 1); G8_STAGE_B(G8_SB(1, 1), 1, 1);
        G8_WAIT_V(6); G8_BAR;
    } else {
        if (wr == 1) G8_BAR;
        wait_v<4 + NEPI>(); G8_BAR;
        G8_STAGE_B(G8_SB(1, 0), 0, 1); G8_STAGE_A(G8_SA(1, 0), 0, 1); G8_STAGE_B(G8_SB(1, 1), 1, 1);
        wait_v<6 + NEPI>(); G8_BAR;
    }
    for (int t = 0; t < nt - 2; t += 2) {
        G8_LDB(B0, 0, 0); G8_SCHED; G8_LDA(At, 0, 0); G8_STAGE_A(G8_SA(1, 1), 1, t + 1);
        G8_WAIT_L(8); G8_BAR; G8_WAIT_L(0); if (do0) G8_MMA(0, 0, At, B0); G8_BAR; G8_SCHED;
        G8_LDB(B1, 0, 1); G8_STAGE_B(G8_SB(0, 0), 0, t + 2);
        G8_BAR; G8_WAIT_L(0); if (do0) G8_MMA(0, 1, At, B1); G8_BAR;
        G8_LDA(At, 0, 1); G8_STAGE_A(G8_SA(0, 0), 0, t + 2);
        G8_BAR; G8_WAIT_L(0); if (do1) G8_MMA(1, 0, At, B0); G8_BAR; G8_SCHED;
        G8_STAGE_B(G8_SB(0, 1), 1, t + 2);
        G8_WAIT_V(6); G8_BAR; if (do1) G8_MMA(1, 1, At, B1); G8_BAR;
        G8_LDB(B0, 1, 0); G8_SCHED; G8_LDA(At, 1, 0); G8_STAGE_A(G8_SA(0, 1), 1, t + 2);
        G8_WAIT_L(8); G8_BAR; G8_WAIT_L(0); if (do0) G8_MMA(0, 0, At, B0); G8_BAR; G8_SCHED;
        G8_LDB(B1, 1, 1); G8_STAGE_B(G8_SB(1, 0), 0, t + 3);
        G8_BAR; G8_WAIT_L(0); if (do0) G8_MMA(0, 1, At, B1); G8_BAR;
        G8_LDA(At, 1, 1); G8_STAGE_A(G8_SA(1, 0), 0, t + 3);
        G8_BAR; G8_WAIT_L(0); if (do1) G8_MMA(1, 0, At, B0); G8_BAR; G8_SCHED;
        G8_STAGE_B(G8_SB(1, 1), 1, t + 3);
        G8_WAIT_V(6); G8_BAR; if (do1) G8_MMA(1, 1, At, B1); G8_BAR;
    }
    { G8_LDB(B0, 0, 0); G8_LDA(At, 0, 0); G8_STAGE_A(G8_SA(1, 1), 1, nt - 1);
      G8_BAR; G8_WAIT_L(0); if (do0) G8_MMA(0, 0, At, B0); G8_BAR;
      G8_LDB(B1, 0, 1); G8_BAR; G8_WAIT_L(0); if (do0) G8_MMA(0, 1, At, B1); G8_BAR;
      G8_LDA(At, 0, 1); G8_WAIT_V(4); G8_BAR; G8_WAIT_L(0); if (do1) { G8_MMA(1, 0, At, B0); G8_MMA(1, 1, At, B1); }; G8_BAR; }
    { G8_LDB(B0, 1, 0); G8_LDA(At, 1, 0); G8_WAIT_V(2); G8_BAR; G8_WAIT_L(0); if (do0) G8_MMA(0, 0, At, B0); G8_BAR;
      G8_LDB(B1, 1, 1); G8_WAIT_V(0); G8_BAR; G8_WAIT_L(0); if (do0) G8_MMA(0, 1, At, B1); G8_BAR;
      G8_LDA(At, 1, 1); G8_BAR; G8_WAIT_L(0); if (do1) { G8_MMA(1, 0, At, B0); G8_MMA(1, 1, At, B1); }; G8_BAR; }
    if (wr == 0) G8_BAR;
    asm volatile("" ::: "memory");
    unsigned m0[8], m1[8];
#pragma unroll
    for (int ai = 0; ai < 2; ++ai)
#pragma unroll
        for (int m = 0; m < 4; ++m) { const int rl = ai * 128 + wr * 64 + m * 16 + fr; m0[ai * 4 + m] = ((const LAS unsigned*)mbuf)[rl]; m1[ai * 4 + m] = ((const LAS unsigned*)(mbuf + 1024))[rl]; }
    G8_WAIT_L(0);
    if (has_next) {
        LAS unsigned char* nb = lds + 131072 + (parity ^ 1) * 2048;
        if (nx.meta0) { if (wid < 4) __builtin_amdgcn_global_load_lds(nx.meta0 + wid * 64 + lane, (LAS unsigned*)(nb + wid * 256), 4, 0, 0);
                        else if (nx.meta1) __builtin_amdgcn_global_load_lds(nx.meta1 + (wid - 4) * 64 + lane, (LAS unsigned*)(nb + 1024 + (wid - 4) * 256), 4, 0, 0); }
        G8_STAGE_BX(G8_SB(0, 0), 0, 0, nx.Bb); G8_STAGE_AX(G8_SA(0, 0), 0, 0, nx.Ab, nx.aoff);
        G8_STAGE_BX(G8_SB(0, 1), 1, 0, nx.Bb); G8_STAGE_AX(G8_SA(0, 1), 1, 0, nx.Ab, nx.aoff);
        asm volatile("" ::: "memory");
    }
    E(acc, m0, m1, wr, wc, fr, fq, mh);
    if (!has_next) __syncthreads();
}
__device__ __forceinline__ bool sched_get(int nU, int i, int& unit, int& mh) {
    const int G = gridDim.x, full = (nU / G) * G, rem = nU - full;
    const int L = blockIdx.x + i * G; mh = -1; unit = L;
    if (L < full) return true;
    const int j = L - full; if (j >= G) return false;
    if (rem > 0 && 2 * rem <= G) { if (j < 2 * rem) { unit = full + (j >> 1); mh = j & 1; return true; } return false; }
    return j < rem;
}
__device__ __forceinline__ void aoff_rows(unsigned (&aoff)[2][2], int K) {
    int tid = threadIdx.x; asm volatile("" : "+v"(tid));
#pragma unroll
    for (int i = 0; i < 2; ++i) { int R, C; stage_rc(tid * 16 + i * 8192, R, C);
#pragma unroll
        for (int h = 0; h < 2; ++h) aoff[h][i] = (unsigned)((h * HALF + R) * K + C) * 2u; }
}
__device__ __forceinline__ void tile_order(int L, int nM, int nN, int& pm, int& pn) {
    const int nwg = nM * nN; int wgid = L;
    { const int q = nwg / 8, r = nwg % 8, xcd = wgid % 8, off = wgid / 8; wgid = (xcd < r ? xcd * (q + 1) : r * (q + 1) + (xcd - r) * q) + off; }
    const int nig = 8 * nN, gid = wgid / nig, fm = gid * 8, gsz = (nM - fm) < 8 ? (nM - fm) : 8;
    pm = fm + ((wgid % nig) % gsz); pn = (wgid % nig) / gsz;
}
}

__device__ __forceinline__ void p0_transpose_item(const float* W, int K, int N, int k0, int n0, bf16_t* WTrow0  , const float* kscale, float mul, LAS float* scr, int lane) {
    float v[32];
#pragma unroll
    for (int i = 0; i < 32; ++i) v[i] = __builtin_nontemporal_load(W + (size_t)(k0 + 2 * i + (lane >> 5)) * N + n0 + (lane & 31));
    if (kscale) {
#pragma unroll
        for (int i = 0; i < 32; ++i) v[i] *= kscale[k0 + 2 * i + (lane >> 5)];
    }
#pragma unroll
    for (int i = 0; i < 32; ++i) scr[(2 * i + (lane >> 5)) * 33 + (lane & 31)] = v[i] * mul;
    LDS_WAIT();
    const int c = lane & 7;
#pragma unroll
    for (int j = 0; j < 4; ++j) { const int n = (lane >> 3) + 8 * j; const LAS float* s = scr + (8 * c) * 33 + n;
        u32x4 o; o.x = cvt_pk_bf16(s[0 * 33], s[1 * 33]); o.y = cvt_pk_bf16(s[2 * 33], s[3 * 33]); o.z = cvt_pk_bf16(s[4 * 33], s[5 * 33]); o.w = cvt_pk_bf16(s[6 * 33], s[7 * 33]);
        *(u32x4*)(WTrow0 + (size_t)n * K + k0 + 8 * c) = o; }
    LDS_WAIT();
}

__device__ __forceinline__ void p0_transpose64(const float* W, int K, int N, int k0, int n0, bf16_t* WTrow0  , const float* kscale, LAS float* scr, int lane) {
    const int rq = lane >> 4, c4 = 4 * (lane & 15);
    f32x4 v[16];
#pragma unroll
    for (int i = 0; i < 16; ++i) v[i] = __builtin_nontemporal_load((const f32x4*)(W + (size_t)(k0 + 4 * i + rq) * N + n0 + c4));
    if (kscale) {
#pragma unroll
        for (int i = 0; i < 16; ++i) v[i] = v[i] * kscale[k0 + 4 * i + rq];
    }
#pragma unroll
    for (int i = 0; i < 16; ++i) { LAS float* d = scr + (4 * i + rq) * 65 + c4; d[0] = v[i][0]; d[1] = v[i][1]; d[2] = v[i][2]; d[3] = v[i][3]; }
    LDS_WAIT();
#pragma unroll
    for (int j = 0; j < 8; ++j) { const int c = lane & 7, n = (lane >> 3) + 8 * j; const LAS float* sp = scr + (8 * c) * 65 + n;
        u32x4 o; o.x = cvt_pk_bf16(sp[0], sp[65]); o.y = cvt_pk_bf16(sp[2 * 65], sp[3 * 65]); o.z = cvt_pk_bf16(sp[4 * 65], sp[5 * 65]); o.w = cvt_pk_bf16(sp[6 * 65], sp[7 * 65]);
        *(u32x4*)(WTrow0 + (size_t)n * K + k0 + 8 * c) = o; }
    LDS_WAIT();
}
__device__ __forceinline__ void p0_expert_weights(const Params& p, LAS unsigned char* lds, int gw, int NGW) {
    int tid = threadIdx.x; asm volatile("" : "+v"(tid));
    const int wave = tid >> 6, lane = tid & 63;
    LAS float* scr = (LAS float*)(lds + wave * 16640);
    bf16_t* wgu = (bf16_t*)(p.ws + WS_WGU); bf16_t* wdn = (bf16_t*)(p.ws + WS_WDN);
    constexpr int I_G = NE * 16 * 4, I_D = NE * 4 * 16;
    for (int it = gw; it < 2 * I_G + I_D; it += NGW) {
        int r = it;
        if (r < 2 * I_G) { const int up = r >= I_G; if (up) r -= I_G; const int e = r / 64, q = r % 64, kb = q / 4, nb = q % 4, n0 = nb * 64;
            const int drow = (n0 >> 7) * 256 + up * 128 + (n0 & 127);
            p0_transpose64((up ? p.w_up : p.w_gate) + (size_t)e * D * DE, D, DE, kb * 64, n0, wgu + ((size_t)e * 512 + drow) * D, p.norm_ffn_g, scr, lane); continue; } r -= 2 * I_G;
        { const int e = r / 64, q = r % 64, kb = q / 16, nb = q % 16, n0 = nb * 64;
            p0_transpose64(p.w_down + (size_t)e * DE * D, DE, D, kb * 64, n0, wdn + ((size_t)e * D + n0) * DE, nullptr, scr, lane); }
    }
}
__device__ __forceinline__ void phase0(const Params& p, LAS unsigned char* lds) {
    int tid = threadIdx.x; asm volatile("" : "+v"(tid));
    const int wave = tid >> 6, lane = tid & 63;
    const int gw = blockIdx.x * NWAVES + wave, NGW = gridDim.x * NWAVES;
    LAS float* scr = (LAS float*)(lds + wave * 8704);
    bf16_t* win = (bf16_t*)(p.ws + WS_WIN); bf16_t* wout = (bf16_t*)(p.ws + WS_WOUT);
    bf16_t* xb = (bf16_t*)(p.ws + WS_B); float* rstd1 = (float*)(p.ws + WS_RSTD1);
    f32x4 na[4], nb[4];
    if (gw < T) {
#pragma unroll
        for (int j = 0; j < 4; ++j) na[j] = __builtin_nontemporal_load(((const f32x4*)(p.x + (size_t)gw * D) + lane) + 64 * j);
    }
    if (gw + NGW < T) {
#pragma unroll
        for (int j = 0; j < 4; ++j) nb[j] = __builtin_nontemporal_load(((const f32x4*)(p.x + (size_t)(gw + NGW) * D) + lane) + 64 * j);
    }
    constexpr int I_IN = 16 * 104, I_OUT = 16 * 32;
    for (int it = gw; it < I_IN + I_OUT; it += NGW) {
        int r = it;
        if (r < I_IN) { const int kb = r / 104, nb = r % 104, n0 = nb * 32; p0_transpose_item(p.w_in, D, NIN, kb * 64, n0, win + (size_t)n0 * D, p.norm_mix_g, n0 < 512 ? QSCALE : 1.f, scr, lane); continue; } r -= I_IN;
        { const int kb = r / 32, nb = r % 32, n0 = nb * 32; p0_transpose_item(p.w_out, D, D, kb * 64, n0, wout + (size_t)n0 * D, nullptr, 1.f, scr, lane); }
    }
    bf16_t* wr_hi = (bf16_t*)(p.ws + WS_WR); bf16_t* wr_lo = wr_hi + 48 * D;
    for (int i = blockIdx.x * NTHREADS + tid; i < 48 * D; i += gridDim.x * NTHREADS) {
        const int c = i / D, k = i % D; float w = 0.f;
        if (c < 4) w = p.r_grp_w[k * 4 + c]; else if (c < 36) w = p.r_exp_w[k * 32 + (c - 4)];
        w *= p.norm_ffn_g[k];
        const unsigned hi = cvt_pk_bf16(w, 0.f) & 0xffffu; const float rem = w - __uint_as_float(hi << 16);
        wr_hi[i] = (bf16_t)hi; wr_lo[i] = (bf16_t)(cvt_pk_bf16(rem, 0.f) & 0xffffu);
    }
    { bf16_t* w2t = (bf16_t*)(p.ws + WS_LT); bf16_t* a2t = w2t + 512 * 64; bf16_t* g2t = a2t + 512 * 64;
      for (int i = blockIdx.x * NTHREADS + tid; i < 512 * 256; i += gridDim.x * NTHREADS) {
          if (i < 512 * 64) { const int c = i >> 6, m = i & 63; w2t[i] = (bf16_t)(cvt_pk_bf16(p.rw_w2[m * 512 + c], 0.f) & 0xffffu); }
          else if (i < 2 * 512 * 64) { const int q = i - 512 * 64, c = q >> 6, m = q & 63; a2t[q] = (bf16_t)(cvt_pk_bf16(p.rw_a2[m * 512 + c], 0.f) & 0xffffu); }
          else { const int q = i - 2 * 512 * 64, c = q >> 7, m = q & 127; g2t[q] = (bf16_t)(cvt_pk_bf16(p.rw_g2[m * 512 + c], 0.f) & 0xffffu); } } }
    {
        auto xrow = [&](int row, const f32x4 (&v)[4]) __attribute__((always_inline)) {
            float s = 0.f;
#pragma unroll
            for (int j = 0; j < 4; ++j) s += (v[j].x * v[j].x + v[j].y * v[j].y) + (v[j].z * v[j].z + v[j].w * v[j].w);
            s = wave_sum(s);
            u32x2* o = (u32x2*)(xb + (size_t)row * D) + lane;
#pragma unroll
            for (int j = 0; j < 4; ++j) { u32x2 w; w.x = cvt_pk_bf16(v[j].x, v[j].y); w.y = cvt_pk_bf16(v[j].z, v[j].w); o[64 * j] = w; }
            if (lane == 0) rstd1[row] = 1.0f / sqrtf(s * (1.0f / D) + 1e-6f);
        };
        for (int row = gw; row < T; row += 2 * NGW) {
            f32x4 v[4];
#pragma unroll
            for (int j = 0; j < 4; ++j) v[j] = na[j];
            if (row + 2 * NGW < T) {
#pragma unroll
                for (int j = 0; j < 4; ++j) na[j] = __builtin_nontemporal_load(((const f32x4*)(p.x + (size_t)(row + 2 * NGW) * D) + lane) + 64 * j);
            }
            xrow(row, v);
            if (row + NGW < T) {
#pragma unroll
                for (int j = 0; j < 4; ++j) v[j] = nb[j];
                if (row + 3 * NGW < T) {
#pragma unroll
                    for (int j = 0; j < 4; ++j) nb[j] = __builtin_nontemporal_load(((const f32x4*)(p.x + (size_t)(row + 3 * NGW) * D) + lane) + 64 * j);
                }
                xrow(row + NGW, v);
            }
        }
    }
    if (blockIdx.x == 0 && tid < 64) ((unsigned*)(p.ws + WS_CTL))[tid] = 0u;
}

struct EpiU {
    bf16_t* u; const float* rstd; int row0, col0; unsigned char* rkv;
    __device__ __forceinline__ void operator()(const f32x4 (&acc)[2][2][4][2], const unsigned (&m0)[8], const unsigned (&m1)[8], int wr, int wc, int fr, int fq, int mh) const {
        const bool isrkv = col0 >= UR && col0 < UXW;
        const int cbase = col0 - UR, mat = cbase >> 9, head0 = (cbase & 511) >> 6;
#pragma unroll
        for (int ai = 0; ai < 2; ++ai) if (mh < 0 || ai == mh)
#pragma unroll
            for (int m = 0; m < 4; ++m) { const int rl = ai * 128 + wr * 64 + m * 16 + fr, row = row0 + rl; const float rs = __uint_as_float(m0[ai * 4 + m]); bf16_t* rp = u + (size_t)row * NIN + col0 + wc * 32 + 8 * fq;
#pragma unroll
                for (int bj = 0; bj < 2; ++bj) { const f32x4 v0 = acc[ai][bj][m][0] * rs, v1 = acc[ai][bj][m][1] * rs;
                    const u32x4 o = (u32x4){cvt_pk_bf16(v0[0], v0[1]), cvt_pk_bf16(v0[2], v0[3]), cvt_pk_bf16(v1[0], v1[1]), cvt_pk_bf16(v1[2], v1[3])};
                    if (isrkv) *(u32x4*)(rkv + (((size_t)(row >> 5) * 3 + mat) * 8 + (head0 + 2 * bj + (wc >> 1))) * 4096 + fq * 1024 + ((wc & 1) * 32 + (row & 31)) * 16) = o;
                    else *(u32x4*)(rp + bj * 128) = o; } }
    }
};
__device__ __forceinline__ void phase1(const Params& p, LAS unsigned char* lds) {
    constexpr int nM = T / 256, nN = NIN / 256;
    g8::UnitIO cur, nxt; g8::aoff_rows(cur.aoff, D);
#pragma unroll
    for (int a = 0; a < 2; ++a)
#pragma unroll
        for (int b = 0; b < 2; ++b) nxt.aoff[a][b] = cur.aoff[a][b];
    cur.meta1 = nullptr; nxt.meta1 = nullptr;
    int pm = 0, pn = 0, L = 0, mh = -1;
    bool have = g8::sched_get(nM * nN, 0, L, mh);
    if (have) { g8::tile_order(L, nM, nN, pm, pn); cur.Ab = (const char*)(p.ws + WS_B) + (size_t)pm * 256 * D * 2; cur.Bb = (const char*)(p.ws + WS_WIN) + (size_t)pn * 256 * D * 2; cur.meta0 = (const unsigned*)(p.ws + WS_RSTD1) + pm * 256; }
    for (int i = 0; have; ++i) {
        int L2 = 0, mh2 = -1, pm2 = 0, pn2 = 0; const bool hn = g8::sched_get(nM * nN, i + 1, L2, mh2);
        if (hn) { g8::tile_order(L2, nM, nN, pm2, pn2); nxt.Ab = (const char*)(p.ws + WS_B) + (size_t)pm2 * 256 * D * 2; nxt.Bb = (const char*)(p.ws + WS_WIN) + (size_t)pn2 * 256 * D * 2; nxt.meta0 = (const unsigned*)(p.ws + WS_RSTD1) + pm2 * 256; }
        EpiU E{(bf16_t*)(p.ws + WS_A), (const float*)(p.ws + WS_RSTD1), pm * 256, pn * 256, (unsigned char*)(p.ws + WS_D)};
        g8::gemm_unit_p<16>(lds, cur, D, E, i & 1, i > 0, hn, nxt, mh);
        cur.Ab = nxt.Ab; cur.Bb = nxt.Bb; cur.meta0 = nxt.meta0; pm = pm2; pn = pn2; mh = mh2; have = hn;
    }
}


typedef short v4i16_t __attribute__((ext_vector_type(4)));
__device__ __forceinline__ s16x4 lds_tr16(const LAS unsigned char* p) { return __builtin_bit_cast(s16x4, __builtin_amdgcn_ds_read_tr16_b64_v4i16((LAS v4i16_t*)p)); }

__device__ __forceinline__ void attn_tile(const Params& p, LAS unsigned char* vl  , int b, int h, int qt) {
    const int lane = threadIdx.x & 63, r32 = lane & 31, hi = lane >> 5;
    const bf16_t* u = (const bf16_t*)(p.ws + WS_A);
    const size_t row0 = (size_t)b * S; const int q0 = qt * 32;
    bf16x8 qf[4];
    { const bf16_t* qp = u + (row0 + q0 + r32) * NIN + UQ + h * HD + 8 * hi;
#pragma unroll
      for (int s = 0; s < 4; ++s) qf[s] = *(const bf16x8*)(qp + 16 * s); }
    f32x16 o0, o1;
#pragma unroll
    for (int i = 0; i < 16; ++i) { o0[i] = 0.f; o1[i] = 0.f; }
    float carry = 0.f;
    const int kperm = 16 * ((r32 >> 2) & 1) + (r32 & 3) + 4 * (r32 >> 3);
    const int g = lane >> 4, i16 = lane & 15, tq = i16 >> 2, tp = i16 & 3;
    const LAS unsigned char* vrd = vl + (16 * (g >> 1) + tq) * 144 + (16 * (g & 1) + 4 * tp) * 2;
    LAS unsigned char* kl = vl + 4608;
    const int lrow = lane >> 3, lchk = lane & 7;
    const bf16_t* kvp = u + (row0 + lrow) * NIN + h * HD + lchk * 8;
    u32x4 kreg[4], vreg[4];
#pragma unroll
    for (int i = 0; i < 4; ++i) { const bf16_t* a = kvp + (size_t)(qt * 32 + 8 * i) * NIN; kreg[i] = *(const u32x4*)(a + UK); vreg[i] = *(const u32x4*)(a + UV); }
    for (int kb = qt; kb >= 0; --kb) {
        const int key0 = kb * 32;
#pragma unroll
        for (int i = 0; i < 4; ++i) { *(LAS u32x4*)(kl + (8 * i + lrow) * 144 + lchk * 16) = kreg[i]; *(LAS u32x4*)(vl + (8 * i + lrow) * 144 + lchk * 16) = vreg[i]; }
        if (kb > 0) {
#pragma unroll
            for (int i = 0; i < 4; ++i) { const bf16_t* a = kvp + (size_t)(key0 - 32 + 8 * i) * NIN; kreg[i] = *(const u32x4*)(a + UK); vreg[i] = *(const u32x4*)(a + UV); }
        }
        LDS_WAIT();
        f32x16 st;
#pragma unroll
        for (int i = 0; i < 16; ++i) st[i] = 0.f;
        { const LAS unsigned char* kp = kl + kperm * 144 + 16 * hi;
          bf16x8 kf[4];
#pragma unroll
          for (int s = 0; s < 4; ++s) kf[s] = *(const LAS bf16x8*)(kp + 32 * s);
#pragma unroll
          for (int s = 0; s < 4; ++s) st = __builtin_amdgcn_mfma_f32_32x32x16_bf16(kf[s], qf[s], st, 0, 0, 0); }
        const bool diag = (kb == qt);
        float lw[16], suf[16];
        float run = 0.f;
#pragma unroll
        for (int reg = 15; reg >= 0; --reg) {
            const float z = st[reg];
            const float l = flog2(1.0f + fexp2(-fabsf(z)));
            const float sp = fmaxf(z, 0.f) + l;
            const bool valid = !diag || (16 * hi + reg < r32);
            lw[reg] = valid ? (z - sp) : -1.0e30f;
            suf[reg] = run;
            run += valid ? -sp : 0.f;
        }
        const float other = swap32(run);
        const float tot_hi = hi ? run : other, tot_lo = hi ? other : run;
        const float base = carry + (hi ? 0.f : tot_hi);
        carry += tot_lo + tot_hi;
        unsigned pk[8];
#pragma unroll
        for (int j = 0; j < 8; ++j) pk[j] = cvt_pk_bf16(fexp2(lw[2 * j] + suf[2 * j] + base), fexp2(lw[2 * j + 1] + suf[2 * j + 1] + base));
        LDS_WAIT();
#pragma unroll
        for (int s2 = 0; s2 < 2; ++s2) {
            bf16x8 pf = __builtin_bit_cast(bf16x8, (u32x4){pk[4 * s2], pk[4 * s2 + 1], pk[4 * s2 + 2], pk[4 * s2 + 3]});
#pragma unroll
            for (int dh = 0; dh < 2; ++dh) {
                const s16x4 a = lds_tr16(vrd + (8 * s2) * 144 + 64 * dh), c = lds_tr16(vrd + (8 * s2 + 4) * 144 + 64 * dh);
                bf16x8 vf; vf[0] = a[0]; vf[1] = a[1]; vf[2] = a[2]; vf[3] = a[3]; vf[4] = c[0]; vf[5] = c[1]; vf[6] = c[2]; vf[7] = c[3];
                if (dh == 0) o0 = __builtin_amdgcn_mfma_f32_32x32x16_bf16(vf, pf, o0, 0, 0, 0); else o1 = __builtin_amdgcn_mfma_f32_32x32x16_bf16(vf, pf, o1, 0, 0, 0);
            }
        }
        LDS_WAIT();
        if (__builtin_amdgcn_ballot_w64(carry > -150.0f) == 0ull) break;
    }
    float ss = 0.f;
#pragma unroll
    for (int i = 0; i < 16; ++i) ss += o0[i] * o0[i] + o1[i] * o1[i];
    ss += swap32(ss);
    const float rs = 1.0f / sqrtf(ss * (1.0f / HD) + 1e-6f);
    bf16_t* op = (bf16_t*)(p.ws + WS_C) + (row0 + q0 + r32) * D + h * HD + 4 * hi;
    const float* gp = p.sb_out_g + h * HD + 4 * hi;
#pragma unroll
    for (int dh = 0; dh < 2; ++dh)
#pragma unroll
        for (int gq = 0; gq < 4; ++gq) {
            const f32x4 gg = *(const f32x4*)(gp + 32 * dh + 8 * gq);
            const f32x16& o = dh ? o1 : o0;
            u32x2 w; w.x = cvt_pk_bf16(o[4 * gq] * rs * gg[0], o[4 * gq + 1] * rs * gg[1]); w.y = cvt_pk_bf16(o[4 * gq + 2] * rs * gg[2], o[4 * gq + 3] * rs * gg[3]);
            *(u32x2*)(op + 32 * dh + 8 * gq) = w;
        }
}

constexpr size_t ACT_OFF = (size_t)64 << 20;
namespace rk {
constexpr int C = 32, NCH = S / C, NSLOT = 8;
constexpr int SL_PS = 0, SL_QS = 8192, SL_PO = 12288, SL_QO = 16384, SL_VR = 18432, SL_BON = 22528, SL_GW = 22784, SLOT_BYTES = 26880;
constexpr int MSTR = 144;
constexpr int PM_AT = 0, PM_RT = 4608, PM_BT = 9216, PM_KT = 13824, PM_GC = 18432, PROD_LDS = 18688;
constexpr int NPROD = 6;
constexpr int L_CONS = NPROD * PROD_LDS;
constexpr int OSTR = 272;
constexpr int L_OBUF = L_CONS + 4608;
constexpr int L_FLAG = L_OBUF + 32 * OSTR;
constexpr int L_W2 = L_FLAG + 256;
constexpr int L_A2 = L_W2 + 8192;
constexpr int L_G2 = L_A2 + 8192;
constexpr int L_CST = L_G2 + 16384;
constexpr int C_MUL = 0, C_MUR = 256, C_MUK = 320, C_MUV = 384, C_W0 = 448, C_A0 = 512, C_KK = 576, C_KA = 640, C_RK = 704, C_LNB = 768, C_END = 832;
static_assert(L_CST + C_END * 4 <= 161792, "rwkv LDS layout overflows");
}
__device__ __forceinline__ bf16x8 accfrag(const f32x16& a, int s) {
    return __builtin_bit_cast(bf16x8, (u32x4){cvt_pk_bf16(a[8 * s], a[8 * s + 1]), cvt_pk_bf16(a[8 * s + 2], a[8 * s + 3]), cvt_pk_bf16(a[8 * s + 4], a[8 * s + 5]), cvt_pk_bf16(a[8 * s + 6], a[8 * s + 7])});
}
__device__ __forceinline__ bf16x8 trfrag(const LAS unsigned char* mat, int s, int nt, int lane) {
    const int g = lane >> 4, i16 = lane & 15, q = i16 >> 2, pp = i16 & 3, h = g >> 1;
    const LAS unsigned char* a = mat + (16 * s + 4 * h + q) * rk::MSTR + (32 * nt + 16 * (g & 1) + 4 * pp) * 2;
    const s16x4 x = lds_tr16(a), y = lds_tr16(a + 8 * rk::MSTR);
    bf16x8 r; r[0] = x[0]; r[1] = x[1]; r[2] = x[2]; r[3] = x[3]; r[4] = y[0]; r[5] = y[1]; r[6] = y[2]; r[7] = y[3]; return r;
}
__device__ __forceinline__ void f8_from_bf16(const u32x4 w, float (&o)[8]) {
#pragma unroll
    for (int j = 0; j < 4; ++j) { o[2 * j] = bf16_lo(w[j]); o[2 * j + 1] = bf16_hi(w[j]); }
}
__device__ __forceinline__ f32x16 mfma32(bf16x8 a, bf16x8 b, f32x16 c) { return __builtin_amdgcn_mfma_f32_32x32x16_bf16(a, b, c, 0, 0, 0); }
__device__ __forceinline__ f32x16 zero16() { f32x16 z; for (int i = 0; i < 16; ++i) z[i] = 0.f; return z; }
__device__ __forceinline__ void um8(const bf16_t* urow  , bool has_prev, const float* mu, float (&o)[8]) {
    const u32x4 c = *(const u32x4*)urow; u32x4 pv = (u32x4){0u, 0u, 0u, 0u}; if (has_prev) pv = *(const u32x4*)(urow - NIN);
    const f32x4 m0 = *(const f32x4*)mu, m1 = *(const f32x4*)(mu + 4);
    float cv[8], pf[8]; f8_from_bf16(c, cv); f8_from_bf16(pv, pf);
#pragma unroll
    for (int j = 0; j < 4; ++j) { o[j] = cv[j] + (pf[j] - cv[j]) * m0[j]; o[4 + j] = cv[4 + j] + (pf[4 + j] - cv[4 + j]) * m1[j]; }
}
__device__ __forceinline__ void lerp8(const u32x4 c, const u32x4 pv, const LAS float* mu, float (&o)[8]) {
    const f32x4 m0 = *(const LAS f32x4*)mu, m1 = *(const LAS f32x4*)(mu + 4);
    float cv[8], pf[8]; f8_from_bf16(c, cv); f8_from_bf16(pv, pf);
#pragma unroll
    for (int j = 0; j < 4; ++j) { o[j] = cv[j] + (pf[j] - cv[j]) * m0[j]; o[4 + j] = cv[4 + j] + (pf[4 + j] - cv[4 + j]) * m1[j]; }
}
__device__ __forceinline__ void lerp8(const u32x4 c, const u32x4 pv, const float* mu, float (&o)[8]) {
    const f32x4 m0 = *(const f32x4*)mu, m1 = *(const f32x4*)(mu + 4);
    float cv[8], pf[8]; f8_from_bf16(c, cv); f8_from_bf16(pv, pf);
#pragma unroll
    for (int j = 0; j < 4; ++j) { o[j] = cv[j] + (pf[j] - cv[j]) * m0[j]; o[4 + j] = cv[4 + j] + (pf[4 + j] - cv[4 + j]) * m1[j]; }
}
__device__ __forceinline__ float shr1(float v) { return __builtin_bit_cast(float, __builtin_amdgcn_update_dpp(0, __builtin_bit_cast(int, v), 0x138, 0xF, 0xF, false)); }
__device__ __forceinline__ u32x4 prev4(const u32x4 c, const u32x4 p, bool first) {
    u32x4 r;
#pragma unroll
    for (int j = 0; j < 4; ++j) { const unsigned sh = (unsigned)__builtin_amdgcn_update_dpp(0, (int)c[j], 0x138, 0xF, 0xF, false); r[j] = first ? p[j] : sh; }
    return r;
}
__device__ __forceinline__ float scan32(float x) {
    x += dppf<0x111>(x); x += dppf<0x112>(x); x += dppf<0x114>(x); x += dppf<0x118>(x);
    const float bc = __builtin_bit_cast(float, __builtin_amdgcn_update_dpp(0, __builtin_bit_cast(int, x), 0x142, 0xA, 0xF, false));
    return x + bc;
}

__device__ __forceinline__ void rk_produce(const Params& p, LAS unsigned char* lds, LAS unsigned char* pl  , unsigned char* slot, int b, int hh, int c, volatile LAS unsigned* rdy_prev, unsigned rdy_val) {
    using namespace rk;
    int lane = threadIdx.x & 63; asm volatile("" : "+v"(lane));
    const int r32 = lane & 31, h = lane >> 5;
    const bf16_t* u = (const bf16_t*)(p.ws + WS_A);
    const size_t row0 = (size_t)b * S; const int t0 = c * C; const int tt = t0 + r32; const bool hp = tt > 0;
    const bf16_t* urow = u + (row0 + tt) * NIN; (void)urow;
    constexpr size_t RKV_CHUNK = (size_t)3 * 8 * 4096;
    const unsigned char* rkvb = (const unsigned char*)(p.ws + WS_D) + (size_t)(b * NCH + c) * RKV_CHUNK + (size_t)hh * 4096;
    const LAS float* cst = (const LAS float*)(lds + L_CST);
    const int jrow0 = 32 * ((r32 >> 2) & 1) + (r32 & 3) + 4 * (r32 >> 3);
    f32x16 lw[2], la[2], lg[2];
#pragma unroll
    for (int mt = 0; mt < 2; ++mt) { lw[mt] = zero16(); la[mt] = zero16(); lg[mt] = zero16(); }
    const int cb = hh * HD + 32 * h;
    u32x4 ck[4], pk4[4], cr[4], pr4[4];
    {
        const unsigned char* act = (const unsigned char*)p.out + ACT_OFF + ((size_t)b * NCH + c) * 16384 + lane * 16;
        u32x4 bw[4], ba[4], bg[8];
#pragma unroll
        for (int s = 0; s < 4; ++s) { bw[s] = *(const u32x4*)(act + s * 1024); ba[s] = *(const u32x4*)(act + (4 + s) * 1024); }
#pragma unroll
        for (int s = 0; s < 8; ++s) bg[s] = *(const u32x4*)(act + (8 + s) * 1024);
#pragma unroll
        for (int q = 0; q < 4; ++q) { ck[q] = *(const u32x4*)(rkvb + (size_t)8 * 4096 + q * 1024 + lane * 16); cr[q] = *(const u32x4*)(rkvb + q * 1024 + lane * 16); }
        asm volatile("s_waitcnt vmcnt(16)" ::: "memory");
        if (rdy_prev && (threadIdx.x & 63) == 0) *rdy_prev = rdy_val;
        {
            bf16x8 fw[2][4];
#pragma unroll
            for (int mt = 0; mt < 2; ++mt)
#pragma unroll
                for (int s = 0; s < 4; ++s) { const int jl = jrow0 + 16 * mt; fw[mt][s] = *(const LAS bf16x8*)(lds + L_W2 + jl * 128 + (((2 * s + h) ^ (jl & 7)) << 4)); }
#pragma unroll
            for (int s = 0; s < 4; ++s)
#pragma unroll
                for (int mt = 0; mt < 2; ++mt) lw[mt] = mfma32(fw[mt][s], __builtin_bit_cast(bf16x8, bw[s]), lw[mt]);
        }
        {
            bf16x8 fa[2][4];
#pragma unroll
            for (int mt = 0; mt < 2; ++mt)
#pragma unroll
                for (int s = 0; s < 4; ++s) { const int jl = jrow0 + 16 * mt; fa[mt][s] = *(const LAS bf16x8*)(lds + L_A2 + jl * 128 + (((2 * s + h) ^ (jl & 7)) << 4)); }
#pragma unroll
            for (int s = 0; s < 4; ++s)
#pragma unroll
                for (int mt = 0; mt < 2; ++mt) la[mt] = mfma32(fa[mt][s], __builtin_bit_cast(bf16x8, ba[s]), la[mt]);
        }
        asm volatile("" ::: "memory");
#pragma unroll
        for (int half = 0; half < 2; ++half) {
            bf16x8 fg[2][4];
#pragma unroll
            for (int mt = 0; mt < 2; ++mt)
#pragma unroll
                for (int s4 = 0; s4 < 4; ++s4) { const int s = 4 * half + s4, jl = jrow0 + 16 * mt; fg[mt][s4] = *(const LAS bf16x8*)(lds + L_G2 + jl * 256 + (((2 * s + h) ^ (jl & 7)) << 4)); }
#pragma unroll
            for (int s4 = 0; s4 < 4; ++s4)
#pragma unroll
                for (int mt = 0; mt < 2; ++mt) lg[mt] = mfma32(fg[mt][s4], __builtin_bit_cast(bf16x8, bg[4 * half + s4]), lg[mt]);
        }
        asm volatile("" ::: "memory");
#pragma unroll
        for (int q = 0; q < 4; ++q) { const unsigned char* a = rkvb + (size_t)8 * 4096 + q * 1024; const unsigned char* bq = rkvb + q * 1024;
            pk4[q] = (u32x4){0u, 0u, 0u, 0u}; pr4[q] = pk4[q];
            if (hp && r32 == 0) { pk4[q] = *(const u32x4*)(a - RKV_CHUNK + (h * 32 + 31) * 16); pr4[q] = *(const u32x4*)(bq - RKV_CHUNK + (h * 32 + 31) * 16); } }
    }
#pragma unroll
    for (int mt = 0; mt < 2; ++mt) {
        u32x4 w0, w1; w0.x = cvt_pk_bf16(lg[mt][0], lg[mt][1]); w0.y = cvt_pk_bf16(lg[mt][2], lg[mt][3]); w0.z = cvt_pk_bf16(lg[mt][4], lg[mt][5]); w0.w = cvt_pk_bf16(lg[mt][6], lg[mt][7]);
        w1.x = cvt_pk_bf16(lg[mt][8], lg[mt][9]); w1.y = cvt_pk_bf16(lg[mt][10], lg[mt][11]); w1.z = cvt_pk_bf16(lg[mt][12], lg[mt][13]); w1.w = cvt_pk_bf16(lg[mt][14], lg[mt][15]);
        *(u32x4*)(slot + SL_GW + (2 * mt) * 1024 + lane * 16) = w0; *(u32x4*)(slot + SL_GW + (2 * mt + 1) * 1024 + lane * 16) = w1;
    }
    asm volatile("" ::: "memory");
    float kl[32];
    float ssq = 0.f;
#pragma unroll
    for (int q = 0; q < 4; ++q) {
        float t8[8]; lerp8(ck[q], prev4(ck[q], pk4[q], r32 == 0), cst + C_MUK + 32 * h + 8 * q, t8);
        const f32x4 c0 = *(const LAS f32x4*)(cst + C_KK + 32 * h + 8 * q), c1 = *(const LAS f32x4*)(cst + C_KK + 32 * h + 8 * q + 4);
#pragma unroll
        for (int j = 0; j < 4; ++j) { const float x0 = t8[j] * c0[j], x1 = t8[4 + j] * c1[j]; ssq += x0 * x0 + x1 * x1; kl[8 * q + j] = t8[j]; kl[8 * q + 4 + j] = t8[4 + j]; }
    }
    ssq += swap32(ssq);
    const float kinv = frsq(fmaxf(ssq, 1e-24f));
    u32x4 cv4[4], pv4[4];
#pragma unroll
    for (int q = 0; q < 4; ++q) { const unsigned char* cq = rkvb + (size_t)2 * 8 * 4096 + q * 1024; cv4[q] = *(const u32x4*)(cq + lane * 16); pv4[q] = (u32x4){0u, 0u, 0u, 0u}; if (hp && r32 == 0) pv4[q] = *(const u32x4*)(cq - RKV_CHUNK + (h * 32 + 31) * 16); }
    f32x2 bonus2 = (f32x2){0.f, 0.f};
    LAS unsigned char* mAT = pl + PM_AT; LAS unsigned char* mRT = pl + PM_RT; LAS unsigned char* mBT = pl + PM_BT; LAS unsigned char* mKT = pl + PM_KT;
    LAS float* gc = (LAS float*)(pl + PM_GC);
#pragma unroll
    for (int mt = 0; mt < 2; ++mt) {
#pragma unroll
        for (int q8 = 0; q8 < 2; ++q8) {
            const int jl0 = 32 * h + 16 * mt + 8 * q8, q = 2 * mt + q8;
            float r8[8];
            lerp8(cr[q], prev4(cr[q], pr4[q], r32 == 0), cst + C_MUR + jl0, r8);
            float cw0[8], ca0[8], ckk[8], cka[8], crk[8];
#pragma unroll
            for (int e = 0; e < 2; ++e) { const f32x4 a = *(const LAS f32x4*)(cst + C_W0 + jl0 + 4 * e), bq = *(const LAS f32x4*)(cst + C_A0 + jl0 + 4 * e), cc = *(const LAS f32x4*)(cst + C_KK + jl0 + 4 * e), dd = *(const LAS f32x4*)(cst + C_KA + jl0 + 4 * e), ee = *(const LAS f32x4*)(cst + C_RK + jl0 + 4 * e);
#pragma unroll
                for (int j = 0; j < 4; ++j) { cw0[4 * e + j] = a[j]; ca0[4 * e + j] = bq[j]; ckk[4 * e + j] = cc[j]; cka[4 * e + j] = dd[j]; crk[4 * e + j] = ee[j]; } }
            float oa[8], orr[8], ob[8], ok[8], eg8[8];
#pragma unroll
            for (int e2 = 0; e2 < 4; ++e2) {
                const int e = 2 * e2, reg = 8 * q8 + e;
                const f32x2 tw = ((f32x2){cw0[e], cw0[e + 1]} + (f32x2){lw[mt][reg], lw[mt][reg + 1]}) * (-LOG2E);
                const f32x2 dw = (f32x2){fexp2(tw.x), fexp2(tw.y)} + 1.0f;
                const f32x2 ld = (f32x2){frcp(dw.x), frcp(dw.y)} * (-0.60653065971263342f);
                const f32x2 ta = ((f32x2){ca0[e], ca0[e + 1]} + (f32x2){la[mt][reg], la[mt][reg + 1]}) * (-LOG2E);
                const f32x2 da = (f32x2){fexp2(ta.x), fexp2(ta.y)} + 1.0f;
                const f32x2 al = (f32x2){frcp(da.x), frcp(da.y)};
                const f32x2 k2 = (f32x2){kl[8 * q + e], kl[8 * q + e + 1]}, r2 = (f32x2){r8[e], r8[e + 1]};
                const f32x2 kk = k2 * (f32x2){ckk[e], ckk[e + 1]} * kinv;
                const f32x2 kmod = k2 * (1.0f + (al - 1.0f) * (f32x2){cka[e], cka[e + 1]});
                const f32x2 bb = kk * al;
                bonus2 += r2 * kmod * (f32x2){crk[e], crk[e + 1]};
                const f32x2 Gl = (f32x2){scan32(ld.x), scan32(ld.y)} * LOG2E;
                const f32x2 eG = (f32x2){fexp2(Gl.x), fexp2(Gl.y)}, eiG = (f32x2){fexp2(-Gl.x), fexp2(-Gl.y)};
                f32x2 eGm = (f32x2){shr1(eG.x), shr1(eG.y)};
                if (r32 == 0) eGm = (f32x2){1.0f, 1.0f};
                const f32x2 va = -kk * eGm, vr = r2 * eG, vb = bb * eiG, vk = kmod * eiG;
                oa[e] = va.x; oa[e + 1] = va.y; orr[e] = vr.x; orr[e + 1] = vr.y; ob[e] = vb.x; ob[e + 1] = vb.y; ok[e] = vk.x; ok[e + 1] = vk.y; eg8[e] = eG.x; eg8[e + 1] = eG.y;
            }
            if (r32 == 31) { *(LAS f32x4*)(gc + jl0) = (f32x4){eg8[0], eg8[1], eg8[2], eg8[3]}; *(LAS f32x4*)(gc + jl0 + 4) = (f32x4){eg8[4], eg8[5], eg8[6], eg8[7]}; }
            const int off = r32 * MSTR + (32 * h + 16 * mt + 8 * q8) * 2;
            *(LAS u32x4*)(mAT + off) = (u32x4){cvt_pk_bf16(oa[0], oa[1]), cvt_pk_bf16(oa[2], oa[3]), cvt_pk_bf16(oa[4], oa[5]), cvt_pk_bf16(oa[6], oa[7])};
            *(LAS u32x4*)(mRT + off) = (u32x4){cvt_pk_bf16(orr[0], orr[1]), cvt_pk_bf16(orr[2], orr[3]), cvt_pk_bf16(orr[4], orr[5]), cvt_pk_bf16(orr[6], orr[7])};
            *(LAS u32x4*)(mBT + off) = (u32x4){cvt_pk_bf16(ob[0], ob[1]), cvt_pk_bf16(ob[2], ob[3]), cvt_pk_bf16(ob[4], ob[5]), cvt_pk_bf16(ob[6], ob[7])};
            *(LAS u32x4*)(mKT + off) = (u32x4){cvt_pk_bf16(ok[0], ok[1]), cvt_pk_bf16(ok[2], ok[3]), cvt_pk_bf16(ok[4], ok[5]), cvt_pk_bf16(ok[6], ok[7])};
            asm volatile("" ::: "memory");
        }
    }
    float bonus = bonus2.x + bonus2.y;
    bonus += swap32(bonus);
#pragma unroll
    for (int q = 0; q < 4; ++q) {
        float v8[8]; lerp8(cv4[q], prev4(cv4[q], pv4[q], r32 == 0), cst + C_MUV + 32 * h + 8 * q, v8);
        *(u32x4*)(slot + SL_VR + q * 1024 + lane * 16) = (u32x4){cvt_pk_bf16(v8[0], v8[1]), cvt_pk_bf16(v8[2], v8[3]), cvt_pk_bf16(v8[4], v8[5]), cvt_pk_bf16(v8[6], v8[7])};
    }
    *(float*)(slot + SL_BON + lane * 4) = bonus;
    LDS_WAIT();
    f32x16 nab = zero16(), nabT = zero16(), nakT = zero16(), mbr = zero16(), mkr = zero16();
#pragma unroll
    for (int s = 0; s < 4; ++s) {
        const int off = r32 * MSTR + (16 * s + 8 * h) * 2;
        const bf16x8 fa = *(const LAS bf16x8*)(mAT + off), fr = *(const LAS bf16x8*)(mRT + off), fb = *(const LAS bf16x8*)(mBT + off), fk = *(const LAS bf16x8*)(mKT + off);
        nab = mfma32(fb, fa, nab); nabT = mfma32(fa, fb, nabT); nakT = mfma32(fa, fk, nakT); mbr = mfma32(fb, fr, mbr); mkr = mfma32(fk, fr, mkr);
    }
#pragma unroll
    for (int reg = 0; reg < 16; ++reg) {
        const int row = (reg & 3) + 8 * (reg >> 2) + 4 * h;
        nab[reg] = row < r32 ? nab[reg] : 0.f;
        nabT[reg] = r32 < row ? nabT[reg] : 0.f;
        nakT[reg] = r32 < row ? nakT[reg] : 0.f;
        mbr[reg] = row <= r32 ? mbr[reg] : 0.f;
        mkr[reg] = row <= r32 ? mkr[reg] : 0.f;
    }
    f32x16 Y = nab;
#pragma unroll
    for (int reg = 0; reg < 16; ++reg) { const int row = (reg & 3) + 8 * (reg >> 2) + 4 * h; if (row == r32) Y[reg] += 1.0f; }
    {
        f32x16 M = nab, MT = nabT;
#pragma unroll
        for (int lvl = 0; lvl < 4; ++lvl) {
            const bf16x8 m0 = accfrag(M, 0), m1 = accfrag(M, 1), t0f = accfrag(MT, 0), t1f = accfrag(MT, 1);
            f32x16 M2T = mfma32(m0, t0f, zero16()); M2T = mfma32(m1, t1f, M2T);
            f32x16 M2 = zero16();
            if (lvl < 3) { M2 = mfma32(t0f, m0, M2); M2 = mfma32(t1f, m1, M2); }
            const bf16x8 y0 = accfrag(Y, 0), y1 = accfrag(Y, 1);
            Y = mfma32(accfrag(M2T, 0), y0, Y); Y = mfma32(accfrag(M2T, 1), y1, Y);
            M = M2; MT = M2T;
        }
    }
    int lane5 = lane; asm volatile("" : "+v"(lane5));
    const int r5 = lane5 & 31, h5 = lane5 >> 5;
    const bf16x8 ty0 = accfrag(Y, 0), ty1 = accfrag(Y, 1);
    f32x16 paT[2];
#pragma unroll
    for (int nt = 0; nt < 2; ++nt) { paT[nt] = mfma32(ty0, trfrag(mAT, 0, nt, lane5), zero16()); paT[nt] = mfma32(ty1, trfrag(mAT, 1, nt, lane5), paT[nt]); }
    f32x16 qakT = mfma32(ty0, accfrag(nakT, 0), zero16()); qakT = mfma32(ty1, accfrag(nakT, 1), qakT);
    const bf16x8 mb0 = accfrag(mbr, 0), mb1 = accfrag(mbr, 1);
#pragma unroll
    for (int mt = 0; mt < 2; ++mt) {
        f32x16 po;
#pragma unroll
        for (int g = 0; g < 4; ++g) { const u32x2 w = *(const LAS u32x2*)(mRT + r5 * MSTR + (32 * mt + 8 * g + 4 * h5) * 2);
            po[4 * g] = bf16_lo(w.x); po[4 * g + 1] = bf16_hi(w.x); po[4 * g + 2] = bf16_lo(w.y); po[4 * g + 3] = bf16_hi(w.y); }
        po = mfma32(accfrag(paT[mt], 0), mb0, po); po = mfma32(accfrag(paT[mt], 1), mb1, po);
#pragma unroll
        for (int sp = 0; sp < 2; ++sp)
            *(u32x4*)(slot + SL_PO + (2 * mt + sp) * 1024 + lane5 * 16) = (u32x4){cvt_pk_bf16(po[8 * sp], po[8 * sp + 1]), cvt_pk_bf16(po[8 * sp + 2], po[8 * sp + 3]), cvt_pk_bf16(po[8 * sp + 4], po[8 * sp + 5]), cvt_pk_bf16(po[8 * sp + 6], po[8 * sp + 7])};
    }
    {
        f32x16 qo = mfma32(accfrag(qakT, 0), mb0, mkr); qo = mfma32(accfrag(qakT, 1), mb1, qo);
#pragma unroll
        for (int sp = 0; sp < 2; ++sp) *(u32x4*)(slot + SL_QO + sp * 1024 + lane5 * 16) = (u32x4){cvt_pk_bf16(qo[8 * sp], qo[8 * sp + 1]), cvt_pk_bf16(qo[8 * sp + 2], qo[8 * sp + 3]), cvt_pk_bf16(qo[8 * sp + 4], qo[8 * sp + 5]), cvt_pk_bf16(qo[8 * sp + 6], qo[8 * sp + 7])};
    }
#pragma unroll
    for (int nt = 0; nt < 2; ++nt) {
        const bf16x8 bt0 = trfrag(mBT, 0, nt, lane5), bt1 = trfrag(mBT, 1, nt, lane5);
        const float gam = gc[32 * nt + r5];
#pragma unroll
        for (int mt = 0; mt < 2; ++mt) {
            f32x16 ps = zero16();
            if (mt == nt) {
#pragma unroll
                for (int reg = 0; reg < 16; ++reg) { const int row = (reg & 3) + 8 * (reg >> 2) + 4 * h5; ps[reg] = (row == r5) ? 1.0f : 0.f; }
            }
            ps = mfma32(accfrag(paT[mt], 0), bt0, ps); ps = mfma32(accfrag(paT[mt], 1), bt1, ps);
#pragma unroll
            for (int sp = 0; sp < 2; ++sp)
                *(u32x4*)(slot + SL_PS + ((nt * 2 + mt) * 2 + sp) * 1024 + lane5 * 16) = (u32x4){cvt_pk_bf16(ps[8 * sp] * gam, ps[8 * sp + 1] * gam), cvt_pk_bf16(ps[8 * sp + 2] * gam, ps[8 * sp + 3] * gam), cvt_pk_bf16(ps[8 * sp + 4] * gam, ps[8 * sp + 5] * gam), cvt_pk_bf16(ps[8 * sp + 6] * gam, ps[8 * sp + 7] * gam)};
        }
        f32x16 qs;
        { const bf16x8 k0 = trfrag(mKT, 0, nt, lane5), k1 = trfrag(mKT, 1, nt, lane5);
          const u32x4 w0 = __builtin_bit_cast(u32x4, k0), w1 = __builtin_bit_cast(u32x4, k1);
#pragma unroll
          for (int j = 0; j < 4; ++j) { qs[2 * j] = bf16_lo(w0[j]); qs[2 * j + 1] = bf16_hi(w0[j]); qs[8 + 2 * j] = bf16_lo(w1[j]); qs[8 + 2 * j + 1] = bf16_hi(w1[j]); } }
        qs = mfma32(accfrag(qakT, 0), bt0, qs); qs = mfma32(accfrag(qakT, 1), bt1, qs);
#pragma unroll
        for (int sp = 0; sp < 2; ++sp) *(u32x4*)(slot + SL_QS + (nt * 2 + sp) * 1024 + lane5 * 16) = (u32x4){cvt_pk_bf16(qs[8 * sp] * gam, qs[8 * sp + 1] * gam), cvt_pk_bf16(qs[8 * sp + 2] * gam, qs[8 * sp + 3] * gam), cvt_pk_bf16(qs[8 * sp + 4] * gam, qs[8 * sp + 5] * gam), cvt_pk_bf16(qs[8 * sp + 6] * gam, qs[8 * sp + 7] * gam)};
    }
    LDS_WAIT();
}

__device__ __forceinline__ u32x4 ntload16(const void* ptr) { return __builtin_nontemporal_load((const u32x4*)ptr); }
struct RkOps { u32x4 vr[4]; bf16x8 fps[2][2][2], fqs[2][2], fpo[2][2], fqo[2]; };
__device__ __forceinline__ void rk_load_ops_a(RkOps& o, const unsigned char* slot, int lane) {
    using namespace rk;
    const int r32 = lane & 31, h = lane >> 5;
#pragma unroll
    for (int k = 0; k < 4; ++k) o.vr[k] = ntload16(slot + SL_VR + k * 1024 + lane * 16);
#pragma unroll
    for (int jt = 0; jt < 2; ++jt)
#pragma unroll
        for (int s = 0; s < 2; ++s) o.fpo[jt][s] = __builtin_bit_cast(bf16x8, ntload16(slot + SL_PO + (2 * jt + s) * 1024 + lane * 16));
#pragma unroll
    for (int s = 0; s < 2; ++s) o.fqo[s] = __builtin_bit_cast(bf16x8, ntload16(slot + SL_QO + s * 1024 + lane * 16));
}
__device__ __forceinline__ void rk_load_ops_b(RkOps& o, const unsigned char* slot, int lane) {
    using namespace rk;
    const int r32 = lane & 31, h = lane >> 5;
#pragma unroll
    for (int mt = 0; mt < 2; ++mt) {
#pragma unroll
        for (int jt = 0; jt < 2; ++jt)
#pragma unroll
            for (int s = 0; s < 2; ++s) o.fps[mt][jt][s] = __builtin_bit_cast(bf16x8, ntload16(slot + SL_PS + ((mt * 2 + jt) * 2 + s) * 1024 + lane * 16));
#pragma unroll
        for (int s = 0; s < 2; ++s) o.fqs[mt][s] = __builtin_bit_cast(bf16x8, ntload16(slot + SL_QS + (mt * 2 + s) * 1024 + lane * 16));
    }
}
#define RK_SPIN(cond) do { unsigned _sp = 0; while (cond) { __builtin_amdgcn_s_sleep(1); if (++_sp > (1u << 24)) { err[0] = 1u; break; } } asm volatile("" ::: "memory"); } while (0)

__device__ __forceinline__ void rwkv_chain(const Params& p, LAS unsigned char* lds, int b, int hh) {
    using namespace rk;
    int tid = threadIdx.x; asm volatile("" : "+v"(tid));
    volatile LAS unsigned* ready = (volatile LAS unsigned*)(lds + L_FLAG); volatile LAS unsigned* freed = ready + NSLOT; volatile LAS unsigned* ofull = freed + NSLOT; volatile LAS unsigned* ofree = ofull + 2; volatile LAS unsigned* err = ofree + 2;
    if (tid < 2 * NSLOT + 5) ready[tid] = 0u;
    {
        const bf16_t* w2t = (const bf16_t*)(p.ws + WS_LT); const bf16_t* a2t = w2t + 512 * 64; const bf16_t* g2t = a2t + 512 * 64;
        for (int i = tid; i < 64 * 8; i += NTHREADS) { const int j = i >> 3, ch = i & 7, d = j * 128 + ((ch ^ (j & 7)) << 4);
            *(LAS u32x4*)(lds + L_W2 + d) = *(const u32x4*)(w2t + (hh * HD + j) * 64 + 8 * ch); *(LAS u32x4*)(lds + L_A2 + d) = *(const u32x4*)(a2t + (hh * HD + j) * 64 + 8 * ch); }
        for (int i = tid; i < 64 * 16; i += NTHREADS) { const int j = i >> 4, ch = i & 15; *(LAS u32x4*)(lds + L_G2 + j * 256 + ((ch ^ (j & 7)) << 4)) = *(const u32x4*)(g2t + (hh * HD + j) * 128 + 8 * ch); }
        LAS float* cst = (LAS float*)(lds + L_CST);
        for (int i = tid; i < C_END; i += NTHREADS) { float v;
            if (i < 256) v = p.shift_mu[(UXW - UR) + i];
            else if (i < 320) v = p.shift_mu[hh * HD + (i - 256)];
            else if (i < 384) v = p.shift_mu[(URK - UR) + hh * HD + (i - 320)];
            else if (i < 448) v = p.shift_mu[(URV - UR) + hh * HD + (i - 384)];
            else if (i < 512) v = p.rw_w0[hh * HD + (i - 448)];
            else if (i < 576) v = p.rw_a0[hh * HD + (i - 512)];
            else if (i < 640) v = p.rw_k_k[hh * HD + (i - 576)];
            else if (i < 704) v = p.rw_k_a[hh * HD + (i - 640)];
            else if (i < 768) v = p.rw_r_k[hh * HD + (i - 704)];
            else v = p.rw_ln_b[hh * HD + (i - 768)];
            cst[i] = v; }
    }
    __syncthreads();
    asm volatile("" : "+v"(tid));
    const int wave = __builtin_amdgcn_readfirstlane(tid >> 6);
    unsigned char* ring = (unsigned char*)p.out + (size_t)(b * NH + hh) * NSLOT * SLOT_BYTES;
    if (wave == 0) {
        int lane = tid & 63; asm volatile("" : "+v"(lane));
        const int r32 = lane & 31, h = lane >> 5;
        LAS unsigned char* vs = lds + L_CONS;
        f32x16 st[2][2];
#pragma unroll
        for (int a = 0; a < 2; ++a)
#pragma unroll
            for (int d = 0; d < 2; ++d) st[a][d] = zero16();
        RkOps ops;
        RK_SPIN(ready[0] != 1u);
        rk_load_ops_a(ops, ring, lane); rk_load_ops_b(ops, ring, lane);
        for (int c = 0; c < NCH; ++c) {
            bf16x8 sf[2][2][2];
#pragma unroll
            for (int jt = 0; jt < 2; ++jt)
#pragma unroll
                for (int it = 0; it < 2; ++it) { sf[jt][it][0] = accfrag(st[jt][it], 0); sf[jt][it][1] = accfrag(st[jt][it], 1); }
            { LAS unsigned char* d = vs + r32 * MSTR + h * 64;
              *(LAS u32x4*)d = ops.vr[0]; *(LAS u32x4*)(d + 16) = ops.vr[1]; *(LAS u32x4*)(d + 32) = ops.vr[2]; *(LAS u32x4*)(d + 48) = ops.vr[3]; }
            LDS_WAIT();
            bf16x8 vf[2][2];
            { const int g = lane >> 4, i16 = lane & 15, q = i16 >> 2, pp = i16 & 3;
#pragma unroll
              for (int it = 0; it < 2; ++it)
#pragma unroll
                  for (int s = 0; s < 2; ++s) { const LAS unsigned char* a = vs + (16 * s + 4 * h + q) * MSTR + (32 * it + 16 * (g & 1) + 4 * pp) * 2;
                      const s16x4 x = lds_tr16(a), y = lds_tr16(a + 8 * MSTR);
                      bf16x8 r; r[0] = x[0]; r[1] = x[1]; r[2] = x[2]; r[3] = x[3]; r[4] = y[0]; r[5] = y[1]; r[6] = y[2]; r[7] = y[3]; vf[it][s] = r; } }
            f32x16 o[2];
#pragma unroll
            for (int it = 0; it < 2; ++it) {
                o[it] = zero16();
#pragma unroll
                for (int jt = 0; jt < 2; ++jt)
#pragma unroll
                    for (int s = 0; s < 2; ++s) o[it] = mfma32(sf[jt][it][s], ops.fpo[jt][s], o[it]);
#pragma unroll
                for (int s = 0; s < 2; ++s) o[it] = mfma32(vf[it][s], ops.fqo[s], o[it]);
            }
            const unsigned char* nslot = ring + (size_t)((c + 1) % NSLOT) * SLOT_BYTES;
            if (c + 1 < NCH) { RK_SPIN(ready[(c + 1) % NSLOT] != (unsigned)(c + 2)); rk_load_ops_a(ops, nslot, lane); }
#pragma unroll
            for (int mt = 0; mt < 2; ++mt)
#pragma unroll
                for (int it = 0; it < 2; ++it) {
                    f32x16 a = zero16();
#pragma unroll
                    for (int jt = 0; jt < 2; ++jt)
#pragma unroll
                        for (int s = 0; s < 2; ++s) a = mfma32(ops.fps[mt][jt][s], sf[jt][it][s], a);
#pragma unroll
                    for (int s = 0; s < 2; ++s) a = mfma32(ops.fqs[mt][s], vf[it][s], a);
                    st[mt][it] = a;
                }
            if (c + 1 < NCH) rk_load_ops_b(ops, nslot, lane);
            if (c >= 1) RK_SPIN(ofree[0] != (unsigned)c);
            { LAS unsigned char* ob = lds + L_OBUF + r32 * OSTR;
#pragma unroll
              for (int it = 0; it < 2; ++it)
#pragma unroll
                  for (int g = 0; g < 4; ++g) *(LAS f32x4*)(ob + (32 * it + 8 * g + 4 * h) * 4) = (f32x4){o[it][4 * g], o[it][4 * g + 1], o[it][4 * g + 2], o[it][4 * g + 3]}; }
            LDS_WAIT();
            if (lane == 0) ofull[0] = (unsigned)(c + 1);
        }
    } else if (wave == 1) {
        int lane = tid & 63; asm volatile("" : "+v"(lane));
        const int r32 = lane & 31, h = lane >> 5;
        u32x4 gw[4], gb[4]; float bon;
        float lnw[32], lnb[32];
#pragma unroll
        for (int k = 0; k < 8; ++k) { const f32x4 l = *(const f32x4*)(p.rw_ln_w + hh * HD + 32 * h + 4 * k); lnw[4 * k] = l[0]; lnw[4 * k + 1] = l[1]; lnw[4 * k + 2] = l[2]; lnw[4 * k + 3] = l[3];
            const f32x4 lb = *(const f32x4*)(p.rw_ln_b + hh * HD + 32 * h + 4 * k); lnb[4 * k] = lb[0]; lnb[4 * k + 1] = lb[1]; lnb[4 * k + 2] = lb[2]; lnb[4 * k + 3] = lb[3]; }
        RK_SPIN(ready[0] != 1u);
#pragma unroll
        for (int k = 0; k < 4; ++k) { gw[k] = ntload16(ring + SL_GW + k * 1024 + lane * 16); gb[k] = ntload16(ring + SL_VR + k * 1024 + lane * 16); }
        bon = __builtin_nontemporal_load((const float*)(ring + SL_BON + lane * 4));
        for (int c = 0; c < NCH; ++c) {
            const int sl = c % NSLOT;
            RK_SPIN(ofull[0] != (unsigned)(c + 1));
            float ov[32];
            { const LAS unsigned char* ob = lds + L_OBUF + r32 * OSTR + 128 * h;
#pragma unroll
              for (int k = 0; k < 8; ++k) { const f32x4 x = *(const LAS f32x4*)(ob + 16 * k); ov[4 * k] = x[0]; ov[4 * k + 1] = x[1]; ov[4 * k + 2] = x[2]; ov[4 * k + 3] = x[3]; } }
            LDS_WAIT();
            if (lane == 0) ofree[0] = (unsigned)(c + 1);
            float sm = 0.f;
#pragma unroll
            for (int k = 0; k < 32; ++k) sm += ov[k];
            sm += swap32(sm);
            const float mean = sm * (1.0f / 64.0f);
            float sv = 0.f;
#pragma unroll
            for (int k = 0; k < 32; ++k) { const float d = ov[k] - mean; sv += d * d; }
            sv += swap32(sv);
            const float rstd = 1.0f / sqrtf(sv * (1.0f / 64.0f) + 64e-5f);
            bf16_t* mrow = (bf16_t*)(p.ws + WS_C) + ((size_t)b * S + c * C + r32) * D + 512 + hh * HD + 32 * h;
#pragma unroll
            for (int k = 0; k < 4; ++k) {
                float w8[8], b8[8], r[8]; f8_from_bf16(gw[k], w8); f8_from_bf16(gb[k], b8);
#pragma unroll
                for (int e = 0; e < 8; ++e) r[e] = ((ov[8 * k + e] - mean) * rstd * lnw[8 * k + e] + (lnb[8 * k + e] + bon * b8[e])) * w8[e];
                *(u32x4*)(mrow + 8 * k) = (u32x4){cvt_pk_bf16(r[0], r[1]), cvt_pk_bf16(r[2], r[3]), cvt_pk_bf16(r[4], r[5]), cvt_pk_bf16(r[6], r[7])};
            }
            if (lane == 0) freed[sl] = (unsigned)(c + 1);
            if (c + 1 < NCH) { const int sn = (c + 1) % NSLOT; const unsigned char* sp_ = ring + (size_t)sn * SLOT_BYTES; RK_SPIN(ready[sn] != (unsigned)(c + 2));
#pragma unroll
                for (int k = 0; k < 4; ++k) { gw[k] = ntload16(sp_ + SL_GW + k * 1024 + lane * 16); gb[k] = ntload16(sp_ + SL_VR + k * 1024 + lane * 16); }
                bon = __builtin_nontemporal_load((const float*)(sp_ + SL_BON + lane * 4)); }
        }
    } else {
        int lane = tid & 63;
        if (wave - 2 < NPROD) {
            int pc = -1;
            for (int c = wave - 2; c < NCH; c += NPROD) {
                const int sl = c % NSLOT;
                if (c >= NSLOT && freed[sl] != (unsigned)(c - NSLOT + 1)) {
                    if (pc >= 0) { asm volatile("s_waitcnt vmcnt(0)" ::: "memory"); if (lane == 0) ready[pc % NSLOT] = (unsigned)(pc + 1); pc = -1; }
                    RK_SPIN(freed[sl] != (unsigned)(c - NSLOT + 1));
                }
                rk_produce(p, lds, lds + (wave - 2) * PROD_LDS, ring + (size_t)sl * SLOT_BYTES, b, hh, c, pc >= 0 ? ready + (pc % NSLOT) : nullptr, (unsigned)(pc + 1));
                pc = c;
            }
            asm volatile("s_waitcnt vmcnt(0)" ::: "memory");
            if (pc >= 0 && lane == 0) ready[pc % NSLOT] = (unsigned)(pc + 1);
        }
    }
    __syncthreads();
}


__device__ __forceinline__ void phase2a(const Params& p) {
    int tid = threadIdx.x; asm volatile("" : "+v"(tid));
    const int wave = tid >> 6, lane = tid & 63, t8 = lane & 7, pl = lane >> 3;
    const bf16_t* u = (const bf16_t*)(p.ws + WS_A);
    unsigned char* act = (unsigned char*)p.out + ACT_OFF;
    const int ngrp = T / 8, stride = gridDim.x * NWAVES;
    for (int grp = blockIdx.x * NWAVES + wave; grp < ngrp; grp += stride) {
        const int row = grp * 8 + t8; const bool hp = (row & (S - 1)) != 0;
        const bf16_t* a = u + (size_t)row * NIN + UXW + 8 * pl;
        u32x4 c[4], pv[4];
#pragma unroll
        for (int it = 0; it < 4; ++it) { c[it] = *(const u32x4*)(a + 64 * it); pv[it] = (u32x4){0u, 0u, 0u, 0u}; if (hp) pv[it] = *(const u32x4*)(a + 64 * it - NIN); }
#pragma unroll
        for (int it = 0; it < 4; ++it) {
            const int pc = 8 * it + pl;
            float x[8]; lerp8(c[it], pv[it], p.shift_mu + (UXW - UR) + 8 * pc, x);
#pragma unroll
            for (int j = 0; j < 8; ++j) {
                if (it == 0) x[j] = 1.0f - 2.0f * frcp(1.0f + fexp2(x[j] * (2.0f * LOG2E)));
                else if (it >= 2) x[j] = frcp(1.0f + fexp2(-x[j] * LOG2E)); }
            *(u32x4*)(act + (size_t)(row >> 5) * 16384 + (pc >> 1) * 1024 + ((pc & 1) * 32 + (row & 31)) * 16) = (u32x4){cvt_pk_bf16(x[0], x[1]), cvt_pk_bf16(x[2], x[3]), cvt_pk_bf16(x[4], x[5]), cvt_pk_bf16(x[6], x[7])};
        }
    }
}

__device__ __forceinline__ void phase2(const Params& p, LAS unsigned char* lds) {
    const int nchain = NB * NH, G = gridDim.x, wave = threadIdx.x >> 6;
    const int nscan = G >= 2 * nchain ? nchain : (G > 1 ? G / 2 : 0);
    const bool ilv = (G == 256 && nscan == 128);
    const int slot_ = blockIdx.x >> 3, vidx = ilv ? ((slot_ >> 1) * 8 + (blockIdx.x & 7)) + ((slot_ & 1) ? nscan : 0) : (int)blockIdx.x;
    if (vidx < nscan || nscan == 0) {
        const int stride = nscan == 0 ? G : nscan;
        for (int it = vidx; it < nchain; it += stride) {
            int cb = it / NH, ch = it % NH;
            if (NB * NH == 128 && NH == 8) { cb = (it & 7) * 2 + (it >> 6); ch = (it >> 3) & 7; }
            rwkv_chain(p, lds, cb, ch);
        }
    }
    if (vidx >= nscan) {
        const int nb = G - nscan, bi = vidx - nscan;
        if (nb * 8 == 1024 && NB * NH * 64 == 8192) {
            const int li = (bi & 7) * (nb >> 3) + (bi >> 3), w = li * 8 + wave;
            for (int k = 0; k < 8; ++k) { const int bh = (w >> 6) * 8 + k, pos = ((w & 63) + 8 * k) & 63; attn_tile(p, lds + wave * 9216, bh / NH, bh % NH, pos); }
        } else
            for (int it = bi * 8 + wave; it < NB * NH * 64; it += nb * 8) attn_tile(p, lds + wave * 9216, it / (NH * 64), (it / 64) % NH, 63 - (it % 64));
        __syncthreads();
        p0_expert_weights(p, lds, bi * 8 + wave, nb * 8);
    }
}

struct EpiH {
    const bf16_t* xb; bf16_t* hb; int row0, col0;
    __device__ __forceinline__ void operator()(const f32x4 (&acc)[2][2][4][2], const unsigned (&m0)[8], const unsigned (&m1)[8], int wr, int wc, int fr, int fq, int mh) const {
#pragma unroll
        for (int ai = 0; ai < 2; ++ai) if (mh < 0 || ai == mh) {
            u32x4 xv[4][2];
#pragma unroll
            for (int m = 0; m < 4; ++m) { const size_t off = (size_t)(row0 + ai * 128 + wr * 64 + m * 16 + fr) * D + col0 + wc * 32 + 8 * fq;
#pragma unroll
                for (int bj = 0; bj < 2; ++bj) xv[m][bj] = *(const u32x4*)(xb + off + bj * 128); }
#pragma unroll
            for (int m = 0; m < 4; ++m) { const size_t off = (size_t)(row0 + ai * 128 + wr * 64 + m * 16 + fr) * D + col0 + wc * 32 + 8 * fq;
#pragma unroll
                for (int bj = 0; bj < 2; ++bj) { const u32x4 w = xv[m][bj];
                    const f32x4 v0 = (f32x4){bf16_lo(w.x), bf16_hi(w.x), bf16_lo(w.y), bf16_hi(w.y)} + acc[ai][bj][m][0], v1 = (f32x4){bf16_lo(w.z), bf16_hi(w.z), bf16_lo(w.w), bf16_hi(w.w)} + acc[ai][bj][m][1];
                    *(u32x4*)(hb + off + bj * 128) = (u32x4){cvt_pk_bf16(v0[0], v0[1]), cvt_pk_bf16(v0[2], v0[3]), cvt_pk_bf16(v1[0], v1[1]), cvt_pk_bf16(v1[2], v1[3])}; } }
            asm volatile("" ::: "memory");
        }
    }
};
__device__ __forceinline__ void phase3(const Params& p, LAS unsigned char* lds) {
    constexpr int nM = T / 256, nN = D / 256;
    g8::UnitIO cur, nxt; g8::aoff_rows(cur.aoff, D);
#pragma unroll
    for (int a = 0; a < 2; ++a)
#pragma unroll
        for (int b = 0; b < 2; ++b) nxt.aoff[a][b] = cur.aoff[a][b];
    cur.meta0 = nullptr; cur.meta1 = nullptr; nxt.meta0 = nullptr; nxt.meta1 = nullptr;
    int pm = 0, pn = 0; int L = blockIdx.x;
    if (L < nM * nN) { g8::tile_order(L, nM, nN, pm, pn); cur.Ab = (const char*)(p.ws + WS_C) + (size_t)pm * 256 * D * 2; cur.Bb = (const char*)(p.ws + WS_WOUT) + (size_t)pn * 256 * D * 2; }
    for (int i = 0; L < nM * nN; L += gridDim.x, ++i) {
        const bool hn = L + (int)gridDim.x < nM * nN; int pm2 = 0, pn2 = 0;
        if (hn) { g8::tile_order(L + gridDim.x, nM, nN, pm2, pn2); nxt.Ab = (const char*)(p.ws + WS_C) + (size_t)pm2 * 256 * D * 2; nxt.Bb = (const char*)(p.ws + WS_WOUT) + (size_t)pn2 * 256 * D * 2; }
        EpiH E{(const bf16_t*)(p.ws + WS_B), (bf16_t*)(p.ws + WS_A), pm * 256, pn * 256};
        g8::gemm_unit_p<16>(lds, cur, D, E, i & 1, i > 0, hn, nxt);
        cur.Ab = nxt.Ab; cur.Bb = nxt.Bb; pm = pm2; pn = pn2;
    }
}

__device__ __forceinline__ void phase4(const Params& p, LAS unsigned char* lds) {
    int tid = threadIdx.x; asm volatile("" : "+v"(tid));
    const int wave = tid >> 6, lane = tid & 63, fr = lane & 15, fq = lane >> 4;
    const float* hsrc = p.out; bf16_t* hb = (bf16_t*)(p.ws + WS_A); float* rstd2 = (float*)(p.ws + WS_RSTD2);
    const bf16_t* wr_hi = (const bf16_t*)(p.ws + WS_WR); const bf16_t* wr_lo = wr_hi + 48 * D;
    int* list = (int*)(p.ws + WS_LIST); float* listw = (float*)(p.ws + WS_LISTW); float* listr = (float*)(p.ws + WS_LISTR); unsigned* cnt = (unsigned*)(p.ws + WS_CTL);
    LAS float* lg = (LAS float*)(lds + wave * 3072);
    LAS unsigned* lcnt = (LAS unsigned*)(lds + 8 * 3072);
    LAS unsigned* gbase = lcnt + 32;
    for (int blk = blockIdx.x; blk < T / 128; blk += gridDim.x) {
        if (tid < 32) lcnt[tid] = 0u;
        __syncthreads();
        const int tok0 = blk * 128 + wave * 16;
        f32x4 acc[3];
#pragma unroll
        for (int n = 0; n < 3; ++n) acc[n] = (f32x4){0.f, 0.f, 0.f, 0.f};
        float ss = 0.f;
        const bf16_t* hbp = hb + (size_t)(tok0 + fr) * D + 8 * fq;
        LAS unsigned char* wl_ = lds + 32768;
#pragma unroll 1
        for (int half = 0; half < 2; ++half) {
            __syncthreads();
            for (int i = tid; i < 2 * 48 * 64; i += NTHREADS) { const int mat = i / 3072, r = (i % 3072) >> 6, ch = i & 63;
                *(LAS u32x4*)(wl_ + mat * 49152 + r * 1024 + ((ch ^ (r & 15)) << 4)) = *(const u32x4*)((mat ? wr_lo : wr_hi) + (size_t)r * D + half * 512 + ch * 8); }
            u32x4 av[16];
#pragma unroll
            for (int ks = 0; ks < 16; ++ks) av[ks] = *(const u32x4*)(hbp + half * 512 + 32 * ks);
            __syncthreads();
#pragma unroll
            for (int ks = 0; ks < 16; ++ks) {
                float f[8]; f8_from_bf16(av[ks], f);
                ss += (f[0] * f[0] + f[1] * f[1]) + (f[2] * f[2] + f[3] * f[3]) + ((f[4] * f[4] + f[5] * f[5]) + (f[6] * f[6] + f[7] * f[7]));
                const bf16x8 ah = __builtin_bit_cast(bf16x8, av[ks]);
#pragma unroll
                for (int n = 0; n < 3; ++n) {
                    const int r = 16 * n + fr, off = r * 1024 + (((4 * ks + fq) ^ (r & 15)) << 4);
                    const bf16x8 wh = *(const LAS bf16x8*)(wl_ + off), wl = *(const LAS bf16x8*)(wl_ + 49152 + off);
                    acc[n] = __builtin_amdgcn_mfma_f32_16x16x32_bf16(ah, wh, acc[n], 0, 0, 0);
                    acc[n] = __builtin_amdgcn_mfma_f32_16x16x32_bf16(ah, wl, acc[n], 0, 0, 0);
                }
            }
        }
        ss += __shfl_xor(ss, 16); ss += __shfl_xor(ss, 32);
        const float rs = 1.0f / sqrtf(ss * (1.0f / D) + 1e-6f);
        if (fq == 0) rstd2[tok0 + fr] = rs;
#pragma unroll
        for (int n = 0; n < 3; ++n)
#pragma unroll
            for (int r = 0; r < 4; ++r) lg[(4 * fq + r) * 48 + 16 * n + fr] = acc[n][r];
        LDS_WAIT();
        int e0 = 0, e1 = 0; float w0 = 0.f, w1 = 0.f; unsigned lp0 = 0, lp1 = 0;
        if (lane < 16) {
            const float rst = rs;
            const LAS float* L = lg + lane * 48;
            float gl[4]; int gi = 0; float gm;
#pragma unroll
            for (int g = 0; g < 4; ++g) gl[g] = L[g] * rst + p.r_grp_b[g];
            gm = gl[0];
#pragma unroll
            for (int g = 1; g < 4; ++g) if (gl[g] > gm) { gm = gl[g]; gi = g; }
            float gs = 0.f;
#pragma unroll
            for (int g = 0; g < 4; ++g) gs += __expf(gl[g] - gm);
            const float gval = 1.0f / gs;
            float el[8];
#pragma unroll
            for (int e = 0; e < 8; ++e) el[e] = L[4 + gi * 8 + e] * rst + p.r_exp_b[gi * 8 + e];
            int i0 = 0; float m0 = el[0];
#pragma unroll
            for (int e = 1; e < 8; ++e) if (el[e] > m0) { m0 = el[e]; i0 = e; }
            int i1 = i0 == 0 ? 1 : 0; float m1 = el[i1];
#pragma unroll
            for (int e = 0; e < 8; ++e) if (e != i0 && el[e] > m1) { m1 = el[e]; i1 = e; }
            const float x1 = __expf(m1 - m0); const float den = 1.0f / (1.0f + x1);
            e0 = gi * 8 + i0; e1 = gi * 8 + i1; w0 = gval * den; w1 = gval * x1 * den;
            lp0 = atomicAdd((unsigned*)&lcnt[e0], 1u); lp1 = atomicAdd((unsigned*)&lcnt[e1], 1u);
        }
        __syncthreads();
        if (tid < 32) gbase[tid] = atomicAdd(&cnt[tid], lcnt[tid]);
        __syncthreads();
        if (lane < 16) {
            const int tok = tok0 + lane;
            const unsigned q0 = gbase[e0] + lp0, q1 = gbase[e1] + lp1;
            list[(size_t)e0 * T + q0] = tok * 2;     listw[(size_t)e0 * T + q0] = w0; listr[(size_t)e0 * T + q0] = rs;
            list[(size_t)e1 * T + q1] = tok * 2 + 1; listw[(size_t)e1 * T + q1] = w1; listr[(size_t)e1 * T + q1] = rs;
        }
        __syncthreads();
    }
}

constexpr int LDS_MAP = 161792;
__device__ __forceinline__ void expert_map_build(const unsigned* cnt, LAS unsigned char* lds) {
    LAS int* pre = (LAS int*)(lds + LDS_MAP); LAS int* cn = pre + 40;
    if (threadIdx.x == 0) { int acc = 0; for (int i = 0; i < NE; ++i) { const int ci = (int)__hip_atomic_load(cnt + i, __ATOMIC_RELAXED, __HIP_MEMORY_SCOPE_AGENT); pre[i] = acc; cn[i] = ci; acc += (ci + 255) >> 8; } pre[NE] = acc; }
    __syncthreads();
}
__device__ __forceinline__ void expert_find(LAS unsigned char* lds, int mt, int& e, int& local, int& c) {
    const LAS int* pre = (const LAS int*)(lds + LDS_MAP); const LAS int* cn = pre + 40;
    int lo = 0;
#pragma unroll 1
    for (int i = 1; i < NE; ++i) if (pre[i] <= mt) lo = i;
    e = __builtin_amdgcn_readfirstlane(lo); local = mt - __builtin_amdgcn_readfirstlane(pre[e]); c = __builtin_amdgcn_readfirstlane(cn[e]);
}
__device__ __forceinline__ int expert_tiles(LAS unsigned char* lds) { return __builtin_amdgcn_readfirstlane(((const LAS int*)(lds + LDS_MAP))[NE]); }

struct EpiGU {
    bf16_t* hid; const float* rstd2; const int* lst; int cnt, p0, hrow0, ct;
    __device__ __forceinline__ void operator()(const f32x4 (&acc)[2][2][4][2], const unsigned (&m0)[8], const unsigned (&m1)[8], int wr, int wc, int fr, int fq, int mh) const {
#pragma unroll
        for (int ai = 0; ai < 2; ++ai) if (mh < 0 || ai == mh)
#pragma unroll
            for (int m = 0; m < 4; ++m) { const int r = ai * 128 + wr * 64 + m * 16 + fr; const int pp = p0 + r;
                const float rs = pp < cnt ? __uint_as_float(m0[ai * 4 + m]) : 0.f;
                bf16_t* op = hid + (size_t)(hrow0 + r) * DE + ct * 128 + wc * 32 + 8 * fq;
                float o[8];
#pragma unroll
                for (int n = 0; n < 2; ++n) { const f32x4 g = acc[ai][0][m][n] * rs, uu = acc[ai][1][m][n] * rs;
#pragma unroll
                    for (int j = 0; j < 4; ++j) o[4 * n + j] = g[j] * frcp(1.0f + fexp2(-g[j] * LOG2E)) * uu[j]; }
                *(u32x4*)op = (u32x4){cvt_pk_bf16(o[0], o[1]), cvt_pk_bf16(o[2], o[3]), cvt_pk_bf16(o[4], o[5]), cvt_pk_bf16(o[6], o[7])}; }
    }
};
__device__ __forceinline__ void phase5(const Params& p, LAS unsigned char* lds) {
    expert_map_build((const unsigned*)(p.ws + WS_CTL), lds);
    const int MT = expert_tiles(lds);
    int tid = threadIdx.x; asm volatile("" : "+v"(tid));
    int Rr[2], Cc[2];
#pragma unroll
    for (int i = 0; i < 2; ++i) g8::stage_rc(tid * 16 + i * 8192, Rr[i], Cc[i]);
    g8::UnitIO cur, nxt; cur.meta1 = nullptr; nxt.meta1 = nullptr;
    auto fill = [&](g8::UnitIO& io, int unit, int& e, int& c, int& p0, int& mt, int& ct) {
        mt = unit >> 1; ct = unit & 1; int local; expert_find(lds, mt, e, local, c); p0 = local * 256;
        const int* lst = (const int*)(p.ws + WS_LIST) + (size_t)e * T;
#pragma unroll
        for (int i = 0; i < 2; ++i)
#pragma unroll
            for (int hh = 0; hh < 2; ++hh) { const int pp = p0 + hh * 128 + Rr[i]; const int tok = pp < c ? (lst[pp] >> 1) : 0; io.aoff[hh][i] = (unsigned)(tok * D + Cc[i]) * 2u; }
        io.Ab = (const char*)(p.ws + WS_A); io.Bb = (const char*)(p.ws + WS_WGU) + ((size_t)e * 512 + ct * 256) * D * 2; io.meta0 = (const unsigned*)(p.ws + WS_LISTR) + (size_t)e * T + p0;
    };
    int e = 0, c = 0, p0 = 0, mt = 0, ct = 0, unit = 0, mh = -1;
    bool have = g8::sched_get(MT * 2, 0, unit, mh);
    if (have) fill(cur, unit, e, c, p0, mt, ct);
    for (int i = 0; have; ++i) {
        int unit2 = 0, mh2 = -1, e2 = 0, c2 = 0, p02 = 0, mt2 = 0, ct2 = 0; const bool hn = g8::sched_get(MT * 2, i + 1, unit2, mh2);
        if (hn) fill(nxt, unit2, e2, c2, p02, mt2, ct2);
        EpiGU E{(bf16_t*)(p.ws + WS_B), (const float*)(p.ws + WS_RSTD2), nullptr, c, p0, mt * 256, ct};
        g8::gemm_unit_p<8>(lds, cur, D, E, i & 1, i > 0, hn, nxt, mh);
        cur = nxt; e = e2; c = c2; p0 = p02; mt = mt2; ct = ct2; mh = mh2; have = hn;
    }
}
struct EpiDN {
    bf16_t* y; bf16_t* dummy; const int* lst; const float* lw; int cnt, p0, col0;
    __device__ __forceinline__ void operator()(const f32x4 (&acc)[2][2][4][2], const unsigned (&m0)[8], const unsigned (&m1)[8], int wr, int wc, int fr, int fq, int mh) const {
#pragma unroll
        for (int ai = 0; ai < 2; ++ai) if (mh < 0 || ai == mh)
#pragma unroll
            for (int m = 0; m < 4; ++m) { const int pp = p0 + ai * 128 + wr * 64 + m * 16 + fr;
                const bool ok = pp < cnt; const int rl = pp - p0; const int ent = (int)m0[ai * 4 + m]; const float w = __uint_as_float(m1[ai * 4 + m]);
                bf16_t* op = (ok ? y + ((size_t)(ent & 1) * T + (ent >> 1)) * D : dummy) + col0 + wc * 32 + 8 * fq;
#pragma unroll
                for (int bj = 0; bj < 2; ++bj) { const f32x4 v0 = acc[ai][bj][m][0] * w, v1 = acc[ai][bj][m][1] * w;
                    *(u32x4*)(op + bj * 128) = (u32x4){cvt_pk_bf16(v0[0], v0[1]), cvt_pk_bf16(v0[2], v0[3]), cvt_pk_bf16(v1[0], v1[1]), cvt_pk_bf16(v1[2], v1[3])}; }
                if (m & 1) asm volatile("" ::: "memory"); }
    }
};
__device__ __forceinline__ void phase6(const Params& p, LAS unsigned char* lds) {
    expert_map_build((const unsigned*)(p.ws + WS_CTL), lds);
    const int MT = expert_tiles(lds);
    constexpr int kdn = DE;
    g8::UnitIO cur, nxt; g8::aoff_rows(cur.aoff, kdn);
#pragma unroll
    for (int a = 0; a < 2; ++a)
#pragma unroll
        for (int b = 0; b < 2; ++b) nxt.aoff[a][b] = cur.aoff[a][b];
    auto fill = [&](g8::UnitIO& io, int unit, int& c, int& p0, int& pn) {
        const int mt = unit >> 2; pn = unit & 3; int e, local; expert_find(lds, mt, e, local, c); p0 = local * 256;
        io.Ab = (const char*)(p.ws + WS_B) + (size_t)mt * 256 * DE * 2; io.Bb = (const char*)(p.ws + WS_WDN) + ((size_t)e * D + pn * 256) * DE * 2;
        io.meta0 = (const unsigned*)(p.ws + WS_LIST) + (size_t)e * T + p0; io.meta1 = (const unsigned*)(p.ws + WS_LISTW) + (size_t)e * T + p0;
    };
    int c = 0, p0 = 0, pn = 0, unit = 0, mh = -1;
    bool have = g8::sched_get(MT * 4, 0, unit, mh);
    if (have) fill(cur, unit, c, p0, pn);
    for (int i = 0; have; ++i) {
        int unit2 = 0, mh2 = -1, c2 = 0, p02 = 0, pn2 = 0; const bool hn = g8::sched_get(MT * 4, i + 1, unit2, mh2);
        if (hn) fill(nxt, unit2, c2, p02, pn2);
        EpiDN E{(bf16_t*)(p.ws + WS_A + (size_t)T * D * 2), (bf16_t*)(p.ws + WS_A + (size_t)3 * T * D * 2), nullptr, nullptr, c, p0, pn * 256};
        g8::gemm_unit_p<16>(lds, cur, kdn, E, i & 1, i > 0, hn, nxt, mh);
        cur.Ab = nxt.Ab; cur.Bb = nxt.Bb; cur.meta0 = nxt.meta0; cur.meta1 = nxt.meta1; c = c2; p0 = p02; pn = pn2; mh = mh2; have = hn;
    }
}

__device__ __forceinline__ void phase7(const Params& p) {
    int tid7 = threadIdx.x; asm volatile("" : "+v"(tid7));
    const int wave = tid7 >> 6, lane = tid7 & 63;
    const bf16_t* hb = (const bf16_t*)(p.ws + WS_A);
    const bf16_t* y0 = (const bf16_t*)(p.ws + WS_A + (size_t)T * D * 2); const bf16_t* y1 = y0 + (size_t)T * D;
    f32x4 g[4];
#pragma unroll
    for (int j = 0; j < 4; ++j) g[j] = *((const f32x4*)p.final_g + lane + 64 * j);
    const int stride = gridDim.x * NWAVES;
    int row = blockIdx.x * NWAVES + wave;
    struct Row { u32x2 hv[4], ya[4], yb[4]; };
    auto ld = [&](Row& r, int rw) __attribute__((always_inline)) {
#pragma unroll
        for (int j = 0; j < 4; ++j) { r.hv[j] = ((const u32x2*)(hb + (size_t)rw * D) + lane)[64 * j]; r.ya[j] = ((const u32x2*)(y0 + (size_t)rw * D) + lane)[64 * j]; r.yb[j] = ((const u32x2*)(y1 + (size_t)rw * D) + lane)[64 * j]; }
    };
    Row ra, rb;
    if (row < T) ld(ra, row);
    if (row + stride < T) ld(rb, row + stride);
    auto one = [&](Row& r, int rw, int nrow) __attribute__((always_inline)) {
        f32x4 v[4]; float s = 0.f;
#pragma unroll
        for (int j = 0; j < 4; ++j) {
            v[j][0] = bf16_lo(r.hv[j].x) + (bf16_lo(r.ya[j].x) + bf16_lo(r.yb[j].x)); v[j][1] = bf16_hi(r.hv[j].x) + (bf16_hi(r.ya[j].x) + bf16_hi(r.yb[j].x));
            v[j][2] = bf16_lo(r.hv[j].y) + (bf16_lo(r.ya[j].y) + bf16_lo(r.yb[j].y)); v[j][3] = bf16_hi(r.hv[j].y) + (bf16_hi(r.ya[j].y) + bf16_hi(r.yb[j].y));
            s += (v[j][0] * v[j][0] + v[j][1] * v[j][1]) + (v[j][2] * v[j][2] + v[j][3] * v[j][3]); }
        if (nrow < T) ld(r, nrow);
        s = wave_sum(s);
        const float rs = 1.0f / sqrtf(s * (1.0f / D) + 1e-6f);
        f32x4* orow = (f32x4*)(p.out + (size_t)rw * D) + lane;
#pragma unroll
        for (int j = 0; j < 4; ++j) orow[64 * j] = v[j] * rs * g[j];
    };
    for (; row < T; row += 2 * stride) {
        one(ra, row, row + 2 * stride);
        if (row + stride < T) one(rb, row + stride, row + 3 * stride);
    }
}

__global__ __launch_bounds__(512) void mega(Params p) {
    extern __shared__ __attribute__((aligned(16))) unsigned char lds_raw[];
    LAS unsigned char* lds = (LAS unsigned char*)lds_raw;
    volatile LAS unsigned* bst = (volatile LAS unsigned*)(lds + LDS_MAP + 512);
    if (threadIdx.x == 0) { bst[0] = 0u; bst[1] = 0u; bst[2] = 0u; bst[3] = 0u; }
    __syncthreads();
    const XcdBarrier gb = xcd_barrier_post((unsigned*)(p.ws + WS_BAR), bst);
#define GSYNC() xcd_barrier(gb)
    phase0(p, lds); GSYNC();
    phase1(p, lds); GSYNC();
    { phase2a(p); GSYNC(); phase2(p, lds); } GSYNC();
    phase3(p, lds); GSYNC();
    phase4(p, lds); GSYNC();
    phase5(p, lds); GSYNC();
    phase6(p, lds); GSYNC();
    phase7(p);
}

extern "C" void kernel_launch(void* const* d_in, const int* in_sizes, int n_in, void* d_out, int out_size, void* d_ws, size_t ws_size, hipStream_t stream) {
    static int grid = 0;
    if (grid == 0) {
        if (n_in != 25 || out_size != T * D || ws_size < WS_END) { fprintf(stderr, "kernel_launch: unexpected sizes n_in %d out %d ws %zu (need %zu)\n", n_in, out_size, ws_size, (size_t)WS_END); grid = -1; return; }
        int dev = 0, cus = 0, per_cu = 0;
        (void)hipGetDevice(&dev); (void)hipDeviceGetAttribute(&cus, hipDeviceAttributeMultiprocessorCount, dev);
        if (hipFuncSetAttribute((const void*)mega, hipFuncAttributeMaxDynamicSharedMemorySize, LDS_BYTES) != hipSuccess) { fprintf(stderr, "kernel_launch: hipFuncSetAttribute failed\n"); grid = -1; return; }
        if (hipOccupancyMaxActiveBlocksPerMultiprocessor(&per_cu, (const void*)mega, NTHREADS, LDS_BYTES) != hipSuccess || per_cu < 1) { fprintf(stderr, "kernel_launch: occupancy query failed (%d)\n", per_cu); (void)hipGetLastError(); per_cu = 1; }
        grid = cus * 1;
    }
    if (grid < 0) return;
    Params p{};
    const float** f = (const float**)&p;
    for (int i = 0; i < 25; ++i) f[i] = (const float*)d_in[i];
    p.out = (float*)d_out; p.ws = (unsigned char*)d_ws;
    if (hipMemsetAsync((char*)d_ws + WS_BAR, 0, XCD_BAR_WORDS * 4, stream) != hipSuccess) { fprintf(stderr, "kernel_launch: memset failed\n"); return; }
    hipLaunchKernelGGL(mega, dim3(grid), dim3(NTHREADS), LDS_BYTES, stream, p);
    hipError_t e = hipPeekAtLastError();
    if (e != hipSuccess) fprintf(stderr, "launch failed: %s (grid %d)\n", hipGetErrorString(e), grid);
}
```
